# Optimizing an MI355X kernel written in HIP

```python
import math
import jax, jax.numpy as jnp
from jax import lax
import numpy as np

D_MODEL = 1024
BATCH = 4
SEQ = 8192
DEPTH = 2

N_META = 16
Q_BLOCK = 128
HEAD_DIM = 64
N_HEADS_A = D_MODEL // (2 * HEAD_DIM)
N_MAPS_A = 2 * N_HEADS_A
N_HEADS_B = D_MODEL // HEAD_DIM
N_BUCKETS = 32
MAX_EXACT = N_BUCKETS // 2
MAX_DISTANCE = 128
N_GROUPS = 4
EXPERTS_PER_GROUP = 8
N_EXPERTS = N_GROUPS * EXPERTS_PER_GROUP
TOP_K_IN_GROUP = 2
D_EXPERT = 512
N_MIXERS = 2
N_LAYERS_A = (DEPTH + 1) // 2
N_LAYERS_B = DEPTH // 2
DN_ALPHA = (2 * DEPTH) ** 0.25
DN_BETA = (8 * DEPTH) ** -0.25
LN_EPS = 1e-5
NEG_INF = -1e30

kernel_name = 'hybrid_diffattn_fox_hmoe_deepnorm'


def layer_norm(x, g, b):
    xf = x.astype(jnp.float32)
    mu = jnp.mean(xf, axis=-1, keepdims=True)
    var = jnp.mean(jnp.square(xf - mu), axis=-1, keepdims=True)
    y = (xf - mu) * lax.rsqrt(var + LN_EPS) * g.astype(jnp.float32) + b.astype(jnp.float32)
    return y.astype(x.dtype)


def rms_norm(x, w):
    xf = x.astype(jnp.float32)
    y = xf * lax.rsqrt(jnp.mean(xf * xf, axis=-1, keepdims=True) + LN_EPS) * w.astype(jnp.float32)
    return y.astype(x.dtype)


def t5_bucket(dist):
    n = jnp.maximum(dist, 0)
    nf = jnp.maximum(n, 1).astype(jnp.float32)
    large = MAX_EXACT + (jnp.log(nf / MAX_EXACT) / math.log(MAX_DISTANCE / MAX_EXACT)
                         * (N_BUCKETS - MAX_EXACT)).astype(jnp.int32)
    large = jnp.minimum(large, N_BUCKETS - 1)
    return jnp.where(n < MAX_EXACT, n, large)


def diff_lambda_init(layer_idx):
    return 0.8 - 0.6 * math.exp(-0.3 * layer_idx)


def sweep_causal_blocks(block_fn, seq_len):
    o_meta = block_fn(0, N_META)
    n_blocks = (seq_len - N_META) // Q_BLOCK
    o_real = lax.map(lambda j: block_fn(N_META + j * Q_BLOCK, Q_BLOCK),
                     jnp.arange(n_blocks, dtype=jnp.int32))
    nb, bsz, _, nh, e = o_real.shape
    o_real = jnp.transpose(o_real, (1, 0, 2, 3, 4)).reshape(bsz, nb * Q_BLOCK, nh, e)
    return jnp.concatenate([o_meta, o_real], axis=1)


def differential_attention(h, w_qkv, lam, subln_w, w_o, rel_bias, lambda_init):
    bsz, seq_len, d = h.shape
    qkv = h @ w_qkv
    q = qkv[..., :d].reshape(bsz, seq_len, N_MAPS_A, HEAD_DIM) * (HEAD_DIM ** -0.5)
    k = qkv[..., d:2 * d].reshape(bsz, seq_len, N_MAPS_A, HEAD_DIM)
    v = qkv[..., 2 * d:].reshape(bsz, seq_len, N_HEADS_A, 2 * HEAD_DIM)
    lamf = lam.astype(jnp.float32)
    lam_full = (jnp.exp(jnp.sum(lamf[0] * lamf[1])) - jnp.exp(jnp.sum(lamf[2] * lamf[3]))
                + lambda_init)
    bias_tab = rel_bias.astype(jnp.float32)
    k_pos = jnp.arange(seq_len, dtype=jnp.int32)

    def block_fn(start, size):
        q_blk = lax.dynamic_slice_in_dim(q, start, size, axis=1)
        q_pos = start + jnp.arange(size, dtype=jnp.int32)
        s = jnp.einsum('bqmd,bkmd->bmqk', q_blk, k, preferred_element_type=jnp.float32)
        dist = q_pos[:, None] - k_pos[None, :]
        s = s + jnp.transpose(bias_tab[t5_bucket(dist)], (2, 0, 1))[None]
        s = jnp.where((dist >= 0)[None, None], s, NEG_INF)
        p = jax.nn.softmax(s, axis=-1).reshape(bsz, N_HEADS_A, 2, size, seq_len)
        a = p[:, :, 0] - lam_full * p[:, :, 1]
        return jnp.einsum('bhqk,bkhe->bqhe', a.astype(v.dtype), v)

    o = sweep_causal_blocks(block_fn, seq_len)
    o = rms_norm(o, subln_w) * (1.0 - lambda_init)
    return o.reshape(bsz, seq_len, d) @ w_o


def forgetting_attention(h, w_in, b_f, w_o):
    bsz, seq_len, d = h.shape
    proj = h @ w_in
    q = proj[..., :d].reshape(bsz, seq_len, N_HEADS_B, HEAD_DIM) * (HEAD_DIM ** -0.5)
    k = proj[..., d:2 * d].reshape(bsz, seq_len, N_HEADS_B, HEAD_DIM)
    v = proj[..., 2 * d:3 * d].reshape(bsz, seq_len, N_HEADS_B, HEAD_DIM)
    log_f = jax.nn.log_sigmoid((proj[..., 3 * d:] + b_f).astype(jnp.float32))
    cum = jnp.transpose(jnp.cumsum(log_f, axis=1), (0, 2, 1))
    k_pos = jnp.arange(seq_len, dtype=jnp.int32)

    def block_fn(start, size):
        q_blk = lax.dynamic_slice_in_dim(q, start, size, axis=1)
        cum_q = lax.dynamic_slice_in_dim(cum, start, size, axis=2)
        q_pos = start + jnp.arange(size, dtype=jnp.int32)
        s = jnp.einsum('bqhd,bkhd->bhqk', q_blk, k, preferred_element_type=jnp.float32)
        s = s + cum_q[:, :, :, None] - cum[:, :, None, :]
        dist = q_pos[:, None] - k_pos[None, :]
        s = jnp.where((dist >= 0)[None, None], s, NEG_INF)
        p = jax.nn.softmax(s, axis=-1)
        return jnp.einsum('bhqk,bkhd->bqhd', p.astype(v.dtype), v)

    o = sweep_causal_blocks(block_fn, seq_len)
    return o.reshape(bsz, seq_len, d) @ w_o


def hierarchical_moe(h, w_rg, b_rg, w_re, b_re, w_gate, w_up, w_down):
    bsz, seq_len, d = h.shape
    t = h.reshape(-1, d)
    g_logits = (t @ w_rg + b_rg).astype(jnp.float32)
    g_prob = jax.nn.softmax(g_logits, axis=-1)
    g_sel = jnp.argmax(g_logits, axis=-1)
    p_group = jnp.take_along_axis(g_prob, g_sel[:, None], axis=1)[:, 0]
    e_logits = (jnp.einsum('nd,dge->nge', t, w_re) + b_re).astype(jnp.float32)
    e_in = jnp.take_along_axis(e_logits, g_sel[:, None, None], axis=1)[:, 0]
    top_v, top_i = lax.top_k(e_in, TOP_K_IN_GROUP)
    w_top = jax.nn.softmax(top_v, axis=-1)
    within = jnp.sum(w_top[..., None] * jax.nn.one_hot(top_i, EXPERTS_PER_GROUP), axis=1)
    gates = (p_group[:, None, None] * jax.nn.one_hot(g_sel, N_GROUPS)[:, :, None]
             * within[:, None, :]).reshape(-1, N_EXPERTS).astype(t.dtype)
    out = jnp.zeros_like(t)
    for e in range(N_EXPERTS):
        u = jax.nn.silu(t @ w_gate[e]) * (t @ w_up[e])
        out = out + gates[:, e:e + 1] * (u @ w_down[e])
    return out.reshape(bsz, seq_len, d)


def setup_inputs(seed: int = 0) -> dict:
    key = jax.random.key(seed)
    ks = jax.random.split(key, 24)
    d = D_MODEL
    nrm = jax.random.normal
    f32 = jnp.float32
    v_scale_a = jnp.concatenate([jnp.ones((2 * d,), f32), jnp.full((d,), DN_BETA, f32)])
    v_scale_b = jnp.concatenate([jnp.ones((2 * d,), f32), jnp.full((d,), DN_BETA, f32),
                                 jnp.ones((N_HEADS_B,), f32)])
    return {
        'x': nrm(ks[0], (BATCH, SEQ, d), f32),
        'meta_tokens': nrm(ks[1], (N_META, d), f32),
        'rel_bias': 0.5 * nrm(ks[2], (N_BUCKETS, N_MAPS_A), f32),
        'diff_w_qkv': nrm(ks[3], (N_LAYERS_A, d, 3 * d), f32) * (d ** -0.5) * v_scale_a,
        'diff_lambda': 0.1 * nrm(ks[4], (N_LAYERS_A, 4, HEAD_DIM), f32),
        'diff_subln': 1.0 + 0.02 * nrm(ks[5], (N_LAYERS_A, 2 * HEAD_DIM), f32),
        'diff_w_o': nrm(ks[6], (N_LAYERS_A, d, d), f32) * (d ** -0.5) * DN_BETA,
        'fox_w_in': nrm(ks[7], (N_LAYERS_B, d, 3 * d + N_HEADS_B), f32) * (d ** -0.5) * v_scale_b,
        'fox_b_f': jax.random.uniform(ks[8], (N_LAYERS_B, N_HEADS_B), f32, minval=1.0, maxval=4.0),
        'fox_w_o': nrm(ks[9], (N_LAYERS_B, d, d), f32) * (d ** -0.5) * DN_BETA,
        'ln_mix_g': 1.0 + 0.02 * nrm(ks[10], (DEPTH, d), f32),
        'ln_mix_b': 0.02 * nrm(ks[11], (DEPTH, d), f32),
        'ln_ffn_g': 1.0 + 0.02 * nrm(ks[12], (DEPTH, d), f32),
        'ln_ffn_b': 0.02 * nrm(ks[13], (DEPTH, d), f32),
        'router_group_w': nrm(ks[14], (DEPTH, d, N_GROUPS), f32) * (d ** -0.5),
        'router_group_b': 0.01 * nrm(ks[15], (DEPTH, N_GROUPS), f32),
        'router_expert_w': nrm(ks[16], (DEPTH, d, N_GROUPS, EXPERTS_PER_GROUP), f32) * (d ** -0.5),
        'router_expert_b': 0.01 * nrm(ks[17], (DEPTH, N_GROUPS, EXPERTS_PER_GROUP), f32),
        'expert_w_gate': nrm(ks[18], (DEPTH, N_EXPERTS, d, D_EXPERT), f32) * (d ** -0.5),
        'expert_w_up': nrm(ks[19], (DEPTH, N_EXPERTS, d, D_EXPERT), f32) * (d ** -0.5),
        'expert_w_down': nrm(ks[20], (DEPTH, N_EXPERTS, D_EXPERT, d), f32) * (D_EXPERT ** -0.5) * DN_BETA,
    }


def reference(x, meta_tokens, rel_bias, diff_w_qkv, diff_lambda, diff_subln, diff_w_o,
              fox_w_in, fox_b_f, fox_w_o, ln_mix_g, ln_mix_b, ln_ffn_g, ln_ffn_b,
              router_group_w, router_group_b, router_expert_w, router_expert_b,
              expert_w_gate, expert_w_up, expert_w_down):
    bsz = x.shape[0]
    meta = jnp.broadcast_to(meta_tokens[None].astype(x.dtype), (bsz, N_META, x.shape[-1]))
    h = jnp.concatenate([meta, x], axis=1)
    for i in range(DEPTH):
        j = i // N_MIXERS
        if i % N_MIXERS == 0:
            mix = differential_attention(h, diff_w_qkv[j], diff_lambda[j], diff_subln[j],
                                         diff_w_o[j], rel_bias, diff_lambda_init(i))
        else:
            mix = forgetting_attention(h, fox_w_in[j], fox_b_f[j], fox_w_o[j])
        h = layer_norm(DN_ALPHA * h + mix, ln_mix_g[i], ln_mix_b[i])
        ffn = hierarchical_moe(h, router_group_w[i], router_group_b[i], router_expert_w[i],
                               router_expert_b[i], expert_w_gate[i], expert_w_up[i], expert_w_down[i])
        h = layer_norm(DN_ALPHA * h + ffn, ln_ffn_g[i], ln_ffn_b[i])
    return h[:, N_META:]
```

```cpp
#include <hip/hip_runtime.h>
#include <hip/hip_bf16.h>
#include <cstdio>
#include <cstdint>
#include <cmath>

constexpr int DM = 1024, NBATCH = 4, SEQ = 8192, NMETA = 16;
constexpr int NREAL = NBATCH * SEQ;
constexpr int NR = NREAL + NMETA;
constexpr int NRP = 129 * 256;
constexpr int KPRE = 64;
constexpr int KROWS = KPRE + SEQ + 64;
constexpr int NSLOT = 2 * NR;
constexpr int NEXP = 32, DEXP = 512;
constexpr float ALPHA = 1.41421356237309515f;
constexpr float LN_EPS = 1e-5f;
constexpr float LOG2E = 1.4426950408889634f;
constexpr float LAMBDA_INIT0 = 0.2f;

namespace pg8 {
#define PG8_LAS __attribute__((address_space(3)))
typedef unsigned short bf16_t;
typedef short bf16x8 __attribute__((ext_vector_type(8)));
typedef float f32x4 __attribute__((ext_vector_type(4)));
typedef unsigned u32x4 __attribute__((ext_vector_type(4)));
constexpr int BM = 256, BK = 64, HALF = 128, HTB = HALF * BK * 2  , STAGE_BYTES = 8 * HTB, NXCD = 8, WGM = 8;

__host__ __device__ __forceinline__ int lds_byte(int r, int c) { const int st = (r >> 4) * 2 + (c >> 5), rr = r & 15, cc = c & 31, ob = rr * 64 + cc * 2; return st * 1024 + (ob ^ (((ob >> 9) & 1) << 5)); }
__host__ __device__ __forceinline__ void stage_rc(int b, int& R, int& C) { const int st = b / 1024, sb = b % 1024, swz = sb ^ (((sb >> 9) & 1) << 5); R = (st >> 1) * 16 + swz / 64; C = (st & 1) * 32 + (swz % 64) / 2; }
__host__ __device__ __forceinline__ int perm32(int rho) { const int n = rho >> 4, i = rho & 15; return 8 * (i >> 2) + 4 * n + (i & 3); }

struct Unit { int pm, pn; const char* A; const char* B; int tab; int e; };

struct StaticOrder {
    int nM, nN, nwg, G, c; const char* A; const char* B; size_t tsA, tsB;
    __device__ void init(int M, int N, int G_, int c_, const void* A_, size_t lda_bytes, const void* B_, size_t ldb_bytes) { nM = M / BM; nN = N / BM; nwg = nM * nN; G = G_; c = c_; A = (const char*)A_; B = (const char*)B_; tsA = lda_bytes * BM; tsB = ldb_bytes * BM; }
    __device__ bool next(int i, Unit& u) const {
        const long L = (long)i * G + c; if (L >= nwg) return false;
        int wgid = (int)L; { const int q = nwg / NXCD, r = nwg % NXCD, xcd = wgid % NXCD, off = wgid / NXCD; wgid = (xcd < r ? xcd * (q + 1) : r * (q + 1) + (xcd - r) * q) + off; }
        const int nig = WGM * nN, gid = wgid / nig, fm = gid * WGM, gsz = (nM - fm) < WGM ? (nM - fm) : WGM;
        u.pm = fm + ((wgid % nig) % gsz); u.pn = (wgid % nig) / gsz; u.A = A + (size_t)u.pm * tsA; u.B = B + (size_t)u.pn * tsB; u.tab = 0; u.e = 0; return true;
    }
};

__device__ __forceinline__ unsigned cvt_pk_bf16(float lo, float hi) { unsigned r; asm volatile("v_cvt_pk_bf16_f32 %0, %1, %2" : "=v"(r) : "v"(lo), "v"(hi)); return r; }

template <class Epi, class Sched, bool ALIGN_EPI, bool GATHER>
__device__ __forceinline__ void gemm_phase(PG8_LAS unsigned char* lds, const int K, const unsigned lda, const Sched& S, const Epi& E, const PG8_LAS int* rowtab, const int ashift) {
    int tid_ = threadIdx.x; asm volatile("" : "+v"(tid_));
    const int tid = tid_, wid = __builtin_amdgcn_readfirstlane(tid >> 6), lane = tid & 63, wr = wid >> 2, wc = wid & 3, fr = lane & 15, fq = lane >> 4;
    const int nt = K / BK;
    unsigned voffB[2], offA[2][2], noffA[2][2]; int Rr[2], Cc[2];
#pragma unroll
    for (int i = 0; i < 2; ++i) { int R, C; stage_rc(tid * 16 + i * 8192, R, C); const int Rb = Epi::PERM ? ((R & ~31) + perm32(R & 31)) : R; Rr[i] = R; Cc[i] = C;
        voffB[i] = (unsigned)(Rb * K + C) * 2u;
#pragma unroll
        for (int h = 0; h < 2; ++h) { offA[h][i] = (unsigned)(R + HALF * h) * lda + (unsigned)C * 2u; noffA[h][i] = offA[h][i]; } }
    const size_t kstep = (size_t)(BK * 2);
    const size_t hstep = (size_t)HALF * K * 2;
    const unsigned ldsw = (unsigned)wid * 1024u;
    const int aoff = lds_byte(wr * 64 + fr, fq * 8), boff = lds_byte(wc * 32 + fr, fq * 8);
#define PG8_SA(b, h) (((b) * 2 + (h)) * HTB)
#define PG8_SB(b, h) ((4 + (b) * 2 + (h)) * HTB)
#define PG8_STAGE(bufoff, gbase, voff) do { _Pragma("unroll") for (int _i = 0; _i < 2; ++_i) \
        __builtin_amdgcn_global_load_lds((const unsigned*)((const char*)(gbase) + (voff)[_i]), (PG8_LAS unsigned*)(lds + (bufoff) + ldsw + _i * 8192), 16, 0, 0); } while (0)
#define PG8_LDA(dst, b, h) do { _Pragma("unroll") for (int m = 0; m < 4; ++m) _Pragma("unroll") for (int k = 0; k < 2; ++k) dst[m][k] = *(const PG8_LAS bf16x8*)(lds + PG8_SA(b, h) + aoff + m * 2048 + k * 1024); } while (0)
#define PG8_LDB(dst, b, h) do { _Pragma("unroll") for (int n = 0; n < 2; ++n) _Pragma("unroll") for (int k = 0; k < 2; ++k) dst[n][k] = *(const PG8_LAS bf16x8*)(lds + PG8_SB(b, h) + boff + n * 2048 + k * 1024); } while (0)
#define PG8_MMA(ai, bj, At, Bt) do { __builtin_amdgcn_s_setprio(1); _Pragma("unroll") for (int m = 0; m < 4; ++m) _Pragma("unroll") for (int n = 0; n < 2; ++n) _Pragma("unroll") for (int k = 0; k < 2; ++k) \
        acc[ai][bj][m][n] = __builtin_amdgcn_mfma_f32_16x16x32_bf16(Bt[n][k], At[m][k], acc[ai][bj][m][n], 0, 0, 0); __builtin_amdgcn_s_setprio(0); } while (0)
#define PG8_WAIT_V(n) asm volatile("s_waitcnt vmcnt(" #n ")" ::: "memory")
#define PG8_WAIT_L(n) asm volatile("s_waitcnt lgkmcnt(" #n ")" ::: "memory")
#define PG8_BAR __builtin_amdgcn_s_barrier()
#define PG8_SCHED __builtin_amdgcn_sched_barrier(0)
#define PG8_GOFF(dst, u) do { if constexpr (GATHER) { _Pragma("unroll") for (int _h = 0; _h < 2; ++_h) _Pragma("unroll") for (int _i = 0; _i < 2; ++_i) { \
        int _e = rowtab[(u).tab * 256 + _h * HALF + Rr[_i]]; _e = _e < 0 ? 0 : (_e >> ashift); dst[_h][_i] = (unsigned)_e * lda + (unsigned)Cc[_i] * 2u; } } } while (0)
    Unit cur, nxt; int ui = 0;
    if (!S.next(0, cur)) return;
    f32x4 acc[2][2][4][2];
#pragma unroll
    for (int a = 0; a < 2; ++a)
#pragma unroll
        for (int b = 0; b < 2; ++b)
#pragma unroll
            for (int m = 0; m < 4; ++m)
#pragma unroll
                for (int n = 0; n < 2; ++n) acc[a][b][m][n] = (f32x4){0.f, 0.f, 0.f, 0.f};
    bf16x8 At[4][2], B0[2][2], B1[2][2];
    const char* cA = cur.A; const char* cB = cur.B;
    PG8_GOFF(offA, cur);
    PG8_STAGE(PG8_SB(0, 0), cB, voffB); PG8_STAGE(PG8_SB(0, 1), cB + hstep, voffB); PG8_STAGE(PG8_SA(0, 0), cA, offA[0]); PG8_STAGE(PG8_SA(0, 1), cA, offA[1]);
    if (wr == 1) PG8_BAR;
    PG8_WAIT_V(2); PG8_BAR;
    PG8_STAGE(PG8_SB(1, 0), cB + kstep, voffB); PG8_STAGE(PG8_SA(1, 0), cA + kstep, offA[0]); PG8_STAGE(PG8_SB(1, 1), cB + hstep + kstep, voffB);
    PG8_WAIT_V(6); PG8_BAR;
    for (;;) {
        const bool has_next = S.next(ui + 1, nxt);
        const char* nA = has_next ? nxt.A : cA; const char* nB = has_next ? nxt.B : cB;
        if constexpr (GATHER) { if (has_next) PG8_GOFF(noffA, nxt); else {
#pragma unroll
            for (int h = 0; h < 2; ++h)
#pragma unroll
                for (int i = 0; i < 2; ++i) noffA[h][i] = offA[h][i]; } }
        for (int t = 0; t < nt; t += 2) {
            const bool last = (t == nt - 2);
            const char* a1 = cA + (size_t)(t + 1) * kstep;
            const char* a2 = last ? nA : cA + (size_t)(t + 2) * kstep; const char* b2 = last ? nB : cB + (size_t)(t + 2) * kstep;
            const char* a3 = a2 + kstep; const char* b3 = b2 + kstep;
            unsigned o2[2][2];
#pragma unroll
            for (int h = 0; h < 2; ++h)
#pragma unroll
                for (int i = 0; i < 2; ++i) o2[h][i] = (GATHER && last) ? noffA[h][i] : offA[h][i];
            PG8_LDB(B0, 0, 0); PG8_LDB(B1, 0, 1); PG8_SCHED; PG8_LDA(At, 0, 0); PG8_STAGE(PG8_SA(1, 1), a1, offA[1]);
            PG8_WAIT_V(8); PG8_WAIT_L(0); PG8_BAR; PG8_MMA(0, 0, At, B0); PG8_MMA(0, 1, At, B1); PG8_BAR; PG8_SCHED;
            PG8_LDA(At, 0, 1); PG8_STAGE(PG8_SB(0, 0), b2, voffB); PG8_STAGE(PG8_SB(0, 1), b2 + hstep, voffB); PG8_STAGE(PG8_SA(0, 0), a2, o2[0]);
            PG8_WAIT_V(8); PG8_WAIT_L(0); PG8_BAR; PG8_MMA(1, 0, At, B0); PG8_MMA(1, 1, At, B1); PG8_BAR; PG8_SCHED;
            PG8_LDB(B0, 1, 0); PG8_LDB(B1, 1, 1); PG8_SCHED; PG8_LDA(At, 1, 0); PG8_STAGE(PG8_SA(0, 1), a2, o2[1]);
            PG8_WAIT_V(8); PG8_WAIT_L(0); PG8_BAR; PG8_MMA(0, 0, At, B0); PG8_MMA(0, 1, At, B1); PG8_BAR; PG8_SCHED;
            PG8_LDA(At, 1, 1); PG8_STAGE(PG8_SB(1, 0), b3, voffB); PG8_STAGE(PG8_SB(1, 1), b3 + hstep, voffB); PG8_STAGE(PG8_SA(1, 0), a3, o2[0]);
            PG8_WAIT_V(8); PG8_WAIT_L(0); PG8_BAR; PG8_MMA(1, 0, At, B0); PG8_MMA(1, 1, At, B1); PG8_BAR; PG8_SCHED;
        }
        if constexpr (ALIGN_EPI) { if (wr == 0) PG8_BAR; }
        E(acc, cur, wr, wc, fr, fq, rowtab);
        if (!has_next) break;
#pragma unroll
        for (int a = 0; a < 2; ++a)
#pragma unroll
            for (int b = 0; b < 2; ++b)
#pragma unroll
                for (int m = 0; m < 4; ++m)
#pragma unroll
                    for (int n = 0; n < 2; ++n) acc[a][b][m][n] = (f32x4){0.f, 0.f, 0.f, 0.f};
        cur = nxt; cA = nA; cB = nB; ++ui;
        if constexpr (GATHER) {
#pragma unroll
            for (int h = 0; h < 2; ++h)
#pragma unroll
                for (int i = 0; i < 2; ++i) offA[h][i] = noffA[h][i]; }
        if constexpr (ALIGN_EPI) { if (wr == 1) PG8_BAR; }
    }
    PG8_WAIT_V(0);
    if constexpr (!ALIGN_EPI) { if (wr == 0) PG8_BAR; }
    PG8_BAR;
#undef PG8_SA
#undef PG8_SB
#undef PG8_STAGE
#undef PG8_LDA
#undef PG8_LDB
#undef PG8_MMA
#undef PG8_WAIT_V
#undef PG8_WAIT_L
#undef PG8_BAR
#undef PG8_SCHED
#undef PG8_GOFF
}

struct EpiQKV {
    static constexpr bool PERM = true;
    bf16_t* Q; bf16_t* Kb; bf16_t* Vb; float qscale;
    __device__ __forceinline__ void operator()(const f32x4 (&acc)[2][2][4][2], const Unit& u, int wr, int wc, int fr, int fq, const PG8_LAS int*) const {
        const int row0 = u.pm * BM + wr * 64 + fr; const int t = (u.pn * BM) >> 10; const int colt = (u.pn * BM) & 1023;
        const int col0 = colt + wc * 32 + 8 * fq; const float sc = (t == 0) ? qscale : 1.f;
        bf16_t* kv = (t == 1) ? Kb : Vb;
#pragma unroll
        for (int ai = 0; ai < 2; ++ai)
#pragma unroll
            for (int m = 0; m < 4; ++m) { const int r = row0 + ai * HALF + m * 16;
                if (r < NR) {
#pragma unroll
                for (int bj = 0; bj < 2; ++bj) { const f32x4 v0 = acc[ai][bj][m][0] * sc, v1 = acc[ai][bj][m][1] * sc;
                    u32x4 w; w.x = cvt_pk_bf16(v0[0], v0[1]); w.y = cvt_pk_bf16(v0[2], v0[3]); w.z = cvt_pk_bf16(v1[0], v1[1]); w.w = cvt_pk_bf16(v1[2], v1[3]);
                    const int c = col0 + bj * HALF;
                    bf16_t* dst = (t == 0) ? Q + (size_t)r * DM : kv + (size_t)(r < NREAL ? (r >> 13) * KROWS + KPRE + (r & (SEQ - 1)) : r - NREAL) * DM;
                    *(u32x4*)(dst + c) = w; } } }
    }
};
struct EpiZ {
    static constexpr bool PERM = false;
    const float* base_real; const float* base_meta; float* out_real; float* out_meta;
    __device__ __forceinline__ void operator()(const f32x4 (&acc)[2][2][4][2], const Unit& u, int wr, int wc, int fr, int fq, const PG8_LAS int*) const {
        const int row0 = u.pm * BM + wr * 64 + fr; const int col0 = u.pn * BM + wc * 32 + 4 * fq;
#pragma unroll
        for (int ai = 0; ai < 2; ++ai)
#pragma unroll
            for (int m = 0; m < 4; ++m) { const int r = row0 + ai * HALF + m * 16;
                if (r < NR) { const float* bp = r < NREAL ? base_real + (size_t)r * DM : base_meta + (size_t)(r - NREAL) * DM; float* op = r < NREAL ? out_real + (size_t)r * DM : out_meta + (size_t)(r - NREAL) * DM;
#pragma unroll
                    for (int bj = 0; bj < 2; ++bj)
#pragma unroll
                        for (int n = 0; n < 2; ++n) { const int c = col0 + bj * HALF + n * 16; const f32x4 bs = *(const f32x4*)(bp + c); *(f32x4*)(op + c) = acc[ai][bj][m][n] + bs * ALPHA; } } }
    }
};
struct EpiGU {
    static constexpr bool PERM = true;
    bf16_t* U;
    __device__ __forceinline__ void operator()(const f32x4 (&acc)[2][2][4][2], const Unit& u, int wr, int wc, int fr, int fq, const PG8_LAS int* rowtab) const {
        const int col0 = u.pn * HALF + wc * 32 + 8 * fq;
#pragma unroll
        for (int ai = 0; ai < 2; ++ai)
#pragma unroll
            for (int m = 0; m < 4; ++m) { const int slot = rowtab[u.tab * 256 + ai * HALF + wr * 64 + m * 16 + fr];
                if (slot >= 0) { float o[8];
#pragma unroll
                    for (int n = 0; n < 2; ++n)
#pragma unroll
                        for (int c = 0; c < 4; ++c) { const float g = acc[ai][0][m][n][c], up = acc[ai][1][m][n][c]; o[n * 4 + c] = g * up * __builtin_amdgcn_rcpf(1.f + __builtin_amdgcn_exp2f(-g * LOG2E)); }
                    u32x4 w; w.x = cvt_pk_bf16(o[0], o[1]); w.y = cvt_pk_bf16(o[2], o[3]); w.z = cvt_pk_bf16(o[4], o[5]); w.w = cvt_pk_bf16(o[6], o[7]);
                    *(u32x4*)(U + (size_t)slot * DEXP + col0) = w; } }
    }
};
struct EpiDown {
    static constexpr bool PERM = true;
    bf16_t* Y; const float* GV;
    __device__ __forceinline__ void operator()(const f32x4 (&acc)[2][2][4][2], const Unit& u, int wr, int wc, int fr, int fq, const PG8_LAS int* rowtab) const {
        const int col0 = u.pn * BM + wc * 32 + 8 * fq;
#pragma unroll
        for (int ai = 0; ai < 2; ++ai)
#pragma unroll
            for (int m = 0; m < 4; ++m) { const int slot = rowtab[u.tab * 256 + ai * HALF + wr * 64 + m * 16 + fr];
                if (slot >= 0) { const float gv = GV[slot];
#pragma unroll
                    for (int bj = 0; bj < 2; ++bj) { const f32x4 v0 = acc[ai][bj][m][0] * gv, v1 = acc[ai][bj][m][1] * gv;
                        u32x4 w; w.x = cvt_pk_bf16(v0[0], v0[1]); w.y = cvt_pk_bf16(v0[2], v0[3]); w.z = cvt_pk_bf16(v1[0], v1[1]); w.w = cvt_pk_bf16(v1[2], v1[3]);
                        *(u32x4*)(Y + (size_t)slot * DM + col0 + bj * HALF) = w; } } }
    }
};
}
namespace attn_body {
using bf16=__hip_bfloat16;
using bf16x8=__attribute__((ext_vector_type(8)))short;
using s16x4=__attribute__((ext_vector_type(4)))short;
using f32x16=__attribute__((ext_vector_type(16)))float;
using u32x4=__attribute__((ext_vector_type(4)))unsigned;
constexpr int D=64;
constexpr int NW=8,QBLK=32,QB=QBLK*NW,KVBLK=64,NQB=SEQ/QB;
constexpr int ATTN_PITCH=DM, ATTN_UNIT_ROWS=QB;
__device__ __forceinline__ int crow(int r,int hi){return (r&3)+8*(r>>2)+4*hi;}
#define SBAR() __builtin_amdgcn_sched_barrier(0)
__device__ __forceinline__ void cmask(f32x16&p0,f32x16&p1,int jb,int qrel,int hi){
  const float NEG=-INFINITY; int kb=64*jb+4*hi;
  #pragma unroll
  for(int r=0;r<16;++r){int kv=kb+(r&3)+8*(r>>2); if(kv>qrel)p0[r]=NEG; if(kv+32>qrel)p1[r]=NEG;}
}


template<int MODE> __device__ __forceinline__ void modtile_slow(f32x16&p0,f32x16&p1,int t,int q_abs,int hi,const __attribute__((address_space(3))) float* tab){
  const float NEG=-INFINITY; int hi4=4*hi; asm volatile("":"+v"(hi4),"+v"(q_abs));
  #pragma unroll
  for(int r=0;r<16;++r){
    #pragma unroll
    for(int hf=0;hf<2;++hf){
      const int js=32*hf+(r&3)+8*(r>>2)+hi4;
      const int ks=64*t+js;
      float x=hf?p1[r]:p0[r];
      if(t==0){ if(js>=NMETA)x=NEG; else { if(MODE==0){int d=16+q_abs-js; d=d>127?127:d; x+=tab[d];} else x+=tab[ks]; } }
      else { const int kr=ks-KPRE; if(kr>q_abs)x=NEG; else { if(MODE==0){int d=q_abs-kr; d=d>127?127:d; x+=tab[d];} else x+=tab[ks]; } }
      if(hf)p1[r]=x; else p0[r]=x; }
    if((r&1)==1)asm volatile("":::"memory"); }
}
__device__ __forceinline__ void modtile_fast1(f32x16&p0,f32x16&p1,int t,int hi,const __attribute__((address_space(3))) float* tab){
  typedef float f4 __attribute__((ext_vector_type(4)));
  const __attribute__((address_space(3))) f4* tp=(const __attribute__((address_space(3))) f4*)(tab+64*t+4*hi);
  #pragma unroll
  for(int g=0;g<4;++g){ const f4 a=tp[2*g], b=tp[8+2*g];
    #pragma unroll
    for(int c=0;c<4;++c){ p0[4*g+c]+=a[c]; p1[4*g+c]+=b[c]; } }
}
constexpr int NSLOT=3, SLOTB=8192;
constexpr int LDS_K=0, LDS_V=NSLOT*SLOTB, LDS_WS=2*NSLOT*SLOTB, LDS_OST=LDS_WS+NW*64*4, LDS_TAB=LDS_OST+NW*4096, LDS_BYTES=LDS_TAB+KROWS*4;
constexpr float C2=0.125f*1.4426950408889634f;
__device__ __forceinline__ void glds16(const void*gsrc,unsigned lds_dst){unsigned keep;
  asm volatile("s_mov_b32 %0, m0\n\ts_mov_b32 m0, %2\n\ts_nop 0\n\tglobal_load_lds_dwordx4 %1, off\n\ts_mov_b32 m0, %0":"=&s"(keep):"v"(gsrc),"s"(lds_dst):"memory");}
__device__ __forceinline__ float max3f(float a,float b,float c){float r;asm("v_max3_f32 %0, %1, %2, %3":"=v"(r):"v"(a),"v"(b),"v"(c));return r;}
__device__ __forceinline__ float max2f(float a,float b){float r;asm("v_max_f32_e32 %0, %1, %2":"=v"(r):"v"(a),"v"(b));return r;}
__device__ __forceinline__ float fadd_s(float a,float b){float r;asm("v_add_f32_e32 %0, %1, %2":"=v"(r):"v"(a),"v"(b));return r;}
__device__ __forceinline__ float fsub_s(float a,float b){float r;asm("v_sub_f32_e32 %0, %1, %2":"=v"(r):"v"(a),"v"(b));return r;}
typedef float f32x2_t __attribute__((ext_vector_type(2))); typedef __bf16 bf16x2_t __attribute__((ext_vector_type(2)));
__device__ __forceinline__ unsigned cvtpk_s(float lo,float hi){f32x2_t v={lo,hi};bf16x2_t b=__builtin_convertvector(v,bf16x2_t);return __builtin_bit_cast(unsigned,b);}
#define WAIT_BAR(N) asm volatile("s_waitcnt vmcnt(" #N ") lgkmcnt(0)\n\ts_barrier":::"memory")

__device__ __forceinline__ void qkt(f32x16&p0,f32x16&p1,const char*Kslot,const bf16x8*qr,const f32x16&negm,int r32,int hi){
  const char*kb=Kslot+hi*1024+r32*16;
  #pragma unroll
  for(int d0=0;d0<4;++d0){
    const bf16x8 b0=*reinterpret_cast<const bf16x8*>(kb+d0*2048);
    const bf16x8 b1=*reinterpret_cast<const bf16x8*>(kb+d0*2048+512);
    if(d0==0){p0=__builtin_amdgcn_mfma_f32_32x32x16_bf16(b0,qr[0],negm,0,0,0);p1=__builtin_amdgcn_mfma_f32_32x32x16_bf16(b1,qr[0],negm,0,0,0);}
    else{p0=__builtin_amdgcn_mfma_f32_32x32x16_bf16(b0,qr[d0],p0,0,0,0);p1=__builtin_amdgcn_mfma_f32_32x32x16_bf16(b1,qr[d0],p1,0,0,0);}}
}
typedef __attribute__((address_space(3))) const char* lds_cptr;
typedef short v4i16_t __attribute__((ext_vector_type(4)));
__device__ __forceinline__ void kload8(bf16x8*kf,lds_cptr kp){
  kf[0]=*(const __attribute__((address_space(3))) bf16x8*)(kp);      kf[1]=*(const __attribute__((address_space(3))) bf16x8*)(kp+512);
  kf[2]=*(const __attribute__((address_space(3))) bf16x8*)(kp+2048); kf[3]=*(const __attribute__((address_space(3))) bf16x8*)(kp+2560);
  kf[4]=*(const __attribute__((address_space(3))) bf16x8*)(kp+4096); kf[5]=*(const __attribute__((address_space(3))) bf16x8*)(kp+4608);
  kf[6]=*(const __attribute__((address_space(3))) bf16x8*)(kp+6144); kf[7]=*(const __attribute__((address_space(3))) bf16x8*)(kp+6656);
}
__device__ __forceinline__ void kload2(bf16x8*kf,lds_cptr kp,int j){ kf[2*j]=*(const __attribute__((address_space(3))) bf16x8*)(kp+j*2048); kf[2*j+1]=*(const __attribute__((address_space(3))) bf16x8*)(kp+j*2048+512); }
__device__ __forceinline__ s16x4 vtr(lds_cptr p){ return __builtin_bit_cast(s16x4,__builtin_amdgcn_ds_read_tr16_b64_v4i16((__attribute__((address_space(3))) v4i16_t*)p)); }
__device__ __forceinline__ float rowmax(const f32x16&p0,const f32x16&p1){
  float a=max3f(p0[0],p0[1],p1[0]),b=max3f(p0[2],p0[3],p1[1]);a=max3f(a,p1[2],p1[3]);
  #pragma unroll
  for(int r=4;r<16;r+=4){a=max3f(a,p0[r],p0[r+1]);b=max3f(b,p0[r+2],p0[r+3]);a=max3f(a,p1[r],p1[r+1]);b=max3f(b,p1[r+2],p1[r+3]);}
  const float m=max2f(a,b);
  auto rr=__builtin_amdgcn_permlane32_swap(__float_as_uint(m),__float_as_uint(m),false,false);
  return max2f(__uint_as_float(rr[0]),__uint_as_float(rr[1]));
}
__device__ __forceinline__ void pv(f32x16*o,int vb,bf16x8 pa0,bf16x8 pa1,bf16x8 pa2,bf16x8 pa3){
  #pragma unroll
  for(int d0=0;d0<2;++d0){s16x4 lo[4],hi[4];
    #pragma unroll
    for(int ks=0;ks<4;++ks){
      asm volatile("ds_read_b64_tr_b16 %0,%1 offset:%c2":"=&v"(lo[ks]):"v"(vb),"i"(d0*4096+ks*1024):"memory");
      asm volatile("ds_read_b64_tr_b16 %0,%1 offset:%c2":"=&v"(hi[ks]):"v"(vb),"i"(d0*4096+ks*1024+512):"memory");}
    asm volatile("s_waitcnt lgkmcnt(0)":::"memory");SBAR();
    #define PK(k) (bf16x8){lo[k][0],lo[k][1],lo[k][2],lo[k][3],hi[k][0],hi[k][1],hi[k][2],hi[k][3]}
    o[d0]=__builtin_amdgcn_mfma_f32_32x32x16_bf16(pa0,PK(0),o[d0],0,0,0);
    o[d0]=__builtin_amdgcn_mfma_f32_32x32x16_bf16(pa1,PK(1),o[d0],0,0,0);
    o[d0]=__builtin_amdgcn_mfma_f32_32x32x16_bf16(pa2,PK(2),o[d0],0,0,0);
    o[d0]=__builtin_amdgcn_mfma_f32_32x32x16_bf16(pa3,PK(3),o[d0],0,0,0);
    #undef PK
  }
}

#ifndef ATTN_STORE16
#define ATTN_STORE16(p,v) (*(u32x4*)(p)=(v))
#endif
template<int MODE,int THRL> __device__ __forceinline__ void attn_unit(int b,int qb,int cq,int cv,int co,const bf16*Q,const bf16*__restrict__ K,const bf16*__restrict__ V,bf16*O,const float*tabsrc,char*shm){
  int tid_=threadIdx.x; asm volatile("":"+v"(tid_));
  const int tid=tid_,lane=tid&63,r32=lane&31,hi=lane>>5; const int wid=__builtin_amdgcn_readfirstlane(tid>>6);
  const long rowbase=(long)b*SEQ, rowbase_k=(long)b*KROWS; const int q0=qb*QB;
  const bf16*Qw=Q+(rowbase+q0+wid*QBLK)*DM+cq;
  const bf16*Kh=K+rowbase_k*DM+cq,*Vh=V+rowbase_k*DM+cv;
  const unsigned lds0=(unsigned)(uintptr_t)shm;
  const __attribute__((address_space(3))) char* shm3_=(const __attribute__((address_space(3))) char*)shm;
  float*wsf=(float*)(shm+LDS_WS)+wid*64;
  const bf16*ksrc=Kh+(long)lane*DM+wid*8;
  const bf16*vsrc=Vh+(long)(16*(wid&3)+(lane>>2))*DM+(wid>>2)*32+(lane&3)*8;
  const unsigned kdst=lds0+LDS_K+wid*1024, vdst=lds0+LDS_V+wid*1024;
  #define DMA_K(t,slot) glds16(ksrc+(long)(t)*KVBLK*DM,(unsigned)__builtin_amdgcn_readfirstlane(kdst+(slot)))
  #define DMA_V(t,slot) glds16(vsrc+(long)(t)*KVBLK*DM,(unsigned)__builtin_amdgcn_readfirstlane(vdst+(slot)))
  const int vb0=(int)(lds0+LDS_V)+((lane>>4)&1)*32+(lane&3)*8+(4*hi+((lane&15)>>2))*64;
  const char*Kbase=shm+LDS_K; bf16x8 kf[8];
  const lds_cptr shm3=(lds_cptr)shm; const lds_cptr kp0=shm3+LDS_K+hi*1024+r32*16; const lds_cptr vp0=shm3+LDS_V+((lane>>4)&1)*32+(lane&3)*8+(4*hi+((lane&15)>>2))*64;
  const int NT=(KPRE+q0+QB+KVBLK)/KVBLK;
  const __attribute__((address_space(3))) float* tab=(const __attribute__((address_space(3))) float*)(shm3_+LDS_TAB);
  { __attribute__((address_space(3))) float* tw=(__attribute__((address_space(3))) float*)(shm3_+LDS_TAB);
    if(MODE==0){ if(tid<128)tw[tid]=tabsrc[tid]; }
    else { const int n=KPRE+q0+QB+KVBLK; for(int i=tid*4;i<n;i+=2048){ const float4 v=*(const float4*)(tabsrc+i); tw[i]=v.x;tw[i+1]=v.y;tw[i+2]=v.z;tw[i+3]=v.w; } } }
  glds16(K+cq+(long)lane*DM+wid*8,(unsigned)__builtin_amdgcn_readfirstlane(kdst)); glds16(V+cv+(long)(16*(wid&3)+(lane>>2))*DM+(wid>>2)*32+(lane&3)*8,(unsigned)__builtin_amdgcn_readfirstlane(vdst)); DMA_K(1,SLOTB);
  bf16x8 qr[4];
  #pragma unroll
  for(int d0=0;d0<4;++d0)qr[d0]=*reinterpret_cast<const bf16x8*>(&Qw[(long)r32*DM+d0*16+hi*8]);
  float mhat=0.f,l_reg=0.f;f32x16 o[2];o[0]=f32x16{};o[1]=f32x16{};f32x16 negm=f32x16{};asm volatile("":"+v"(negm));
  const int qrel=wid*QBLK+r32, q_abs=q0+qrel;
  #define MODT(P0,P1,t,SL) do{ if(SL)modtile_slow<MODE>(P0,P1,(t),q_abs,hi,tab); else if(MODE==1)modtile_fast1(P0,P1,(t),hi,tab); }while(0)
  bool resc=false;
  #define START(P0,P1) do{ const float rm=rowmax(P0,P1); resc=false; \
    { const float dl=(MODE==1)?__builtin_fmaxf(rm,0.f):rm; mhat=fadd_s(mhat,dl); \
      _Pragma("unroll") for(int r=0;r<16;++r){P0[r]=fsub_s(P0[r],dl);P1[r]=fsub_s(P1[r],dl);} \
      _Pragma("unroll") for(int r=0;r<16;++r)negm[r]=-mhat; asm volatile("":"+v"(negm)); } \
    _Pragma("unroll") for(int r=0;r<16;++r)P0[r]=__builtin_amdgcn_exp2f(P0[r]); }while(0)
  #define RESC() do{ if(resc){ asm volatile("s_waitcnt lgkmcnt(0)":::"memory"); \
      _Pragma("unroll") for(int d_=0;d_<2;++d_) _Pragma("unroll") for(int r=0;r<16;++r)o[d_][r]*=wsf[crow(r,hi)]; } }while(0)
  f32x16 pA0,pA1,pB0,pB1;
  int sl_prev=0,sl_cur=0,sl_next=SLOTB;
  #define ROT() do{sl_prev=sl_cur;sl_cur=sl_next;sl_next=(sl_next==(NSLOT-1)*SLOTB)?0:sl_next+SLOTB;}while(0)
  DMA_K(2,2*SLOTB);
  WAIT_BAR(3);
  if(MODE==1){ mhat=tab[KPRE+q_abs]; _Pragma("unroll") for(int r=0;r<16;++r)negm[r]=-mhat; asm volatile("":"+v"(negm)); }
  qkt(pA0,pA1,Kbase,qr,negm,r32,hi);asm volatile("s_nop 15\n\ts_nop 7":"+v"(pA0),"+v"(pA1));MODT(pA0,pA1,0,true);
  START(pA0,pA1);
  _Pragma("unroll") for(int r=0;r<16;++r)pA1[r]=__builtin_amdgcn_exp2f(pA1[r]);
  WAIT_BAR(0);
  DMA_K(3,0);DMA_V(1,SLOTB);
  ROT();
  kload8(kf,kp0+sl_cur);
  WAIT_BAR(2);
  s16x4 vlo[8],vhi[8]; u32x4 pw0,pw1,pw2,pw3;
  #define PKW(P,B) cvtpk_s(P[B],P[B+1])
  #define PAF(k) __builtin_bit_cast(bf16x8,pw##k)
  #define VFR(i) (bf16x8){vlo[i][0],vlo[i][1],vlo[i][2],vlo[i][3],vhi[i][0],vhi[i][1],vhi[i][2],vhi[i][3]}
  #define PIN(x) asm volatile("":"+v"(x))
  #define MX3(a,b,c) __builtin_fmaxf(__builtin_fmaxf((a),(b)),(c))
  #define GAPA(MF,A0,A1,A2,A3,W0,W1,PW) do{ MF; sacc+=A0; sacc+=A1; sacc+=A2; sacc+=A3; PIN(sacc); W0; W1; PIN(PW); SBAR(); }while(0)
  #define EX(v) __builtin_amdgcn_exp2f(v)
  #define GAPB(MF,X,B) do{ MF; X[B]=EX(X[B]); X[B+1]=EX(X[B+1]); X[B+2]=EX(X[B+2]); X[B+3]=EX(X[B+3]); PIN(X); SBAR(); }while(0)
  #define VRD(i) do{ vlo[i]=vtr(vp_+(((i)>>2)*4096+((i)&3)*1024)); vhi[i]=vtr(vp_+(((i)>>2)*4096+((i)&3)*1024+512)); }while(0)
  #define KRD(G,j) do{ if(G){ kload2(kf,kp0+sl_next,j); SBAR(); } }while(0)
  #define STEP(C0,C1,P0,P1,t,GK,GV,GL,SL) do{ SBAR(); \
    const lds_cptr vp_=vp0+sl_prev; \
    VRD(0); SBAR(); float sacc=(P0[0]+P0[1]); \
    GAPA(C0=__builtin_amdgcn_mfma_f32_32x32x16_bf16(kf[0],qr[0],negm,0,0,0), P0[2],P0[3],P0[4],P0[5],     pw0[0]=PKW(P0,0), pw0[1]=PKW(P0,2), pw0); \
    VRD(4); SBAR(); GAPA(C1=__builtin_amdgcn_mfma_f32_32x32x16_bf16(kf[1],qr[0],negm,0,0,0), P0[6],P0[7],P0[8],P0[9],     pw0[2]=PKW(P0,4), pw0[3]=PKW(P0,6), pw0); \
    VRD(1); SBAR(); GAPA(C0=__builtin_amdgcn_mfma_f32_32x32x16_bf16(kf[2],qr[1],C0,0,0,0),   P0[10],P0[11],P0[12],P0[13], pw1[0]=PKW(P0,8), pw1[1]=PKW(P0,10), pw1); \
    VRD(5); SBAR(); GAPA(C1=__builtin_amdgcn_mfma_f32_32x32x16_bf16(kf[3],qr[1],C1,0,0,0),   P0[14],P0[15],P1[0],P1[1],   pw1[2]=PKW(P0,12),pw1[3]=PKW(P0,14), pw1); \
    VRD(2); SBAR(); GAPA(C0=__builtin_amdgcn_mfma_f32_32x32x16_bf16(kf[4],qr[2],C0,0,0,0),   P1[2],P1[3],P1[4],P1[5],     pw2[0]=PKW(P1,0), pw2[1]=PKW(P1,2), pw2); \
    VRD(6); SBAR(); GAPA(C1=__builtin_amdgcn_mfma_f32_32x32x16_bf16(kf[5],qr[2],C1,0,0,0),   P1[6],P1[7],P1[8],P1[9],     pw2[2]=PKW(P1,4), pw2[3]=PKW(P1,6), pw2); \
    VRD(3); SBAR(); GAPA(C0=__builtin_amdgcn_mfma_f32_32x32x16_bf16(kf[6],qr[3],C0,0,0,0),   P1[10],P1[11],P1[12],P1[13], pw3[0]=PKW(P1,8), pw3[1]=PKW(P1,10), pw3); \
    VRD(7); SBAR(); GAPA(C1=__builtin_amdgcn_mfma_f32_32x32x16_bf16(kf[7],qr[3],C1,0,0,0),   P1[14],P1[15],0.f,0.f,       pw3[2]=PKW(P1,12),pw3[3]=PKW(P1,14), pw3); \
    l_reg+=sacc; \
    if(GK){DMA_K((t)+3,sl_cur);} if(GV){DMA_V((t)+1,sl_next);} \
    MODT(C0,C1,t,SL); \
    { float a=MX3(C0[0],C0[1],C1[0]),b=MX3(C0[2],C0[3],C1[1]); a=MX3(a,C1[2],C1[3]); \
      _Pragma("unroll") for(int r=4;r<16;r+=4){a=MX3(a,C0[r],C0[r+1]);b=MX3(b,C0[r+2],C0[r+3]);a=MX3(a,C1[r],C1[r+1]);b=MX3(b,C1[r+2],C1[r+3]);} \
      float rm=__builtin_fmaxf(a,b); { auto rr=__builtin_amdgcn_permlane32_swap(__float_as_uint(rm),__float_as_uint(rm),false,false); rm=__builtin_fmaxf(__uint_as_float(rr[0]),__uint_as_float(rr[1])); } \
      resc=false; \
      if(__builtin_expect(__any(rm>(float)THRL),0)){ const float dl=__builtin_fmaxf(rm,0.f); mhat+=dl; \
        _Pragma("unroll") for(int r=0;r<16;++r){C0[r]-=dl;C1[r]-=dl;} \
        _Pragma("unroll") for(int r=0;r<16;++r)negm[r]=-mhat; asm volatile("":"+v"(negm)); \
        const float f=__builtin_amdgcn_exp2f(-dl); l_reg*=f; if(hi==0)wsf[r32]=f; resc=true; } } \
    SBAR(); \
    GAPB(o[0]=__builtin_amdgcn_mfma_f32_32x32x16_bf16(PAF(0),VFR(0),o[0],0,0,0), C0,0); \
    GAPB(o[1]=__builtin_amdgcn_mfma_f32_32x32x16_bf16(PAF(0),VFR(4),o[1],0,0,0), C0,4); \
    KRD(GL,0); GAPB(o[0]=__builtin_amdgcn_mfma_f32_32x32x16_bf16(PAF(1),VFR(1),o[0],0,0,0), C0,8); \
    KRD(GL,1); GAPB(o[1]=__builtin_amdgcn_mfma_f32_32x32x16_bf16(PAF(1),VFR(5),o[1],0,0,0), C0,12); \
    KRD(GL,2); GAPB(o[0]=__builtin_amdgcn_mfma_f32_32x32x16_bf16(PAF(2),VFR(2),o[0],0,0,0), C1,0); \
    KRD(GL,3); GAPB(o[1]=__builtin_amdgcn_mfma_f32_32x32x16_bf16(PAF(2),VFR(6),o[1],0,0,0), C1,4); \
    GAPB(o[0]=__builtin_amdgcn_mfma_f32_32x32x16_bf16(PAF(3),VFR(3),o[0],0,0,0), C1,8); \
    GAPB(o[1]=__builtin_amdgcn_mfma_f32_32x32x16_bf16(PAF(3),VFR(7),o[1],0,0,0), C1,12); \
    }while(0)
  int t=1;
  #define ENDW(tt) do{ if((tt)+3<NT){WAIT_BAR(2);} else if((tt)+2<NT){WAIT_BAR(1);} else {WAIT_BAR(0);} }while(0)
  for(;t+7<NT;t+=2){
    STEP(pB0,pB1,pA0,pA1,t,true,true,true,false);     WAIT_BAR(2); RESC(); ROT();
    STEP(pA0,pA1,pB0,pB1,t+1,true,true,true,false);   WAIT_BAR(2); RESC(); ROT();
  }
  for(;t+1<NT;t+=2){
    STEP(pB0,pB1,pA0,pA1,t,(t+3<NT),(t+1<NT),(t+1<NT),true);       ENDW(t);   RESC(); ROT();
    STEP(pA0,pA1,pB0,pB1,t+1,(t+4<NT),(t+2<NT),(t+2<NT),true);     ENDW(t+1); RESC(); ROT();
  }
  STEP(pB0,pB1,pA0,pA1,NT-1,false,false,false,true); RESC();
  { float sacc=pB0[0]+pB0[1]; _Pragma("unroll") for(int r=2;r<16;++r)sacc+=pB0[r]; _Pragma("unroll") for(int r=0;r<16;++r)sacc+=pB1[r]; l_reg+=sacc;
    pw0=(u32x4){PKW(pB0,0),PKW(pB0,2),PKW(pB0,4),PKW(pB0,6)};pw1=(u32x4){PKW(pB0,8),PKW(pB0,10),PKW(pB0,12),PKW(pB0,14)};pw2=(u32x4){PKW(pB1,0),PKW(pB1,2),PKW(pB1,4),PKW(pB1,6)};pw3=(u32x4){PKW(pB1,8),PKW(pB1,10),PKW(pB1,12),PKW(pB1,14)};
    SBAR(); pv(o,vb0+sl_cur,PAF(0),PAF(1),PAF(2),PAF(3)); }
  #undef PKW
  #undef PAF
  #undef VFR
  #undef PIN
  #undef MX3
  #undef GAPA
  #undef GAPB
  #undef EX
  #undef VRD
  #undef KRD
  #undef STEP
  #undef ENDW
  {auto rr=__builtin_amdgcn_permlane32_swap(__float_as_uint(l_reg),__float_as_uint(l_reg),false,false);l_reg=__uint_as_float(rr[0])+__uint_as_float(rr[1]);}
  if(hi==0)wsf[32+r32]=l_reg;asm volatile("s_waitcnt lgkmcnt(0)":::"memory");
  float rli[16];
  #pragma unroll
  for(int r=0;r<16;++r)rli[r]=__builtin_amdgcn_rcpf(wsf[32+crow(r,hi)]);
  bf16*Ow=O+(rowbase+q0+wid*QBLK)*DM+co;
  { bf16*stg=(bf16*)(shm+LDS_OST)+wid*2048;
    #pragma unroll
    for(int r=0;r<16;++r){const int orow=crow(r,hi);
      #pragma unroll
      for(int d0=0;d0<2;++d0)stg[orow*64+d0*32+r32]=__float2bfloat16(o[d0][r]*rli[r]);}
    asm volatile("s_waitcnt lgkmcnt(0)":::"memory");
    #pragma unroll
    for(int i=0;i<4;++i){const int row=i*8+(lane>>3),ch=lane&7; const u32x4 v=*(const u32x4*)(stg+row*64+ch*8); ATTN_STORE16(Ow+(long)row*DM+ch*8,v);} }
  asm volatile("s_waitcnt lgkmcnt(0)\n\ts_barrier":::"memory");
  #undef DMA_K
  #undef DMA_V
  #undef MODT
  #undef START
  #undef RESC
  #undef ROT
}
constexpr int ATTN_LDS_BYTES=LDS_BYTES;
#undef SBAR
#undef WAIT_BAR
}
#define GAS __attribute__((address_space(1)))
#define LAS __attribute__((address_space(3)))
typedef unsigned short bf16;
typedef unsigned v4u __attribute__((ext_vector_type(4)));
typedef float f32x4 __attribute__((ext_vector_type(4)));
typedef short bf16x8 __attribute__((ext_vector_type(8)));
typedef GAS unsigned gu32;
typedef GAS unsigned long long gu64;
#define RLX_AGENT __ATOMIC_RELAXED, __HIP_MEMORY_SCOPE_AGENT
#define LDS_WAIT() asm volatile("s_waitcnt lgkmcnt(0)" ::: "memory")
#define VM_WAIT() asm volatile("s_waitcnt vmcnt(0)" ::: "memory")
__device__ __forceinline__ unsigned long long rt() { return __builtin_amdgcn_s_memrealtime(); }
__device__ __forceinline__ unsigned f2bf(float f) { unsigned u = __builtin_bit_cast(unsigned, f); return (u + 0x7fffu + ((u >> 16) & 1u)) >> 16; }
__device__ __forceinline__ unsigned pk2(float lo, float hi) { return f2bf(lo) | (f2bf(hi) << 16); }

#define XB_TMO      128
#define XB_XCNT(j)  (256  + 64 * (j))
#define XB_XSUB(j)  (1280 + 64 * (j))
#define XB_XGEN(j)  (2304 + 64 * (j))
#define XB_TOP      3328
#define XB_TOPGEN   3392
#define XCD_BAR_WORDS 3456
#define XB_SPIN_CAP (1u << 18)

__device__ __forceinline__ unsigned xb_ld(unsigned* p)              { return __hip_atomic_load(p, __ATOMIC_RELAXED, __HIP_MEMORY_SCOPE_AGENT); }
__device__ __forceinline__ unsigned xb_add(unsigned* p, unsigned v) { return __hip_atomic_fetch_add(p, v, __ATOMIC_RELAXED, __HIP_MEMORY_SCOPE_AGENT); }
__device__ __forceinline__ unsigned xb_xcc_id() { return (unsigned)__builtin_amdgcn_s_getreg((3 << 11) | 20) & 0xFu; }
#define XB_SPIN(cond, bar) do { unsigned _sp = 0; while (cond) { __builtin_amdgcn_s_sleep(1); \
    if ((++_sp & 255u) == 0u) { if (xb_ld(&(bar)[XB_TMO])) break; if (_sp > XB_SPIN_CAP) { atomicAdd(&(bar)[XB_TMO], 1u); break; } } } } while (0)

struct XcdBarrier {
    unsigned* bar; unsigned x;
    volatile LAS unsigned* st;
};

__device__ __forceinline__ XcdBarrier xcd_barrier_post(unsigned* bar, volatile LAS unsigned* st) {
    XcdBarrier b; b.bar = bar; b.x = xb_xcc_id(); b.st = st;
    if (threadIdx.x == 0) (void)xb_add(&bar[XB_XCNT(b.x)], 1u);
    return b;
}
__device__ __forceinline__ void xcd_barrier_complete(unsigned* bar, unsigned x, unsigned& nloc, unsigned& nx) {
    const unsigned G = gridDim.x * gridDim.y * gridDim.z;
    unsigned sum, cnt, mine, sp = 0u;
    for (;;) {
        sum = 0u; cnt = 0u; mine = 0u;
#pragma unroll
        for (unsigned j = 0; j < 16; ++j) { const unsigned c = xb_ld(&bar[XB_XCNT(j)]); sum += c; cnt += (c > 0u) ? 1u : 0u; mine = (j == x) ? c : mine; }
        if (sum == G) break;
        __builtin_amdgcn_s_sleep(1);
        if ((++sp & 255u) == 0u) { if (xb_ld(&bar[XB_TMO])) break; if (sp > XB_SPIN_CAP) { atomicAdd(&bar[XB_TMO], 1u); break; } }
    }
    nloc = mine > 0u ? mine : 1u; nx = cnt > 0u ? cnt : 1u;
}

__device__ __forceinline__ void xcd_barrier(const XcdBarrier& b) {
    asm volatile("s_waitcnt vmcnt(0)" ::: "memory");
    __syncthreads();
    if (threadIdx.x == 0) {
        unsigned* bar = b.bar;
        __builtin_amdgcn_s_waitcnt(0);
        unsigned nloc = b.st[0], nx = b.st[1];
        if (nloc == 0u) { xcd_barrier_complete(bar, b.x, nloc, nx); b.st[0] = nloc; b.st[1] = nx; }
        const unsigned old = xb_add(&bar[XB_XSUB(b.x)], 1u);
        const unsigned gen = old / nloc;
        if (old + 1u == (gen + 1u) * nloc) {
            __builtin_amdgcn_fence(__ATOMIC_RELEASE, "agent");
            asm volatile("s_waitcnt vmcnt(0)" ::: "memory");
            const unsigned og = xb_add(&bar[XB_TOP], 1u);
            const unsigned tg = og / nx;
            if (og + 1u == (tg + 1u) * nx) xb_add(&bar[XB_TOPGEN], 1u);
            else XB_SPIN(xb_ld(&bar[XB_TOPGEN]) == tg, bar);
            __builtin_amdgcn_fence(__ATOMIC_ACQUIRE, "agent");
            xb_add(&bar[XB_XGEN(b.x)], 1u);
            asm volatile("s_waitcnt vmcnt(0)" ::: "memory");
        } else {
            XB_SPIN(xb_ld(&bar[XB_XGEN(b.x)]) == gen, bar);
            __builtin_amdgcn_fence(__ATOMIC_ACQUIRE, "agent");
            asm volatile("s_waitcnt vmcnt(0)" ::: "memory");
        }
    }
    __syncthreads();
}

constexpr int NWAVES = 8;
#ifndef MK_PER_PHASE
#define MK_PER_PHASE 1
#endif
constexpr int N_PHASES = 16;

constexpr size_t MiB = 1u << 20;
constexpr size_t WS_CTL = 0, CTL_ZERO_BYTES = 1 * MiB;
constexpr size_t WS_GV = 1 * MiB + 512 * 1024;
constexpr size_t WS_HM = 2 * MiB;
constexpr size_t WS_TAB = 2 * MiB + 256 * 1024;
constexpr size_t WS_LF = 3 * MiB;
constexpr size_t WS_DK = 6 * MiB;
constexpr size_t WS_LIST = 9 * MiB;
constexpr int LCAP = NSLOT;
constexpr size_t WS_WQKV0 = 18 * MiB, WS_WO0 = 24 * MiB, WS_WQKV1 = 26 * MiB, WS_WO1 = 32 * MiB, WS_WGU = 34 * MiB, WS_WD = 98 * MiB;
constexpr size_t WS_XH = 130 * MiB;
constexpr size_t WS_Q = 195 * MiB;
constexpr size_t WS_K = 260 * MiB, WS_V = 325 * MiB;
constexpr size_t WS_O0 = 390 * MiB;
constexpr size_t WS_END = 455 * MiB;
static_assert(WS_LIST + (size_t)NEXP * LCAP * 4 <= WS_WQKV0 && WS_DK + (size_t)NBATCH * 16 * KROWS * 4 <= WS_LIST && WS_LF + (size_t)NRP * 16 * 4 <= WS_DK, "small arrays");
static_assert(WS_XH + (size_t)NRP * DM * 2 <= WS_Q && WS_Q + (size_t)NRP * DM * 2 <= WS_K && WS_K + (size_t)NBATCH * KROWS * DM * 2 <= WS_V && WS_V + (size_t)NBATCH * KROWS * DM * 2 <= WS_O0 && WS_O0 + (size_t)NRP * DM * 2 <= WS_END, "activations");
static_assert(WS_K + (size_t)NSLOT * DM * 2 <= WS_O0 && WS_O0 + (size_t)NSLOT * DEXP * 2 <= WS_END, "MoE overlays");
constexpr int CW_TMO = 0, CW_CODE = 1;
constexpr int CW_BAR = 4096;
constexpr int CW_CNT = 65536;
constexpr int RING_OFF = 0, RING_BYTES = 131072;
constexpr int ROWTAB_OFF = RING_BYTES, ROWTAB_UNITS = 12;
constexpr int MOEPRE_OFF = ROWTAB_OFF + ROWTAB_UNITS * 1024;
constexpr int MISC_OFF = MOEPRE_OFF + 512;
constexpr int LDS_BYTES = 147456;
static_assert(MISC_OFF + 128 <= LDS_BYTES && attn_body::ATTN_LDS_BYTES <= RING_BYTES, "LDS map");

struct Params {
    const float *x, *meta, *rel_bias, *w_qkv, *lam, *subln, *w_o, *fox_w_in, *fox_b_f, *fox_w_o, *ln_mix_g, *ln_mix_b, *ln_ffn_g, *ln_ffn_b, *rg_w, *rg_b, *re_w, *re_b, *w_gate, *w_up, *w_down;
    float* out; unsigned char* ws; int ph_lo, ph_hi, li, pad;
};
struct Ctx { int tid, lane, wave, vcu, G; LAS unsigned char* lds; };
__device__ __forceinline__ Ctx fresh(const Ctx& C) { Ctx r = C; int t = threadIdx.x; asm volatile("" : "+v"(t)); r.tid = t; r.lane = t & 63; r.wave = __builtin_amdgcn_readfirstlane(t >> 6); return r; }

__device__ __forceinline__ float wave_sum(float v) {
#pragma unroll
    for (int o = 1; o < 64; o <<= 1) v += __shfl_xor(v, o);
    return v;
}
__device__ __forceinline__ float bf2f(unsigned short h) { return __uint_as_float((unsigned)h << 16); }
__device__ __forceinline__ float bflo(unsigned w) { return __uint_as_float(w << 16); }
__device__ __forceinline__ float bfhi(unsigned w) { return __uint_as_float(w & 0xffff0000u); }
__device__ __forceinline__ float* h32_row(const Params& p, int r) { return r < NREAL ? p.out + (size_t)r * DM : (float*)(p.ws + WS_HM) + (size_t)(r - NREAL) * DM; }
__device__ __forceinline__ int meta_slot(int j) { return j; }

__device__ __forceinline__ void tr_item(const float* W, int ldw, int k0, int n0, bf16* WT, int ldt, int drow0, LAS float* scr, int lane) {
#pragma unroll 8
    for (int i = 0; i < 32; ++i) { const int kk = 2 * i + (lane >> 5); scr[kk * 33 + (lane & 31)] = W[(size_t)(k0 + kk) * ldw + n0 + (lane & 31)]; }
    LDS_WAIT(); asm volatile("" ::: "memory");
    const int c = lane & 7;
#pragma unroll
    for (int j = 0; j < 4; ++j) { const int n = (lane >> 3) + 8 * j; const LAS float* s = scr + (8 * c) * 33 + n;
        v4u o; o.x = pk2(s[0 * 33], s[1 * 33]); o.y = pk2(s[2 * 33], s[3 * 33]); o.z = pk2(s[4 * 33], s[5 * 33]); o.w = pk2(s[6 * 33], s[7 * 33]);
        *(GAS v4u*)(WT + (size_t)(drow0 + n) * ldt + k0 + 8 * c) = o; }
    LDS_WAIT(); asm volatile("" ::: "memory");
}
__device__ __forceinline__ void convert_experts(const Params& p, const Ctx& C, int layer, int first_item, int gw, int NGW) {
    LAS float* scr = (LAS float*)(C.lds + RING_OFF + C.wave * 16384);
    bf16* Wgu = (bf16*)(p.ws + WS_WGU); bf16* Wd = (bf16*)(p.ws + WS_WD);
    constexpr int PER_E = 768, NIT = NEXP * PER_E;
    for (int it = gw - first_item; it < NIT; it += NGW) { if (it < 0) continue;
        const int e = it / PER_E; int r = it % PER_E; const size_t eo = (size_t)(layer * NEXP + e);
        if (r < 512) { const bool up = r >= 256; r &= 255; const int kb = r >> 4, nb = r & 15, n0 = 32 * nb;
            tr_item((up ? p.w_up : p.w_gate) + eo * DM * DEXP, DEXP, 64 * kb, n0, Wgu + (size_t)e * DM * DM, DM, (n0 >> 7) * 256 + (n0 & 127) + (up ? 128 : 0), scr, C.lane); }
        else { r -= 512; const int kb = r >> 5, nb = r & 31;
            tr_item(p.w_down + eo * DEXP * DM, DM, 64 * kb, 32 * nb, Wd + (size_t)e * DM * DEXP, DEXP, 32 * nb, scr, C.lane); } }
}
__device__ __forceinline__ void p0_prologue(const Params& p, const Ctx& C) {
    LAS float* scr = (LAS float*)(C.lds + RING_OFF + C.wave * 16384);
    const int gw = C.vcu * NWAVES + C.wave, NGW = C.G * NWAVES;
    for (int it = gw; it < 4096; it += NGW) { int r = it;
        if (r < 1536) { tr_item(p.w_qkv, 3072, 64 * (r / 96), 32 * (r % 96), (bf16*)(p.ws + WS_WQKV0), DM, 32 * (r % 96), scr, C.lane); continue; } r -= 1536;
        if (r < 512) { tr_item(p.w_o, DM, 64 * (r >> 5), 32 * (r & 31), (bf16*)(p.ws + WS_WO0), DM, 32 * (r & 31), scr, C.lane); continue; } r -= 512;
        if (r < 1536) { tr_item(p.fox_w_in, 3088, 64 * (r / 96), 32 * (r % 96), (bf16*)(p.ws + WS_WQKV1), DM, 32 * (r % 96), scr, C.lane); continue; } r -= 1536;
        tr_item(p.fox_w_o, DM, 64 * (r >> 5), 32 * (r & 31), (bf16*)(p.ws + WS_WO1), DM, 32 * (r & 31), scr, C.lane); }
    convert_experts(p, C, 0, 0, gw, NGW);
    bf16* XH = (bf16*)(p.ws + WS_XH);
    for (int m = gw; m < NRP; m += NGW) {
        GAS unsigned long long* o8 = (GAS unsigned long long*)(XH + (size_t)m * DM) + C.lane;
        if (m < NR) { const GAS f32x4* xr = (const GAS f32x4*)(m < NREAL ? p.x + (size_t)m * DM : p.meta + (size_t)(m - NREAL) * DM) + C.lane;
#pragma unroll
            for (int j = 0; j < 4; ++j) { const f32x4 v = xr[64 * j]; o8[64 * j] = (unsigned long long)pk2(v.x, v.y) | ((unsigned long long)pk2(v.z, v.w) << 32); } }
        else {
#pragma unroll
            for (int j = 0; j < 4; ++j) o8[64 * j] = 0ull; } }
    { const int gt = C.vcu * (NWAVES * 64) + C.tid;
      if (gt < 16 * 128) { const int m = gt >> 7, d = gt & 127; int bk = d;
          if (d >= 16) { bk = 16 + (d >= 19) + (d >= 21) + (d >= 24) + (d >= 27) + (d >= 31) + (d >= 35) + (d >= 40) + (d >= 46) + (d >= 52) + (d >= 59) + (d >= 67) + (d >= 77) + (d >= 87) + (d >= 99) + (d >= 113); }
          ((float*)(p.ws + WS_TAB))[gt] = (p.rel_bias[bk * 16 + m] - p.rel_bias[31 * 16 + m]) * LOG2E; } }
}

__device__ __forceinline__ float diff_lambda_full(const Params& p, int lane) {
    const float a = p.lam[lane] * p.lam[64 + lane], b = p.lam[128 + lane] * p.lam[192 + lane];
    return __expf(wave_sum(a)) - __expf(wave_sum(b)) + LAMBDA_INIT0;
}
__device__ __forceinline__ void combine_phase(const Params& p, const Ctx& C) {
    const int gw = C.vcu * NWAVES + C.wave, NGW = C.G * NWAVES, lane = C.lane;
    const float lam = diff_lambda_full(p, lane);
    const bf16* O0 = (const bf16*)(p.ws + WS_O0); const bf16* O1 = (const bf16*)(p.ws + WS_XH); bf16* OA = (bf16*)(p.ws + WS_Q);
    float sw[8];
#pragma unroll
    for (int c = 0; c < 8; ++c) sw[c] = p.subln[((8 * lane) & 127) + c] * (1.f - LAMBDA_INIT0);
    for (int r = gw; r < NREAL; r += NGW) {
#pragma unroll
        for (int j = 0; j < 2; ++j) { const size_t off = (size_t)r * DM + 8 * lane + 512 * j;
            const v4u a = *(const GAS v4u*)(O0 + off), b = *(const GAS v4u*)(O1 + off);
            float d[8]; const unsigned aw[4] = {a.x, a.y, a.z, a.w}, bw[4] = {b.x, b.y, b.z, b.w}; float ss = 0.f;
#pragma unroll
            for (int c = 0; c < 4; ++c) { d[2 * c] = bflo(aw[c]) - lam * bflo(bw[c]); d[2 * c + 1] = bfhi(aw[c]) - lam * bfhi(bw[c]); ss += d[2 * c] * d[2 * c] + d[2 * c + 1] * d[2 * c + 1]; }
            ss += __shfl_xor(ss, 1); ss += __shfl_xor(ss, 2); ss += __shfl_xor(ss, 4); ss += __shfl_xor(ss, 8);
            const float rs = 1.f / sqrtf(ss * (1.f / 128.f) + LN_EPS);
            v4u o; o.x = pk2(d[0] * rs * sw[0], d[1] * rs * sw[1]); o.y = pk2(d[2] * rs * sw[2], d[3] * rs * sw[3]); o.z = pk2(d[4] * rs * sw[4], d[5] * rs * sw[5]); o.w = pk2(d[6] * rs * sw[6], d[7] * rs * sw[7]);
            *(GAS v4u*)(OA + off) = o; } }
    if (gw < 128) { const int h = gw >> 4, j = gw & 15, kj = lane & 15, s = (lane >> 4) & 1, m = 2 * h + s;
        const bf16* Q = (const bf16*)(p.ws + WS_Q); const bf16* K = (const bf16*)(p.ws + WS_K); const bf16* V = (const bf16*)(p.ws + WS_V);
        const bf16* qp = Q + (size_t)(NREAL + j) * DM + m * 64; const bf16* kp = K + (size_t)meta_slot(kj) * DM + m * 64;
        float dot = 0.f;
#pragma unroll
        for (int c = 0; c < 8; ++c) { const v4u qa = *(const GAS v4u*)(qp + 8 * c), ka = *(const GAS v4u*)(kp + 8 * c); const unsigned qw[4] = {qa.x, qa.y, qa.z, qa.w}, kw[4] = {ka.x, ka.y, ka.z, ka.w};
#pragma unroll
            for (int e = 0; e < 4; ++e) dot += bflo(qw[e]) * bflo(kw[e]) + bfhi(qw[e]) * bfhi(kw[e]); }
        float sc = (kj <= j) ? dot + p.rel_bias[(j - kj) * 16 + m] * LOG2E : -INFINITY;
        float mx = sc; mx = fmaxf(mx, __shfl_xor(mx, 1)); mx = fmaxf(mx, __shfl_xor(mx, 2)); mx = fmaxf(mx, __shfl_xor(mx, 4)); mx = fmaxf(mx, __shfl_xor(mx, 8));
        float pe = __builtin_amdgcn_exp2f(sc - mx); float l = pe; l += __shfl_xor(l, 1); l += __shfl_xor(l, 2); l += __shfl_xor(l, 4); l += __shfl_xor(l, 8);
        pe /= l;
        const float a = pe - lam * __shfl_xor(pe, 16);
        float o0 = 0.f, o1 = 0.f;
        for (int k2 = 0; k2 <= j; ++k2) { const float ak = __shfl(a, k2); const unsigned vw = *(const GAS unsigned*)(V + (size_t)meta_slot(k2) * DM + h * 128 + 2 * lane); o0 += ak * bflo(vw); o1 += ak * bfhi(vw); }
        const float ss = wave_sum(o0 * o0 + o1 * o1); const float rs = 1.f / sqrtf(ss * (1.f / 128.f) + LN_EPS);
        const float w0 = p.subln[2 * lane] * (1.f - LAMBDA_INIT0), w1 = p.subln[2 * lane + 1] * (1.f - LAMBDA_INIT0);
        *(GAS unsigned*)(OA + (size_t)(NREAL + j) * DM + h * 128 + 2 * lane) = pk2(o0 * rs * w0, o1 * rs * w1); }
}
__device__ __forceinline__ void fox_meta_attn(const Params& p, const Ctx& C) {
    const int gw = C.vcu * NWAVES + C.wave, lane = C.lane;
    if (gw < 256) { const int h = gw >> 4, j = gw & 15, kj = lane & 15;
        bf16* Q = (bf16*)(p.ws + WS_Q); const bf16* K = (const bf16*)(p.ws + WS_K); const bf16* V = (const bf16*)(p.ws + WS_V); const float* DK = (const float*)(p.ws + WS_DK) + (size_t)h * KROWS;
        const bf16* qp = Q + (size_t)(NREAL + j) * DM + h * 64; const bf16* kp = K + (size_t)meta_slot(kj) * DM + h * 64;
        float dot = 0.f;
#pragma unroll
        for (int c = 0; c < 8; ++c) { const v4u qa = *(const GAS v4u*)(qp + 8 * c), ka = *(const GAS v4u*)(kp + 8 * c); const unsigned qw[4] = {qa.x, qa.y, qa.z, qa.w}, kw[4] = {ka.x, ka.y, ka.z, ka.w};
#pragma unroll
            for (int e = 0; e < 4; ++e) dot += bflo(qw[e]) * bflo(kw[e]) + bfhi(qw[e]) * bfhi(kw[e]); }
        float sc = (kj <= j) ? dot + DK[meta_slot(kj)] - DK[meta_slot(j)] : -INFINITY;
        float mx = sc; mx = fmaxf(mx, __shfl_xor(mx, 1)); mx = fmaxf(mx, __shfl_xor(mx, 2)); mx = fmaxf(mx, __shfl_xor(mx, 4)); mx = fmaxf(mx, __shfl_xor(mx, 8));
        float pe = __builtin_amdgcn_exp2f(sc - mx); float l = pe; l += __shfl_xor(l, 1); l += __shfl_xor(l, 2); l += __shfl_xor(l, 4); l += __shfl_xor(l, 8);
        pe /= l;
        float o = 0.f;
        for (int k2 = 0; k2 <= j; ++k2) { const float ak = __shfl(pe, k2); o += ak * bf2f(V[(size_t)meta_slot(k2) * DM + h * 64 + lane]); }
        asm volatile("s_waitcnt vmcnt(0)" ::: "memory");
        Q[(size_t)(NREAL + j) * DM + h * 64 + lane] = (bf16)f2bf(o); }
}

typedef float f32x4m __attribute__((ext_vector_type(4)));
template <int KIND> __device__ __forceinline__ void ln_phase(const Params& p, const Ctx& C, int layer) {
    constexpr int NCB = (KIND == 0) ? 3 : (KIND == 1 ? 1 : 0), NC = 16 * (NCB ? NCB : 1);
    constexpr int AT_PITCH = 1028;
    const int tid = C.tid, lane = C.lane, wave = C.wave;
    LAS float* At = (LAS float*)(C.lds + RING_OFF);
    LAS float* part = (LAS float*)(C.lds + RING_OFF + 65792);
    LAS float* logit = (LAS float*)(C.lds + RING_OFF + 90368);
    LAS int* sl_e = (LAS int*)(C.lds + RING_OFF + 93440);
    LAS int* cnt_l = (LAS int*)(C.lds + RING_OFF + 94720);
    const float* gsrc = (KIND == 0 ? p.ln_mix_g : p.ln_ffn_g) + layer * DM; const float* bsrc = (KIND == 0 ? p.ln_mix_b : p.ln_ffn_b) + layer * DM;
    f32x4 gv[4], bv[4];
#pragma unroll
    for (int j = 0; j < 4; ++j) { gv[j] = *(const GAS f32x4*)(gsrc + 4 * lane + 256 * j); bv[j] = *(const GAS f32x4*)(bsrc + 4 * lane + 256 * j); }
    float Bf[NCB ? NCB : 1][8][4];
    if constexpr (NCB > 0) { const int kq = lane >> 4, col = lane & 15;
#pragma unroll
        for (int cb = 0; cb < NCB; ++cb)
#pragma unroll
            for (int g = 0; g < 8; ++g)
#pragma unroll
                for (int c = 0; c < 4; ++c) { const int k = 128 * wave + 16 * g + 4 * kq + c, cc = cb * 16 + col; float w;
                    if (KIND == 0) w = cc < 4 ? p.rg_w[((size_t)layer * DM + k) * 4 + cc] : (cc < 36 ? p.re_w[((size_t)layer * DM + k) * 32 + (cc - 4)] : 0.f);
                    else w = p.fox_w_in[(size_t)k * 3088 + 3072 + cc];
                    Bf[cb][g][c] = w; } }
    if (KIND == 0) { if (tid < 96) cnt_l[tid] = 0; }
    bf16* XH = (bf16*)(p.ws + WS_XH); const bf16* Y = (const bf16*)(p.ws + WS_K);
    constexpr int NTILES = NR / 16;
    int it = 0;
    for (int tile = C.vcu; tile < NTILES; tile += C.G, ++it) {
#pragma unroll 1
        for (int rr = 0; rr < 2; ++rr) { const int rl = wave * 2 + rr, row = tile * 16 + rl;
            float* hrow = h32_row(p, row);
            f32x4 v[4];
#pragma unroll
            for (int j = 0; j < 4; ++j) v[j] = *(const GAS f32x4*)(hrow + 4 * lane + 256 * j);
            if (KIND != 0) {
#pragma unroll
                for (int j = 0; j < 4; ++j) { const unsigned long long y0 = *(const GAS unsigned long long*)(Y + (size_t)(2 * row) * DM + 4 * lane + 256 * j), y1 = *(const GAS unsigned long long*)(Y + (size_t)(2 * row + 1) * DM + 4 * lane + 256 * j);
                    const unsigned a0 = (unsigned)y0, a1 = (unsigned)(y0 >> 32), b0 = (unsigned)y1, b1 = (unsigned)(y1 >> 32);
                    v[j].x = v[j].x * ALPHA + (bflo(a0) + bflo(b0)); v[j].y = v[j].y * ALPHA + (bfhi(a0) + bfhi(b0)); v[j].z = v[j].z * ALPHA + (bflo(a1) + bflo(b1)); v[j].w = v[j].w * ALPHA + (bfhi(a1) + bfhi(b1)); } }
            float s = 0.f;
#pragma unroll
            for (int j = 0; j < 4; ++j) s += (v[j].x + v[j].y) + (v[j].z + v[j].w);
            const float mean = wave_sum(s) * (1.f / DM); float s2 = 0.f;
#pragma unroll
            for (int j = 0; j < 4; ++j) { v[j] = v[j] - mean; s2 += (v[j].x * v[j].x + v[j].y * v[j].y) + (v[j].z * v[j].z + v[j].w * v[j].w); }
            const float rstd = 1.f / sqrtf(wave_sum(s2) * (1.f / DM) + LN_EPS);
#pragma unroll
            for (int j = 0; j < 4; ++j) v[j] = v[j] * rstd * gv[j] + bv[j];
            if (KIND == 2) { if (row < NREAL) {
#pragma unroll
                for (int j = 0; j < 4; ++j) *(GAS f32x4*)(hrow + 4 * lane + 256 * j) = v[j]; } }
            else {
#pragma unroll
                for (int j = 0; j < 4; ++j) { *(GAS f32x4*)(hrow + 4 * lane + 256 * j) = v[j];
                    *((GAS unsigned long long*)(XH + (size_t)row * DM) + lane + 64 * j) = (unsigned long long)pk2(v[j].x, v[j].y) | ((unsigned long long)pk2(v[j].z, v[j].w) << 32);
                    *(LAS f32x4*)(At + rl * AT_PITCH + 4 * lane + 256 * j) = v[j]; } } }
        if constexpr (NCB > 0) {
            __syncthreads();
            f32x4m acc[NCB];
#pragma unroll
            for (int cb = 0; cb < NCB; ++cb) acc[cb] = (f32x4m){0.f, 0.f, 0.f, 0.f};
#pragma unroll
            for (int g = 0; g < 8; ++g) { const f32x4 a4 = *(const LAS f32x4*)(At + (lane & 15) * AT_PITCH + 128 * wave + 16 * g + 4 * (lane >> 4));
#pragma unroll
                for (int c = 0; c < 4; ++c)
#pragma unroll
                    for (int cb = 0; cb < NCB; ++cb) acc[cb] = __builtin_amdgcn_mfma_f32_16x16x4f32(a4[c], Bf[cb][g][c], acc[cb], 0, 0, 0); }
#pragma unroll
            for (int cb = 0; cb < NCB; ++cb)
#pragma unroll
                for (int r = 0; r < 4; ++r) part[(wave * 16 + 4 * (lane >> 4) + r) * 48 + cb * 16 + (lane & 15)] = acc[cb][r];
            __syncthreads();
            for (int idx = tid; idx < 16 * NC; idx += NWAVES * 64) { const int rw = idx / NC, cl = idx % NC; float sacc = 0.f;
#pragma unroll
                for (int w = 0; w < 8; ++w) sacc += part[(w * 16 + rw) * 48 + cl];
                logit[rw * 48 + cl] = sacc; }
            __syncthreads();
            if (KIND == 0) { if (tid < 16) { const int row = tile * 16 + tid; const LAS float* lg = logit + tid * 48;
                float gl[4]; int gs = 0;
#pragma unroll
                for (int i = 0; i < 4; ++i) gl[i] = lg[i] + p.rg_b[layer * 4 + i];
#pragma unroll
                for (int i = 1; i < 4; ++i) if (gl[i] > gl[gs]) gs = i;
                float den = 0.f;
#pragma unroll
                for (int i = 0; i < 4; ++i) den += __expf(gl[i] - gl[gs]);
                const float pg = 1.f / den;
                float el[8];
#pragma unroll
                for (int i = 0; i < 8; ++i) el[i] = lg[4 + gs * 8 + i] + p.re_b[layer * 32 + gs * 8 + i];
                int i0 = 0;
#pragma unroll
                for (int i = 1; i < 8; ++i) if (el[i] > el[i0]) i0 = i;
                int i1 = (i0 == 0) ? 1 : 0;
#pragma unroll
                for (int i = 0; i < 8; ++i) if (i != i0 && el[i] > el[i1]) i1 = i;
                const float ex = __expf(el[i1] - el[i0]); const float w0 = 1.f / (1.f + ex), w1 = ex * w0;
                float* GVp = (float*)(p.ws + WS_GV); GVp[2 * row] = pg * w0; GVp[2 * row + 1] = pg * w1;
                sl_e[it * 32 + 2 * tid] = gs * 8 + i0; sl_e[it * 32 + 2 * tid + 1] = gs * 8 + i1; } }
            else { if (tid < 256) { const int rw = tid >> 4, hh = tid & 15; const float vv = logit[rw * 48 + hh] + p.fox_b_f[hh];
                ((float*)(p.ws + WS_LF))[(size_t)(tile * 16 + rw) * 16 + hh] = fminf(vv, 0.f) - log1pf(__expf(-fabsf(vv))); } }
        }
    }
    if (KIND == 0) {
        gu32* CNT = (gu32*)(p.ws + WS_CTL) + CW_CNT + layer * 2048; int* LIST = (int*)(p.ws + WS_LIST);
        __syncthreads();
        const int nloc = it * 32;
        for (int s = tid; s < nloc; s += NWAVES * 64) atomicAdd((int*)&cnt_l[sl_e[s]], 1);
        __syncthreads();
        if (tid < 32) { const int n = cnt_l[tid]; cnt_l[32 + tid] = n > 0 ? (int)__hip_atomic_fetch_add(CNT + 64 * tid, (unsigned)n, RLX_AGENT) : 0; cnt_l[64 + tid] = 0; }
        __syncthreads();
        for (int s = tid; s < nloc; s += NWAVES * 64) { const int e = sl_e[s]; const int pos = cnt_l[32 + e] + atomicAdd((int*)&cnt_l[64 + e], 1);
            const int tl = C.vcu + (s >> 5) * C.G; LIST[(size_t)e * LCAP + pos] = 2 * (tl * 16 + ((s & 31) >> 1)) + (s & 1); }
    }
    __syncthreads();
}

__device__ __forceinline__ void cumsum_job(const Params& p, const Ctx& C) {
    if (C.vcu >= 64) return;
    const int b = C.vcu >> 4, h = C.vcu & 15, tid = C.tid, lane = C.lane, wave = C.wave;
    const float* LF = (const float*)(p.ws + WS_LF); float* DK = (float*)(p.ws + WS_DK) + (size_t)(b * 16 + h) * KROWS;
    LAS float* wt = (LAS float*)(C.lds + RING_OFF);
    float cm = 0.f, mine = 0.f; const int myj = (tid < NMETA) ? tid : -1;
    for (int i = 0; i < NMETA; ++i) { cm += LF[(size_t)(NREAL + i) * 16 + h]; if (i == myj) mine = cm; }
    if (tid < KPRE) DK[tid] = (myj >= 0) ? -mine * LOG2E : 0.f;
    if (tid < 64) DK[KPRE + SEQ + tid] = 0.f;
    const float* lp = LF + (size_t)(b * SEQ + tid * 16) * 16 + h;
    float run = 0.f;
#pragma unroll 1
    for (int i = 0; i < 16; ++i) run += lp[i * 16];
    float inc = run;
#pragma unroll
    for (int o = 1; o < 64; o <<= 1) { const float t = __shfl_up(inc, o); if (lane >= o) inc += t; }
    if (lane == 63) wt[wave] = inc;
    __syncthreads();
    float base = cm;
    for (int w = 0; w < wave; ++w) base += wt[w];
    base += inc - run;
#pragma unroll 1
    for (int i = 0; i < 16; ++i) { base += lp[i * 16]; DK[KPRE + tid * 16 + i] = -base * LOG2E; }
    __syncthreads();
}

struct MoeOrder {
    int G, c, UT; const LAS int* pre; const char* A; const char* W; size_t wexp, tsB;
    __device__ __forceinline__ bool next(int i, pg8::Unit& u) const {
        const int g = i * G + c; if (g >= UT || i >= ROWTAB_UNITS) return false;
        const int rt = g >> 2; int e = 0; while (pre[e + 1] <= rt) ++e;
        u.pm = rt - pre[e]; u.pn = g & 3; u.A = A; u.B = W + (size_t)e * wexp + (size_t)u.pn * tsB; u.tab = i; u.e = e; return true;
    }
};
__device__ __forceinline__ int moe_setup(const Params& p, const Ctx& C, int layer, MoeOrder& S) {
    LAS int* pre = (LAS int*)(C.lds + MOEPRE_OFF); LAS int* cnts = pre + 40; LAS int* rowtab = (LAS int*)(C.lds + ROWTAB_OFF);
    const gu32* CNT = (const gu32*)(p.ws + WS_CTL) + CW_CNT + layer * 2048;
    if (C.tid < 32) cnts[C.tid] = (int)__hip_atomic_load(CNT + 64 * C.tid, RLX_AGENT);
    __syncthreads();
    if (C.tid == 0) { int a = 0; for (int e = 0; e < NEXP; ++e) { pre[e] = a; a += (cnts[e] + 255) >> 8; } pre[NEXP] = a; pre[NEXP + 1] = 0x7fffffff; }
    __syncthreads();
    S.pre = pre; S.UT = 4 * pre[NEXP];
    const int* LIST = (const int*)(p.ws + WS_LIST);
    pg8::Unit u;
    for (int i = 0; S.next(i, u); ++i) { if (C.tid < 256) { const int idx = 256 * u.pm + C.tid; rowtab[i * 256 + C.tid] = idx < cnts[u.e] ? LIST[(size_t)u.e * LCAP + idx] : -1; } }
    __syncthreads();
    return S.UT;
}

__global__ void __launch_bounds__(NWAVES * 64, 2) trunk_fwd(Params p) {
    extern __shared__ __attribute__((aligned(16))) unsigned char lds[];
    Ctx C;
    C.lds = (LAS unsigned char*)lds; C.tid = threadIdx.x; C.lane = C.tid & 63; C.wave = __builtin_amdgcn_readfirstlane(C.tid >> 6);
    C.G = gridDim.x; { const int bx = blockIdx.x; C.vcu = (C.G % 8 == 0) ? (bx % 8) * (C.G / 8) + bx / 8 : bx; }
    volatile LAS unsigned* MISC = (volatile LAS unsigned*)(C.lds + MISC_OFF);
    gu32* ctl = (gu32*)(p.ws + WS_CTL);
    if (C.tid < 32) MISC[C.tid] = 0u;
    __syncthreads();
    XcdBarrier bar; bar.bar = (unsigned*)(ctl + CW_BAR) + p.li * XCD_BAR_WORDS; bar.x = 0; bar.st = nullptr;
    if (!MK_PER_PHASE) bar = xcd_barrier_post((unsigned*)(ctl + CW_BAR) + p.li * XCD_BAR_WORDS, MISC + 8);
#define GRID_BAR() do { if (MK_PER_PHASE) { if (C.tid == 0) __hip_atomic_store(ctl + CW_TMO, 0xBADBA0u, RLX_AGENT); } else { xcd_barrier(bar); } } while (0)
    const int lo = p.ph_lo, hi = p.ph_hi;
#ifndef SUBMASK
#define SUBMASK 0x7f
#endif
#ifndef PHASE_MASK
#define PHASE_MASK 0xffff
#endif
#define IN(k) (((PHASE_MASK >> (k)) & 1) && lo <= (k) && (k) < hi)
#define SEAM(k) do { if (IN(k) && IN((k) + 1)) GRID_BAR(); } while (0)
    bf16* XH = (bf16*)(p.ws + WS_XH); bf16* QB = (bf16*)(p.ws + WS_Q); bf16* KB = (bf16*)(p.ws + WS_K); bf16* VB = (bf16*)(p.ws + WS_V);
    bf16* O0 = (bf16*)(p.ws + WS_O0); bf16* O1 = (bf16*)(p.ws + WS_XH);
    const LAS int* rowtab = (const LAS int*)(C.lds + ROWTAB_OFF);

    if (IN(0)) { p0_prologue(p, fresh(C)); } SEAM(0);

    for (int layer = 0; layer < 2; ++layer) {
        const int pb = 1 + (layer ? 8 : 0);
        if ((SUBMASK & 1) && IN(pb)) {
            if (layer == 1) cumsum_job(p, fresh(C));
            pg8::StaticOrder S; S.init(NRP, 3 * DM, C.G, (int)blockIdx.x, XH, DM * 2, p.ws + (layer ? WS_WQKV1 : WS_WQKV0), DM * 2);
            pg8::EpiQKV E{QB, KB, VB, attn_body::C2};
            pg8::gemm_phase<pg8::EpiQKV, pg8::StaticOrder, true, false>(C.lds + RING_OFF, DM, DM * 2, S, E, rowtab, 0);
        } SEAM(pb);
        if (layer == 0) {
            if (IN(2)) {
                const float* TAB = (const float*)(p.ws + WS_TAB);
                for (int pr = C.vcu; pr < NBATCH * 32 * 16; pr += C.G) { const int trip = pr >> 4, s = pr & 15, b = trip >> 5, m = (trip & 31) >> 1, f = trip & 1; const int cv = (m >> 1) * 128 + f * 64;
#pragma unroll 1
                    for (int w = 0; w < 2; ++w) attn_body::attn_unit<0, 8>(b, w ? s : 31 - s, m * 64, cv, cv, (const attn_body::bf16*)QB, (const attn_body::bf16*)KB, (const attn_body::bf16*)VB, (attn_body::bf16*)((m & 1) ? O1 : O0), TAB + m * 128, (char*)lds + RING_OFF); }
            } SEAM(2);
            if (IN(3)) { combine_phase(p, fresh(C)); } SEAM(3);
        } else {
            if (IN(10)) {
                const float* DK = (const float*)(p.ws + WS_DK);
                for (int pr = C.vcu; pr < NBATCH * 16 * 16; pr += C.G) { const int bh = pr >> 4, s = pr & 15, b = bh >> 4, h = bh & 15;
#pragma unroll 1
                    for (int w = 0; w < 2; ++w) attn_body::attn_unit<1, 8>(b, w ? s : 31 - s, h * 64, h * 64, h * 64, (const attn_body::bf16*)QB, (const attn_body::bf16*)KB, (const attn_body::bf16*)VB, (attn_body::bf16*)QB, DK + (size_t)bh * KROWS, (char*)lds + RING_OFF); }
                fox_meta_attn(p, fresh(C));
            } SEAM(10);
        }
        const int pw = layer ? 11 : 4;
        if ((SUBMASK & 4) && IN(pw)) {
            pg8::StaticOrder S; S.init(NRP, DM, C.G, (int)blockIdx.x, QB, DM * 2, p.ws + (layer ? WS_WO1 : WS_WO0), DM * 2);
            pg8::EpiZ E{layer ? p.out : p.x, layer ? (const float*)(p.ws + WS_HM) : p.meta, p.out, (float*)(p.ws + WS_HM)};
            pg8::gemm_phase<pg8::EpiZ, pg8::StaticOrder, true, false>(C.lds + RING_OFF, DM, DM * 2, S, E, rowtab, 0);
        } SEAM(pw);
        if ((SUBMASK & 8) && IN(pw + 1)) { ln_phase<0>(p, fresh(C), layer); } SEAM(pw + 1);
        if ((SUBMASK & 16) && IN(pw + 2)) {
            MoeOrder S; S.G = C.G; S.c = (int)blockIdx.x; S.A = (const char*)XH; S.W = (const char*)(p.ws + WS_WGU); S.wexp = (size_t)DM * DM * 2; S.tsB = (size_t)256 * DM * 2;
            moe_setup(p, fresh(C), layer, S);
            pg8::EpiGU E{(pg8::bf16_t*)O0};
            pg8::gemm_phase<pg8::EpiGU, MoeOrder, true, true>(C.lds + RING_OFF, DM, DM * 2, S, E, rowtab, 1);
        } SEAM(pw + 2);
        if ((SUBMASK & 32) && IN(pw + 3)) {
            MoeOrder S; S.G = C.G; S.c = (int)blockIdx.x; S.A = (const char*)O0; S.W = (const char*)(p.ws + WS_WD); S.wexp = (size_t)DM * DEXP * 2; S.tsB = (size_t)256 * DEXP * 2;
            moe_setup(p, fresh(C), layer, S);
            pg8::EpiDown E{(pg8::bf16_t*)KB, (const float*)(p.ws + WS_GV)};
            pg8::gemm_phase<pg8::EpiDown, MoeOrder, true, true>(C.lds + RING_OFF, DEXP, DEXP * 2, S, E, rowtab, 0);
        } SEAM(pw + 3);
        if ((SUBMASK & 64) && IN(pw + 4)) {
            if (layer == 0) { ln_phase<1>(p, fresh(C), 0); { const Ctx Cf = fresh(C); convert_experts(p, Cf, 1, 0, Cf.vcu * NWAVES + Cf.wave, Cf.G * NWAVES); } }
            else ln_phase<2>(p, fresh(C), 1);
        }
        if (layer == 0) SEAM(8);
    }
#undef IN
#undef SEAM
#undef GRID_BAR
}

extern "C" void kernel_launch(void* const* d_in, const int* in_sizes, int n_in, void* d_out, int out_size, void* d_ws, size_t ws_size, hipStream_t stream) {
    static int grid = 0;
    if (grid == 0) {
        if (n_in != 21 || in_sizes[0] != NREAL * DM || out_size != NREAL * DM || ws_size < WS_END) { fprintf(stderr, "kernel_launch: unexpected shapes (n_in %d, in0 %d, out %d, ws %zu); nothing launched\n", n_in, n_in > 0 ? in_sizes[0] : -1, out_size, ws_size); grid = -1; return; }
        int dev = 0, cus = 0, per_cu = 0;
        if (hipGetDevice(&dev) != hipSuccess || hipDeviceGetAttribute(&cus, hipDeviceAttributeMultiprocessorCount, dev) != hipSuccess) { fprintf(stderr, "kernel_launch: device query failed\n"); grid = -1; return; }
        if (hipFuncSetAttribute((const void*)trunk_fwd, hipFuncAttributeMaxDynamicSharedMemorySize, LDS_BYTES) != hipSuccess) { fprintf(stderr, "kernel_launch: hipFuncSetAttribute failed\n"); grid = -1; return; }
        if (hipOccupancyMaxActiveBlocksPerMultiprocessor(&per_cu, (const void*)trunk_fwd, NWAVES * 64, LDS_BYTES) != hipSuccess || per_cu < 1) { fprintf(stderr, "kernel_launch: occupancy query reports %d workgroups per CU\n", per_cu); }
        (void)hipGetLastError();
        grid = cus;
    }
    if (grid < 0) return;
    if (hipMemsetAsync((char*)d_ws + WS_CTL, 0, CTL_ZERO_BYTES, stream) != hipSuccess) { fprintf(stderr, "kernel_launch: hipMemsetAsync failed\n"); return; }
    Params a{};
    const float** dst = (const float**)&a.x;
    for (int i = 0; i < 21; ++i) dst[i] = (const float*)d_in[i];
    a.out = (float*)d_out; a.ws = (unsigned char*)d_ws;
#if MK_PER_PHASE
    for (int k = 0; k < N_PHASES; ++k) { a.ph_lo = k; a.ph_hi = k + 1; a.li = 0; hipLaunchKernelGGL(trunk_fwd, dim3(grid), dim3(NWAVES * 64), LDS_BYTES, stream, a); }
#else
    a.ph_lo = 0; a.ph_hi = N_PHASES; a.li = 0;
    hipLaunchKernelGGL(trunk_fwd, dim3(grid), dim3(NWAVES * 64), LDS_BYTES, stream, a);
#endif
    const hipError_t le = hipPeekAtLastError();
    if (le != hipSuccess) fprintf(stderr, "kernel_launch: launch failed: %s\n", hipGetErrorName(le));
}
```

```cpp
#include <hip/hip_runtime.h>
#include <hip/hip_bf16.h>
#include <cstdio>
#include <cstdint>
#include <cmath>

constexpr int DM = 1024, NBATCH = 4, SEQ = 8192, NMETA = 16;
constexpr int NREAL = NBATCH * SEQ;
constexpr int NR = NREAL + NMETA;
constexpr int NRP = 129 * 256;
constexpr int KPRE = 64;
constexpr int KROWS = KPRE + SEQ + 64;
constexpr int NSLOT = 2 * NR;
constexpr int NEXP = 32, DEXP = 512;
constexpr float ALPHA = 1.41421356237309515f;
constexpr float LN_EPS = 1e-5f;
constexpr float LOG2E = 1.4426950408889634f;
constexpr float LAMBDA_INIT0 = 0.2f;

namespace pg8 {
#define PG8_LAS __attribute__((address_space(3)))
typedef unsigned short bf16_t;
typedef short bf16x8 __attribute__((ext_vector_type(8)));
typedef float f32x4 __attribute__((ext_vector_type(4)));
typedef unsigned u32x4 __attribute__((ext_vector_type(4)));
constexpr int BM = 256, BK = 64, HALF = 128, HTB = HALF * BK * 2  , STAGE_BYTES = 8 * HTB, NXCD = 8, WGM = 8;

__host__ __device__ __forceinline__ int lds_byte(int r, int c) { const int st = (r >> 4) * 2 + (c >> 5), rr = r & 15, cc = c & 31, ob = rr * 64 + cc * 2; return st * 1024 + (ob ^ (((ob >> 9) & 1) << 5)); }
__host__ __device__ __forceinline__ void stage_rc(int b, int& R, int& C) { const int st = b / 1024, sb = b % 1024, swz = sb ^ (((sb >> 9) & 1) << 5); R = (st >> 1) * 16 + swz / 64; C = (st & 1) * 32 + (swz % 64) / 2; }
__host__ __device__ __forceinline__ int perm32(int rho) { const int n = rho >> 4, i = rho & 15; return 8 * (i >> 2) + 4 * n + (i & 3); }

struct Unit { int pm, pn; const char* A; const char* B; int tab; int e; };

struct StaticOrder {
    int nM, nN, nwg, G, c; const char* A; const char* B; size_t tsA, tsB;
    __device__ void init(int M, int N, int G_, int c_, const void* A_, size_t lda_bytes, const void* B_, size_t ldb_bytes) { nM = M / BM; nN = N / BM; nwg = nM * nN; G = G_; c = c_; A = (const char*)A_; B = (const char*)B_; tsA = lda_bytes * BM; tsB = ldb_bytes * BM; }
    __device__ bool next(int i, Unit& u) const {
        const long L = (long)i * G + c; if (L >= nwg) return false;
        int wgid = (int)L; { const int q = nwg / NXCD, r = nwg % NXCD, xcd = wgid % NXCD, off = wgid / NXCD; wgid = (xcd < r ? xcd * (q + 1) : r * (q + 1) + (xcd - r) * q) + off; }
        const int nig = WGM * nN, gid = wgid / nig, fm = gid * WGM, gsz = (nM - fm) < WGM ? (nM - fm) : WGM;
        u.pm = fm + ((wgid % nig) % gsz); u.pn = (wgid % nig) / gsz; u.A = A + (size_t)u.pm * tsA; u.B = B + (size_t)u.pn * tsB; u.tab = 0; u.e = 0; return true;
    }
};

__device__ __forceinline__ unsigned cvt_pk_bf16(float lo, float hi) { unsigned r; asm volatile("v_cvt_pk_bf16_f32 %0, %1, %2" : "=v"(r) : "v"(lo), "v"(hi)); return r; }

template <class Epi, class Sched, bool ALIGN_EPI, bool GATHER>
__device__ __forceinline__ void gemm_phase(PG8_LAS unsigned char* lds, const int K, const unsigned lda, const Sched& S, const Epi& E, const PG8_LAS int* rowtab, const int ashift) {
    int tid_ = threadIdx.x; asm volatile("" : "+v"(tid_));
    const int tid = tid_, wid = __builtin_amdgcn_readfirstlane(tid >> 6), lane = tid & 63, wr = wid >> 2, wc = wid & 3, fr = lane & 15, fq = lane >> 4;
    const int nt = K / BK;
    unsigned voffB[2], offA[2][2], noffA[2][2]; int Rr[2], Cc[2];
#pragma unroll
    for (int i = 0; i < 2; ++i) { int R, C; stage_rc(tid * 16 + i * 8192, R, C); const int Rb = Epi::PERM ? ((R & ~31) + perm32(R & 31)) : R; Rr[i] = R; Cc[i] = C;
        voffB[i] = (unsigned)(Rb * K + C) * 2u;
#pragma unroll
        for (int h = 0; h < 2; ++h) { offA[h][i] = (unsigned)(R + HALF * h) * lda + (unsigned)C * 2u; noffA[h][i] = offA[h][i]; } }
    const size_t kstep = (size_t)(BK * 2);
    const size_t hstep = (size_t)HALF * K * 2;
    const unsigned ldsw = (unsigned)wid * 1024u;
    const int aoff = lds_byte(wr * 64 + fr, fq * 8), boff = lds_byte(wc * 32 + fr, fq * 8);
#define PG8_SA(b, h) (((b) * 2 + (h)) * HTB)
#define PG8_SB(b, h) ((4 + (b) * 2 + (h)) * HTB)
#define PG8_STAGE(bufoff, gbase, voff) do { _Pragma("unroll") for (int _i = 0; _i < 2; ++_i) \
        __builtin_amdgcn_global_load_lds((const unsigned*)((const char*)(gbase) + (voff)[_i]), (PG8_LAS unsigned*)(lds + (bufoff) + ldsw + _i * 8192), 16, 0, 0); } while (0)
#define PG8_LDA(dst, b, h) do { _Pragma("unroll") for (int m = 0; m < 4; ++m) _Pragma("unroll") for (int k = 0; k < 2; ++k) dst[m][k] = *(const PG8_LAS bf16x8*)(lds + PG8_SA(b, h) + aoff + m * 2048 + k * 1024); } while (0)
#define PG8_LDB(dst, b, h) do { _Pragma("unroll") for (int n = 0; n < 2; ++n) _Pragma("unroll") for (int k = 0; k < 2; ++k) dst[n][k] = *(const PG8_LAS bf16x8*)(lds + PG8_SB(b, h) + boff + n * 2048 + k * 1024); } while (0)
#define PG8_MMA(ai, bj, At, Bt) do { __builtin_amdgcn_s_setprio(1); _Pragma("unroll") for (int m = 0; m < 4; ++m) _Pragma("unroll") for (int n = 0; n < 2; ++n) _Pragma("unroll") for (int k = 0; k < 2; ++k) \
        acc[ai][bj][m][n] = __builtin_amdgcn_mfma_f32_16x16x32_bf16(Bt[n][k], At[m][k], acc[ai][bj][m][n], 0, 0, 0); __builtin_amdgcn_s_setprio(0); } while (0)
#define PG8_WAIT_V(n) asm volatile("s_waitcnt vmcnt(" #n ")" ::: "memory")
#define PG8_WAIT_L(n) asm volatile("s_waitcnt lgkmcnt(" #n ")" ::: "memory")
#define PG8_BAR __builtin_amdgcn_s_barrier()
#define PG8_SCHED __builtin_amdgcn_sched_barrier(0)
#define PG8_GOFF(dst, u) do { if constexpr (GATHER) { _Pragma("unroll") for (int _h = 0; _h < 2; ++_h) _Pragma("unroll") for (int _i = 0; _i < 2; ++_i) { \
        int _e = rowtab[(u).tab * 256 + _h * HALF + Rr[_i]]; _e = _e < 0 ? 0 : (_e >> ashift); dst[_h][_i] = (unsigned)_e * lda + (unsigned)Cc[_i] * 2u; } } } while (0)
    Unit cur, nxt; int ui = 0;
    if (!S.next(0, cur)) return;
    f32x4 acc[2][2][4][2];
#pragma unroll
    for (int a = 0; a < 2; ++a)
#pragma unroll
        for (int b = 0; b < 2; ++b)
#pragma unroll
            for (int m = 0; m < 4; ++m)
#pragma unroll
                for (int n = 0; n < 2; ++n) acc[a][b][m][n] = (f32x4){0.f, 0.f, 0.f, 0.f};
    bf16x8 At[4][2], B0[2][2], B1[2][2];
    const char* cA = cur.A; const char* cB = cur.B;
    PG8_GOFF(offA, cur);
    PG8_STAGE(PG8_SB(0, 0), cB, voffB); PG8_STAGE(PG8_SB(0, 1), cB + hstep, voffB); PG8_STAGE(PG8_SA(0, 0), cA, offA[0]); PG8_STAGE(PG8_SA(0, 1), cA, offA[1]);
    if (wr == 1) PG8_BAR;
    PG8_WAIT_V(2); PG8_BAR;
    PG8_STAGE(PG8_SB(1, 0), cB + kstep, voffB); PG8_STAGE(PG8_SA(1, 0), cA + kstep, offA[0]); PG8_STAGE(PG8_SB(1, 1), cB + hstep + kstep, voffB);
    PG8_WAIT_V(6); PG8_BAR;
    for (;;) {
        const bool has_next = S.next(ui + 1, nxt);
        const char* nA = has_next ? nxt.A : cA; const char* nB = has_next ? nxt.B : cB;
        if constexpr (GATHER) { if (has_next) PG8_GOFF(noffA, nxt); else {
#pragma unroll
            for (int h = 0; h < 2; ++h)
#pragma unroll
                for (int i = 0; i < 2; ++i) noffA[h][i] = offA[h][i]; } }
        for (int t = 0; t < nt; t += 2) {
            const bool last = (t == nt - 2);
            const char* a1 = cA + (size_t)(t + 1) * kstep;
            const char* a2 = last ? nA : cA + (size_t)(t + 2) * kstep; const char* b2 = last ? nB : cB + (size_t)(t + 2) * kstep;
            const char* a3 = a2 + kstep; const char* b3 = b2 + kstep;
            unsigned o2[2][2];
#pragma unroll
            for (int h = 0; h < 2; ++h)
#pragma unroll
                for (int i = 0; i < 2; ++i) o2[h][i] = (GATHER && last) ? noffA[h][i] : offA[h][i];
            PG8_LDB(B0, 0, 0); PG8_LDB(B1, 0, 1); PG8_SCHED; PG8_LDA(At, 0, 0); PG8_STAGE(PG8_SA(1, 1), a1, offA[1]);
            PG8_WAIT_V(8); PG8_WAIT_L(0); PG8_BAR; PG8_MMA(0, 0, At, B0); PG8_MMA(0, 1, At, B1); PG8_BAR; PG8_SCHED;
            PG8_LDA(At, 0, 1); PG8_STAGE(PG8_SB(0, 0), b2, voffB); PG8_STAGE(PG8_SB(0, 1), b2 + hstep, voffB); PG8_STAGE(PG8_SA(0, 0), a2, o2[0]);
            PG8_WAIT_V(8); PG8_WAIT_L(0); PG8_BAR; PG8_MMA(1, 0, At, B0); PG8_MMA(1, 1, At, B1); PG8_BAR; PG8_SCHED;
            PG8_LDB(B0, 1, 0); PG8_LDB(B1, 1, 1); PG8_SCHED; PG8_LDA(At, 1, 0); PG8_STAGE(PG8_SA(0, 1), a2, o2[1]);
            PG8_WAIT_V(8); PG8_WAIT_L(0); PG8_BAR; PG8_MMA(0, 0, At, B0); PG8_MMA(0, 1, At, B1); PG8_BAR; PG8_SCHED;
            PG8_LDA(At, 1, 1); PG8_STAGE(PG8_SB(1, 0), b3, voffB); PG8_STAGE(PG8_SB(1, 1), b3 + hstep, voffB); PG8_STAGE(PG8_SA(1, 0), a3, o2[0]);
            PG8_WAIT_V(8); PG8_WAIT_L(0); PG8_BAR; PG8_MMA(1, 0, At, B0); PG8_MMA(1, 1, At, B1); PG8_BAR; PG8_SCHED;
        }
        if constexpr (ALIGN_EPI) { if (wr == 0) PG8_BAR; }
        E(acc, cur, wr, wc, fr, fq, rowtab);
        if (!has_next) break;
#pragma unroll
        for (int a = 0; a < 2; ++a)
#pragma unroll
            for (int b = 0; b < 2; ++b)
#pragma unroll
                for (int m = 0; m < 4; ++m)
#pragma unroll
                    for (int n = 0; n < 2; ++n) acc[a][b][m][n] = (f32x4){0.f, 0.f, 0.f, 0.f};
        cur = nxt; cA = nA; cB = nB; ++ui;
        if constexpr (GATHER) {
#pragma unroll
            for (int h = 0; h < 2; ++h)
#pragma unroll
                for (int i = 0; i < 2; ++i) offA[h][i] = noffA[h][i]; }
        if constexpr (ALIGN_EPI) { if (wr == 1) PG8_BAR; }
    }
    PG8_WAIT_V(0);
    if constexpr (!ALIGN_EPI) { if (wr == 0) PG8_BAR; }
    PG8_BAR;
#undef PG8_SA
#undef PG8_SB
#undef PG8_STAGE
#undef PG8_LDA
#undef PG8_LDB
#undef PG8_MMA
#undef PG8_WAIT_V
#undef PG8_WAIT_L
#undef PG8_BAR
#undef PG8_SCHED
#undef PG8_GOFF
}

struct EpiQKV {
    static constexpr bool PERM = true;
    bf16_t* Q; bf16_t* Kb; bf16_t* Vb; float qscale;
    unsigned* qm; unsigned* km;
    __device__ __forceinline__ void operator()(const f32x4 (&acc)[2][2][4][2], const Unit& u, int wr, int wc, int fr, int fq, const PG8_LAS int*) const {
        const int row0 = u.pm * BM + wr * 64 + fr; const int t = (u.pn * BM) >> 10; const int colt = (u.pn * BM) & 1023;
        const int col0 = colt + wc * 32 + 8 * fq; const float sc = (t == 0) ? qscale : 1.f;
        bf16_t* kv = (t == 1) ? Kb : Vb;
        float mx[2] = {0.f, 0.f};
#pragma unroll
        for (int ai = 0; ai < 2; ++ai)
#pragma unroll
            for (int m = 0; m < 4; ++m) { const int r = row0 + ai * HALF + m * 16;
                if (r < NR) {
#pragma unroll
                for (int bj = 0; bj < 2; ++bj) { const f32x4 v0 = acc[ai][bj][m][0] * sc, v1 = acc[ai][bj][m][1] * sc;
                    u32x4 w; w.x = cvt_pk_bf16(v0[0], v0[1]); w.y = cvt_pk_bf16(v0[2], v0[3]); w.z = cvt_pk_bf16(v1[0], v1[1]); w.w = cvt_pk_bf16(v1[2], v1[3]);
                    const int c = col0 + bj * HALF;
                    bf16_t* dst = (t == 0) ? Q + (size_t)r * DM : kv + (size_t)(r < NREAL ? (r >> 13) * KROWS + KPRE + (r & (SEQ - 1)) : r - NREAL) * DM;
                    *(u32x4*)(dst + c) = w; } }
                if (qm != nullptr && t < 2) {
#pragma unroll
                    for (int bj = 0; bj < 2; ++bj) { const f32x4 v0 = acc[ai][bj][m][0] * sc, v1 = acc[ai][bj][m][1] * sc;
                        float ss = (v0[0] * v0[0] + v0[1] * v0[1]) + (v0[2] * v0[2] + v0[3] * v0[3]) + (v1[0] * v1[0] + v1[1] * v1[1]) + (v1[2] * v1[2] + v1[3] * v1[3]);
                        ss += __shfl_xor(ss, 16); ss += __shfl_xor(ss, 32);
                        if (r < NR) mx[bj] = fmaxf(mx[bj], ss); } } }
        if (qm != nullptr && t < 2) {
#pragma unroll
            for (int bj = 0; bj < 2; ++bj) { float v = mx[bj]; v = fmaxf(v, __shfl_xor(v, 1)); v = fmaxf(v, __shfl_xor(v, 2)); v = fmaxf(v, __shfl_xor(v, 4)); v = fmaxf(v, __shfl_xor(v, 8));
                if (fr == 0 && fq == 0) { const int head = 4 * (u.pn & 3) + 2 * bj + (wc >> 1), part = wc & 1; const unsigned bits = __float_as_uint(v);
                    if (t == 0) { if (u.pm < NREAL / BM) atomicMax(qm + ((size_t)u.pm * 16 + head) * 8 + part, bits); }
                    else if (u.pm < NREAL / BM) atomicMax(km + ((size_t)(u.pm >> 5) * 16 + head) * 8 + part, bits);
                    else { for (int b = 0; b < NBATCH; ++b) atomicMax(km + ((size_t)b * 16 + head) * 8 + part, bits); } } } }
    }
};
struct EpiZ {
    static constexpr bool PERM = false;
    const float* base_real; const float* base_meta; float* out_real; float* out_meta;
    __device__ __forceinline__ void operator()(const f32x4 (&acc)[2][2][4][2], const Unit& u, int wr, int wc, int fr, int fq, const PG8_LAS int*) const {
        const int row0 = u.pm * BM + wr * 64 + fr; const int col0 = u.pn * BM + wc * 32 + 4 * fq;
#pragma unroll
        for (int ai = 0; ai < 2; ++ai)
#pragma unroll
            for (int m = 0; m < 4; ++m) { const int r = row0 + ai * HALF + m * 16;
                if (r < NR) { const float* bp = r < NREAL ? base_real + (size_t)r * DM : base_meta + (size_t)(r - NREAL) * DM; float* op = r < NREAL ? out_real + (size_t)r * DM : out_meta + (size_t)(r - NREAL) * DM;
#pragma unroll
                    for (int bj = 0; bj < 2; ++bj)
#pragma unroll
                        for (int n = 0; n < 2; ++n) { const int c = col0 + bj * HALF + n * 16; const f32x4 bs = *(const f32x4*)(bp + c); *(f32x4*)(op + c) = acc[ai][bj][m][n] + bs * ALPHA; } } }
    }
};
struct EpiGU {
    static constexpr bool PERM = true;
    bf16_t* U;
    __device__ __forceinline__ void operator()(const f32x4 (&acc)[2][2][4][2], const Unit& u, int wr, int wc, int fr, int fq, const PG8_LAS int* rowtab) const {
        const int col0 = u.pn * HALF + wc * 32 + 8 * fq;
#pragma unroll
        for (int ai = 0; ai < 2; ++ai)
#pragma unroll
            for (int m = 0; m < 4; ++m) { const int slot = rowtab[u.tab * 256 + ai * HALF + wr * 64 + m * 16 + fr];
                if (slot >= 0) { float o[8];
#pragma unroll
                    for (int n = 0; n < 2; ++n)
#pragma unroll
                        for (int c = 0; c < 4; ++c) { const float g = acc[ai][0][m][n][c], up = acc[ai][1][m][n][c]; o[n * 4 + c] = g * up * __builtin_amdgcn_rcpf(1.f + __builtin_amdgcn_exp2f(-g * LOG2E)); }
                    u32x4 w; w.x = cvt_pk_bf16(o[0], o[1]); w.y = cvt_pk_bf16(o[2], o[3]); w.z = cvt_pk_bf16(o[4], o[5]); w.w = cvt_pk_bf16(o[6], o[7]);
                    *(u32x4*)(U + (size_t)slot * DEXP + col0) = w; } }
    }
};
struct EpiDown {
    static constexpr bool PERM = true;
    bf16_t* Y; const float* GV;
    __device__ __forceinline__ void operator()(const f32x4 (&acc)[2][2][4][2], const Unit& u, int wr, int wc, int fr, int fq, const PG8_LAS int* rowtab) const {
        const int col0 = u.pn * BM + wc * 32 + 8 * fq;
#pragma unroll
        for (int ai = 0; ai < 2; ++ai)
#pragma unroll
            for (int m = 0; m < 4; ++m) { const int slot = rowtab[u.tab * 256 + ai * HALF + wr * 64 + m * 16 + fr];
                if (slot >= 0) { const float gv = GV[slot];
#pragma unroll
                    for (int bj = 0; bj < 2; ++bj) { const f32x4 v0 = acc[ai][bj][m][0] * gv, v1 = acc[ai][bj][m][1] * gv;
                        u32x4 w; w.x = cvt_pk_bf16(v0[0], v0[1]); w.y = cvt_pk_bf16(v0[2], v0[3]); w.z = cvt_pk_bf16(v1[0], v1[1]); w.w = cvt_pk_bf16(v1[2], v1[3]);
                        *(u32x4*)(Y + (size_t)slot * DM + col0 + bj * HALF) = w; } } }
    }
};
}
namespace attn_body {
using bf16=__hip_bfloat16;
using bf16x8=__attribute__((ext_vector_type(8)))short;
using s16x4=__attribute__((ext_vector_type(4)))short;
using f32x16=__attribute__((ext_vector_type(16)))float;
using u32x4=__attribute__((ext_vector_type(4)))unsigned;
constexpr int D=64;
constexpr int NW=8,QBLK=32,QB=QBLK*NW,KVBLK=64,NQB=SEQ/QB;
constexpr int ATTN_PITCH=DM, ATTN_UNIT_ROWS=QB;
__device__ __forceinline__ int crow(int r,int hi){return (r&3)+8*(r>>2)+4*hi;}
#define SBAR() __builtin_amdgcn_sched_barrier(0)
__device__ __forceinline__ void cmask(f32x16&p0,f32x16&p1,int jb,int qrel,int hi){
  const float NEG=-INFINITY; int kb=64*jb+4*hi;
  #pragma unroll
  for(int r=0;r<16;++r){int kv=kb+(r&3)+8*(r>>2); if(kv>qrel)p0[r]=NEG; if(kv+32>qrel)p1[r]=NEG;}
}

constexpr int RT_OFFS=320, RT_SIZE=704;

template<int MODE> __device__ __forceinline__ void modtile_slow(f32x16&p0,f32x16&p1,int t,int q_abs,int hi,const __attribute__((address_space(3))) float* tab){
  const float NEG=-INFINITY; int hi4=4*hi; asm volatile("":"+v"(hi4),"+v"(q_abs));
  if(MODE==0){
    if(t==0){
      int bd=16+q_abs; bd=bd>383?383:bd; const __attribute__((address_space(3))) float* bp=tab+(RT_OFFS+bd-hi4-15);
      #pragma unroll
      for(int r=0;r<16;++r){ p1[r]=NEG; if(r<8)p0[r]+=bp[15-((r&3)+8*(r>>2))]; else p0[r]=NEG; }
    } else {
      const __attribute__((address_space(3))) float* bp=tab+(RT_OFFS+q_abs-64*t+KPRE-hi4-63);
      const int dq=q_abs-64*t+KPRE-hi4;
      #pragma unroll
      for(int r=0;r<16;++r){ const int c=(r&3)+8*(r>>2); p0[r]+=bp[63-c]; p1[r]+=bp[31-c]; if(c>dq)p0[r]=NEG; if(c+32>dq)p1[r]=NEG; }
    }
  } else {
    #pragma unroll
    for(int r=0;r<16;++r){
      #pragma unroll
      for(int hf=0;hf<2;++hf){
        const int js=32*hf+(r&3)+8*(r>>2)+hi4;
        const int ks=64*t+js;
        float x=hf?p1[r]:p0[r];
        if(t==0){ if(js>=NMETA)x=NEG; else x+=tab[ks]; }
        else { const int kr=ks-KPRE; if(kr>q_abs)x=NEG; else x+=tab[ks]; }
        if(hf)p1[r]=x; else p0[r]=x; }
      if((r&1)==1)asm volatile("":::"memory"); }
  }
}
__device__ __forceinline__ void modtile_fast1(f32x16&p0,f32x16&p1,int t,int hi,const __attribute__((address_space(3))) float* tab){
  typedef float f4 __attribute__((ext_vector_type(4)));
  const __attribute__((address_space(3))) f4* tp=(const __attribute__((address_space(3))) f4*)(tab+64*t+4*hi);
  #pragma unroll
  for(int g=0;g<4;++g){ const f4 a=tp[2*g], b=tp[8+2*g];
    #pragma unroll
    for(int c=0;c<4;++c){ p0[4*g+c]+=a[c]; p1[4*g+c]+=b[c]; } }
}
constexpr int NSLOT=3, SLOTB=8192;
constexpr int LDS_K=0, LDS_V=NSLOT*SLOTB, LDS_WS=2*NSLOT*SLOTB, LDS_OST=LDS_WS+NW*64*4, LDS_TAB=LDS_OST+NW*4096, LDS_BYTES=LDS_TAB+KROWS*4;
constexpr float C2=0.125f*1.4426950408889634f;
__device__ __forceinline__ void glds16(const void*gsrc,unsigned lds_dst){unsigned keep;
  asm volatile("s_mov_b32 %0, m0\n\ts_mov_b32 m0, %2\n\ts_nop 0\n\tglobal_load_lds_dwordx4 %1, off\n\ts_mov_b32 m0, %0":"=&s"(keep):"v"(gsrc),"s"(lds_dst):"memory");}
__device__ __forceinline__ float max3f(float a,float b,float c){float r;asm("v_max3_f32 %0, %1, %2, %3":"=v"(r):"v"(a),"v"(b),"v"(c));return r;}
__device__ __forceinline__ float max2f(float a,float b){float r;asm("v_max_f32_e32 %0, %1, %2":"=v"(r):"v"(a),"v"(b));return r;}
__device__ __forceinline__ float fadd_s(float a,float b){float r;asm("v_add_f32_e32 %0, %1, %2":"=v"(r):"v"(a),"v"(b));return r;}
__device__ __forceinline__ float fsub_s(float a,float b){float r;asm("v_sub_f32_e32 %0, %1, %2":"=v"(r):"v"(a),"v"(b));return r;}
typedef float f32x2_t __attribute__((ext_vector_type(2))); typedef __bf16 bf16x2_t __attribute__((ext_vector_type(2)));
__device__ __forceinline__ unsigned cvtpk_s(float lo,float hi){f32x2_t v={lo,hi};bf16x2_t b=__builtin_convertvector(v,bf16x2_t);return __builtin_bit_cast(unsigned,b);}
#define WAIT_BAR(N) asm volatile("s_waitcnt vmcnt(" #N ") lgkmcnt(0)\n\ts_barrier":::"memory")

__device__ __forceinline__ void qkt(f32x16&p0,f32x16&p1,const char*Kslot,const bf16x8*qr,const f32x16&negm,int r32,int hi){
  const char*kb=Kslot+hi*1024+r32*16;
  #pragma unroll
  for(int d0=0;d0<4;++d0){
    const bf16x8 b0=*reinterpret_cast<const bf16x8*>(kb+d0*2048);
    const bf16x8 b1=*reinterpret_cast<const bf16x8*>(kb+d0*2048+512);
    if(d0==0){p0=__builtin_amdgcn_mfma_f32_32x32x16_bf16(b0,qr[0],negm,0,0,0);p1=__builtin_amdgcn_mfma_f32_32x32x16_bf16(b1,qr[0],negm,0,0,0);}
    else{p0=__builtin_amdgcn_mfma_f32_32x32x16_bf16(b0,qr[d0],p0,0,0,0);p1=__builtin_amdgcn_mfma_f32_32x32x16_bf16(b1,qr[d0],p1,0,0,0);}}
}
typedef __attribute__((address_space(3))) const char* lds_cptr;
typedef short v4i16_t __attribute__((ext_vector_type(4)));
__device__ __forceinline__ void kload8(bf16x8*kf,lds_cptr kp){
  kf[0]=*(const __attribute__((address_space(3))) bf16x8*)(kp);      kf[1]=*(const __attribute__((address_space(3))) bf16x8*)(kp+512);
  kf[2]=*(const __attribute__((address_space(3))) bf16x8*)(kp+2048); kf[3]=*(const __attribute__((address_space(3))) bf16x8*)(kp+2560);
  kf[4]=*(const __attribute__((address_space(3))) bf16x8*)(kp+4096); kf[5]=*(const __attribute__((address_space(3))) bf16x8*)(kp+4608);
  kf[6]=*(const __attribute__((address_space(3))) bf16x8*)(kp+6144); kf[7]=*(const __attribute__((address_space(3))) bf16x8*)(kp+6656);
}
__device__ __forceinline__ void kload2(bf16x8*kf,lds_cptr kp,int j){ kf[2*j]=*(const __attribute__((address_space(3))) bf16x8*)(kp+j*2048); kf[2*j+1]=*(const __attribute__((address_space(3))) bf16x8*)(kp+j*2048+512); }
__device__ __forceinline__ s16x4 vtr(lds_cptr p){ return __builtin_bit_cast(s16x4,__builtin_amdgcn_ds_read_tr16_b64_v4i16((__attribute__((address_space(3))) v4i16_t*)p)); }
__device__ __forceinline__ float rowmax(const f32x16&p0,const f32x16&p1){
  float a=max3f(p0[0],p0[1],p1[0]),b=max3f(p0[2],p0[3],p1[1]);a=max3f(a,p1[2],p1[3]);
  #pragma unroll
  for(int r=4;r<16;r+=4){a=max3f(a,p0[r],p0[r+1]);b=max3f(b,p0[r+2],p0[r+3]);a=max3f(a,p1[r],p1[r+1]);b=max3f(b,p1[r+2],p1[r+3]);}
  const float m=max2f(a,b);
  auto rr=__builtin_amdgcn_permlane32_swap(__float_as_uint(m),__float_as_uint(m),false,false);
  return max2f(__uint_as_float(rr[0]),__uint_as_float(rr[1]));
}
__device__ __forceinline__ void pv(f32x16*o,int vb,bf16x8 pa0,bf16x8 pa1,bf16x8 pa2,bf16x8 pa3){
  #pragma unroll
  for(int d0=0;d0<2;++d0){s16x4 lo[4],hi[4];
    #pragma unroll
    for(int ks=0;ks<4;++ks){
      asm volatile("ds_read_b64_tr_b16 %0,%1 offset:%c2":"=&v"(lo[ks]):"v"(vb),"i"(d0*4096+ks*1024):"memory");
      asm volatile("ds_read_b64_tr_b16 %0,%1 offset:%c2":"=&v"(hi[ks]):"v"(vb),"i"(d0*4096+ks*1024+512):"memory");}
    asm volatile("s_waitcnt lgkmcnt(0)":::"memory");SBAR();
    #define PK(k) (bf16x8){lo[k][0],lo[k][1],lo[k][2],lo[k][3],hi[k][0],hi[k][1],hi[k][2],hi[k][3]}
    o[d0]=__builtin_amdgcn_mfma_f32_32x32x16_bf16(pa0,PK(0),o[d0],0,0,0);
    o[d0]=__builtin_amdgcn_mfma_f32_32x32x16_bf16(pa1,PK(1),o[d0],0,0,0);
    o[d0]=__builtin_amdgcn_mfma_f32_32x32x16_bf16(pa2,PK(2),o[d0],0,0,0);
    o[d0]=__builtin_amdgcn_mfma_f32_32x32x16_bf16(pa3,PK(3),o[d0],0,0,0);
    #undef PK
  }
}

#ifndef ATTN_STORE16
#define ATTN_STORE16(p,v) (*(u32x4*)(p)=(v))
#endif
template<int MODE,int THRL> __device__ __forceinline__ void attn_unit(int b,int qb,int tb,int cq,int cv,int co,const bf16*Q,const bf16*__restrict__ K,const bf16*__restrict__ V,bf16*O,const float*tabsrc,char*shm){
  int tid_=threadIdx.x; asm volatile("":"+v"(tid_));
  const int tid=tid_,lane=tid&63,r32=lane&31,hi=lane>>5; const int wid=__builtin_amdgcn_readfirstlane(tid>>6);
  const long rowbase=(long)b*SEQ, rowbase_k=(long)b*KROWS; const int q0=qb*QB;
  const bf16*Qw=Q+(rowbase+q0+wid*QBLK)*DM+cq;
  const bf16*Kh=K+rowbase_k*DM+cq,*Vh=V+rowbase_k*DM+cv;
  const unsigned lds0=(unsigned)(uintptr_t)shm;
  const __attribute__((address_space(3))) char* shm3_=(const __attribute__((address_space(3))) char*)shm;
  float*wsf=(float*)(shm+LDS_WS)+wid*64;
  const bf16*ksrc=Kh+(long)(lane+64*tb)*DM+wid*8;
  const bf16*vsrc=Vh+(long)(16*(wid&3)+(lane>>2)+64*tb)*DM+(wid>>2)*32+(lane&3)*8;
  const unsigned kdst=lds0+LDS_K+wid*1024, vdst=lds0+LDS_V+wid*1024;
  #define DMA_K(t,slot) glds16(ksrc+(long)(t)*KVBLK*DM,(unsigned)__builtin_amdgcn_readfirstlane(kdst+(slot)))
  #define DMA_V(t,slot) glds16(vsrc+(long)(t)*KVBLK*DM,(unsigned)__builtin_amdgcn_readfirstlane(vdst+(slot)))
  const int vb0=(int)(lds0+LDS_V)+((lane>>4)&1)*32+(lane&3)*8+(4*hi+((lane&15)>>2))*64;
  const char*Kbase=shm+LDS_K; bf16x8 kf[8];
  const lds_cptr shm3=(lds_cptr)shm; const lds_cptr kp0=shm3+LDS_K+hi*1024+r32*16; const lds_cptr vp0=shm3+LDS_V+((lane>>4)&1)*32+(lane&3)*8+(4*hi+((lane&15)>>2))*64;
  const int NT=(KPRE+q0+QB+KVBLK)/KVBLK-tb;
  const __attribute__((address_space(3))) float* tab=(const __attribute__((address_space(3))) float*)(shm3_+LDS_TAB);
  { __attribute__((address_space(3))) float* tw=(__attribute__((address_space(3))) float*)(shm3_+LDS_TAB);
    if(MODE==0){ for(int i=tid;i<RT_SIZE;i+=512){ const int d=i-RT_OFFS; tw[i]=d<0?-INFINITY:(d<128?tabsrc[d]:0.f); } }
    else { const int n=KPRE+q0+QB+KVBLK; for(int i=64*tb+tid*4;i<n;i+=2048){ const float4 v=*(const float4*)(tabsrc+i); tw[i]=v.x;tw[i+1]=v.y;tw[i+2]=v.z;tw[i+3]=v.w; } } }
  if(tb==0){ glds16(K+cq+(long)lane*DM+wid*8,(unsigned)__builtin_amdgcn_readfirstlane(kdst)); glds16(V+cv+(long)(16*(wid&3)+(lane>>2))*DM+(wid>>2)*32+(lane&3)*8,(unsigned)__builtin_amdgcn_readfirstlane(vdst)); } else { DMA_K(0,0); DMA_V(0,0); } DMA_K(1,SLOTB);
  bf16x8 qr[4];
  #pragma unroll
  for(int d0=0;d0<4;++d0)qr[d0]=*reinterpret_cast<const bf16x8*>(&Qw[(long)r32*DM+d0*16+hi*8]);
  float mhat=0.f,l_reg=0.f;f32x16 o[2];o[0]=f32x16{};o[1]=f32x16{};f32x16 negm=f32x16{};asm volatile("":"+v"(negm));
  const int qrel=wid*QBLK+r32, q_abs=q0+qrel;
  #define MODT(P0,P1,t,SL) do{ if(SL)modtile_slow<MODE>(P0,P1,(t)+tb,q_abs,hi,tab); else if(MODE==1)modtile_fast1(P0,P1,(t)+tb,hi,tab); }while(0)
  bool resc=false;
  #define START(P0,P1) do{ const float rm=rowmax(P0,P1); resc=false; \
    { const float dl=(MODE==1)?__builtin_fmaxf(rm,0.f):rm; mhat=fadd_s(mhat,dl); \
      _Pragma("unroll") for(int r=0;r<16;++r){P0[r]=fsub_s(P0[r],dl);P1[r]=fsub_s(P1[r],dl);} \
      _Pragma("unroll") for(int r=0;r<16;++r)negm[r]=-mhat; asm volatile("":"+v"(negm)); } \
    _Pragma("unroll") for(int r=0;r<16;++r)P0[r]=__builtin_amdgcn_exp2f(P0[r]); }while(0)
  #define RESC() do{ if(resc){ asm volatile("s_waitcnt lgkmcnt(0)":::"memory"); \
      _Pragma("unroll") for(int d_=0;d_<2;++d_) _Pragma("unroll") for(int r=0;r<16;++r)o[d_][r]*=wsf[crow(r,hi)]; } }while(0)
  f32x16 pA0,pA1,pB0,pB1;
  int sl_prev=0,sl_cur=0,sl_next=SLOTB;
  #define ROT() do{sl_prev=sl_cur;sl_cur=sl_next;sl_next=(sl_next==(NSLOT-1)*SLOTB)?0:sl_next+SLOTB;}while(0)
  DMA_K(2,2*SLOTB);
  WAIT_BAR(3);
  if(MODE==1){ mhat=tab[KPRE+q_abs]; _Pragma("unroll") for(int r=0;r<16;++r)negm[r]=-mhat; asm volatile("":"+v"(negm)); }
  qkt(pA0,pA1,Kbase,qr,negm,r32,hi);asm volatile("s_nop 15\n\ts_nop 7":"+v"(pA0),"+v"(pA1));MODT(pA0,pA1,0,true);
  START(pA0,pA1);
  _Pragma("unroll") for(int r=0;r<16;++r)pA1[r]=__builtin_amdgcn_exp2f(pA1[r]);
  WAIT_BAR(0);
  DMA_K(3,0);DMA_V(1,SLOTB);
  ROT();
  kload8(kf,kp0+sl_cur);
  WAIT_BAR(2);
  s16x4 vlo[8],vhi[8]; u32x4 pw0,pw1,pw2,pw3;
  #define PKW(P,B) cvtpk_s(P[B],P[B+1])
  #define PAF(k) __builtin_bit_cast(bf16x8,pw##k)
  #define VFR(i) (bf16x8){vlo[i][0],vlo[i][1],vlo[i][2],vlo[i][3],vhi[i][0],vhi[i][1],vhi[i][2],vhi[i][3]}
  #define PIN(x) asm volatile("":"+v"(x))
  #define MX3(a,b,c) __builtin_fmaxf(__builtin_fmaxf((a),(b)),(c))
  #define GAPA(MF,A0,A1,A2,A3,W0,W1,PW) do{ MF; sacc+=A0; sacc+=A1; sacc+=A2; sacc+=A3; PIN(sacc); W0; W1; PIN(PW); SBAR(); }while(0)
  #define EX(v) __builtin_amdgcn_exp2f(v)
  #define GAPB(MF,X,B) do{ MF; X[B]=EX(X[B]); X[B+1]=EX(X[B+1]); X[B+2]=EX(X[B+2]); X[B+3]=EX(X[B+3]); PIN(X); SBAR(); }while(0)
  #define VRD(i) do{ vlo[i]=vtr(vp_+(((i)>>2)*4096+((i)&3)*1024)); vhi[i]=vtr(vp_+(((i)>>2)*4096+((i)&3)*1024+512)); }while(0)
  #define KRD(G,j) do{ if(G){ kload2(kf,kp0+sl_next,j); SBAR(); } }while(0)
  #define STEP(C0,C1,P0,P1,t,GK,GV,GL,SL) do{ SBAR(); \
    const lds_cptr vp_=vp0+sl_prev; \
    VRD(0); SBAR(); float sacc=(P0[0]+P0[1]); \
    GAPA(C0=__builtin_amdgcn_mfma_f32_32x32x16_bf16(kf[0],qr[0],negm,0,0,0), P0[2],P0[3],P0[4],P0[5],     pw0[0]=PKW(P0,0), pw0[1]=PKW(P0,2), pw0); \
    VRD(4); SBAR(); GAPA(C1=__builtin_amdgcn_mfma_f32_32x32x16_bf16(kf[1],qr[0],negm,0,0,0), P0[6],P0[7],P0[8],P0[9],     pw0[2]=PKW(P0,4), pw0[3]=PKW(P0,6), pw0); \
    VRD(1); SBAR(); GAPA(C0=__builtin_amdgcn_mfma_f32_32x32x16_bf16(kf[2],qr[1],C0,0,0,0),   P0[10],P0[11],P0[12],P0[13], pw1[0]=PKW(P0,8), pw1[1]=PKW(P0,10), pw1); \
    VRD(5); SBAR(); GAPA(C1=__builtin_amdgcn_mfma_f32_32x32x16_bf16(kf[3],qr[1],C1,0,0,0),   P0[14],P0[15],P1[0],P1[1],   pw1[2]=PKW(P0,12),pw1[3]=PKW(P0,14), pw1); \
    VRD(2); SBAR(); GAPA(C0=__builtin_amdgcn_mfma_f32_32x32x16_bf16(kf[4],qr[2],C0,0,0,0),   P1[2],P1[3],P1[4],P1[5],     pw2[0]=PKW(P1,0), pw2[1]=PKW(P1,2), pw2); \
    VRD(6); SBAR(); GAPA(C1=__builtin_amdgcn_mfma_f32_32x32x16_bf16(kf[5],qr[2],C1,0,0,0),   P1[6],P1[7],P1[8],P1[9],     pw2[2]=PKW(P1,4), pw2[3]=PKW(P1,6), pw2); \
    VRD(3); SBAR(); GAPA(C0=__builtin_amdgcn_mfma_f32_32x32x16_bf16(kf[6],qr[3],C0,0,0,0),   P1[10],P1[11],P1[12],P1[13], pw3[0]=PKW(P1,8), pw3[1]=PKW(P1,10), pw3); \
    VRD(7); SBAR(); GAPA(C1=__builtin_amdgcn_mfma_f32_32x32x16_bf16(kf[7],qr[3],C1,0,0,0),   P1[14],P1[15],0.f,0.f,       pw3[2]=PKW(P1,12),pw3[3]=PKW(P1,14), pw3); \
    l_reg+=sacc; \
    if(GK){DMA_K((t)+3,sl_cur);} if(GV){DMA_V((t)+1,sl_next);} \
    MODT(C0,C1,t,SL); \
    { float a=MX3(C0[0],C0[1],C1[0]),b=MX3(C0[2],C0[3],C1[1]); a=MX3(a,C1[2],C1[3]); \
      _Pragma("unroll") for(int r=4;r<16;r+=4){a=MX3(a,C0[r],C0[r+1]);b=MX3(b,C0[r+2],C0[r+3]);a=MX3(a,C1[r],C1[r+1]);b=MX3(b,C1[r+2],C1[r+3]);} \
      float rm=__builtin_fmaxf(a,b); { auto rr=__builtin_amdgcn_permlane32_swap(__float_as_uint(rm),__float_as_uint(rm),false,false); rm=__builtin_fmaxf(__uint_as_float(rr[0]),__uint_as_float(rr[1])); } \
      resc=false; \
      if(__builtin_expect(__any(rm>(float)THRL),0)){ const float dl=__builtin_fmaxf(rm,0.f); mhat+=dl; \
        _Pragma("unroll") for(int r=0;r<16;++r){C0[r]-=dl;C1[r]-=dl;} \
        _Pragma("unroll") for(int r=0;r<16;++r)negm[r]=-mhat; asm volatile("":"+v"(negm)); \
        const float f=__builtin_amdgcn_exp2f(-dl); l_reg*=f; if(hi==0)wsf[r32]=f; resc=true; } } \
    SBAR(); \
    GAPB(o[0]=__builtin_amdgcn_mfma_f32_32x32x16_bf16(PAF(0),VFR(0),o[0],0,0,0), C0,0); \
    GAPB(o[1]=__builtin_amdgcn_mfma_f32_32x32x16_bf16(PAF(0),VFR(4),o[1],0,0,0), C0,4); \
    KRD(GL,0); GAPB(o[0]=__builtin_amdgcn_mfma_f32_32x32x16_bf16(PAF(1),VFR(1),o[0],0,0,0), C0,8); \
    KRD(GL,1); GAPB(o[1]=__builtin_amdgcn_mfma_f32_32x32x16_bf16(PAF(1),VFR(5),o[1],0,0,0), C0,12); \
    KRD(GL,2); GAPB(o[0]=__builtin_amdgcn_mfma_f32_32x32x16_bf16(PAF(2),VFR(2),o[0],0,0,0), C1,0); \
    KRD(GL,3); GAPB(o[1]=__builtin_amdgcn_mfma_f32_32x32x16_bf16(PAF(2),VFR(6),o[1],0,0,0), C1,4); \
    GAPB(o[0]=__builtin_amdgcn_mfma_f32_32x32x16_bf16(PAF(3),VFR(3),o[0],0,0,0), C1,8); \
    GAPB(o[1]=__builtin_amdgcn_mfma_f32_32x32x16_bf16(PAF(3),VFR(7),o[1],0,0,0), C1,12); \
    }while(0)
  int t=1;
  #define ENDW(tt) do{ if((tt)+3<NT){WAIT_BAR(2);} else if((tt)+2<NT){WAIT_BAR(1);} else {WAIT_BAR(0);} }while(0)
  for(;t+7<NT;t+=2){
    STEP(pB0,pB1,pA0,pA1,t,true,true,true,false);     WAIT_BAR(2); RESC(); ROT();
    STEP(pA0,pA1,pB0,pB1,t+1,true,true,true,false);   WAIT_BAR(2); RESC(); ROT();
  }
  for(;t+1<NT;t+=2){
    STEP(pB0,pB1,pA0,pA1,t,(t+3<NT),(t+1<NT),(t+1<NT),true);       ENDW(t);   RESC(); ROT();
    STEP(pA0,pA1,pB0,pB1,t+1,(t+4<NT),(t+2<NT),(t+2<NT),true);     ENDW(t+1); RESC(); ROT();
  }
  STEP(pB0,pB1,pA0,pA1,NT-1,false,false,false,true); RESC();
  { float sacc=pB0[0]+pB0[1]; _Pragma("unroll") for(int r=2;r<16;++r)sacc+=pB0[r]; _Pragma("unroll") for(int r=0;r<16;++r)sacc+=pB1[r]; l_reg+=sacc;
    pw0=(u32x4){PKW(pB0,0),PKW(pB0,2),PKW(pB0,4),PKW(pB0,6)};pw1=(u32x4){PKW(pB0,8),PKW(pB0,10),PKW(pB0,12),PKW(pB0,14)};pw2=(u32x4){PKW(pB1,0),PKW(pB1,2),PKW(pB1,4),PKW(pB1,6)};pw3=(u32x4){PKW(pB1,8),PKW(pB1,10),PKW(pB1,12),PKW(pB1,14)};
    SBAR(); pv(o,vb0+sl_cur,PAF(0),PAF(1),PAF(2),PAF(3)); }
  #undef PKW
  #undef PAF
  #undef VFR
  #undef PIN
  #undef MX3
  #undef GAPA
  #undef GAPB
  #undef EX
  #undef VRD
  #undef KRD
  #undef STEP
  #undef ENDW
  {auto rr=__builtin_amdgcn_permlane32_swap(__float_as_uint(l_reg),__float_as_uint(l_reg),false,false);l_reg=__uint_as_float(rr[0])+__uint_as_float(rr[1]);}
  if(hi==0)wsf[32+r32]=l_reg;asm volatile("s_waitcnt lgkmcnt(0)":::"memory");
  float rli[16];
  #pragma unroll
  for(int r=0;r<16;++r)rli[r]=__builtin_amdgcn_rcpf(wsf[32+crow(r,hi)]);
  bf16*Ow=O+(rowbase+q0+wid*QBLK)*DM+co;
  { bf16*stg=(bf16*)(shm+LDS_OST)+wid*2048;
    #pragma unroll
    for(int r=0;r<16;++r){const int orow=crow(r,hi);
      #pragma unroll
      for(int d0=0;d0<2;++d0)stg[orow*64+d0*32+r32]=__float2bfloat16(o[d0][r]*rli[r]);}
    asm volatile("s_waitcnt lgkmcnt(0)":::"memory");
    #pragma unroll
    for(int i=0;i<4;++i){const int row=i*8+(lane>>3),ch=lane&7; const u32x4 v=*(const u32x4*)(stg+row*64+ch*8); ATTN_STORE16(Ow+(long)row*DM+ch*8,v);} }
  asm volatile("s_waitcnt lgkmcnt(0)\n\ts_barrier":::"memory");
  #undef DMA_K
  #undef DMA_V
  #undef MODT
  #undef START
  #undef RESC
  #undef ROT
}
constexpr int ATTN_LDS_BYTES=LDS_BYTES;
#undef SBAR
#undef WAIT_BAR
}
#define GAS __attribute__((address_space(1)))
#define LAS __attribute__((address_space(3)))
typedef unsigned short bf16;
typedef unsigned v4u __attribute__((ext_vector_type(4)));
typedef float f32x4 __attribute__((ext_vector_type(4)));
typedef short bf16x8 __attribute__((ext_vector_type(8)));
typedef GAS unsigned gu32;
typedef GAS unsigned long long gu64;
#define RLX_AGENT __ATOMIC_RELAXED, __HIP_MEMORY_SCOPE_AGENT
#define LDS_WAIT() asm volatile("s_waitcnt lgkmcnt(0)" ::: "memory")
#define VM_WAIT() asm volatile("s_waitcnt vmcnt(0)" ::: "memory")
__device__ __forceinline__ unsigned long long rt() { return __builtin_amdgcn_s_memrealtime(); }
__device__ __forceinline__ unsigned f2bf(float f) { unsigned u = __builtin_bit_cast(unsigned, f); return (u + 0x7fffu + ((u >> 16) & 1u)) >> 16; }
__device__ __forceinline__ unsigned pk2(float lo, float hi) { return f2bf(lo) | (f2bf(hi) << 16); }

#define XB_TMO      128
#define XB_XCNT(j)  (256  + 64 * (j))
#define XB_XSUB(j)  (1280 + 64 * (j))
#define XB_XGEN(j)  (2304 + 64 * (j))
#define XB_TOP      3328
#define XB_TOPGEN   3392
#define XCD_BAR_WORDS 3456
#define XB_SPIN_CAP (1u << 18)

__device__ __forceinline__ unsigned xb_ld(unsigned* p)              { return __hip_atomic_load(p, __ATOMIC_RELAXED, __HIP_MEMORY_SCOPE_AGENT); }
__device__ __forceinline__ unsigned xb_add(unsigned* p, unsigned v) { return __hip_atomic_fetch_add(p, v, __ATOMIC_RELAXED, __HIP_MEMORY_SCOPE_AGENT); }
__device__ __forceinline__ unsigned xb_xcc_id() { return (unsigned)__builtin_amdgcn_s_getreg((3 << 11) | 20) & 0xFu; }
#define XB_SPIN(cond, bar) do { unsigned _sp = 0; while (cond) { __builtin_amdgcn_s_sleep(1); \
    if ((++_sp & 255u) == 0u) { if (xb_ld(&(bar)[XB_TMO])) break; if (_sp > XB_SPIN_CAP) { atomicAdd(&(bar)[XB_TMO], 1u); break; } } } } while (0)

struct XcdBarrier {
    unsigned* bar; unsigned x;
    volatile LAS unsigned* st;
};

__device__ __forceinline__ XcdBarrier xcd_barrier_post(unsigned* bar, volatile LAS unsigned* st) {
    XcdBarrier b; b.bar = bar; b.x = xb_xcc_id(); b.st = st;
    if (threadIdx.x == 0) (void)xb_add(&bar[XB_XCNT(b.x)], 1u);
    return b;
}
__device__ __forceinline__ void xcd_barrier_complete(unsigned* bar, unsigned x, unsigned& nloc, unsigned& nx) {
    const unsigned G = gridDim.x * gridDim.y * gridDim.z;
    unsigned sum, cnt, mine, sp = 0u;
    for (;;) {
        sum = 0u; cnt = 0u; mine = 0u;
#pragma unroll
        for (unsigned j = 0; j < 16; ++j) { const unsigned c = xb_ld(&bar[XB_XCNT(j)]); sum += c; cnt += (c > 0u) ? 1u : 0u; mine = (j == x) ? c : mine; }
        if (sum == G) break;
        __builtin_amdgcn_s_sleep(1);
        if ((++sp & 255u) == 0u) { if (xb_ld(&bar[XB_TMO])) break; if (sp > XB_SPIN_CAP) { atomicAdd(&bar[XB_TMO], 1u); break; } }
    }
    nloc = mine > 0u ? mine : 1u; nx = cnt > 0u ? cnt : 1u;
}

__device__ __forceinline__ void xcd_barrier(const XcdBarrier& b) {
    asm volatile("s_waitcnt vmcnt(0)" ::: "memory");
    __syncthreads();
    if (threadIdx.x == 0) {
        unsigned* bar = b.bar;
        __builtin_amdgcn_s_waitcnt(0);
        unsigned nloc = b.st[0], nx = b.st[1];
        if (nloc == 0u) { xcd_barrier_complete(bar, b.x, nloc, nx); b.st[0] = nloc; b.st[1] = nx; }
        const unsigned old = xb_add(&bar[XB_XSUB(b.x)], 1u);
        const unsigned gen = old / nloc;
        if (old + 1u == (gen + 1u) * nloc) {
            __builtin_amdgcn_fence(__ATOMIC_RELEASE, "agent");
            asm volatile("s_waitcnt vmcnt(0)" ::: "memory");
            const unsigned og = xb_add(&bar[XB_TOP], 1u);
            const unsigned tg = og / nx;
            if (og + 1u == (tg + 1u) * nx) xb_add(&bar[XB_TOPGEN], 1u);
            else XB_SPIN(xb_ld(&bar[XB_TOPGEN]) == tg, bar);
            __builtin_amdgcn_fence(__ATOMIC_ACQUIRE, "agent");
            xb_add(&bar[XB_XGEN(b.x)], 1u);
            asm volatile("s_waitcnt vmcnt(0)" ::: "memory");
        } else {
            XB_SPIN(xb_ld(&bar[XB_XGEN(b.x)]) == gen, bar);
            __builtin_amdgcn_fence(__ATOMIC_ACQUIRE, "agent");
            asm volatile("s_waitcnt vmcnt(0)" ::: "memory");
        }
    }
    __syncthreads();
}

constexpr int NWAVES = 8;
#ifndef MK_PER_PHASE
#define MK_PER_PHASE 0
#endif
constexpr int N_PHASES = 16;

constexpr size_t MiB = 1u << 20;
constexpr size_t WS_CTL = 0, CTL_ZERO_BYTES = 1 * MiB;
constexpr size_t WS_GV = 1 * MiB + 512 * 1024;
constexpr size_t WS_HM = 2 * MiB;
constexpr size_t WS_TAB = 2 * MiB + 256 * 1024;
constexpr size_t WS_LF = 3 * MiB;
constexpr size_t WS_DK = 6 * MiB;
constexpr size_t WS_LIST = 9 * MiB;
constexpr int LCAP = NSLOT;
constexpr size_t WS_WQKV0 = 18 * MiB, WS_WO0 = 24 * MiB, WS_WQKV1 = 26 * MiB, WS_WO1 = 32 * MiB, WS_WGU = 34 * MiB, WS_WD = 98 * MiB;
constexpr size_t WS_XH = 130 * MiB;
constexpr size_t WS_Q = 195 * MiB;
constexpr size_t WS_K = 260 * MiB, WS_V = 325 * MiB;
constexpr size_t WS_O0 = 390 * MiB;
constexpr size_t WS_END = 455 * MiB;
static_assert(WS_LIST + (size_t)NEXP * LCAP * 4 <= WS_WQKV0 && WS_DK + (size_t)NBATCH * 16 * KROWS * 4 <= WS_LIST && WS_LF + (size_t)NRP * 16 * 4 <= WS_DK, "small arrays");
static_assert(WS_XH + (size_t)NRP * DM * 2 <= WS_Q && WS_Q + (size_t)NRP * DM * 2 <= WS_K && WS_K + (size_t)NBATCH * KROWS * DM * 2 <= WS_V && WS_V + (size_t)NBATCH * KROWS * DM * 2 <= WS_O0 && WS_O0 + (size_t)NRP * DM * 2 <= WS_END, "activations");
static_assert(WS_K + (size_t)NSLOT * DM * 2 <= WS_O0 && WS_O0 + (size_t)NSLOT * DEXP * 2 <= WS_END, "MoE overlays");
constexpr int CW_TMO = 0, CW_CODE = 1;
constexpr int CW_BAR = 4096;
constexpr int CW_QM = 131072, CW_KM = 147456, CW_QCTR = 148480;
constexpr int CW_CNT = 65536;
constexpr int RING_OFF = 0, RING_BYTES = 131072;
constexpr int ROWTAB_OFF = RING_BYTES, ROWTAB_UNITS = 12;
constexpr int MOEPRE_OFF = ROWTAB_OFF + ROWTAB_UNITS * 1024;
constexpr int MISC_OFF = MOEPRE_OFF + 512;
constexpr int LDS_BYTES = 147456;
static_assert(MISC_OFF + 128 <= LDS_BYTES && attn_body::ATTN_LDS_BYTES <= RING_BYTES, "LDS map");

struct Params {
    const float *x, *meta, *rel_bias, *w_qkv, *lam, *subln, *w_o, *fox_w_in, *fox_b_f, *fox_w_o, *ln_mix_g, *ln_mix_b, *ln_ffn_g, *ln_ffn_b, *rg_w, *rg_b, *re_w, *re_b, *w_gate, *w_up, *w_down;
    float* out; unsigned char* ws; int ph_lo, ph_hi, li, pad;
};
struct Ctx { int tid, lane, wave, vcu, G; LAS unsigned char* lds; };
__device__ __forceinline__ Ctx fresh(const Ctx& C) { Ctx r = C; int t = threadIdx.x; asm volatile("" : "+v"(t)); r.tid = t; r.lane = t & 63; r.wave = __builtin_amdgcn_readfirstlane(t >> 6); return r; }

__device__ __forceinline__ float wave_sum(float v) {
#pragma unroll
    for (int o = 1; o < 64; o <<= 1) v += __shfl_xor(v, o);
    return v;
}
__device__ __forceinline__ float bf2f(unsigned short h) { return __uint_as_float((unsigned)h << 16); }
__device__ __forceinline__ float bflo(unsigned w) { return __uint_as_float(w << 16); }
__device__ __forceinline__ float bfhi(unsigned w) { return __uint_as_float(w & 0xffff0000u); }
__device__ __forceinline__ float* h32_row(const Params& p, int r) { return r < NREAL ? p.out + (size_t)r * DM : (float*)(p.ws + WS_HM) + (size_t)(r - NREAL) * DM; }
__device__ __forceinline__ int meta_slot(int j) { return j; }

__device__ __forceinline__ void tr_item(const float* W, int ldw, int k0, int n0, bf16* WT, int ldt, int drow0, LAS float* scr, int lane) {
#pragma unroll 8
    for (int i = 0; i < 32; ++i) { const int kk = 2 * i + (lane >> 5); scr[kk * 33 + (lane & 31)] = W[(size_t)(k0 + kk) * ldw + n0 + (lane & 31)]; }
    LDS_WAIT(); asm volatile("" ::: "memory");
    const int c = lane & 7;
#pragma unroll
    for (int j = 0; j < 4; ++j) { const int n = (lane >> 3) + 8 * j; const LAS float* s = scr + (8 * c) * 33 + n;
        v4u o; o.x = pk2(s[0 * 33], s[1 * 33]); o.y = pk2(s[2 * 33], s[3 * 33]); o.z = pk2(s[4 * 33], s[5 * 33]); o.w = pk2(s[6 * 33], s[7 * 33]);
        *(GAS v4u*)(WT + (size_t)(drow0 + n) * ldt + k0 + 8 * c) = o; }
    LDS_WAIT(); asm volatile("" ::: "memory");
}
__device__ __forceinline__ void convert_experts(const Params& p, const Ctx& C, int layer, int first_item, int gw, int NGW) {
    LAS float* scr = (LAS float*)(C.lds + RING_OFF + C.wave * 16384);
    bf16* Wgu = (bf16*)(p.ws + WS_WGU); bf16* Wd = (bf16*)(p.ws + WS_WD);
    constexpr int PER_E = 768, NIT = NEXP * PER_E;
    for (int it = gw - first_item; it < NIT; it += NGW) { if (it < 0) continue;
        const int e = it / PER_E; int r = it % PER_E; const size_t eo = (size_t)(layer * NEXP + e);
        if (r < 512) { const bool up = r >= 256; r &= 255; const int kb = r >> 4, nb = r & 15, n0 = 32 * nb;
            tr_item((up ? p.w_up : p.w_gate) + eo * DM * DEXP, DEXP, 64 * kb, n0, Wgu + (size_t)e * DM * DM, DM, (n0 >> 7) * 256 + (n0 & 127) + (up ? 128 : 0), scr, C.lane); }
        else { r -= 512; const int kb = r >> 5, nb = r & 31;
            tr_item(p.w_down + eo * DEXP * DM, DM, 64 * kb, 32 * nb, Wd + (size_t)e * DM * DEXP, DEXP, 32 * nb, scr, C.lane); } }
}
__device__ __forceinline__ void p0_prologue(const Params& p, const Ctx& C) {
    LAS float* scr = (LAS float*)(C.lds + RING_OFF + C.wave * 16384);
    const int gw = C.vcu * NWAVES + C.wave, NGW = C.G * NWAVES;
    for (int it = gw; it < 4096; it += NGW) { int r = it;
        if (r < 1536) { tr_item(p.w_qkv, 3072, 64 * (r / 96), 32 * (r % 96), (bf16*)(p.ws + WS_WQKV0), DM, 32 * (r % 96), scr, C.lane); continue; } r -= 1536;
        if (r < 512) { tr_item(p.w_o, DM, 64 * (r >> 5), 32 * (r & 31), (bf16*)(p.ws + WS_WO0), DM, 32 * (r & 31), scr, C.lane); continue; } r -= 512;
        if (r < 1536) { tr_item(p.fox_w_in, 3088, 64 * (r / 96), 32 * (r % 96), (bf16*)(p.ws + WS_WQKV1), DM, 32 * (r % 96), scr, C.lane); continue; } r -= 1536;
        tr_item(p.fox_w_o, DM, 64 * (r >> 5), 32 * (r & 31), (bf16*)(p.ws + WS_WO1), DM, 32 * (r & 31), scr, C.lane); }
    convert_experts(p, C, 0, 0, gw, NGW);
    bf16* XH = (bf16*)(p.ws + WS_XH);
    for (int m = gw; m < NRP; m += NGW) {
        GAS unsigned long long* o8 = (GAS unsigned long long*)(XH + (size_t)m * DM) + C.lane;
        if (m < NR) { const GAS f32x4* xr = (const GAS f32x4*)(m < NREAL ? p.x + (size_t)m * DM : p.meta + (size_t)(m - NREAL) * DM) + C.lane;
#pragma unroll
            for (int j = 0; j < 4; ++j) { const f32x4 v = xr[64 * j]; o8[64 * j] = (unsigned long long)pk2(v.x, v.y) | ((unsigned long long)pk2(v.z, v.w) << 32); } }
        else {
#pragma unroll
            for (int j = 0; j < 4; ++j) o8[64 * j] = 0ull; } }
    { const int gt = C.vcu * (NWAVES * 64) + C.tid;
      if (gt < 16 * 128) { const int m = gt >> 7, d = gt & 127; int bk = d;
          if (d >= 16) { bk = 16 + (d >= 19) + (d >= 21) + (d >= 24) + (d >= 27) + (d >= 31) + (d >= 35) + (d >= 40) + (d >= 46) + (d >= 52) + (d >= 59) + (d >= 67) + (d >= 77) + (d >= 87) + (d >= 99) + (d >= 113); }
          ((float*)(p.ws + WS_TAB))[gt] = (p.rel_bias[bk * 16 + m] - p.rel_bias[31 * 16 + m]) * LOG2E; } }
}

__device__ __forceinline__ float diff_lambda_full(const Params& p, int lane) {
    const float a = p.lam[lane] * p.lam[64 + lane], b = p.lam[128 + lane] * p.lam[192 + lane];
    return __expf(wave_sum(a)) - __expf(wave_sum(b)) + LAMBDA_INIT0;
}
__device__ __forceinline__ void combine_phase(const Params& p, const Ctx& C) {
    const int gw = C.vcu * NWAVES + C.wave, NGW = C.G * NWAVES, lane = C.lane;
    const float lam = diff_lambda_full(p, lane);
    const bf16* O0 = (const bf16*)(p.ws + WS_O0); const bf16* O1 = (const bf16*)(p.ws + WS_XH); bf16* OA = (bf16*)(p.ws + WS_Q);
    float sw[8];
#pragma unroll
    for (int c = 0; c < 8; ++c) sw[c] = p.subln[((8 * lane) & 127) + c] * (1.f - LAMBDA_INIT0);
    for (int r = gw; r < NREAL; r += NGW) {
#pragma unroll
        for (int j = 0; j < 2; ++j) { const size_t off = (size_t)r * DM + 8 * lane + 512 * j;
            const v4u a = *(const GAS v4u*)(O0 + off), b = *(const GAS v4u*)(O1 + off);
            float d[8]; const unsigned aw[4] = {a.x, a.y, a.z, a.w}, bw[4] = {b.x, b.y, b.z, b.w}; float ss = 0.f;
#pragma unroll
            for (int c = 0; c < 4; ++c) { d[2 * c] = bflo(aw[c]) - lam * bflo(bw[c]); d[2 * c + 1] = bfhi(aw[c]) - lam * bfhi(bw[c]); ss += d[2 * c] * d[2 * c] + d[2 * c + 1] * d[2 * c + 1]; }
            ss += __shfl_xor(ss, 1); ss += __shfl_xor(ss, 2); ss += __shfl_xor(ss, 4); ss += __shfl_xor(ss, 8);
            const float rs = 1.f / sqrtf(ss * (1.f / 128.f) + LN_EPS);
            v4u o; o.x = pk2(d[0] * rs * sw[0], d[1] * rs * sw[1]); o.y = pk2(d[2] * rs * sw[2], d[3] * rs * sw[3]); o.z = pk2(d[4] * rs * sw[4], d[5] * rs * sw[5]); o.w = pk2(d[6] * rs * sw[6], d[7] * rs * sw[7]);
            *(GAS v4u*)(OA + off) = o; } }
    if (gw < 128) { const int h = gw >> 4, j = gw & 15, kj = lane & 15, s = (lane >> 4) & 1, m = 2 * h + s;
        const bf16* Q = (const bf16*)(p.ws + WS_Q); const bf16* K = (const bf16*)(p.ws + WS_K); const bf16* V = (const bf16*)(p.ws + WS_V);
        const bf16* qp = Q + (size_t)(NREAL + j) * DM + m * 64; const bf16* kp = K + (size_t)meta_slot(kj) * DM + m * 64;
        float dot = 0.f;
#pragma unroll
        for (int c = 0; c < 8; ++c) { const v4u qa = *(const GAS v4u*)(qp + 8 * c), ka = *(const GAS v4u*)(kp + 8 * c); const unsigned qw[4] = {qa.x, qa.y, qa.z, qa.w}, kw[4] = {ka.x, ka.y, ka.z, ka.w};
#pragma unroll
            for (int e = 0; e < 4; ++e) dot += bflo(qw[e]) * bflo(kw[e]) + bfhi(qw[e]) * bfhi(kw[e]); }
        float sc = (kj <= j) ? dot + p.rel_bias[(j - kj) * 16 + m] * LOG2E : -INFINITY;
        float mx = sc; mx = fmaxf(mx, __shfl_xor(mx, 1)); mx = fmaxf(mx, __shfl_xor(mx, 2)); mx = fmaxf(mx, __shfl_xor(mx, 4)); mx = fmaxf(mx, __shfl_xor(mx, 8));
        float pe = __builtin_amdgcn_exp2f(sc - mx); float l = pe; l += __shfl_xor(l, 1); l += __shfl_xor(l, 2); l += __shfl_xor(l, 4); l += __shfl_xor(l, 8);
        pe /= l;
        const float a = pe - lam * __shfl_xor(pe, 16);
        float o0 = 0.f, o1 = 0.f;
        for (int k2 = 0; k2 <= j; ++k2) { const float ak = __shfl(a, k2); const unsigned vw = *(const GAS unsigned*)(V + (size_t)meta_slot(k2) * DM + h * 128 + 2 * lane); o0 += ak * bflo(vw); o1 += ak * bfhi(vw); }
        const float ss = wave_sum(o0 * o0 + o1 * o1); const float rs = 1.f / sqrtf(ss * (1.f / 128.f) + LN_EPS);
        const float w0 = p.subln[2 * lane] * (1.f - LAMBDA_INIT0), w1 = p.subln[2 * lane + 1] * (1.f - LAMBDA_INIT0);
        *(GAS unsigned*)(OA + (size_t)(NREAL + j) * DM + h * 128 + 2 * lane) = pk2(o0 * rs * w0, o1 * rs * w1); }
}
__device__ __forceinline__ void fox_meta_attn(const Params& p, const Ctx& C) {
    const int gw = C.vcu * NWAVES + C.wave, lane = C.lane;
    if (gw < 256) { const int h = gw >> 4, j = gw & 15, kj = lane & 15;
        bf16* Q = (bf16*)(p.ws + WS_Q); const bf16* K = (const bf16*)(p.ws + WS_K); const bf16* V = (const bf16*)(p.ws + WS_V); const float* DK = (const float*)(p.ws + WS_DK) + (size_t)h * KROWS;
        const bf16* qp = Q + (size_t)(NREAL + j) * DM + h * 64; const bf16* kp = K + (size_t)meta_slot(kj) * DM + h * 64;
        float dot = 0.f;
#pragma unroll
        for (int c = 0; c < 8; ++c) { const v4u qa = *(const GAS v4u*)(qp + 8 * c), ka = *(const GAS v4u*)(kp + 8 * c); const unsigned qw[4] = {qa.x, qa.y, qa.z, qa.w}, kw[4] = {ka.x, ka.y, ka.z, ka.w};
#pragma unroll
            for (int e = 0; e < 4; ++e) dot += bflo(qw[e]) * bflo(kw[e]) + bfhi(qw[e]) * bfhi(kw[e]); }
        float sc = (kj <= j) ? dot + DK[meta_slot(kj)] - DK[meta_slot(j)] : -INFINITY;
        float mx = sc; mx = fmaxf(mx, __shfl_xor(mx, 1)); mx = fmaxf(mx, __shfl_xor(mx, 2)); mx = fmaxf(mx, __shfl_xor(mx, 4)); mx = fmaxf(mx, __shfl_xor(mx, 8));
        float pe = __builtin_amdgcn_exp2f(sc - mx); float l = pe; l += __shfl_xor(l, 1); l += __shfl_xor(l, 2); l += __shfl_xor(l, 4); l += __shfl_xor(l, 8);
        pe /= l;
        float o = 0.f;
        for (int k2 = 0; k2 <= j; ++k2) { const float ak = __shfl(pe, k2); o += ak * bf2f(V[(size_t)meta_slot(k2) * DM + h * 64 + lane]); }
        ((bf16*)(p.ws + WS_O0))[(size_t)(NREAL + j) * DM + h * 64 + lane] = (bf16)f2bf(o); }
}

typedef float f32x4m __attribute__((ext_vector_type(4)));
template <int KIND> __device__ __forceinline__ void ln_phase(const Params& p, const Ctx& C, int layer) {
    constexpr int NCB = (KIND == 0) ? 3 : (KIND == 1 ? 1 : 0), NC = 16 * (NCB ? NCB : 1);
    constexpr int AT_PITCH = 1028;
    const int tid = C.tid, lane = C.lane, wave = C.wave;
    LAS float* At = (LAS float*)(C.lds + RING_OFF);
    LAS float* part = (LAS float*)(C.lds + RING_OFF + 65792);
    LAS float* logit = (LAS float*)(C.lds + RING_OFF + 90368);
    LAS int* sl_e = (LAS int*)(C.lds + RING_OFF + 93440);
    LAS int* cnt_l = (LAS int*)(C.lds + RING_OFF + 94720);
    const float* gsrc = (KIND == 0 ? p.ln_mix_g : p.ln_ffn_g) + layer * DM; const float* bsrc = (KIND == 0 ? p.ln_mix_b : p.ln_ffn_b) + layer * DM;
    f32x4 gv[4], bv[4];
#pragma unroll
    for (int j = 0; j < 4; ++j) { gv[j] = *(const GAS f32x4*)(gsrc + 4 * lane + 256 * j); bv[j] = *(const GAS f32x4*)(bsrc + 4 * lane + 256 * j); }
    float Bf[NCB ? NCB : 1][8][4];
    if constexpr (NCB > 0) { const int kq = lane >> 4, col = lane & 15;
#pragma unroll
        for (int cb = 0; cb < NCB; ++cb)
#pragma unroll
            for (int g = 0; g < 8; ++g)
#pragma unroll
                for (int c = 0; c < 4; ++c) { const int k = 128 * wave + 16 * g + 4 * kq + c, cc = cb * 16 + col; float w;
                    if (KIND == 0) w = cc < 4 ? p.rg_w[((size_t)layer * DM + k) * 4 + cc] : (cc < 36 ? p.re_w[((size_t)layer * DM + k) * 32 + (cc - 4)] : 0.f);
                    else w = p.fox_w_in[(size_t)k * 3088 + 3072 + cc];
                    Bf[cb][g][c] = w; } }
    if (KIND == 0) { if (tid < 96) cnt_l[tid] = 0; }
    bf16* XH = (bf16*)(p.ws + WS_XH); const bf16* Y = (const bf16*)(p.ws + WS_K);
    constexpr int NTILES = NR / 16;
    int it = 0;
    for (int tile = C.vcu; tile < NTILES; tile += C.G, ++it) {
#pragma unroll 1
        for (int rr = 0; rr < 2; ++rr) { const int rl = wave * 2 + rr, row = tile * 16 + rl;
            float* hrow = h32_row(p, row);
            f32x4 v[4];
#pragma unroll
            for (int j = 0; j < 4; ++j) v[j] = *(const GAS f32x4*)(hrow + 4 * lane + 256 * j);
            if (KIND != 0) {
#pragma unroll
                for (int j = 0; j < 4; ++j) { const unsigned long long y0 = *(const GAS unsigned long long*)(Y + (size_t)(2 * row) * DM + 4 * lane + 256 * j), y1 = *(const GAS unsigned long long*)(Y + (size_t)(2 * row + 1) * DM + 4 * lane + 256 * j);
                    const unsigned a0 = (unsigned)y0, a1 = (unsigned)(y0 >> 32), b0 = (unsigned)y1, b1 = (unsigned)(y1 >> 32);
                    v[j].x = v[j].x * ALPHA + (bflo(a0) + bflo(b0)); v[j].y = v[j].y * ALPHA + (bfhi(a0) + bfhi(b0)); v[j].z = v[j].z * ALPHA + (bflo(a1) + bflo(b1)); v[j].w = v[j].w * ALPHA + (bfhi(a1) + bfhi(b1)); } }
            float s = 0.f;
#pragma unroll
            for (int j = 0; j < 4; ++j) s += (v[j].x + v[j].y) + (v[j].z + v[j].w);
            const float mean = wave_sum(s) * (1.f / DM); float s2 = 0.f;
#pragma unroll
            for (int j = 0; j < 4; ++j) { v[j] = v[j] - mean; s2 += (v[j].x * v[j].x + v[j].y * v[j].y) + (v[j].z * v[j].z + v[j].w * v[j].w); }
            const float rstd = 1.f / sqrtf(wave_sum(s2) * (1.f / DM) + LN_EPS);
#pragma unroll
            for (int j = 0; j < 4; ++j) v[j] = v[j] * rstd * gv[j] + bv[j];
            if (KIND == 2) { if (row < NREAL) {
#pragma unroll
                for (int j = 0; j < 4; ++j) *(GAS f32x4*)(hrow + 4 * lane + 256 * j) = v[j]; } }
            else {
#pragma unroll
                for (int j = 0; j < 4; ++j) { *(GAS f32x4*)(hrow + 4 * lane + 256 * j) = v[j];
                    *((GAS unsigned long long*)(XH + (size_t)row * DM) + lane + 64 * j) = (unsigned long long)pk2(v[j].x, v[j].y) | ((unsigned long long)pk2(v[j].z, v[j].w) << 32);
                    *(LAS f32x4*)(At + rl * AT_PITCH + 4 * lane + 256 * j) = v[j]; } } }
        if constexpr (NCB > 0) {
            __syncthreads();
            f32x4m acc[NCB];
#pragma unroll
            for (int cb = 0; cb < NCB; ++cb) acc[cb] = (f32x4m){0.f, 0.f, 0.f, 0.f};
#pragma unroll
            for (int g = 0; g < 8; ++g) { const f32x4 a4 = *(const LAS f32x4*)(At + (lane & 15) * AT_PITCH + 128 * wave + 16 * g + 4 * (lane >> 4));
#pragma unroll
                for (int c = 0; c < 4; ++c)
#pragma unroll
                    for (int cb = 0; cb < NCB; ++cb) acc[cb] = __builtin_amdgcn_mfma_f32_16x16x4f32(a4[c], Bf[cb][g][c], acc[cb], 0, 0, 0); }
#pragma unroll
            for (int cb = 0; cb < NCB; ++cb)
#pragma unroll
                for (int r = 0; r < 4; ++r) part[(wave * 16 + 4 * (lane >> 4) + r) * 48 + cb * 16 + (lane & 15)] = acc[cb][r];
            __syncthreads();
            for (int idx = tid; idx < 16 * NC; idx += NWAVES * 64) { const int rw = idx / NC, cl = idx % NC; float sacc = 0.f;
#pragma unroll
                for (int w = 0; w < 8; ++w) sacc += part[(w * 16 + rw) * 48 + cl];
                logit[rw * 48 + cl] = sacc; }
            __syncthreads();
            if (KIND == 0) { if (tid < 16) { const int row = tile * 16 + tid; const LAS float* lg = logit + tid * 48;
                float gl[4]; int gs = 0;
#pragma unroll
                for (int i = 0; i < 4; ++i) gl[i] = lg[i] + p.rg_b[layer * 4 + i];
#pragma unroll
                for (int i = 1; i < 4; ++i) if (gl[i] > gl[gs]) gs = i;
                float den = 0.f;
#pragma unroll
                for (int i = 0; i < 4; ++i) den += __expf(gl[i] - gl[gs]);
                const float pg = 1.f / den;
                float el[8];
#pragma unroll
                for (int i = 0; i < 8; ++i) el[i] = lg[4 + gs * 8 + i] + p.re_b[layer * 32 + gs * 8 + i];
                int i0 = 0;
#pragma unroll
                for (int i = 1; i < 8; ++i) if (el[i] > el[i0]) i0 = i;
                int i1 = (i0 == 0) ? 1 : 0;
#pragma unroll
                for (int i = 0; i < 8; ++i) if (i != i0 && el[i] > el[i1]) i1 = i;
                const float ex = __expf(el[i1] - el[i0]); const float w0 = 1.f / (1.f + ex), w1 = ex * w0;
                float* GVp = (float*)(p.ws + WS_GV); GVp[2 * row] = pg * w0; GVp[2 * row + 1] = pg * w1;
                sl_e[it * 32 + 2 * tid] = gs * 8 + i0; sl_e[it * 32 + 2 * tid + 1] = gs * 8 + i1; } }
            else { if (tid < 256) { const int rw = tid >> 4, hh = tid & 15; const float vv = logit[rw * 48 + hh] + p.fox_b_f[hh];
                ((float*)(p.ws + WS_LF))[(size_t)(tile * 16 + rw) * 16 + hh] = fminf(vv, 0.f) - log1pf(__expf(-fabsf(vv))); } }
        }
    }
    if (KIND == 0) {
        gu32* CNT = (gu32*)(p.ws + WS_CTL) + CW_CNT + layer * 2048; int* LIST = (int*)(p.ws + WS_LIST);
        __syncthreads();
        const int nloc = it * 32;
        for (int s = tid; s < nloc; s += NWAVES * 64) atomicAdd((int*)&cnt_l[sl_e[s]], 1);
        __syncthreads();
        if (tid < 32) { const int n = cnt_l[tid]; cnt_l[32 + tid] = n > 0 ? (int)__hip_atomic_fetch_add(CNT + 64 * tid, (unsigned)n, RLX_AGENT) : 0; cnt_l[64 + tid] = 0; }
        __syncthreads();
        for (int s = tid; s < nloc; s += NWAVES * 64) { const int e = sl_e[s]; const int pos = cnt_l[32 + e] + atomicAdd((int*)&cnt_l[64 + e], 1);
            const int tl = C.vcu + (s >> 5) * C.G; LIST[(size_t)e * LCAP + pos] = 2 * (tl * 16 + ((s & 31) >> 1)) + (s & 1); }
    }
    __syncthreads();
}

__device__ __forceinline__ void cumsum_job(const Params& p, const Ctx& C) {
    if (C.vcu >= 64) return;
    const int b = C.vcu >> 4, h = C.vcu & 15, tid = C.tid, lane = C.lane, wave = C.wave;
    const float* LF = (const float*)(p.ws + WS_LF); float* DK = (float*)(p.ws + WS_DK) + (size_t)(b * 16 + h) * KROWS;
    LAS float* wt = (LAS float*)(C.lds + RING_OFF);
    float cm = 0.f, mine = 0.f; const int myj = (tid < NMETA) ? tid : -1;
    for (int i = 0; i < NMETA; ++i) { cm += LF[(size_t)(NREAL + i) * 16 + h]; if (i == myj) mine = cm; }
    if (tid < KPRE) DK[tid] = (myj >= 0) ? -mine * LOG2E : 0.f;
    if (tid < 64) DK[KPRE + SEQ + tid] = 0.f;
    const float* lp = LF + (size_t)(b * SEQ + tid * 16) * 16 + h;
    float run = 0.f;
#pragma unroll 1
    for (int i = 0; i < 16; ++i) run += lp[i * 16];
    float inc = run;
#pragma unroll
    for (int o = 1; o < 64; o <<= 1) { const float t = __shfl_up(inc, o); if (lane >= o) inc += t; }
    if (lane == 63) wt[wave] = inc;
    __syncthreads();
    float base = cm;
    for (int w = 0; w < wave; ++w) base += wt[w];
    base += inc - run;
#pragma unroll 1
    for (int i = 0; i < 16; ++i) { base += lp[i * 16]; DK[KPRE + tid * 16 + i] = -base * LOG2E; }
    __syncthreads();
}

struct MoeOrder {
    int G, c, UT; const LAS int* pre; const char* A; const char* W; size_t wexp, tsB;
    __device__ __forceinline__ bool next(int i, pg8::Unit& u) const {
        const int g = i * G + c; if (g >= UT || i >= ROWTAB_UNITS) return false;
        const int rt = g >> 2; int e = 0; while (pre[e + 1] <= rt) ++e;
        u.pm = rt - pre[e]; u.pn = g & 3; u.A = A; u.B = W + (size_t)e * wexp + (size_t)u.pn * tsB; u.tab = i; u.e = e; return true;
    }
};
__device__ __forceinline__ int moe_setup(const Params& p, const Ctx& C, int layer, MoeOrder& S) {
    LAS int* pre = (LAS int*)(C.lds + MOEPRE_OFF); LAS int* cnts = pre + 40; LAS int* rowtab = (LAS int*)(C.lds + ROWTAB_OFF);
    const gu32* CNT = (const gu32*)(p.ws + WS_CTL) + CW_CNT + layer * 2048;
    if (C.tid < 32) cnts[C.tid] = (int)__hip_atomic_load(CNT + 64 * C.tid, RLX_AGENT);
    __syncthreads();
    if (C.tid == 0) { int a = 0; for (int e = 0; e < NEXP; ++e) { pre[e] = a; a += (cnts[e] + 255) >> 8; } pre[NEXP] = a; pre[NEXP + 1] = 0x7fffffff; }
    __syncthreads();
    S.pre = pre; S.UT = 4 * pre[NEXP];
    const int* LIST = (const int*)(p.ws + WS_LIST);
    pg8::Unit u;
    for (int i = 0; S.next(i, u); ++i) { if (C.tid < 256) { const int idx = 256 * u.pm + C.tid; rowtab[i * 256 + C.tid] = idx < cnts[u.e] ? LIST[(size_t)u.e * LCAP + idx] : -1; } }
    __syncthreads();
    return S.UT;
}

__global__ void __launch_bounds__(NWAVES * 64, 2) trunk_fwd(Params p) {
    extern __shared__ __attribute__((aligned(16))) unsigned char lds[];
    Ctx C;
    C.lds = (LAS unsigned char*)lds; C.tid = threadIdx.x; C.lane = C.tid & 63; C.wave = __builtin_amdgcn_readfirstlane(C.tid >> 6);
    C.G = gridDim.x; { const int bx = blockIdx.x; C.vcu = (C.G % 8 == 0) ? (bx % 8) * (C.G / 8) + bx / 8 : bx; }
    volatile LAS unsigned* MISC = (volatile LAS unsigned*)(C.lds + MISC_OFF);
    gu32* ctl = (gu32*)(p.ws + WS_CTL);
    if (C.tid < 32) MISC[C.tid] = 0u;
    __syncthreads();
    XcdBarrier bar; bar.bar = (unsigned*)(ctl + CW_BAR) + p.li * XCD_BAR_WORDS; bar.x = 0; bar.st = nullptr;
    if (!MK_PER_PHASE) bar = xcd_barrier_post((unsigned*)(ctl + CW_BAR) + p.li * XCD_BAR_WORDS, MISC + 8);
#define GRID_BAR() do { if (MK_PER_PHASE) { if (C.tid == 0) __hip_atomic_store(ctl + CW_TMO, 0xBADBA0u, RLX_AGENT); } else { xcd_barrier(bar); } } while (0)
    const int lo = p.ph_lo, hi = p.ph_hi;
#ifndef SUBMASK
#define SUBMASK 0x7f
#endif
#ifndef REP_MASK
#define REP_MASK 0
#endif
#define NREP(k) (((REP_MASK >> (k)) & 1) ? 2 : 1)
#ifndef PHASE_MASK
#define PHASE_MASK 0xffff
#endif
#define IN(k) (((PHASE_MASK >> (k)) & 1) && lo <= (k) && (k) < hi)
#define SEAM(k) do { if (IN(k) && IN((k) + 1)) GRID_BAR(); } while (0)
    bf16* XH = (bf16*)(p.ws + WS_XH); bf16* QB = (bf16*)(p.ws + WS_Q); bf16* KB = (bf16*)(p.ws + WS_K); bf16* VB = (bf16*)(p.ws + WS_V);
    bf16* O0 = (bf16*)(p.ws + WS_O0); bf16* O1 = (bf16*)(p.ws + WS_XH);
    const LAS int* rowtab = (const LAS int*)(C.lds + ROWTAB_OFF);

    if (IN(0)) { for (int rep_ = 0; rep_ < NREP(0); ++rep_) p0_prologue(p, fresh(C)); } SEAM(0);

    for (int layer = 0; layer < 2; ++layer) {
        const int pb = 1 + (layer ? 8 : 0);
        if ((SUBMASK & 1) && IN(pb)) { for (int rep_ = 0; rep_ < NREP(pb); ++rep_) {
            if (layer == 1) cumsum_job(p, fresh(C));
            pg8::StaticOrder S; S.init(NRP, 3 * DM, C.G, (int)blockIdx.x, XH, DM * 2, p.ws + (layer ? WS_WQKV1 : WS_WQKV0), DM * 2);
            pg8::EpiQKV E{QB, KB, VB, attn_body::C2, layer ? (unsigned*)(ctl + CW_QM) : nullptr, (unsigned*)(ctl + CW_KM)};
            pg8::gemm_phase<pg8::EpiQKV, pg8::StaticOrder, true, false>(C.lds + RING_OFF, DM, DM * 2, S, E, rowtab, 0);
        } } SEAM(pb);
        if (layer == 0) {
            if (IN(2)) { for (int rep_ = 0; rep_ < NREP(2); ++rep_) {
                const float* TAB = (const float*)(p.ws + WS_TAB);
                for (int pr = C.vcu; pr < NBATCH * 32 * 16; pr += C.G) { const int trip = pr >> 4, s = pr & 15, b = trip >> 5, m = (trip & 31) >> 1, f = trip & 1; const int cv = (m >> 1) * 128 + f * 64;
#pragma unroll 1
                    for (int w = 0; w < 2; ++w) attn_body::attn_unit<0, 8>(b, w ? s : 31 - s, 0, m * 64, cv, cv, (const attn_body::bf16*)QB, (const attn_body::bf16*)KB, (const attn_body::bf16*)VB, (attn_body::bf16*)((m & 1) ? O1 : O0), TAB + m * 128, (char*)lds + RING_OFF); }
            } } SEAM(2);
            if (IN(3)) { combine_phase(p, fresh(C)); } SEAM(3);
        } else {
            if (IN(10)) { for (int rep_ = 0; rep_ < NREP(10); ++rep_) {
                const float* DK = (const float*)(p.ws + WS_DK);
                LAS int* tk = (LAS int*)(C.lds + MOEPRE_OFF);
                const int lane_ = C.lane;
                for (;;) {
                    if (C.tid == 0) tk[0] = (int)__hip_atomic_fetch_add(ctl + CW_QCTR + 64 * rep_, 1u, RLX_AGENT);
                    __syncthreads(); const int u = tk[0]; __syncthreads();
                    if (u >= NBATCH * 16 * 32) break;
                    const int qb = 31 - (u >> 6), bh = u & 63, b = bh >> 4, h = bh & 15;
                    const float* dk = DK + (size_t)bh * KROWS;
                    const unsigned qmb = lane_ < 8 ? __hip_atomic_load(ctl + CW_QM + ((size_t)(b * 32 + qb) * 16 + h) * 8 + lane_, RLX_AGENT) : 0u;
                    const unsigned kmb = lane_ < 8 ? __hip_atomic_load(ctl + CW_KM + ((size_t)bh) * 8 + lane_, RLX_AGENT) : 0u;
                    const int ntf = 4 * qb + 6;
                    float e0 = lane_ < ntf ? dk[lane_ == 0 ? NMETA - 1 : 64 * lane_ + 63] : 0.f, e1 = lane_ + 64 < ntf ? dk[64 * (lane_ + 64) + 63] : 0.f, e2 = lane_ + 128 < ntf ? dk[64 * (lane_ + 128) + 63] : 0.f;
                    const float q2 = wave_sum(__uint_as_float(qmb)), k2 = wave_sum(__uint_as_float(kmb));
                    const float thr = dk[KPRE + 256 * qb] - 40.f - 2.1f * sqrtf(q2 * k2);
                    const unsigned long long m0 = __ballot(lane_ < ntf && e0 >= thr), m1 = __ballot(lane_ + 64 < ntf && e1 >= thr), m2 = __ballot(lane_ + 128 < ntf && e2 >= thr);
                    int tb = m0 ? __builtin_ctzll(m0) : (m1 ? 64 + __builtin_ctzll(m1) : (m2 ? 128 + __builtin_ctzll(m2) : ntf - 6));
                    tb &= ~1; tb = tb > ntf - 6 ? ntf - 6 : tb; tb = __builtin_amdgcn_readfirstlane(tb);
                    attn_body::attn_unit<1, 8>(b, qb, tb, h * 64, h * 64, h * 64, (const attn_body::bf16*)QB, (const attn_body::bf16*)KB, (const attn_body::bf16*)VB, (attn_body::bf16*)O0, dk, (char*)lds + RING_OFF);
                }
                fox_meta_attn(p, fresh(C));
            } } SEAM(10);
        }
        const int pw = layer ? 11 : 4;
        if ((SUBMASK & 4) && IN(pw)) { for (int rep_ = 0; rep_ < NREP(pw); ++rep_) {
            pg8::StaticOrder S; S.init(NRP, DM, C.G, (int)blockIdx.x, layer ? O0 : QB, DM * 2, p.ws + (layer ? WS_WO1 : WS_WO0), DM * 2);
            pg8::EpiZ E{layer ? p.out : p.x, layer ? (const float*)(p.ws + WS_HM) : p.meta, p.out, (float*)(p.ws + WS_HM)};
            pg8::gemm_phase<pg8::EpiZ, pg8::StaticOrder, true, false>(C.lds + RING_OFF, DM, DM * 2, S, E, rowtab, 0);
        } } SEAM(pw);
        if ((SUBMASK & 8) && IN(pw + 1)) { ln_phase<0>(p, fresh(C), layer); } SEAM(pw + 1);
        if ((SUBMASK & 16) && IN(pw + 2)) { for (int rep_ = 0; rep_ < NREP(pw + 2); ++rep_) {
            MoeOrder S; S.G = C.G; S.c = (int)blockIdx.x; S.A = (const char*)XH; S.W = (const char*)(p.ws + WS_WGU); S.wexp = (size_t)DM * DM * 2; S.tsB = (size_t)256 * DM * 2;
            moe_setup(p, fresh(C), layer, S);
            pg8::EpiGU E{(pg8::bf16_t*)O0};
            pg8::gemm_phase<pg8::EpiGU, MoeOrder, true, true>(C.lds + RING_OFF, DM, DM * 2, S, E, rowtab, 1);
        } } SEAM(pw + 2);
        if ((SUBMASK & 32) && IN(pw + 3)) { for (int rep_ = 0; rep_ < NREP(pw + 3); ++rep_) {
            MoeOrder S; S.G = C.G; S.c = (int)blockIdx.x; S.A = (const char*)O0; S.W = (const char*)(p.ws + WS_WD); S.wexp = (size_t)DM * DEXP * 2; S.tsB = (size_t)256 * DEXP * 2;
            moe_setup(p, fresh(C), layer, S);
            pg8::EpiDown E{(pg8::bf16_t*)KB, (const float*)(p.ws + WS_GV)};
            pg8::gemm_phase<pg8::EpiDown, MoeOrder, true, true>(C.lds + RING_OFF, DEXP, DEXP * 2, S, E, rowtab, 0);
        } } SEAM(pw + 3);
        if ((SUBMASK & 64) && IN(pw + 4)) {
            if (layer == 0) { ln_phase<1>(p, fresh(C), 0); { const Ctx Cf = fresh(C); convert_experts(p, Cf, 1, 0, Cf.vcu * NWAVES + Cf.wave, Cf.G * NWAVES); } }
            else ln_phase<2>(p, fresh(C), 1);
        }
        if (layer == 0) SEAM(8);
    }
#undef IN
#undef SEAM
#undef GRID_BAR
}

extern "C" void kernel_launch(void* const* d_in, const int* in_sizes, int n_in, void* d_out, int out_size, void* d_ws, size_t ws_size, hipStream_t stream) {
    static int grid = 0;
    if (grid == 0) {
        if (n_in != 21 || in_sizes[0] != NREAL * DM || out_size != NREAL * DM || ws_size < WS_END) { fprintf(stderr, "kernel_launch: unexpected shapes (n_in %d, in0 %d, out %d, ws %zu); nothing launched\n", n_in, n_in > 0 ? in_sizes[0] : -1, out_size, ws_size); grid = -1; return; }
        int dev = 0, cus = 0, per_cu = 0;
        if (hipGetDevice(&dev) != hipSuccess || hipDeviceGetAttribute(&cus, hipDeviceAttributeMultiprocessorCount, dev) != hipSuccess) { fprintf(stderr, "kernel_launch: device query failed\n"); grid = -1; return; }
        if (hipFuncSetAttribute((const void*)trunk_fwd, hipFuncAttributeMaxDynamicSharedMemorySize, LDS_BYTES) != hipSuccess) { fprintf(stderr, "kernel_launch: hipFuncSetAttribute failed\n"); grid = -1; return; }
        if (hipOccupancyMaxActiveBlocksPerMultiprocessor(&per_cu, (const void*)trunk_fwd, NWAVES * 64, LDS_BYTES) != hipSuccess || per_cu < 1) { fprintf(stderr, "kernel_launch: occupancy query reports %d workgroups per CU\n", per_cu); }
        (void)hipGetLastError();
        grid = cus;
    }
    if (grid < 0) return;
    if (hipMemsetAsync((char*)d_ws + WS_CTL, 0, CTL_ZERO_BYTES, stream) != hipSuccess) { fprintf(stderr, "kernel_launch: hipMemsetAsync failed\n"); return; }
    Params a{};
    const float** dst = (const float**)&a.x;
    for (int i = 0; i < 21; ++i) dst[i] = (const float*)d_in[i];
    a.out = (float*)d_out; a.ws = (unsigned char*)d_ws;
#if MK_PER_PHASE
    for (int k = 0; k < N_PHASES; ++k) { a.ph_lo = k; a.ph_hi = k + 1; a.li = 0; hipLaunchKernelGGL(trunk_fwd, dim3(grid), dim3(NWAVES * 64), LDS_BYTES, stream, a); }
#else
    a.ph_lo = 0; a.ph_hi = N_PHASES; a.li = 0;
    hipLaunchKernelGGL(trunk_fwd, dim3(grid), dim3(NWAVES * 64), LDS_BYTES, stream, a);
#endif
    const hipError_t le = hipPeekAtLastError();
    if (le != hipSuccess) fprintf(stderr, "kernel_launch: launch failed: %s\n", hipGetErrorName(le));
}
```

```cpp
#include <hip/hip_runtime.h>
#include <hip/hip_bf16.h>
#include <cstdio>
#include <cstdint>
#include <cmath>

constexpr int DM = 1024, NBATCH = 4, SEQ = 8192, NMETA = 16;
constexpr int NREAL = NBATCH * SEQ;
constexpr int NR = NREAL + NMETA;
constexpr int NRP = 129 * 256;
constexpr int KPRE = 64;
constexpr int KROWS = KPRE + SEQ + 64;
constexpr int NSLOT = 2 * NR;
constexpr int NEXP = 32, DEXP = 512;
constexpr float ALPHA = 1.41421356237309515f;
constexpr float LN_EPS = 1e-5f;
constexpr float LOG2E = 1.4426950408889634f;
constexpr float LAMBDA_INIT0 = 0.2f;

namespace pg8 {
#define PG8_LAS __attribute__((address_space(3)))
typedef unsigned short bf16_t;
typedef short bf16x8 __attribute__((ext_vector_type(8)));
typedef float f32x4 __attribute__((ext_vector_type(4)));
typedef unsigned u32x4 __attribute__((ext_vector_type(4)));
constexpr int BM = 256, BK = 64, HALF = 128, HTB = HALF * BK * 2  , STAGE_BYTES = 8 * HTB, NXCD = 8, WGM = 8;

__host__ __device__ __forceinline__ int lds_byte(int r, int c) { const int st = (r >> 4) * 2 + (c >> 5), rr = r & 15, cc = c & 31, ob = rr * 64 + cc * 2; return st * 1024 + (ob ^ (((ob >> 9) & 1) << 5)); }
__host__ __device__ __forceinline__ void stage_rc(int b, int& R, int& C) { const int st = b / 1024, sb = b % 1024, swz = sb ^ (((sb >> 9) & 1) << 5); R = (st >> 1) * 16 + swz / 64; C = (st & 1) * 32 + (swz % 64) / 2; }
__host__ __device__ __forceinline__ int perm32(int rho) { const int n = rho >> 4, i = rho & 15; return 8 * (i >> 2) + 4 * n + (i & 3); }

struct Unit { int pm, pn; const char* A; const char* B; int tab; int e; };

struct StaticOrder {
    int nM, nN, nwg, G, c; const char* A; const char* B; size_t tsA, tsB;
    __device__ void init(int M, int N, int G_, int c_, const void* A_, size_t lda_bytes, const void* B_, size_t ldb_bytes) { nM = M / BM; nN = N / BM; nwg = nM * nN; G = G_; c = c_; A = (const char*)A_; B = (const char*)B_; tsA = lda_bytes * BM; tsB = ldb_bytes * BM; }
    __device__ bool next(int i, Unit& u) const {
        const long L = (long)i * G + c; if (L >= nwg) return false;
        int wgid = (int)L; { const int q = nwg / NXCD, r = nwg % NXCD, xcd = wgid % NXCD, off = wgid / NXCD; wgid = (xcd < r ? xcd * (q + 1) : r * (q + 1) + (xcd - r) * q) + off; }
        const int nig = WGM * nN, gid = wgid / nig, fm = gid * WGM, gsz = (nM - fm) < WGM ? (nM - fm) : WGM;
        u.pm = fm + ((wgid % nig) % gsz); u.pn = (wgid % nig) / gsz; u.A = A + (size_t)u.pm * tsA; u.B = B + (size_t)u.pn * tsB; u.tab = 0; u.e = 0; return true;
    }
};

__device__ __forceinline__ float shx(float v, int m, int lane) { return __uint_as_float((unsigned)__builtin_amdgcn_ds_bpermute((lane ^ m) << 2, (int)__float_as_uint(v))); }
__device__ __forceinline__ unsigned cvt_pk_bf16(float lo, float hi) { unsigned r; asm volatile("v_cvt_pk_bf16_f32 %0, %1, %2" : "=v"(r) : "v"(lo), "v"(hi)); return r; }

template <class Epi, class Sched, bool ALIGN_EPI, bool GATHER>
__device__ __forceinline__ void gemm_phase(PG8_LAS unsigned char* lds, const int K, const unsigned lda, const Sched& S, const Epi& E, const PG8_LAS int* rowtab, const int ashift) {
    int tid_ = threadIdx.x; asm volatile("" : "+v"(tid_));
    const int tid = tid_, wid = __builtin_amdgcn_readfirstlane(tid >> 6), lane = tid & 63, wr = wid >> 2, wc = wid & 3, fr = lane & 15, fq = lane >> 4;
    const int nt = K / BK;
    unsigned voffB[2], offA[2][2], noffA[2][2]; int Rr[2], Cc[2];
#pragma unroll
    for (int i = 0; i < 2; ++i) { int R, C; stage_rc(tid * 16 + i * 8192, R, C); const int Rb = Epi::PERM ? ((R & ~31) + perm32(R & 31)) : R; Rr[i] = R; Cc[i] = C;
        voffB[i] = (unsigned)(Rb * K + C) * 2u;
#pragma unroll
        for (int h = 0; h < 2; ++h) { offA[h][i] = (unsigned)(R + HALF * h) * lda + (unsigned)C * 2u; noffA[h][i] = offA[h][i]; } }
    const size_t kstep = (size_t)(BK * 2);
    const size_t hstep = (size_t)HALF * K * 2;
    const unsigned ldsw = (unsigned)wid * 1024u;
    const int aoff = lds_byte(wr * 64 + fr, fq * 8), boff = lds_byte(wc * 32 + fr, fq * 8);
#define PG8_SA(b, h) (((b) * 2 + (h)) * HTB)
#define PG8_SB(b, h) ((4 + (b) * 2 + (h)) * HTB)
#define PG8_STAGE(bufoff, gbase, voff) do { _Pragma("unroll") for (int _i = 0; _i < 2; ++_i) \
        __builtin_amdgcn_global_load_lds((const unsigned*)((const char*)(gbase) + (voff)[_i]), (PG8_LAS unsigned*)(lds + (bufoff) + ldsw + _i * 8192), 16, 0, 0); } while (0)
#define PG8_LDA(dst, b, h) do { _Pragma("unroll") for (int m = 0; m < 4; ++m) _Pragma("unroll") for (int k = 0; k < 2; ++k) dst[m][k] = *(const PG8_LAS bf16x8*)(lds + PG8_SA(b, h) + aoff + m * 2048 + k * 1024); } while (0)
#define PG8_LDB(dst, b, h) do { _Pragma("unroll") for (int n = 0; n < 2; ++n) _Pragma("unroll") for (int k = 0; k < 2; ++k) dst[n][k] = *(const PG8_LAS bf16x8*)(lds + PG8_SB(b, h) + boff + n * 2048 + k * 1024); } while (0)
#define PG8_MMA(ai, bj, At, Bt) do { __builtin_amdgcn_s_setprio(1); _Pragma("unroll") for (int m = 0; m < 4; ++m) _Pragma("unroll") for (int n = 0; n < 2; ++n) _Pragma("unroll") for (int k = 0; k < 2; ++k) \
        acc[ai][bj][m][n] = __builtin_amdgcn_mfma_f32_16x16x32_bf16(Bt[n][k], At[m][k], acc[ai][bj][m][n], 0, 0, 0); __builtin_amdgcn_s_setprio(0); } while (0)
#define PG8_WAIT_V(n) asm volatile("s_waitcnt vmcnt(" #n ")" ::: "memory")
#define PG8_WAIT_L(n) asm volatile("s_waitcnt lgkmcnt(" #n ")" ::: "memory")
#define PG8_BAR __builtin_amdgcn_s_barrier()
#define PG8_SCHED __builtin_amdgcn_sched_barrier(0)
#define PG8_GOFF(dst, u) do { if constexpr (GATHER) { _Pragma("unroll") for (int _h = 0; _h < 2; ++_h) _Pragma("unroll") for (int _i = 0; _i < 2; ++_i) { \
        int _e = rowtab[(u).tab * 256 + _h * HALF + Rr[_i]]; _e = _e < 0 ? 0 : (_e >> ashift); dst[_h][_i] = (unsigned)_e * lda + (unsigned)Cc[_i] * 2u; } } } while (0)
    Unit cur, nxt; int ui = 0;
    if (!S.next(0, cur)) return;
    f32x4 acc[2][2][4][2];
#pragma unroll
    for (int a = 0; a < 2; ++a)
#pragma unroll
        for (int b = 0; b < 2; ++b)
#pragma unroll
            for (int m = 0; m < 4; ++m)
#pragma unroll
                for (int n = 0; n < 2; ++n) acc[a][b][m][n] = (f32x4){0.f, 0.f, 0.f, 0.f};
    bf16x8 At[4][2], B0[2][2], B1[2][2];
    const char* cA = cur.A; const char* cB = cur.B;
    PG8_GOFF(offA, cur);
    PG8_STAGE(PG8_SB(0, 0), cB, voffB); PG8_STAGE(PG8_SB(0, 1), cB + hstep, voffB); PG8_STAGE(PG8_SA(0, 0), cA, offA[0]); PG8_STAGE(PG8_SA(0, 1), cA, offA[1]);
    if (wr == 1) PG8_BAR;
    PG8_WAIT_V(2); PG8_BAR;
    PG8_STAGE(PG8_SB(1, 0), cB + kstep, voffB); PG8_STAGE(PG8_SA(1, 0), cA + kstep, offA[0]); PG8_STAGE(PG8_SB(1, 1), cB + hstep + kstep, voffB);
    PG8_WAIT_V(6); PG8_BAR;
    for (;;) {
        const bool has_next = S.next(ui + 1, nxt);
        const char* nA = has_next ? nxt.A : cA; const char* nB = has_next ? nxt.B : cB;
        if constexpr (GATHER) { if (has_next) PG8_GOFF(noffA, nxt); else {
#pragma unroll
            for (int h = 0; h < 2; ++h)
#pragma unroll
                for (int i = 0; i < 2; ++i) noffA[h][i] = offA[h][i]; } }
        for (int t = 0; t < nt; t += 2) {
            const bool last = (t == nt - 2);
            const char* a1 = cA + (size_t)(t + 1) * kstep;
            const char* a2 = last ? nA : cA + (size_t)(t + 2) * kstep; const char* b2 = last ? nB : cB + (size_t)(t + 2) * kstep;
            const char* a3 = a2 + kstep; const char* b3 = b2 + kstep;
            unsigned o2[2][2];
#pragma unroll
            for (int h = 0; h < 2; ++h)
#pragma unroll
                for (int i = 0; i < 2; ++i) o2[h][i] = (GATHER && last) ? noffA[h][i] : offA[h][i];
            PG8_LDB(B0, 0, 0); PG8_LDB(B1, 0, 1); PG8_SCHED; PG8_LDA(At, 0, 0); PG8_STAGE(PG8_SA(1, 1), a1, offA[1]);
            PG8_WAIT_V(8); PG8_WAIT_L(0); PG8_BAR; PG8_MMA(0, 0, At, B0); PG8_MMA(0, 1, At, B1); PG8_BAR; PG8_SCHED;
            PG8_LDA(At, 0, 1); PG8_STAGE(PG8_SB(0, 0), b2, voffB); PG8_STAGE(PG8_SB(0, 1), b2 + hstep, voffB); PG8_STAGE(PG8_SA(0, 0), a2, o2[0]);
            PG8_WAIT_V(8); PG8_WAIT_L(0); PG8_BAR; PG8_MMA(1, 0, At, B0); PG8_MMA(1, 1, At, B1); PG8_BAR; PG8_SCHED;
            PG8_LDB(B0, 1, 0); PG8_LDB(B1, 1, 1); PG8_SCHED; PG8_LDA(At, 1, 0); PG8_STAGE(PG8_SA(0, 1), a2, o2[1]);
            PG8_WAIT_V(8); PG8_WAIT_L(0); PG8_BAR; PG8_MMA(0, 0, At, B0); PG8_MMA(0, 1, At, B1); PG8_BAR; PG8_SCHED;
            PG8_LDA(At, 1, 1); PG8_STAGE(PG8_SB(1, 0), b3, voffB); PG8_STAGE(PG8_SB(1, 1), b3 + hstep, voffB); PG8_STAGE(PG8_SA(1, 0), a3, o2[0]);
            PG8_WAIT_V(8); PG8_WAIT_L(0); PG8_BAR; PG8_MMA(1, 0, At, B0); PG8_MMA(1, 1, At, B1); PG8_BAR; PG8_SCHED;
        }
        if constexpr (ALIGN_EPI) { if (wr == 0) PG8_BAR; }
        E(acc, cur, wr, wc, fr, fq, rowtab);
        if (!has_next) break;
#pragma unroll
        for (int a = 0; a < 2; ++a)
#pragma unroll
            for (int b = 0; b < 2; ++b)
#pragma unroll
                for (int m = 0; m < 4; ++m)
#pragma unroll
                    for (int n = 0; n < 2; ++n) acc[a][b][m][n] = (f32x4){0.f, 0.f, 0.f, 0.f};
        cur = nxt; cA = nA; cB = nB; ++ui;
        if constexpr (GATHER) {
#pragma unroll
            for (int h = 0; h < 2; ++h)
#pragma unroll
                for (int i = 0; i < 2; ++i) offA[h][i] = noffA[h][i]; }
        if constexpr (ALIGN_EPI) { if (wr == 1) PG8_BAR; }
    }
    PG8_WAIT_V(0);
    if constexpr (!ALIGN_EPI) { if (wr == 0) PG8_BAR; }
    PG8_BAR;
#undef PG8_SA
#undef PG8_SB
#undef PG8_STAGE
#undef PG8_LDA
#undef PG8_LDB
#undef PG8_MMA
#undef PG8_WAIT_V
#undef PG8_WAIT_L
#undef PG8_BAR
#undef PG8_SCHED
#undef PG8_GOFF
}

struct EpiQKV {
    static constexpr bool PERM = true;
    bf16_t* Q; bf16_t* Kb; bf16_t* Vb; float qscale;
    unsigned* qm; unsigned* km;
    __device__ __forceinline__ void operator()(const f32x4 (&acc)[2][2][4][2], const Unit& u, int wr, int wc, int fr, int fq, const PG8_LAS int*) const {
        const int row0 = u.pm * BM + wr * 64 + fr; const int t = (u.pn * BM) >> 10; const int colt = (u.pn * BM) & 1023;
        const int col0 = colt + wc * 32 + 8 * fq; const float sc = (t == 0) ? qscale : 1.f;
        bf16_t* kv = (t == 1) ? Kb : Vb;
        float mx[2] = {0.f, 0.f};
#pragma unroll
        for (int ai = 0; ai < 2; ++ai)
#pragma unroll
            for (int m = 0; m < 4; ++m) { const int r = row0 + ai * HALF + m * 16;
                if (r < NR) {
#pragma unroll
                for (int bj = 0; bj < 2; ++bj) { const f32x4 v0 = acc[ai][bj][m][0] * sc, v1 = acc[ai][bj][m][1] * sc;
                    u32x4 w; w.x = cvt_pk_bf16(v0[0], v0[1]); w.y = cvt_pk_bf16(v0[2], v0[3]); w.z = cvt_pk_bf16(v1[0], v1[1]); w.w = cvt_pk_bf16(v1[2], v1[3]);
                    const int c = col0 + bj * HALF;
                    bf16_t* dst = (t == 0) ? Q + (size_t)r * DM : kv + (size_t)(r < NREAL ? (r >> 13) * KROWS + KPRE + (r & (SEQ - 1)) : r - NREAL) * DM;
                    *(u32x4*)(dst + c) = w; } }
                if (qm != nullptr && t < 2) {
#pragma unroll
                    for (int bj = 0; bj < 2; ++bj) { const f32x4 v0 = acc[ai][bj][m][0] * sc, v1 = acc[ai][bj][m][1] * sc;
                        float ss = (v0[0] * v0[0] + v0[1] * v0[1]) + (v0[2] * v0[2] + v0[3] * v0[3]) + (v1[0] * v1[0] + v1[1] * v1[1]) + (v1[2] * v1[2] + v1[3] * v1[3]);
                        ss += shx(ss, 16, fq * 16 + fr); ss += shx(ss, 32, fq * 16 + fr);
                        if (r < NR) mx[bj] = fmaxf(mx[bj], ss); } } }
        if (qm != nullptr && t < 2) {
#pragma unroll
            for (int bj = 0; bj < 2; ++bj) { float v = mx[bj]; v = fmaxf(v, shx(v, 1, fq * 16 + fr)); v = fmaxf(v, shx(v, 2, fq * 16 + fr)); v = fmaxf(v, shx(v, 4, fq * 16 + fr)); v = fmaxf(v, shx(v, 8, fq * 16 + fr));
                if (fr == 0 && fq == 0) { const int head = 4 * (u.pn & 3) + 2 * bj + (wc >> 1), part = wc & 1; const unsigned bits = __float_as_uint(v);
                    if (t == 0) { if (u.pm < NREAL / BM) atomicMax(qm + ((size_t)u.pm * 16 + head) * 8 + part, bits); }
                    else if (u.pm < NREAL / BM) atomicMax(km + ((size_t)(u.pm >> 5) * 16 + head) * 8 + part, bits);
                    else { for (int b = 0; b < NBATCH; ++b) atomicMax(km + ((size_t)b * 16 + head) * 8 + part, bits); } } } }
    }
};
struct EpiZ {
    static constexpr bool PERM = false;
    const float* base_real; const float* base_meta; float* out_real; float* out_meta;
    __device__ __forceinline__ void operator()(const f32x4 (&acc)[2][2][4][2], const Unit& u, int wr, int wc, int fr, int fq, const PG8_LAS int*) const {
        const int row0 = u.pm * BM + wr * 64 + fr; const int col0 = u.pn * BM + wc * 32 + 4 * fq;
#pragma unroll
        for (int ai = 0; ai < 2; ++ai)
#pragma unroll
            for (int m = 0; m < 4; ++m) { const int r = row0 + ai * HALF + m * 16;
                if (r < NR) { const float* bp = r < NREAL ? base_real + (size_t)r * DM : base_meta + (size_t)(r - NREAL) * DM; float* op = r < NREAL ? out_real + (size_t)r * DM : out_meta + (size_t)(r - NREAL) * DM;
#pragma unroll
                    for (int bj = 0; bj < 2; ++bj)
#pragma unroll
                        for (int n = 0; n < 2; ++n) { const int c = col0 + bj * HALF + n * 16; const f32x4 bs = *(const f32x4*)(bp + c); *(f32x4*)(op + c) = acc[ai][bj][m][n] + bs * ALPHA; } } }
    }
};
struct EpiGU {
    static constexpr bool PERM = true;
    bf16_t* U;
    __device__ __forceinline__ void operator()(const f32x4 (&acc)[2][2][4][2], const Unit& u, int wr, int wc, int fr, int fq, const PG8_LAS int* rowtab) const {
        const int col0 = u.pn * HALF + wc * 32 + 8 * fq;
#pragma unroll
        for (int ai = 0; ai < 2; ++ai)
#pragma unroll
            for (int m = 0; m < 4; ++m) { const int slot = rowtab[u.tab * 256 + ai * HALF + wr * 64 + m * 16 + fr];
                if (slot >= 0) { float o[8];
#pragma unroll
                    for (int n = 0; n < 2; ++n)
#pragma unroll
                        for (int c = 0; c < 4; ++c) { const float g = acc[ai][0][m][n][c], up = acc[ai][1][m][n][c]; o[n * 4 + c] = g * up * __builtin_amdgcn_rcpf(1.f + __builtin_amdgcn_exp2f(-g * LOG2E)); }
                    u32x4 w; w.x = cvt_pk_bf16(o[0], o[1]); w.y = cvt_pk_bf16(o[2], o[3]); w.z = cvt_pk_bf16(o[4], o[5]); w.w = cvt_pk_bf16(o[6], o[7]);
                    *(u32x4*)(U + (size_t)slot * DEXP + col0) = w; } }
    }
};
struct EpiDown {
    static constexpr bool PERM = true;
    bf16_t* Y; const float* GV;
    __device__ __forceinline__ void operator()(const f32x4 (&acc)[2][2][4][2], const Unit& u, int wr, int wc, int fr, int fq, const PG8_LAS int* rowtab) const {
        const int col0 = u.pn * BM + wc * 32 + 8 * fq;
#pragma unroll
        for (int ai = 0; ai < 2; ++ai)
#pragma unroll
            for (int m = 0; m < 4; ++m) { const int slot = rowtab[u.tab * 256 + ai * HALF + wr * 64 + m * 16 + fr];
                if (slot >= 0) { const float gv = GV[slot];
#pragma unroll
                    for (int bj = 0; bj < 2; ++bj) { const f32x4 v0 = acc[ai][bj][m][0] * gv, v1 = acc[ai][bj][m][1] * gv;
                        u32x4 w; w.x = cvt_pk_bf16(v0[0], v0[1]); w.y = cvt_pk_bf16(v0[2], v0[3]); w.z = cvt_pk_bf16(v1[0], v1[1]); w.w = cvt_pk_bf16(v1[2], v1[3]);
                        *(u32x4*)(Y + (size_t)slot * DM + col0 + bj * HALF) = w; } } }
    }
};
}
namespace attn_body {
using bf16=__hip_bfloat16;
using bf16x8=__attribute__((ext_vector_type(8)))short;
using s16x4=__attribute__((ext_vector_type(4)))short;
using f32x16=__attribute__((ext_vector_type(16)))float;
using u32x4=__attribute__((ext_vector_type(4)))unsigned;
constexpr int D=64;
constexpr int NW=8,QBLK=32,QB=QBLK*NW,KVBLK=64,NQB=SEQ/QB;
constexpr int ATTN_PITCH=DM, ATTN_UNIT_ROWS=QB;
__device__ __forceinline__ int crow(int r,int hi){return (r&3)+8*(r>>2)+4*hi;}
#define SBAR() __builtin_amdgcn_sched_barrier(0)
__device__ __forceinline__ void cmask(f32x16&p0,f32x16&p1,int jb,int qrel,int hi){
  const float NEG=-INFINITY; int kb=64*jb+4*hi;
  #pragma unroll
  for(int r=0;r<16;++r){int kv=kb+(r&3)+8*(r>>2); if(kv>qrel)p0[r]=NEG; if(kv+32>qrel)p1[r]=NEG;}
}

constexpr int RT_OFFS=320, RT_SIZE=704;

template<int MODE> __device__ __forceinline__ void modtile_slow(f32x16&p0,f32x16&p1,int t,int q_abs,int hi,const __attribute__((address_space(3))) float* tab){
  const float NEG=-INFINITY; int hi4=4*hi; asm volatile("":"+v"(hi4),"+v"(q_abs));
  if(MODE==0){
    if(t==0){
      int bd=16+q_abs; bd=bd>383?383:bd; const __attribute__((address_space(3))) float* bp=tab+(RT_OFFS+bd-hi4-15);
      #pragma unroll
      for(int r=0;r<16;++r){ p1[r]=NEG; if(r<8)p0[r]+=bp[15-((r&3)+8*(r>>2))]; else p0[r]=NEG; }
    } else {
      const __attribute__((address_space(3))) float* bp=tab+(RT_OFFS+q_abs-64*t+KPRE-hi4-63);
      const int dq=q_abs-64*t+KPRE-hi4;
      #pragma unroll
      for(int r=0;r<16;++r){ const int c=(r&3)+8*(r>>2); p0[r]+=bp[63-c]; p1[r]+=bp[31-c]; if(c>dq)p0[r]=NEG; if(c+32>dq)p1[r]=NEG; }
    }
  } else {
    #pragma unroll
    for(int r=0;r<16;++r){
      #pragma unroll
      for(int hf=0;hf<2;++hf){
        const int js=32*hf+(r&3)+8*(r>>2)+hi4;
        const int ks=64*t+js;
        float x=hf?p1[r]:p0[r];
        if(t==0){ if(js>=NMETA)x=NEG; else x+=tab[ks]; }
        else { const int kr=ks-KPRE; if(kr>q_abs)x=NEG; else x+=tab[ks]; }
        if(hf)p1[r]=x; else p0[r]=x; }
      if((r&1)==1)asm volatile("":::"memory"); }
  }
}
__device__ __forceinline__ void modtile_fast1(f32x16&p0,f32x16&p1,int t,int hi,const __attribute__((address_space(3))) float* tab){
  typedef float f4 __attribute__((ext_vector_type(4)));
  const __attribute__((address_space(3))) f4* tp=(const __attribute__((address_space(3))) f4*)(tab+64*t+4*hi);
  #pragma unroll
  for(int g=0;g<4;++g){ const f4 a=tp[2*g], b=tp[8+2*g];
    #pragma unroll
    for(int c=0;c<4;++c){ p0[4*g+c]+=a[c]; p1[4*g+c]+=b[c]; } }
}
constexpr int NSLOT=3, SLOTB=8192;
constexpr int LDS_K=0, LDS_V=NSLOT*SLOTB, LDS_WS=2*NSLOT*SLOTB, LDS_OST=LDS_WS+NW*64*4, LDS_TAB=LDS_OST+NW*4096, LDS_BYTES=LDS_TAB+KROWS*4;
constexpr float C2=0.125f*1.4426950408889634f;
__device__ __forceinline__ void glds16(const void*gsrc,unsigned lds_dst){unsigned keep;
  asm volatile("s_mov_b32 %0, m0\n\ts_mov_b32 m0, %2\n\ts_nop 0\n\tglobal_load_lds_dwordx4 %1, off\n\ts_mov_b32 m0, %0":"=&s"(keep):"v"(gsrc),"s"(lds_dst):"memory");}
__device__ __forceinline__ float max3f(float a,float b,float c){float r;asm("v_max3_f32 %0, %1, %2, %3":"=v"(r):"v"(a),"v"(b),"v"(c));return r;}
__device__ __forceinline__ float max2f(float a,float b){float r;asm("v_max_f32_e32 %0, %1, %2":"=v"(r):"v"(a),"v"(b));return r;}
__device__ __forceinline__ float fadd_s(float a,float b){float r;asm("v_add_f32_e32 %0, %1, %2":"=v"(r):"v"(a),"v"(b));return r;}
__device__ __forceinline__ float fsub_s(float a,float b){float r;asm("v_sub_f32_e32 %0, %1, %2":"=v"(r):"v"(a),"v"(b));return r;}
typedef float f32x2_t __attribute__((ext_vector_type(2))); typedef __bf16 bf16x2_t __attribute__((ext_vector_type(2)));
__device__ __forceinline__ unsigned cvtpk_s(float lo,float hi){f32x2_t v={lo,hi};bf16x2_t b=__builtin_convertvector(v,bf16x2_t);return __builtin_bit_cast(unsigned,b);}
#define WAIT_BAR(N) asm volatile("s_waitcnt vmcnt(" #N ") lgkmcnt(0)\n\ts_barrier":::"memory")

__device__ __forceinline__ void qkt(f32x16&p0,f32x16&p1,const char*Kslot,const bf16x8*qr,const f32x16&negm,int r32,int hi){
  const char*kb=Kslot+hi*1024+r32*16;
  #pragma unroll
  for(int d0=0;d0<4;++d0){
    const bf16x8 b0=*reinterpret_cast<const bf16x8*>(kb+d0*2048);
    const bf16x8 b1=*reinterpret_cast<const bf16x8*>(kb+d0*2048+512);
    if(d0==0){p0=__builtin_amdgcn_mfma_f32_32x32x16_bf16(b0,qr[0],negm,0,0,0);p1=__builtin_amdgcn_mfma_f32_32x32x16_bf16(b1,qr[0],negm,0,0,0);}
    else{p0=__builtin_amdgcn_mfma_f32_32x32x16_bf16(b0,qr[d0],p0,0,0,0);p1=__builtin_amdgcn_mfma_f32_32x32x16_bf16(b1,qr[d0],p1,0,0,0);}}
}
typedef __attribute__((address_space(3))) const char* lds_cptr;
typedef short v4i16_t __attribute__((ext_vector_type(4)));
__device__ __forceinline__ void kload8(bf16x8*kf,lds_cptr kp){
  kf[0]=*(const __attribute__((address_space(3))) bf16x8*)(kp);      kf[1]=*(const __attribute__((address_space(3))) bf16x8*)(kp+512);
  kf[2]=*(const __attribute__((address_space(3))) bf16x8*)(kp+2048); kf[3]=*(const __attribute__((address_space(3))) bf16x8*)(kp+2560);
  kf[4]=*(const __attribute__((address_space(3))) bf16x8*)(kp+4096); kf[5]=*(const __attribute__((address_space(3))) bf16x8*)(kp+4608);
  kf[6]=*(const __attribute__((address_space(3))) bf16x8*)(kp+6144); kf[7]=*(const __attribute__((address_space(3))) bf16x8*)(kp+6656);
}
__device__ __forceinline__ void kload2(bf16x8*kf,lds_cptr kp,int j){ kf[2*j]=*(const __attribute__((address_space(3))) bf16x8*)(kp+j*2048); kf[2*j+1]=*(const __attribute__((address_space(3))) bf16x8*)(kp+j*2048+512); }
__device__ __forceinline__ s16x4 vtr(lds_cptr p){ return __builtin_bit_cast(s16x4,__builtin_amdgcn_ds_read_tr16_b64_v4i16((__attribute__((address_space(3))) v4i16_t*)p)); }
__device__ __forceinline__ float rowmax(const f32x16&p0,const f32x16&p1){
  float a=max3f(p0[0],p0[1],p1[0]),b=max3f(p0[2],p0[3],p1[1]);a=max3f(a,p1[2],p1[3]);
  #pragma unroll
  for(int r=4;r<16;r+=4){a=max3f(a,p0[r],p0[r+1]);b=max3f(b,p0[r+2],p0[r+3]);a=max3f(a,p1[r],p1[r+1]);b=max3f(b,p1[r+2],p1[r+3]);}
  const float m=max2f(a,b);
  auto rr=__builtin_amdgcn_permlane32_swap(__float_as_uint(m),__float_as_uint(m),false,false);
  return max2f(__uint_as_float(rr[0]),__uint_as_float(rr[1]));
}
__device__ __forceinline__ void pv(f32x16*o,int vb,bf16x8 pa0,bf16x8 pa1,bf16x8 pa2,bf16x8 pa3){
  #pragma unroll
  for(int d0=0;d0<2;++d0){s16x4 lo[4],hi[4];
    #pragma unroll
    for(int ks=0;ks<4;++ks){
      asm volatile("ds_read_b64_tr_b16 %0,%1 offset:%c2":"=&v"(lo[ks]):"v"(vb),"i"(d0*4096+ks*1024):"memory");
      asm volatile("ds_read_b64_tr_b16 %0,%1 offset:%c2":"=&v"(hi[ks]):"v"(vb),"i"(d0*4096+ks*1024+512):"memory");}
    asm volatile("s_waitcnt lgkmcnt(0)":::"memory");SBAR();
    #define PK(k) (bf16x8){lo[k][0],lo[k][1],lo[k][2],lo[k][3],hi[k][0],hi[k][1],hi[k][2],hi[k][3]}
    o[d0]=__builtin_amdgcn_mfma_f32_32x32x16_bf16(pa0,PK(0),o[d0],0,0,0);
    o[d0]=__builtin_amdgcn_mfma_f32_32x32x16_bf16(pa1,PK(1),o[d0],0,0,0);
    o[d0]=__builtin_amdgcn_mfma_f32_32x32x16_bf16(pa2,PK(2),o[d0],0,0,0);
    o[d0]=__builtin_amdgcn_mfma_f32_32x32x16_bf16(pa3,PK(3),o[d0],0,0,0);
    #undef PK
  }
}

#ifndef ATTN_STORE16
#define ATTN_STORE16(p,v) (*(u32x4*)(p)=(v))
#endif
template<int MODE,int THRL> __device__ __forceinline__ void attn_unit(int b,int qb,int tb,int cq,int cv,int co,const bf16*Q,const bf16*__restrict__ K,const bf16*__restrict__ V,bf16*O,const float*tabsrc,char*shm){
  int tid_=threadIdx.x; asm volatile("":"+v"(tid_));
  const int tid=tid_,lane=tid&63,r32=lane&31,hi=lane>>5; const int wid=__builtin_amdgcn_readfirstlane(tid>>6);
  const long rowbase=(long)b*SEQ, rowbase_k=(long)b*KROWS; const int q0=qb*QB;
  const bf16*Qw=Q+(rowbase+q0+wid*QBLK)*DM+cq;
  const bf16*Kh=K+rowbase_k*DM+cq,*Vh=V+rowbase_k*DM+cv;
  const unsigned lds0=(unsigned)(uintptr_t)shm;
  const __attribute__((address_space(3))) char* shm3_=(const __attribute__((address_space(3))) char*)shm;
  float*wsf=(float*)(shm+LDS_WS)+wid*64;
  const bf16*ksrc=Kh+(long)(lane+64*tb)*DM+wid*8;
  const bf16*vsrc=Vh+(long)(16*(wid&3)+(lane>>2)+64*tb)*DM+(wid>>2)*32+(lane&3)*8;
  const unsigned kdst=lds0+LDS_K+wid*1024, vdst=lds0+LDS_V+wid*1024;
  #define DMA_K(t,slot) glds16(ksrc+(long)(t)*KVBLK*DM,(unsigned)__builtin_amdgcn_readfirstlane(kdst+(slot)))
  #define DMA_V(t,slot) glds16(vsrc+(long)(t)*KVBLK*DM,(unsigned)__builtin_amdgcn_readfirstlane(vdst+(slot)))
  const int vb0=(int)(lds0+LDS_V)+((lane>>4)&1)*32+(lane&3)*8+(4*hi+((lane&15)>>2))*64;
  const char*Kbase=shm+LDS_K; bf16x8 kf[8];
  const lds_cptr shm3=(lds_cptr)shm; const lds_cptr kp0=shm3+LDS_K+hi*1024+r32*16; const lds_cptr vp0=shm3+LDS_V+((lane>>4)&1)*32+(lane&3)*8+(4*hi+((lane&15)>>2))*64;
  const int NT=(KPRE+q0+QB+KVBLK)/KVBLK-tb;
  const __attribute__((address_space(3))) float* tab=(const __attribute__((address_space(3))) float*)(shm3_+LDS_TAB);
  { __attribute__((address_space(3))) float* tw=(__attribute__((address_space(3))) float*)(shm3_+LDS_TAB);
    if(MODE==0){ for(int i=tid;i<RT_SIZE;i+=512){ const int d=i-RT_OFFS; tw[i]=d<0?-INFINITY:(d<128?tabsrc[d]:0.f); } }
    else { const int n=KPRE+q0+QB+KVBLK; for(int i=64*tb+tid*4;i<n;i+=2048){ const float4 v=*(const float4*)(tabsrc+i); tw[i]=v.x;tw[i+1]=v.y;tw[i+2]=v.z;tw[i+3]=v.w; } } }
  if(tb==0){ glds16(K+cq+(long)lane*DM+wid*8,(unsigned)__builtin_amdgcn_readfirstlane(kdst)); glds16(V+cv+(long)(16*(wid&3)+(lane>>2))*DM+(wid>>2)*32+(lane&3)*8,(unsigned)__builtin_amdgcn_readfirstlane(vdst)); } else { DMA_K(0,0); DMA_V(0,0); } DMA_K(1,SLOTB);
  bf16x8 qr[4];
  #pragma unroll
  for(int d0=0;d0<4;++d0)qr[d0]=*reinterpret_cast<const bf16x8*>(&Qw[(long)r32*DM+d0*16+hi*8]);
  float mhat=0.f,l_reg=0.f;f32x16 o[2];o[0]=f32x16{};o[1]=f32x16{};f32x16 negm=f32x16{};asm volatile("":"+v"(negm));
  const int qrel=wid*QBLK+r32, q_abs=q0+qrel;
  #define MODT(P0,P1,t,SL) do{ if(SL)modtile_slow<MODE>(P0,P1,(t)+tb,q_abs,hi,tab); else if(MODE==1)modtile_fast1(P0,P1,(t)+tb,hi,tab); }while(0)
  bool resc=false;
  #define START(P0,P1) do{ const float rm=rowmax(P0,P1); resc=false; \
    { const float dl=(MODE==1)?__builtin_fmaxf(rm,0.f):rm; mhat=fadd_s(mhat,dl); \
      _Pragma("unroll") for(int r=0;r<16;++r){P0[r]=fsub_s(P0[r],dl);P1[r]=fsub_s(P1[r],dl);} \
      _Pragma("unroll") for(int r=0;r<16;++r)negm[r]=-mhat; asm volatile("":"+v"(negm)); } \
    _Pragma("unroll") for(int r=0;r<16;++r)P0[r]=__builtin_amdgcn_exp2f(P0[r]); }while(0)
  #define RESC() do{ if(resc){ asm volatile("s_waitcnt lgkmcnt(0)":::"memory"); \
      _Pragma("unroll") for(int d_=0;d_<2;++d_) _Pragma("unroll") for(int r=0;r<16;++r)o[d_][r]*=wsf[crow(r,hi)]; } }while(0)
  f32x16 pA0,pA1,pB0,pB1;
  int sl_prev=0,sl_cur=0,sl_next=SLOTB;
  #define ROT() do{sl_prev=sl_cur;sl_cur=sl_next;sl_next=(sl_next==(NSLOT-1)*SLOTB)?0:sl_next+SLOTB;}while(0)
  DMA_K(2,2*SLOTB);
  WAIT_BAR(3);
  if(MODE==1){ mhat=tab[KPRE+q_abs]; _Pragma("unroll") for(int r=0;r<16;++r)negm[r]=-mhat; asm volatile("":"+v"(negm)); }
  qkt(pA0,pA1,Kbase,qr,negm,r32,hi);asm volatile("s_nop 15\n\ts_nop 7":"+v"(pA0),"+v"(pA1));MODT(pA0,pA1,0,true);
  START(pA0,pA1);
  _Pragma("unroll") for(int r=0;r<16;++r)pA1[r]=__builtin_amdgcn_exp2f(pA1[r]);
  WAIT_BAR(0);
  DMA_K(3,0);DMA_V(1,SLOTB);
  ROT();
  kload8(kf,kp0+sl_cur);
  WAIT_BAR(2);
  s16x4 vlo[8],vhi[8]; u32x4 pw0,pw1,pw2,pw3;
  #define PKW(P,B) cvtpk_s(P[B],P[B+1])
  #define PAF(k) __builtin_bit_cast(bf16x8,pw##k)
  #define VFR(i) (bf16x8){vlo[i][0],vlo[i][1],vlo[i][2],vlo[i][3],vhi[i][0],vhi[i][1],vhi[i][2],vhi[i][3]}
  #define PIN(x) asm volatile("":"+v"(x))
  #define MX3(a,b,c) __builtin_fmaxf(__builtin_fmaxf((a),(b)),(c))
  #define GAPA(MF,A0,A1,A2,A3,W0,W1,PW) do{ MF; sacc+=A0; sacc+=A1; sacc+=A2; sacc+=A3; PIN(sacc); W0; W1; PIN(PW); SBAR(); }while(0)
  #define EX(v) __builtin_amdgcn_exp2f(v)
  #define GAPB(MF,X,B) do{ MF; X[B]=EX(X[B]); X[B+1]=EX(X[B+1]); X[B+2]=EX(X[B+2]); X[B+3]=EX(X[B+3]); PIN(X); SBAR(); }while(0)
  #define VRD(i) do{ vlo[i]=vtr(vp_+(((i)>>2)*4096+((i)&3)*1024)); vhi[i]=vtr(vp_+(((i)>>2)*4096+((i)&3)*1024+512)); }while(0)
  #define KRD(G,j) do{ if(G){ kload2(kf,kp0+sl_next,j); SBAR(); } }while(0)
  #define STEP(C0,C1,P0,P1,t,GK,GV,GL,SL) do{ SBAR(); \
    const lds_cptr vp_=vp0+sl_prev; \
    VRD(0); SBAR(); float sacc=(P0[0]+P0[1]); \
    GAPA(C0=__builtin_amdgcn_mfma_f32_32x32x16_bf16(kf[0],qr[0],negm,0,0,0), P0[2],P0[3],P0[4],P0[5],     pw0[0]=PKW(P0,0), pw0[1]=PKW(P0,2), pw0); \
    VRD(4); SBAR(); GAPA(C1=__builtin_amdgcn_mfma_f32_32x32x16_bf16(kf[1],qr[0],negm,0,0,0), P0[6],P0[7],P0[8],P0[9],     pw0[2]=PKW(P0,4), pw0[3]=PKW(P0,6), pw0); \
    VRD(1); SBAR(); GAPA(C0=__builtin_amdgcn_mfma_f32_32x32x16_bf16(kf[2],qr[1],C0,0,0,0),   P0[10],P0[11],P0[12],P0[13], pw1[0]=PKW(P0,8), pw1[1]=PKW(P0,10), pw1); \
    VRD(5); SBAR(); GAPA(C1=__builtin_amdgcn_mfma_f32_32x32x16_bf16(kf[3],qr[1],C1,0,0,0),   P0[14],P0[15],P1[0],P1[1],   pw1[2]=PKW(P0,12),pw1[3]=PKW(P0,14), pw1); \
    VRD(2); SBAR(); GAPA(C0=__builtin_amdgcn_mfma_f32_32x32x16_bf16(kf[4],qr[2],C0,0,0,0),   P1[2],P1[3],P1[4],P1[5],     pw2[0]=PKW(P1,0), pw2[1]=PKW(P1,2), pw2); \
    VRD(6); SBAR(); GAPA(C1=__builtin_amdgcn_mfma_f32_32x32x16_bf16(kf[5],qr[2],C1,0,0,0),   P1[6],P1[7],P1[8],P1[9],     pw2[2]=PKW(P1,4), pw2[3]=PKW(P1,6), pw2); \
    VRD(3); SBAR(); GAPA(C0=__builtin_amdgcn_mfma_f32_32x32x16_bf16(kf[6],qr[3],C0,0,0,0),   P1[10],P1[11],P1[12],P1[13], pw3[0]=PKW(P1,8), pw3[1]=PKW(P1,10), pw3); \
    VRD(7); SBAR(); GAPA(C1=__builtin_amdgcn_mfma_f32_32x32x16_bf16(kf[7],qr[3],C1,0,0,0),   P1[14],P1[15],0.f,0.f,       pw3[2]=PKW(P1,12),pw3[3]=PKW(P1,14), pw3); \
    l_reg+=sacc; \
    if(GK){DMA_K((t)+3,sl_cur);} if(GV){DMA_V((t)+1,sl_next);} \
    MODT(C0,C1,t,SL); \
    { float a=MX3(C0[0],C0[1],C1[0]),b=MX3(C0[2],C0[3],C1[1]); a=MX3(a,C1[2],C1[3]); \
      _Pragma("unroll") for(int r=4;r<16;r+=4){a=MX3(a,C0[r],C0[r+1]);b=MX3(b,C0[r+2],C0[r+3]);a=MX3(a,C1[r],C1[r+1]);b=MX3(b,C1[r+2],C1[r+3]);} \
      float rm=__builtin_fmaxf(a,b); { auto rr=__builtin_amdgcn_permlane32_swap(__float_as_uint(rm),__float_as_uint(rm),false,false); rm=__builtin_fmaxf(__uint_as_float(rr[0]),__uint_as_float(rr[1])); } \
      resc=false; \
      if(__builtin_expect(__any(rm>(float)THRL),0)){ const float dl=__builtin_fmaxf(rm,0.f); mhat+=dl; \
        _Pragma("unroll") for(int r=0;r<16;++r){C0[r]-=dl;C1[r]-=dl;} \
        _Pragma("unroll") for(int r=0;r<16;++r)negm[r]=-mhat; asm volatile("":"+v"(negm)); \
        const float f=__builtin_amdgcn_exp2f(-dl); l_reg*=f; if(hi==0)wsf[r32]=f; resc=true; } } \
    SBAR(); \
    GAPB(o[0]=__builtin_amdgcn_mfma_f32_32x32x16_bf16(PAF(0),VFR(0),o[0],0,0,0), C0,0); \
    GAPB(o[1]=__builtin_amdgcn_mfma_f32_32x32x16_bf16(PAF(0),VFR(4),o[1],0,0,0), C0,4); \
    KRD(GL,0); GAPB(o[0]=__builtin_amdgcn_mfma_f32_32x32x16_bf16(PAF(1),VFR(1),o[0],0,0,0), C0,8); \
    KRD(GL,1); GAPB(o[1]=__builtin_amdgcn_mfma_f32_32x32x16_bf16(PAF(1),VFR(5),o[1],0,0,0), C0,12); \
    KRD(GL,2); GAPB(o[0]=__builtin_amdgcn_mfma_f32_32x32x16_bf16(PAF(2),VFR(2),o[0],0,0,0), C1,0); \
    KRD(GL,3); GAPB(o[1]=__builtin_amdgcn_mfma_f32_32x32x16_bf16(PAF(2),VFR(6),o[1],0,0,0), C1,4); \
    GAPB(o[0]=__builtin_amdgcn_mfma_f32_32x32x16_bf16(PAF(3),VFR(3),o[0],0,0,0), C1,8); \
    GAPB(o[1]=__builtin_amdgcn_mfma_f32_32x32x16_bf16(PAF(3),VFR(7),o[1],0,0,0), C1,12); \
    }while(0)
  int t=1;
  #define ENDW(tt) do{ if((tt)+3<NT){WAIT_BAR(2);} else if((tt)+2<NT){WAIT_BAR(1);} else {WAIT_BAR(0);} }while(0)
  for(;t+7<NT;t+=2){
    STEP(pB0,pB1,pA0,pA1,t,true,true,true,false);     WAIT_BAR(2); RESC(); ROT();
    STEP(pA0,pA1,pB0,pB1,t+1,true,true,true,false);   WAIT_BAR(2); RESC(); ROT();
  }
  for(;t+1<NT;t+=2){
    STEP(pB0,pB1,pA0,pA1,t,(t+3<NT),(t+1<NT),(t+1<NT),true);       ENDW(t);   RESC(); ROT();
    STEP(pA0,pA1,pB0,pB1,t+1,(t+4<NT),(t+2<NT),(t+2<NT),true);     ENDW(t+1); RESC(); ROT();
  }
  STEP(pB0,pB1,pA0,pA1,NT-1,false,false,false,true); RESC();
  { float sacc=pB0[0]+pB0[1]; _Pragma("unroll") for(int r=2;r<16;++r)sacc+=pB0[r]; _Pragma("unroll") for(int r=0;r<16;++r)sacc+=pB1[r]; l_reg+=sacc;
    pw0=(u32x4){PKW(pB0,0),PKW(pB0,2),PKW(pB0,4),PKW(pB0,6)};pw1=(u32x4){PKW(pB0,8),PKW(pB0,10),PKW(pB0,12),PKW(pB0,14)};pw2=(u32x4){PKW(pB1,0),PKW(pB1,2),PKW(pB1,4),PKW(pB1,6)};pw3=(u32x4){PKW(pB1,8),PKW(pB1,10),PKW(pB1,12),PKW(pB1,14)};
    SBAR(); pv(o,vb0+sl_cur,PAF(0),PAF(1),PAF(2),PAF(3)); }
  #undef PKW
  #undef PAF
  #undef VFR
  #undef PIN
  #undef MX3
  #undef GAPA
  #undef GAPB
  #undef EX
  #undef VRD
  #undef KRD
  #undef STEP
  #undef ENDW
  {auto rr=__builtin_amdgcn_permlane32_swap(__float_as_uint(l_reg),__float_as_uint(l_reg),false,false);l_reg=__uint_as_float(rr[0])+__uint_as_float(rr[1]);}
  if(hi==0)wsf[32+r32]=l_reg;asm volatile("s_waitcnt lgkmcnt(0)":::"memory");
  float rli[16];
  #pragma unroll
  for(int r=0;r<16;++r)rli[r]=__builtin_amdgcn_rcpf(wsf[32+crow(r,hi)]);
  bf16*Ow=O+(rowbase+q0+wid*QBLK)*DM+co;
  { bf16*stg=(bf16*)(shm+LDS_OST)+wid*2048;
    #pragma unroll
    for(int r=0;r<16;++r){const int orow=crow(r,hi);
      #pragma unroll
      for(int d0=0;d0<2;++d0)stg[orow*64+d0*32+r32]=__float2bfloat16(o[d0][r]*rli[r]);}
    asm volatile("s_waitcnt lgkmcnt(0)":::"memory");
    #pragma unroll
    for(int i=0;i<4;++i){const int row=i*8+(lane>>3),ch=lane&7; const u32x4 v=*(const u32x4*)(stg+row*64+ch*8); ATTN_STORE16(Ow+(long)row*DM+ch*8,v);} }
  asm volatile("s_waitcnt lgkmcnt(0)\n\ts_barrier":::"memory");
  #undef DMA_K
  #undef DMA_V
  #undef MODT
  #undef START
  #undef RESC
  #undef ROT
}

template<int THRL> __device__ __forceinline__ void attn_unit_dv(int b,int qb,int cq,int cv,int co,const bf16*Q,const bf16*__restrict__ K,const bf16*__restrict__ V,bf16*O,const float*tabsrc,char*shm){
  int tid_=threadIdx.x; asm volatile("":"+v"(tid_));
  constexpr int MODE=0, tb=0; const int tid=tid_,lane=tid&63,r32=lane&31,hi=lane>>5; const int wid=__builtin_amdgcn_readfirstlane(tid>>6);
  constexpr int LDS_K=0, LDS_V=NSLOT*SLOTB, LDS_WS=LDS_V+NSLOT*2*SLOTB, LDS_OST=LDS_WS+NW*64*4, LDS_TAB=LDS_OST+NW*4096;
  static_assert(LDS_TAB+RT_SIZE*4<=131072,"dv LDS map");
  const long rowbase=(long)b*SEQ, rowbase_k=(long)b*KROWS; const int q0=qb*QB;
  const bf16*Qw=Q+(rowbase+q0+wid*QBLK)*DM+cq;
  const bf16*Kh=K+rowbase_k*DM+cq,*Vh=V+rowbase_k*DM+cv;
  const unsigned lds0=(unsigned)(uintptr_t)shm;
  const __attribute__((address_space(3))) char* shm3_=(const __attribute__((address_space(3))) char*)shm;
  float*wsf=(float*)(shm+LDS_WS)+wid*64;
  const bf16*ksrc=Kh+(long)(lane+64*tb)*DM+wid*8;
  const bf16*vsrc=Vh+(long)(16*(wid&3)+(lane>>2)+64*tb)*DM+(wid>>2)*32+(lane&3)*8;
  const unsigned kdst=lds0+LDS_K+wid*1024, vdst=lds0+LDS_V+wid*1024;
  #define DMA_K(t,slot) glds16(ksrc+(long)(t)*KVBLK*DM,(unsigned)__builtin_amdgcn_readfirstlane(kdst+(slot)))
  #define DMA_V(t,slot) do{ glds16(vsrc+(long)(t)*KVBLK*DM,(unsigned)__builtin_amdgcn_readfirstlane(vdst+2*(slot))); glds16(vsrc+(long)(t)*KVBLK*DM+64,(unsigned)__builtin_amdgcn_readfirstlane(vdst+2*(slot)+8192)); }while(0)
  const int vb0=(int)(lds0+LDS_V)+((lane>>4)&1)*32+(lane&3)*8+(4*hi+((lane&15)>>2))*64;
  const char*Kbase=shm+LDS_K; bf16x8 kf[8];
  const lds_cptr shm3=(lds_cptr)shm; const lds_cptr kp0=shm3+LDS_K+hi*1024+r32*16; const lds_cptr vp0=shm3+LDS_V+((lane>>4)&1)*32+(lane&3)*8+(4*hi+((lane&15)>>2))*64;
  const int NT=(KPRE+q0+QB+KVBLK)/KVBLK-tb;
  const __attribute__((address_space(3))) float* tab=(const __attribute__((address_space(3))) float*)(shm3_+LDS_TAB);
  { __attribute__((address_space(3))) float* tw=(__attribute__((address_space(3))) float*)(shm3_+LDS_TAB);
    if(MODE==0){ for(int i=tid;i<RT_SIZE;i+=512){ const int d=i-RT_OFFS; tw[i]=d<0?-INFINITY:(d<128?tabsrc[d]:0.f); } }
    else { const int n=KPRE+q0+QB+KVBLK; for(int i=64*tb+tid*4;i<n;i+=2048){ const float4 v=*(const float4*)(tabsrc+i); tw[i]=v.x;tw[i+1]=v.y;tw[i+2]=v.z;tw[i+3]=v.w; } } }
  if(tb==0){ glds16(K+cq+(long)lane*DM+wid*8,(unsigned)__builtin_amdgcn_readfirstlane(kdst)); glds16(V+cv+(long)(16*(wid&3)+(lane>>2))*DM+(wid>>2)*32+(lane&3)*8,(unsigned)__builtin_amdgcn_readfirstlane(vdst)); glds16(V+cv+(long)(16*(wid&3)+(lane>>2))*DM+(wid>>2)*32+(lane&3)*8+64,(unsigned)__builtin_amdgcn_readfirstlane(vdst+8192)); } else { DMA_K(0,0); DMA_V(0,0); } DMA_K(1,SLOTB);
  bf16x8 qr[4];
  #pragma unroll
  for(int d0=0;d0<4;++d0)qr[d0]=*reinterpret_cast<const bf16x8*>(&Qw[(long)r32*DM+d0*16+hi*8]);
  float mhat=0.f,l_reg=0.f;f32x16 o[4];o[0]=f32x16{};o[1]=f32x16{};o[2]=f32x16{};o[3]=f32x16{};const f32x16 zero16=f32x16{};
  const int qrel=wid*QBLK+r32, q_abs=q0+qrel;
  #define MODT(P0,P1,t,SL) do{ if(SL)modtile_slow<MODE>(P0,P1,(t)+tb,q_abs,hi,tab); else if(MODE==1)modtile_fast1(P0,P1,(t)+tb,hi,tab); }while(0)
  bool resc=false;
  #define START(P0,P1) do{ const float rm=rowmax(P0,P1); resc=false; mhat=rm; \
    _Pragma("unroll") for(int r=0;r<16;++r)P0[r]=__builtin_amdgcn_exp2f(P0[r]-mhat); }while(0)
  #define RESC() do{ if(resc){ asm volatile("s_waitcnt lgkmcnt(0)":::"memory"); \
      _Pragma("unroll") for(int d_=0;d_<4;++d_) _Pragma("unroll") for(int r=0;r<16;++r)o[d_][r]*=wsf[crow(r,hi)]; } }while(0)
  f32x16 pA0,pA1,pB0,pB1;
  int sl_prev=0,sl_cur=0,sl_next=SLOTB;
  #define ROT() do{sl_prev=sl_cur;sl_cur=sl_next;sl_next=(sl_next==(NSLOT-1)*SLOTB)?0:sl_next+SLOTB;}while(0)
  DMA_K(2,2*SLOTB);
  WAIT_BAR(3);
  qkt(pA0,pA1,Kbase,qr,zero16,r32,hi);asm volatile("s_nop 15\n\ts_nop 7":"+v"(pA0),"+v"(pA1));MODT(pA0,pA1,0,true);
  START(pA0,pA1);
  _Pragma("unroll") for(int r=0;r<16;++r)pA1[r]=__builtin_amdgcn_exp2f(pA1[r]-mhat);
  WAIT_BAR(0);
  DMA_K(3,0);DMA_V(1,SLOTB);
  ROT();
  kload8(kf,kp0+sl_cur);
  WAIT_BAR(3);
  s16x4 vlo[8],vhi[8],wlo[8],whi[8]; u32x4 pw0,pw1,pw2,pw3;
  #define PKW(P,B) cvtpk_s(P[B],P[B+1])
  #define PAF(k) __builtin_bit_cast(bf16x8,pw##k)
  #define VFR(i) (bf16x8){vlo[i][0],vlo[i][1],vlo[i][2],vlo[i][3],vhi[i][0],vhi[i][1],vhi[i][2],vhi[i][3]}
  #define WFR(i) (bf16x8){wlo[i][0],wlo[i][1],wlo[i][2],wlo[i][3],whi[i][0],whi[i][1],whi[i][2],whi[i][3]}
  #define WRD(i) do{ wlo[i]=vtr(vp_+((2+((i)>>2))*4096+((i)&3)*1024)); whi[i]=vtr(vp_+((2+((i)>>2))*4096+((i)&3)*1024+512)); SBAR(); }while(0)
  #define GAPB2(MF,X,B) do{ MF; X[B]=EX(X[B]-mhat); X[B+1]=EX(X[B+1]-mhat); PIN(X); SBAR(); }while(0)
  #define PIN(x) asm volatile("":"+v"(x))
  #define MX3(a,b,c) __builtin_fmaxf(__builtin_fmaxf((a),(b)),(c))
  #define GAPA(MF,A0,A1,A2,A3,W0,W1,PW) do{ MF; sacc+=A0; sacc+=A1; sacc+=A2; sacc+=A3; PIN(sacc); W0; W1; PIN(PW); SBAR(); }while(0)
  #define EX(v) __builtin_amdgcn_exp2f(v)
  #define GAPB(MF,X,B) do{ MF; X[B]=EX(X[B]); X[B+1]=EX(X[B+1]); X[B+2]=EX(X[B+2]); X[B+3]=EX(X[B+3]); PIN(X); SBAR(); }while(0)
  #define VRD(i) do{ vlo[i]=vtr(vp_+(((i)>>2)*4096+((i)&3)*1024)); vhi[i]=vtr(vp_+(((i)>>2)*4096+((i)&3)*1024+512)); }while(0)
  #define KRD(G,j) do{ if(G){ kload2(kf,kp0+sl_next,j); SBAR(); } }while(0)
  #define STEP(C0,C1,P0,P1,t,GK,GV,GL,SL) do{ SBAR(); \
    const lds_cptr vp_=vp0+2*sl_prev; \
    VRD(0); SBAR(); float sacc=(P0[0]+P0[1]); \
    GAPA(C0=__builtin_amdgcn_mfma_f32_32x32x16_bf16(kf[0],qr[0],zero16,0,0,0), P0[2],P0[3],P0[4],P0[5],     pw0[0]=PKW(P0,0), pw0[1]=PKW(P0,2), pw0); \
    VRD(4); SBAR(); GAPA(C1=__builtin_amdgcn_mfma_f32_32x32x16_bf16(kf[1],qr[0],zero16,0,0,0), P0[6],P0[7],P0[8],P0[9],     pw0[2]=PKW(P0,4), pw0[3]=PKW(P0,6), pw0); \
    VRD(1); SBAR(); GAPA(C0=__builtin_amdgcn_mfma_f32_32x32x16_bf16(kf[2],qr[1],C0,0,0,0),   P0[10],P0[11],P0[12],P0[13], pw1[0]=PKW(P0,8), pw1[1]=PKW(P0,10), pw1); \
    VRD(5); SBAR(); GAPA(C1=__builtin_amdgcn_mfma_f32_32x32x16_bf16(kf[3],qr[1],C1,0,0,0),   P0[14],P0[15],P1[0],P1[1],   pw1[2]=PKW(P0,12),pw1[3]=PKW(P0,14), pw1); \
    VRD(2); SBAR(); GAPA(C0=__builtin_amdgcn_mfma_f32_32x32x16_bf16(kf[4],qr[2],C0,0,0,0),   P1[2],P1[3],P1[4],P1[5],     pw2[0]=PKW(P1,0), pw2[1]=PKW(P1,2), pw2); \
    VRD(6); SBAR(); GAPA(C1=__builtin_amdgcn_mfma_f32_32x32x16_bf16(kf[5],qr[2],C1,0,0,0),   P1[6],P1[7],P1[8],P1[9],     pw2[2]=PKW(P1,4), pw2[3]=PKW(P1,6), pw2); \
    VRD(3); SBAR(); GAPA(C0=__builtin_amdgcn_mfma_f32_32x32x16_bf16(kf[6],qr[3],C0,0,0,0),   P1[10],P1[11],P1[12],P1[13], pw3[0]=PKW(P1,8), pw3[1]=PKW(P1,10), pw3); \
    VRD(7); SBAR(); GAPA(C1=__builtin_amdgcn_mfma_f32_32x32x16_bf16(kf[7],qr[3],C1,0,0,0),   P1[14],P1[15],0.f,0.f,       pw3[2]=PKW(P1,12),pw3[3]=PKW(P1,14), pw3); \
    l_reg+=sacc; \
    if(GK){DMA_K((t)+3,sl_cur);} if(GV){DMA_V((t)+1,sl_next);} \
    MODT(C0,C1,t,SL); \
    { float a=MX3(C0[0],C0[1],C1[0]),b=MX3(C0[2],C0[3],C1[1]); a=MX3(a,C1[2],C1[3]); \
      _Pragma("unroll") for(int r=4;r<16;r+=4){a=MX3(a,C0[r],C0[r+1]);b=MX3(b,C0[r+2],C0[r+3]);a=MX3(a,C1[r],C1[r+1]);b=MX3(b,C1[r+2],C1[r+3]);} \
      float rm=__builtin_fmaxf(a,b); { auto rr=__builtin_amdgcn_permlane32_swap(__float_as_uint(rm),__float_as_uint(rm),false,false); rm=__builtin_fmaxf(__uint_as_float(rr[0]),__uint_as_float(rr[1])); } \
      resc=false; \
      const float rmd=rm-mhat; \
      if(__builtin_expect(__any(rmd>(float)THRL),0)){ const float dl=__builtin_fmaxf(rmd,0.f); mhat+=dl; \
        const float f=__builtin_amdgcn_exp2f(-dl); l_reg*=f; if(hi==0)wsf[r32]=f; resc=true; } } \
    SBAR(); \
    WRD(0); GAPB2(o[0]=__builtin_amdgcn_mfma_f32_32x32x16_bf16(PAF(0),VFR(0),o[0],0,0,0), C0,0); \
    WRD(4); GAPB2(o[1]=__builtin_amdgcn_mfma_f32_32x32x16_bf16(PAF(0),VFR(4),o[1],0,0,0), C0,2); \
    WRD(1); GAPB2(o[0]=__builtin_amdgcn_mfma_f32_32x32x16_bf16(PAF(1),VFR(1),o[0],0,0,0), C0,4); \
    WRD(5); GAPB2(o[1]=__builtin_amdgcn_mfma_f32_32x32x16_bf16(PAF(1),VFR(5),o[1],0,0,0), C0,6); \
    WRD(2); GAPB2(o[0]=__builtin_amdgcn_mfma_f32_32x32x16_bf16(PAF(2),VFR(2),o[0],0,0,0), C0,8); \
    WRD(6); GAPB2(o[1]=__builtin_amdgcn_mfma_f32_32x32x16_bf16(PAF(2),VFR(6),o[1],0,0,0), C0,10); \
    WRD(3); GAPB2(o[0]=__builtin_amdgcn_mfma_f32_32x32x16_bf16(PAF(3),VFR(3),o[0],0,0,0), C0,12); \
    WRD(7); GAPB2(o[1]=__builtin_amdgcn_mfma_f32_32x32x16_bf16(PAF(3),VFR(7),o[1],0,0,0), C0,14); \
    KRD(GL,0); GAPB2(o[2]=__builtin_amdgcn_mfma_f32_32x32x16_bf16(PAF(0),WFR(0),o[2],0,0,0), C1,0); \
    KRD(GL,1); GAPB2(o[3]=__builtin_amdgcn_mfma_f32_32x32x16_bf16(PAF(0),WFR(4),o[3],0,0,0), C1,2); \
    KRD(GL,2); GAPB2(o[2]=__builtin_amdgcn_mfma_f32_32x32x16_bf16(PAF(1),WFR(1),o[2],0,0,0), C1,4); \
    KRD(GL,3); GAPB2(o[3]=__builtin_amdgcn_mfma_f32_32x32x16_bf16(PAF(1),WFR(5),o[3],0,0,0), C1,6); \
    GAPB2(o[2]=__builtin_amdgcn_mfma_f32_32x32x16_bf16(PAF(2),WFR(2),o[2],0,0,0), C1,8); \
    GAPB2(o[3]=__builtin_amdgcn_mfma_f32_32x32x16_bf16(PAF(2),WFR(6),o[3],0,0,0), C1,10); \
    GAPB2(o[2]=__builtin_amdgcn_mfma_f32_32x32x16_bf16(PAF(3),WFR(3),o[2],0,0,0), C1,12); \
    GAPB2(o[3]=__builtin_amdgcn_mfma_f32_32x32x16_bf16(PAF(3),WFR(7),o[3],0,0,0), C1,14); \
    }while(0)
  int t=1;
  #define ENDW(tt) do{ if((tt)+3<NT){WAIT_BAR(3);} else if((tt)+2<NT){WAIT_BAR(2);} else {WAIT_BAR(0);} }while(0)
  for(;t+7<NT;t+=2){
    STEP(pB0,pB1,pA0,pA1,t,true,true,true,false);     WAIT_BAR(3); RESC(); ROT();
    STEP(pA0,pA1,pB0,pB1,t+1,true,true,true,false);   WAIT_BAR(3); RESC(); ROT();
  }
  for(;t+1<NT;t+=2){
    STEP(pB0,pB1,pA0,pA1,t,(t+3<NT),(t+1<NT),(t+1<NT),true);       ENDW(t);   RESC(); ROT();
    STEP(pA0,pA1,pB0,pB1,t+1,(t+4<NT),(t+2<NT),(t+2<NT),true);     ENDW(t+1); RESC(); ROT();
  }
  STEP(pB0,pB1,pA0,pA1,NT-1,false,false,false,true); RESC();
  { float sacc=pB0[0]+pB0[1]; _Pragma("unroll") for(int r=2;r<16;++r)sacc+=pB0[r]; _Pragma("unroll") for(int r=0;r<16;++r)sacc+=pB1[r]; l_reg+=sacc;
    pw0=(u32x4){PKW(pB0,0),PKW(pB0,2),PKW(pB0,4),PKW(pB0,6)};pw1=(u32x4){PKW(pB0,8),PKW(pB0,10),PKW(pB0,12),PKW(pB0,14)};pw2=(u32x4){PKW(pB1,0),PKW(pB1,2),PKW(pB1,4),PKW(pB1,6)};pw3=(u32x4){PKW(pB1,8),PKW(pB1,10),PKW(pB1,12),PKW(pB1,14)};
    SBAR(); pv(o,vb0+2*sl_cur,PAF(0),PAF(1),PAF(2),PAF(3)); pv(o+2,vb0+2*sl_cur+8192,PAF(0),PAF(1),PAF(2),PAF(3)); }
  #undef PKW
  #undef PAF
  #undef VFR
  #undef PIN
  #undef MX3
  #undef GAPA
  #undef GAPB
  #undef EX
  #undef VRD
  #undef WRD
  #undef WFR
  #undef GAPB2
  #undef KRD
  #undef STEP
  #undef ENDW
  {auto rr=__builtin_amdgcn_permlane32_swap(__float_as_uint(l_reg),__float_as_uint(l_reg),false,false);l_reg=__uint_as_float(rr[0])+__uint_as_float(rr[1]);}
  if(hi==0)wsf[32+r32]=l_reg;asm volatile("s_waitcnt lgkmcnt(0)":::"memory");
  float rli[16];
  #pragma unroll
  for(int r=0;r<16;++r)rli[r]=__builtin_amdgcn_rcpf(wsf[32+crow(r,hi)]);
  bf16*Ow=O+(rowbase+q0+wid*QBLK)*DM+co;
  { bf16*stg=(bf16*)(shm+LDS_OST)+wid*2048;
    #pragma unroll
    for(int ps=0;ps<2;++ps){
      #pragma unroll
      for(int r=0;r<16;++r){const int orow=crow(r,hi);
        #pragma unroll
        for(int d0=0;d0<2;++d0)stg[orow*64+d0*32+r32]=__float2bfloat16(o[2*ps+d0][r]*rli[r]);}
      asm volatile("s_waitcnt lgkmcnt(0)":::"memory");
      #pragma unroll
      for(int i=0;i<4;++i){const int row=i*8+(lane>>3),ch=lane&7; const u32x4 v=*(const u32x4*)(stg+row*64+ch*8); ATTN_STORE16(Ow+(long)row*DM+ps*64+ch*8,v);}
      asm volatile("s_waitcnt lgkmcnt(0)":::"memory"); } }
  asm volatile("s_waitcnt lgkmcnt(0)\n\ts_barrier":::"memory");
  #undef DMA_K
  #undef DMA_V
  #undef MODT
  #undef START
  #undef RESC
  #undef ROT
}
constexpr int ATTN_LDS_BYTES=LDS_BYTES;
#undef SBAR
#undef WAIT_BAR
}
#define GAS __attribute__((address_space(1)))
#define LAS __attribute__((address_space(3)))
typedef unsigned short bf16;
typedef unsigned v4u __attribute__((ext_vector_type(4)));
typedef float f32x4 __attribute__((ext_vector_type(4)));
typedef short bf16x8 __attribute__((ext_vector_type(8)));
typedef GAS unsigned gu32;
typedef GAS unsigned long long gu64;
#define RLX_AGENT __ATOMIC_RELAXED, __HIP_MEMORY_SCOPE_AGENT
#define LDS_WAIT() asm volatile("s_waitcnt lgkmcnt(0)" ::: "memory")
#define VM_WAIT() asm volatile("s_waitcnt vmcnt(0)" ::: "memory")
__device__ __forceinline__ unsigned long long rt() { return __builtin_amdgcn_s_memrealtime(); }
__device__ __forceinline__ unsigned f2bf(float f) { unsigned u = __builtin_bit_cast(unsigned, f); return (u + 0x7fffu + ((u >> 16) & 1u)) >> 16; }
__device__ __forceinline__ unsigned pk2(float lo, float hi) { return f2bf(lo) | (f2bf(hi) << 16); }

#define XB_TMO      128
#define XB_XCNT(j)  (256  + 64 * (j))
#define XB_XSUB(j)  (1280 + 64 * (j))
#define XB_XGEN(j)  (2304 + 64 * (j))
#define XB_TOP      3328
#define XB_TOPGEN   3392
#define XCD_BAR_WORDS 3456
#define XB_SPIN_CAP (1u << 18)

__device__ __forceinline__ unsigned xb_ld(unsigned* p)              { return __hip_atomic_load(p, __ATOMIC_RELAXED, __HIP_MEMORY_SCOPE_AGENT); }
__device__ __forceinline__ unsigned xb_add(unsigned* p, unsigned v) { return __hip_atomic_fetch_add(p, v, __ATOMIC_RELAXED, __HIP_MEMORY_SCOPE_AGENT); }
__device__ __forceinline__ unsigned xb_xcc_id() { return (unsigned)__builtin_amdgcn_s_getreg((3 << 11) | 20) & 0xFu; }
#define XB_SPIN(cond, bar) do { unsigned _sp = 0; while (cond) { __builtin_amdgcn_s_sleep(1); \
    if ((++_sp & 255u) == 0u) { if (xb_ld(&(bar)[XB_TMO])) break; if (_sp > XB_SPIN_CAP) { atomicAdd(&(bar)[XB_TMO], 1u); break; } } } } while (0)

struct XcdBarrier {
    unsigned* bar; unsigned x;
    volatile LAS unsigned* st;
};

__device__ __forceinline__ XcdBarrier xcd_barrier_post(unsigned* bar, volatile LAS unsigned* st) {
    XcdBarrier b; b.bar = bar; b.x = xb_xcc_id(); b.st = st;
    if (threadIdx.x == 0) (void)xb_add(&bar[XB_XCNT(b.x)], 1u);
    return b;
}
__device__ __forceinline__ void xcd_barrier_complete(unsigned* bar, unsigned x, unsigned& nloc, unsigned& nx) {
    const unsigned G = gridDim.x * gridDim.y * gridDim.z;
    unsigned sum, cnt, mine, sp = 0u;
    for (;;) {
        sum = 0u; cnt = 0u; mine = 0u;
#pragma unroll
        for (unsigned j = 0; j < 16; ++j) { const unsigned c = xb_ld(&bar[XB_XCNT(j)]); sum += c; cnt += (c > 0u) ? 1u : 0u; mine = (j == x) ? c : mine; }
        if (sum == G) break;
        __builtin_amdgcn_s_sleep(1);
        if ((++sp & 255u) == 0u) { if (xb_ld(&bar[XB_TMO])) break; if (sp > XB_SPIN_CAP) { atomicAdd(&bar[XB_TMO], 1u); break; } }
    }
    nloc = mine > 0u ? mine : 1u; nx = cnt > 0u ? cnt : 1u;
}

__device__ __forceinline__ void xcd_barrier(const XcdBarrier& b) {
    asm volatile("s_waitcnt vmcnt(0)" ::: "memory");
    __syncthreads();
    if (threadIdx.x == 0) {
        unsigned* bar = b.bar;
        __builtin_amdgcn_s_waitcnt(0);
        unsigned nloc = b.st[0], nx = b.st[1];
        if (nloc == 0u) { xcd_barrier_complete(bar, b.x, nloc, nx); b.st[0] = nloc; b.st[1] = nx; }
        const unsigned old = xb_add(&bar[XB_XSUB(b.x)], 1u);
        const unsigned gen = old / nloc;
        if (old + 1u == (gen + 1u) * nloc) {
            __builtin_amdgcn_fence(__ATOMIC_RELEASE, "agent");
            asm volatile("s_waitcnt vmcnt(0)" ::: "memory");
            const unsigned og = xb_add(&bar[XB_TOP], 1u);
            const unsigned tg = og / nx;
            if (og + 1u == (tg + 1u) * nx) xb_add(&bar[XB_TOPGEN], 1u);
            else XB_SPIN(xb_ld(&bar[XB_TOPGEN]) == tg, bar);
            __builtin_amdgcn_fence(__ATOMIC_ACQUIRE, "agent");
            xb_add(&bar[XB_XGEN(b.x)], 1u);
            asm volatile("s_waitcnt vmcnt(0)" ::: "memory");
        } else {
            XB_SPIN(xb_ld(&bar[XB_XGEN(b.x)]) == gen, bar);
            __builtin_amdgcn_fence(__ATOMIC_ACQUIRE, "agent");
            asm volatile("s_waitcnt vmcnt(0)" ::: "memory");
        }
    }
    __syncthreads();
}

constexpr int NWAVES = 8;
#ifndef MK_PER_PHASE
#define MK_PER_PHASE 0
#endif
constexpr int N_PHASES = 16;

constexpr size_t MiB = 1u << 20;
constexpr size_t WS_CTL = 0, CTL_ZERO_BYTES = 1 * MiB;
constexpr size_t WS_GV = 1 * MiB + 512 * 1024;
constexpr size_t WS_HM = 2 * MiB;
constexpr size_t WS_TAB = 2 * MiB + 256 * 1024;
constexpr size_t WS_LF = 3 * MiB;
constexpr size_t WS_DK = 6 * MiB;
constexpr size_t WS_LIST = 9 * MiB;
constexpr int LCAP = NSLOT;
constexpr size_t WS_WQKV0 = 18 * MiB, WS_WO0 = 24 * MiB, WS_WQKV1 = 26 * MiB, WS_WO1 = 32 * MiB, WS_WGU = 34 * MiB, WS_WD = 98 * MiB;
constexpr size_t WS_XH = 130 * MiB;
constexpr size_t WS_Q = 195 * MiB;
constexpr size_t WS_K = 260 * MiB, WS_V = 325 * MiB;
constexpr size_t WS_O0 = 390 * MiB;
constexpr size_t WS_END = 455 * MiB;
static_assert(WS_LIST + (size_t)NEXP * LCAP * 4 <= WS_WQKV0 && WS_DK + (size_t)NBATCH * 16 * KROWS * 4 <= WS_LIST && WS_LF + (size_t)NRP * 16 * 4 <= WS_DK, "small arrays");
static_assert(WS_XH + (size_t)NRP * DM * 2 <= WS_Q && WS_Q + (size_t)NRP * DM * 2 <= WS_K && WS_K + (size_t)NBATCH * KROWS * DM * 2 <= WS_V && WS_V + (size_t)NBATCH * KROWS * DM * 2 <= WS_O0 && WS_O0 + (size_t)NRP * DM * 2 <= WS_END, "activations");
static_assert(WS_K + (size_t)NSLOT * DM * 2 <= WS_O0 && WS_O0 + (size_t)NSLOT * DEXP * 2 <= WS_END, "MoE overlays");
constexpr int CW_TMO = 0, CW_CODE = 1;
constexpr int CW_BAR = 4096;
constexpr int CW_QM = 131072, CW_KM = 147456, CW_QCTR = 148480;
constexpr int CW_CNT = 65536;
constexpr int RING_OFF = 0, RING_BYTES = 131072;
constexpr int ROWTAB_OFF = RING_BYTES, ROWTAB_UNITS = 12;
constexpr int MOEPRE_OFF = ROWTAB_OFF + ROWTAB_UNITS * 1024;
constexpr int MISC_OFF = MOEPRE_OFF + 512;
constexpr int LDS_BYTES = 147456;
static_assert(MISC_OFF + 128 <= LDS_BYTES && attn_body::ATTN_LDS_BYTES <= RING_BYTES, "LDS map");

struct Params {
    const float *x, *meta, *rel_bias, *w_qkv, *lam, *subln, *w_o, *fox_w_in, *fox_b_f, *fox_w_o, *ln_mix_g, *ln_mix_b, *ln_ffn_g, *ln_ffn_b, *rg_w, *rg_b, *re_w, *re_b, *w_gate, *w_up, *w_down;
    float* out; unsigned char* ws; int ph_lo, ph_hi, li, pad;
};
struct Ctx { int tid, lane, wave, vcu, G; LAS unsigned char* lds; };
__device__ __forceinline__ Ctx fresh(const Ctx& C) { Ctx r = C; int t = threadIdx.x; asm volatile("" : "+v"(t)); r.tid = t; r.lane = t & 63; r.wave = __builtin_amdgcn_readfirstlane(t >> 6); return r; }

using pg8::shx;
__device__ __forceinline__ float wave_sum(float v, int lane) {
#pragma unroll
    for (int o = 1; o < 64; o <<= 1) v += shx(v, o, lane);
    return v;
}
__device__ __forceinline__ float bf2f(unsigned short h) { return __uint_as_float((unsigned)h << 16); }
__device__ __forceinline__ float bflo(unsigned w) { return __uint_as_float(w << 16); }
__device__ __forceinline__ float bfhi(unsigned w) { return __uint_as_float(w & 0xffff0000u); }
__device__ __forceinline__ float* h32_row(const Params& p, int r) { return r < NREAL ? p.out + (size_t)r * DM : (float*)(p.ws + WS_HM) + (size_t)(r - NREAL) * DM; }
__device__ __forceinline__ int meta_slot(int j) { return j; }

__device__ __forceinline__ void tr_item(const float* W, int ldw, int k0, int n0, bf16* WT, int ldt, int drow0, LAS float* scr, int lane) {
#pragma unroll 8
    for (int i = 0; i < 32; ++i) { const int kk = 2 * i + (lane >> 5); scr[kk * 33 + (lane & 31)] = W[(size_t)(k0 + kk) * ldw + n0 + (lane & 31)]; }
    LDS_WAIT(); asm volatile("" ::: "memory");
    const int c = lane & 7;
#pragma unroll
    for (int j = 0; j < 4; ++j) { const int n = (lane >> 3) + 8 * j; const LAS float* s = scr + (8 * c) * 33 + n;
        v4u o; o.x = pk2(s[0 * 33], s[1 * 33]); o.y = pk2(s[2 * 33], s[3 * 33]); o.z = pk2(s[4 * 33], s[5 * 33]); o.w = pk2(s[6 * 33], s[7 * 33]);
        *(GAS v4u*)(WT + (size_t)(drow0 + n) * ldt + k0 + 8 * c) = o; }
    LDS_WAIT(); asm volatile("" ::: "memory");
}
__device__ __forceinline__ void convert_experts(const Params& p, const Ctx& C, int layer, int first_item, int gw, int NGW) {
    LAS float* scr = (LAS float*)(C.lds + RING_OFF + C.wave * 16384);
    bf16* Wgu = (bf16*)(p.ws + WS_WGU); bf16* Wd = (bf16*)(p.ws + WS_WD);
    constexpr int PER_E = 768, NIT = NEXP * PER_E;
    for (int it = gw - first_item; it < NIT; it += NGW) { if (it < 0) continue;
        const int e = it / PER_E; int r = it % PER_E; const size_t eo = (size_t)(layer * NEXP + e);
        if (r < 512) { const bool up = r >= 256; r &= 255; const int kb = r >> 4, nb = r & 15, n0 = 32 * nb;
            tr_item((up ? p.w_up : p.w_gate) + eo * DM * DEXP, DEXP, 64 * kb, n0, Wgu + (size_t)e * DM * DM, DM, (n0 >> 7) * 256 + (n0 & 127) + (up ? 128 : 0), scr, C.lane); }
        else { r -= 512; const int kb = r >> 5, nb = r & 31;
            tr_item(p.w_down + eo * DEXP * DM, DM, 64 * kb, 32 * nb, Wd + (size_t)e * DM * DEXP, DEXP, 32 * nb, scr, C.lane); } }
}
__device__ __forceinline__ void p0_prologue(const Params& p, const Ctx& C) {
    LAS float* scr = (LAS float*)(C.lds + RING_OFF + C.wave * 16384);
    const int gw = C.vcu * NWAVES + C.wave, NGW = C.G * NWAVES;
    for (int it = gw; it < 4096; it += NGW) { int r = it;
        if (r < 1536) { tr_item(p.w_qkv, 3072, 64 * (r / 96), 32 * (r % 96), (bf16*)(p.ws + WS_WQKV0), DM, 32 * (r % 96), scr, C.lane); continue; } r -= 1536;
        if (r < 512) { tr_item(p.w_o, DM, 64 * (r >> 5), 32 * (r & 31), (bf16*)(p.ws + WS_WO0), DM, 32 * (r & 31), scr, C.lane); continue; } r -= 512;
        if (r < 1536) { tr_item(p.fox_w_in, 3088, 64 * (r / 96), 32 * (r % 96), (bf16*)(p.ws + WS_WQKV1), DM, 32 * (r % 96), scr, C.lane); continue; } r -= 1536;
        tr_item(p.fox_w_o, DM, 64 * (r >> 5), 32 * (r & 31), (bf16*)(p.ws + WS_WO1), DM, 32 * (r & 31), scr, C.lane); }
    convert_experts(p, C, 0, 0, gw, NGW);
    bf16* XH = (bf16*)(p.ws + WS_XH);
    for (int m = gw; m < NRP; m += NGW) {
        GAS unsigned long long* o8 = (GAS unsigned long long*)(XH + (size_t)m * DM) + C.lane;
        if (m < NR) { const GAS f32x4* xr = (const GAS f32x4*)(m < NREAL ? p.x + (size_t)m * DM : p.meta + (size_t)(m - NREAL) * DM) + C.lane;
#pragma unroll
            for (int j = 0; j < 4; ++j) { const f32x4 v = xr[64 * j]; o8[64 * j] = (unsigned long long)pk2(v.x, v.y) | ((unsigned long long)pk2(v.z, v.w) << 32); } }
        else {
#pragma unroll
            for (int j = 0; j < 4; ++j) o8[64 * j] = 0ull; } }
    { const int gt = C.vcu * (NWAVES * 64) + C.tid;
      if (gt < 16 * 128) { const int m = gt >> 7, d = gt & 127; int bk = d;
          if (d >= 16) { bk = 16 + (d >= 19) + (d >= 21) + (d >= 24) + (d >= 27) + (d >= 31) + (d >= 35) + (d >= 40) + (d >= 46) + (d >= 52) + (d >= 59) + (d >= 67) + (d >= 77) + (d >= 87) + (d >= 99) + (d >= 113); }
          ((float*)(p.ws + WS_TAB))[gt] = (p.rel_bias[bk * 16 + m] - p.rel_bias[31 * 16 + m]) * LOG2E; } }
}

__device__ __forceinline__ float diff_lambda_full(const Params& p, int lane) {
    const float a = p.lam[lane] * p.lam[64 + lane], b = p.lam[128 + lane] * p.lam[192 + lane];
    return __expf(wave_sum(a, lane)) - __expf(wave_sum(b, lane)) + LAMBDA_INIT0;
}
__device__ __forceinline__ void combine_phase(const Params& p, const Ctx& C) {
    const int gw = C.vcu * NWAVES + C.wave, NGW = C.G * NWAVES, lane = C.lane;
    const float lam = diff_lambda_full(p, lane);
    const bf16* O0 = (const bf16*)(p.ws + WS_O0); const bf16* O1 = (const bf16*)(p.ws + WS_XH); bf16* OA = (bf16*)(p.ws + WS_Q);
    float sw[8];
#pragma unroll
    for (int c = 0; c < 8; ++c) sw[c] = p.subln[((8 * lane) & 127) + c] * (1.f - LAMBDA_INIT0);
    for (int r = gw; r < NREAL; r += NGW) {
#pragma unroll
        for (int j = 0; j < 2; ++j) { const size_t off = (size_t)r * DM + 8 * lane + 512 * j;
            const v4u a = *(const GAS v4u*)(O0 + off), b = *(const GAS v4u*)(O1 + off);
            float d[8]; const unsigned aw[4] = {a.x, a.y, a.z, a.w}, bw[4] = {b.x, b.y, b.z, b.w}; float ss = 0.f;
#pragma unroll
            for (int c = 0; c < 4; ++c) { d[2 * c] = bflo(aw[c]) - lam * bflo(bw[c]); d[2 * c + 1] = bfhi(aw[c]) - lam * bfhi(bw[c]); ss += d[2 * c] * d[2 * c] + d[2 * c + 1] * d[2 * c + 1]; }
            ss += shx(ss, 1, lane); ss += shx(ss, 2, lane); ss += shx(ss, 4, lane); ss += shx(ss, 8, lane);
            const float rs = 1.f / sqrtf(ss * (1.f / 128.f) + LN_EPS);
            v4u o; o.x = pk2(d[0] * rs * sw[0], d[1] * rs * sw[1]); o.y = pk2(d[2] * rs * sw[2], d[3] * rs * sw[3]); o.z = pk2(d[4] * rs * sw[4], d[5] * rs * sw[5]); o.w = pk2(d[6] * rs * sw[6], d[7] * rs * sw[7]);
            *(GAS v4u*)(OA + off) = o; } }
    if (gw < 128) { const int h = gw >> 4, j = gw & 15, kj = lane & 15, s = (lane >> 4) & 1, m = 2 * h + s;
        const bf16* Q = (const bf16*)(p.ws + WS_Q); const bf16* K = (const bf16*)(p.ws + WS_K); const bf16* V = (const bf16*)(p.ws + WS_V);
        const bf16* qp = Q + (size_t)(NREAL + j) * DM + m * 64; const bf16* kp = K + (size_t)meta_slot(kj) * DM + m * 64;
        float dot = 0.f;
#pragma unroll
        for (int c = 0; c < 8; ++c) { const v4u qa = *(const GAS v4u*)(qp + 8 * c), ka = *(const GAS v4u*)(kp + 8 * c); const unsigned qw[4] = {qa.x, qa.y, qa.z, qa.w}, kw[4] = {ka.x, ka.y, ka.z, ka.w};
#pragma unroll
            for (int e = 0; e < 4; ++e) dot += bflo(qw[e]) * bflo(kw[e]) + bfhi(qw[e]) * bfhi(kw[e]); }
        float sc = (kj <= j) ? dot + p.rel_bias[(j - kj) * 16 + m] * LOG2E : -INFINITY;
        float mx = sc; mx = fmaxf(mx, shx(mx, 1, lane)); mx = fmaxf(mx, shx(mx, 2, lane)); mx = fmaxf(mx, shx(mx, 4, lane)); mx = fmaxf(mx, shx(mx, 8, lane));
        float pe = __builtin_amdgcn_exp2f(sc - mx); float l = pe; l += shx(l, 1, lane); l += shx(l, 2, lane); l += shx(l, 4, lane); l += shx(l, 8, lane);
        pe /= l;
        const float a = pe - lam * shx(pe, 16, lane);
        float o0 = 0.f, o1 = 0.f;
        for (int k2 = 0; k2 <= j; ++k2) { const float ak = __builtin_amdgcn_readlane(a, k2); const unsigned vw = *(const GAS unsigned*)(V + (size_t)meta_slot(k2) * DM + h * 128 + 2 * lane); o0 += ak * bflo(vw); o1 += ak * bfhi(vw); }
        const float ss = wave_sum(o0 * o0 + o1 * o1, lane); const float rs = 1.f / sqrtf(ss * (1.f / 128.f) + LN_EPS);
        const float w0 = p.subln[2 * lane] * (1.f - LAMBDA_INIT0), w1 = p.subln[2 * lane + 1] * (1.f - LAMBDA_INIT0);
        *(GAS unsigned*)(OA + (size_t)(NREAL + j) * DM + h * 128 + 2 * lane) = pk2(o0 * rs * w0, o1 * rs * w1); }
}
__device__ __forceinline__ void fox_meta_attn(const Params& p, const Ctx& C) {
    const int gw = C.vcu * NWAVES + C.wave, lane = C.lane;
    if (gw < 256) { const int h = gw >> 4, j = gw & 15, kj = lane & 15;
        bf16* Q = (bf16*)(p.ws + WS_Q); const bf16* K = (const bf16*)(p.ws + WS_K); const bf16* V = (const bf16*)(p.ws + WS_V); const float* DK = (const float*)(p.ws + WS_DK) + (size_t)h * KROWS;
        const bf16* qp = Q + (size_t)(NREAL + j) * DM + h * 64; const bf16* kp = K + (size_t)meta_slot(kj) * DM + h * 64;
        float dot = 0.f;
#pragma unroll
        for (int c = 0; c < 8; ++c) { const v4u qa = *(const GAS v4u*)(qp + 8 * c), ka = *(const GAS v4u*)(kp + 8 * c); const unsigned qw[4] = {qa.x, qa.y, qa.z, qa.w}, kw[4] = {ka.x, ka.y, ka.z, ka.w};
#pragma unroll
            for (int e = 0; e < 4; ++e) dot += bflo(qw[e]) * bflo(kw[e]) + bfhi(qw[e]) * bfhi(kw[e]); }
        float sc = (kj <= j) ? dot + DK[meta_slot(kj)] - DK[meta_slot(j)] : -INFINITY;
        float mx = sc; mx = fmaxf(mx, shx(mx, 1, lane)); mx = fmaxf(mx, shx(mx, 2, lane)); mx = fmaxf(mx, shx(mx, 4, lane)); mx = fmaxf(mx, shx(mx, 8, lane));
        float pe = __builtin_amdgcn_exp2f(sc - mx); float l = pe; l += shx(l, 1, lane); l += shx(l, 2, lane); l += shx(l, 4, lane); l += shx(l, 8, lane);
        pe /= l;
        float o = 0.f;
        for (int k2 = 0; k2 <= j; ++k2) { const float ak = __builtin_amdgcn_readlane(pe, k2); o += ak * bf2f(V[(size_t)meta_slot(k2) * DM + h * 64 + lane]); }
        ((bf16*)(p.ws + WS_O0))[(size_t)(NREAL + j) * DM + h * 64 + lane] = (bf16)f2bf(o); }
}

typedef float f32x4m __attribute__((ext_vector_type(4)));
template <int KIND> __device__ __forceinline__ void ln_phase(const Params& p, const Ctx& C, int layer) {
    constexpr int NCB = (KIND == 0) ? 3 : (KIND == 1 ? 1 : 0), NC = 16 * (NCB ? NCB : 1);
    constexpr int AT_PITCH = 1028;
    const int tid = C.tid, lane = C.lane, wave = C.wave;
    LAS float* At = (LAS float*)(C.lds + RING_OFF);
    LAS float* part = (LAS float*)(C.lds + RING_OFF + 65792);
    LAS float* logit = (LAS float*)(C.lds + RING_OFF + 90368);
    LAS int* sl_e = (LAS int*)(C.lds + RING_OFF + 93440);
    LAS int* cnt_l = (LAS int*)(C.lds + RING_OFF + 94720);
    const float* gsrc = (KIND == 0 ? p.ln_mix_g : p.ln_ffn_g) + layer * DM; const float* bsrc = (KIND == 0 ? p.ln_mix_b : p.ln_ffn_b) + layer * DM;
    f32x4 gv[4], bv[4];
#pragma unroll
    for (int j = 0; j < 4; ++j) { gv[j] = *(const GAS f32x4*)(gsrc + 4 * lane + 256 * j); bv[j] = *(const GAS f32x4*)(bsrc + 4 * lane + 256 * j); }
    float Bf[NCB ? NCB : 1][8][4];
    if constexpr (NCB > 0) { const int kq = lane >> 4, col = lane & 15;
#pragma unroll
        for (int cb = 0; cb < NCB; ++cb)
#pragma unroll
            for (int g = 0; g < 8; ++g)
#pragma unroll
                for (int c = 0; c < 4; ++c) { const int k = 128 * wave + 16 * g + 4 * kq + c, cc = cb * 16 + col; float w;
                    if (KIND == 0) w = cc < 4 ? p.rg_w[((size_t)layer * DM + k) * 4 + cc] : (cc < 36 ? p.re_w[((size_t)layer * DM + k) * 32 + (cc - 4)] : 0.f);
                    else w = p.fox_w_in[(size_t)k * 3088 + 3072 + cc];
                    Bf[cb][g][c] = w; } }
    if (KIND == 0) { if (tid < 96) cnt_l[tid] = 0; }
    bf16* XH = (bf16*)(p.ws + WS_XH); const bf16* Y = (const bf16*)(p.ws + WS_K);
    constexpr int NTILES = NR / 16;
    int it = 0;
    for (int tile = C.vcu; tile < NTILES; tile += C.G, ++it) {
#pragma unroll 1
        for (int rr = 0; rr < 2; ++rr) { const int rl = wave * 2 + rr, row = tile * 16 + rl;
            float* hrow = h32_row(p, row);
            f32x4 v[4];
#pragma unroll
            for (int j = 0; j < 4; ++j) v[j] = *(const GAS f32x4*)(hrow + 4 * lane + 256 * j);
            if (KIND != 0) {
#pragma unroll
                for (int j = 0; j < 4; ++j) { const unsigned long long y0 = *(const GAS unsigned long long*)(Y + (size_t)(2 * row) * DM + 4 * lane + 256 * j), y1 = *(const GAS unsigned long long*)(Y + (size_t)(2 * row + 1) * DM + 4 * lane + 256 * j);
                    const unsigned a0 = (unsigned)y0, a1 = (unsigned)(y0 >> 32), b0 = (unsigned)y1, b1 = (unsigned)(y1 >> 32);
                    v[j].x = v[j].x * ALPHA + (bflo(a0) + bflo(b0)); v[j].y = v[j].y * ALPHA + (bfhi(a0) + bfhi(b0)); v[j].z = v[j].z * ALPHA + (bflo(a1) + bflo(b1)); v[j].w = v[j].w * ALPHA + (bfhi(a1) + bfhi(b1)); } }
            float s = 0.f;
#pragma unroll
            for (int j = 0; j < 4; ++j) s += (v[j].x + v[j].y) + (v[j].z + v[j].w);
            const float mean = wave_sum(s, lane) * (1.f / DM); float s2 = 0.f;
#pragma unroll
            for (int j = 0; j < 4; ++j) { v[j] = v[j] - mean; s2 += (v[j].x * v[j].x + v[j].y * v[j].y) + (v[j].z * v[j].z + v[j].w * v[j].w); }
            const float rstd = 1.f / sqrtf(wave_sum(s2, lane) * (1.f / DM) + LN_EPS);
#pragma unroll
            for (int j = 0; j < 4; ++j) v[j] = v[j] * rstd * gv[j] + bv[j];
            if (KIND == 2) { if (row < NREAL) {
#pragma unroll
                for (int j = 0; j < 4; ++j) *(GAS f32x4*)(hrow + 4 * lane + 256 * j) = v[j]; } }
            else {
#pragma unroll
                for (int j = 0; j < 4; ++j) { *(GAS f32x4*)(hrow + 4 * lane + 256 * j) = v[j];
                    *((GAS unsigned long long*)(XH + (size_t)row * DM) + lane + 64 * j) = (unsigned long long)pk2(v[j].x, v[j].y) | ((unsigned long long)pk2(v[j].z, v[j].w) << 32);
                    *(LAS f32x4*)(At + rl * AT_PITCH + 4 * lane + 256 * j) = v[j]; } } }
        if constexpr (NCB > 0) {
            __syncthreads();
            f32x4m acc[NCB];
#pragma unroll
            for (int cb = 0; cb < NCB; ++cb) acc[cb] = (f32x4m){0.f, 0.f, 0.f, 0.f};
#pragma unroll
            for (int g = 0; g < 8; ++g) { const f32x4 a4 = *(const LAS f32x4*)(At + (lane & 15) * AT_PITCH + 128 * wave + 16 * g + 4 * (lane >> 4));
#pragma unroll
                for (int c = 0; c < 4; ++c)
#pragma unroll
                    for (int cb = 0; cb < NCB; ++cb) acc[cb] = __builtin_amdgcn_mfma_f32_16x16x4f32(a4[c], Bf[cb][g][c], acc[cb], 0, 0, 0); }
#pragma unroll
            for (int cb = 0; cb < NCB; ++cb)
#pragma unroll
                for (int r = 0; r < 4; ++r) part[(wave * 16 + 4 * (lane >> 4) + r) * 48 + cb * 16 + (lane & 15)] = acc[cb][r];
            __syncthreads();
            for (int idx = tid; idx < 16 * NC; idx += NWAVES * 64) { const int rw = idx / NC, cl = idx % NC; float sacc = 0.f;
#pragma unroll
                for (int w = 0; w < 8; ++w) sacc += part[(w * 16 + rw) * 48 + cl];
                logit[rw * 48 + cl] = sacc; }
            __syncthreads();
            if (KIND == 0) { if (tid < 16) { const int row = tile * 16 + tid; const LAS float* lg = logit + tid * 48;
                float gl[4]; int gs = 0;
#pragma unroll
                for (int i = 0; i < 4; ++i) gl[i] = lg[i] + p.rg_b[layer * 4 + i];
#pragma unroll
                for (int i = 1; i < 4; ++i) if (gl[i] > gl[gs]) gs = i;
                float den = 0.f;
#pragma unroll
                for (int i = 0; i < 4; ++i) den += __expf(gl[i] - gl[gs]);
                const float pg = 1.f / den;
                float el[8];
#pragma unroll
                for (int i = 0; i < 8; ++i) el[i] = lg[4 + gs * 8 + i] + p.re_b[layer * 32 + gs * 8 + i];
                int i0 = 0;
#pragma unroll
                for (int i = 1; i < 8; ++i) if (el[i] > el[i0]) i0 = i;
                int i1 = (i0 == 0) ? 1 : 0;
#pragma unroll
                for (int i = 0; i < 8; ++i) if (i != i0 && el[i] > el[i1]) i1 = i;
                const float ex = __expf(el[i1] - el[i0]); const float w0 = 1.f / (1.f + ex), w1 = ex * w0;
                float* GVp = (float*)(p.ws + WS_GV); GVp[2 * row] = pg * w0; GVp[2 * row + 1] = pg * w1;
                sl_e[it * 32 + 2 * tid] = gs * 8 + i0; sl_e[it * 32 + 2 * tid + 1] = gs * 8 + i1; } }
            else { if (tid < 256) { const int rw = tid >> 4, hh = tid & 15; const float vv = logit[rw * 48 + hh] + p.fox_b_f[hh];
                ((float*)(p.ws + WS_LF))[(size_t)(tile * 16 + rw) * 16 + hh] = fminf(vv, 0.f) - __builtin_amdgcn_logf(1.f + __builtin_amdgcn_exp2f(-fabsf(vv) * LOG2E)) * 0.69314718056f;   } }
        }
    }
    if (KIND == 0) {
        gu32* CNT = (gu32*)(p.ws + WS_CTL) + CW_CNT + layer * 2048; int* LIST = (int*)(p.ws + WS_LIST);
        __syncthreads();
        const int nloc = it * 32;
        for (int s = tid; s < nloc; s += NWAVES * 64) atomicAdd((int*)&cnt_l[sl_e[s]], 1);
        __syncthreads();
        if (tid < 32) { const int n = cnt_l[tid]; cnt_l[32 + tid] = n > 0 ? (int)__hip_atomic_fetch_add(CNT + 64 * tid, (unsigned)n, RLX_AGENT) : 0; cnt_l[64 + tid] = 0; }
        __syncthreads();
        for (int s = tid; s < nloc; s += NWAVES * 64) { const int e = sl_e[s]; const int pos = cnt_l[32 + e] + atomicAdd((int*)&cnt_l[64 + e], 1);
            const int tl = C.vcu + (s >> 5) * C.G; LIST[(size_t)e * LCAP + pos] = 2 * (tl * 16 + ((s & 31) >> 1)) + (s & 1); }
    }
    __syncthreads();
}

__device__ __forceinline__ void cumsum_job(const Params& p, const Ctx& C) {
    if (C.vcu >= 64) return;
    const int b = C.vcu >> 4, h = C.vcu & 15, tid = C.tid, lane = C.lane, wave = C.wave;
    const float* LF = (const float*)(p.ws + WS_LF); float* DK = (float*)(p.ws + WS_DK) + (size_t)(b * 16 + h) * KROWS;
    LAS float* wt = (LAS float*)(C.lds + RING_OFF);
    float cm = 0.f, mine = 0.f; const int myj = (tid < NMETA) ? tid : -1;
    for (int i = 0; i < NMETA; ++i) { cm += LF[(size_t)(NREAL + i) * 16 + h]; if (i == myj) mine = cm; }
    if (tid < KPRE) DK[tid] = (myj >= 0) ? -mine * LOG2E : 0.f;
    if (tid < 64) DK[KPRE + SEQ + tid] = 0.f;
    const float* lp = LF + (size_t)(b * SEQ + tid * 16) * 16 + h;
    float run = 0.f;
#pragma unroll 1
    for (int i = 0; i < 16; ++i) run += lp[i * 16];
    float inc = run;
#pragma unroll
    for (int o = 1; o < 64; o <<= 1) { const float t = __uint_as_float((unsigned)__builtin_amdgcn_ds_bpermute((lane - o) << 2, (int)__float_as_uint(inc))); if (lane >= o) inc += t; }
    if (lane == 63) wt[wave] = inc;
    __syncthreads();
    float base = cm;
    for (int w = 0; w < wave; ++w) base += wt[w];
    base += inc - run;
#pragma unroll 1
    for (int i = 0; i < 16; ++i) { base += lp[i * 16]; DK[KPRE + tid * 16 + i] = -base * LOG2E; }
    __syncthreads();
}

struct MoeOrder {
    int G, c, UT; const LAS int* pre; const char* A; const char* W; size_t wexp, tsB;
    __device__ __forceinline__ bool next(int i, pg8::Unit& u) const {
        const int g = i * G + c; if (g >= UT || i >= ROWTAB_UNITS) return false;
        const int rt = g >> 2; int e = 0; while (pre[e + 1] <= rt) ++e;
        u.pm = rt - pre[e]; u.pn = g & 3; u.A = A; u.B = W + (size_t)e * wexp + (size_t)u.pn * tsB; u.tab = i; u.e = e; return true;
    }
};
__device__ __forceinline__ int moe_setup(const Params& p, const Ctx& C, int layer, MoeOrder& S) {
    LAS int* pre = (LAS int*)(C.lds + MOEPRE_OFF); LAS int* cnts = pre + 40; LAS int* rowtab = (LAS int*)(C.lds + ROWTAB_OFF);
    const gu32* CNT = (const gu32*)(p.ws + WS_CTL) + CW_CNT + layer * 2048;
    if (C.tid < 32) cnts[C.tid] = (int)__hip_atomic_load(CNT + 64 * C.tid, RLX_AGENT);
    __syncthreads();
    if (C.tid == 0) { int a = 0; for (int e = 0; e < NEXP; ++e) { pre[e] = a; a += (cnts[e] + 255) >> 8; } pre[NEXP] = a; }
    __syncthreads();
    S.pre = pre; S.UT = 4 * pre[NEXP];
    const int* LIST = (const int*)(p.ws + WS_LIST);
    pg8::Unit u;
    for (int i = 0; S.next(i, u); ++i) { if (C.tid < 256) { const int idx = 256 * u.pm + C.tid; rowtab[i * 256 + C.tid] = idx < cnts[u.e] ? LIST[(size_t)u.e * LCAP + idx] : -1; } }
    __syncthreads();
    return S.UT;
}

__global__ void __launch_bounds__(NWAVES * 64, 2) trunk_fwd(Params p) {
    extern __shared__ __attribute__((aligned(16))) unsigned char lds[];
    Ctx C;
    C.lds = (LAS unsigned char*)lds; C.tid = threadIdx.x; C.lane = C.tid & 63; C.wave = __builtin_amdgcn_readfirstlane(C.tid >> 6);
    C.G = gridDim.x; { const int bx = blockIdx.x; C.vcu = (C.G % 8 == 0) ? (bx % 8) * (C.G / 8) + bx / 8 : bx; }
    volatile LAS unsigned* MISC = (volatile LAS unsigned*)(C.lds + MISC_OFF);
    gu32* ctl = (gu32*)(p.ws + WS_CTL);
    if (C.tid < 32) MISC[C.tid] = 0u;
    __syncthreads();
    XcdBarrier bar; bar.bar = (unsigned*)(ctl + CW_BAR) + p.li * XCD_BAR_WORDS; bar.x = 0; bar.st = nullptr;
    if (!MK_PER_PHASE) bar = xcd_barrier_post((unsigned*)(ctl + CW_BAR) + p.li * XCD_BAR_WORDS, MISC + 8);
#define GRID_BAR() do { if (MK_PER_PHASE) { if (C.tid == 0) __hip_atomic_store(ctl + CW_TMO, 0xBADBA0u, RLX_AGENT); } else { xcd_barrier(bar); } } while (0)
    const int lo = p.ph_lo, hi = p.ph_hi;
#ifndef SUBMASK
#define SUBMASK 0x7f
#endif
#ifndef REP_MASK
#define REP_MASK 0
#endif
#define NREP(k) (((REP_MASK >> (k)) & 1) ? 2 : 1)
#ifndef PHASE_MASK
#define PHASE_MASK 0xffff
#endif
#define IN(k) (((PHASE_MASK >> (k)) & 1) && lo <= (k) && (k) < hi)
#define SEAM(k) do { if (IN(k) && IN((k) + 1)) GRID_BAR(); } while (0)
    bf16* XH = (bf16*)(p.ws + WS_XH); bf16* QB = (bf16*)(p.ws + WS_Q); bf16* KB = (bf16*)(p.ws + WS_K); bf16* VB = (bf16*)(p.ws + WS_V);
    bf16* O0 = (bf16*)(p.ws + WS_O0); bf16* O1 = (bf16*)(p.ws + WS_XH);
    const LAS int* rowtab = (const LAS int*)(C.lds + ROWTAB_OFF);

    if (IN(0)) { for (int rep_ = 0; rep_ < NREP(0); ++rep_) p0_prologue(p, fresh(C)); } SEAM(0);

    for (int layer = 0; layer < 2; ++layer) {
        const int pb = 1 + (layer ? 8 : 0);
        if ((SUBMASK & 1) && IN(pb)) { for (int rep_ = 0; rep_ < NREP(pb); ++rep_) {
            if (layer == 1) cumsum_job(p, fresh(C));
            pg8::StaticOrder S; S.init(NRP, 3 * DM, C.G, (int)blockIdx.x, XH, DM * 2, p.ws + (layer ? WS_WQKV1 : WS_WQKV0), DM * 2);
            pg8::EpiQKV E{QB, KB, VB, attn_body::C2, layer ? (unsigned*)(ctl + CW_QM) : nullptr, (unsigned*)(ctl + CW_KM)};
            pg8::gemm_phase<pg8::EpiQKV, pg8::StaticOrder, true, false>(C.lds + RING_OFF, DM, DM * 2, S, E, rowtab, 0);
        } } SEAM(pb);
        if (layer == 0) {
            if (IN(2)) { for (int rep_ = 0; rep_ < NREP(2); ++rep_) {
                const float* TAB = (const float*)(p.ws + WS_TAB);
                for (int pr = C.vcu; pr < NBATCH * 16 * 16; pr += C.G) { const int trip = pr >> 4, s = pr & 15, b = trip >> 4, m = trip & 15; const int cv = (m >> 1) * 128;
#pragma unroll 1
                    for (int w = 0; w < 2; ++w) attn_body::attn_unit_dv<8>(b, w ? s : 31 - s, m * 64, cv, cv, (const attn_body::bf16*)QB, (const attn_body::bf16*)KB, (const attn_body::bf16*)VB, (attn_body::bf16*)((m & 1) ? O1 : O0), TAB + m * 128, (char*)lds + RING_OFF); }
            } } SEAM(2);
            if (IN(3)) { combine_phase(p, fresh(C)); } SEAM(3);
        } else {
            if (IN(10)) { for (int rep_ = 0; rep_ < NREP(10); ++rep_) {
                const float* DK = (const float*)(p.ws + WS_DK);
                LAS int* tk = (LAS int*)(C.lds + MOEPRE_OFF);
                for (;;) {
                    const int lane_ = fresh(C).lane;
                    if (C.tid == 0) tk[0] = (int)__hip_atomic_fetch_add(ctl + CW_QCTR + 64 * rep_, 1u, RLX_AGENT);
                    __syncthreads(); const int u = tk[0]; __syncthreads();
                    if (u >= NBATCH * 16 * 32) break;
                    const int qb = 31 - (u >> 6), bh = u & 63, b = bh >> 4, h = bh & 15;
                    const float* dk = DK + (size_t)bh * KROWS;
                    const unsigned qmb = lane_ < 8 ? __hip_atomic_load(ctl + CW_QM + ((size_t)(b * 32 + qb) * 16 + h) * 8 + lane_, RLX_AGENT) : 0u;
                    const unsigned kmb = lane_ < 8 ? __hip_atomic_load(ctl + CW_KM + ((size_t)bh) * 8 + lane_, RLX_AGENT) : 0u;
                    const int ntf = 4 * qb + 6;
                    float e0 = lane_ < ntf ? dk[lane_ == 0 ? NMETA - 1 : 64 * lane_ + 63] : 0.f, e1 = lane_ + 64 < ntf ? dk[64 * (lane_ + 64) + 63] : 0.f, e2 = lane_ + 128 < ntf ? dk[64 * (lane_ + 128) + 63] : 0.f;
                    const float q2 = wave_sum(__uint_as_float(qmb), lane_), k2 = wave_sum(__uint_as_float(kmb), lane_);
                    const float thr = dk[KPRE + 256 * qb] - 40.f - 2.1f * sqrtf(q2 * k2);
                    const unsigned long long m0 = __ballot(lane_ < ntf && e0 >= thr), m1 = __ballot(lane_ + 64 < ntf && e1 >= thr), m2 = __ballot(lane_ + 128 < ntf && e2 >= thr);
                    int tb = m0 ? __builtin_ctzll(m0) : (m1 ? 64 + __builtin_ctzll(m1) : (m2 ? 128 + __builtin_ctzll(m2) : ntf - 6));
                    tb &= ~1; tb = tb > ntf - 6 ? ntf - 6 : tb; tb = __builtin_amdgcn_readfirstlane(tb);
                    attn_body::attn_unit<1, 8>(b, qb, tb, h * 64, h * 64, h * 64, (const attn_body::bf16*)QB, (const attn_body::bf16*)KB, (const attn_body::bf16*)VB, (attn_body::bf16*)O0, dk, (char*)lds + RING_OFF);
                }
                fox_meta_attn(p, fresh(C));
            } } SEAM(10);
        }
        const int pw = layer ? 11 : 4;
        if ((SUBMASK & 4) && IN(pw)) { for (int rep_ = 0; rep_ < NREP(pw); ++rep_) {
            pg8::StaticOrder S; S.init(NRP, DM, C.G, (int)blockIdx.x, layer ? O0 : QB, DM * 2, p.ws + (layer ? WS_WO1 : WS_WO0), DM * 2);
            pg8::EpiZ E{layer ? p.out : p.x, layer ? (const float*)(p.ws + WS_HM) : p.meta, p.out, (float*)(p.ws + WS_HM)};
            pg8::gemm_phase<pg8::EpiZ, pg8::StaticOrder, true, false>(C.lds + RING_OFF, DM, DM * 2, S, E, rowtab, 0);
        } } SEAM(pw);
        if ((SUBMASK & 8) && IN(pw + 1)) { ln_phase<0>(p, fresh(C), layer); } SEAM(pw + 1);
        if ((SUBMASK & 16) && IN(pw + 2)) { for (int rep_ = 0; rep_ < NREP(pw + 2); ++rep_) {
            MoeOrder S; S.G = C.G; S.c = (int)blockIdx.x; S.A = (const char*)XH; S.W = (const char*)(p.ws + WS_WGU); S.wexp = (size_t)DM * DM * 2; S.tsB = (size_t)256 * DM * 2;
            moe_setup(p, fresh(C), layer, S);
            pg8::EpiGU E{(pg8::bf16_t*)O0};
            pg8::gemm_phase<pg8::EpiGU, MoeOrder, true, true>(C.lds + RING_OFF, DM, DM * 2, S, E, rowtab, 1);
        } } SEAM(pw + 2);
        if ((SUBMASK & 32) && IN(pw + 3)) { for (int rep_ = 0; rep_ < NREP(pw + 3); ++rep_) {
            MoeOrder S; S.G = C.G; S.c = (int)blockIdx.x; S.A = (const char*)O0; S.W = (const char*)(p.ws + WS_WD); S.wexp = (size_t)DM * DEXP * 2; S.tsB = (size_t)256 * DEXP * 2;
            moe_setup(p, fresh(C), layer, S);
            pg8::EpiDown E{(pg8::bf16_t*)KB, (const float*)(p.ws + WS_GV)};
            pg8::gemm_phase<pg8::EpiDown, MoeOrder, true, true>(C.lds + RING_OFF, DEXP, DEXP * 2, S, E, rowtab, 0);
        } } SEAM(pw + 3);
        if ((SUBMASK & 64) && IN(pw + 4)) {
            if (layer == 0) { ln_phase<1>(p, fresh(C), 0); { const Ctx Cf = fresh(C); convert_experts(p, Cf, 1, 0, Cf.vcu * NWAVES + Cf.wave, Cf.G * NWAVES); } }
            else ln_phase<2>(p, fresh(C), 1);
        }
        if (layer == 0) SEAM(8);
    }
#undef IN
#undef SEAM
#undef GRID_BAR
}

extern "C" void kernel_launch(void* const* d_in, const int* in_sizes, int n_in, void* d_out, int out_size, void* d_ws, size_t ws_size, hipStream_t stream) {
    static int grid = 0;
    if (grid == 0) {
        if (n_in != 21 || in_sizes[0] != NREAL * DM || out_size != NREAL * DM || ws_size < WS_END) { fprintf(stderr, "kernel_launch: unexpected shapes (n_in %d, in0 %d, out %d, ws %zu); nothing launched\n", n_in, n_in > 0 ? in_sizes[0] : -1, out_size, ws_size); grid = -1; return; }
        int dev = 0, cus = 0, per_cu = 0;
        if (hipGetDevice(&dev) != hipSuccess || hipDeviceGetAttribute(&cus, hipDeviceAttributeMultiprocessorCount, dev) != hipSuccess) { fprintf(stderr, "kernel_launch: device query failed\n"); grid = -1; return; }
        if (hipFuncSetAttribute((const void*)trunk_fwd, hipFuncAttributeMaxDynamicSharedMemorySize, LDS_BYTES) != hipSuccess) { fprintf(stderr, "kernel_launch: hipFuncSetAttribute failed\n"); grid = -1; return; }
        if (hipOccupancyMaxActiveBlocksPerMultiprocessor(&per_cu, (const void*)trunk_fwd, NWAVES * 64, LDS_BYTES) != hipSuccess || per_cu < 1) { fprintf(stderr, "kernel_launch: occupancy query reports %d workgroups per CU\n", per_cu); }
        (void)hipGetLastError();
        grid = cus;
    }
    if (grid < 0) return;
    if (hipMemsetAsync((char*)d_ws + WS_CTL, 0, CTL_ZERO_BYTES, stream) != hipSuccess) { fprintf(stderr, "kernel_launch: hipMemsetAsync failed\n"); return; }
    Params a{};
    const float** dst = (const float**)&a.x;
    for (int i = 0; i < 21; ++i) dst[i] = (const float*)d_in[i];
    a.out = (float*)d_out; a.ws = (unsigned char*)d_ws;
#if MK_PER_PHASE
    for (int k = 0; k < N_PHASES; ++k) { a.ph_lo = k; a.ph_hi = k + 1; a.li = 0; hipLaunchKernelGGL(trunk_fwd, dim3(grid), dim3(NWAVES * 64), LDS_BYTES, stream, a); }
#else
    a.ph_lo = 0; a.ph_hi = N_PHASES; a.li = 0;
    hipLaunchKernelGGL(trunk_fwd, dim3(grid), dim3(NWAVES * 64), LDS_BYTES, stream, a);
#endif
    const hipError_t le = hipPeekAtLastError();
    if (le != hipSuccess) fprintf(stderr, "kernel_launch: launch failed: %s\n", hipGetErrorName(le));
}
```

```cpp
#include <hip/hip_runtime.h>
#include <hip/hip_bf16.h>
#include <cstdio>
#include <cstdint>
#include <cmath>

constexpr int DM = 1024, NBATCH = 4, SEQ = 8192, NMETA = 16;
constexpr int NREAL = NBATCH * SEQ;
constexpr int NR = NREAL + NMETA;
constexpr int NRP = 129 * 256;
constexpr int KPRE = 64;
constexpr int KROWS = KPRE + SEQ + 64;
constexpr int NSLOT = 2 * NR;
constexpr int NEXP = 32, DEXP = 512;
constexpr float ALPHA = 1.41421356237309515f;
constexpr float LN_EPS = 1e-5f;
constexpr float LOG2E = 1.4426950408889634f;
constexpr float LAMBDA_INIT0 = 0.2f;

namespace pg8 {
#define PG8_LAS __attribute__((address_space(3)))
typedef unsigned short bf16_t;
typedef short bf16x8 __attribute__((ext_vector_type(8)));
typedef float f32x4 __attribute__((ext_vector_type(4)));
typedef unsigned u32x4 __attribute__((ext_vector_type(4)));
constexpr int BM = 256, BK = 64, HALF = 128, HTB = HALF * BK * 2  , STAGE_BYTES = 8 * HTB, NXCD = 8, WGM = 8;

__host__ __device__ __forceinline__ int lds_byte(int r, int c) { const int st = (r >> 4) * 2 + (c >> 5), rr = r & 15, cc = c & 31, ob = rr * 64 + cc * 2; return st * 1024 + (ob ^ (((ob >> 9) & 1) << 5)); }
__host__ __device__ __forceinline__ void stage_rc(int b, int& R, int& C) { const int st = b / 1024, sb = b % 1024, swz = sb ^ (((sb >> 9) & 1) << 5); R = (st >> 1) * 16 + swz / 64; C = (st & 1) * 32 + (swz % 64) / 2; }
__host__ __device__ __forceinline__ int perm32(int rho) { const int n = rho >> 4, i = rho & 15; return 8 * (i >> 2) + 4 * n + (i & 3); }

struct Unit { int pm, pn; const char* A; const char* B; int tab; int e; };

struct StaticOrder {
    int nM, nN, nwg, G, c; const char* A; const char* B; size_t tsA, tsB;
    __device__ void init(int M, int N, int G_, int c_, const void* A_, size_t lda_bytes, const void* B_, size_t ldb_bytes) { nM = M / BM; nN = N / BM; nwg = nM * nN; G = G_; c = c_; A = (const char*)A_; B = (const char*)B_; tsA = lda_bytes * BM; tsB = ldb_bytes * BM; }
    __device__ bool next(int i, Unit& u) const {
        const long L = (long)i * G + c; if (L >= nwg) return false;
        int wgid = (int)L; { const int q = nwg / NXCD, r = nwg % NXCD, xcd = wgid % NXCD, off = wgid / NXCD; wgid = (xcd < r ? xcd * (q + 1) : r * (q + 1) + (xcd - r) * q) + off; }
        const int nig = WGM * nN, gid = wgid / nig, fm = gid * WGM, gsz = (nM - fm) < WGM ? (nM - fm) : WGM;
        u.pm = fm + ((wgid % nig) % gsz); u.pn = (wgid % nig) / gsz; u.A = A + (size_t)u.pm * tsA; u.B = B + (size_t)u.pn * tsB; u.tab = 0; u.e = 0; return true;
    }
};

__device__ __forceinline__ float shx(float v, int m, int lane) { return __uint_as_float((unsigned)__builtin_amdgcn_ds_bpermute((lane ^ m) << 2, (int)__float_as_uint(v))); }
__device__ __forceinline__ unsigned cvt_pk_bf16(float lo, float hi) { unsigned r; asm volatile("v_cvt_pk_bf16_f32 %0, %1, %2" : "=v"(r) : "v"(lo), "v"(hi)); return r; }

template <class Epi, class Sched, bool ALIGN_EPI, bool GATHER>
__device__ __forceinline__ void gemm_phase(PG8_LAS unsigned char* lds, const int K, const unsigned lda, const Sched& S, const Epi& E, const PG8_LAS int* rowtab, const int ashift) {
    int tid_ = threadIdx.x; asm volatile("" : "+v"(tid_));
    const int tid = tid_, wid = __builtin_amdgcn_readfirstlane(tid >> 6), lane = tid & 63, wr = wid >> 2, wc = wid & 3, fr = lane & 15, fq = lane >> 4;
    const int nt = K / BK;
    unsigned voffB[2], offA[2][2], noffA[2][2]; int Rr[2], Cc[2];
#pragma unroll
    for (int i = 0; i < 2; ++i) { int R, C; stage_rc(tid * 16 + i * 8192, R, C); const int Rb = Epi::PERM ? ((R & ~31) + perm32(R & 31)) : R; Rr[i] = R; Cc[i] = C;
        voffB[i] = (unsigned)(Rb * K + C) * 2u;
#pragma unroll
        for (int h = 0; h < 2; ++h) { offA[h][i] = (unsigned)(R + HALF * h) * lda + (unsigned)C * 2u; noffA[h][i] = offA[h][i]; } }
    const size_t kstep = (size_t)(BK * 2);
    const size_t hstep = (size_t)HALF * K * 2;
    const unsigned ldsw = (unsigned)wid * 1024u;
    const int aoff = lds_byte(wr * 64 + fr, fq * 8), boff = lds_byte(wc * 32 + fr, fq * 8);
#define PG8_SA(b, h) (((b) * 2 + (h)) * HTB)
#define PG8_SB(b, h) ((4 + (b) * 2 + (h)) * HTB)
#define PG8_STAGE(bufoff, gbase, voff) do { _Pragma("unroll") for (int _i = 0; _i < 2; ++_i) \
        __builtin_amdgcn_global_load_lds((const unsigned*)((const char*)(gbase) + (voff)[_i]), (PG8_LAS unsigned*)(lds + (bufoff) + ldsw + _i * 8192), 16, 0, 0); } while (0)
#define PG8_LDA(dst, b, h) do { _Pragma("unroll") for (int m = 0; m < 4; ++m) _Pragma("unroll") for (int k = 0; k < 2; ++k) dst[m][k] = *(const PG8_LAS bf16x8*)(lds + PG8_SA(b, h) + aoff + m * 2048 + k * 1024); } while (0)
#define PG8_LDB(dst, b, h) do { _Pragma("unroll") for (int n = 0; n < 2; ++n) _Pragma("unroll") for (int k = 0; k < 2; ++k) dst[n][k] = *(const PG8_LAS bf16x8*)(lds + PG8_SB(b, h) + boff + n * 2048 + k * 1024); } while (0)
#define PG8_MMA(ai, bj, At, Bt) do { __builtin_amdgcn_s_setprio(1); _Pragma("unroll") for (int m = 0; m < 4; ++m) _Pragma("unroll") for (int n = 0; n < 2; ++n) _Pragma("unroll") for (int k = 0; k < 2; ++k) \
        acc[ai][bj][m][n] = __builtin_amdgcn_mfma_f32_16x16x32_bf16(Bt[n][k], At[m][k], acc[ai][bj][m][n], 0, 0, 0); __builtin_amdgcn_s_setprio(0); } while (0)
#define PG8_WAIT_V(n) asm volatile("s_waitcnt vmcnt(" #n ")" ::: "memory")
#define PG8_WAIT_L(n) asm volatile("s_waitcnt lgkmcnt(" #n ")" ::: "memory")
#define PG8_BAR __builtin_amdgcn_s_barrier()
#define PG8_SCHED __builtin_amdgcn_sched_barrier(0)
#define PG8_GOFF(dst, u) do { if constexpr (GATHER) { _Pragma("unroll") for (int _h = 0; _h < 2; ++_h) _Pragma("unroll") for (int _i = 0; _i < 2; ++_i) { \
        int _e = rowtab[(u).tab * 256 + _h * HALF + Rr[_i]]; _e = _e < 0 ? 0 : (_e >> ashift); dst[_h][_i] = (unsigned)_e * lda + (unsigned)Cc[_i] * 2u; } } } while (0)
    Unit cur, nxt; int ui = 0;
    if (!S.next(0, cur)) return;
    f32x4 acc[2][2][4][2];
#pragma unroll
    for (int a = 0; a < 2; ++a)
#pragma unroll
        for (int b = 0; b < 2; ++b)
#pragma unroll
            for (int m = 0; m < 4; ++m)
#pragma unroll
                for (int n = 0; n < 2; ++n) acc[a][b][m][n] = (f32x4){0.f, 0.f, 0.f, 0.f};
    bf16x8 At[4][2], B0[2][2], B1[2][2];
    const char* cA = cur.A; const char* cB = cur.B;
    PG8_GOFF(offA, cur);
    PG8_STAGE(PG8_SB(0, 0), cB, voffB); PG8_STAGE(PG8_SB(0, 1), cB + hstep, voffB); PG8_STAGE(PG8_SA(0, 0), cA, offA[0]); PG8_STAGE(PG8_SA(0, 1), cA, offA[1]);
    if (wr == 1) PG8_BAR;
    PG8_WAIT_V(2); PG8_BAR;
    PG8_STAGE(PG8_SB(1, 0), cB + kstep, voffB); PG8_STAGE(PG8_SA(1, 0), cA + kstep, offA[0]); PG8_STAGE(PG8_SB(1, 1), cB + hstep + kstep, voffB);
    PG8_WAIT_V(6); PG8_BAR;
    for (;;) {
        const bool has_next = S.next(ui + 1, nxt);
        const char* nA = has_next ? nxt.A : cA; const char* nB = has_next ? nxt.B : cB;
        if constexpr (GATHER) { if (has_next) PG8_GOFF(noffA, nxt); else {
#pragma unroll
            for (int h = 0; h < 2; ++h)
#pragma unroll
                for (int i = 0; i < 2; ++i) noffA[h][i] = offA[h][i]; } }
        for (int t = 0; t < nt; t += 2) {
            const bool last = (t == nt - 2);
            const char* a1 = cA + (size_t)(t + 1) * kstep;
            const char* a2 = last ? nA : cA + (size_t)(t + 2) * kstep; const char* b2 = last ? nB : cB + (size_t)(t + 2) * kstep;
            const char* a3 = a2 + kstep; const char* b3 = b2 + kstep;
            unsigned o2[2][2];
#pragma unroll
            for (int h = 0; h < 2; ++h)
#pragma unroll
                for (int i = 0; i < 2; ++i) o2[h][i] = (GATHER && last) ? noffA[h][i] : offA[h][i];
            PG8_LDB(B0, 0, 0); PG8_LDB(B1, 0, 1); PG8_SCHED; PG8_LDA(At, 0, 0); PG8_STAGE(PG8_SA(1, 1), a1, offA[1]);
            PG8_WAIT_V(8); PG8_WAIT_L(0); PG8_BAR; PG8_MMA(0, 0, At, B0); PG8_MMA(0, 1, At, B1); PG8_BAR; PG8_SCHED;
            PG8_LDA(At, 0, 1); PG8_STAGE(PG8_SB(0, 0), b2, voffB); PG8_STAGE(PG8_SB(0, 1), b2 + hstep, voffB); PG8_STAGE(PG8_SA(0, 0), a2, o2[0]);
            PG8_WAIT_V(8); PG8_WAIT_L(0); PG8_BAR; PG8_MMA(1, 0, At, B0); PG8_MMA(1, 1, At, B1); PG8_BAR; PG8_SCHED;
            PG8_LDB(B0, 1, 0); PG8_LDB(B1, 1, 1); PG8_SCHED; PG8_LDA(At, 1, 0); PG8_STAGE(PG8_SA(0, 1), a2, o2[1]);
            PG8_WAIT_V(8); PG8_WAIT_L(0); PG8_BAR; PG8_MMA(0, 0, At, B0); PG8_MMA(0, 1, At, B1); PG8_BAR; PG8_SCHED;
            PG8_LDA(At, 1, 1); PG8_STAGE(PG8_SB(1, 0), b3, voffB); PG8_STAGE(PG8_SB(1, 1), b3 + hstep, voffB); PG8_STAGE(PG8_SA(1, 0), a3, o2[0]);
            PG8_WAIT_V(8); PG8_WAIT_L(0); PG8_BAR; PG8_MMA(1, 0, At, B0); PG8_MMA(1, 1, At, B1); PG8_BAR; PG8_SCHED;
        }
        if constexpr (ALIGN_EPI) { if (wr == 0) PG8_BAR; }
        E(acc, cur, wr, wc, fr, fq, rowtab);
        if (!has_next) break;
#pragma unroll
        for (int a = 0; a < 2; ++a)
#pragma unroll
            for (int b = 0; b < 2; ++b)
#pragma unroll
                for (int m = 0; m < 4; ++m)
#pragma unroll
                    for (int n = 0; n < 2; ++n) acc[a][b][m][n] = (f32x4){0.f, 0.f, 0.f, 0.f};
        cur = nxt; cA = nA; cB = nB; ++ui;
        if constexpr (GATHER) {
#pragma unroll
            for (int h = 0; h < 2; ++h)
#pragma unroll
                for (int i = 0; i < 2; ++i) offA[h][i] = noffA[h][i]; }
        if constexpr (ALIGN_EPI) { if (wr == 1) PG8_BAR; }
    }
    PG8_WAIT_V(0);
    if constexpr (!ALIGN_EPI) { if (wr == 0) PG8_BAR; }
    PG8_BAR;
#undef PG8_SA
#undef PG8_SB
#undef PG8_STAGE
#undef PG8_LDA
#undef PG8_LDB
#undef PG8_MMA
#undef PG8_WAIT_V
#undef PG8_WAIT_L
#undef PG8_BAR
#undef PG8_SCHED
#undef PG8_GOFF
}

struct EpiQKV {
    static constexpr bool PERM = true;
    bf16_t* Q; bf16_t* Kb; bf16_t* Vb; float qscale;
    unsigned* qm; unsigned* km;
    __device__ __forceinline__ void operator()(const f32x4 (&acc)[2][2][4][2], const Unit& u, int wr, int wc, int fr, int fq, const PG8_LAS int*) const {
        const int row0 = u.pm * BM + wr * 64 + fr; const int t = (u.pn * BM) >> 10; const int colt = (u.pn * BM) & 1023;
        const int col0 = colt + wc * 32 + 8 * fq; const float sc = (t == 0) ? qscale : 1.f;
        bf16_t* kv = (t == 1) ? Kb : Vb;
        float mx[2] = {0.f, 0.f};
#pragma unroll
        for (int ai = 0; ai < 2; ++ai)
#pragma unroll
            for (int m = 0; m < 4; ++m) { const int r = row0 + ai * HALF + m * 16;
                if (r < NR) {
#pragma unroll
                for (int bj = 0; bj < 2; ++bj) { const f32x4 v0 = acc[ai][bj][m][0] * sc, v1 = acc[ai][bj][m][1] * sc;
                    u32x4 w; w.x = cvt_pk_bf16(v0[0], v0[1]); w.y = cvt_pk_bf16(v0[2], v0[3]); w.z = cvt_pk_bf16(v1[0], v1[1]); w.w = cvt_pk_bf16(v1[2], v1[3]);
                    const int c = col0 + bj * HALF;
                    bf16_t* dst = (t == 0) ? Q + (size_t)r * DM : kv + (size_t)(r < NREAL ? (r >> 13) * KROWS + KPRE + (r & (SEQ - 1)) : r - NREAL) * DM;
                    *(u32x4*)(dst + c) = w; } }
                if (qm != nullptr && t < 2) {
#pragma unroll
                    for (int bj = 0; bj < 2; ++bj) { const f32x4 v0 = acc[ai][bj][m][0] * sc, v1 = acc[ai][bj][m][1] * sc;
                        float ss = (v0[0] * v0[0] + v0[1] * v0[1]) + (v0[2] * v0[2] + v0[3] * v0[3]) + (v1[0] * v1[0] + v1[1] * v1[1]) + (v1[2] * v1[2] + v1[3] * v1[3]);
                        ss += shx(ss, 16, fq * 16 + fr); ss += shx(ss, 32, fq * 16 + fr);
                        if (r < NR) mx[bj] = fmaxf(mx[bj], ss); } } }
        if (qm != nullptr && t < 2) {
#pragma unroll
            for (int bj = 0; bj < 2; ++bj) { float v = mx[bj]; v = fmaxf(v, shx(v, 1, fq * 16 + fr)); v = fmaxf(v, shx(v, 2, fq * 16 + fr)); v = fmaxf(v, shx(v, 4, fq * 16 + fr)); v = fmaxf(v, shx(v, 8, fq * 16 + fr));
                if (fr == 0 && fq == 0) { const int head = 4 * (u.pn & 3) + 2 * bj + (wc >> 1), part = wc & 1; const unsigned bits = __float_as_uint(v);
                    if (t == 0) { if (u.pm < NREAL / BM) atomicMax(qm + ((size_t)u.pm * 16 + head) * 8 + part, bits); }
                    else if (u.pm < NREAL / BM) atomicMax(km + ((size_t)(u.pm >> 5) * 16 + head) * 8 + part, bits);
                    else { for (int b = 0; b < NBATCH; ++b) atomicMax(km + ((size_t)b * 16 + head) * 8 + part, bits); } } } }
    }
};
struct EpiZ {
    static constexpr bool PERM = false;
    const float* base_real; const float* base_meta; float* out_real; float* out_meta;
    __device__ __forceinline__ void operator()(const f32x4 (&acc)[2][2][4][2], const Unit& u, int wr, int wc, int fr, int fq, const PG8_LAS int*) const {
        const int row0 = u.pm * BM + wr * 64 + fr; const int col0 = u.pn * BM + wc * 32 + 4 * fq;
#pragma unroll
        for (int ai = 0; ai < 2; ++ai)
#pragma unroll
            for (int m = 0; m < 4; ++m) { const int r = row0 + ai * HALF + m * 16;
                if (r < NR) { const float* bp = r < NREAL ? base_real + (size_t)r * DM : base_meta + (size_t)(r - NREAL) * DM; float* op = r < NREAL ? out_real + (size_t)r * DM : out_meta + (size_t)(r - NREAL) * DM;
#pragma unroll
                    for (int bj = 0; bj < 2; ++bj)
#pragma unroll
                        for (int n = 0; n < 2; ++n) { const int c = col0 + bj * HALF + n * 16; const f32x4 bs = *(const f32x4*)(bp + c); *(f32x4*)(op + c) = acc[ai][bj][m][n] + bs * ALPHA; } } }
    }
};
struct EpiGU {
    static constexpr bool PERM = true;
    bf16_t* U;
    __device__ __forceinline__ void operator()(const f32x4 (&acc)[2][2][4][2], const Unit& u, int wr, int wc, int fr, int fq, const PG8_LAS int* rowtab) const {
        const int col0 = u.pn * HALF + wc * 32 + 8 * fq;
#pragma unroll
        for (int ai = 0; ai < 2; ++ai)
#pragma unroll
            for (int m = 0; m < 4; ++m) { const int slot = rowtab[u.tab * 256 + ai * HALF + wr * 64 + m * 16 + fr];
                if (slot >= 0) { float o[8];
#pragma unroll
                    for (int n = 0; n < 2; ++n)
#pragma unroll
                        for (int c = 0; c < 4; ++c) { const float g = acc[ai][0][m][n][c], up = acc[ai][1][m][n][c]; o[n * 4 + c] = g * up * __builtin_amdgcn_rcpf(1.f + __builtin_amdgcn_exp2f(-g * LOG2E)); }
                    u32x4 w; w.x = cvt_pk_bf16(o[0], o[1]); w.y = cvt_pk_bf16(o[2], o[3]); w.z = cvt_pk_bf16(o[4], o[5]); w.w = cvt_pk_bf16(o[6], o[7]);
                    *(u32x4*)(U + (size_t)slot * DEXP + col0) = w; } }
    }
};
struct EpiDown {
    static constexpr bool PERM = true;
    bf16_t* Y; const float* GV;
    __device__ __forceinline__ void operator()(const f32x4 (&acc)[2][2][4][2], const Unit& u, int wr, int wc, int fr, int fq, const PG8_LAS int* rowtab) const {
        const int col0 = u.pn * BM + wc * 32 + 8 * fq;
#pragma unroll
        for (int ai = 0; ai < 2; ++ai)
#pragma unroll
            for (int m = 0; m < 4; ++m) { const int slot = rowtab[u.tab * 256 + ai * HALF + wr * 64 + m * 16 + fr];
                if (slot >= 0) { const float gv = GV[slot];
#pragma unroll
                    for (int bj = 0; bj < 2; ++bj) { const f32x4 v0 = acc[ai][bj][m][0] * gv, v1 = acc[ai][bj][m][1] * gv;
                        u32x4 w; w.x = cvt_pk_bf16(v0[0], v0[1]); w.y = cvt_pk_bf16(v0[2], v0[3]); w.z = cvt_pk_bf16(v1[0], v1[1]); w.w = cvt_pk_bf16(v1[2], v1[3]);
                        *(u32x4*)(Y + (size_t)slot * DM + col0 + bj * HALF) = w; } } }
    }
};
}
namespace attn_body {
using bf16=__hip_bfloat16;
using bf16x8=__attribute__((ext_vector_type(8)))short;
using s16x4=__attribute__((ext_vector_type(4)))short;
using f32x16=__attribute__((ext_vector_type(16)))float;
using u32x4=__attribute__((ext_vector_type(4)))unsigned;
constexpr int D=64;
constexpr int NW=8,QBLK=32,QB=QBLK*NW,KVBLK=64,NQB=SEQ/QB;
constexpr int ATTN_PITCH=DM, ATTN_UNIT_ROWS=QB;
__device__ __forceinline__ int crow(int r,int hi){return (r&3)+8*(r>>2)+4*hi;}
#define SBAR() __builtin_amdgcn_sched_barrier(0)
__device__ __forceinline__ void cmask(f32x16&p0,f32x16&p1,int jb,int qrel,int hi){
  const float NEG=-INFINITY; int kb=64*jb+4*hi;
  #pragma unroll
  for(int r=0;r<16;++r){int kv=kb+(r&3)+8*(r>>2); if(kv>qrel)p0[r]=NEG; if(kv+32>qrel)p1[r]=NEG;}
}

constexpr int RT_OFFS=320, RT_SIZE=704;

template<int MODE> __device__ __forceinline__ void modtile_slow(f32x16&p0,f32x16&p1,int t,int q_abs,int hi,const __attribute__((address_space(3))) float* tab){
  const float NEG=-INFINITY; int hi4=4*hi; asm volatile("":"+v"(hi4),"+v"(q_abs));
  if(MODE==0){
    if(t==0){
      int bd=16+q_abs; bd=bd>383?383:bd; const __attribute__((address_space(3))) float* bp=tab+(RT_OFFS+bd-hi4-15);
      #pragma unroll
      for(int r=0;r<16;++r){ p1[r]=NEG; if(r<8)p0[r]+=bp[15-((r&3)+8*(r>>2))]; else p0[r]=NEG; }
    } else {
      const __attribute__((address_space(3))) float* bp=tab+(RT_OFFS+q_abs-64*t+KPRE-hi4-63);
      const int dq=q_abs-64*t+KPRE-hi4;
      #pragma unroll
      for(int r=0;r<16;++r){ const int c=(r&3)+8*(r>>2); p0[r]+=bp[63-c]; p1[r]+=bp[31-c]; if(c>dq)p0[r]=NEG; if(c+32>dq)p1[r]=NEG; }
    }
  } else {
    #pragma unroll
    for(int r=0;r<16;++r){
      #pragma unroll
      for(int hf=0;hf<2;++hf){
        const int js=32*hf+(r&3)+8*(r>>2)+hi4;
        const int ks=64*t+js;
        float x=hf?p1[r]:p0[r];
        if(t==0){ if(js>=NMETA)x=NEG; else x+=tab[ks]; }
        else { const int kr=ks-KPRE; if(kr>q_abs)x=NEG; else x+=tab[ks]; }
        if(hf)p1[r]=x; else p0[r]=x; }
      if((r&1)==1)asm volatile("":::"memory"); }
  }
}
__device__ __forceinline__ void modtile_fast1(f32x16&p0,f32x16&p1,int t,int hi,const __attribute__((address_space(3))) float* tab){
  typedef float f4 __attribute__((ext_vector_type(4)));
  const __attribute__((address_space(3))) f4* tp=(const __attribute__((address_space(3))) f4*)(tab+64*t+4*hi);
  #pragma unroll
  for(int g=0;g<4;++g){ const f4 a=tp[2*g], b=tp[8+2*g];
    #pragma unroll
    for(int c=0;c<4;++c){ p0[4*g+c]+=a[c]; p1[4*g+c]+=b[c]; } }
}
constexpr int NSLOT=3, SLOTB=8192;
constexpr int LDS_K=0, LDS_V=NSLOT*SLOTB, LDS_WS=2*NSLOT*SLOTB, LDS_OST=LDS_WS+NW*64*4, LDS_TAB=LDS_OST+NW*4096, LDS_BYTES=LDS_TAB+KROWS*4;
constexpr float C2=0.125f*1.4426950408889634f;
__device__ __forceinline__ void glds16(const void*gsrc,unsigned lds_dst){unsigned keep;
  asm volatile("s_mov_b32 %0, m0\n\ts_mov_b32 m0, %2\n\ts_nop 0\n\tglobal_load_lds_dwordx4 %1, off\n\ts_mov_b32 m0, %0":"=&s"(keep):"v"(gsrc),"s"(lds_dst):"memory");}
__device__ __forceinline__ float max3f(float a,float b,float c){float r;asm("v_max3_f32 %0, %1, %2, %3":"=v"(r):"v"(a),"v"(b),"v"(c));return r;}
__device__ __forceinline__ float max2f(float a,float b){float r;asm("v_max_f32_e32 %0, %1, %2":"=v"(r):"v"(a),"v"(b));return r;}
__device__ __forceinline__ float fadd_s(float a,float b){float r;asm("v_add_f32_e32 %0, %1, %2":"=v"(r):"v"(a),"v"(b));return r;}
__device__ __forceinline__ float fsub_s(float a,float b){float r;asm("v_sub_f32_e32 %0, %1, %2":"=v"(r):"v"(a),"v"(b));return r;}
typedef float f32x2_t __attribute__((ext_vector_type(2))); typedef __bf16 bf16x2_t __attribute__((ext_vector_type(2)));
__device__ __forceinline__ unsigned cvtpk_s(float lo,float hi){f32x2_t v={lo,hi};bf16x2_t b=__builtin_convertvector(v,bf16x2_t);return __builtin_bit_cast(unsigned,b);}
#define WAIT_BAR(N) asm volatile("s_waitcnt vmcnt(" #N ") lgkmcnt(0)\n\ts_barrier":::"memory")

__device__ __forceinline__ void qkt(f32x16&p0,f32x16&p1,const char*Kslot,const bf16x8*qr,const f32x16&negm,int r32,int hi){
  const char*kb=Kslot+hi*1024+r32*16;
  #pragma unroll
  for(int d0=0;d0<4;++d0){
    const bf16x8 b0=*reinterpret_cast<const bf16x8*>(kb+d0*2048);
    const bf16x8 b1=*reinterpret_cast<const bf16x8*>(kb+d0*2048+512);
    if(d0==0){p0=__builtin_amdgcn_mfma_f32_32x32x16_bf16(b0,qr[0],negm,0,0,0);p1=__builtin_amdgcn_mfma_f32_32x32x16_bf16(b1,qr[0],negm,0,0,0);}
    else{p0=__builtin_amdgcn_mfma_f32_32x32x16_bf16(b0,qr[d0],p0,0,0,0);p1=__builtin_amdgcn_mfma_f32_32x32x16_bf16(b1,qr[d0],p1,0,0,0);}}
}
typedef __attribute__((address_space(3))) const char* lds_cptr;
typedef short v4i16_t __attribute__((ext_vector_type(4)));
__device__ __forceinline__ void kload8(bf16x8*kf,lds_cptr kp){
  kf[0]=*(const __attribute__((address_space(3))) bf16x8*)(kp);      kf[1]=*(const __attribute__((address_space(3))) bf16x8*)(kp+512);
  kf[2]=*(const __attribute__((address_space(3))) bf16x8*)(kp+2048); kf[3]=*(const __attribute__((address_space(3))) bf16x8*)(kp+2560);
  kf[4]=*(const __attribute__((address_space(3))) bf16x8*)(kp+4096); kf[5]=*(const __attribute__((address_space(3))) bf16x8*)(kp+4608);
  kf[6]=*(const __attribute__((address_space(3))) bf16x8*)(kp+6144); kf[7]=*(const __attribute__((address_space(3))) bf16x8*)(kp+6656);
}
__device__ __forceinline__ void kload2(bf16x8*kf,lds_cptr kp,int j){ kf[2*j]=*(const __attribute__((address_space(3))) bf16x8*)(kp+j*2048); kf[2*j+1]=*(const __attribute__((address_space(3))) bf16x8*)(kp+j*2048+512); }
__device__ __forceinline__ s16x4 vtr(lds_cptr p){ return __builtin_bit_cast(s16x4,__builtin_amdgcn_ds_read_tr16_b64_v4i16((__attribute__((address_space(3))) v4i16_t*)p)); }
__device__ __forceinline__ float rowmax(const f32x16&p0,const f32x16&p1){
  float a=max3f(p0[0],p0[1],p1[0]),b=max3f(p0[2],p0[3],p1[1]);a=max3f(a,p1[2],p1[3]);
  #pragma unroll
  for(int r=4;r<16;r+=4){a=max3f(a,p0[r],p0[r+1]);b=max3f(b,p0[r+2],p0[r+3]);a=max3f(a,p1[r],p1[r+1]);b=max3f(b,p1[r+2],p1[r+3]);}
  const float m=max2f(a,b);
  auto rr=__builtin_amdgcn_permlane32_swap(__float_as_uint(m),__float_as_uint(m),false,false);
  return max2f(__uint_as_float(rr[0]),__uint_as_float(rr[1]));
}
__device__ __forceinline__ void pv(f32x16*o,int vb,bf16x8 pa0,bf16x8 pa1,bf16x8 pa2,bf16x8 pa3){
  #pragma unroll
  for(int d0=0;d0<2;++d0){s16x4 lo[4],hi[4];
    #pragma unroll
    for(int ks=0;ks<4;++ks){
      asm volatile("ds_read_b64_tr_b16 %0,%1 offset:%c2":"=&v"(lo[ks]):"v"(vb),"i"(d0*4096+ks*1024):"memory");
      asm volatile("ds_read_b64_tr_b16 %0,%1 offset:%c2":"=&v"(hi[ks]):"v"(vb),"i"(d0*4096+ks*1024+512):"memory");}
    asm volatile("s_waitcnt lgkmcnt(0)":::"memory");SBAR();
    #define PK(k) (bf16x8){lo[k][0],lo[k][1],lo[k][2],lo[k][3],hi[k][0],hi[k][1],hi[k][2],hi[k][3]}
    o[d0]=__builtin_amdgcn_mfma_f32_32x32x16_bf16(pa0,PK(0),o[d0],0,0,0);
    o[d0]=__builtin_amdgcn_mfma_f32_32x32x16_bf16(pa1,PK(1),o[d0],0,0,0);
    o[d0]=__builtin_amdgcn_mfma_f32_32x32x16_bf16(pa2,PK(2),o[d0],0,0,0);
    o[d0]=__builtin_amdgcn_mfma_f32_32x32x16_bf16(pa3,PK(3),o[d0],0,0,0);
    #undef PK
  }
}

#ifndef ATTN_STORE16
#define ATTN_STORE16(p,v) (*(u32x4*)(p)=(v))
#endif
template<int MODE,int THRL> __device__ __forceinline__ void attn_unit(int b,int qb,int tb,int cq,int cv,int co,const bf16*Q,const bf16*__restrict__ K,const bf16*__restrict__ V,bf16*O,const float*tabsrc,char*shm){
  int tid_=threadIdx.x; asm volatile("":"+v"(tid_));
  const int tid=tid_,lane=tid&63,r32=lane&31,hi=lane>>5; const int wid=__builtin_amdgcn_readfirstlane(tid>>6);
  const long rowbase=(long)b*SEQ, rowbase_k=(long)b*KROWS; const int q0=qb*QB;
  const bf16*Qw=Q+(rowbase+q0+wid*QBLK)*DM+cq;
  const bf16*Kh=K+rowbase_k*DM+cq,*Vh=V+rowbase_k*DM+cv;
  const unsigned lds0=(unsigned)(uintptr_t)shm;
  const __attribute__((address_space(3))) char* shm3_=(const __attribute__((address_space(3))) char*)shm;
  float*wsf=(float*)(shm+LDS_WS)+wid*64;
  const bf16*ksrc=Kh+(long)(lane+64*tb)*DM+wid*8;
  const bf16*vsrc=Vh+(long)(16*(wid&3)+(lane>>2)+64*tb)*DM+(wid>>2)*32+(lane&3)*8;
  const unsigned kdst=lds0+LDS_K+wid*1024, vdst=lds0+LDS_V+wid*1024;
  #define DMA_K(t,slot) glds16(ksrc+(long)(t)*KVBLK*DM,(unsigned)__builtin_amdgcn_readfirstlane(kdst+(slot)))
  #define DMA_V(t,slot) glds16(vsrc+(long)(t)*KVBLK*DM,(unsigned)__builtin_amdgcn_readfirstlane(vdst+(slot)))
  const int vb0=(int)(lds0+LDS_V)+((lane>>4)&1)*32+(lane&3)*8+(4*hi+((lane&15)>>2))*64;
  const char*Kbase=shm+LDS_K; bf16x8 kf[8];
  const lds_cptr shm3=(lds_cptr)shm; const lds_cptr kp0=shm3+LDS_K+hi*1024+r32*16; const lds_cptr vp0=shm3+LDS_V+((lane>>4)&1)*32+(lane&3)*8+(4*hi+((lane&15)>>2))*64;
  const int NT=(KPRE+q0+QB+KVBLK)/KVBLK-tb;
  const __attribute__((address_space(3))) float* tab=(const __attribute__((address_space(3))) float*)(shm3_+LDS_TAB);
  { __attribute__((address_space(3))) float* tw=(__attribute__((address_space(3))) float*)(shm3_+LDS_TAB);
    if(MODE==0){ for(int i=tid;i<RT_SIZE;i+=512){ const int d=i-RT_OFFS; tw[i]=d<0?-INFINITY:(d<128?tabsrc[d]:0.f); } }
    else { const int n=KPRE+q0+QB+KVBLK; for(int i=64*tb+tid*4;i<n;i+=2048){ const float4 v=*(const float4*)(tabsrc+i); tw[i]=v.x;tw[i+1]=v.y;tw[i+2]=v.z;tw[i+3]=v.w; } } }
  if(tb==0){ glds16(K+cq+(long)lane*DM+wid*8,(unsigned)__builtin_amdgcn_readfirstlane(kdst)); glds16(V+cv+(long)(16*(wid&3)+(lane>>2))*DM+(wid>>2)*32+(lane&3)*8,(unsigned)__builtin_amdgcn_readfirstlane(vdst)); } else { DMA_K(0,0); DMA_V(0,0); } DMA_K(1,SLOTB);
  bf16x8 qr[4];
  #pragma unroll
  for(int d0=0;d0<4;++d0)qr[d0]=*reinterpret_cast<const bf16x8*>(&Qw[(long)r32*DM+d0*16+hi*8]);
  float mhat=0.f,l_reg=0.f;f32x16 o[2];o[0]=f32x16{};o[1]=f32x16{};f32x16 negm=f32x16{};asm volatile("":"+v"(negm));
  const int qrel=wid*QBLK+r32, q_abs=q0+qrel;
  #define MODT(P0,P1,t,SL) do{ if(SL)modtile_slow<MODE>(P0,P1,(t)+tb,q_abs,hi,tab); else if(MODE==1)modtile_fast1(P0,P1,(t)+tb,hi,tab); }while(0)
  bool resc=false;
  #define START(P0,P1) do{ const float rm=rowmax(P0,P1); resc=false; \
    { const float dl=(MODE==1)?__builtin_fmaxf(rm,0.f):rm; mhat=fadd_s(mhat,dl); \
      _Pragma("unroll") for(int r=0;r<16;++r){P0[r]=fsub_s(P0[r],dl);P1[r]=fsub_s(P1[r],dl);} \
      _Pragma("unroll") for(int r=0;r<16;++r)negm[r]=-mhat; asm volatile("":"+v"(negm)); } \
    _Pragma("unroll") for(int r=0;r<16;++r)P0[r]=__builtin_amdgcn_exp2f(P0[r]); }while(0)
  #define RESC() do{ if(resc){ asm volatile("s_waitcnt lgkmcnt(0)":::"memory"); \
      _Pragma("unroll") for(int d_=0;d_<2;++d_) _Pragma("unroll") for(int r=0;r<16;++r)o[d_][r]*=wsf[crow(r,hi)]; } }while(0)
  f32x16 pA0,pA1,pB0,pB1;
  int sl_prev=0,sl_cur=0,sl_next=SLOTB;
  #define ROT() do{sl_prev=sl_cur;sl_cur=sl_next;sl_next=(sl_next==(NSLOT-1)*SLOTB)?0:sl_next+SLOTB;}while(0)
  DMA_K(2,2*SLOTB);
  WAIT_BAR(3);
  if(MODE==1){ mhat=tab[KPRE+q_abs]; _Pragma("unroll") for(int r=0;r<16;++r)negm[r]=-mhat; asm volatile("":"+v"(negm)); }
  qkt(pA0,pA1,Kbase,qr,negm,r32,hi);asm volatile("s_nop 15\n\ts_nop 7":"+v"(pA0),"+v"(pA1));MODT(pA0,pA1,0,true);
  START(pA0,pA1);
  _Pragma("unroll") for(int r=0;r<16;++r)pA1[r]=__builtin_amdgcn_exp2f(pA1[r]);
  WAIT_BAR(0);
  DMA_K(3,0);DMA_V(1,SLOTB);
  ROT();
  kload8(kf,kp0+sl_cur);
  WAIT_BAR(2);
  s16x4 vlo[8],vhi[8]; u32x4 pw0,pw1,pw2,pw3;
  #define PKW(P,B) cvtpk_s(P[B],P[B+1])
  #define PAF(k) __builtin_bit_cast(bf16x8,pw##k)
  #define VFR(i) (bf16x8){vlo[i][0],vlo[i][1],vlo[i][2],vlo[i][3],vhi[i][0],vhi[i][1],vhi[i][2],vhi[i][3]}
  #define PIN(x) asm volatile("":"+v"(x))
  #define MX3(a,b,c) __builtin_fmaxf(__builtin_fmaxf((a),(b)),(c))
  #define GAPA(MF,A0,A1,A2,A3,W0,W1,PW) do{ MF; sacc+=A0; sacc+=A1; sacc+=A2; sacc+=A3; PIN(sacc); W0; W1; PIN(PW); SBAR(); }while(0)
  #define EX(v) __builtin_amdgcn_exp2f(v)
  #define GAPB(MF,X,B) do{ MF; X[B]=EX(X[B]); X[B+1]=EX(X[B+1]); X[B+2]=EX(X[B+2]); X[B+3]=EX(X[B+3]); PIN(X); SBAR(); }while(0)
  #define VRD(i) do{ vlo[i]=vtr(vp_+(((i)>>2)*4096+((i)&3)*1024)); vhi[i]=vtr(vp_+(((i)>>2)*4096+((i)&3)*1024+512)); }while(0)
  #define KRD(G,j) do{ if(G){ kload2(kf,kp0+sl_next,j); SBAR(); } }while(0)
  #define STEP(C0,C1,P0,P1,t,GK,GV,GL,SL) do{ SBAR(); \
    const lds_cptr vp_=vp0+sl_prev; \
    VRD(0); SBAR(); float sacc=(P0[0]+P0[1]); \
    GAPA(C0=__builtin_amdgcn_mfma_f32_32x32x16_bf16(kf[0],qr[0],negm,0,0,0), P0[2],P0[3],P0[4],P0[5],     pw0[0]=PKW(P0,0), pw0[1]=PKW(P0,2), pw0); \
    VRD(4); SBAR(); GAPA(C1=__builtin_amdgcn_mfma_f32_32x32x16_bf16(kf[1],qr[0],negm,0,0,0), P0[6],P0[7],P0[8],P0[9],     pw0[2]=PKW(P0,4), pw0[3]=PKW(P0,6), pw0); \
    VRD(1); SBAR(); GAPA(C0=__builtin_amdgcn_mfma_f32_32x32x16_bf16(kf[2],qr[1],C0,0,0,0),   P0[10],P0[11],P0[12],P0[13], pw1[0]=PKW(P0,8), pw1[1]=PKW(P0,10), pw1); \
    VRD(5); SBAR(); GAPA(C1=__builtin_amdgcn_mfma_f32_32x32x16_bf16(kf[3],qr[1],C1,0,0,0),   P0[14],P0[15],P1[0],P1[1],   pw1[2]=PKW(P0,12),pw1[3]=PKW(P0,14), pw1); \
    VRD(2); SBAR(); GAPA(C0=__builtin_amdgcn_mfma_f32_32x32x16_bf16(kf[4],qr[2],C0,0,0,0),   P1[2],P1[3],P1[4],P1[5],     pw2[0]=PKW(P1,0), pw2[1]=PKW(P1,2), pw2); \
    VRD(6); SBAR(); GAPA(C1=__builtin_amdgcn_mfma_f32_32x32x16_bf16(kf[5],qr[2],C1,0,0,0),   P1[6],P1[7],P1[8],P1[9],     pw2[2]=PKW(P1,4), pw2[3]=PKW(P1,6), pw2); \
    VRD(3); SBAR(); GAPA(C0=__builtin_amdgcn_mfma_f32_32x32x16_bf16(kf[6],qr[3],C0,0,0,0),   P1[10],P1[11],P1[12],P1[13], pw3[0]=PKW(P1,8), pw3[1]=PKW(P1,10), pw3); \
    VRD(7); SBAR(); GAPA(C1=__builtin_amdgcn_mfma_f32_32x32x16_bf16(kf[7],qr[3],C1,0,0,0),   P1[14],P1[15],0.f,0.f,       pw3[2]=PKW(P1,12),pw3[3]=PKW(P1,14), pw3); \
    l_reg+=sacc; \
    if(GK){DMA_K((t)+3,sl_cur);} if(GV){DMA_V((t)+1,sl_next);} \
    MODT(C0,C1,t,SL); \
    { float a=MX3(C0[0],C0[1],C1[0]),b=MX3(C0[2],C0[3],C1[1]); a=MX3(a,C1[2],C1[3]); \
      _Pragma("unroll") for(int r=4;r<16;r+=4){a=MX3(a,C0[r],C0[r+1]);b=MX3(b,C0[r+2],C0[r+3]);a=MX3(a,C1[r],C1[r+1]);b=MX3(b,C1[r+2],C1[r+3]);} \
      float rm=__builtin_fmaxf(a,b); { auto rr=__builtin_amdgcn_permlane32_swap(__float_as_uint(rm),__float_as_uint(rm),false,false); rm=__builtin_fmaxf(__uint_as_float(rr[0]),__uint_as_float(rr[1])); } \
      resc=false; \
      if(__builtin_expect(__any(rm>(float)THRL),0)){ const float dl=__builtin_fmaxf(rm,0.f); mhat+=dl; \
        _Pragma("unroll") for(int r=0;r<16;++r){C0[r]-=dl;C1[r]-=dl;} \
        _Pragma("unroll") for(int r=0;r<16;++r)negm[r]=-mhat; asm volatile("":"+v"(negm)); \
        const float f=__builtin_amdgcn_exp2f(-dl); l_reg*=f; if(hi==0)wsf[r32]=f; resc=true; } } \
    SBAR(); \
    GAPB(o[0]=__builtin_amdgcn_mfma_f32_32x32x16_bf16(PAF(0),VFR(0),o[0],0,0,0), C0,0); \
    GAPB(o[1]=__builtin_amdgcn_mfma_f32_32x32x16_bf16(PAF(0),VFR(4),o[1],0,0,0), C0,4); \
    KRD(GL,0); GAPB(o[0]=__builtin_amdgcn_mfma_f32_32x32x16_bf16(PAF(1),VFR(1),o[0],0,0,0), C0,8); \
    KRD(GL,1); GAPB(o[1]=__builtin_amdgcn_mfma_f32_32x32x16_bf16(PAF(1),VFR(5),o[1],0,0,0), C0,12); \
    KRD(GL,2); GAPB(o[0]=__builtin_amdgcn_mfma_f32_32x32x16_bf16(PAF(2),VFR(2),o[0],0,0,0), C1,0); \
    KRD(GL,3); GAPB(o[1]=__builtin_amdgcn_mfma_f32_32x32x16_bf16(PAF(2),VFR(6),o[1],0,0,0), C1,4); \
    GAPB(o[0]=__builtin_amdgcn_mfma_f32_32x32x16_bf16(PAF(3),VFR(3),o[0],0,0,0), C1,8); \
    GAPB(o[1]=__builtin_amdgcn_mfma_f32_32x32x16_bf16(PAF(3),VFR(7),o[1],0,0,0), C1,12); \
    }while(0)
  int t=1;
  #define ENDW(tt) do{ if((tt)+3<NT){WAIT_BAR(2);} else if((tt)+2<NT){WAIT_BAR(1);} else {WAIT_BAR(0);} }while(0)
  for(;t+7<NT;t+=2){
    STEP(pB0,pB1,pA0,pA1,t,true,true,true,false);     WAIT_BAR(2); RESC(); ROT();
    STEP(pA0,pA1,pB0,pB1,t+1,true,true,true,false);   WAIT_BAR(2); RESC(); ROT();
  }
  for(;t+1<NT;t+=2){
    STEP(pB0,pB1,pA0,pA1,t,(t+3<NT),(t+1<NT),(t+1<NT),true);       ENDW(t);   RESC(); ROT();
    STEP(pA0,pA1,pB0,pB1,t+1,(t+4<NT),(t+2<NT),(t+2<NT),true);     ENDW(t+1); RESC(); ROT();
  }
  STEP(pB0,pB1,pA0,pA1,NT-1,false,false,false,true); RESC();
  { float sacc=pB0[0]+pB0[1]; _Pragma("unroll") for(int r=2;r<16;++r)sacc+=pB0[r]; _Pragma("unroll") for(int r=0;r<16;++r)sacc+=pB1[r]; l_reg+=sacc;
    pw0=(u32x4){PKW(pB0,0),PKW(pB0,2),PKW(pB0,4),PKW(pB0,6)};pw1=(u32x4){PKW(pB0,8),PKW(pB0,10),PKW(pB0,12),PKW(pB0,14)};pw2=(u32x4){PKW(pB1,0),PKW(pB1,2),PKW(pB1,4),PKW(pB1,6)};pw3=(u32x4){PKW(pB1,8),PKW(pB1,10),PKW(pB1,12),PKW(pB1,14)};
    SBAR(); pv(o,vb0+sl_cur,PAF(0),PAF(1),PAF(2),PAF(3)); }
  #undef PKW
  #undef PAF
  #undef VFR
  #undef PIN
  #undef MX3
  #undef GAPA
  #undef GAPB
  #undef EX
  #undef VRD
  #undef KRD
  #undef STEP
  #undef ENDW
  {auto rr=__builtin_amdgcn_permlane32_swap(__float_as_uint(l_reg),__float_as_uint(l_reg),false,false);l_reg=__uint_as_float(rr[0])+__uint_as_float(rr[1]);}
  if(hi==0)wsf[32+r32]=l_reg;asm volatile("s_waitcnt lgkmcnt(0)":::"memory");
  float rli[16];
  #pragma unroll
  for(int r=0;r<16;++r)rli[r]=__builtin_amdgcn_rcpf(wsf[32+crow(r,hi)]);
  bf16*Ow=O+(rowbase+q0+wid*QBLK)*DM+co;
  { bf16*stg=(bf16*)(shm+LDS_OST)+wid*2048;
    #pragma unroll
    for(int r=0;r<16;++r){const int orow=crow(r,hi);
      #pragma unroll
      for(int d0=0;d0<2;++d0)stg[orow*64+d0*32+r32]=__float2bfloat16(o[d0][r]*rli[r]);}
    asm volatile("s_waitcnt lgkmcnt(0)":::"memory");
    #pragma unroll
    for(int i=0;i<4;++i){const int row=i*8+(lane>>3),ch=lane&7; const u32x4 v=*(const u32x4*)(stg+row*64+ch*8); ATTN_STORE16(Ow+(long)row*DM+ch*8,v);} }
  asm volatile("s_waitcnt lgkmcnt(0)\n\ts_barrier":::"memory");
  #undef DMA_K
  #undef DMA_V
  #undef MODT
  #undef START
  #undef RESC
  #undef ROT
}

template<int THRL> __device__ __forceinline__ void attn_unit_dv(int b,int qb,int cq,int cv,int co,const bf16*Q,const bf16*__restrict__ K,const bf16*__restrict__ V,bf16*O,const float*tabsrc,char*shm){
  int tid_=threadIdx.x; asm volatile("":"+v"(tid_));
  constexpr int MODE=0, tb=0; const int tid=tid_,lane=tid&63,r32=lane&31,hi=lane>>5; const int wid=__builtin_amdgcn_readfirstlane(tid>>6);
  constexpr int LDS_K=0, LDS_V=NSLOT*SLOTB, LDS_WS=LDS_V+NSLOT*2*SLOTB, LDS_OST=LDS_WS+NW*64*4, LDS_TAB=LDS_OST+NW*4096;
  static_assert(LDS_TAB+RT_SIZE*4<=131072,"dv LDS map");
  const long rowbase=(long)b*SEQ, rowbase_k=(long)b*KROWS; const int q0=qb*QB;
  const bf16*Qw=Q+(rowbase+q0+wid*QBLK)*DM+cq;
  const bf16*Kh=K+rowbase_k*DM+cq,*Vh=V+rowbase_k*DM+cv;
  const unsigned lds0=(unsigned)(uintptr_t)shm;
  const __attribute__((address_space(3))) char* shm3_=(const __attribute__((address_space(3))) char*)shm;
  float*wsf=(float*)(shm+LDS_WS)+wid*64;
  const bf16*ksrc=Kh+(long)(lane+64*tb)*DM+wid*8;
  const bf16*vsrc=Vh+(long)(16*(wid&3)+(lane>>2)+64*tb)*DM+(wid>>2)*32+(lane&3)*8;
  const unsigned kdst=lds0+LDS_K+wid*1024, vdst=lds0+LDS_V+wid*1024;
  #define DMA_K(t,slot) glds16(ksrc+(long)(t)*KVBLK*DM,(unsigned)__builtin_amdgcn_readfirstlane(kdst+(slot)))
  #define DMA_V(t,slot) do{ glds16(vsrc+(long)(t)*KVBLK*DM,(unsigned)__builtin_amdgcn_readfirstlane(vdst+2*(slot))); glds16(vsrc+(long)(t)*KVBLK*DM+64,(unsigned)__builtin_amdgcn_readfirstlane(vdst+2*(slot)+8192)); }while(0)
  const int vb0=(int)(lds0+LDS_V)+((lane>>4)&1)*32+(lane&3)*8+(4*hi+((lane&15)>>2))*64;
  const char*Kbase=shm+LDS_K; bf16x8 kf[8];
  const lds_cptr shm3=(lds_cptr)shm; const lds_cptr kp0=shm3+LDS_K+hi*1024+r32*16; const lds_cptr vp0=shm3+LDS_V+((lane>>4)&1)*32+(lane&3)*8+(4*hi+((lane&15)>>2))*64;
  const int NT=(KPRE+q0+QB+KVBLK)/KVBLK-tb;
  const __attribute__((address_space(3))) float* tab=(const __attribute__((address_space(3))) float*)(shm3_+LDS_TAB);
  { __attribute__((address_space(3))) float* tw=(__attribute__((address_space(3))) float*)(shm3_+LDS_TAB);
    if(MODE==0){ for(int i=tid;i<RT_SIZE;i+=512){ const int d=i-RT_OFFS; tw[i]=d<0?-INFINITY:(d<128?tabsrc[d]:0.f); } }
    else { const int n=KPRE+q0+QB+KVBLK; for(int i=64*tb+tid*4;i<n;i+=2048){ const float4 v=*(const float4*)(tabsrc+i); tw[i]=v.x;tw[i+1]=v.y;tw[i+2]=v.z;tw[i+3]=v.w; } } }
  if(tb==0){ glds16(K+cq+(long)lane*DM+wid*8,(unsigned)__builtin_amdgcn_readfirstlane(kdst)); glds16(V+cv+(long)(16*(wid&3)+(lane>>2))*DM+(wid>>2)*32+(lane&3)*8,(unsigned)__builtin_amdgcn_readfirstlane(vdst)); glds16(V+cv+(long)(16*(wid&3)+(lane>>2))*DM+(wid>>2)*32+(lane&3)*8+64,(unsigned)__builtin_amdgcn_readfirstlane(vdst+8192)); } else { DMA_K(0,0); DMA_V(0,0); } DMA_K(1,SLOTB);
  bf16x8 qr[4];
  #pragma unroll
  for(int d0=0;d0<4;++d0)qr[d0]=*reinterpret_cast<const bf16x8*>(&Qw[(long)r32*DM+d0*16+hi*8]);
  float mhat=0.f,l_reg=0.f;f32x16 o[4];o[0]=f32x16{};o[1]=f32x16{};o[2]=f32x16{};o[3]=f32x16{};const f32x16 zero16=f32x16{};
  const int qrel=wid*QBLK+r32, q_abs=q0+qrel;
  #define MODT(P0,P1,t,SL) do{ if(SL)modtile_slow<MODE>(P0,P1,(t)+tb,q_abs,hi,tab); else if(MODE==1)modtile_fast1(P0,P1,(t)+tb,hi,tab); }while(0)
  bool resc=false;
  #define START(P0,P1) do{ const float rm=rowmax(P0,P1); resc=false; mhat=rm; \
    _Pragma("unroll") for(int r=0;r<16;++r)P0[r]=__builtin_amdgcn_exp2f(P0[r]-mhat); }while(0)
  #define RESC() do{ if(resc){ asm volatile("s_waitcnt lgkmcnt(0)":::"memory"); \
      _Pragma("unroll") for(int d_=0;d_<4;++d_) _Pragma("unroll") for(int r=0;r<16;++r)o[d_][r]*=wsf[crow(r,hi)]; } }while(0)
  f32x16 pA0,pA1,pB0,pB1;
  int sl_prev=0,sl_cur=0,sl_next=SLOTB;
  #define ROT() do{sl_prev=sl_cur;sl_cur=sl_next;sl_next=(sl_next==(NSLOT-1)*SLOTB)?0:sl_next+SLOTB;}while(0)
  DMA_K(2,2*SLOTB);
  WAIT_BAR(3);
  qkt(pA0,pA1,Kbase,qr,zero16,r32,hi);asm volatile("s_nop 15\n\ts_nop 7":"+v"(pA0),"+v"(pA1));MODT(pA0,pA1,0,true);
  START(pA0,pA1);
  _Pragma("unroll") for(int r=0;r<16;++r)pA1[r]=__builtin_amdgcn_exp2f(pA1[r]-mhat);
  WAIT_BAR(0);
  DMA_K(3,0);DMA_V(1,SLOTB);
  ROT();
  kload8(kf,kp0+sl_cur);
  WAIT_BAR(3);
  s16x4 vlo[8],vhi[8],wlo[8],whi[8]; u32x4 pw0,pw1,pw2,pw3;
  #define PKW(P,B) cvtpk_s(P[B],P[B+1])
  #define PAF(k) __builtin_bit_cast(bf16x8,pw##k)
  #define VFR(i) (bf16x8){vlo[i][0],vlo[i][1],vlo[i][2],vlo[i][3],vhi[i][0],vhi[i][1],vhi[i][2],vhi[i][3]}
  #define WFR(i) (bf16x8){wlo[i][0],wlo[i][1],wlo[i][2],wlo[i][3],whi[i][0],whi[i][1],whi[i][2],whi[i][3]}
  #define WRD(i) do{ wlo[i]=vtr(vp_+((2+((i)>>2))*4096+((i)&3)*1024)); whi[i]=vtr(vp_+((2+((i)>>2))*4096+((i)&3)*1024+512)); SBAR(); }while(0)
  #define GAPB2(MF,X,B) do{ MF; X[B]=EX(X[B]-mhat); X[B+1]=EX(X[B+1]-mhat); PIN(X); SBAR(); }while(0)
  #define PIN(x) asm volatile("":"+v"(x))
  #define MX3(a,b,c) __builtin_fmaxf(__builtin_fmaxf((a),(b)),(c))
  #define GAPA(MF,A0,A1,A2,A3,W0,W1,PW) do{ MF; sacc+=A0; sacc+=A1; sacc+=A2; sacc+=A3; PIN(sacc); W0; W1; PIN(PW); SBAR(); }while(0)
  #define EX(v) __builtin_amdgcn_exp2f(v)
  #define GAPB(MF,X,B) do{ MF; X[B]=EX(X[B]); X[B+1]=EX(X[B+1]); X[B+2]=EX(X[B+2]); X[B+3]=EX(X[B+3]); PIN(X); SBAR(); }while(0)
  #define VRD(i) do{ vlo[i]=vtr(vp_+(((i)>>2)*4096+((i)&3)*1024)); vhi[i]=vtr(vp_+(((i)>>2)*4096+((i)&3)*1024+512)); }while(0)
  #define KRD(G,j) do{ if(G){ kload2(kf,kp0+sl_next,j); SBAR(); } }while(0)
  #define STEP(C0,C1,P0,P1,t,GK,GV,GL,SL) do{ SBAR(); \
    const lds_cptr vp_=vp0+2*sl_prev; \
    VRD(0); SBAR(); float sacc=(P0[0]+P0[1]); \
    GAPA(C0=__builtin_amdgcn_mfma_f32_32x32x16_bf16(kf[0],qr[0],zero16,0,0,0), P0[2],P0[3],P0[4],P0[5],     pw0[0]=PKW(P0,0), pw0[1]=PKW(P0,2), pw0); \
    VRD(4); SBAR(); GAPA(C1=__builtin_amdgcn_mfma_f32_32x32x16_bf16(kf[1],qr[0],zero16,0,0,0), P0[6],P0[7],P0[8],P0[9],     pw0[2]=PKW(P0,4), pw0[3]=PKW(P0,6), pw0); \
    VRD(1); SBAR(); GAPA(C0=__builtin_amdgcn_mfma_f32_32x32x16_bf16(kf[2],qr[1],C0,0,0,0),   P0[10],P0[11],P0[12],P0[13], pw1[0]=PKW(P0,8), pw1[1]=PKW(P0,10), pw1); \
    VRD(5); SBAR(); GAPA(C1=__builtin_amdgcn_mfma_f32_32x32x16_bf16(kf[3],qr[1],C1,0,0,0),   P0[14],P0[15],P1[0],P1[1],   pw1[2]=PKW(P0,12),pw1[3]=PKW(P0,14), pw1); \
    VRD(2); SBAR(); GAPA(C0=__builtin_amdgcn_mfma_f32_32x32x16_bf16(kf[4],qr[2],C0,0,0,0),   P1[2],P1[3],P1[4],P1[5],     pw2[0]=PKW(P1,0), pw2[1]=PKW(P1,2), pw2); \
    VRD(6); SBAR(); GAPA(C1=__builtin_amdgcn_mfma_f32_32x32x16_bf16(kf[5],qr[2],C1,0,0,0),   P1[6],P1[7],P1[8],P1[9],     pw2[2]=PKW(P1,4), pw2[3]=PKW(P1,6), pw2); \
    VRD(3); SBAR(); GAPA(C0=__builtin_amdgcn_mfma_f32_32x32x16_bf16(kf[6],qr[3],C0,0,0,0),   P1[10],P1[11],P1[12],P1[13], pw3[0]=PKW(P1,8), pw3[1]=PKW(P1,10), pw3); \
    VRD(7); SBAR(); GAPA(C1=__builtin_amdgcn_mfma_f32_32x32x16_bf16(kf[7],qr[3],C1,0,0,0),   P1[14],P1[15],0.f,0.f,       pw3[2]=PKW(P1,12),pw3[3]=PKW(P1,14), pw3); \
    l_reg+=sacc; \
    if(GK){DMA_K((t)+3,sl_cur);} if(GV){DMA_V((t)+1,sl_next);} \
    MODT(C0,C1,t,SL); \
    { float a=MX3(C0[0],C0[1],C1[0]),b=MX3(C0[2],C0[3],C1[1]); a=MX3(a,C1[2],C1[3]); \
      _Pragma("unroll") for(int r=4;r<16;r+=4){a=MX3(a,C0[r],C0[r+1]);b=MX3(b,C0[r+2],C0[r+3]);a=MX3(a,C1[r],C1[r+1]);b=MX3(b,C1[r+2],C1[r+3]);} \
      float rm=__builtin_fmaxf(a,b); { auto rr=__builtin_amdgcn_permlane32_swap(__float_as_uint(rm),__float_as_uint(rm),false,false); rm=__builtin_fmaxf(__uint_as_float(rr[0]),__uint_as_float(rr[1])); } \
      resc=false; \
      const float rmd=rm-mhat; \
      if(__builtin_expect(__any(rmd>(float)THRL),0)){ const float dl=__builtin_fmaxf(rmd,0.f); mhat+=dl; \
        const float f=__builtin_amdgcn_exp2f(-dl); l_reg*=f; if(hi==0)wsf[r32]=f; resc=true; } } \
    SBAR(); \
    WRD(0); GAPB2(o[0]=__builtin_amdgcn_mfma_f32_32x32x16_bf16(PAF(0),VFR(0),o[0],0,0,0), C0,0); \
    WRD(4); GAPB2(o[1]=__builtin_amdgcn_mfma_f32_32x32x16_bf16(PAF(0),VFR(4),o[1],0,0,0), C0,2); \
    WRD(1); GAPB2(o[0]=__builtin_amdgcn_mfma_f32_32x32x16_bf16(PAF(1),VFR(1),o[0],0,0,0), C0,4); \
    WRD(5); GAPB2(o[1]=__builtin_amdgcn_mfma_f32_32x32x16_bf16(PAF(1),VFR(5),o[1],0,0,0), C0,6); \
    WRD(2); GAPB2(o[0]=__builtin_amdgcn_mfma_f32_32x32x16_bf16(PAF(2),VFR(2),o[0],0,0,0), C0,8); \
    WRD(6); GAPB2(o[1]=__builtin_amdgcn_mfma_f32_32x32x16_bf16(PAF(2),VFR(6),o[1],0,0,0), C0,10); \
    WRD(3); GAPB2(o[0]=__builtin_amdgcn_mfma_f32_32x32x16_bf16(PAF(3),VFR(3),o[0],0,0,0), C0,12); \
    WRD(7); GAPB2(o[1]=__builtin_amdgcn_mfma_f32_32x32x16_bf16(PAF(3),VFR(7),o[1],0,0,0), C0,14); \
    KRD(GL,0); GAPB2(o[2]=__builtin_amdgcn_mfma_f32_32x32x16_bf16(PAF(0),WFR(0),o[2],0,0,0), C1,0); \
    KRD(GL,1); GAPB2(o[3]=__builtin_amdgcn_mfma_f32_32x32x16_bf16(PAF(0),WFR(4),o[3],0,0,0), C1,2); \
    KRD(GL,2); GAPB2(o[2]=__builtin_amdgcn_mfma_f32_32x32x16_bf16(PAF(1),WFR(1),o[2],0,0,0), C1,4); \
    KRD(GL,3); GAPB2(o[3]=__builtin_amdgcn_mfma_f32_32x32x16_bf16(PAF(1),WFR(5),o[3],0,0,0), C1,6); \
    GAPB2(o[2]=__builtin_amdgcn_mfma_f32_32x32x16_bf16(PAF(2),WFR(2),o[2],0,0,0), C1,8); \
    GAPB2(o[3]=__builtin_amdgcn_mfma_f32_32x32x16_bf16(PAF(2),WFR(6),o[3],0,0,0), C1,10); \
    GAPB2(o[2]=__builtin_amdgcn_mfma_f32_32x32x16_bf16(PAF(3),WFR(3),o[2],0,0,0), C1,12); \
    GAPB2(o[3]=__builtin_amdgcn_mfma_f32_32x32x16_bf16(PAF(3),WFR(7),o[3],0,0,0), C1,14); \
    }while(0)
  int t=1;
  #define ENDW(tt) do{ if((tt)+3<NT){WAIT_BAR(3);} else if((tt)+2<NT){WAIT_BAR(2);} else {WAIT_BAR(0);} }while(0)
  for(;t+7<NT;t+=2){
    STEP(pB0,pB1,pA0,pA1,t,true,true,true,false);     WAIT_BAR(3); RESC(); ROT();
    STEP(pA0,pA1,pB0,pB1,t+1,true,true,true,false);   WAIT_BAR(3); RESC(); ROT();
  }
  for(;t+1<NT;t+=2){
    STEP(pB0,pB1,pA0,pA1,t,(t+3<NT),(t+1<NT),(t+1<NT),true);       ENDW(t);   RESC(); ROT();
    STEP(pA0,pA1,pB0,pB1,t+1,(t+4<NT),(t+2<NT),(t+2<NT),true);     ENDW(t+1); RESC(); ROT();
  }
  STEP(pB0,pB1,pA0,pA1,NT-1,false,false,false,true); RESC();
  { float sacc=pB0[0]+pB0[1]; _Pragma("unroll") for(int r=2;r<16;++r)sacc+=pB0[r]; _Pragma("unroll") for(int r=0;r<16;++r)sacc+=pB1[r]; l_reg+=sacc;
    pw0=(u32x4){PKW(pB0,0),PKW(pB0,2),PKW(pB0,4),PKW(pB0,6)};pw1=(u32x4){PKW(pB0,8),PKW(pB0,10),PKW(pB0,12),PKW(pB0,14)};pw2=(u32x4){PKW(pB1,0),PKW(pB1,2),PKW(pB1,4),PKW(pB1,6)};pw3=(u32x4){PKW(pB1,8),PKW(pB1,10),PKW(pB1,12),PKW(pB1,14)};
    SBAR(); pv(o,vb0+2*sl_cur,PAF(0),PAF(1),PAF(2),PAF(3)); pv(o+2,vb0+2*sl_cur+8192,PAF(0),PAF(1),PAF(2),PAF(3)); }
  #undef PKW
  #undef PAF
  #undef VFR
  #undef PIN
  #undef MX3
  #undef GAPA
  #undef GAPB
  #undef EX
  #undef VRD
  #undef WRD
  #undef WFR
  #undef GAPB2
  #undef KRD
  #undef STEP
  #undef ENDW
  {auto rr=__builtin_amdgcn_permlane32_swap(__float_as_uint(l_reg),__float_as_uint(l_reg),false,false);l_reg=__uint_as_float(rr[0])+__uint_as_float(rr[1]);}
  if(hi==0)wsf[32+r32]=l_reg;asm volatile("s_waitcnt lgkmcnt(0)":::"memory");
  float rli[16];
  #pragma unroll
  for(int r=0;r<16;++r)rli[r]=__builtin_amdgcn_rcpf(wsf[32+crow(r,hi)]);
  bf16*Ow=O+(rowbase+q0+wid*QBLK)*DM+co;
  { bf16*stg=(bf16*)(shm+LDS_OST)+wid*2048;
    #pragma unroll
    for(int ps=0;ps<2;++ps){
      #pragma unroll
      for(int r=0;r<16;++r){const int orow=crow(r,hi);
        #pragma unroll
        for(int d0=0;d0<2;++d0)stg[orow*64+d0*32+r32]=__float2bfloat16(o[2*ps+d0][r]*rli[r]);}
      asm volatile("s_waitcnt lgkmcnt(0)":::"memory");
      #pragma unroll
      for(int i=0;i<4;++i){const int row=i*8+(lane>>3),ch=lane&7; const u32x4 v=*(const u32x4*)(stg+row*64+ch*8); ATTN_STORE16(Ow+(long)row*DM+ps*64+ch*8,v);}
      asm volatile("s_waitcnt lgkmcnt(0)":::"memory"); } }
  asm volatile("s_waitcnt lgkmcnt(0)\n\ts_barrier":::"memory");
  #undef DMA_K
  #undef DMA_V
  #undef MODT
  #undef START
  #undef RESC
  #undef ROT
}
constexpr int ATTN_LDS_BYTES=LDS_BYTES;
#undef SBAR
#undef WAIT_BAR
}
#define GAS __attribute__((address_space(1)))
#define LAS __attribute__((address_space(3)))
typedef unsigned short bf16;
typedef unsigned v4u __attribute__((ext_vector_type(4)));
typedef float f32x4 __attribute__((ext_vector_type(4)));
typedef short bf16x8 __attribute__((ext_vector_type(8)));
typedef GAS unsigned gu32;
typedef GAS unsigned long long gu64;
#define RLX_AGENT __ATOMIC_RELAXED, __HIP_MEMORY_SCOPE_AGENT
#define LDS_WAIT() asm volatile("s_waitcnt lgkmcnt(0)" ::: "memory")
#define VM_WAIT() asm volatile("s_waitcnt vmcnt(0)" ::: "memory")
__device__ __forceinline__ unsigned long long rt() { return __builtin_amdgcn_s_memrealtime(); }
__device__ __forceinline__ unsigned f2bf(float f) { unsigned u = __builtin_bit_cast(unsigned, f); return (u + 0x7fffu + ((u >> 16) & 1u)) >> 16; }
__device__ __forceinline__ unsigned pk2(float lo, float hi) { return f2bf(lo) | (f2bf(hi) << 16); }

#define XB_TMO      128
#define XB_XCNT(j)  (256  + 64 * (j))
#define XB_XSUB(j)  (1280 + 64 * (j))
#define XB_XGEN(j)  (2304 + 64 * (j))
#define XB_TOP      3328
#define XB_TOPGEN   3392
#define XCD_BAR_WORDS 3456
#define XB_SPIN_CAP (1u << 18)

__device__ __forceinline__ unsigned xb_ld(unsigned* p)              { return __hip_atomic_load(p, __ATOMIC_RELAXED, __HIP_MEMORY_SCOPE_AGENT); }
__device__ __forceinline__ unsigned xb_add(unsigned* p, unsigned v) { return __hip_atomic_fetch_add(p, v, __ATOMIC_RELAXED, __HIP_MEMORY_SCOPE_AGENT); }
__device__ __forceinline__ unsigned xb_xcc_id() { return (unsigned)__builtin_amdgcn_s_getreg((3 << 11) | 20) & 0xFu; }
#define XB_SPIN(cond, bar) do { unsigned _sp = 0; while (cond) { __builtin_amdgcn_s_sleep(1); \
    if ((++_sp & 255u) == 0u) { if (xb_ld(&(bar)[XB_TMO])) break; if (_sp > XB_SPIN_CAP) { atomicAdd(&(bar)[XB_TMO], 1u); break; } } } } while (0)

struct XcdBarrier {
    unsigned* bar; unsigned x;
    volatile LAS unsigned* st;
};

__device__ __forceinline__ XcdBarrier xcd_barrier_post(unsigned* bar, volatile LAS unsigned* st) {
    XcdBarrier b; b.bar = bar; b.x = xb_xcc_id(); b.st = st;
    if (threadIdx.x == 0) (void)xb_add(&bar[XB_XCNT(b.x)], 1u);
    return b;
}
__device__ __forceinline__ void xcd_barrier_complete(unsigned* bar, unsigned x, unsigned& nloc, unsigned& nx) {
    const unsigned G = gridDim.x * gridDim.y * gridDim.z;
    unsigned sum, cnt, mine, sp = 0u;
    for (;;) {
        sum = 0u; cnt = 0u; mine = 0u;
#pragma unroll
        for (unsigned j = 0; j < 16; ++j) { const unsigned c = xb_ld(&bar[XB_XCNT(j)]); sum += c; cnt += (c > 0u) ? 1u : 0u; mine = (j == x) ? c : mine; }
        if (sum == G) break;
        __builtin_amdgcn_s_sleep(1);
        if ((++sp & 255u) == 0u) { if (xb_ld(&bar[XB_TMO])) break; if (sp > XB_SPIN_CAP) { atomicAdd(&bar[XB_TMO], 1u); break; } }
    }
    nloc = mine > 0u ? mine : 1u; nx = cnt > 0u ? cnt : 1u;
}

__device__ __forceinline__ void xcd_barrier(const XcdBarrier& b) {
    asm volatile("s_waitcnt vmcnt(0)" ::: "memory");
    __syncthreads();
    if (threadIdx.x == 0) {
        unsigned* bar = b.bar;
        __builtin_amdgcn_s_waitcnt(0);
        unsigned nloc = b.st[0], nx = b.st[1];
        if (nloc == 0u) { xcd_barrier_complete(bar, b.x, nloc, nx); b.st[0] = nloc; b.st[1] = nx; }
        const unsigned old = xb_add(&bar[XB_XSUB(b.x)], 1u);
        const unsigned gen = old / nloc;
        if (old + 1u == (gen + 1u) * nloc) {
            __builtin_amdgcn_fence(__ATOMIC_RELEASE, "agent");
            asm volatile("s_waitcnt vmcnt(0)" ::: "memory");
            const unsigned og = xb_add(&bar[XB_TOP], 1u);
            const unsigned tg = og / nx;
            if (og + 1u == (tg + 1u) * nx) xb_add(&bar[XB_TOPGEN], 1u);
            else XB_SPIN(xb_ld(&bar[XB_TOPGEN]) == tg, bar);
            __builtin_amdgcn_fence(__ATOMIC_ACQUIRE, "agent");
            xb_add(&bar[XB_XGEN(b.x)], 1u);
            asm volatile("s_waitcnt vmcnt(0)" ::: "memory");
        } else {
            XB_SPIN(xb_ld(&bar[XB_XGEN(b.x)]) == gen, bar);
            __builtin_amdgcn_fence(__ATOMIC_ACQUIRE, "agent");
            asm volatile("s_waitcnt vmcnt(0)" ::: "memory");
        }
    }
    __syncthreads();
}

constexpr int NWAVES = 8;
#ifndef MK_PER_PHASE
#define MK_PER_PHASE 0
#endif
constexpr int N_PHASES = 16;

constexpr size_t MiB = 1u << 20;
constexpr size_t WS_CTL = 0, CTL_ZERO_BYTES = 1 * MiB;
constexpr size_t WS_GV = 1 * MiB + 512 * 1024;
constexpr size_t WS_HM = 2 * MiB;
constexpr size_t WS_TAB = 2 * MiB + 256 * 1024;
constexpr size_t WS_LF = 3 * MiB;
constexpr size_t WS_DK = 6 * MiB;
constexpr size_t WS_LIST = 9 * MiB;
constexpr int LCAP = NSLOT;
constexpr size_t WS_WQKV0 = 18 * MiB, WS_WO0 = 24 * MiB, WS_WQKV1 = 26 * MiB, WS_WO1 = 32 * MiB, WS_WGU = 34 * MiB, WS_WD = 98 * MiB;
constexpr size_t WS_XH = 130 * MiB;
constexpr size_t WS_Q = 195 * MiB;
constexpr size_t WS_K = 260 * MiB, WS_V = 325 * MiB;
constexpr size_t WS_O0 = 390 * MiB;
constexpr size_t WS_END = 455 * MiB;
static_assert(WS_LIST + (size_t)NEXP * LCAP * 4 <= WS_WQKV0 && WS_DK + (size_t)NBATCH * 16 * KROWS * 4 <= WS_LIST && WS_LF + (size_t)NRP * 16 * 4 <= WS_DK, "small arrays");
static_assert(WS_XH + (size_t)NRP * DM * 2 <= WS_Q && WS_Q + (size_t)NRP * DM * 2 <= WS_K && WS_K + (size_t)NBATCH * KROWS * DM * 2 <= WS_V && WS_V + (size_t)NBATCH * KROWS * DM * 2 <= WS_O0 && WS_O0 + (size_t)NRP * DM * 2 <= WS_END, "activations");
static_assert(WS_K + (size_t)NSLOT * DM * 2 <= WS_O0 && WS_O0 + (size_t)NSLOT * DEXP * 2 <= WS_END, "MoE overlays");
constexpr int CW_TMO = 0, CW_CODE = 1;
constexpr int CW_BAR = 4096;
constexpr int CW_QM = 131072, CW_KM = 147456, CW_QCTR = 148480;
constexpr int CW_CNT = 65536;
constexpr int RING_OFF = 0, RING_BYTES = 131072;
constexpr int ROWTAB_OFF = RING_BYTES, ROWTAB_UNITS = 12;
constexpr int MOEPRE_OFF = ROWTAB_OFF + ROWTAB_UNITS * 1024;
constexpr int MISC_OFF = MOEPRE_OFF + 512;
constexpr int LDS_BYTES = 147456;
static_assert(MISC_OFF + 128 <= LDS_BYTES && attn_body::ATTN_LDS_BYTES <= RING_BYTES, "LDS map");

struct Params {
    const float *x, *meta, *rel_bias, *w_qkv, *lam, *subln, *w_o, *fox_w_in, *fox_b_f, *fox_w_o, *ln_mix_g, *ln_mix_b, *ln_ffn_g, *ln_ffn_b, *rg_w, *rg_b, *re_w, *re_b, *w_gate, *w_up, *w_down;
    float* out; unsigned char* ws; int ph_lo, ph_hi, li, pad;
};
struct Ctx { int tid, lane, wave, vcu, G; LAS unsigned char* lds; };
__device__ __forceinline__ Ctx fresh(const Ctx& C) { Ctx r = C; int t = threadIdx.x; asm volatile("" : "+v"(t)); r.tid = t; r.lane = t & 63; r.wave = __builtin_amdgcn_readfirstlane(t >> 6); return r; }

using pg8::shx;
__device__ __forceinline__ float wave_sum(float v, int lane) {
#pragma unroll
    for (int o = 1; o < 64; o <<= 1) v += shx(v, o, lane);
    return v;
}
__device__ __forceinline__ float bf2f(unsigned short h) { return __uint_as_float((unsigned)h << 16); }
__device__ __forceinline__ float bflo(unsigned w) { return __uint_as_float(w << 16); }
__device__ __forceinline__ float bfhi(unsigned w) { return __uint_as_float(w & 0xffff0000u); }
__device__ __forceinline__ float* h32_row(const Params& p, int r) { return r < NREAL ? p.out + (size_t)r * DM : (float*)(p.ws + WS_HM) + (size_t)(r - NREAL) * DM; }
__device__ __forceinline__ int meta_slot(int j) { return j; }

__device__ __forceinline__ void tr_item(const float* W, int ldw, int k0, int n0, bf16* WT, int ldt, int drow0, LAS float* scr, int lane) {
#pragma unroll 8
    for (int i = 0; i < 32; ++i) { const int kk = 2 * i + (lane >> 5); scr[kk * 33 + (lane & 31)] = W[(size_t)(k0 + kk) * ldw + n0 + (lane & 31)]; }
    LDS_WAIT(); asm volatile("" ::: "memory");
    const int c = lane & 7;
#pragma unroll
    for (int j = 0; j < 4; ++j) { const int n = (lane >> 3) + 8 * j; const LAS float* s = scr + (8 * c) * 33 + n;
        v4u o; o.x = pk2(s[0 * 33], s[1 * 33]); o.y = pk2(s[2 * 33], s[3 * 33]); o.z = pk2(s[4 * 33], s[5 * 33]); o.w = pk2(s[6 * 33], s[7 * 33]);
        *(GAS v4u*)(WT + (size_t)(drow0 + n) * ldt + k0 + 8 * c) = o; }
    LDS_WAIT(); asm volatile("" ::: "memory");
}
__device__ __forceinline__ void convert_experts(const Params& p, const Ctx& C, int layer, int first_item, int gw, int NGW) {
    LAS float* scr = (LAS float*)(C.lds + RING_OFF + C.wave * 16384);
    bf16* Wgu = (bf16*)(p.ws + WS_WGU); bf16* Wd = (bf16*)(p.ws + WS_WD);
    constexpr int PER_E = 768, NIT = NEXP * PER_E;
    for (int it = gw - first_item; it < NIT; it += NGW) { if (it < 0) continue;
        const int e = it / PER_E; int r = it % PER_E; const size_t eo = (size_t)(layer * NEXP + e);
        if (r < 512) { const bool up = r >= 256; r &= 255; const int kb = r >> 4, nb = r & 15, n0 = 32 * nb;
            tr_item((up ? p.w_up : p.w_gate) + eo * DM * DEXP, DEXP, 64 * kb, n0, Wgu + (size_t)e * DM * DM, DM, (n0 >> 7) * 256 + (n0 & 127) + (up ? 128 : 0), scr, C.lane); }
        else { r -= 512; const int kb = r >> 5, nb = r & 31;
            tr_item(p.w_down + eo * DEXP * DM, DM, 64 * kb, 32 * nb, Wd + (size_t)e * DM * DEXP, DEXP, 32 * nb, scr, C.lane); } }
}
__device__ __forceinline__ void p0_prologue(const Params& p, const Ctx& C) {
    LAS float* scr = (LAS float*)(C.lds + RING_OFF + C.wave * 16384);
    const int gw = C.vcu * NWAVES + C.wave, NGW = C.G * NWAVES;
    for (int it = gw; it < 4096; it += NGW) { int r = it;
        if (r < 1536) { tr_item(p.w_qkv, 3072, 64 * (r / 96), 32 * (r % 96), (bf16*)(p.ws + WS_WQKV0), DM, 32 * (r % 96), scr, C.lane); continue; } r -= 1536;
        if (r < 512) { tr_item(p.w_o, DM, 64 * (r >> 5), 32 * (r & 31), (bf16*)(p.ws + WS_WO0), DM, 32 * (r & 31), scr, C.lane); continue; } r -= 512;
        if (r < 1536) { tr_item(p.fox_w_in, 3088, 64 * (r / 96), 32 * (r % 96), (bf16*)(p.ws + WS_WQKV1), DM, 32 * (r % 96), scr, C.lane); continue; } r -= 1536;
        tr_item(p.fox_w_o, DM, 64 * (r >> 5), 32 * (r & 31), (bf16*)(p.ws + WS_WO1), DM, 32 * (r & 31), scr, C.lane); }
    convert_experts(p, C, 0, 0, gw, NGW);
    bf16* XH = (bf16*)(p.ws + WS_XH);
    for (int m = gw; m < NRP; m += NGW) {
        GAS unsigned long long* o8 = (GAS unsigned long long*)(XH + (size_t)m * DM) + C.lane;
        if (m < NR) { const GAS f32x4* xr = (const GAS f32x4*)(m < NREAL ? p.x + (size_t)m * DM : p.meta + (size_t)(m - NREAL) * DM) + C.lane;
#pragma unroll
            for (int j = 0; j < 4; ++j) { const f32x4 v = xr[64 * j]; o8[64 * j] = (unsigned long long)pk2(v.x, v.y) | ((unsigned long long)pk2(v.z, v.w) << 32); } }
        else {
#pragma unroll
            for (int j = 0; j < 4; ++j) o8[64 * j] = 0ull; } }
    { const int gt = C.vcu * (NWAVES * 64) + C.tid;
      if (gt < 16 * 128) { const int m = gt >> 7, d = gt & 127; int bk = d;
          if (d >= 16) { bk = 16 + (d >= 19) + (d >= 21) + (d >= 24) + (d >= 27) + (d >= 31) + (d >= 35) + (d >= 40) + (d >= 46) + (d >= 52) + (d >= 59) + (d >= 67) + (d >= 77) + (d >= 87) + (d >= 99) + (d >= 113); }
          ((float*)(p.ws + WS_TAB))[gt] = (p.rel_bias[bk * 16 + m] - p.rel_bias[31 * 16 + m]) * LOG2E; } }
}

__device__ __forceinline__ float diff_lambda_full(const Params& p, int lane) {
    const float a = p.lam[lane] * p.lam[64 + lane], b = p.lam[128 + lane] * p.lam[192 + lane];
    return __expf(wave_sum(a, lane)) - __expf(wave_sum(b, lane)) + LAMBDA_INIT0;
}
__device__ __forceinline__ void combine_phase(const Params& p, const Ctx& C) {
    const int gw = C.vcu * NWAVES + C.wave, NGW = C.G * NWAVES, lane = C.lane;
    const float lam = diff_lambda_full(p, lane);
    const bf16* O0 = (const bf16*)(p.ws + WS_O0); const bf16* O1 = (const bf16*)(p.ws + WS_XH); bf16* OA = (bf16*)(p.ws + WS_Q);
    float sw[8];
#pragma unroll
    for (int c = 0; c < 8; ++c) sw[c] = p.subln[((8 * lane) & 127) + c] * (1.f - LAMBDA_INIT0);
    for (int r = gw; r < NREAL; r += NGW) {
#pragma unroll
        for (int j = 0; j < 2; ++j) { const size_t off = (size_t)r * DM + 8 * lane + 512 * j;
            const v4u a = *(const GAS v4u*)(O0 + off), b = *(const GAS v4u*)(O1 + off);
            float d[8]; const unsigned aw[4] = {a.x, a.y, a.z, a.w}, bw[4] = {b.x, b.y, b.z, b.w}; float ss = 0.f;
#pragma unroll
            for (int c = 0; c < 4; ++c) { d[2 * c] = bflo(aw[c]) - lam * bflo(bw[c]); d[2 * c + 1] = bfhi(aw[c]) - lam * bfhi(bw[c]); ss += d[2 * c] * d[2 * c] + d[2 * c + 1] * d[2 * c + 1]; }
            ss += shx(ss, 1, lane); ss += shx(ss, 2, lane); ss += shx(ss, 4, lane); ss += shx(ss, 8, lane);
            const float rs = 1.f / sqrtf(ss * (1.f / 128.f) + LN_EPS);
            v4u o; o.x = pk2(d[0] * rs * sw[0], d[1] * rs * sw[1]); o.y = pk2(d[2] * rs * sw[2], d[3] * rs * sw[3]); o.z = pk2(d[4] * rs * sw[4], d[5] * rs * sw[5]); o.w = pk2(d[6] * rs * sw[6], d[7] * rs * sw[7]);
            *(GAS v4u*)(OA + off) = o; } }
    if (gw < 128) { const int h = gw >> 4, j = gw & 15, kj = lane & 15, s = (lane >> 4) & 1, m = 2 * h + s;
        const bf16* Q = (const bf16*)(p.ws + WS_Q); const bf16* K = (const bf16*)(p.ws + WS_K); const bf16* V = (const bf16*)(p.ws + WS_V);
        const bf16* qp = Q + (size_t)(NREAL + j) * DM + m * 64; const bf16* kp = K + (size_t)meta_slot(kj) * DM + m * 64;
        float dot = 0.f;
#pragma unroll
        for (int c = 0; c < 8; ++c) { const v4u qa = *(const GAS v4u*)(qp + 8 * c), ka = *(const GAS v4u*)(kp + 8 * c); const unsigned qw[4] = {qa.x, qa.y, qa.z, qa.w}, kw[4] = {ka.x, ka.y, ka.z, ka.w};
#pragma unroll
            for (int e = 0; e < 4; ++e) dot += bflo(qw[e]) * bflo(kw[e]) + bfhi(qw[e]) * bfhi(kw[e]); }
        float sc = (kj <= j) ? dot + p.rel_bias[(j - kj) * 16 + m] * LOG2E : -INFINITY;
        float mx = sc; mx = fmaxf(mx, shx(mx, 1, lane)); mx = fmaxf(mx, shx(mx, 2, lane)); mx = fmaxf(mx, shx(mx, 4, lane)); mx = fmaxf(mx, shx(mx, 8, lane));
        float pe = __builtin_amdgcn_exp2f(sc - mx); float l = pe; l += shx(l, 1, lane); l += shx(l, 2, lane); l += shx(l, 4, lane); l += shx(l, 8, lane);
        pe /= l;
        const float a = pe - lam * shx(pe, 16, lane);
        float o0 = 0.f, o1 = 0.f;
        for (int k2 = 0; k2 <= j; ++k2) { const float ak = __builtin_amdgcn_readlane(a, k2); const unsigned vw = *(const GAS unsigned*)(V + (size_t)meta_slot(k2) * DM + h * 128 + 2 * lane); o0 += ak * bflo(vw); o1 += ak * bfhi(vw); }
        const float ss = wave_sum(o0 * o0 + o1 * o1, lane); const float rs = 1.f / sqrtf(ss * (1.f / 128.f) + LN_EPS);
        const float w0 = p.subln[2 * lane] * (1.f - LAMBDA_INIT0), w1 = p.subln[2 * lane + 1] * (1.f - LAMBDA_INIT0);
        *(GAS unsigned*)(OA + (size_t)(NREAL + j) * DM + h * 128 + 2 * lane) = pk2(o0 * rs * w0, o1 * rs * w1); }
}
__device__ __forceinline__ void fox_meta_attn(const Params& p, const Ctx& C) {
    const int gw = C.vcu * NWAVES + C.wave, lane = C.lane;
    if (gw < 256) { const int h = gw >> 4, j = gw & 15, kj = lane & 15;
        bf16* Q = (bf16*)(p.ws + WS_Q); const bf16* K = (const bf16*)(p.ws + WS_K); const bf16* V = (const bf16*)(p.ws + WS_V); const float* DK = (const float*)(p.ws + WS_DK) + (size_t)h * KROWS;
        const bf16* qp = Q + (size_t)(NREAL + j) * DM + h * 64; const bf16* kp = K + (size_t)meta_slot(kj) * DM + h * 64;
        float dot = 0.f;
#pragma unroll
        for (int c = 0; c < 8; ++c) { const v4u qa = *(const GAS v4u*)(qp + 8 * c), ka = *(const GAS v4u*)(kp + 8 * c); const unsigned qw[4] = {qa.x, qa.y, qa.z, qa.w}, kw[4] = {ka.x, ka.y, ka.z, ka.w};
#pragma unroll
            for (int e = 0; e < 4; ++e) dot += bflo(qw[e]) * bflo(kw[e]) + bfhi(qw[e]) * bfhi(kw[e]); }
        float sc = (kj <= j) ? dot + DK[meta_slot(kj)] - DK[meta_slot(j)] : -INFINITY;
        float mx = sc; mx = fmaxf(mx, shx(mx, 1, lane)); mx = fmaxf(mx, shx(mx, 2, lane)); mx = fmaxf(mx, shx(mx, 4, lane)); mx = fmaxf(mx, shx(mx, 8, lane));
        float pe = __builtin_amdgcn_exp2f(sc - mx); float l = pe; l += shx(l, 1, lane); l += shx(l, 2, lane); l += shx(l, 4, lane); l += shx(l, 8, lane);
        pe /= l;
        float o = 0.f;
        for (int k2 = 0; k2 <= j; ++k2) { const float ak = __builtin_amdgcn_readlane(pe, k2); o += ak * bf2f(V[(size_t)meta_slot(k2) * DM + h * 64 + lane]); }
        ((bf16*)(p.ws + WS_O0))[(size_t)(NREAL + j) * DM + h * 64 + lane] = (bf16)f2bf(o); }
}

typedef float f32x4m __attribute__((ext_vector_type(4)));
template <int KIND> __device__ __forceinline__ void ln_phase(const Params& p, const Ctx& C, int layer) {
    constexpr int NCB = (KIND == 0) ? 3 : (KIND == 1 ? 1 : 0), NC = 16 * (NCB ? NCB : 1);
    constexpr int AT_PITCH = 1028;
    const int tid = C.tid, lane = C.lane, wave = C.wave;
    LAS float* At = (LAS float*)(C.lds + RING_OFF);
    LAS float* part = (LAS float*)(C.lds + RING_OFF + 65792);
    LAS float* logit = (LAS float*)(C.lds + RING_OFF + 90368);
    LAS int* sl_e = (LAS int*)(C.lds + RING_OFF + 93440);
    LAS int* cnt_l = (LAS int*)(C.lds + RING_OFF + 94720);
    const float* gsrc = (KIND == 0 ? p.ln_mix_g : p.ln_ffn_g) + layer * DM; const float* bsrc = (KIND == 0 ? p.ln_mix_b : p.ln_ffn_b) + layer * DM;
    f32x4 gv[4], bv[4];
#pragma unroll
    for (int j = 0; j < 4; ++j) { gv[j] = *(const GAS f32x4*)(gsrc + 4 * lane + 256 * j); bv[j] = *(const GAS f32x4*)(bsrc + 4 * lane + 256 * j); }
    float Bf[NCB ? NCB : 1][8][4];
    if constexpr (NCB > 0) { const int kq = lane >> 4, col = lane & 15;
#pragma unroll
        for (int cb = 0; cb < NCB; ++cb)
#pragma unroll
            for (int g = 0; g < 8; ++g)
#pragma unroll
                for (int c = 0; c < 4; ++c) { const int k = 128 * wave + 16 * g + 4 * kq + c, cc = cb * 16 + col; float w;
                    if (KIND == 0) w = cc < 4 ? p.rg_w[((size_t)layer * DM + k) * 4 + cc] : (cc < 36 ? p.re_w[((size_t)layer * DM + k) * 32 + (cc - 4)] : 0.f);
                    else w = p.fox_w_in[(size_t)k * 3088 + 3072 + cc];
                    Bf[cb][g][c] = w; } }
    if (KIND == 0) { if (tid < 96) cnt_l[tid] = 0; }
    bf16* XH = (bf16*)(p.ws + WS_XH); const bf16* Y = (const bf16*)(p.ws + WS_K);
    constexpr int NTILES = NR / 16;
    int it = 0;
    for (int tile = C.vcu; tile < NTILES; tile += C.G, ++it) {
        f32x4 vv[2][4]; unsigned long long yy[2][2][4];
#pragma unroll
        for (int rr = 0; rr < 2; ++rr) { const int row = tile * 16 + wave * 2 + rr; const float* hrow = h32_row(p, row);
#pragma unroll
            for (int j = 0; j < 4; ++j) vv[rr][j] = *(const GAS f32x4*)(hrow + 4 * lane + 256 * j);
            if (KIND != 0) {
#pragma unroll
                for (int j = 0; j < 4; ++j) { yy[rr][0][j] = *(const GAS unsigned long long*)(Y + (size_t)(2 * row) * DM + 4 * lane + 256 * j); yy[rr][1][j] = *(const GAS unsigned long long*)(Y + (size_t)(2 * row + 1) * DM + 4 * lane + 256 * j); } } }
#pragma unroll
        for (int rr = 0; rr < 2; ++rr) { const int rl = wave * 2 + rr, row = tile * 16 + rl;
            float* hrow = h32_row(p, row);
            f32x4 v[4];
#pragma unroll
            for (int j = 0; j < 4; ++j) v[j] = vv[rr][j];
            if (KIND != 0) {
#pragma unroll
                for (int j = 0; j < 4; ++j) { const unsigned long long y0 = yy[rr][0][j], y1 = yy[rr][1][j];
                    const unsigned a0 = (unsigned)y0, a1 = (unsigned)(y0 >> 32), b0 = (unsigned)y1, b1 = (unsigned)(y1 >> 32);
                    v[j].x = v[j].x * ALPHA + (bflo(a0) + bflo(b0)); v[j].y = v[j].y * ALPHA + (bfhi(a0) + bfhi(b0)); v[j].z = v[j].z * ALPHA + (bflo(a1) + bflo(b1)); v[j].w = v[j].w * ALPHA + (bfhi(a1) + bfhi(b1)); } }
            float s = 0.f;
#pragma unroll
            for (int j = 0; j < 4; ++j) s += (v[j].x + v[j].y) + (v[j].z + v[j].w);
            const float mean = wave_sum(s, lane) * (1.f / DM); float s2 = 0.f;
#pragma unroll
            for (int j = 0; j < 4; ++j) { v[j] = v[j] - mean; s2 += (v[j].x * v[j].x + v[j].y * v[j].y) + (v[j].z * v[j].z + v[j].w * v[j].w); }
            const float rstd = 1.f / sqrtf(wave_sum(s2, lane) * (1.f / DM) + LN_EPS);
#pragma unroll
            for (int j = 0; j < 4; ++j) v[j] = v[j] * rstd * gv[j] + bv[j];
            if (KIND == 2) { if (row < NREAL) {
#pragma unroll
                for (int j = 0; j < 4; ++j) *(GAS f32x4*)(hrow + 4 * lane + 256 * j) = v[j]; } }
            else {
#pragma unroll
                for (int j = 0; j < 4; ++j) { *(GAS f32x4*)(hrow + 4 * lane + 256 * j) = v[j];
                    *((GAS unsigned long long*)(XH + (size_t)row * DM) + lane + 64 * j) = (unsigned long long)pk2(v[j].x, v[j].y) | ((unsigned long long)pk2(v[j].z, v[j].w) << 32);
                    *(LAS f32x4*)(At + rl * AT_PITCH + 4 * lane + 256 * j) = v[j]; } } }
        if constexpr (NCB > 0) {
            __syncthreads();
            f32x4m acc[NCB];
#pragma unroll
            for (int cb = 0; cb < NCB; ++cb) acc[cb] = (f32x4m){0.f, 0.f, 0.f, 0.f};
#pragma unroll
            for (int g = 0; g < 8; ++g) { const f32x4 a4 = *(const LAS f32x4*)(At + (lane & 15) * AT_PITCH + 128 * wave + 16 * g + 4 * (lane >> 4));
#pragma unroll
                for (int c = 0; c < 4; ++c)
#pragma unroll
                    for (int cb = 0; cb < NCB; ++cb) acc[cb] = __builtin_amdgcn_mfma_f32_16x16x4f32(a4[c], Bf[cb][g][c], acc[cb], 0, 0, 0); }
#pragma unroll
            for (int cb = 0; cb < NCB; ++cb)
#pragma unroll
                for (int r = 0; r < 4; ++r) part[(wave * 16 + 4 * (lane >> 4) + r) * 48 + cb * 16 + (lane & 15)] = acc[cb][r];
            __syncthreads();
            for (int idx = tid; idx < 16 * NC; idx += NWAVES * 64) { const int rw = idx / NC, cl = idx % NC; float sacc = 0.f;
#pragma unroll
                for (int w = 0; w < 8; ++w) sacc += part[(w * 16 + rw) * 48 + cl];
                logit[rw * 48 + cl] = sacc; }
            __syncthreads();
            if (KIND == 0) { if (tid < 16) { const int row = tile * 16 + tid; const LAS float* lg = logit + tid * 48;
                float gl[4]; int gs = 0;
#pragma unroll
                for (int i = 0; i < 4; ++i) gl[i] = lg[i] + p.rg_b[layer * 4 + i];
#pragma unroll
                for (int i = 1; i < 4; ++i) if (gl[i] > gl[gs]) gs = i;
                float den = 0.f;
#pragma unroll
                for (int i = 0; i < 4; ++i) den += __expf(gl[i] - gl[gs]);
                const float pg = 1.f / den;
                float el[8];
#pragma unroll
                for (int i = 0; i < 8; ++i) el[i] = lg[4 + gs * 8 + i] + p.re_b[layer * 32 + gs * 8 + i];
                int i0 = 0;
#pragma unroll
                for (int i = 1; i < 8; ++i) if (el[i] > el[i0]) i0 = i;
                int i1 = (i0 == 0) ? 1 : 0;
#pragma unroll
                for (int i = 0; i < 8; ++i) if (i != i0 && el[i] > el[i1]) i1 = i;
                const float ex = __expf(el[i1] - el[i0]); const float w0 = 1.f / (1.f + ex), w1 = ex * w0;
                float* GVp = (float*)(p.ws + WS_GV); GVp[2 * row] = pg * w0; GVp[2 * row + 1] = pg * w1;
                sl_e[it * 32 + 2 * tid] = gs * 8 + i0; sl_e[it * 32 + 2 * tid + 1] = gs * 8 + i1; } }
            else { if (tid < 256) { const int rw = tid >> 4, hh = tid & 15; const float vv = logit[rw * 48 + hh] + p.fox_b_f[hh];
                ((float*)(p.ws + WS_LF))[(size_t)(tile * 16 + rw) * 16 + hh] = fminf(vv, 0.f) - __builtin_amdgcn_logf(1.f + __builtin_amdgcn_exp2f(-fabsf(vv) * LOG2E)) * 0.69314718056f;   } }
        }
    }
    if (KIND == 0) {
        gu32* CNT = (gu32*)(p.ws + WS_CTL) + CW_CNT + layer * 2048; int* LIST = (int*)(p.ws + WS_LIST);
        __syncthreads();
        const int nloc = it * 32;
        for (int s = tid; s < nloc; s += NWAVES * 64) atomicAdd((int*)&cnt_l[sl_e[s]], 1);
        __syncthreads();
        if (tid < 32) { const int n = cnt_l[tid]; cnt_l[32 + tid] = n > 0 ? (int)__hip_atomic_fetch_add(CNT + 64 * tid, (unsigned)n, RLX_AGENT) : 0; cnt_l[64 + tid] = 0; }
        __syncthreads();
        for (int s = tid; s < nloc; s += NWAVES * 64) { const int e = sl_e[s]; const int pos = cnt_l[32 + e] + atomicAdd((int*)&cnt_l[64 + e], 1);
            const int tl = C.vcu + (s >> 5) * C.G; LIST[(size_t)e * LCAP + pos] = 2 * (tl * 16 + ((s & 31) >> 1)) + (s & 1); }
    }
    __syncthreads();
}

__device__ __forceinline__ void cumsum_job(const Params& p, const Ctx& C) {
    if (C.vcu >= 64) return;
    const int b = C.vcu >> 4, h = C.vcu & 15, tid = C.tid, lane = C.lane, wave = C.wave;
    const float* LF = (const float*)(p.ws + WS_LF); float* DK = (float*)(p.ws + WS_DK) + (size_t)(b * 16 + h) * KROWS;
    LAS float* wt = (LAS float*)(C.lds + RING_OFF);
    float cm = 0.f, mine = 0.f; const int myj = (tid < NMETA) ? tid : -1;
    for (int i = 0; i < NMETA; ++i) { cm += LF[(size_t)(NREAL + i) * 16 + h]; if (i == myj) mine = cm; }
    if (tid < KPRE) DK[tid] = (myj >= 0) ? -mine * LOG2E : 0.f;
    if (tid < 64) DK[KPRE + SEQ + tid] = 0.f;
    const float* lp = LF + (size_t)(b * SEQ + tid * 16) * 16 + h;
    float run = 0.f;
#pragma unroll 1
    for (int i = 0; i < 16; ++i) run += lp[i * 16];
    float inc = run;
#pragma unroll
    for (int o = 1; o < 64; o <<= 1) { const float t = __uint_as_float((unsigned)__builtin_amdgcn_ds_bpermute((lane - o) << 2, (int)__float_as_uint(inc))); if (lane >= o) inc += t; }
    if (lane == 63) wt[wave] = inc;
    __syncthreads();
    float base = cm;
    for (int w = 0; w < wave; ++w) base += wt[w];
    base += inc - run;
#pragma unroll 1
    for (int i = 0; i < 16; ++i) { base += lp[i * 16]; DK[KPRE + tid * 16 + i] = -base * LOG2E; }
    __syncthreads();
}

struct MoeOrder {
    int G, c, UT; const LAS int* pre; const char* A; const char* W; size_t wexp, tsB;
    __device__ __forceinline__ bool next(int i, pg8::Unit& u) const {
        const int g = i * G + c; if (g >= UT || i >= ROWTAB_UNITS) return false;
        const int rt = g >> 2; int e = 0; while (pre[e + 1] <= rt) ++e;
        u.pm = rt - pre[e]; u.pn = g & 3; u.A = A; u.B = W + (size_t)e * wexp + (size_t)u.pn * tsB; u.tab = i; u.e = e; return true;
    }
};
__device__ __forceinline__ int moe_setup(const Params& p, const Ctx& C, int layer, MoeOrder& S) {
    LAS int* pre = (LAS int*)(C.lds + MOEPRE_OFF); LAS int* cnts = pre + 40; LAS int* rowtab = (LAS int*)(C.lds + ROWTAB_OFF);
    const gu32* CNT = (const gu32*)(p.ws + WS_CTL) + CW_CNT + layer * 2048;
    if (C.tid < 32) cnts[C.tid] = (int)__hip_atomic_load(CNT + 64 * C.tid, RLX_AGENT);
    __syncthreads();
    if (C.tid == 0) { int a = 0; for (int e = 0; e < NEXP; ++e) { pre[e] = a; a += (cnts[e] + 255) >> 8; } pre[NEXP] = a; }
    __syncthreads();
    S.pre = pre; S.UT = 4 * pre[NEXP];
    const int* LIST = (const int*)(p.ws + WS_LIST);
    pg8::Unit u;
    for (int i = 0; S.next(i, u); ++i) { if (C.tid < 256) { const int idx = 256 * u.pm + C.tid; rowtab[i * 256 + C.tid] = idx < cnts[u.e] ? LIST[(size_t)u.e * LCAP + idx] : -1; } }
    __syncthreads();
    return S.UT;
}

__global__ void __launch_bounds__(NWAVES * 64, 2) trunk_fwd(Params p) {
    extern __shared__ __attribute__((aligned(16))) unsigned char lds[];
    Ctx C;
    C.lds = (LAS unsigned char*)lds; C.tid = threadIdx.x; C.lane = C.tid & 63; C.wave = __builtin_amdgcn_readfirstlane(C.tid >> 6);
    C.G = gridDim.x; { const int bx = blockIdx.x; C.vcu = (C.G % 8 == 0) ? (bx % 8) * (C.G / 8) + bx / 8 : bx; }
    volatile LAS unsigned* MISC = (volatile LAS unsigned*)(C.lds + MISC_OFF);
    gu32* ctl = (gu32*)(p.ws + WS_CTL);
    if (C.tid < 32) MISC[C.tid] = 0u;
    __syncthreads();
    XcdBarrier bar; bar.bar = (unsigned*)(ctl + CW_BAR) + p.li * XCD_BAR_WORDS; bar.x = 0; bar.st = nullptr;
    if (!MK_PER_PHASE) bar = xcd_barrier_post((unsigned*)(ctl + CW_BAR) + p.li * XCD_BAR_WORDS, MISC + 8);
#define GRID_BAR() do { if (MK_PER_PHASE) { if (C.tid == 0) __hip_atomic_store(ctl + CW_TMO, 0xBADBA0u, RLX_AGENT); } else { xcd_barrier(bar); } } while (0)
    const int lo = p.ph_lo, hi = p.ph_hi;
#ifndef SUBMASK
#define SUBMASK 0x7f
#endif
#ifndef REP_MASK
#define REP_MASK 0
#endif
#define NREP(k) (((REP_MASK >> (k)) & 1) ? 2 : 1)
#ifndef PHASE_MASK
#define PHASE_MASK 0xffff
#endif
#define IN(k) (((PHASE_MASK >> (k)) & 1) && lo <= (k) && (k) < hi)
#define SEAM(k) do { if (IN(k) && IN((k) + 1)) GRID_BAR(); } while (0)
    bf16* XH = (bf16*)(p.ws + WS_XH); bf16* QB = (bf16*)(p.ws + WS_Q); bf16* KB = (bf16*)(p.ws + WS_K); bf16* VB = (bf16*)(p.ws + WS_V);
    bf16* O0 = (bf16*)(p.ws + WS_O0); bf16* O1 = (bf16*)(p.ws + WS_XH);
    const LAS int* rowtab = (const LAS int*)(C.lds + ROWTAB_OFF);

    if (IN(0)) { for (int rep_ = 0; rep_ < NREP(0); ++rep_) p0_prologue(p, fresh(C)); } SEAM(0);

    for (int layer = 0; layer < 2; ++layer) {
        const int pb = 1 + (layer ? 8 : 0);
        if ((SUBMASK & 1) && IN(pb)) { for (int rep_ = 0; rep_ < NREP(pb); ++rep_) {
            if (layer == 1) cumsum_job(p, fresh(C));
            pg8::StaticOrder S; S.init(NRP, 3 * DM, C.G, (int)blockIdx.x, XH, DM * 2, p.ws + (layer ? WS_WQKV1 : WS_WQKV0), DM * 2);
            pg8::EpiQKV E{QB, KB, VB, attn_body::C2, layer ? (unsigned*)(ctl + CW_QM) : nullptr, (unsigned*)(ctl + CW_KM)};
            pg8::gemm_phase<pg8::EpiQKV, pg8::StaticOrder, true, false>(C.lds + RING_OFF, DM, DM * 2, S, E, rowtab, 0);
        } } SEAM(pb);
        if (layer == 0) {
            if (IN(2)) { for (int rep_ = 0; rep_ < NREP(2); ++rep_) {
                const float* TAB = (const float*)(p.ws + WS_TAB);
                for (int pr = C.vcu; pr < NBATCH * 16 * 16; pr += C.G) { const int trip = pr >> 4, s = pr & 15, b = trip >> 4, m = trip & 15; const int cv = (m >> 1) * 128;
#pragma unroll 1
                    for (int w = 0; w < 2; ++w) attn_body::attn_unit_dv<8>(b, w ? s : 31 - s, m * 64, cv, cv, (const attn_body::bf16*)QB, (const attn_body::bf16*)KB, (const attn_body::bf16*)VB, (attn_body::bf16*)((m & 1) ? O1 : O0), TAB + m * 128, (char*)lds + RING_OFF); }
            } } SEAM(2);
            if (IN(3)) { combine_phase(p, fresh(C)); } SEAM(3);
        } else {
            if (IN(10)) { for (int rep_ = 0; rep_ < NREP(10); ++rep_) {
                const float* DK = (const float*)(p.ws + WS_DK);
                LAS int* tk = (LAS int*)(C.lds + MOEPRE_OFF);
                for (;;) {
                    const int lane_ = fresh(C).lane;
                    if (C.tid == 0) tk[0] = (int)__hip_atomic_fetch_add(ctl + CW_QCTR + 64 * rep_, 1u, RLX_AGENT);
                    __syncthreads(); const int u = tk[0]; __syncthreads();
                    if (u >= NBATCH * 16 * 32) break;
                    const int qb = 31 - (u >> 6), bh = u & 63, b = bh >> 4, h = bh & 15;
                    const float* dk = DK + (size_t)bh * KROWS;
                    const unsigned qmb = lane_ < 8 ? __hip_atomic_load(ctl + CW_QM + ((size_t)(b * 32 + qb) * 16 + h) * 8 + lane_, RLX_AGENT) : 0u;
                    const unsigned kmb = lane_ < 8 ? __hip_atomic_load(ctl + CW_KM + ((size_t)bh) * 8 + lane_, RLX_AGENT) : 0u;
                    const int ntf = 4 * qb + 6;
                    float e0 = lane_ < ntf ? dk[lane_ == 0 ? NMETA - 1 : 64 * lane_ + 63] : 0.f, e1 = lane_ + 64 < ntf ? dk[64 * (lane_ + 64) + 63] : 0.f, e2 = lane_ + 128 < ntf ? dk[64 * (lane_ + 128) + 63] : 0.f;
                    const float q2 = wave_sum(__uint_as_float(qmb), lane_), k2 = wave_sum(__uint_as_float(kmb), lane_);
                    const float thr = dk[KPRE + 256 * qb] - 40.f - 2.1f * sqrtf(q2 * k2);
                    const unsigned long long m0 = __ballot(lane_ < ntf && e0 >= thr), m1 = __ballot(lane_ + 64 < ntf && e1 >= thr), m2 = __ballot(lane_ + 128 < ntf && e2 >= thr);
                    int tb = m0 ? __builtin_ctzll(m0) : (m1 ? 64 + __builtin_ctzll(m1) : (m2 ? 128 + __builtin_ctzll(m2) : ntf - 6));
                    tb &= ~1; tb = tb > ntf - 6 ? ntf - 6 : tb; tb = __builtin_amdgcn_readfirstlane(tb);
                    attn_body::attn_unit<1, 8>(b, qb, tb, h * 64, h * 64, h * 64, (const attn_body::bf16*)QB, (const attn_body::bf16*)KB, (const attn_body::bf16*)VB, (attn_body::bf16*)O0, dk, (char*)lds + RING_OFF);
                }
                fox_meta_attn(p, fresh(C));
            } } SEAM(10);
        }
        const int pw = layer ? 11 : 4;
        if ((SUBMASK & 4) && IN(pw)) { for (int rep_ = 0; rep_ < NREP(pw); ++rep_) {
            pg8::StaticOrder S; S.init(NRP, DM, C.G, (int)blockIdx.x, layer ? O0 : QB, DM * 2, p.ws + (layer ? WS_WO1 : WS_WO0), DM * 2);
            pg8::EpiZ E{layer ? p.out : p.x, layer ? (const float*)(p.ws + WS_HM) : p.meta, p.out, (float*)(p.ws + WS_HM)};
            pg8::gemm_phase<pg8::EpiZ, pg8::StaticOrder, true, false>(C.lds + RING_OFF, DM, DM * 2, S, E, rowtab, 0);
        } } SEAM(pw);
        if ((SUBMASK & 8) && IN(pw + 1)) { ln_phase<0>(p, fresh(C), layer); } SEAM(pw + 1);
        if ((SUBMASK & 16) && IN(pw + 2)) { for (int rep_ = 0; rep_ < NREP(pw + 2); ++rep_) {
            MoeOrder S; S.G = C.G; S.c = (int)blockIdx.x; S.A = (const char*)XH; S.W = (const char*)(p.ws + WS_WGU); S.wexp = (size_t)DM * DM * 2; S.tsB = (size_t)256 * DM * 2;
            moe_setup(p, fresh(C), layer, S);
            pg8::EpiGU E{(pg8::bf16_t*)O0};
            pg8::gemm_phase<pg8::EpiGU, MoeOrder, true, true>(C.lds + RING_OFF, DM, DM * 2, S, E, rowtab, 1);
        } } SEAM(pw + 2);
        if ((SUBMASK & 32) && IN(pw + 3)) { for (int rep_ = 0; rep_ < NREP(pw + 3); ++rep_) {
            MoeOrder S; S.G = C.G; S.c = (int)blockIdx.x; S.A = (const char*)O0; S.W = (const char*)(p.ws + WS_WD); S.wexp = (size_t)DM * DEXP * 2; S.tsB = (size_t)256 * DEXP * 2;
            moe_setup(p, fresh(C), layer, S);
            pg8::EpiDown E{(pg8::bf16_t*)KB, (const float*)(p.ws + WS_GV)};
            pg8::gemm_phase<pg8::EpiDown, MoeOrder, true, true>(C.lds + RING_OFF, DEXP, DEXP * 2, S, E, rowtab, 0);
        } } SEAM(pw + 3);
        if ((SUBMASK & 64) && IN(pw + 4)) {
            if (layer == 0) { ln_phase<1>(p, fresh(C), 0); { const Ctx Cf = fresh(C); convert_experts(p, Cf, 1, 0, Cf.vcu * NWAVES + Cf.wave, Cf.G * NWAVES); } }
            else ln_phase<2>(p, fresh(C), 1);
        }
        if (layer == 0) SEAM(8);
    }
#undef IN
#undef SEAM
#undef GRID_BAR
}

extern "C" void kernel_launch(void* const* d_in, const int* in_sizes, int n_in, void* d_out, int out_size, void* d_ws, size_t ws_size, hipStream_t stream) {
    static int grid = 0;
    if (grid == 0) {
        if (n_in != 21 || in_sizes[0] != NREAL * DM || out_size != NREAL * DM || ws_size < WS_END) { fprintf(stderr, "kernel_launch: unexpected shapes (n_in %d, in0 %d, out %d, ws %zu); nothing launched\n", n_in, n_in > 0 ? in_sizes[0] : -1, out_size, ws_size); grid = -1; return; }
        int dev = 0, cus = 0, per_cu = 0;
        if (hipGetDevice(&dev) != hipSuccess || hipDeviceGetAttribute(&cus, hipDeviceAttributeMultiprocessorCount, dev) != hipSuccess) { fprintf(stderr, "kernel_launch: device query failed\n"); grid = -1; return; }
        if (hipFuncSetAttribute((const void*)trunk_fwd, hipFuncAttributeMaxDynamicSharedMemorySize, LDS_BYTES) != hipSuccess) { fprintf(stderr, "kernel_launch: hipFuncSetAttribute failed\n"); grid = -1; return; }
        if (hipOccupancyMaxActiveBlocksPerMultiprocessor(&per_cu, (const void*)trunk_fwd, NWAVES * 64, LDS_BYTES) != hipSuccess || per_cu < 1) { fprintf(stderr, "kernel_launch: occupancy query reports %d workgroups per CU\n", per_cu); }
        (void)hipGetLastError();
        grid = cus;
    }
    if (grid < 0) return;
    if (hipMemsetAsync((char*)d_ws + WS_CTL, 0, CTL_ZERO_BYTES, stream) != hipSuccess) { fprintf(stderr, "kernel_launch: hipMemsetAsync failed\n"); return; }
    Params a{};
    const float** dst = (const float**)&a.x;
    for (int i = 0; i < 21; ++i) dst[i] = (const float*)d_in[i];
    a.out = (float*)d_out; a.ws = (unsigned char*)d_ws;
#if MK_PER_PHASE
    for (int k = 0; k < N_PHASES; ++k) { a.ph_lo = k; a.ph_hi = k + 1; a.li = 0; hipLaunchKernelGGL(trunk_fwd, dim3(grid), dim3(NWAVES * 64), LDS_BYTES, stream, a); }
#else
    a.ph_lo = 0; a.ph_hi = N_PHASES; a.li = 0;
    hipLaunchKernelGGL(trunk_fwd, dim3(grid), dim3(NWAVES * 64), LDS_BYTES, stream, a);
#endif
    const hipError_t le = hipPeekAtLastError();
    if (le != hipSuccess) fprintf(stderr, "kernel_launch: launch failed: %s\n", hipGetErrorName(le));
}
```

```cpp
#include <hip/hip_runtime.h>
#include <hip/hip_bf16.h>
#include <cstdio>
#include <cstdint>
#include <cmath>

constexpr int DM = 1024, NBATCH = 4, SEQ = 8192, NMETA = 16;
constexpr int NREAL = NBATCH * SEQ;
constexpr int NR = NREAL + NMETA;
constexpr int NRP = 129 * 256;
constexpr int KPRE = 64;
constexpr int KROWS = KPRE + SEQ + 64;
constexpr int NSLOT = 2 * NR;
constexpr int NEXP = 32, DEXP = 512;
constexpr float ALPHA = 1.41421356237309515f;
constexpr float LN_EPS = 1e-5f;
constexpr float LOG2E = 1.4426950408889634f;
constexpr float LAMBDA_INIT0 = 0.2f;

namespace pg8 {
#define PG8_LAS __attribute__((address_space(3)))
typedef unsigned short bf16_t;
typedef short bf16x8 __attribute__((ext_vector_type(8)));
typedef float f32x4 __attribute__((ext_vector_type(4)));
typedef unsigned u32x4 __attribute__((ext_vector_type(4)));
constexpr int BM = 256, BK = 64, HALF = 128, HTB = HALF * BK * 2  , STAGE_BYTES = 8 * HTB, NXCD = 8, WGM = 8;

__host__ __device__ __forceinline__ int lds_byte(int r, int c) { const int st = (r >> 4) * 2 + (c >> 5), rr = r & 15, cc = c & 31, ob = rr * 64 + cc * 2; return st * 1024 + (ob ^ (((ob >> 9) & 1) << 5)); }
__host__ __device__ __forceinline__ void stage_rc(int b, int& R, int& C) { const int st = b / 1024, sb = b % 1024, swz = sb ^ (((sb >> 9) & 1) << 5); R = (st >> 1) * 16 + swz / 64; C = (st & 1) * 32 + (swz % 64) / 2; }
__host__ __device__ __forceinline__ int perm32(int rho) { const int n = rho >> 4, i = rho & 15; return 8 * (i >> 2) + 4 * n + (i & 3); }

struct Unit { int pm, pn; const char* A; const char* B; int tab; int e; };

struct StaticOrder {
    int nM, nN, nwg, G, c; const char* A; const char* B; size_t tsA, tsB;
    __device__ void init(int M, int N, int G_, int c_, const void* A_, size_t lda_bytes, const void* B_, size_t ldb_bytes) { nM = M / BM; nN = N / BM; nwg = nM * nN; G = G_; c = c_; A = (const char*)A_; B = (const char*)B_; tsA = lda_bytes * BM; tsB = ldb_bytes * BM; }
    __device__ bool next(int i, Unit& u) const {
        const long L = (long)i * G + c; if (L >= nwg) return false;
        int wgid = (int)L; { const int q = nwg / NXCD, r = nwg % NXCD, xcd = wgid % NXCD, off = wgid / NXCD; wgid = (xcd < r ? xcd * (q + 1) : r * (q + 1) + (xcd - r) * q) + off; }
        const int nig = WGM * nN, gid = wgid / nig, fm = gid * WGM, gsz = (nM - fm) < WGM ? (nM - fm) : WGM;
        u.pm = fm + ((wgid % nig) % gsz); u.pn = (wgid % nig) / gsz; u.A = A + (size_t)u.pm * tsA; u.B = B + (size_t)u.pn * tsB; u.tab = 0; u.e = 0; return true;
    }
};

__device__ __forceinline__ float shx(float v, int m, int lane) { return __uint_as_float((unsigned)__builtin_amdgcn_ds_bpermute((lane ^ m) << 2, (int)__float_as_uint(v))); }
__device__ __forceinline__ unsigned cvt_pk_bf16(float lo, float hi) { unsigned r; asm volatile("v_cvt_pk_bf16_f32 %0, %1, %2" : "=v"(r) : "v"(lo), "v"(hi)); return r; }

template <class Epi, class Sched, bool ALIGN_EPI, bool GATHER>
__device__ __forceinline__ void gemm_phase(PG8_LAS unsigned char* lds, const int K, const unsigned lda, const Sched& S, const Epi& E, const PG8_LAS int* rowtab, const int ashift) {
    int tid_ = threadIdx.x; asm volatile("" : "+v"(tid_));
    const int tid = tid_, wid = __builtin_amdgcn_readfirstlane(tid >> 6), lane = tid & 63, wr = wid >> 2, wc = wid & 3, fr = lane & 15, fq = lane >> 4;
    const int nt = K / BK;
    unsigned voffB[2], offA[2][2], noffA[2][2]; int Rr[2], Cc[2];
#pragma unroll
    for (int i = 0; i < 2; ++i) { int R, C; stage_rc(tid * 16 + i * 8192, R, C); const int Rb = Epi::PERM ? ((R & ~31) + perm32(R & 31)) : R; Rr[i] = R; Cc[i] = C;
        voffB[i] = (unsigned)(Rb * K + C) * 2u;
#pragma unroll
        for (int h = 0; h < 2; ++h) { offA[h][i] = (unsigned)(R + HALF * h) * lda + (unsigned)C * 2u; noffA[h][i] = offA[h][i]; } }
    const size_t kstep = (size_t)(BK * 2);
    const size_t hstep = (size_t)HALF * K * 2;
    const unsigned ldsw = (unsigned)wid * 1024u;
    const int aoff = lds_byte(wr * 64 + fr, fq * 8), boff = lds_byte(wc * 32 + fr, fq * 8);
#define PG8_SA(b, h) (((b) * 2 + (h)) * HTB)
#define PG8_SB(b, h) ((4 + (b) * 2 + (h)) * HTB)
#define PG8_STAGE(bufoff, gbase, voff) do { _Pragma("unroll") for (int _i = 0; _i < 2; ++_i) \
        __builtin_amdgcn_global_load_lds((const unsigned*)((const char*)(gbase) + (voff)[_i]), (PG8_LAS unsigned*)(lds + (bufoff) + ldsw + _i * 8192), 16, 0, 0); } while (0)
#define PG8_LDA(dst, b, h) do { _Pragma("unroll") for (int m = 0; m < 4; ++m) _Pragma("unroll") for (int k = 0; k < 2; ++k) dst[m][k] = *(const PG8_LAS bf16x8*)(lds + PG8_SA(b, h) + aoff + m * 2048 + k * 1024); } while (0)
#define PG8_LDB(dst, b, h) do { _Pragma("unroll") for (int n = 0; n < 2; ++n) _Pragma("unroll") for (int k = 0; k < 2; ++k) dst[n][k] = *(const PG8_LAS bf16x8*)(lds + PG8_SB(b, h) + boff + n * 2048 + k * 1024); } while (0)
#define PG8_MMA(ai, bj, At, Bt) do { __builtin_amdgcn_s_setprio(1); _Pragma("unroll") for (int m = 0; m < 4; ++m) _Pragma("unroll") for (int n = 0; n < 2; ++n) _Pragma("unroll") for (int k = 0; k < 2; ++k) \
        acc[ai][bj][m][n] = __builtin_amdgcn_mfma_f32_16x16x32_bf16(Bt[n][k], At[m][k], acc[ai][bj][m][n], 0, 0, 0); __builtin_amdgcn_s_setprio(0); } while (0)
#define PG8_WAIT_V(n) asm volatile("s_waitcnt vmcnt(" #n ")" ::: "memory")
#define PG8_WAIT_L(n) asm volatile("s_waitcnt lgkmcnt(" #n ")" ::: "memory")
#define PG8_BAR __builtin_amdgcn_s_barrier()
#define PG8_SCHED __builtin_amdgcn_sched_barrier(0)
#define PG8_GOFF(dst, u) do { if constexpr (GATHER) { _Pragma("unroll") for (int _h = 0; _h < 2; ++_h) _Pragma("unroll") for (int _i = 0; _i < 2; ++_i) { \
        int _e = rowtab[(u).tab * 256 + _h * HALF + Rr[_i]]; _e = _e < 0 ? 0 : (_e >> ashift); dst[_h][_i] = (unsigned)_e * lda + (unsigned)Cc[_i] * 2u; } } } while (0)
    Unit cur, nxt; int ui = 0;
    if (!S.next(0, cur)) return;
    f32x4 acc[2][2][4][2];
#pragma unroll
    for (int a = 0; a < 2; ++a)
#pragma unroll
        for (int b = 0; b < 2; ++b)
#pragma unroll
            for (int m = 0; m < 4; ++m)
#pragma unroll
                for (int n = 0; n < 2; ++n) acc[a][b][m][n] = (f32x4){0.f, 0.f, 0.f, 0.f};
    bf16x8 At[4][2], B0[2][2], B1[2][2];
    const char* cA = cur.A; const char* cB = cur.B;
    PG8_GOFF(offA, cur);
    PG8_STAGE(PG8_SB(0, 0), cB, voffB); PG8_STAGE(PG8_SB(0, 1), cB + hstep, voffB); PG8_STAGE(PG8_SA(0, 0), cA, offA[0]); PG8_STAGE(PG8_SA(0, 1), cA, offA[1]);
    if (wr == 1) PG8_BAR;
    PG8_WAIT_V(2); PG8_BAR;
    PG8_STAGE(PG8_SB(1, 0), cB + kstep, voffB); PG8_STAGE(PG8_SA(1, 0), cA + kstep, offA[0]); PG8_STAGE(PG8_SB(1, 1), cB + hstep + kstep, voffB);
    PG8_WAIT_V(6); PG8_BAR;
    for (;;) {
        const bool has_next = S.next(ui + 1, nxt);
        const char* nA = has_next ? nxt.A : cA; const char* nB = has_next ? nxt.B : cB;
        if constexpr (GATHER) { if (has_next) PG8_GOFF(noffA, nxt); else {
#pragma unroll
            for (int h = 0; h < 2; ++h)
#pragma unroll
                for (int i = 0; i < 2; ++i) noffA[h][i] = offA[h][i]; } }
        for (int t = 0; t < nt; t += 2) {
            const bool last = (t == nt - 2);
            const char* a1 = cA + (size_t)(t + 1) * kstep;
            const char* a2 = last ? nA : cA + (size_t)(t + 2) * kstep; const char* b2 = last ? nB : cB + (size_t)(t + 2) * kstep;
            const char* a3 = a2 + kstep; const char* b3 = b2 + kstep;
            unsigned o2[2][2];
#pragma unroll
            for (int h = 0; h < 2; ++h)
#pragma unroll
                for (int i = 0; i < 2; ++i) o2[h][i] = (GATHER && last) ? noffA[h][i] : offA[h][i];
            PG8_LDB(B0, 0, 0); PG8_LDB(B1, 0, 1); PG8_SCHED; PG8_LDA(At, 0, 0); PG8_STAGE(PG8_SA(1, 1), a1, offA[1]);
            PG8_WAIT_V(8); PG8_WAIT_L(0); PG8_BAR; PG8_MMA(0, 0, At, B0); PG8_MMA(0, 1, At, B1); PG8_BAR; PG8_SCHED;
            PG8_LDA(At, 0, 1); PG8_STAGE(PG8_SB(0, 0), b2, voffB); PG8_STAGE(PG8_SB(0, 1), b2 + hstep, voffB); PG8_STAGE(PG8_SA(0, 0), a2, o2[0]);
            PG8_WAIT_V(8); PG8_WAIT_L(0); PG8_BAR; PG8_MMA(1, 0, At, B0); PG8_MMA(1, 1, At, B1); PG8_BAR; PG8_SCHED;
            PG8_LDB(B0, 1, 0); PG8_LDB(B1, 1, 1); PG8_SCHED; PG8_LDA(At, 1, 0); PG8_STAGE(PG8_SA(0, 1), a2, o2[1]);
            PG8_WAIT_V(8); PG8_WAIT_L(0); PG8_BAR; PG8_MMA(0, 0, At, B0); PG8_MMA(0, 1, At, B1); PG8_BAR; PG8_SCHED;
            PG8_LDA(At, 1, 1); PG8_STAGE(PG8_SB(1, 0), b3, voffB); PG8_STAGE(PG8_SB(1, 1), b3 + hstep, voffB); PG8_STAGE(PG8_SA(1, 0), a3, o2[0]);
            PG8_WAIT_V(8); PG8_WAIT_L(0); PG8_BAR; PG8_MMA(1, 0, At, B0); PG8_MMA(1, 1, At, B1); PG8_BAR; PG8_SCHED;
        }
        if constexpr (ALIGN_EPI) { if (wr == 0) PG8_BAR; }
        E(acc, cur, wr, wc, fr, fq, rowtab);
        if (!has_next) break;
#pragma unroll
        for (int a = 0; a < 2; ++a)
#pragma unroll
            for (int b = 0; b < 2; ++b)
#pragma unroll
                for (int m = 0; m < 4; ++m)
#pragma unroll
                    for (int n = 0; n < 2; ++n) acc[a][b][m][n] = (f32x4){0.f, 0.f, 0.f, 0.f};
        cur = nxt; cA = nA; cB = nB; ++ui;
        if constexpr (GATHER) {
#pragma unroll
            for (int h = 0; h < 2; ++h)
#pragma unroll
                for (int i = 0; i < 2; ++i) offA[h][i] = noffA[h][i]; }
        if constexpr (ALIGN_EPI) { if (wr == 1) PG8_BAR; }
    }
    PG8_WAIT_V(0);
    if constexpr (!ALIGN_EPI) { if (wr == 0) PG8_BAR; }
    PG8_BAR;
#undef PG8_SA
#undef PG8_SB
#undef PG8_STAGE
#undef PG8_LDA
#undef PG8_LDB
#undef PG8_MMA
#undef PG8_WAIT_V
#undef PG8_WAIT_L
#undef PG8_BAR
#undef PG8_SCHED
#undef PG8_GOFF
}

struct EpiQKV {
    static constexpr bool PERM = true;
    bf16_t* Q; bf16_t* Kb; bf16_t* Vb; float qscale;
    unsigned* qm; unsigned* km;
    __device__ __forceinline__ void operator()(const f32x4 (&acc)[2][2][4][2], const Unit& u, int wr, int wc, int fr, int fq, const PG8_LAS int*) const {
        const int row0 = u.pm * BM + wr * 64 + fr; const int t = (u.pn * BM) >> 10; const int colt = (u.pn * BM) & 1023;
        const int col0 = colt + wc * 32 + 8 * fq; const float sc = (t == 0) ? qscale : 1.f;
        bf16_t* kv = (t == 1) ? Kb : Vb;
        float mx[2] = {0.f, 0.f};
#pragma unroll
        for (int ai = 0; ai < 2; ++ai)
#pragma unroll
            for (int m = 0; m < 4; ++m) { const int r = row0 + ai * HALF + m * 16;
                if (r < NR) {
#pragma unroll
                for (int bj = 0; bj < 2; ++bj) { const f32x4 v0 = acc[ai][bj][m][0] * sc, v1 = acc[ai][bj][m][1] * sc;
                    u32x4 w; w.x = cvt_pk_bf16(v0[0], v0[1]); w.y = cvt_pk_bf16(v0[2], v0[3]); w.z = cvt_pk_bf16(v1[0], v1[1]); w.w = cvt_pk_bf16(v1[2], v1[3]);
                    const int c = col0 + bj * HALF;
                    bf16_t* dst = (t == 0) ? Q + (size_t)r * DM : kv + (size_t)(r < NREAL ? (r >> 13) * KROWS + KPRE + (r & (SEQ - 1)) : r - NREAL) * DM;
                    *(u32x4*)(dst + c) = w; } }
                if (qm != nullptr && t < 2) {
#pragma unroll
                    for (int bj = 0; bj < 2; ++bj) { const f32x4 v0 = acc[ai][bj][m][0] * sc, v1 = acc[ai][bj][m][1] * sc;
                        float ss = (v0[0] * v0[0] + v0[1] * v0[1]) + (v0[2] * v0[2] + v0[3] * v0[3]) + (v1[0] * v1[0] + v1[1] * v1[1]) + (v1[2] * v1[2] + v1[3] * v1[3]);
                        ss += shx(ss, 16, fq * 16 + fr); ss += shx(ss, 32, fq * 16 + fr);
                        if (r < NR) mx[bj] = fmaxf(mx[bj], ss); } } }
        if (qm != nullptr && t < 2) {
#pragma unroll
            for (int bj = 0; bj < 2; ++bj) { float v = mx[bj]; v = fmaxf(v, shx(v, 1, fq * 16 + fr)); v = fmaxf(v, shx(v, 2, fq * 16 + fr)); v = fmaxf(v, shx(v, 4, fq * 16 + fr)); v = fmaxf(v, shx(v, 8, fq * 16 + fr));
                if (fr == 0 && fq == 0) { const int head = 4 * (u.pn & 3) + 2 * bj + (wc >> 1), part = wc & 1; const unsigned bits = __float_as_uint(v);
                    if (t == 0) { if (u.pm < NREAL / BM) atomicMax(qm + ((size_t)u.pm * 16 + head) * 8 + part, bits); }
                    else if (u.pm < NREAL / BM) atomicMax(km + ((size_t)(u.pm >> 5) * 16 + head) * 8 + part, bits);
                    else { for (int b = 0; b < NBATCH; ++b) atomicMax(km + ((size_t)b * 16 + head) * 8 + part, bits); } } } }
    }
};
struct EpiZ {
    static constexpr bool PERM = true;
    bf16_t* H;
    __device__ __forceinline__ void operator()(const f32x4 (&acc)[2][2][4][2], const Unit& u, int wr, int wc, int fr, int fq, const PG8_LAS int*) const {
        const int row0 = u.pm * BM + wr * 64 + fr; const int col0 = u.pn * BM + wc * 32 + 8 * fq;
#pragma unroll
        for (int ai = 0; ai < 2; ++ai)
#pragma unroll
            for (int m = 0; m < 4; ++m) { const int r = row0 + ai * HALF + m * 16;
                if (r < NR) {
#pragma unroll
                    for (int bj = 0; bj < 2; ++bj) { bf16_t* hp = H + (size_t)r * DM + col0 + bj * HALF; const u32x4 b = *(const u32x4*)hp;
                        const f32x4 v0 = acc[ai][bj][m][0], v1 = acc[ai][bj][m][1];
                        u32x4 w; w.x = cvt_pk_bf16(v0[0] + ALPHA * __uint_as_float(b.x << 16), v0[1] + ALPHA * __uint_as_float(b.x & 0xffff0000u)); w.y = cvt_pk_bf16(v0[2] + ALPHA * __uint_as_float(b.y << 16), v0[3] + ALPHA * __uint_as_float(b.y & 0xffff0000u));
                        w.z = cvt_pk_bf16(v1[0] + ALPHA * __uint_as_float(b.z << 16), v1[1] + ALPHA * __uint_as_float(b.z & 0xffff0000u)); w.w = cvt_pk_bf16(v1[2] + ALPHA * __uint_as_float(b.w << 16), v1[3] + ALPHA * __uint_as_float(b.w & 0xffff0000u));
                        *(u32x4*)hp = w; } } }
    }
};
struct EpiGU {
    static constexpr bool PERM = true;
    bf16_t* U;
    __device__ __forceinline__ void operator()(const f32x4 (&acc)[2][2][4][2], const Unit& u, int wr, int wc, int fr, int fq, const PG8_LAS int* rowtab) const {
        const int col0 = u.pn * HALF + wc * 32 + 8 * fq;
#pragma unroll
        for (int ai = 0; ai < 2; ++ai)
#pragma unroll
            for (int m = 0; m < 4; ++m) { const int slot = rowtab[u.tab * 256 + ai * HALF + wr * 64 + m * 16 + fr];
                if (slot >= 0) { float o[8];
#pragma unroll
                    for (int n = 0; n < 2; ++n)
#pragma unroll
                        for (int c = 0; c < 4; ++c) { const float g = acc[ai][0][m][n][c], up = acc[ai][1][m][n][c]; o[n * 4 + c] = g * up * __builtin_amdgcn_rcpf(1.f + __builtin_amdgcn_exp2f(-g * LOG2E)); }
                    u32x4 w; w.x = cvt_pk_bf16(o[0], o[1]); w.y = cvt_pk_bf16(o[2], o[3]); w.z = cvt_pk_bf16(o[4], o[5]); w.w = cvt_pk_bf16(o[6], o[7]);
                    *(u32x4*)(U + (size_t)slot * DEXP + col0) = w; } }
    }
};
struct EpiDown {
    static constexpr bool PERM = true;
    bf16_t* Y; const float* GV;
    __device__ __forceinline__ void operator()(const f32x4 (&acc)[2][2][4][2], const Unit& u, int wr, int wc, int fr, int fq, const PG8_LAS int* rowtab) const {
        const int col0 = u.pn * BM + wc * 32 + 8 * fq;
#pragma unroll
        for (int ai = 0; ai < 2; ++ai)
#pragma unroll
            for (int m = 0; m < 4; ++m) { const int slot = rowtab[u.tab * 256 + ai * HALF + wr * 64 + m * 16 + fr];
                if (slot >= 0) { const float gv = GV[slot];
#pragma unroll
                    for (int bj = 0; bj < 2; ++bj) { const f32x4 v0 = acc[ai][bj][m][0] * gv, v1 = acc[ai][bj][m][1] * gv;
                        u32x4 w; w.x = cvt_pk_bf16(v0[0], v0[1]); w.y = cvt_pk_bf16(v0[2], v0[3]); w.z = cvt_pk_bf16(v1[0], v1[1]); w.w = cvt_pk_bf16(v1[2], v1[3]);
                        *(u32x4*)(Y + (size_t)slot * DM + col0 + bj * HALF) = w; } } }
    }
};
}
namespace attn_body {
using bf16=__hip_bfloat16;
using bf16x8=__attribute__((ext_vector_type(8)))short;
using s16x4=__attribute__((ext_vector_type(4)))short;
using f32x16=__attribute__((ext_vector_type(16)))float;
using u32x4=__attribute__((ext_vector_type(4)))unsigned;
constexpr int D=64;
constexpr int NW=8,QBLK=32,QB=QBLK*NW,KVBLK=64,NQB=SEQ/QB;
constexpr int ATTN_PITCH=DM, ATTN_UNIT_ROWS=QB;
__device__ __forceinline__ int crow(int r,int hi){return (r&3)+8*(r>>2)+4*hi;}
#define SBAR() __builtin_amdgcn_sched_barrier(0)
__device__ __forceinline__ void cmask(f32x16&p0,f32x16&p1,int jb,int qrel,int hi){
  const float NEG=-INFINITY; int kb=64*jb+4*hi;
  #pragma unroll
  for(int r=0;r<16;++r){int kv=kb+(r&3)+8*(r>>2); if(kv>qrel)p0[r]=NEG; if(kv+32>qrel)p1[r]=NEG;}
}

constexpr int RT_OFFS=320, RT_SIZE=704;

template<int MODE> __device__ __forceinline__ void modtile_slow(f32x16&p0,f32x16&p1,int t,int q_abs,int hi,const __attribute__((address_space(3))) float* tab){
  const float NEG=-INFINITY; int hi4=4*hi; asm volatile("":"+v"(hi4),"+v"(q_abs));
  if(MODE==0){
    if(t==0){
      int bd=16+q_abs; bd=bd>383?383:bd; const __attribute__((address_space(3))) float* bp=tab+(RT_OFFS+bd-hi4-15);
      #pragma unroll
      for(int r=0;r<16;++r){ p1[r]=NEG; if(r<8)p0[r]+=bp[15-((r&3)+8*(r>>2))]; else p0[r]=NEG; }
    } else {
      const __attribute__((address_space(3))) float* bp=tab+(RT_OFFS+q_abs-64*t+KPRE-hi4-63);
      const int dq=q_abs-64*t+KPRE-hi4;
      #pragma unroll
      for(int r=0;r<16;++r){ const int c=(r&3)+8*(r>>2); p0[r]+=bp[63-c]; p1[r]+=bp[31-c]; if(c>dq)p0[r]=NEG; if(c+32>dq)p1[r]=NEG; }
    }
  } else {
    #pragma unroll
    for(int r=0;r<16;++r){
      #pragma unroll
      for(int hf=0;hf<2;++hf){
        const int js=32*hf+(r&3)+8*(r>>2)+hi4;
        const int ks=64*t+js;
        float x=hf?p1[r]:p0[r];
        if(t==0){ if(js>=NMETA)x=NEG; else x+=tab[ks]; }
        else { const int kr=ks-KPRE; if(kr>q_abs)x=NEG; else x+=tab[ks]; }
        if(hf)p1[r]=x; else p0[r]=x; }
      if((r&1)==1)asm volatile("":::"memory"); }
  }
}
__device__ __forceinline__ void modtile_fast1(f32x16&p0,f32x16&p1,int t,int hi,const __attribute__((address_space(3))) float* tab){
  typedef float f4 __attribute__((ext_vector_type(4)));
  const __attribute__((address_space(3))) f4* tp=(const __attribute__((address_space(3))) f4*)(tab+64*t+4*hi);
  #pragma unroll
  for(int g=0;g<4;++g){ const f4 a=tp[2*g], b=tp[8+2*g];
    #pragma unroll
    for(int c=0;c<4;++c){ p0[4*g+c]+=a[c]; p1[4*g+c]+=b[c]; } }
}
constexpr int NSLOT=3, SLOTB=8192;
constexpr int LDS_K=0, LDS_V=NSLOT*SLOTB, LDS_WS=2*NSLOT*SLOTB, LDS_OST=LDS_WS+NW*64*4, LDS_TAB=LDS_OST+NW*4096, LDS_BYTES=LDS_TAB+KROWS*4;
constexpr float C2=0.125f*1.4426950408889634f;
__device__ __forceinline__ void glds16(const void*gsrc,unsigned lds_dst){unsigned keep;
  asm volatile("s_mov_b32 %0, m0\n\ts_mov_b32 m0, %2\n\ts_nop 0\n\tglobal_load_lds_dwordx4 %1, off\n\ts_mov_b32 m0, %0":"=&s"(keep):"v"(gsrc),"s"(lds_dst):"memory");}
__device__ __forceinline__ float max3f(float a,float b,float c){float r;asm("v_max3_f32 %0, %1, %2, %3":"=v"(r):"v"(a),"v"(b),"v"(c));return r;}
__device__ __forceinline__ float max2f(float a,float b){float r;asm("v_max_f32_e32 %0, %1, %2":"=v"(r):"v"(a),"v"(b));return r;}
__device__ __forceinline__ float fadd_s(float a,float b){float r;asm("v_add_f32_e32 %0, %1, %2":"=v"(r):"v"(a),"v"(b));return r;}
__device__ __forceinline__ float fsub_s(float a,float b){float r;asm("v_sub_f32_e32 %0, %1, %2":"=v"(r):"v"(a),"v"(b));return r;}
typedef float f32x2_t __attribute__((ext_vector_type(2))); typedef __bf16 bf16x2_t __attribute__((ext_vector_type(2)));
__device__ __forceinline__ unsigned cvtpk_s(float lo,float hi){f32x2_t v={lo,hi};bf16x2_t b=__builtin_convertvector(v,bf16x2_t);return __builtin_bit_cast(unsigned,b);}
#define WAIT_BAR(N) asm volatile("s_waitcnt vmcnt(" #N ") lgkmcnt(0)\n\ts_barrier":::"memory")

__device__ __forceinline__ void qkt(f32x16&p0,f32x16&p1,const char*Kslot,const bf16x8*qr,const f32x16&negm,int r32,int hi){
  const char*kb=Kslot+hi*1024+r32*16;
  #pragma unroll
  for(int d0=0;d0<4;++d0){
    const bf16x8 b0=*reinterpret_cast<const bf16x8*>(kb+d0*2048);
    const bf16x8 b1=*reinterpret_cast<const bf16x8*>(kb+d0*2048+512);
    if(d0==0){p0=__builtin_amdgcn_mfma_f32_32x32x16_bf16(b0,qr[0],negm,0,0,0);p1=__builtin_amdgcn_mfma_f32_32x32x16_bf16(b1,qr[0],negm,0,0,0);}
    else{p0=__builtin_amdgcn_mfma_f32_32x32x16_bf16(b0,qr[d0],p0,0,0,0);p1=__builtin_amdgcn_mfma_f32_32x32x16_bf16(b1,qr[d0],p1,0,0,0);}}
}
typedef __attribute__((address_space(3))) const char* lds_cptr;
typedef short v4i16_t __attribute__((ext_vector_type(4)));
__device__ __forceinline__ void kload8(bf16x8*kf,lds_cptr kp){
  kf[0]=*(const __attribute__((address_space(3))) bf16x8*)(kp);      kf[1]=*(const __attribute__((address_space(3))) bf16x8*)(kp+512);
  kf[2]=*(const __attribute__((address_space(3))) bf16x8*)(kp+2048); kf[3]=*(const __attribute__((address_space(3))) bf16x8*)(kp+2560);
  kf[4]=*(const __attribute__((address_space(3))) bf16x8*)(kp+4096); kf[5]=*(const __attribute__((address_space(3))) bf16x8*)(kp+4608);
  kf[6]=*(const __attribute__((address_space(3))) bf16x8*)(kp+6144); kf[7]=*(const __attribute__((address_space(3))) bf16x8*)(kp+6656);
}
__device__ __forceinline__ void kload2(bf16x8*kf,lds_cptr kp,int j){ kf[2*j]=*(const __attribute__((address_space(3))) bf16x8*)(kp+j*2048); kf[2*j+1]=*(const __attribute__((address_space(3))) bf16x8*)(kp+j*2048+512); }
__device__ __forceinline__ s16x4 vtr(lds_cptr p){ return __builtin_bit_cast(s16x4,__builtin_amdgcn_ds_read_tr16_b64_v4i16((__attribute__((address_space(3))) v4i16_t*)p)); }
__device__ __forceinline__ float rowmax(const f32x16&p0,const f32x16&p1){
  float a=max3f(p0[0],p0[1],p1[0]),b=max3f(p0[2],p0[3],p1[1]);a=max3f(a,p1[2],p1[3]);
  #pragma unroll
  for(int r=4;r<16;r+=4){a=max3f(a,p0[r],p0[r+1]);b=max3f(b,p0[r+2],p0[r+3]);a=max3f(a,p1[r],p1[r+1]);b=max3f(b,p1[r+2],p1[r+3]);}
  const float m=max2f(a,b);
  auto rr=__builtin_amdgcn_permlane32_swap(__float_as_uint(m),__float_as_uint(m),false,false);
  return max2f(__uint_as_float(rr[0]),__uint_as_float(rr[1]));
}
__device__ __forceinline__ void pv(f32x16*o,int vb,bf16x8 pa0,bf16x8 pa1,bf16x8 pa2,bf16x8 pa3){
  #pragma unroll
  for(int d0=0;d0<2;++d0){s16x4 lo[4],hi[4];
    #pragma unroll
    for(int ks=0;ks<4;++ks){
      asm volatile("ds_read_b64_tr_b16 %0,%1 offset:%c2":"=&v"(lo[ks]):"v"(vb),"i"(d0*4096+ks*1024):"memory");
      asm volatile("ds_read_b64_tr_b16 %0,%1 offset:%c2":"=&v"(hi[ks]):"v"(vb),"i"(d0*4096+ks*1024+512):"memory");}
    asm volatile("s_waitcnt lgkmcnt(0)":::"memory");SBAR();
    #define PK(k) (bf16x8){lo[k][0],lo[k][1],lo[k][2],lo[k][3],hi[k][0],hi[k][1],hi[k][2],hi[k][3]}
    o[d0]=__builtin_amdgcn_mfma_f32_32x32x16_bf16(pa0,PK(0),o[d0],0,0,0);
    o[d0]=__builtin_amdgcn_mfma_f32_32x32x16_bf16(pa1,PK(1),o[d0],0,0,0);
    o[d0]=__builtin_amdgcn_mfma_f32_32x32x16_bf16(pa2,PK(2),o[d0],0,0,0);
    o[d0]=__builtin_amdgcn_mfma_f32_32x32x16_bf16(pa3,PK(3),o[d0],0,0,0);
    #undef PK
  }
}

#ifndef ATTN_STORE16
#define ATTN_STORE16(p,v) (*(u32x4*)(p)=(v))
#endif
template<int MODE,int THRL> __device__ __forceinline__ void attn_unit(int b,int qb,int tb,int cq,int cv,int co,const bf16*Q,const bf16*__restrict__ K,const bf16*__restrict__ V,bf16*O,const float*tabsrc,char*shm){
  int tid_=threadIdx.x; asm volatile("":"+v"(tid_));
  const int tid=tid_,lane=tid&63,r32=lane&31,hi=lane>>5; const int wid=__builtin_amdgcn_readfirstlane(tid>>6);
  const long rowbase=(long)b*SEQ, rowbase_k=(long)b*KROWS; const int q0=qb*QB;
  const bf16*Qw=Q+(rowbase+q0+wid*QBLK)*DM+cq;
  const bf16*Kh=K+rowbase_k*DM+cq,*Vh=V+rowbase_k*DM+cv;
  const unsigned lds0=(unsigned)(uintptr_t)shm;
  const __attribute__((address_space(3))) char* shm3_=(const __attribute__((address_space(3))) char*)shm;
  float*wsf=(float*)(shm+LDS_WS)+wid*64;
  const bf16*ksrc=Kh+(long)(lane+64*tb)*DM+wid*8;
  const bf16*vsrc=Vh+(long)(16*(wid&3)+(lane>>2)+64*tb)*DM+(wid>>2)*32+(lane&3)*8;
  const unsigned kdst=lds0+LDS_K+wid*1024, vdst=lds0+LDS_V+wid*1024;
  #define DMA_K(t,slot) glds16(ksrc+(long)(t)*KVBLK*DM,(unsigned)__builtin_amdgcn_readfirstlane(kdst+(slot)))
  #define DMA_V(t,slot) glds16(vsrc+(long)(t)*KVBLK*DM,(unsigned)__builtin_amdgcn_readfirstlane(vdst+(slot)))
  const int vb0=(int)(lds0+LDS_V)+((lane>>4)&1)*32+(lane&3)*8+(4*hi+((lane&15)>>2))*64;
  const char*Kbase=shm+LDS_K; bf16x8 kf[8];
  const lds_cptr shm3=(lds_cptr)shm; const lds_cptr kp0=shm3+LDS_K+hi*1024+r32*16; const lds_cptr vp0=shm3+LDS_V+((lane>>4)&1)*32+(lane&3)*8+(4*hi+((lane&15)>>2))*64;
  const int NT=(KPRE+q0+QB+KVBLK)/KVBLK-tb;
  const __attribute__((address_space(3))) float* tab=(const __attribute__((address_space(3))) float*)(shm3_+LDS_TAB);
  { __attribute__((address_space(3))) float* tw=(__attribute__((address_space(3))) float*)(shm3_+LDS_TAB);
    if(MODE==0){ for(int i=tid;i<RT_SIZE;i+=512){ const int d=i-RT_OFFS; tw[i]=d<0?-INFINITY:(d<128?tabsrc[d]:0.f); } }
    else { const int n=KPRE+q0+QB+KVBLK; for(int i=64*tb+tid*4;i<n;i+=2048){ const float4 v=*(const float4*)(tabsrc+i); tw[i]=v.x;tw[i+1]=v.y;tw[i+2]=v.z;tw[i+3]=v.w; } } }
  if(tb==0){ glds16(K+cq+(long)lane*DM+wid*8,(unsigned)__builtin_amdgcn_readfirstlane(kdst)); glds16(V+cv+(long)(16*(wid&3)+(lane>>2))*DM+(wid>>2)*32+(lane&3)*8,(unsigned)__builtin_amdgcn_readfirstlane(vdst)); } else { DMA_K(0,0); DMA_V(0,0); } DMA_K(1,SLOTB);
  bf16x8 qr[4];
  #pragma unroll
  for(int d0=0;d0<4;++d0)qr[d0]=*reinterpret_cast<const bf16x8*>(&Qw[(long)r32*DM+d0*16+hi*8]);
  float mhat=0.f,l_reg=0.f;f32x16 o[2];o[0]=f32x16{};o[1]=f32x16{};f32x16 negm=f32x16{};asm volatile("":"+v"(negm));
  const int qrel=wid*QBLK+r32, q_abs=q0+qrel;
  #define MODT(P0,P1,t,SL) do{ if(SL)modtile_slow<MODE>(P0,P1,(t)+tb,q_abs,hi,tab); else if(MODE==1)modtile_fast1(P0,P1,(t)+tb,hi,tab); }while(0)
  bool resc=false;
  #define START(P0,P1) do{ const float rm=rowmax(P0,P1); resc=false; \
    { const float dl=(MODE==1)?__builtin_fmaxf(rm,0.f):rm; mhat=fadd_s(mhat,dl); \
      _Pragma("unroll") for(int r=0;r<16;++r){P0[r]=fsub_s(P0[r],dl);P1[r]=fsub_s(P1[r],dl);} \
      _Pragma("unroll") for(int r=0;r<16;++r)negm[r]=-mhat; asm volatile("":"+v"(negm)); } \
    _Pragma("unroll") for(int r=0;r<16;++r)P0[r]=__builtin_amdgcn_exp2f(P0[r]); }while(0)
  #define RESC() do{ if(resc){ asm volatile("s_waitcnt lgkmcnt(0)":::"memory"); \
      _Pragma("unroll") for(int d_=0;d_<2;++d_) _Pragma("unroll") for(int r=0;r<16;++r)o[d_][r]*=wsf[crow(r,hi)]; } }while(0)
  f32x16 pA0,pA1,pB0,pB1;
  int sl_prev=0,sl_cur=0,sl_next=SLOTB;
  #define ROT() do{sl_prev=sl_cur;sl_cur=sl_next;sl_next=(sl_next==(NSLOT-1)*SLOTB)?0:sl_next+SLOTB;}while(0)
  DMA_K(2,2*SLOTB);
  WAIT_BAR(3);
  if(MODE==1){ mhat=tab[KPRE+q_abs]; _Pragma("unroll") for(int r=0;r<16;++r)negm[r]=-mhat; asm volatile("":"+v"(negm)); }
  qkt(pA0,pA1,Kbase,qr,negm,r32,hi);asm volatile("s_nop 15\n\ts_nop 7":"+v"(pA0),"+v"(pA1));MODT(pA0,pA1,0,true);
  START(pA0,pA1);
  _Pragma("unroll") for(int r=0;r<16;++r)pA1[r]=__builtin_amdgcn_exp2f(pA1[r]);
  WAIT_BAR(0);
  DMA_K(3,0);DMA_V(1,SLOTB);
  ROT();
  kload8(kf,kp0+sl_cur);
  WAIT_BAR(2);
  s16x4 vlo[8],vhi[8]; u32x4 pw0,pw1,pw2,pw3;
  #define PKW(P,B) cvtpk_s(P[B],P[B+1])
  #define PAF(k) __builtin_bit_cast(bf16x8,pw##k)
  #define VFR(i) (bf16x8){vlo[i][0],vlo[i][1],vlo[i][2],vlo[i][3],vhi[i][0],vhi[i][1],vhi[i][2],vhi[i][3]}
  #define PIN(x) asm volatile("":"+v"(x))
  #define MX3(a,b,c) __builtin_fmaxf(__builtin_fmaxf((a),(b)),(c))
  #define GAPA(MF,A0,A1,A2,A3,W0,W1,PW) do{ MF; sacc+=A0; sacc+=A1; sacc+=A2; sacc+=A3; PIN(sacc); W0; W1; PIN(PW); SBAR(); }while(0)
  #define EX(v) __builtin_amdgcn_exp2f(v)
  #define GAPB(MF,X,B) do{ MF; X[B]=EX(X[B]); X[B+1]=EX(X[B+1]); X[B+2]=EX(X[B+2]); X[B+3]=EX(X[B+3]); PIN(X); SBAR(); }while(0)
  #define VRD(i) do{ vlo[i]=vtr(vp_+(((i)>>2)*4096+((i)&3)*1024)); vhi[i]=vtr(vp_+(((i)>>2)*4096+((i)&3)*1024+512)); }while(0)
  #define KRD(G,j) do{ if(G){ kload2(kf,kp0+sl_next,j); SBAR(); } }while(0)
  #define STEP(C0,C1,P0,P1,t,GK,GV,GL,SL) do{ SBAR(); \
    const lds_cptr vp_=vp0+sl_prev; \
    VRD(0); SBAR(); float sacc=(P0[0]+P0[1]); \
    GAPA(C0=__builtin_amdgcn_mfma_f32_32x32x16_bf16(kf[0],qr[0],negm,0,0,0), P0[2],P0[3],P0[4],P0[5],     pw0[0]=PKW(P0,0), pw0[1]=PKW(P0,2), pw0); \
    VRD(4); SBAR(); GAPA(C1=__builtin_amdgcn_mfma_f32_32x32x16_bf16(kf[1],qr[0],negm,0,0,0), P0[6],P0[7],P0[8],P0[9],     pw0[2]=PKW(P0,4), pw0[3]=PKW(P0,6), pw0); \
    VRD(1); SBAR(); GAPA(C0=__builtin_amdgcn_mfma_f32_32x32x16_bf16(kf[2],qr[1],C0,0,0,0),   P0[10],P0[11],P0[12],P0[13], pw1[0]=PKW(P0,8), pw1[1]=PKW(P0,10), pw1); \
    VRD(5); SBAR(); GAPA(C1=__builtin_amdgcn_mfma_f32_32x32x16_bf16(kf[3],qr[1],C1,0,0,0),   P0[14],P0[15],P1[0],P1[1],   pw1[2]=PKW(P0,12),pw1[3]=PKW(P0,14), pw1); \
    VRD(2); SBAR(); GAPA(C0=__builtin_amdgcn_mfma_f32_32x32x16_bf16(kf[4],qr[2],C0,0,0,0),   P1[2],P1[3],P1[4],P1[5],     pw2[0]=PKW(P1,0), pw2[1]=PKW(P1,2), pw2); \
    VRD(6); SBAR(); GAPA(C1=__builtin_amdgcn_mfma_f32_32x32x16_bf16(kf[5],qr[2],C1,0,0,0),   P1[6],P1[7],P1[8],P1[9],     pw2[2]=PKW(P1,4), pw2[3]=PKW(P1,6), pw2); \
    VRD(3); SBAR(); GAPA(C0=__builtin_amdgcn_mfma_f32_32x32x16_bf16(kf[6],qr[3],C0,0,0,0),   P1[10],P1[11],P1[12],P1[13], pw3[0]=PKW(P1,8), pw3[1]=PKW(P1,10), pw3); \
    VRD(7); SBAR(); GAPA(C1=__builtin_amdgcn_mfma_f32_32x32x16_bf16(kf[7],qr[3],C1,0,0,0),   P1[14],P1[15],0.f,0.f,       pw3[2]=PKW(P1,12),pw3[3]=PKW(P1,14), pw3); \
    l_reg+=sacc; \
    if(GK){DMA_K((t)+3,sl_cur);} if(GV){DMA_V((t)+1,sl_next);} \
    MODT(C0,C1,t,SL); \
    { float a=MX3(C0[0],C0[1],C1[0]),b=MX3(C0[2],C0[3],C1[1]); a=MX3(a,C1[2],C1[3]); \
      _Pragma("unroll") for(int r=4;r<16;r+=4){a=MX3(a,C0[r],C0[r+1]);b=MX3(b,C0[r+2],C0[r+3]);a=MX3(a,C1[r],C1[r+1]);b=MX3(b,C1[r+2],C1[r+3]);} \
      float rm=__builtin_fmaxf(a,b); { auto rr=__builtin_amdgcn_permlane32_swap(__float_as_uint(rm),__float_as_uint(rm),false,false); rm=__builtin_fmaxf(__uint_as_float(rr[0]),__uint_as_float(rr[1])); } \
      resc=false; \
      if(__builtin_expect(__any(rm>(float)THRL),0)){ const float dl=__builtin_fmaxf(rm,0.f); mhat+=dl; \
        _Pragma("unroll") for(int r=0;r<16;++r){C0[r]-=dl;C1[r]-=dl;} \
        _Pragma("unroll") for(int r=0;r<16;++r)negm[r]=-mhat; asm volatile("":"+v"(negm)); \
        const float f=__builtin_amdgcn_exp2f(-dl); l_reg*=f; if(hi==0)wsf[r32]=f; resc=true; } } \
    SBAR(); \
    GAPB(o[0]=__builtin_amdgcn_mfma_f32_32x32x16_bf16(PAF(0),VFR(0),o[0],0,0,0), C0,0); \
    GAPB(o[1]=__builtin_amdgcn_mfma_f32_32x32x16_bf16(PAF(0),VFR(4),o[1],0,0,0), C0,4); \
    KRD(GL,0); GAPB(o[0]=__builtin_amdgcn_mfma_f32_32x32x16_bf16(PAF(1),VFR(1),o[0],0,0,0), C0,8); \
    KRD(GL,1); GAPB(o[1]=__builtin_amdgcn_mfma_f32_32x32x16_bf16(PAF(1),VFR(5),o[1],0,0,0), C0,12); \
    KRD(GL,2); GAPB(o[0]=__builtin_amdgcn_mfma_f32_32x32x16_bf16(PAF(2),VFR(2),o[0],0,0,0), C1,0); \
    KRD(GL,3); GAPB(o[1]=__builtin_amdgcn_mfma_f32_32x32x16_bf16(PAF(2),VFR(6),o[1],0,0,0), C1,4); \
    GAPB(o[0]=__builtin_amdgcn_mfma_f32_32x32x16_bf16(PAF(3),VFR(3),o[0],0,0,0), C1,8); \
    GAPB(o[1]=__builtin_amdgcn_mfma_f32_32x32x16_bf16(PAF(3),VFR(7),o[1],0,0,0), C1,12); \
    }while(0)
  int t=1;
  #define ENDW(tt) do{ if((tt)+3<NT){WAIT_BAR(2);} else if((tt)+2<NT){WAIT_BAR(1);} else {WAIT_BAR(0);} }while(0)
  for(;t+7<NT;t+=2){
    STEP(pB0,pB1,pA0,pA1,t,true,true,true,false);     WAIT_BAR(2); RESC(); ROT();
    STEP(pA0,pA1,pB0,pB1,t+1,true,true,true,false);   WAIT_BAR(2); RESC(); ROT();
  }
  for(;t+1<NT;t+=2){
    STEP(pB0,pB1,pA0,pA1,t,(t+3<NT),(t+1<NT),(t+1<NT),true);       ENDW(t);   RESC(); ROT();
    STEP(pA0,pA1,pB0,pB1,t+1,(t+4<NT),(t+2<NT),(t+2<NT),true);     ENDW(t+1); RESC(); ROT();
  }
  STEP(pB0,pB1,pA0,pA1,NT-1,false,false,false,true); RESC();
  { float sacc=pB0[0]+pB0[1]; _Pragma("unroll") for(int r=2;r<16;++r)sacc+=pB0[r]; _Pragma("unroll") for(int r=0;r<16;++r)sacc+=pB1[r]; l_reg+=sacc;
    pw0=(u32x4){PKW(pB0,0),PKW(pB0,2),PKW(pB0,4),PKW(pB0,6)};pw1=(u32x4){PKW(pB0,8),PKW(pB0,10),PKW(pB0,12),PKW(pB0,14)};pw2=(u32x4){PKW(pB1,0),PKW(pB1,2),PKW(pB1,4),PKW(pB1,6)};pw3=(u32x4){PKW(pB1,8),PKW(pB1,10),PKW(pB1,12),PKW(pB1,14)};
    SBAR(); pv(o,vb0+sl_cur,PAF(0),PAF(1),PAF(2),PAF(3)); }
  #undef PKW
  #undef PAF
  #undef VFR
  #undef PIN
  #undef MX3
  #undef GAPA
  #undef GAPB
  #undef EX
  #undef VRD
  #undef KRD
  #undef STEP
  #undef ENDW
  {auto rr=__builtin_amdgcn_permlane32_swap(__float_as_uint(l_reg),__float_as_uint(l_reg),false,false);l_reg=__uint_as_float(rr[0])+__uint_as_float(rr[1]);}
  if(hi==0)wsf[32+r32]=l_reg;asm volatile("s_waitcnt lgkmcnt(0)":::"memory");
  float rli[16];
  #pragma unroll
  for(int r=0;r<16;++r)rli[r]=__builtin_amdgcn_rcpf(wsf[32+crow(r,hi)]);
  bf16*Ow=O+(rowbase+q0+wid*QBLK)*DM+co;
  { bf16*stg=(bf16*)(shm+LDS_OST)+wid*2048;
    #pragma unroll
    for(int r=0;r<16;++r){const int orow=crow(r,hi);
      #pragma unroll
      for(int d0=0;d0<2;++d0)stg[orow*64+d0*32+r32]=__float2bfloat16(o[d0][r]*rli[r]);}
    asm volatile("s_waitcnt lgkmcnt(0)":::"memory");
    #pragma unroll
    for(int i=0;i<4;++i){const int row=i*8+(lane>>3),ch=lane&7; const u32x4 v=*(const u32x4*)(stg+row*64+ch*8); ATTN_STORE16(Ow+(long)row*DM+ch*8,v);} }
  asm volatile("s_waitcnt lgkmcnt(0)\n\ts_barrier":::"memory");
  #undef DMA_K
  #undef DMA_V
  #undef MODT
  #undef START
  #undef RESC
  #undef ROT
}

template<int THRL> __device__ __forceinline__ void attn_unit_dv(int b,int qb,int cq,int cv,int co,const bf16*Q,const bf16*__restrict__ K,const bf16*__restrict__ V,bf16*O,const float*tabsrc,char*shm){
  int tid_=threadIdx.x; asm volatile("":"+v"(tid_));
  constexpr int MODE=0, tb=0; const int tid=tid_,lane=tid&63,r32=lane&31,hi=lane>>5; const int wid=__builtin_amdgcn_readfirstlane(tid>>6);
  constexpr int LDS_K=0, LDS_V=NSLOT*SLOTB, LDS_WS=LDS_V+NSLOT*2*SLOTB, LDS_OST=LDS_WS+NW*64*4, LDS_TAB=LDS_OST+NW*4096;
  static_assert(LDS_TAB+RT_SIZE*4<=131072,"dv LDS map");
  const long rowbase=(long)b*SEQ, rowbase_k=(long)b*KROWS; const int q0=qb*QB;
  const bf16*Qw=Q+(rowbase+q0+wid*QBLK)*DM+cq;
  const bf16*Kh=K+rowbase_k*DM+cq,*Vh=V+rowbase_k*DM+cv;
  const unsigned lds0=(unsigned)(uintptr_t)shm;
  const __attribute__((address_space(3))) char* shm3_=(const __attribute__((address_space(3))) char*)shm;
  float*wsf=(float*)(shm+LDS_WS)+wid*64;
  const bf16*ksrc=Kh+(long)(lane+64*tb)*DM+wid*8;
  const bf16*vsrc=Vh+(long)(16*(wid&3)+(lane>>2)+64*tb)*DM+(wid>>2)*32+(lane&3)*8;
  const unsigned kdst=lds0+LDS_K+wid*1024, vdst=lds0+LDS_V+wid*1024;
  #define DMA_K(t,slot) glds16(ksrc+(long)(t)*KVBLK*DM,(unsigned)__builtin_amdgcn_readfirstlane(kdst+(slot)))
  #define DMA_V(t,slot) do{ glds16(vsrc+(long)(t)*KVBLK*DM,(unsigned)__builtin_amdgcn_readfirstlane(vdst+2*(slot))); glds16(vsrc+(long)(t)*KVBLK*DM+64,(unsigned)__builtin_amdgcn_readfirstlane(vdst+2*(slot)+8192)); }while(0)
  const int vb0=(int)(lds0+LDS_V)+((lane>>4)&1)*32+(lane&3)*8+(4*hi+((lane&15)>>2))*64;
  const char*Kbase=shm+LDS_K; bf16x8 kf[8];
  const lds_cptr shm3=(lds_cptr)shm; const lds_cptr kp0=shm3+LDS_K+hi*1024+r32*16; const lds_cptr vp0=shm3+LDS_V+((lane>>4)&1)*32+(lane&3)*8+(4*hi+((lane&15)>>2))*64;
  const int NT=(KPRE+q0+QB+KVBLK)/KVBLK-tb;
  const __attribute__((address_space(3))) float* tab=(const __attribute__((address_space(3))) float*)(shm3_+LDS_TAB);
  { __attribute__((address_space(3))) float* tw=(__attribute__((address_space(3))) float*)(shm3_+LDS_TAB);
    if(MODE==0){ for(int i=tid;i<RT_SIZE;i+=512){ const int d=i-RT_OFFS; tw[i]=d<0?-INFINITY:(d<128?tabsrc[d]:0.f); } }
    else { const int n=KPRE+q0+QB+KVBLK; for(int i=64*tb+tid*4;i<n;i+=2048){ const float4 v=*(const float4*)(tabsrc+i); tw[i]=v.x;tw[i+1]=v.y;tw[i+2]=v.z;tw[i+3]=v.w; } } }
  if(tb==0){ glds16(K+cq+(long)lane*DM+wid*8,(unsigned)__builtin_amdgcn_readfirstlane(kdst)); glds16(V+cv+(long)(16*(wid&3)+(lane>>2))*DM+(wid>>2)*32+(lane&3)*8,(unsigned)__builtin_amdgcn_readfirstlane(vdst)); glds16(V+cv+(long)(16*(wid&3)+(lane>>2))*DM+(wid>>2)*32+(lane&3)*8+64,(unsigned)__builtin_amdgcn_readfirstlane(vdst+8192)); } else { DMA_K(0,0); DMA_V(0,0); } DMA_K(1,SLOTB);
  bf16x8 qr[4];
  #pragma unroll
  for(int d0=0;d0<4;++d0)qr[d0]=*reinterpret_cast<const bf16x8*>(&Qw[(long)r32*DM+d0*16+hi*8]);
  float mhat=0.f,l_reg=0.f;f32x16 o[4];o[0]=f32x16{};o[1]=f32x16{};o[2]=f32x16{};o[3]=f32x16{};const f32x16 zero16=f32x16{};
  const int qrel=wid*QBLK+r32, q_abs=q0+qrel;
  #define MODT(P0,P1,t,SL) do{ if(SL)modtile_slow<MODE>(P0,P1,(t)+tb,q_abs,hi,tab); else if(MODE==1)modtile_fast1(P0,P1,(t)+tb,hi,tab); }while(0)
  bool resc=false;
  #define START(P0,P1) do{ const float rm=rowmax(P0,P1); resc=false; mhat=rm; \
    _Pragma("unroll") for(int r=0;r<16;++r)P0[r]=__builtin_amdgcn_exp2f(P0[r]-mhat); }while(0)
  #define RESC() do{ if(resc){ asm volatile("s_waitcnt lgkmcnt(0)":::"memory"); \
      _Pragma("unroll") for(int d_=0;d_<4;++d_) _Pragma("unroll") for(int r=0;r<16;++r)o[d_][r]*=wsf[crow(r,hi)]; } }while(0)
  f32x16 pA0,pA1,pB0,pB1;
  int sl_prev=0,sl_cur=0,sl_next=SLOTB;
  #define ROT() do{sl_prev=sl_cur;sl_cur=sl_next;sl_next=(sl_next==(NSLOT-1)*SLOTB)?0:sl_next+SLOTB;}while(0)
  DMA_K(2,2*SLOTB);
  WAIT_BAR(3);
  qkt(pA0,pA1,Kbase,qr,zero16,r32,hi);asm volatile("s_nop 15\n\ts_nop 7":"+v"(pA0),"+v"(pA1));MODT(pA0,pA1,0,true);
  START(pA0,pA1);
  _Pragma("unroll") for(int r=0;r<16;++r)pA1[r]=__builtin_amdgcn_exp2f(pA1[r]-mhat);
  WAIT_BAR(0);
  DMA_K(3,0);DMA_V(1,SLOTB);
  ROT();
  kload8(kf,kp0+sl_cur);
  WAIT_BAR(3);
  s16x4 vlo[8],vhi[8],wlo[8],whi[8]; u32x4 pw0,pw1,pw2,pw3;
  #define PKW(P,B) cvtpk_s(P[B],P[B+1])
  #define PAF(k) __builtin_bit_cast(bf16x8,pw##k)
  #define VFR(i) (bf16x8){vlo[i][0],vlo[i][1],vlo[i][2],vlo[i][3],vhi[i][0],vhi[i][1],vhi[i][2],vhi[i][3]}
  #define WFR(i) (bf16x8){wlo[i][0],wlo[i][1],wlo[i][2],wlo[i][3],whi[i][0],whi[i][1],whi[i][2],whi[i][3]}
  #define WRD(i) do{ wlo[i]=vtr(vp_+((2+((i)>>2))*4096+((i)&3)*1024)); whi[i]=vtr(vp_+((2+((i)>>2))*4096+((i)&3)*1024+512)); SBAR(); }while(0)
  #define GAPB2(MF,X,B) do{ MF; X[B]=EX(X[B]-mhat); X[B+1]=EX(X[B+1]-mhat); PIN(X); SBAR(); }while(0)
  #define PIN(x) asm volatile("":"+v"(x))
  #define MX3(a,b,c) __builtin_fmaxf(__builtin_fmaxf((a),(b)),(c))
  #define GAPA(MF,A0,A1,A2,A3,W0,W1,PW) do{ MF; sacc+=A0; sacc+=A1; sacc+=A2; sacc+=A3; PIN(sacc); W0; W1; PIN(PW); SBAR(); }while(0)
  #define EX(v) __builtin_amdgcn_exp2f(v)
  #define GAPB(MF,X,B) do{ MF; X[B]=EX(X[B]); X[B+1]=EX(X[B+1]); X[B+2]=EX(X[B+2]); X[B+3]=EX(X[B+3]); PIN(X); SBAR(); }while(0)
  #define VRD(i) do{ vlo[i]=vtr(vp_+(((i)>>2)*4096+((i)&3)*1024)); vhi[i]=vtr(vp_+(((i)>>2)*4096+((i)&3)*1024+512)); }while(0)
  #define KRD(G,j) do{ if(G){ kload2(kf,kp0+sl_next,j); SBAR(); } }while(0)
  #define STEP(C0,C1,P0,P1,t,GK,GV,GL,SL) do{ SBAR(); \
    const lds_cptr vp_=vp0+2*sl_prev; \
    VRD(0); SBAR(); float sacc=(P0[0]+P0[1]); \
    GAPA(C0=__builtin_amdgcn_mfma_f32_32x32x16_bf16(kf[0],qr[0],zero16,0,0,0), P0[2],P0[3],P0[4],P0[5],     pw0[0]=PKW(P0,0), pw0[1]=PKW(P0,2), pw0); \
    VRD(4); SBAR(); GAPA(C1=__builtin_amdgcn_mfma_f32_32x32x16_bf16(kf[1],qr[0],zero16,0,0,0), P0[6],P0[7],P0[8],P0[9],     pw0[2]=PKW(P0,4), pw0[3]=PKW(P0,6), pw0); \
    VRD(1); SBAR(); GAPA(C0=__builtin_amdgcn_mfma_f32_32x32x16_bf16(kf[2],qr[1],C0,0,0,0),   P0[10],P0[11],P0[12],P0[13], pw1[0]=PKW(P0,8), pw1[1]=PKW(P0,10), pw1); \
    VRD(5); SBAR(); GAPA(C1=__builtin_amdgcn_mfma_f32_32x32x16_bf16(kf[3],qr[1],C1,0,0,0),   P0[14],P0[15],P1[0],P1[1],   pw1[2]=PKW(P0,12),pw1[3]=PKW(P0,14), pw1); \
    VRD(2); SBAR(); GAPA(C0=__builtin_amdgcn_mfma_f32_32x32x16_bf16(kf[4],qr[2],C0,0,0,0),   P1[2],P1[3],P1[4],P1[5],     pw2[0]=PKW(P1,0), pw2[1]=PKW(P1,2), pw2); \
    VRD(6); SBAR(); GAPA(C1=__builtin_amdgcn_mfma_f32_32x32x16_bf16(kf[5],qr[2],C1,0,0,0),   P1[6],P1[7],P1[8],P1[9],     pw2[2]=PKW(P1,4), pw2[3]=PKW(P1,6), pw2); \
    VRD(3); SBAR(); GAPA(C0=__builtin_amdgcn_mfma_f32_32x32x16_bf16(kf[6],qr[3],C0,0,0,0),   P1[10],P1[11],P1[12],P1[13], pw3[0]=PKW(P1,8), pw3[1]=PKW(P1,10), pw3); \
    VRD(7); SBAR(); GAPA(C1=__builtin_amdgcn_mfma_f32_32x32x16_bf16(kf[7],qr[3],C1,0,0,0),   P1[14],P1[15],0.f,0.f,       pw3[2]=PKW(P1,12),pw3[3]=PKW(P1,14), pw3); \
    l_reg+=sacc; \
    if(GK){DMA_K((t)+3,sl_cur);} if(GV){DMA_V((t)+1,sl_next);} \
    MODT(C0,C1,t,SL); \
    { float a=MX3(C0[0],C0[1],C1[0]),b=MX3(C0[2],C0[3],C1[1]); a=MX3(a,C1[2],C1[3]); \
      _Pragma("unroll") for(int r=4;r<16;r+=4){a=MX3(a,C0[r],C0[r+1]);b=MX3(b,C0[r+2],C0[r+3]);a=MX3(a,C1[r],C1[r+1]);b=MX3(b,C1[r+2],C1[r+3]);} \
      float rm=__builtin_fmaxf(a,b); { auto rr=__builtin_amdgcn_permlane32_swap(__float_as_uint(rm),__float_as_uint(rm),false,false); rm=__builtin_fmaxf(__uint_as_float(rr[0]),__uint_as_float(rr[1])); } \
      resc=false; \
      const float rmd=rm-mhat; \
      if(__builtin_expect(__any(rmd>(float)THRL),0)){ const float dl=__builtin_fmaxf(rmd,0.f); mhat+=dl; \
        const float f=__builtin_amdgcn_exp2f(-dl); l_reg*=f; if(hi==0)wsf[r32]=f; resc=true; } } \
    SBAR(); \
    WRD(0); GAPB2(o[0]=__builtin_amdgcn_mfma_f32_32x32x16_bf16(PAF(0),VFR(0),o[0],0,0,0), C0,0); \
    WRD(4); GAPB2(o[1]=__builtin_amdgcn_mfma_f32_32x32x16_bf16(PAF(0),VFR(4),o[1],0,0,0), C0,2); \
    WRD(1); GAPB2(o[0]=__builtin_amdgcn_mfma_f32_32x32x16_bf16(PAF(1),VFR(1),o[0],0,0,0), C0,4); \
    WRD(5); GAPB2(o[1]=__builtin_amdgcn_mfma_f32_32x32x16_bf16(PAF(1),VFR(5),o[1],0,0,0), C0,6); \
    WRD(2); GAPB2(o[0]=__builtin_amdgcn_mfma_f32_32x32x16_bf16(PAF(2),VFR(2),o[0],0,0,0), C0,8); \
    WRD(6); GAPB2(o[1]=__builtin_amdgcn_mfma_f32_32x32x16_bf16(PAF(2),VFR(6),o[1],0,0,0), C0,10); \
    WRD(3); GAPB2(o[0]=__builtin_amdgcn_mfma_f32_32x32x16_bf16(PAF(3),VFR(3),o[0],0,0,0), C0,12); \
    WRD(7); GAPB2(o[1]=__builtin_amdgcn_mfma_f32_32x32x16_bf16(PAF(3),VFR(7),o[1],0,0,0), C0,14); \
    KRD(GL,0); GAPB2(o[2]=__builtin_amdgcn_mfma_f32_32x32x16_bf16(PAF(0),WFR(0),o[2],0,0,0), C1,0); \
    KRD(GL,1); GAPB2(o[3]=__builtin_amdgcn_mfma_f32_32x32x16_bf16(PAF(0),WFR(4),o[3],0,0,0), C1,2); \
    KRD(GL,2); GAPB2(o[2]=__builtin_amdgcn_mfma_f32_32x32x16_bf16(PAF(1),WFR(1),o[2],0,0,0), C1,4); \
    KRD(GL,3); GAPB2(o[3]=__builtin_amdgcn_mfma_f32_32x32x16_bf16(PAF(1),WFR(5),o[3],0,0,0), C1,6); \
    GAPB2(o[2]=__builtin_amdgcn_mfma_f32_32x32x16_bf16(PAF(2),WFR(2),o[2],0,0,0), C1,8); \
    GAPB2(o[3]=__builtin_amdgcn_mfma_f32_32x32x16_bf16(PAF(2),WFR(6),o[3],0,0,0), C1,10); \
    GAPB2(o[2]=__builtin_amdgcn_mfma_f32_32x32x16_bf16(PAF(3),WFR(3),o[2],0,0,0), C1,12); \
    GAPB2(o[3]=__builtin_amdgcn_mfma_f32_32x32x16_bf16(PAF(3),WFR(7),o[3],0,0,0), C1,14); \
    }while(0)
  int t=1;
  #define ENDW(tt) do{ if((tt)+3<NT){WAIT_BAR(3);} else if((tt)+2<NT){WAIT_BAR(2);} else {WAIT_BAR(0);} }while(0)
  for(;t+7<NT;t+=2){
    STEP(pB0,pB1,pA0,pA1,t,true,true,true,false);     WAIT_BAR(3); RESC(); ROT();
    STEP(pA0,pA1,pB0,pB1,t+1,true,true,true,false);   WAIT_BAR(3); RESC(); ROT();
  }
  for(;t+1<NT;t+=2){
    STEP(pB0,pB1,pA0,pA1,t,(t+3<NT),(t+1<NT),(t+1<NT),true);       ENDW(t);   RESC(); ROT();
    STEP(pA0,pA1,pB0,pB1,t+1,(t+4<NT),(t+2<NT),(t+2<NT),true);     ENDW(t+1); RESC(); ROT();
  }
  STEP(pB0,pB1,pA0,pA1,NT-1,false,false,false,true); RESC();
  { float sacc=pB0[0]+pB0[1]; _Pragma("unroll") for(int r=2;r<16;++r)sacc+=pB0[r]; _Pragma("unroll") for(int r=0;r<16;++r)sacc+=pB1[r]; l_reg+=sacc;
    pw0=(u32x4){PKW(pB0,0),PKW(pB0,2),PKW(pB0,4),PKW(pB0,6)};pw1=(u32x4){PKW(pB0,8),PKW(pB0,10),PKW(pB0,12),PKW(pB0,14)};pw2=(u32x4){PKW(pB1,0),PKW(pB1,2),PKW(pB1,4),PKW(pB1,6)};pw3=(u32x4){PKW(pB1,8),PKW(pB1,10),PKW(pB1,12),PKW(pB1,14)};
    SBAR(); pv(o,vb0+2*sl_cur,PAF(0),PAF(1),PAF(2),PAF(3)); pv(o+2,vb0+2*sl_cur+8192,PAF(0),PAF(1),PAF(2),PAF(3)); }
  #undef PKW
  #undef PAF
  #undef VFR
  #undef PIN
  #undef MX3
  #undef GAPA
  #undef GAPB
  #undef EX
  #undef VRD
  #undef WRD
  #undef WFR
  #undef GAPB2
  #undef KRD
  #undef STEP
  #undef ENDW
  {auto rr=__builtin_amdgcn_permlane32_swap(__float_as_uint(l_reg),__float_as_uint(l_reg),false,false);l_reg=__uint_as_float(rr[0])+__uint_as_float(rr[1]);}
  if(hi==0)wsf[32+r32]=l_reg;asm volatile("s_waitcnt lgkmcnt(0)":::"memory");
  float rli[16];
  #pragma unroll
  for(int r=0;r<16;++r)rli[r]=__builtin_amdgcn_rcpf(wsf[32+crow(r,hi)]);
  bf16*Ow=O+(rowbase+q0+wid*QBLK)*DM+co;
  { bf16*stg=(bf16*)(shm+LDS_OST)+wid*2048;
    #pragma unroll
    for(int ps=0;ps<2;++ps){
      #pragma unroll
      for(int r=0;r<16;++r){const int orow=crow(r,hi);
        #pragma unroll
        for(int d0=0;d0<2;++d0)stg[orow*64+d0*32+r32]=__float2bfloat16(o[2*ps+d0][r]*rli[r]);}
      asm volatile("s_waitcnt lgkmcnt(0)":::"memory");
      #pragma unroll
      for(int i=0;i<4;++i){const int row=i*8+(lane>>3),ch=lane&7; const u32x4 v=*(const u32x4*)(stg+row*64+ch*8); ATTN_STORE16(Ow+(long)row*DM+ps*64+ch*8,v);}
      asm volatile("s_waitcnt lgkmcnt(0)":::"memory"); } }
  asm volatile("s_waitcnt lgkmcnt(0)\n\ts_barrier":::"memory");
  #undef DMA_K
  #undef DMA_V
  #undef MODT
  #undef START
  #undef RESC
  #undef ROT
}
constexpr int ATTN_LDS_BYTES=LDS_BYTES;
#undef SBAR
#undef WAIT_BAR
}
#define GAS __attribute__((address_space(1)))
#define LAS __attribute__((address_space(3)))
typedef unsigned short bf16;
typedef unsigned v4u __attribute__((ext_vector_type(4)));
typedef float f32x4 __attribute__((ext_vector_type(4)));
typedef short bf16x8 __attribute__((ext_vector_type(8)));
typedef GAS unsigned gu32;
typedef GAS unsigned long long gu64;
#define RLX_AGENT __ATOMIC_RELAXED, __HIP_MEMORY_SCOPE_AGENT
#define LDS_WAIT() asm volatile("s_waitcnt lgkmcnt(0)" ::: "memory")
#define VM_WAIT() asm volatile("s_waitcnt vmcnt(0)" ::: "memory")
__device__ __forceinline__ unsigned long long rt() { return __builtin_amdgcn_s_memrealtime(); }
__device__ __forceinline__ unsigned f2bf(float f) { unsigned u = __builtin_bit_cast(unsigned, f); return (u + 0x7fffu + ((u >> 16) & 1u)) >> 16; }
__device__ __forceinline__ unsigned pk2(float lo, float hi) { return f2bf(lo) | (f2bf(hi) << 16); }

#define XB_TMO      128
#define XB_XCNT(j)  (256  + 64 * (j))
#define XB_XSUB(j)  (1280 + 64 * (j))
#define XB_XGEN(j)  (2304 + 64 * (j))
#define XB_TOP      3328
#define XB_TOPGEN   3392
#define XCD_BAR_WORDS 3456
#define XB_SPIN_CAP (1u << 18)

__device__ __forceinline__ unsigned xb_ld(unsigned* p)              { return __hip_atomic_load(p, __ATOMIC_RELAXED, __HIP_MEMORY_SCOPE_AGENT); }
__device__ __forceinline__ unsigned xb_add(unsigned* p, unsigned v) { return __hip_atomic_fetch_add(p, v, __ATOMIC_RELAXED, __HIP_MEMORY_SCOPE_AGENT); }
__device__ __forceinline__ unsigned xb_xcc_id() { return (unsigned)__builtin_amdgcn_s_getreg((3 << 11) | 20) & 0xFu; }
#define XB_SPIN(cond, bar) do { unsigned _sp = 0; while (cond) { __builtin_amdgcn_s_sleep(1); \
    if ((++_sp & 255u) == 0u) { if (xb_ld(&(bar)[XB_TMO])) break; if (_sp > XB_SPIN_CAP) { atomicAdd(&(bar)[XB_TMO], 1u); break; } } } } while (0)

struct XcdBarrier {
    unsigned* bar; unsigned x;
    volatile LAS unsigned* st;
};

__device__ __forceinline__ XcdBarrier xcd_barrier_post(unsigned* bar, volatile LAS unsigned* st) {
    XcdBarrier b; b.bar = bar; b.x = xb_xcc_id(); b.st = st;
    if (threadIdx.x == 0) (void)xb_add(&bar[XB_XCNT(b.x)], 1u);
    return b;
}
__device__ __forceinline__ void xcd_barrier_complete(unsigned* bar, unsigned x, unsigned& nloc, unsigned& nx) {
    const unsigned G = gridDim.x * gridDim.y * gridDim.z;
    unsigned sum, cnt, mine, sp = 0u;
    for (;;) {
        sum = 0u; cnt = 0u; mine = 0u;
#pragma unroll
        for (unsigned j = 0; j < 16; ++j) { const unsigned c = xb_ld(&bar[XB_XCNT(j)]); sum += c; cnt += (c > 0u) ? 1u : 0u; mine = (j == x) ? c : mine; }
        if (sum == G) break;
        __builtin_amdgcn_s_sleep(1);
        if ((++sp & 255u) == 0u) { if (xb_ld(&bar[XB_TMO])) break; if (sp > XB_SPIN_CAP) { atomicAdd(&bar[XB_TMO], 1u); break; } }
    }
    nloc = mine > 0u ? mine : 1u; nx = cnt > 0u ? cnt : 1u;
}

__device__ __forceinline__ void xcd_barrier(const XcdBarrier& b) {
    asm volatile("s_waitcnt vmcnt(0)" ::: "memory");
    __syncthreads();
    if (threadIdx.x == 0) {
        unsigned* bar = b.bar;
        __builtin_amdgcn_s_waitcnt(0);
        unsigned nloc = b.st[0], nx = b.st[1];
        if (nloc == 0u) { xcd_barrier_complete(bar, b.x, nloc, nx); b.st[0] = nloc; b.st[1] = nx; }
        const unsigned old = xb_add(&bar[XB_XSUB(b.x)], 1u);
        const unsigned gen = old / nloc;
        if (old + 1u == (gen + 1u) * nloc) {
            __builtin_amdgcn_fence(__ATOMIC_RELEASE, "agent");
            asm volatile("s_waitcnt vmcnt(0)" ::: "memory");
            const unsigned og = xb_add(&bar[XB_TOP], 1u);
            const unsigned tg = og / nx;
            if (og + 1u == (tg + 1u) * nx) xb_add(&bar[XB_TOPGEN], 1u);
            else XB_SPIN(xb_ld(&bar[XB_TOPGEN]) == tg, bar);
            __builtin_amdgcn_fence(__ATOMIC_ACQUIRE, "agent");
            xb_add(&bar[XB_XGEN(b.x)], 1u);
            asm volatile("s_waitcnt vmcnt(0)" ::: "memory");
        } else {
            XB_SPIN(xb_ld(&bar[XB_XGEN(b.x)]) == gen, bar);
            __builtin_amdgcn_fence(__ATOMIC_ACQUIRE, "agent");
            asm volatile("s_waitcnt vmcnt(0)" ::: "memory");
        }
    }
    __syncthreads();
}

constexpr int NWAVES = 8;
#ifndef MK_PER_PHASE
#define MK_PER_PHASE 0
#endif
constexpr int N_PHASES = 16;

constexpr size_t MiB = 1u << 20;
constexpr size_t WS_CTL = 0, CTL_ZERO_BYTES = 1 * MiB;
constexpr size_t WS_GV = 1 * MiB + 512 * 1024;
constexpr size_t WS_HM = 2 * MiB;
constexpr size_t WS_TAB = 2 * MiB + 256 * 1024;
constexpr size_t WS_LF = 3 * MiB;
constexpr size_t WS_DK = 6 * MiB;
constexpr size_t WS_LIST = 9 * MiB;
constexpr int LCAP = NSLOT;
constexpr size_t WS_WQKV0 = 18 * MiB, WS_WO0 = 24 * MiB, WS_WQKV1 = 26 * MiB, WS_WO1 = 32 * MiB, WS_WGU = 34 * MiB, WS_WD = 98 * MiB;
constexpr size_t WS_XH = 130 * MiB;
constexpr size_t WS_Q = 195 * MiB;
constexpr size_t WS_K = 260 * MiB, WS_V = 325 * MiB;
constexpr size_t WS_O0 = 390 * MiB;
constexpr size_t WS_END = 455 * MiB;
static_assert(WS_LIST + (size_t)NEXP * LCAP * 4 <= WS_WQKV0 && WS_DK + (size_t)NBATCH * 16 * KROWS * 4 <= WS_LIST && WS_LF + (size_t)NRP * 16 * 4 <= WS_DK, "small arrays");
static_assert(WS_XH + (size_t)NRP * DM * 2 <= WS_Q && WS_Q + (size_t)NRP * DM * 2 <= WS_K && WS_K + (size_t)NBATCH * KROWS * DM * 2 <= WS_V && WS_V + (size_t)NBATCH * KROWS * DM * 2 <= WS_O0 && WS_O0 + (size_t)NRP * DM * 2 <= WS_END, "activations");
static_assert(WS_K + (size_t)NSLOT * DM * 2 <= WS_O0 && WS_O0 + (size_t)NSLOT * DEXP * 2 <= WS_END, "MoE overlays");
constexpr int CW_TMO = 0, CW_CODE = 1;
constexpr int CW_BAR = 4096;
constexpr int CW_QM = 131072, CW_KM = 147456, CW_QCTR = 148480;
constexpr int CW_CNT = 65536;
constexpr int RING_OFF = 0, RING_BYTES = 131072;
constexpr int ROWTAB_OFF = RING_BYTES, ROWTAB_UNITS = 12;
constexpr int MOEPRE_OFF = ROWTAB_OFF + ROWTAB_UNITS * 1024;
constexpr int MISC_OFF = MOEPRE_OFF + 512;
constexpr int LDS_BYTES = 147456;
static_assert(MISC_OFF + 128 <= LDS_BYTES && attn_body::ATTN_LDS_BYTES <= RING_BYTES, "LDS map");

struct Params {
    const float *x, *meta, *rel_bias, *w_qkv, *lam, *subln, *w_o, *fox_w_in, *fox_b_f, *fox_w_o, *ln_mix_g, *ln_mix_b, *ln_ffn_g, *ln_ffn_b, *rg_w, *rg_b, *re_w, *re_b, *w_gate, *w_up, *w_down;
    float* out; unsigned char* ws; int ph_lo, ph_hi, li, pad;
};
struct Ctx { int tid, lane, wave, vcu, G; LAS unsigned char* lds; };
__device__ __forceinline__ Ctx fresh(const Ctx& C) { Ctx r = C; int t = threadIdx.x; asm volatile("" : "+v"(t)); r.tid = t; r.lane = t & 63; r.wave = __builtin_amdgcn_readfirstlane(t >> 6); return r; }

using pg8::shx;
__device__ __forceinline__ float wave_sum(float v, int lane) {
#pragma unroll
    for (int o = 1; o < 64; o <<= 1) v += shx(v, o, lane);
    return v;
}
__device__ __forceinline__ float bf2f(unsigned short h) { return __uint_as_float((unsigned)h << 16); }
__device__ __forceinline__ float bflo(unsigned w) { return __uint_as_float(w << 16); }
__device__ __forceinline__ float bfhi(unsigned w) { return __uint_as_float(w & 0xffff0000u); }
__device__ __forceinline__ int meta_slot(int j) { return j; }

__device__ __forceinline__ void tr_item(const float* W, int ldw, int k0, int n0, bf16* WT, int ldt, int drow0, LAS float* scr, int lane) {
#pragma unroll 8
    for (int i = 0; i < 32; ++i) { const int kk = 2 * i + (lane >> 5); scr[kk * 33 + (lane & 31)] = W[(size_t)(k0 + kk) * ldw + n0 + (lane & 31)]; }
    LDS_WAIT(); asm volatile("" ::: "memory");
    const int c = lane & 7;
#pragma unroll
    for (int j = 0; j < 4; ++j) { const int n = (lane >> 3) + 8 * j; const LAS float* s = scr + (8 * c) * 33 + n;
        v4u o; o.x = pk2(s[0 * 33], s[1 * 33]); o.y = pk2(s[2 * 33], s[3 * 33]); o.z = pk2(s[4 * 33], s[5 * 33]); o.w = pk2(s[6 * 33], s[7 * 33]);
        *(GAS v4u*)(WT + (size_t)(drow0 + n) * ldt + k0 + 8 * c) = o; }
    LDS_WAIT(); asm volatile("" ::: "memory");
}
__device__ __forceinline__ void convert_experts(const Params& p, const Ctx& C, int layer, int first_item, int gw, int NGW) {
    LAS float* scr = (LAS float*)(C.lds + RING_OFF + C.wave * 16384);
    bf16* Wgu = (bf16*)(p.ws + WS_WGU); bf16* Wd = (bf16*)(p.ws + WS_WD);
    constexpr int PER_E = 768, NIT = NEXP * PER_E;
    for (int it = gw - first_item; it < NIT; it += NGW) { if (it < 0) continue;
        const int e = it / PER_E; int r = it % PER_E; const size_t eo = (size_t)(layer * NEXP + e);
        if (r < 512) { const bool up = r >= 256; r &= 255; const int kb = r >> 4, nb = r & 15, n0 = 32 * nb;
            tr_item((up ? p.w_up : p.w_gate) + eo * DM * DEXP, DEXP, 64 * kb, n0, Wgu + (size_t)e * DM * DM, DM, (n0 >> 7) * 256 + (n0 & 127) + (up ? 128 : 0), scr, C.lane); }
        else { r -= 512; const int kb = r >> 5, nb = r & 31;
            tr_item(p.w_down + eo * DEXP * DM, DM, 64 * kb, 32 * nb, Wd + (size_t)e * DM * DEXP, DEXP, 32 * nb, scr, C.lane); } }
}
__device__ __forceinline__ void p0_prologue(const Params& p, const Ctx& C) {
    LAS float* scr = (LAS float*)(C.lds + RING_OFF + C.wave * 16384);
    const int gw = C.vcu * NWAVES + C.wave, NGW = C.G * NWAVES;
    for (int it = gw; it < 4096; it += NGW) { int r = it;
        if (r < 1536) { tr_item(p.w_qkv, 3072, 64 * (r / 96), 32 * (r % 96), (bf16*)(p.ws + WS_WQKV0), DM, 32 * (r % 96), scr, C.lane); continue; } r -= 1536;
        if (r < 512) { tr_item(p.w_o, DM, 64 * (r >> 5), 32 * (r & 31), (bf16*)(p.ws + WS_WO0), DM, 32 * (r & 31), scr, C.lane); continue; } r -= 512;
        if (r < 1536) { tr_item(p.fox_w_in, 3088, 64 * (r / 96), 32 * (r % 96), (bf16*)(p.ws + WS_WQKV1), DM, 32 * (r % 96), scr, C.lane); continue; } r -= 1536;
        tr_item(p.fox_w_o, DM, 64 * (r >> 5), 32 * (r & 31), (bf16*)(p.ws + WS_WO1), DM, 32 * (r & 31), scr, C.lane); }
    convert_experts(p, C, 0, 0, gw, NGW);
    bf16* XH = (bf16*)(p.ws + WS_XH);
    for (int m = gw; m < NRP; m += NGW) {
        GAS unsigned long long* o8 = (GAS unsigned long long*)(XH + (size_t)m * DM) + C.lane;
        if (m < NR) { const GAS f32x4* xr = (const GAS f32x4*)(m < NREAL ? p.x + (size_t)m * DM : p.meta + (size_t)(m - NREAL) * DM) + C.lane;
#pragma unroll
            for (int j = 0; j < 4; ++j) { const f32x4 v = xr[64 * j]; o8[64 * j] = (unsigned long long)pk2(v.x, v.y) | ((unsigned long long)pk2(v.z, v.w) << 32); } }
        else {
#pragma unroll
            for (int j = 0; j < 4; ++j) o8[64 * j] = 0ull; } }
    { const int gt = C.vcu * (NWAVES * 64) + C.tid;
      if (gt < 16 * 128) { const int m = gt >> 7, d = gt & 127; int bk = d;
          if (d >= 16) { bk = 16 + (d >= 19) + (d >= 21) + (d >= 24) + (d >= 27) + (d >= 31) + (d >= 35) + (d >= 40) + (d >= 46) + (d >= 52) + (d >= 59) + (d >= 67) + (d >= 77) + (d >= 87) + (d >= 99) + (d >= 113); }
          ((float*)(p.ws + WS_TAB))[gt] = (p.rel_bias[bk * 16 + m] - p.rel_bias[31 * 16 + m]) * LOG2E; } }
}

__device__ __forceinline__ float diff_lambda_full(const Params& p, int lane) {
    const float a = p.lam[lane] * p.lam[64 + lane], b = p.lam[128 + lane] * p.lam[192 + lane];
    return __expf(wave_sum(a, lane)) - __expf(wave_sum(b, lane)) + LAMBDA_INIT0;
}
__device__ __forceinline__ void combine_phase(const Params& p, const Ctx& C) {
    const int gw = C.vcu * NWAVES + C.wave, NGW = C.G * NWAVES, lane = C.lane;
    const float lam = diff_lambda_full(p, lane);
    const bf16* O0 = (const bf16*)(p.ws + WS_O0); const bf16* O1 = (const bf16*)p.out; bf16* OA = (bf16*)(p.ws + WS_Q);
    float sw[8];
#pragma unroll
    for (int c = 0; c < 8; ++c) sw[c] = p.subln[((8 * lane) & 127) + c] * (1.f - LAMBDA_INIT0);
    for (int r = gw; r < NREAL; r += NGW) {
#pragma unroll
        for (int j = 0; j < 2; ++j) { const size_t off = (size_t)r * DM + 8 * lane + 512 * j;
            const v4u a = *(const GAS v4u*)(O0 + off), b = *(const GAS v4u*)(O1 + off);
            float d[8]; const unsigned aw[4] = {a.x, a.y, a.z, a.w}, bw[4] = {b.x, b.y, b.z, b.w}; float ss = 0.f;
#pragma unroll
            for (int c = 0; c < 4; ++c) { d[2 * c] = bflo(aw[c]) - lam * bflo(bw[c]); d[2 * c + 1] = bfhi(aw[c]) - lam * bfhi(bw[c]); ss += d[2 * c] * d[2 * c] + d[2 * c + 1] * d[2 * c + 1]; }
            ss += shx(ss, 1, lane); ss += shx(ss, 2, lane); ss += shx(ss, 4, lane); ss += shx(ss, 8, lane);
            const float rs = 1.f / sqrtf(ss * (1.f / 128.f) + LN_EPS);
            v4u o; o.x = pk2(d[0] * rs * sw[0], d[1] * rs * sw[1]); o.y = pk2(d[2] * rs * sw[2], d[3] * rs * sw[3]); o.z = pk2(d[4] * rs * sw[4], d[5] * rs * sw[5]); o.w = pk2(d[6] * rs * sw[6], d[7] * rs * sw[7]);
            *(GAS v4u*)(OA + off) = o; } }
    if (gw < 128) { const int h = gw >> 4, j = gw & 15, kj = lane & 15, s = (lane >> 4) & 1, m = 2 * h + s;
        const bf16* Q = (const bf16*)(p.ws + WS_Q); const bf16* K = (const bf16*)(p.ws + WS_K); const bf16* V = (const bf16*)(p.ws + WS_V);
        const bf16* qp = Q + (size_t)(NREAL + j) * DM + m * 64; const bf16* kp = K + (size_t)meta_slot(kj) * DM + m * 64;
        float dot = 0.f;
#pragma unroll
        for (int c = 0; c < 8; ++c) { const v4u qa = *(const GAS v4u*)(qp + 8 * c), ka = *(const GAS v4u*)(kp + 8 * c); const unsigned qw[4] = {qa.x, qa.y, qa.z, qa.w}, kw[4] = {ka.x, ka.y, ka.z, ka.w};
#pragma unroll
            for (int e = 0; e < 4; ++e) dot += bflo(qw[e]) * bflo(kw[e]) + bfhi(qw[e]) * bfhi(kw[e]); }
        float sc = (kj <= j) ? dot + p.rel_bias[(j - kj) * 16 + m] * LOG2E : -INFINITY;
        float mx = sc; mx = fmaxf(mx, shx(mx, 1, lane)); mx = fmaxf(mx, shx(mx, 2, lane)); mx = fmaxf(mx, shx(mx, 4, lane)); mx = fmaxf(mx, shx(mx, 8, lane));
        float pe = __builtin_amdgcn_exp2f(sc - mx); float l = pe; l += shx(l, 1, lane); l += shx(l, 2, lane); l += shx(l, 4, lane); l += shx(l, 8, lane);
        pe /= l;
        const float a = pe - lam * shx(pe, 16, lane);
        float o0 = 0.f, o1 = 0.f;
        for (int k2 = 0; k2 <= j; ++k2) { const float ak = __builtin_amdgcn_readlane(a, k2); const unsigned vw = *(const GAS unsigned*)(V + (size_t)meta_slot(k2) * DM + h * 128 + 2 * lane); o0 += ak * bflo(vw); o1 += ak * bfhi(vw); }
        const float ss = wave_sum(o0 * o0 + o1 * o1, lane); const float rs = 1.f / sqrtf(ss * (1.f / 128.f) + LN_EPS);
        const float w0 = p.subln[2 * lane] * (1.f - LAMBDA_INIT0), w1 = p.subln[2 * lane + 1] * (1.f - LAMBDA_INIT0);
        *(GAS unsigned*)(OA + (size_t)(NREAL + j) * DM + h * 128 + 2 * lane) = pk2(o0 * rs * w0, o1 * rs * w1); }
}
__device__ __forceinline__ void fox_meta_attn(const Params& p, const Ctx& C) {
    const int gw = C.vcu * NWAVES + C.wave, lane = C.lane;
    if (gw < 256) { const int h = gw >> 4, j = gw & 15, kj = lane & 15;
        bf16* Q = (bf16*)(p.ws + WS_Q); const bf16* K = (const bf16*)(p.ws + WS_K); const bf16* V = (const bf16*)(p.ws + WS_V); const float* DK = (const float*)(p.ws + WS_DK) + (size_t)h * KROWS;
        const bf16* qp = Q + (size_t)(NREAL + j) * DM + h * 64; const bf16* kp = K + (size_t)meta_slot(kj) * DM + h * 64;
        float dot = 0.f;
#pragma unroll
        for (int c = 0; c < 8; ++c) { const v4u qa = *(const GAS v4u*)(qp + 8 * c), ka = *(const GAS v4u*)(kp + 8 * c); const unsigned qw[4] = {qa.x, qa.y, qa.z, qa.w}, kw[4] = {ka.x, ka.y, ka.z, ka.w};
#pragma unroll
            for (int e = 0; e < 4; ++e) dot += bflo(qw[e]) * bflo(kw[e]) + bfhi(qw[e]) * bfhi(kw[e]); }
        float sc = (kj <= j) ? dot + DK[meta_slot(kj)] - DK[meta_slot(j)] : -INFINITY;
        float mx = sc; mx = fmaxf(mx, shx(mx, 1, lane)); mx = fmaxf(mx, shx(mx, 2, lane)); mx = fmaxf(mx, shx(mx, 4, lane)); mx = fmaxf(mx, shx(mx, 8, lane));
        float pe = __builtin_amdgcn_exp2f(sc - mx); float l = pe; l += shx(l, 1, lane); l += shx(l, 2, lane); l += shx(l, 4, lane); l += shx(l, 8, lane);
        pe /= l;
        float o = 0.f;
        for (int k2 = 0; k2 <= j; ++k2) { const float ak = __builtin_amdgcn_readlane(pe, k2); o += ak * bf2f(V[(size_t)meta_slot(k2) * DM + h * 64 + lane]); }
        ((bf16*)(p.ws + WS_O0))[(size_t)(NREAL + j) * DM + h * 64 + lane] = (bf16)f2bf(o); }
}

typedef float f32x4m __attribute__((ext_vector_type(4)));
template <int KIND> __device__ __forceinline__ void ln_phase(const Params& p, const Ctx& C, int layer) {
    constexpr int NCB = (KIND == 0) ? 3 : (KIND == 1 ? 1 : 0), NC = 16 * (NCB ? NCB : 1);
    constexpr int AT_PITCH = 1028;
    const int tid = C.tid, lane = C.lane, wave = C.wave;
    LAS float* At = (LAS float*)(C.lds + RING_OFF);
    LAS float* part = (LAS float*)(C.lds + RING_OFF + 65792);
    LAS float* logit = (LAS float*)(C.lds + RING_OFF + 90368);
    LAS int* sl_e = (LAS int*)(C.lds + RING_OFF + 93440);
    LAS int* cnt_l = (LAS int*)(C.lds + RING_OFF + 94720);
    const float* gsrc = (KIND == 0 ? p.ln_mix_g : p.ln_ffn_g) + layer * DM; const float* bsrc = (KIND == 0 ? p.ln_mix_b : p.ln_ffn_b) + layer * DM;
    f32x4 gv[4], bv[4];
#pragma unroll
    for (int j = 0; j < 4; ++j) { gv[j] = *(const GAS f32x4*)(gsrc + 4 * lane + 256 * j); bv[j] = *(const GAS f32x4*)(bsrc + 4 * lane + 256 * j); }
    float Bf[NCB ? NCB : 1][8][4];
    if constexpr (NCB > 0) { const int kq = lane >> 4, col = lane & 15;
#pragma unroll
        for (int cb = 0; cb < NCB; ++cb)
#pragma unroll
            for (int g = 0; g < 8; ++g)
#pragma unroll
                for (int c = 0; c < 4; ++c) { const int k = 128 * wave + 16 * g + 4 * kq + c, cc = cb * 16 + col; float w;
                    if (KIND == 0) w = cc < 4 ? p.rg_w[((size_t)layer * DM + k) * 4 + cc] : (cc < 36 ? p.re_w[((size_t)layer * DM + k) * 32 + (cc - 4)] : 0.f);
                    else w = p.fox_w_in[(size_t)k * 3088 + 3072 + cc];
                    Bf[cb][g][c] = w; } }
    if (KIND == 0) { if (tid < 96) cnt_l[tid] = 0; }
    bf16* XH = (bf16*)(p.ws + WS_XH); const bf16* Y = (const bf16*)(p.ws + WS_K);
    constexpr int NTILES = NR / 16;
    int it = 0;
    for (int tile = C.vcu; tile < NTILES; tile += C.G, ++it) {
        unsigned long long vv[2][4]; unsigned long long yy[2][2][4];
#pragma unroll
        for (int rr = 0; rr < 2; ++rr) { const int row = tile * 16 + wave * 2 + rr;
#pragma unroll
            for (int j = 0; j < 4; ++j) vv[rr][j] = *((const GAS unsigned long long*)(XH + (size_t)row * DM) + lane + 64 * j);
            if (KIND != 0) {
#pragma unroll
                for (int j = 0; j < 4; ++j) { yy[rr][0][j] = *(const GAS unsigned long long*)(Y + (size_t)(2 * row) * DM + 4 * lane + 256 * j); yy[rr][1][j] = *(const GAS unsigned long long*)(Y + (size_t)(2 * row + 1) * DM + 4 * lane + 256 * j); } } }
#pragma unroll
        for (int rr = 0; rr < 2; ++rr) { const int rl = wave * 2 + rr, row = tile * 16 + rl;
            f32x4 v[4];
#pragma unroll
            for (int j = 0; j < 4; ++j) { const unsigned h0 = (unsigned)vv[rr][j], h1 = (unsigned)(vv[rr][j] >> 32); v[j] = (f32x4){bflo(h0), bfhi(h0), bflo(h1), bfhi(h1)}; }
            if (KIND != 0) {
#pragma unroll
                for (int j = 0; j < 4; ++j) { const unsigned long long y0 = yy[rr][0][j], y1 = yy[rr][1][j];
                    const unsigned a0 = (unsigned)y0, a1 = (unsigned)(y0 >> 32), b0 = (unsigned)y1, b1 = (unsigned)(y1 >> 32);
                    v[j].x = v[j].x * ALPHA + (bflo(a0) + bflo(b0)); v[j].y = v[j].y * ALPHA + (bfhi(a0) + bfhi(b0)); v[j].z = v[j].z * ALPHA + (bflo(a1) + bflo(b1)); v[j].w = v[j].w * ALPHA + (bfhi(a1) + bfhi(b1)); } }
            float s = 0.f;
#pragma unroll
            for (int j = 0; j < 4; ++j) s += (v[j].x + v[j].y) + (v[j].z + v[j].w);
            const float mean = wave_sum(s, lane) * (1.f / DM); float s2 = 0.f;
#pragma unroll
            for (int j = 0; j < 4; ++j) { v[j] = v[j] - mean; s2 += (v[j].x * v[j].x + v[j].y * v[j].y) + (v[j].z * v[j].z + v[j].w * v[j].w); }
            const float rstd = 1.f / sqrtf(wave_sum(s2, lane) * (1.f / DM) + LN_EPS);
#pragma unroll
            for (int j = 0; j < 4; ++j) v[j] = v[j] * rstd * gv[j] + bv[j];
            if (KIND == 2) { if (row < NREAL) {
#pragma unroll
                for (int j = 0; j < 4; ++j) *(GAS f32x4*)(p.out + (size_t)row * DM + 4 * lane + 256 * j) = v[j]; } }
            else {
#pragma unroll
                for (int j = 0; j < 4; ++j) {
                    *((GAS unsigned long long*)(XH + (size_t)row * DM) + lane + 64 * j) = (unsigned long long)pk2(v[j].x, v[j].y) | ((unsigned long long)pk2(v[j].z, v[j].w) << 32);
                    *(LAS f32x4*)(At + rl * AT_PITCH + 4 * lane + 256 * j) = v[j]; } } }
        if constexpr (NCB > 0) {
            __syncthreads();
            f32x4m acc[NCB];
#pragma unroll
            for (int cb = 0; cb < NCB; ++cb) acc[cb] = (f32x4m){0.f, 0.f, 0.f, 0.f};
#pragma unroll
            for (int g = 0; g < 8; ++g) { const f32x4 a4 = *(const LAS f32x4*)(At + (lane & 15) * AT_PITCH + 128 * wave + 16 * g + 4 * (lane >> 4));
#pragma unroll
                for (int c = 0; c < 4; ++c)
#pragma unroll
                    for (int cb = 0; cb < NCB; ++cb) acc[cb] = __builtin_amdgcn_mfma_f32_16x16x4f32(a4[c], Bf[cb][g][c], acc[cb], 0, 0, 0); }
#pragma unroll
            for (int cb = 0; cb < NCB; ++cb)
#pragma unroll
                for (int r = 0; r < 4; ++r) part[(wave * 16 + 4 * (lane >> 4) + r) * 48 + cb * 16 + (lane & 15)] = acc[cb][r];
            __syncthreads();
            for (int idx = tid; idx < 16 * NC; idx += NWAVES * 64) { const int rw = idx / NC, cl = idx % NC; float sacc = 0.f;
#pragma unroll
                for (int w = 0; w < 8; ++w) sacc += part[(w * 16 + rw) * 48 + cl];
                logit[rw * 48 + cl] = sacc; }
            __syncthreads();
            if (KIND == 0) { if (tid < 16) { const int row = tile * 16 + tid; const LAS float* lg = logit + tid * 48;
                float gl[4]; int gs = 0;
#pragma unroll
                for (int i = 0; i < 4; ++i) gl[i] = lg[i] + p.rg_b[layer * 4 + i];
#pragma unroll
                for (int i = 1; i < 4; ++i) if (gl[i] > gl[gs]) gs = i;
                float den = 0.f;
#pragma unroll
                for (int i = 0; i < 4; ++i) den += __expf(gl[i] - gl[gs]);
                const float pg = 1.f / den;
                float el[8];
#pragma unroll
                for (int i = 0; i < 8; ++i) el[i] = lg[4 + gs * 8 + i] + p.re_b[layer * 32 + gs * 8 + i];
                int i0 = 0;
#pragma unroll
                for (int i = 1; i < 8; ++i) if (el[i] > el[i0]) i0 = i;
                int i1 = (i0 == 0) ? 1 : 0;
#pragma unroll
                for (int i = 0; i < 8; ++i) if (i != i0 && el[i] > el[i1]) i1 = i;
                const float ex = __expf(el[i1] - el[i0]); const float w0 = 1.f / (1.f + ex), w1 = ex * w0;
                float* GVp = (float*)(p.ws + WS_GV); GVp[2 * row] = pg * w0; GVp[2 * row + 1] = pg * w1;
                sl_e[it * 32 + 2 * tid] = gs * 8 + i0; sl_e[it * 32 + 2 * tid + 1] = gs * 8 + i1; } }
            else { if (tid < 256) { const int rw = tid >> 4, hh = tid & 15; const float vv = logit[rw * 48 + hh] + p.fox_b_f[hh];
                ((float*)(p.ws + WS_LF))[(size_t)(tile * 16 + rw) * 16 + hh] = fminf(vv, 0.f) - __builtin_amdgcn_logf(1.f + __builtin_amdgcn_exp2f(-fabsf(vv) * LOG2E)) * 0.69314718056f;   } }
        }
    }
    if (KIND == 0) {
        gu32* CNT = (gu32*)(p.ws + WS_CTL) + CW_CNT + layer * 2048; int* LIST = (int*)(p.ws + WS_LIST);
        __syncthreads();
        const int nloc = it * 32;
        for (int s = tid; s < nloc; s += NWAVES * 64) atomicAdd((int*)&cnt_l[sl_e[s]], 1);
        __syncthreads();
        if (tid < 32) { const int n = cnt_l[tid]; cnt_l[32 + tid] = n > 0 ? (int)__hip_atomic_fetch_add(CNT + 64 * tid, (unsigned)n, RLX_AGENT) : 0; cnt_l[64 + tid] = 0; }
        __syncthreads();
        for (int s = tid; s < nloc; s += NWAVES * 64) { const int e = sl_e[s]; const int pos = cnt_l[32 + e] + atomicAdd((int*)&cnt_l[64 + e], 1);
            const int tl = C.vcu + (s >> 5) * C.G; LIST[(size_t)e * LCAP + pos] = 2 * (tl * 16 + ((s & 31) >> 1)) + (s & 1); }
    }
    __syncthreads();
}

__device__ __forceinline__ void cumsum_job(const Params& p, const Ctx& C) {
    if (C.vcu >= 64) return;
    const int b = C.vcu >> 4, h = C.vcu & 15, tid = C.tid, lane = C.lane, wave = C.wave;
    const float* LF = (const float*)(p.ws + WS_LF); float* DK = (float*)(p.ws + WS_DK) + (size_t)(b * 16 + h) * KROWS;
    LAS float* wt = (LAS float*)(C.lds + RING_OFF);
    float cm = 0.f, mine = 0.f; const int myj = (tid < NMETA) ? tid : -1;
    for (int i = 0; i < NMETA; ++i) { cm += LF[(size_t)(NREAL + i) * 16 + h]; if (i == myj) mine = cm; }
    if (tid < KPRE) DK[tid] = (myj >= 0) ? -mine * LOG2E : 0.f;
    if (tid < 64) DK[KPRE + SEQ + tid] = 0.f;
    const float* lp = LF + (size_t)(b * SEQ + tid * 16) * 16 + h;
    float run = 0.f;
#pragma unroll 1
    for (int i = 0; i < 16; ++i) run += lp[i * 16];
    float inc = run;
#pragma unroll
    for (int o = 1; o < 64; o <<= 1) { const float t = __uint_as_float((unsigned)__builtin_amdgcn_ds_bpermute((lane - o) << 2, (int)__float_as_uint(inc))); if (lane >= o) inc += t; }
    if (lane == 63) wt[wave] = inc;
    __syncthreads();
    float base = cm;
    for (int w = 0; w < wave; ++w) base += wt[w];
    base += inc - run;
#pragma unroll 1
    for (int i = 0; i < 16; ++i) { base += lp[i * 16]; DK[KPRE + tid * 16 + i] = -base * LOG2E; }
    __syncthreads();
}

struct MoeOrder {
    int G, c, UT; const LAS int* pre; const char* A; const char* W; size_t wexp, tsB;
    __device__ __forceinline__ bool next(int i, pg8::Unit& u) const {
        const int g = i * G + c; if (g >= UT || i >= ROWTAB_UNITS) return false;
        const int rt = g >> 2; int e = 0; while (pre[e + 1] <= rt) ++e;
        u.pm = rt - pre[e]; u.pn = g & 3; u.A = A; u.B = W + (size_t)e * wexp + (size_t)u.pn * tsB; u.tab = i; u.e = e; return true;
    }
};
__device__ __forceinline__ int moe_setup(const Params& p, const Ctx& C, int layer, MoeOrder& S) {
    LAS int* pre = (LAS int*)(C.lds + MOEPRE_OFF); LAS int* cnts = pre + 40; LAS int* rowtab = (LAS int*)(C.lds + ROWTAB_OFF);
    const gu32* CNT = (const gu32*)(p.ws + WS_CTL) + CW_CNT + layer * 2048;
    if (C.tid < 32) cnts[C.tid] = (int)__hip_atomic_load(CNT + 64 * C.tid, RLX_AGENT);
    __syncthreads();
    if (C.tid == 0) { int a = 0; for (int e = 0; e < NEXP; ++e) { pre[e] = a; a += (cnts[e] + 255) >> 8; } pre[NEXP] = a; }
    __syncthreads();
    S.pre = pre; S.UT = 4 * pre[NEXP];
    const int* LIST = (const int*)(p.ws + WS_LIST);
    pg8::Unit u;
    for (int i = 0; S.next(i, u); ++i) { if (C.tid < 256) { const int idx = 256 * u.pm + C.tid; rowtab[i * 256 + C.tid] = idx < cnts[u.e] ? LIST[(size_t)u.e * LCAP + idx] : -1; } }
    __syncthreads();
    return S.UT;
}

__global__ void __launch_bounds__(NWAVES * 64, 2) trunk_fwd(Params p) {
    extern __shared__ __attribute__((aligned(16))) unsigned char lds[];
    Ctx C;
    C.lds = (LAS unsigned char*)lds; C.tid = threadIdx.x; C.lane = C.tid & 63; C.wave = __builtin_amdgcn_readfirstlane(C.tid >> 6);
    C.G = gridDim.x; { const int bx = blockIdx.x; C.vcu = (C.G % 8 == 0) ? (bx % 8) * (C.G / 8) + bx / 8 : bx; }
    volatile LAS unsigned* MISC = (volatile LAS unsigned*)(C.lds + MISC_OFF);
    gu32* ctl = (gu32*)(p.ws + WS_CTL);
    if (C.tid < 32) MISC[C.tid] = 0u;
    __syncthreads();
    XcdBarrier bar; bar.bar = (unsigned*)(ctl + CW_BAR) + p.li * XCD_BAR_WORDS; bar.x = 0; bar.st = nullptr;
    if (!MK_PER_PHASE) bar = xcd_barrier_post((unsigned*)(ctl + CW_BAR) + p.li * XCD_BAR_WORDS, MISC + 8);
#define GRID_BAR() do { if (MK_PER_PHASE) { if (C.tid == 0) __hip_atomic_store(ctl + CW_TMO, 0xBADBA0u, RLX_AGENT); } else { xcd_barrier(bar); } } while (0)
    const int lo = p.ph_lo, hi = p.ph_hi;
#ifndef SUBMASK
#define SUBMASK 0x7f
#endif
#ifndef REP_MASK
#define REP_MASK 0
#endif
#define NREP(k) (((REP_MASK >> (k)) & 1) ? 2 : 1)
#ifndef PHASE_MASK
#define PHASE_MASK 0xffff
#endif
#define IN(k) (((PHASE_MASK >> (k)) & 1) && lo <= (k) && (k) < hi)
#define SEAM(k) do { if (IN(k) && IN((k) + 1)) GRID_BAR(); } while (0)
    bf16* XH = (bf16*)(p.ws + WS_XH); bf16* QB = (bf16*)(p.ws + WS_Q); bf16* KB = (bf16*)(p.ws + WS_K); bf16* VB = (bf16*)(p.ws + WS_V);
    bf16* O0 = (bf16*)(p.ws + WS_O0); bf16* O1 = (bf16*)p.out;
    const LAS int* rowtab = (const LAS int*)(C.lds + ROWTAB_OFF);

    if (IN(0)) { for (int rep_ = 0; rep_ < NREP(0); ++rep_) p0_prologue(p, fresh(C)); } SEAM(0);

    for (int layer = 0; layer < 2; ++layer) {
        const int pb = 1 + (layer ? 8 : 0);
        if ((SUBMASK & 1) && IN(pb)) { for (int rep_ = 0; rep_ < NREP(pb); ++rep_) {
            if (layer == 1) cumsum_job(p, fresh(C));
            pg8::StaticOrder S; S.init(NRP, 3 * DM, C.G, (int)blockIdx.x, XH, DM * 2, p.ws + (layer ? WS_WQKV1 : WS_WQKV0), DM * 2);
            pg8::EpiQKV E{QB, KB, VB, attn_body::C2, layer ? (unsigned*)(ctl + CW_QM) : nullptr, (unsigned*)(ctl + CW_KM)};
            pg8::gemm_phase<pg8::EpiQKV, pg8::StaticOrder, true, false>(C.lds + RING_OFF, DM, DM * 2, S, E, rowtab, 0);
        } } SEAM(pb);
        if (layer == 0) {
            if (IN(2)) { for (int rep_ = 0; rep_ < NREP(2); ++rep_) {
                const float* TAB = (const float*)(p.ws + WS_TAB);
                for (int pr = C.vcu; pr < NBATCH * 16 * 16; pr += C.G) { const int trip = pr >> 4, s = pr & 15, b = trip >> 4, m = trip & 15; const int cv = (m >> 1) * 128;
#pragma unroll 1
                    for (int w = 0; w < 2; ++w) attn_body::attn_unit_dv<8>(b, w ? s : 31 - s, m * 64, cv, cv, (const attn_body::bf16*)QB, (const attn_body::bf16*)KB, (const attn_body::bf16*)VB, (attn_body::bf16*)((m & 1) ? O1 : O0), TAB + m * 128, (char*)lds + RING_OFF); }
            } } SEAM(2);
            if (IN(3)) { combine_phase(p, fresh(C)); } SEAM(3);
        } else {
            if (IN(10)) { for (int rep_ = 0; rep_ < NREP(10); ++rep_) {
                const float* DK = (const float*)(p.ws + WS_DK);
                LAS int* tk = (LAS int*)(C.lds + MOEPRE_OFF);
                for (;;) {
                    const int lane_ = fresh(C).lane;
                    if (C.tid == 0) tk[0] = (int)__hip_atomic_fetch_add(ctl + CW_QCTR + 64 * rep_, 1u, RLX_AGENT);
                    __syncthreads(); const int u = tk[0]; __syncthreads();
                    if (u >= NBATCH * 16 * 32) break;
                    const int qb = 31 - (u >> 6), bh = u & 63, b = bh >> 4, h = bh & 15;
                    const float* dk = DK + (size_t)bh * KROWS;
                    const unsigned qmb = lane_ < 8 ? __hip_atomic_load(ctl + CW_QM + ((size_t)(b * 32 + qb) * 16 + h) * 8 + lane_, RLX_AGENT) : 0u;
                    const unsigned kmb = lane_ < 8 ? __hip_atomic_load(ctl + CW_KM + ((size_t)bh) * 8 + lane_, RLX_AGENT) : 0u;
                    const int ntf = 4 * qb + 6;
                    float e0 = lane_ < ntf ? dk[lane_ == 0 ? NMETA - 1 : 64 * lane_ + 63] : 0.f, e1 = lane_ + 64 < ntf ? dk[64 * (lane_ + 64) + 63] : 0.f, e2 = lane_ + 128 < ntf ? dk[64 * (lane_ + 128) + 63] : 0.f;
                    const float q2 = wave_sum(__uint_as_float(qmb), lane_), k2 = wave_sum(__uint_as_float(kmb), lane_);
                    const float thr = dk[KPRE + 256 * qb] - 40.f - 2.1f * sqrtf(q2 * k2);
                    const unsigned long long m0 = __ballot(lane_ < ntf && e0 >= thr), m1 = __ballot(lane_ + 64 < ntf && e1 >= thr), m2 = __ballot(lane_ + 128 < ntf && e2 >= thr);
                    int tb = m0 ? __builtin_ctzll(m0) : (m1 ? 64 + __builtin_ctzll(m1) : (m2 ? 128 + __builtin_ctzll(m2) : ntf - 6));
                    tb &= ~1; tb = tb > ntf - 6 ? ntf - 6 : tb; tb = __builtin_amdgcn_readfirstlane(tb);
                    attn_body::attn_unit<1, 8>(b, qb, tb, h * 64, h * 64, h * 64, (const attn_body::bf16*)QB, (const attn_body::bf16*)KB, (const attn_body::bf16*)VB, (attn_body::bf16*)O0, dk, (char*)lds + RING_OFF);
                }
                fox_meta_attn(p, fresh(C));
            } } SEAM(10);
        }
        const int pw = layer ? 11 : 4;
        if ((SUBMASK & 4) && IN(pw)) { for (int rep_ = 0; rep_ < NREP(pw); ++rep_) {
            pg8::StaticOrder S; S.init(NRP, DM, C.G, (int)blockIdx.x, layer ? O0 : QB, DM * 2, p.ws + (layer ? WS_WO1 : WS_WO0), DM * 2);
            pg8::EpiZ E{XH};
            pg8::gemm_phase<pg8::EpiZ, pg8::StaticOrder, true, false>(C.lds + RING_OFF, DM, DM * 2, S, E, rowtab, 0);
        } } SEAM(pw);
        if ((SUBMASK & 8) && IN(pw + 1)) { ln_phase<0>(p, fresh(C), layer); } SEAM(pw + 1);
        if ((SUBMASK & 16) && IN(pw + 2)) { for (int rep_ = 0; rep_ < NREP(pw + 2); ++rep_) {
            MoeOrder S; S.G = C.G; S.c = (int)blockIdx.x; S.A = (const char*)XH; S.W = (const char*)(p.ws + WS_WGU); S.wexp = (size_t)DM * DM * 2; S.tsB = (size_t)256 * DM * 2;
            moe_setup(p, fresh(C), layer, S);
            pg8::EpiGU E{(pg8::bf16_t*)O0};
            pg8::gemm_phase<pg8::EpiGU, MoeOrder, true, true>(C.lds + RING_OFF, DM, DM * 2, S, E, rowtab, 1);
        } } SEAM(pw + 2);
        if ((SUBMASK & 32) && IN(pw + 3)) { for (int rep_ = 0; rep_ < NREP(pw + 3); ++rep_) {
            MoeOrder S; S.G = C.G; S.c = (int)blockIdx.x; S.A = (const char*)O0; S.W = (const char*)(p.ws + WS_WD); S.wexp = (size_t)DM * DEXP * 2; S.tsB = (size_t)256 * DEXP * 2;
            moe_setup(p, fresh(C), layer, S);
            pg8::EpiDown E{(pg8::bf16_t*)KB, (const float*)(p.ws + WS_GV)};
            pg8::gemm_phase<pg8::EpiDown, MoeOrder, true, true>(C.lds + RING_OFF, DEXP, DEXP * 2, S, E, rowtab, 0);
        } } SEAM(pw + 3);
        if ((SUBMASK & 64) && IN(pw + 4)) {
            if (layer == 0) { ln_phase<1>(p, fresh(C), 0); { const Ctx Cf = fresh(C); convert_experts(p, Cf, 1, 0, Cf.vcu * NWAVES + Cf.wave, Cf.G * NWAVES); } }
            else ln_phase<2>(p, fresh(C), 1);
        }
        if (layer == 0) SEAM(8);
    }
#undef IN
#undef SEAM
#undef GRID_BAR
}

extern "C" void kernel_launch(void* const* d_in, const int* in_sizes, int n_in, void* d_out, int out_size, void* d_ws, size_t ws_size, hipStream_t stream) {
    static int grid = 0;
    if (grid == 0) {
        if (n_in != 21 || in_sizes[0] != NREAL * DM || out_size != NREAL * DM || ws_size < WS_END) { fprintf(stderr, "kernel_launch: unexpected shapes (n_in %d, in0 %d, out %d, ws %zu); nothing launched\n", n_in, n_in > 0 ? in_sizes[0] : -1, out_size, ws_size); grid = -1; return; }
        int dev = 0, cus = 0, per_cu = 0;
        if (hipGetDevice(&dev) != hipSuccess || hipDeviceGetAttribute(&cus, hipDeviceAttributeMultiprocessorCount, dev) != hipSuccess) { fprintf(stderr, "kernel_launch: device query failed\n"); grid = -1; return; }
        if (hipFuncSetAttribute((const void*)trunk_fwd, hipFuncAttributeMaxDynamicSharedMemorySize, LDS_BYTES) != hipSuccess) { fprintf(stderr, "kernel_launch: hipFuncSetAttribute failed\n"); grid = -1; return; }
        if (hipOccupancyMaxActiveBlocksPerMultiprocessor(&per_cu, (const void*)trunk_fwd, NWAVES * 64, LDS_BYTES) != hipSuccess || per_cu < 1) { fprintf(stderr, "kernel_launch: occupancy query reports %d workgroups per CU\n", per_cu); }
        (void)hipGetLastError();
        grid = cus;
    }
    if (grid < 0) return;
    if (hipMemsetAsync((char*)d_ws + WS_CTL, 0, CTL_ZERO_BYTES, stream) != hipSuccess) { fprintf(stderr, "kernel_launch: hipMemsetAsync failed\n"); return; }
    Params a{};
    const float** dst = (const float**)&a.x;
    for (int i = 0; i < 21; ++i) dst[i] = (const float*)d_in[i];
    a.out = (float*)d_out; a.ws = (unsigned char*)d_ws;
#if MK_PER_PHASE
    for (int k = 0; k < N_PHASES; ++k) { a.ph_lo = k; a.ph_hi = k + 1; a.li = 0; hipLaunchKernelGGL(trunk_fwd, dim3(grid), dim3(NWAVES * 64), LDS_BYTES, stream, a); }
#else
    a.ph_lo = 0; a.ph_hi = N_PHASES; a.li = 0;
    hipLaunchKernelGGL(trunk_fwd, dim3(grid), dim3(NWAVES * 64), LDS_BYTES, stream, a);
#endif
    const hipError_t le = hipPeekAtLastError();
    if (le != hipSuccess) fprintf(stderr, "kernel_launch: launch failed: %s\n", hipGetErrorName(le));
}
```

```cpp
#include <hip/hip_runtime.h>
#include <hip/hip_bf16.h>
#include <cstdio>
#include <cstdint>
#include <cmath>

constexpr int DM = 1024, NBATCH = 4, SEQ = 8192, NMETA = 16;
constexpr int NREAL = NBATCH * SEQ;
constexpr int NR = NREAL + NMETA;
constexpr int NRP = 129 * 256;
constexpr int KPRE = 64;
constexpr int KROWS = KPRE + SEQ + 64;
constexpr int NSLOT = 2 * NR;
constexpr int NEXP = 32, DEXP = 512;
constexpr float ALPHA = 1.41421356237309515f;
constexpr float LN_EPS = 1e-5f;
constexpr float LOG2E = 1.4426950408889634f;
constexpr float LAMBDA_INIT0 = 0.2f;

namespace pg8 {
#define PG8_LAS __attribute__((address_space(3)))
typedef unsigned short bf16_t;
typedef short bf16x8 __attribute__((ext_vector_type(8)));
typedef float f32x4 __attribute__((ext_vector_type(4)));
typedef unsigned u32x4 __attribute__((ext_vector_type(4)));
constexpr int BM = 256, BK = 64, HALF = 128, HTB = HALF * BK * 2  , STAGE_BYTES = 8 * HTB, NXCD = 8, WGM = 8;

__host__ __device__ __forceinline__ int lds_byte(int r, int c) { const int st = (r >> 4) * 2 + (c >> 5), rr = r & 15, cc = c & 31, ob = rr * 64 + cc * 2; return st * 1024 + (ob ^ (((ob >> 9) & 1) << 5)); }
__host__ __device__ __forceinline__ void stage_rc(int b, int& R, int& C) { const int st = b / 1024, sb = b % 1024, swz = sb ^ (((sb >> 9) & 1) << 5); R = (st >> 1) * 16 + swz / 64; C = (st & 1) * 32 + (swz % 64) / 2; }
__host__ __device__ __forceinline__ int perm32(int rho) { const int n = rho >> 4, i = rho & 15; return 8 * (i >> 2) + 4 * n + (i & 3); }

struct Unit { int pm, pn; const char* A; const char* B; int tab; int e; };

struct StaticOrder {
    int nM, nN, nwg, G, c; const char* A; const char* B; size_t tsA, tsB;
    __device__ void init(int M, int N, int G_, int c_, const void* A_, size_t lda_bytes, const void* B_, size_t ldb_bytes) { nM = M / BM; nN = N / BM; nwg = nM * nN; G = G_; c = c_; A = (const char*)A_; B = (const char*)B_; tsA = lda_bytes * BM; tsB = ldb_bytes * BM; }
    __device__ bool next(int i, Unit& u) const {
        const long L = (long)i * G + c; if (L >= nwg) return false;
        int wgid = (int)L; { const int q = nwg / NXCD, r = nwg % NXCD, xcd = wgid % NXCD, off = wgid / NXCD; wgid = (xcd < r ? xcd * (q + 1) : r * (q + 1) + (xcd - r) * q) + off; }
        const int nig = WGM * nN, gid = wgid / nig, fm = gid * WGM, gsz = (nM - fm) < WGM ? (nM - fm) : WGM;
        u.pm = fm + ((wgid % nig) % gsz); u.pn = (wgid % nig) / gsz; u.A = A + (size_t)u.pm * tsA; u.B = B + (size_t)u.pn * tsB; u.tab = 0; u.e = 0; return true;
    }
};

__device__ __forceinline__ float shx(float v, int m, int lane) { return __uint_as_float((unsigned)__builtin_amdgcn_ds_bpermute((lane ^ m) << 2, (int)__float_as_uint(v))); }
__device__ __forceinline__ unsigned cvt_pk_bf16(float lo, float hi) { unsigned r; asm volatile("v_cvt_pk_bf16_f32 %0, %1, %2" : "=v"(r) : "v"(lo), "v"(hi)); return r; }

template <class Epi, class Sched, bool ALIGN_EPI, bool GATHER>
__device__ __forceinline__ void gemm_phase(PG8_LAS unsigned char* lds, const int K, const unsigned lda, const Sched& S, const Epi& E, const PG8_LAS int* rowtab, const int ashift) {
    int tid_ = threadIdx.x; asm volatile("" : "+v"(tid_));
    const int tid = tid_, wid = __builtin_amdgcn_readfirstlane(tid >> 6), lane = tid & 63, wr = wid >> 2, wc = wid & 3, fr = lane & 15, fq = lane >> 4;
    const int nt = K / BK;
    unsigned voffB[2], offA[2][2], noffA[2][2]; int Rr[2], Cc[2];
#pragma unroll
    for (int i = 0; i < 2; ++i) { int R, C; stage_rc(tid * 16 + i * 8192, R, C); const int Rb = Epi::PERM ? ((R & ~31) + perm32(R & 31)) : R; Rr[i] = R; Cc[i] = C;
        voffB[i] = (unsigned)(Rb * K + C) * 2u;
#pragma unroll
        for (int h = 0; h < 2; ++h) { offA[h][i] = (unsigned)(R + HALF * h) * lda + (unsigned)C * 2u; noffA[h][i] = offA[h][i]; } }
    const size_t kstep = (size_t)(BK * 2);
    const size_t hstep = (size_t)HALF * K * 2;
    const unsigned ldsw = (unsigned)wid * 1024u;
    const int aoff = lds_byte(wr * 64 + fr, fq * 8), boff = lds_byte(wc * 32 + fr, fq * 8);
#define PG8_SA(b, h) (((b) * 2 + (h)) * HTB)
#define PG8_SB(b, h) ((4 + (b) * 2 + (h)) * HTB)
#define PG8_STAGE(bufoff, gbase, voff) do { _Pragma("unroll") for (int _i = 0; _i < 2; ++_i) \
        __builtin_amdgcn_global_load_lds((const unsigned*)((const char*)(gbase) + (voff)[_i]), (PG8_LAS unsigned*)(lds + (bufoff) + ldsw + _i * 8192), 16, 0, 0); } while (0)
#define PG8_LDA(dst, b, h) do { _Pragma("unroll") for (int m = 0; m < 4; ++m) _Pragma("unroll") for (int k = 0; k < 2; ++k) dst[m][k] = *(const PG8_LAS bf16x8*)(lds + PG8_SA(b, h) + aoff + m * 2048 + k * 1024); } while (0)
#define PG8_LDB(dst, b, h) do { _Pragma("unroll") for (int n = 0; n < 2; ++n) _Pragma("unroll") for (int k = 0; k < 2; ++k) dst[n][k] = *(const PG8_LAS bf16x8*)(lds + PG8_SB(b, h) + boff + n * 2048 + k * 1024); } while (0)
#define PG8_MMA(ai, bj, At, Bt) do { __builtin_amdgcn_s_setprio(1); _Pragma("unroll") for (int m = 0; m < 4; ++m) _Pragma("unroll") for (int n = 0; n < 2; ++n) _Pragma("unroll") for (int k = 0; k < 2; ++k) \
        acc[ai][bj][m][n] = __builtin_amdgcn_mfma_f32_16x16x32_bf16(Bt[n][k], At[m][k], acc[ai][bj][m][n], 0, 0, 0); __builtin_amdgcn_s_setprio(0); } while (0)
#define PG8_WAIT_V(n) asm volatile("s_waitcnt vmcnt(" #n ")" ::: "memory")
#define PG8_WAIT_L(n) asm volatile("s_waitcnt lgkmcnt(" #n ")" ::: "memory")
#define PG8_BAR __builtin_amdgcn_s_barrier()
#define PG8_SCHED __builtin_amdgcn_sched_barrier(0)
#define PG8_GOFF(dst, u) do { if constexpr (GATHER) { _Pragma("unroll") for (int _h = 0; _h < 2; ++_h) _Pragma("unroll") for (int _i = 0; _i < 2; ++_i) { \
        int _e = rowtab[(u).tab * 256 + _h * HALF + Rr[_i]]; _e = _e < 0 ? 0 : (_e >> ashift); dst[_h][_i] = (unsigned)_e * lda + (unsigned)Cc[_i] * 2u; } } } while (0)
    Unit cur, nxt; int ui = 0;
    if (!S.next(0, cur)) return;
    f32x4 acc[2][2][4][2];
#pragma unroll
    for (int a = 0; a < 2; ++a)
#pragma unroll
        for (int b = 0; b < 2; ++b)
#pragma unroll
            for (int m = 0; m < 4; ++m)
#pragma unroll
                for (int n = 0; n < 2; ++n) acc[a][b][m][n] = (f32x4){0.f, 0.f, 0.f, 0.f};
    bf16x8 At[4][2], B0[2][2], B1[2][2];
    const char* cA = cur.A; const char* cB = cur.B;
    PG8_GOFF(offA, cur);
    PG8_STAGE(PG8_SB(0, 0), cB, voffB); PG8_STAGE(PG8_SB(0, 1), cB + hstep, voffB); PG8_STAGE(PG8_SA(0, 0), cA, offA[0]); PG8_STAGE(PG8_SA(0, 1), cA, offA[1]);
    if (wr == 1) PG8_BAR;
    PG8_WAIT_V(2); PG8_BAR;
    PG8_STAGE(PG8_SB(1, 0), cB + kstep, voffB); PG8_STAGE(PG8_SA(1, 0), cA + kstep, offA[0]); PG8_STAGE(PG8_SB(1, 1), cB + hstep + kstep, voffB);
    PG8_WAIT_V(6); PG8_BAR;
    for (;;) {
        const bool has_next = S.next(ui + 1, nxt);
        const char* nA = has_next ? nxt.A : cA; const char* nB = has_next ? nxt.B : cB;
        if constexpr (GATHER) { if (has_next) PG8_GOFF(noffA, nxt); else {
#pragma unroll
            for (int h = 0; h < 2; ++h)
#pragma unroll
                for (int i = 0; i < 2; ++i) noffA[h][i] = offA[h][i]; } }
        for (int t = 0; t < nt; t += 2) {
            const bool last = (t == nt - 2);
            const char* a1 = cA + (size_t)(t + 1) * kstep;
            const char* a2 = last ? nA : cA + (size_t)(t + 2) * kstep; const char* b2 = last ? nB : cB + (size_t)(t + 2) * kstep;
            const char* a3 = a2 + kstep; const char* b3 = b2 + kstep;
            unsigned o2[2][2];
#pragma unroll
            for (int h = 0; h < 2; ++h)
#pragma unroll
                for (int i = 0; i < 2; ++i) o2[h][i] = (GATHER && last) ? noffA[h][i] : offA[h][i];
            PG8_LDB(B0, 0, 0); PG8_LDB(B1, 0, 1); PG8_SCHED; PG8_LDA(At, 0, 0); PG8_STAGE(PG8_SA(1, 1), a1, offA[1]);
            PG8_WAIT_V(8); PG8_WAIT_L(0); PG8_BAR; PG8_MMA(0, 0, At, B0); PG8_MMA(0, 1, At, B1); PG8_BAR; PG8_SCHED;
            PG8_LDA(At, 0, 1); PG8_STAGE(PG8_SB(0, 0), b2, voffB); PG8_STAGE(PG8_SB(0, 1), b2 + hstep, voffB); PG8_STAGE(PG8_SA(0, 0), a2, o2[0]);
            PG8_WAIT_V(8); PG8_WAIT_L(0); PG8_BAR; PG8_MMA(1, 0, At, B0); PG8_MMA(1, 1, At, B1); PG8_BAR; PG8_SCHED;
            PG8_LDB(B0, 1, 0); PG8_LDB(B1, 1, 1); PG8_SCHED; PG8_LDA(At, 1, 0); PG8_STAGE(PG8_SA(0, 1), a2, o2[1]);
            PG8_WAIT_V(8); PG8_WAIT_L(0); PG8_BAR; PG8_MMA(0, 0, At, B0); PG8_MMA(0, 1, At, B1); PG8_BAR; PG8_SCHED;
            PG8_LDA(At, 1, 1); PG8_STAGE(PG8_SB(1, 0), b3, voffB); PG8_STAGE(PG8_SB(1, 1), b3 + hstep, voffB); PG8_STAGE(PG8_SA(1, 0), a3, o2[0]);
            PG8_WAIT_V(8); PG8_WAIT_L(0); PG8_BAR; PG8_MMA(1, 0, At, B0); PG8_MMA(1, 1, At, B1); PG8_BAR; PG8_SCHED;
        }
        if constexpr (ALIGN_EPI) { if (wr == 0) PG8_BAR; }
        E(acc, cur, wr, wc, fr, fq, rowtab);
        if (!has_next) break;
#pragma unroll
        for (int a = 0; a < 2; ++a)
#pragma unroll
            for (int b = 0; b < 2; ++b)
#pragma unroll
                for (int m = 0; m < 4; ++m)
#pragma unroll
                    for (int n = 0; n < 2; ++n) acc[a][b][m][n] = (f32x4){0.f, 0.f, 0.f, 0.f};
        cur = nxt; cA = nA; cB = nB; ++ui;
        if constexpr (GATHER) {
#pragma unroll
            for (int h = 0; h < 2; ++h)
#pragma unroll
                for (int i = 0; i < 2; ++i) offA[h][i] = noffA[h][i]; }
        if constexpr (ALIGN_EPI) { if (wr == 1) PG8_BAR; }
    }
    PG8_WAIT_V(0);
    if constexpr (!ALIGN_EPI) { if (wr == 0) PG8_BAR; }
    PG8_BAR;
#undef PG8_SA
#undef PG8_SB
#undef PG8_STAGE
#undef PG8_LDA
#undef PG8_LDB
#undef PG8_MMA
#undef PG8_WAIT_V
#undef PG8_WAIT_L
#undef PG8_BAR
#undef PG8_SCHED
#undef PG8_GOFF
}

struct EpiQKV {
    static constexpr bool PERM = true;
    bf16_t* Q; bf16_t* Kb; bf16_t* Vb; float qscale;
    unsigned* qm; unsigned* km;
    __device__ __forceinline__ void operator()(const f32x4 (&acc)[2][2][4][2], const Unit& u, int wr, int wc, int fr, int fq, const PG8_LAS int*) const {
        const int row0 = u.pm * BM + wr * 64 + fr; const int t = (u.pn * BM) >> 10; const int colt = (u.pn * BM) & 1023;
        const int col0 = colt + wc * 32 + 8 * fq; const float sc = (t == 0) ? qscale : 1.f;
        bf16_t* kv = (t == 1) ? Kb : Vb;
        float mx[2] = {0.f, 0.f};
#pragma unroll
        for (int ai = 0; ai < 2; ++ai)
#pragma unroll
            for (int m = 0; m < 4; ++m) { const int r = row0 + ai * HALF + m * 16;
                if (r < NR) {
#pragma unroll
                for (int bj = 0; bj < 2; ++bj) { const f32x4 v0 = acc[ai][bj][m][0] * sc, v1 = acc[ai][bj][m][1] * sc;
                    u32x4 w; w.x = cvt_pk_bf16(v0[0], v0[1]); w.y = cvt_pk_bf16(v0[2], v0[3]); w.z = cvt_pk_bf16(v1[0], v1[1]); w.w = cvt_pk_bf16(v1[2], v1[3]);
                    const int c = col0 + bj * HALF;
                    bf16_t* dst = (t == 0) ? Q + (size_t)r * DM : kv + (size_t)(r < NREAL ? (r >> 13) * KROWS + KPRE + (r & (SEQ - 1)) : r - NREAL) * DM;
                    *(u32x4*)(dst + c) = w; } }
                if (qm != nullptr && t < 2) {
#pragma unroll
                    for (int bj = 0; bj < 2; ++bj) { const f32x4 v0 = acc[ai][bj][m][0] * sc, v1 = acc[ai][bj][m][1] * sc;
                        float ss = (v0[0] * v0[0] + v0[1] * v0[1]) + (v0[2] * v0[2] + v0[3] * v0[3]) + (v1[0] * v1[0] + v1[1] * v1[1]) + (v1[2] * v1[2] + v1[3] * v1[3]);
                        ss += shx(ss, 16, fq * 16 + fr); ss += shx(ss, 32, fq * 16 + fr);
                        if (r < NR) mx[bj] = fmaxf(mx[bj], ss); } } }
        if (qm != nullptr && t < 2) {
#pragma unroll
            for (int bj = 0; bj < 2; ++bj) { float v = mx[bj]; v = fmaxf(v, shx(v, 1, fq * 16 + fr)); v = fmaxf(v, shx(v, 2, fq * 16 + fr)); v = fmaxf(v, shx(v, 4, fq * 16 + fr)); v = fmaxf(v, shx(v, 8, fq * 16 + fr));
                if (fr == 0 && fq == 0) { const int head = 4 * (u.pn & 3) + 2 * bj + (wc >> 1), part = wc & 1; const unsigned bits = __float_as_uint(v);
                    if (t == 0) { if (u.pm < NREAL / BM) atomicMax(qm + ((size_t)u.pm * 16 + head) * 8 + part, bits); }
                    else if (u.pm < NREAL / BM) atomicMax(km + ((size_t)(u.pm >> 5) * 16 + head) * 8 + part, bits);
                    else { for (int b = 0; b < NBATCH; ++b) atomicMax(km + ((size_t)b * 16 + head) * 8 + part, bits); } } } }
    }
};
struct EpiZ {
    static constexpr bool PERM = true;
    bf16_t* H;
    __device__ __forceinline__ void operator()(const f32x4 (&acc)[2][2][4][2], const Unit& u, int wr, int wc, int fr, int fq, const PG8_LAS int*) const {
        const int row0 = u.pm * BM + wr * 64 + fr; const int col0 = u.pn * BM + wc * 32 + 8 * fq;
#pragma unroll
        for (int ai = 0; ai < 2; ++ai)
#pragma unroll
            for (int m = 0; m < 4; ++m) { const int r = row0 + ai * HALF + m * 16;
                if (r < NR) {
#pragma unroll
                    for (int bj = 0; bj < 2; ++bj) { bf16_t* hp = H + (size_t)r * DM + col0 + bj * HALF; const u32x4 b = *(const u32x4*)hp;
                        const f32x4 v0 = acc[ai][bj][m][0], v1 = acc[ai][bj][m][1];
                        u32x4 w; w.x = cvt_pk_bf16(v0[0] + ALPHA * __uint_as_float(b.x << 16), v0[1] + ALPHA * __uint_as_float(b.x & 0xffff0000u)); w.y = cvt_pk_bf16(v0[2] + ALPHA * __uint_as_float(b.y << 16), v0[3] + ALPHA * __uint_as_float(b.y & 0xffff0000u));
                        w.z = cvt_pk_bf16(v1[0] + ALPHA * __uint_as_float(b.z << 16), v1[1] + ALPHA * __uint_as_float(b.z & 0xffff0000u)); w.w = cvt_pk_bf16(v1[2] + ALPHA * __uint_as_float(b.w << 16), v1[3] + ALPHA * __uint_as_float(b.w & 0xffff0000u));
                        *(u32x4*)hp = w; } } }
    }
};
struct EpiGU {
    static constexpr bool PERM = true;
    bf16_t* U;
    __device__ __forceinline__ void operator()(const f32x4 (&acc)[2][2][4][2], const Unit& u, int wr, int wc, int fr, int fq, const PG8_LAS int* rowtab) const {
        const int col0 = u.pn * HALF + wc * 32 + 8 * fq;
#pragma unroll
        for (int ai = 0; ai < 2; ++ai)
#pragma unroll
            for (int m = 0; m < 4; ++m) { const int slot = rowtab[u.tab * 256 + ai * HALF + wr * 64 + m * 16 + fr];
                if (slot >= 0) { float o[8];
#pragma unroll
                    for (int n = 0; n < 2; ++n)
#pragma unroll
                        for (int c = 0; c < 4; ++c) { const float g = acc[ai][0][m][n][c], up = acc[ai][1][m][n][c]; o[n * 4 + c] = g * up * __builtin_amdgcn_rcpf(1.f + __builtin_amdgcn_exp2f(-g * LOG2E)); }
                    u32x4 w; w.x = cvt_pk_bf16(o[0], o[1]); w.y = cvt_pk_bf16(o[2], o[3]); w.z = cvt_pk_bf16(o[4], o[5]); w.w = cvt_pk_bf16(o[6], o[7]);
                    *(u32x4*)(U + (size_t)slot * DEXP + col0) = w; } }
    }
};
struct EpiDown {
    static constexpr bool PERM = true;
    bf16_t* Y; const float* GV;
    __device__ __forceinline__ void operator()(const f32x4 (&acc)[2][2][4][2], const Unit& u, int wr, int wc, int fr, int fq, const PG8_LAS int* rowtab) const {
        const int col0 = u.pn * BM + wc * 32 + 8 * fq;
#pragma unroll
        for (int ai = 0; ai < 2; ++ai)
#pragma unroll
            for (int m = 0; m < 4; ++m) { const int slot = rowtab[u.tab * 256 + ai * HALF + wr * 64 + m * 16 + fr];
                if (slot >= 0) { const float gv = GV[slot];
#pragma unroll
                    for (int bj = 0; bj < 2; ++bj) { const f32x4 v0 = acc[ai][bj][m][0] * gv, v1 = acc[ai][bj][m][1] * gv;
                        u32x4 w; w.x = cvt_pk_bf16(v0[0], v0[1]); w.y = cvt_pk_bf16(v0[2], v0[3]); w.z = cvt_pk_bf16(v1[0], v1[1]); w.w = cvt_pk_bf16(v1[2], v1[3]);
                        *(u32x4*)(Y + (size_t)slot * DM + col0 + bj * HALF) = w; } } }
    }
};
}
namespace attn_body {
using bf16=__hip_bfloat16;
using bf16x8=__attribute__((ext_vector_type(8)))short;
using s16x4=__attribute__((ext_vector_type(4)))short;
using f32x16=__attribute__((ext_vector_type(16)))float;
using u32x4=__attribute__((ext_vector_type(4)))unsigned;
constexpr int D=64;
constexpr int NW=8,QBLK=32,QB=QBLK*NW,KVBLK=64,NQB=SEQ/QB;
constexpr int ATTN_PITCH=DM, ATTN_UNIT_ROWS=QB;
__device__ __forceinline__ int crow(int r,int hi){return (r&3)+8*(r>>2)+4*hi;}
#define SBAR() __builtin_amdgcn_sched_barrier(0)
__device__ __forceinline__ void cmask(f32x16&p0,f32x16&p1,int jb,int qrel,int hi){
  const float NEG=-INFINITY; int kb=64*jb+4*hi;
  #pragma unroll
  for(int r=0;r<16;++r){int kv=kb+(r&3)+8*(r>>2); if(kv>qrel)p0[r]=NEG; if(kv+32>qrel)p1[r]=NEG;}
}

constexpr int RT_OFFS=320, RT_SIZE=704;

template<int MODE> __device__ __forceinline__ void modtile_slow(f32x16&p0,f32x16&p1,int t,int q_abs,int q0,int hi,const __attribute__((address_space(3))) float* tab){
  const float NEG=-INFINITY; int hi4=4*hi; asm volatile("":"+v"(hi4),"+v"(q_abs));
  if(MODE==0){
    if(t==0){
      int bd=16+q_abs; bd=bd>383?383:bd; const __attribute__((address_space(3))) float* bp=tab+(RT_OFFS+bd-hi4-15);
      #pragma unroll
      for(int r=0;r<16;++r){ p1[r]=NEG; if(r<8)p0[r]+=bp[15-((r&3)+8*(r>>2))]; else p0[r]=NEG; }
    } else {
      const __attribute__((address_space(3))) float* bp=tab+(RT_OFFS+q_abs-64*t+KPRE-hi4-63);
      const int dq=q_abs-64*t+KPRE-hi4;
      #pragma unroll
      for(int r=0;r<16;++r){ const int c=(r&3)+8*(r>>2); p0[r]+=bp[63-c]; p1[r]+=bp[31-c]; }
      if(64*t-KPRE+63>q0){
        #pragma unroll
        for(int r=0;r<16;++r){ const int c=(r&3)+8*(r>>2); if(c>dq)p0[r]=NEG; if(c+32>dq)p1[r]=NEG; } }
    }
  } else {
    if(t==0){
      #pragma unroll
      for(int r=0;r<16;++r){ p1[r]=NEG; if(r<8)p0[r]+=tab[(r&3)+8*(r>>2)+hi4]; else p0[r]=NEG; }
    } else {
      typedef float f4 __attribute__((ext_vector_type(4)));
      const __attribute__((address_space(3))) f4* tp=(const __attribute__((address_space(3))) f4*)(tab+64*t+hi4);
      #pragma unroll
      for(int g=0;g<4;++g){ const f4 a=tp[2*g], b=tp[8+2*g];
        #pragma unroll
        for(int c=0;c<4;++c){ p0[4*g+c]+=a[c]; p1[4*g+c]+=b[c]; }
        asm volatile("":::"memory"); }
      if(64*t-KPRE+63>q0){
        const int dq=q_abs-64*t+KPRE-hi4;
        #pragma unroll
        for(int r=0;r<16;++r){ const int c=(r&3)+8*(r>>2); if(c>dq)p0[r]=NEG; if(c+32>dq)p1[r]=NEG; } }
    }
  }
}
__device__ __forceinline__ void modtile_fast1(f32x16&p0,f32x16&p1,int t,int hi,const __attribute__((address_space(3))) float* tab){
  typedef float f4 __attribute__((ext_vector_type(4)));
  const __attribute__((address_space(3))) f4* tp=(const __attribute__((address_space(3))) f4*)(tab+64*t+4*hi);
  #pragma unroll
  for(int g=0;g<4;++g){ const f4 a=tp[2*g], b=tp[8+2*g];
    #pragma unroll
    for(int c=0;c<4;++c){ p0[4*g+c]+=a[c]; p1[4*g+c]+=b[c]; } }
}
constexpr int NSLOT=3, SLOTB=8192;
constexpr int LDS_K=0, LDS_V=NSLOT*SLOTB, LDS_WS=2*NSLOT*SLOTB, LDS_OST=LDS_WS+NW*64*4, LDS_TAB=LDS_OST+NW*4096, LDS_BYTES=LDS_TAB+KROWS*4;
constexpr float C2=0.125f*1.4426950408889634f;
__device__ __forceinline__ void glds16(const void*gsrc,unsigned lds_dst){unsigned keep;
  asm volatile("s_mov_b32 %0, m0\n\ts_mov_b32 m0, %2\n\ts_nop 0\n\tglobal_load_lds_dwordx4 %1, off\n\ts_mov_b32 m0, %0":"=&s"(keep):"v"(gsrc),"s"(lds_dst):"memory");}
__device__ __forceinline__ float max3f(float a,float b,float c){float r;asm("v_max3_f32 %0, %1, %2, %3":"=v"(r):"v"(a),"v"(b),"v"(c));return r;}
__device__ __forceinline__ float max2f(float a,float b){float r;asm("v_max_f32_e32 %0, %1, %2":"=v"(r):"v"(a),"v"(b));return r;}
__device__ __forceinline__ float fadd_s(float a,float b){float r;asm("v_add_f32_e32 %0, %1, %2":"=v"(r):"v"(a),"v"(b));return r;}
__device__ __forceinline__ float fsub_s(float a,float b){float r;asm("v_sub_f32_e32 %0, %1, %2":"=v"(r):"v"(a),"v"(b));return r;}
typedef float f32x2_t __attribute__((ext_vector_type(2))); typedef __bf16 bf16x2_t __attribute__((ext_vector_type(2)));
__device__ __forceinline__ unsigned cvtpk_s(float lo,float hi){f32x2_t v={lo,hi};bf16x2_t b=__builtin_convertvector(v,bf16x2_t);return __builtin_bit_cast(unsigned,b);}
#define WAIT_BAR(N) asm volatile("s_waitcnt vmcnt(" #N ") lgkmcnt(0)\n\ts_barrier":::"memory")

__device__ __forceinline__ void qkt(f32x16&p0,f32x16&p1,const char*Kslot,const bf16x8*qr,const f32x16&negm,int r32,int hi){
  const char*kb=Kslot+hi*1024+r32*16;
  #pragma unroll
  for(int d0=0;d0<4;++d0){
    const bf16x8 b0=*reinterpret_cast<const bf16x8*>(kb+d0*2048);
    const bf16x8 b1=*reinterpret_cast<const bf16x8*>(kb+d0*2048+512);
    if(d0==0){p0=__builtin_amdgcn_mfma_f32_32x32x16_bf16(b0,qr[0],negm,0,0,0);p1=__builtin_amdgcn_mfma_f32_32x32x16_bf16(b1,qr[0],negm,0,0,0);}
    else{p0=__builtin_amdgcn_mfma_f32_32x32x16_bf16(b0,qr[d0],p0,0,0,0);p1=__builtin_amdgcn_mfma_f32_32x32x16_bf16(b1,qr[d0],p1,0,0,0);}}
}
typedef __attribute__((address_space(3))) const char* lds_cptr;
typedef short v4i16_t __attribute__((ext_vector_type(4)));
__device__ __forceinline__ void kload8(bf16x8*kf,lds_cptr kp){
  kf[0]=*(const __attribute__((address_space(3))) bf16x8*)(kp);      kf[1]=*(const __attribute__((address_space(3))) bf16x8*)(kp+512);
  kf[2]=*(const __attribute__((address_space(3))) bf16x8*)(kp+2048); kf[3]=*(const __attribute__((address_space(3))) bf16x8*)(kp+2560);
  kf[4]=*(const __attribute__((address_space(3))) bf16x8*)(kp+4096); kf[5]=*(const __attribute__((address_space(3))) bf16x8*)(kp+4608);
  kf[6]=*(const __attribute__((address_space(3))) bf16x8*)(kp+6144); kf[7]=*(const __attribute__((address_space(3))) bf16x8*)(kp+6656);
}
__device__ __forceinline__ void kload2(bf16x8*kf,lds_cptr kp,int j){ kf[2*j]=*(const __attribute__((address_space(3))) bf16x8*)(kp+j*2048); kf[2*j+1]=*(const __attribute__((address_space(3))) bf16x8*)(kp+j*2048+512); }
__device__ __forceinline__ s16x4 vtr(lds_cptr p){ return __builtin_bit_cast(s16x4,__builtin_amdgcn_ds_read_tr16_b64_v4i16((__attribute__((address_space(3))) v4i16_t*)p)); }
__device__ __forceinline__ float rowmax(const f32x16&p0,const f32x16&p1){
  float a=max3f(p0[0],p0[1],p1[0]),b=max3f(p0[2],p0[3],p1[1]);a=max3f(a,p1[2],p1[3]);
  #pragma unroll
  for(int r=4;r<16;r+=4){a=max3f(a,p0[r],p0[r+1]);b=max3f(b,p0[r+2],p0[r+3]);a=max3f(a,p1[r],p1[r+1]);b=max3f(b,p1[r+2],p1[r+3]);}
  const float m=max2f(a,b);
  auto rr=__builtin_amdgcn_permlane32_swap(__float_as_uint(m),__float_as_uint(m),false,false);
  return max2f(__uint_as_float(rr[0]),__uint_as_float(rr[1]));
}
__device__ __forceinline__ void pv(f32x16*o,int vb,bf16x8 pa0,bf16x8 pa1,bf16x8 pa2,bf16x8 pa3){
  #pragma unroll
  for(int d0=0;d0<2;++d0){s16x4 lo[4],hi[4];
    #pragma unroll
    for(int ks=0;ks<4;++ks){
      asm volatile("ds_read_b64_tr_b16 %0,%1 offset:%c2":"=&v"(lo[ks]):"v"(vb),"i"(d0*4096+ks*1024):"memory");
      asm volatile("ds_read_b64_tr_b16 %0,%1 offset:%c2":"=&v"(hi[ks]):"v"(vb),"i"(d0*4096+ks*1024+512):"memory");}
    asm volatile("s_waitcnt lgkmcnt(0)":::"memory");SBAR();
    #define PK(k) (bf16x8){lo[k][0],lo[k][1],lo[k][2],lo[k][3],hi[k][0],hi[k][1],hi[k][2],hi[k][3]}
    o[d0]=__builtin_amdgcn_mfma_f32_32x32x16_bf16(pa0,PK(0),o[d0],0,0,0);
    o[d0]=__builtin_amdgcn_mfma_f32_32x32x16_bf16(pa1,PK(1),o[d0],0,0,0);
    o[d0]=__builtin_amdgcn_mfma_f32_32x32x16_bf16(pa2,PK(2),o[d0],0,0,0);
    o[d0]=__builtin_amdgcn_mfma_f32_32x32x16_bf16(pa3,PK(3),o[d0],0,0,0);
    #undef PK
  }
}

#ifndef ATTN_STORE16
#define ATTN_STORE16(p,v) (*(u32x4*)(p)=(v))
#endif
template<int MODE,int THRL> __device__ __forceinline__ void attn_unit(int b,int qb,int tb,int cq,int cv,int co,const bf16*Q,const bf16*__restrict__ K,const bf16*__restrict__ V,bf16*O,const float*tabsrc,char*shm){
  int tid_=threadIdx.x; asm volatile("":"+v"(tid_));
  const int tid=tid_,lane=tid&63,r32=lane&31,hi=lane>>5; const int wid=__builtin_amdgcn_readfirstlane(tid>>6);
  const long rowbase=(long)b*SEQ, rowbase_k=(long)b*KROWS; const int q0=qb*QB;
  const bf16*Qw=Q+(rowbase+q0+wid*QBLK)*DM+cq;
  const bf16*Kh=K+rowbase_k*DM+cq,*Vh=V+rowbase_k*DM+cv;
  const unsigned lds0=(unsigned)(uintptr_t)shm;
  const __attribute__((address_space(3))) char* shm3_=(const __attribute__((address_space(3))) char*)shm;
  float*wsf=(float*)(shm+LDS_WS)+wid*64;
  const bf16*ksrc=Kh+(long)(lane+64*tb)*DM+wid*8;
  const bf16*vsrc=Vh+(long)(16*(wid&3)+(lane>>2)+64*tb)*DM+(wid>>2)*32+(lane&3)*8;
  const unsigned kdst=lds0+LDS_K+wid*1024, vdst=lds0+LDS_V+wid*1024;
  #define DMA_K(t,slot) glds16(ksrc+(long)(t)*KVBLK*DM,(unsigned)__builtin_amdgcn_readfirstlane(kdst+(slot)))
  #define DMA_V(t,slot) glds16(vsrc+(long)(t)*KVBLK*DM,(unsigned)__builtin_amdgcn_readfirstlane(vdst+(slot)))
  const int vb0=(int)(lds0+LDS_V)+((lane>>4)&1)*32+(lane&3)*8+(4*hi+((lane&15)>>2))*64;
  const char*Kbase=shm+LDS_K; bf16x8 kf[8];
  const lds_cptr shm3=(lds_cptr)shm; const lds_cptr kp0=shm3+LDS_K+hi*1024+r32*16; const lds_cptr vp0=shm3+LDS_V+((lane>>4)&1)*32+(lane&3)*8+(4*hi+((lane&15)>>2))*64;
  const int NT=(KPRE+q0+QB+KVBLK)/KVBLK-tb;
  const __attribute__((address_space(3))) float* tab=(const __attribute__((address_space(3))) float*)(shm3_+LDS_TAB);
  { __attribute__((address_space(3))) float* tw=(__attribute__((address_space(3))) float*)(shm3_+LDS_TAB);
    if(MODE==0){ for(int i=tid;i<RT_SIZE;i+=512){ const int d=i-RT_OFFS; tw[i]=d<0?-INFINITY:(d<128?tabsrc[d]:0.f); } }
    else { const int n=KPRE+q0+QB+KVBLK; for(int i=64*tb+tid*4;i<n;i+=2048){ const float4 v=*(const float4*)(tabsrc+i); tw[i]=v.x;tw[i+1]=v.y;tw[i+2]=v.z;tw[i+3]=v.w; } } }
  if(tb==0){ glds16(K+cq+(long)lane*DM+wid*8,(unsigned)__builtin_amdgcn_readfirstlane(kdst)); glds16(V+cv+(long)(16*(wid&3)+(lane>>2))*DM+(wid>>2)*32+(lane&3)*8,(unsigned)__builtin_amdgcn_readfirstlane(vdst)); } else { DMA_K(0,0); DMA_V(0,0); } DMA_K(1,SLOTB);
  bf16x8 qr[4];
  #pragma unroll
  for(int d0=0;d0<4;++d0)qr[d0]=*reinterpret_cast<const bf16x8*>(&Qw[(long)r32*DM+d0*16+hi*8]);
  float l_reg=0.f;f32x16 o[2];o[0]=f32x16{};o[1]=f32x16{};f32x16 negm=f32x16{};asm volatile("":"+v"(negm));
  const int qrel=wid*QBLK+r32, q_abs=q0+qrel;
  #define MODT(P0,P1,t,SL) do{ if(SL)modtile_slow<MODE>(P0,P1,(t)+tb,q_abs,q0,hi,tab); else if(MODE==1)modtile_fast1(P0,P1,(t)+tb,hi,tab); }while(0)
  bool resc=false;
  #define START(P0,P1) do{ const float rm=rowmax(P0,P1); resc=false; \
    { const float dl=(MODE==1)?__builtin_fmaxf(rm,0.f):rm; const float nm_=fsub_s(negm[0],dl); \
      _Pragma("unroll") for(int r=0;r<16;++r){P0[r]=fsub_s(P0[r],dl);P1[r]=fsub_s(P1[r],dl);} \
      _Pragma("unroll") for(int r=0;r<16;++r)negm[r]=nm_; asm volatile("":"+v"(negm)); } \
    _Pragma("unroll") for(int r=0;r<16;++r)P0[r]=__builtin_amdgcn_exp2f(P0[r]); }while(0)
  #define RESC() do{ if(resc){ asm volatile("s_waitcnt lgkmcnt(0)":::"memory"); \
      _Pragma("unroll") for(int d_=0;d_<2;++d_) _Pragma("unroll") for(int r=0;r<16;++r)o[d_][r]*=wsf[crow(r,hi)]; } }while(0)
  f32x16 pA0,pA1,pB0,pB1;
  int sl_prev=0,sl_cur=0,sl_next=SLOTB;
  #define ROT() do{sl_prev=sl_cur;sl_cur=sl_next;sl_next=(sl_next==(NSLOT-1)*SLOTB)?0:sl_next+SLOTB;}while(0)
  DMA_K(2,2*SLOTB);
  WAIT_BAR(3);
  if(MODE==1){ const float m0_=tab[KPRE+q_abs]; _Pragma("unroll") for(int r=0;r<16;++r)negm[r]=-m0_; asm volatile("":"+v"(negm)); }
  qkt(pA0,pA1,Kbase,qr,negm,r32,hi);asm volatile("s_nop 15\n\ts_nop 7":"+v"(pA0),"+v"(pA1));MODT(pA0,pA1,0,true);
  START(pA0,pA1);
  _Pragma("unroll") for(int r=0;r<16;++r)pA1[r]=__builtin_amdgcn_exp2f(pA1[r]);
  WAIT_BAR(0);
  DMA_K(3,0);DMA_V(1,SLOTB);
  ROT();
  kload8(kf,kp0+sl_cur);
  WAIT_BAR(2);
  s16x4 vlo[8],vhi[8]; u32x4 pw0,pw1,pw2,pw3;
  #define PKW(P,B) cvtpk_s(P[B],P[B+1])
  #define PAF(k) __builtin_bit_cast(bf16x8,pw##k)
  #define VFR(i) (bf16x8){vlo[i][0],vlo[i][1],vlo[i][2],vlo[i][3],vhi[i][0],vhi[i][1],vhi[i][2],vhi[i][3]}
  #define PIN(x) asm volatile("":"+v"(x))
  #define MX3(a,b,c) __builtin_fmaxf(__builtin_fmaxf((a),(b)),(c))
  #define GAPA(MF,A0,A1,A2,A3,W0,W1,PW) do{ MF; sacc+=A0; sacc+=A1; sacc+=A2; sacc+=A3; PIN(sacc); W0; W1; PIN(PW); SBAR(); }while(0)
  #define EX(v) __builtin_amdgcn_exp2f(v)
  #define GAPB(MF,X,B) do{ MF; X[B]=EX(X[B]); X[B+1]=EX(X[B+1]); X[B+2]=EX(X[B+2]); X[B+3]=EX(X[B+3]); PIN(X); SBAR(); }while(0)
  #define VRD(i) do{ vlo[i]=vtr(vp_+(((i)>>2)*4096+((i)&3)*1024)); vhi[i]=vtr(vp_+(((i)>>2)*4096+((i)&3)*1024+512)); }while(0)
  #define KRD(G,j) do{ if(G){ kload2(kf,kp0+sl_next,j); SBAR(); } }while(0)
  #define STEP(C0,C1,P0,P1,t,GK,GV,GL,SL) do{ SBAR(); \
    const lds_cptr vp_=vp0+sl_prev; \
    VRD(0); SBAR(); float sacc=(P0[0]+P0[1]); \
    GAPA(C0=__builtin_amdgcn_mfma_f32_32x32x16_bf16(kf[0],qr[0],negm,0,0,0), P0[2],P0[3],P0[4],P0[5],     pw0[0]=PKW(P0,0), pw0[1]=PKW(P0,2), pw0); \
    VRD(4); SBAR(); GAPA(C1=__builtin_amdgcn_mfma_f32_32x32x16_bf16(kf[1],qr[0],negm,0,0,0), P0[6],P0[7],P0[8],P0[9],     pw0[2]=PKW(P0,4), pw0[3]=PKW(P0,6), pw0); \
    VRD(1); SBAR(); GAPA(C0=__builtin_amdgcn_mfma_f32_32x32x16_bf16(kf[2],qr[1],C0,0,0,0),   P0[10],P0[11],P0[12],P0[13], pw1[0]=PKW(P0,8), pw1[1]=PKW(P0,10), pw1); \
    VRD(5); SBAR(); GAPA(C1=__builtin_amdgcn_mfma_f32_32x32x16_bf16(kf[3],qr[1],C1,0,0,0),   P0[14],P0[15],P1[0],P1[1],   pw1[2]=PKW(P0,12),pw1[3]=PKW(P0,14), pw1); \
    VRD(2); SBAR(); GAPA(C0=__builtin_amdgcn_mfma_f32_32x32x16_bf16(kf[4],qr[2],C0,0,0,0),   P1[2],P1[3],P1[4],P1[5],     pw2[0]=PKW(P1,0), pw2[1]=PKW(P1,2), pw2); \
    VRD(6); SBAR(); GAPA(C1=__builtin_amdgcn_mfma_f32_32x32x16_bf16(kf[5],qr[2],C1,0,0,0),   P1[6],P1[7],P1[8],P1[9],     pw2[2]=PKW(P1,4), pw2[3]=PKW(P1,6), pw2); \
    VRD(3); SBAR(); GAPA(C0=__builtin_amdgcn_mfma_f32_32x32x16_bf16(kf[6],qr[3],C0,0,0,0),   P1[10],P1[11],P1[12],P1[13], pw3[0]=PKW(P1,8), pw3[1]=PKW(P1,10), pw3); \
    VRD(7); SBAR(); GAPA(C1=__builtin_amdgcn_mfma_f32_32x32x16_bf16(kf[7],qr[3],C1,0,0,0),   P1[14],P1[15],0.f,0.f,       pw3[2]=PKW(P1,12),pw3[3]=PKW(P1,14), pw3); \
    l_reg+=sacc; \
    if(GK){DMA_K((t)+3,sl_cur);} if(GV){DMA_V((t)+1,sl_next);} \
    MODT(C0,C1,t,SL); \
    { float a=MX3(C0[0],C0[1],C1[0]),b=MX3(C0[2],C0[3],C1[1]); a=MX3(a,C1[2],C1[3]); \
      _Pragma("unroll") for(int r=4;r<16;r+=4){a=MX3(a,C0[r],C0[r+1]);b=MX3(b,C0[r+2],C0[r+3]);a=MX3(a,C1[r],C1[r+1]);b=MX3(b,C1[r+2],C1[r+3]);} \
      float rm=__builtin_fmaxf(a,b); { auto rr=__builtin_amdgcn_permlane32_swap(__float_as_uint(rm),__float_as_uint(rm),false,false); rm=__builtin_fmaxf(__uint_as_float(rr[0]),__uint_as_float(rr[1])); } \
      resc=false; \
      if(__builtin_expect(__any(rm>(float)THRL),0)){ const float dl=__builtin_fmaxf(rm,0.f); const float nm_=negm[0]-dl; \
        _Pragma("unroll") for(int r=0;r<16;++r){C0[r]-=dl;C1[r]-=dl;} \
        _Pragma("unroll") for(int r=0;r<16;++r)negm[r]=nm_; asm volatile("":"+v"(negm)); \
        const float f=__builtin_amdgcn_exp2f(-dl); l_reg*=f; if(hi==0){ int r32_=r32; asm volatile("":"+v"(r32_)); wsf[r32_]=f; } resc=true; } } \
    SBAR(); \
    GAPB(o[0]=__builtin_amdgcn_mfma_f32_32x32x16_bf16(PAF(0),VFR(0),o[0],0,0,0), C0,0); \
    GAPB(o[1]=__builtin_amdgcn_mfma_f32_32x32x16_bf16(PAF(0),VFR(4),o[1],0,0,0), C0,4); \
    KRD(GL,0); GAPB(o[0]=__builtin_amdgcn_mfma_f32_32x32x16_bf16(PAF(1),VFR(1),o[0],0,0,0), C0,8); \
    KRD(GL,1); GAPB(o[1]=__builtin_amdgcn_mfma_f32_32x32x16_bf16(PAF(1),VFR(5),o[1],0,0,0), C0,12); \
    KRD(GL,2); GAPB(o[0]=__builtin_amdgcn_mfma_f32_32x32x16_bf16(PAF(2),VFR(2),o[0],0,0,0), C1,0); \
    KRD(GL,3); GAPB(o[1]=__builtin_amdgcn_mfma_f32_32x32x16_bf16(PAF(2),VFR(6),o[1],0,0,0), C1,4); \
    GAPB(o[0]=__builtin_amdgcn_mfma_f32_32x32x16_bf16(PAF(3),VFR(3),o[0],0,0,0), C1,8); \
    GAPB(o[1]=__builtin_amdgcn_mfma_f32_32x32x16_bf16(PAF(3),VFR(7),o[1],0,0,0), C1,12); \
    }while(0)
  int t=1;
  #define ENDW(tt) do{ if((tt)+3<NT){WAIT_BAR(2);} else if((tt)+2<NT){WAIT_BAR(1);} else {WAIT_BAR(0);} }while(0)
  for(;t+(MODE==1?5:7)<NT;t+=2){
    STEP(pB0,pB1,pA0,pA1,t,true,true,true,false);     WAIT_BAR(2); RESC(); ROT();
    STEP(pA0,pA1,pB0,pB1,t+1,true,true,true,false);   WAIT_BAR(2); RESC(); ROT();
  }
  for(;t+1<NT;t+=2){
    STEP(pB0,pB1,pA0,pA1,t,(t+3<NT),(t+1<NT),(t+1<NT),true);       ENDW(t);   RESC(); ROT();
    STEP(pA0,pA1,pB0,pB1,t+1,(t+4<NT),(t+2<NT),(t+2<NT),true);     ENDW(t+1); RESC(); ROT();
  }
  STEP(pB0,pB1,pA0,pA1,NT-1,false,false,false,true); RESC();
  { float sacc=pB0[0]+pB0[1]; _Pragma("unroll") for(int r=2;r<16;++r)sacc+=pB0[r]; _Pragma("unroll") for(int r=0;r<16;++r)sacc+=pB1[r]; l_reg+=sacc;
    pw0=(u32x4){PKW(pB0,0),PKW(pB0,2),PKW(pB0,4),PKW(pB0,6)};pw1=(u32x4){PKW(pB0,8),PKW(pB0,10),PKW(pB0,12),PKW(pB0,14)};pw2=(u32x4){PKW(pB1,0),PKW(pB1,2),PKW(pB1,4),PKW(pB1,6)};pw3=(u32x4){PKW(pB1,8),PKW(pB1,10),PKW(pB1,12),PKW(pB1,14)};
    SBAR(); pv(o,vb0+sl_cur,PAF(0),PAF(1),PAF(2),PAF(3)); }
  #undef PKW
  #undef PAF
  #undef VFR
  #undef PIN
  #undef MX3
  #undef GAPA
  #undef GAPB
  #undef EX
  #undef VRD
  #undef KRD
  #undef STEP
  #undef ENDW
  {auto rr=__builtin_amdgcn_permlane32_swap(__float_as_uint(l_reg),__float_as_uint(l_reg),false,false);l_reg=__uint_as_float(rr[0])+__uint_as_float(rr[1]);}
  if(hi==0)wsf[32+r32]=l_reg;asm volatile("s_waitcnt lgkmcnt(0)":::"memory");
  float rli[16];
  #pragma unroll
  for(int r=0;r<16;++r)rli[r]=__builtin_amdgcn_rcpf(wsf[32+crow(r,hi)]);
  bf16*Ow=O+(rowbase+q0+wid*QBLK)*DM+co;
  { bf16*stg=(bf16*)(shm+LDS_OST)+wid*2048;
    #pragma unroll
    for(int r=0;r<16;++r){const int orow=crow(r,hi);
      #pragma unroll
      for(int d0=0;d0<2;++d0)stg[orow*64+d0*32+r32]=__float2bfloat16(o[d0][r]*rli[r]);}
    asm volatile("s_waitcnt lgkmcnt(0)":::"memory");
    #pragma unroll
    for(int i=0;i<4;++i){const int row=i*8+(lane>>3),ch=lane&7; const u32x4 v=*(const u32x4*)(stg+row*64+ch*8); ATTN_STORE16(Ow+(long)row*DM+ch*8,v);} }
  asm volatile("s_waitcnt lgkmcnt(0)\n\ts_barrier":::"memory");
  #undef DMA_K
  #undef DMA_V
  #undef MODT
  #undef START
  #undef RESC
  #undef ROT
}

template<int THRL> __device__ __forceinline__ void attn_unit_dv(int b,int qb,int cq,int cv,int co,const bf16*Q,const bf16*__restrict__ K,const bf16*__restrict__ V,bf16*O,const float*tabsrc,char*shm){
  int tid_=threadIdx.x; asm volatile("":"+v"(tid_));
  constexpr int MODE=0, tb=0; const int tid=tid_,lane=tid&63,r32=lane&31,hi=lane>>5; const int wid=__builtin_amdgcn_readfirstlane(tid>>6);
  constexpr int LDS_K=0, LDS_V=NSLOT*SLOTB, LDS_WS=LDS_V+NSLOT*2*SLOTB, LDS_OST=LDS_WS+NW*64*4, LDS_TAB=LDS_OST+NW*4096;
  static_assert(LDS_TAB+RT_SIZE*4<=131072,"dv LDS map");
  const long rowbase=(long)b*SEQ, rowbase_k=(long)b*KROWS; const int q0=qb*QB;
  const bf16*Qw=Q+(rowbase+q0+wid*QBLK)*DM+cq;
  const bf16*Kh=K+rowbase_k*DM+cq,*Vh=V+rowbase_k*DM+cv;
  const unsigned lds0=(unsigned)(uintptr_t)shm;
  const __attribute__((address_space(3))) char* shm3_=(const __attribute__((address_space(3))) char*)shm;
  float*wsf=(float*)(shm+LDS_WS)+wid*64;
  const bf16*ksrc=Kh+(long)(lane+64*tb)*DM+wid*8;
  const bf16*vsrc=Vh+(long)(16*(wid&3)+(lane>>2)+64*tb)*DM+(wid>>2)*32+(lane&3)*8;
  const unsigned kdst=lds0+LDS_K+wid*1024, vdst=lds0+LDS_V+wid*1024;
  #define DMA_K(t,slot) glds16(ksrc+(long)(t)*KVBLK*DM,(unsigned)__builtin_amdgcn_readfirstlane(kdst+(slot)))
  #define DMA_V(t,slot) do{ glds16(vsrc+(long)(t)*KVBLK*DM,(unsigned)__builtin_amdgcn_readfirstlane(vdst+2*(slot))); glds16(vsrc+(long)(t)*KVBLK*DM+64,(unsigned)__builtin_amdgcn_readfirstlane(vdst+2*(slot)+8192)); }while(0)
  const int vb0=(int)(lds0+LDS_V)+((lane>>4)&1)*32+(lane&3)*8+(4*hi+((lane&15)>>2))*64;
  const char*Kbase=shm+LDS_K; bf16x8 kf[8];
  const lds_cptr shm3=(lds_cptr)shm; const lds_cptr kp0=shm3+LDS_K+hi*1024+r32*16; const lds_cptr vp0=shm3+LDS_V+((lane>>4)&1)*32+(lane&3)*8+(4*hi+((lane&15)>>2))*64;
  const int NT=(KPRE+q0+QB+KVBLK)/KVBLK-tb;
  const __attribute__((address_space(3))) float* tab=(const __attribute__((address_space(3))) float*)(shm3_+LDS_TAB);
  { __attribute__((address_space(3))) float* tw=(__attribute__((address_space(3))) float*)(shm3_+LDS_TAB);
    if(MODE==0){ for(int i=tid;i<RT_SIZE;i+=512){ const int d=i-RT_OFFS; tw[i]=d<0?-INFINITY:(d<128?tabsrc[d]:0.f); } }
    else { const int n=KPRE+q0+QB+KVBLK; for(int i=64*tb+tid*4;i<n;i+=2048){ const float4 v=*(const float4*)(tabsrc+i); tw[i]=v.x;tw[i+1]=v.y;tw[i+2]=v.z;tw[i+3]=v.w; } } }
  if(tb==0){ glds16(K+cq+(long)lane*DM+wid*8,(unsigned)__builtin_amdgcn_readfirstlane(kdst)); glds16(V+cv+(long)(16*(wid&3)+(lane>>2))*DM+(wid>>2)*32+(lane&3)*8,(unsigned)__builtin_amdgcn_readfirstlane(vdst)); glds16(V+cv+(long)(16*(wid&3)+(lane>>2))*DM+(wid>>2)*32+(lane&3)*8+64,(unsigned)__builtin_amdgcn_readfirstlane(vdst+8192)); } else { DMA_K(0,0); DMA_V(0,0); } DMA_K(1,SLOTB);
  bf16x8 qr[4];
  #pragma unroll
  for(int d0=0;d0<4;++d0)qr[d0]=*reinterpret_cast<const bf16x8*>(&Qw[(long)r32*DM+d0*16+hi*8]);
  float mhat=0.f,l_reg=0.f;f32x16 o[4];o[0]=f32x16{};o[1]=f32x16{};o[2]=f32x16{};o[3]=f32x16{};const f32x16 zero16=f32x16{};
  const int qrel=wid*QBLK+r32, q_abs=q0+qrel;
  #define MODT(P0,P1,t,SL) do{ if(SL)modtile_slow<MODE>(P0,P1,(t)+tb,q_abs,q0,hi,tab); else if(MODE==1)modtile_fast1(P0,P1,(t)+tb,hi,tab); }while(0)
  bool resc=false;
  #define START(P0,P1) do{ const float rm=rowmax(P0,P1); resc=false; mhat=rm; \
    _Pragma("unroll") for(int r=0;r<16;++r)P0[r]=__builtin_amdgcn_exp2f(P0[r]-mhat); }while(0)
  #define RESC() do{ if(resc){ asm volatile("s_waitcnt lgkmcnt(0)":::"memory"); \
      _Pragma("unroll") for(int d_=0;d_<4;++d_) _Pragma("unroll") for(int r=0;r<16;++r)o[d_][r]*=wsf[crow(r,hi)]; } }while(0)
  f32x16 pA0,pA1,pB0,pB1;
  int sl_prev=0,sl_cur=0,sl_next=SLOTB;
  #define ROT() do{sl_prev=sl_cur;sl_cur=sl_next;sl_next=(sl_next==(NSLOT-1)*SLOTB)?0:sl_next+SLOTB;}while(0)
  DMA_K(2,2*SLOTB);
  WAIT_BAR(3);
  qkt(pA0,pA1,Kbase,qr,zero16,r32,hi);asm volatile("s_nop 15\n\ts_nop 7":"+v"(pA0),"+v"(pA1));MODT(pA0,pA1,0,true);
  START(pA0,pA1);
  _Pragma("unroll") for(int r=0;r<16;++r)pA1[r]=__builtin_amdgcn_exp2f(pA1[r]-mhat);
  WAIT_BAR(0);
  DMA_K(3,0);DMA_V(1,SLOTB);
  ROT();
  kload8(kf,kp0+sl_cur);
  WAIT_BAR(3);
  s16x4 vlo[8],vhi[8],wlo[8],whi[8]; u32x4 pw0,pw1,pw2,pw3;
  #define PKW(P,B) cvtpk_s(P[B],P[B+1])
  #define PAF(k) __builtin_bit_cast(bf16x8,pw##k)
  #define VFR(i) (bf16x8){vlo[i][0],vlo[i][1],vlo[i][2],vlo[i][3],vhi[i][0],vhi[i][1],vhi[i][2],vhi[i][3]}
  #define WFR(i) (bf16x8){wlo[i][0],wlo[i][1],wlo[i][2],wlo[i][3],whi[i][0],whi[i][1],whi[i][2],whi[i][3]}
  #define WRD(i) do{ wlo[i]=vtr(vp_+((2+((i)>>2))*4096+((i)&3)*1024)); whi[i]=vtr(vp_+((2+((i)>>2))*4096+((i)&3)*1024+512)); SBAR(); }while(0)
  #define GAPB2(MF,X,B) do{ MF; X[B]=EX(X[B]-mhat); X[B+1]=EX(X[B+1]-mhat); PIN(X); SBAR(); }while(0)
  #define PIN(x) asm volatile("":"+v"(x))
  #define MX3(a,b,c) __builtin_fmaxf(__builtin_fmaxf((a),(b)),(c))
  #define GAPA(MF,A0,A1,A2,A3,W0,W1,PW) do{ MF; sacc+=A0; sacc+=A1; sacc+=A2; sacc+=A3; PIN(sacc); W0; W1; PIN(PW); SBAR(); }while(0)
  #define EX(v) __builtin_amdgcn_exp2f(v)
  #define GAPB(MF,X,B) do{ MF; X[B]=EX(X[B]); X[B+1]=EX(X[B+1]); X[B+2]=EX(X[B+2]); X[B+3]=EX(X[B+3]); PIN(X); SBAR(); }while(0)
  #define VRD(i) do{ vlo[i]=vtr(vp_+(((i)>>2)*4096+((i)&3)*1024)); vhi[i]=vtr(vp_+(((i)>>2)*4096+((i)&3)*1024+512)); }while(0)
  #define KRD(G,j) do{ if(G){ kload2(kf,kp0+sl_next,j); SBAR(); } }while(0)
  #define STEP(C0,C1,P0,P1,t,GK,GV,GL,SL) do{ SBAR(); \
    const lds_cptr vp_=vp0+2*sl_prev; \
    VRD(0); SBAR(); float sacc=(P0[0]+P0[1]); \
    GAPA(C0=__builtin_amdgcn_mfma_f32_32x32x16_bf16(kf[0],qr[0],zero16,0,0,0), P0[2],P0[3],P0[4],P0[5],     pw0[0]=PKW(P0,0), pw0[1]=PKW(P0,2), pw0); \
    VRD(4); SBAR(); GAPA(C1=__builtin_amdgcn_mfma_f32_32x32x16_bf16(kf[1],qr[0],zero16,0,0,0), P0[6],P0[7],P0[8],P0[9],     pw0[2]=PKW(P0,4), pw0[3]=PKW(P0,6), pw0); \
    VRD(1); SBAR(); GAPA(C0=__builtin_amdgcn_mfma_f32_32x32x16_bf16(kf[2],qr[1],C0,0,0,0),   P0[10],P0[11],P0[12],P0[13], pw1[0]=PKW(P0,8), pw1[1]=PKW(P0,10), pw1); \
    VRD(5); SBAR(); GAPA(C1=__builtin_amdgcn_mfma_f32_32x32x16_bf16(kf[3],qr[1],C1,0,0,0),   P0[14],P0[15],P1[0],P1[1],   pw1[2]=PKW(P0,12),pw1[3]=PKW(P0,14), pw1); \
    VRD(2); SBAR(); GAPA(C0=__builtin_amdgcn_mfma_f32_32x32x16_bf16(kf[4],qr[2],C0,0,0,0),   P1[2],P1[3],P1[4],P1[5],     pw2[0]=PKW(P1,0), pw2[1]=PKW(P1,2), pw2); \
    VRD(6); SBAR(); GAPA(C1=__builtin_amdgcn_mfma_f32_32x32x16_bf16(kf[5],qr[2],C1,0,0,0),   P1[6],P1[7],P1[8],P1[9],     pw2[2]=PKW(P1,4), pw2[3]=PKW(P1,6), pw2); \
    VRD(3); SBAR(); GAPA(C0=__builtin_amdgcn_mfma_f32_32x32x16_bf16(kf[6],qr[3],C0,0,0,0),   P1[10],P1[11],P1[12],P1[13], pw3[0]=PKW(P1,8), pw3[1]=PKW(P1,10), pw3); \
    VRD(7); SBAR(); GAPA(C1=__builtin_amdgcn_mfma_f32_32x32x16_bf16(kf[7],qr[3],C1,0,0,0),   P1[14],P1[15],0.f,0.f,       pw3[2]=PKW(P1,12),pw3[3]=PKW(P1,14), pw3); \
    l_reg+=sacc; \
    if(GK){DMA_K((t)+3,sl_cur);} if(GV){DMA_V((t)+1,sl_next);} \
    MODT(C0,C1,t,SL); \
    { float a=MX3(C0[0],C0[1],C1[0]),b=MX3(C0[2],C0[3],C1[1]); a=MX3(a,C1[2],C1[3]); \
      _Pragma("unroll") for(int r=4;r<16;r+=4){a=MX3(a,C0[r],C0[r+1]);b=MX3(b,C0[r+2],C0[r+3]);a=MX3(a,C1[r],C1[r+1]);b=MX3(b,C1[r+2],C1[r+3]);} \
      float rm=__builtin_fmaxf(a,b); { auto rr=__builtin_amdgcn_permlane32_swap(__float_as_uint(rm),__float_as_uint(rm),false,false); rm=__builtin_fmaxf(__uint_as_float(rr[0]),__uint_as_float(rr[1])); } \
      resc=false; \
      const float rmd=rm-mhat; \
      if(__builtin_expect(__any(rmd>(float)THRL),0)){ const float dl=__builtin_fmaxf(rmd,0.f); mhat+=dl; \
        const float f=__builtin_amdgcn_exp2f(-dl); l_reg*=f; if(hi==0)wsf[r32]=f; resc=true; } } \
    SBAR(); \
    WRD(0); GAPB2(o[0]=__builtin_amdgcn_mfma_f32_32x32x16_bf16(PAF(0),VFR(0),o[0],0,0,0), C0,0); \
    WRD(4); GAPB2(o[1]=__builtin_amdgcn_mfma_f32_32x32x16_bf16(PAF(0),VFR(4),o[1],0,0,0), C0,2); \
    WRD(1); GAPB2(o[0]=__builtin_amdgcn_mfma_f32_32x32x16_bf16(PAF(1),VFR(1),o[0],0,0,0), C0,4); \
    WRD(5); GAPB2(o[1]=__builtin_amdgcn_mfma_f32_32x32x16_bf16(PAF(1),VFR(5),o[1],0,0,0), C0,6); \
    WRD(2); GAPB2(o[0]=__builtin_amdgcn_mfma_f32_32x32x16_bf16(PAF(2),VFR(2),o[0],0,0,0), C0,8); \
    WRD(6); GAPB2(o[1]=__builtin_amdgcn_mfma_f32_32x32x16_bf16(PAF(2),VFR(6),o[1],0,0,0), C0,10); \
    WRD(3); GAPB2(o[0]=__builtin_amdgcn_mfma_f32_32x32x16_bf16(PAF(3),VFR(3),o[0],0,0,0), C0,12); \
    WRD(7); GAPB2(o[1]=__builtin_amdgcn_mfma_f32_32x32x16_bf16(PAF(3),VFR(7),o[1],0,0,0), C0,14); \
    KRD(GL,0); GAPB2(o[2]=__builtin_amdgcn_mfma_f32_32x32x16_bf16(PAF(0),WFR(0),o[2],0,0,0), C1,0); \
    KRD(GL,1); GAPB2(o[3]=__builtin_amdgcn_mfma_f32_32x32x16_bf16(PAF(0),WFR(4),o[3],0,0,0), C1,2); \
    KRD(GL,2); GAPB2(o[2]=__builtin_amdgcn_mfma_f32_32x32x16_bf16(PAF(1),WFR(1),o[2],0,0,0), C1,4); \
    KRD(GL,3); GAPB2(o[3]=__builtin_amdgcn_mfma_f32_32x32x16_bf16(PAF(1),WFR(5),o[3],0,0,0), C1,6); \
    GAPB2(o[2]=__builtin_amdgcn_mfma_f32_32x32x16_bf16(PAF(2),WFR(2),o[2],0,0,0), C1,8); \
    GAPB2(o[3]=__builtin_amdgcn_mfma_f32_32x32x16_bf16(PAF(2),WFR(6),o[3],0,0,0), C1,10); \
    GAPB2(o[2]=__builtin_amdgcn_mfma_f32_32x32x16_bf16(PAF(3),WFR(3),o[2],0,0,0), C1,12); \
    GAPB2(o[3]=__builtin_amdgcn_mfma_f32_32x32x16_bf16(PAF(3),WFR(7),o[3],0,0,0), C1,14); \
    }while(0)
  int t=1;
  #define ENDW(tt) do{ if((tt)+3<NT){WAIT_BAR(3);} else if((tt)+2<NT){WAIT_BAR(2);} else {WAIT_BAR(0);} }while(0)
  for(;t+(MODE==1?5:7)<NT;t+=2){
    STEP(pB0,pB1,pA0,pA1,t,true,true,true,false);     WAIT_BAR(3); RESC(); ROT();
    STEP(pA0,pA1,pB0,pB1,t+1,true,true,true,false);   WAIT_BAR(3); RESC(); ROT();
  }
  for(;t+1<NT;t+=2){
    STEP(pB0,pB1,pA0,pA1,t,(t+3<NT),(t+1<NT),(t+1<NT),true);       ENDW(t);   RESC(); ROT();
    STEP(pA0,pA1,pB0,pB1,t+1,(t+4<NT),(t+2<NT),(t+2<NT),true);     ENDW(t+1); RESC(); ROT();
  }
  STEP(pB0,pB1,pA0,pA1,NT-1,false,false,false,true); RESC();
  { float sacc=pB0[0]+pB0[1]; _Pragma("unroll") for(int r=2;r<16;++r)sacc+=pB0[r]; _Pragma("unroll") for(int r=0;r<16;++r)sacc+=pB1[r]; l_reg+=sacc;
    pw0=(u32x4){PKW(pB0,0),PKW(pB0,2),PKW(pB0,4),PKW(pB0,6)};pw1=(u32x4){PKW(pB0,8),PKW(pB0,10),PKW(pB0,12),PKW(pB0,14)};pw2=(u32x4){PKW(pB1,0),PKW(pB1,2),PKW(pB1,4),PKW(pB1,6)};pw3=(u32x4){PKW(pB1,8),PKW(pB1,10),PKW(pB1,12),PKW(pB1,14)};
    SBAR(); pv(o,vb0+2*sl_cur,PAF(0),PAF(1),PAF(2),PAF(3)); pv(o+2,vb0+2*sl_cur+8192,PAF(0),PAF(1),PAF(2),PAF(3)); }
  #undef PKW
  #undef PAF
  #undef VFR
  #undef PIN
  #undef MX3
  #undef GAPA
  #undef GAPB
  #undef EX
  #undef VRD
  #undef WRD
  #undef WFR
  #undef GAPB2
  #undef KRD
  #undef STEP
  #undef ENDW
  {auto rr=__builtin_amdgcn_permlane32_swap(__float_as_uint(l_reg),__float_as_uint(l_reg),false,false);l_reg=__uint_as_float(rr[0])+__uint_as_float(rr[1]);}
  if(hi==0)wsf[32+r32]=l_reg;asm volatile("s_waitcnt lgkmcnt(0)":::"memory");
  float rli[16];
  #pragma unroll
  for(int r=0;r<16;++r)rli[r]=__builtin_amdgcn_rcpf(wsf[32+crow(r,hi)]);
  bf16*Ow=O+(rowbase+q0+wid*QBLK)*DM+co;
  { bf16*stg=(bf16*)(shm+LDS_OST)+wid*2048;
    #pragma unroll
    for(int ps=0;ps<2;++ps){
      #pragma unroll
      for(int r=0;r<16;++r){const int orow=crow(r,hi);
        #pragma unroll
        for(int d0=0;d0<2;++d0)stg[orow*64+d0*32+r32]=__float2bfloat16(o[2*ps+d0][r]*rli[r]);}
      asm volatile("s_waitcnt lgkmcnt(0)":::"memory");
      #pragma unroll
      for(int i=0;i<4;++i){const int row=i*8+(lane>>3),ch=lane&7; const u32x4 v=*(const u32x4*)(stg+row*64+ch*8); ATTN_STORE16(Ow+(long)row*DM+ps*64+ch*8,v);}
      asm volatile("s_waitcnt lgkmcnt(0)":::"memory"); } }
  asm volatile("s_waitcnt lgkmcnt(0)\n\ts_barrier":::"memory");
  #undef DMA_K
  #undef DMA_V
  #undef MODT
  #undef START
  #undef RESC
  #undef ROT
}
constexpr int ATTN_LDS_BYTES=LDS_BYTES;
#undef SBAR
#undef WAIT_BAR
}
#define GAS __attribute__((address_space(1)))
#define LAS __attribute__((address_space(3)))
typedef unsigned short bf16;
typedef unsigned v4u __attribute__((ext_vector_type(4)));
typedef float f32x4 __attribute__((ext_vector_type(4)));
typedef short bf16x8 __attribute__((ext_vector_type(8)));
typedef GAS unsigned gu32;
typedef GAS unsigned long long gu64;
#define RLX_AGENT __ATOMIC_RELAXED, __HIP_MEMORY_SCOPE_AGENT
#define LDS_WAIT() asm volatile("s_waitcnt lgkmcnt(0)" ::: "memory")
#define VM_WAIT() asm volatile("s_waitcnt vmcnt(0)" ::: "memory")
__device__ __forceinline__ unsigned long long rt() { return __builtin_amdgcn_s_memrealtime(); }
__device__ __forceinline__ unsigned f2bf(float f) { unsigned u = __builtin_bit_cast(unsigned, f); return (u + 0x7fffu + ((u >> 16) & 1u)) >> 16; }
__device__ __forceinline__ unsigned pk2(float lo, float hi) { return f2bf(lo) | (f2bf(hi) << 16); }

#define XB_TMO      128
#define XB_XCNT(j)  (256  + 64 * (j))
#define XB_XSUB(j)  (1280 + 64 * (j))
#define XB_XGEN(j)  (2304 + 64 * (j))
#define XB_TOP      3328
#define XB_TOPGEN   3392
#define XCD_BAR_WORDS 3456
#define XB_SPIN_CAP (1u << 18)

__device__ __forceinline__ unsigned xb_ld(unsigned* p)              { return __hip_atomic_load(p, __ATOMIC_RELAXED, __HIP_MEMORY_SCOPE_AGENT); }
__device__ __forceinline__ unsigned xb_add(unsigned* p, unsigned v) { return __hip_atomic_fetch_add(p, v, __ATOMIC_RELAXED, __HIP_MEMORY_SCOPE_AGENT); }
__device__ __forceinline__ unsigned xb_xcc_id() { return (unsigned)__builtin_amdgcn_s_getreg((3 << 11) | 20) & 0xFu; }
#define XB_SPIN(cond, bar) do { unsigned _sp = 0; while (cond) { __builtin_amdgcn_s_sleep(1); \
    if ((++_sp & 255u) == 0u) { if (xb_ld(&(bar)[XB_TMO])) break; if (_sp > XB_SPIN_CAP) { atomicAdd(&(bar)[XB_TMO], 1u); break; } } } } while (0)

struct XcdBarrier {
    unsigned* bar; unsigned x;
    volatile LAS unsigned* st;
};

__device__ __forceinline__ XcdBarrier xcd_barrier_post(unsigned* bar, volatile LAS unsigned* st) {
    XcdBarrier b; b.bar = bar; b.x = xb_xcc_id(); b.st = st;
    if (threadIdx.x == 0) (void)xb_add(&bar[XB_XCNT(b.x)], 1u);
    return b;
}
__device__ __forceinline__ void xcd_barrier_complete(unsigned* bar, unsigned x, unsigned& nloc, unsigned& nx) {
    const unsigned G = gridDim.x * gridDim.y * gridDim.z;
    unsigned sum, cnt, mine, sp = 0u;
    for (;;) {
        sum = 0u; cnt = 0u; mine = 0u;
#pragma unroll
        for (unsigned j = 0; j < 16; ++j) { const unsigned c = xb_ld(&bar[XB_XCNT(j)]); sum += c; cnt += (c > 0u) ? 1u : 0u; mine = (j == x) ? c : mine; }
        if (sum == G) break;
        __builtin_amdgcn_s_sleep(1);
        if ((++sp & 255u) == 0u) { if (xb_ld(&bar[XB_TMO])) break; if (sp > XB_SPIN_CAP) { atomicAdd(&bar[XB_TMO], 1u); break; } }
    }
    nloc = mine > 0u ? mine : 1u; nx = cnt > 0u ? cnt : 1u;
}

__device__ __forceinline__ void xcd_barrier(const XcdBarrier& b) {
    asm volatile("s_waitcnt vmcnt(0)" ::: "memory");
    __syncthreads();
    if (threadIdx.x == 0) {
        unsigned* bar = b.bar;
        __builtin_amdgcn_s_waitcnt(0);
        unsigned nloc = b.st[0], nx = b.st[1];
        if (nloc == 0u) { xcd_barrier_complete(bar, b.x, nloc, nx); b.st[0] = nloc; b.st[1] = nx; }
        const unsigned old = xb_add(&bar[XB_XSUB(b.x)], 1u);
        const unsigned gen = old / nloc;
        if (old + 1u == (gen + 1u) * nloc) {
            __builtin_amdgcn_fence(__ATOMIC_RELEASE, "agent");
            asm volatile("s_waitcnt vmcnt(0)" ::: "memory");
            const unsigned og = xb_add(&bar[XB_TOP], 1u);
            const unsigned tg = og / nx;
            if (og + 1u == (tg + 1u) * nx) xb_add(&bar[XB_TOPGEN], 1u);
            else XB_SPIN(xb_ld(&bar[XB_TOPGEN]) == tg, bar);
            __builtin_amdgcn_fence(__ATOMIC_ACQUIRE, "agent");
            xb_add(&bar[XB_XGEN(b.x)], 1u);
            asm volatile("s_waitcnt vmcnt(0)" ::: "memory");
        } else {
            XB_SPIN(xb_ld(&bar[XB_XGEN(b.x)]) == gen, bar);
            __builtin_amdgcn_fence(__ATOMIC_ACQUIRE, "agent");
            asm volatile("s_waitcnt vmcnt(0)" ::: "memory");
        }
    }
    __syncthreads();
}

constexpr int NWAVES = 8;
#ifndef MK_PER_PHASE
#define MK_PER_PHASE 0
#endif
constexpr int N_PHASES = 16;

constexpr size_t MiB = 1u << 20;
constexpr size_t WS_CTL = 0, CTL_ZERO_BYTES = 1 * MiB;
constexpr size_t WS_GV = 1 * MiB + 512 * 1024;
constexpr size_t WS_HM = 2 * MiB;
constexpr size_t WS_TAB = 2 * MiB + 256 * 1024;
constexpr size_t WS_LF = 3 * MiB;
constexpr size_t WS_DK = 6 * MiB;
constexpr size_t WS_LIST = 9 * MiB;
constexpr int LCAP = NSLOT;
constexpr size_t WS_WQKV0 = 18 * MiB, WS_WO0 = 24 * MiB, WS_WQKV1 = 26 * MiB, WS_WO1 = 32 * MiB, WS_WGU = 34 * MiB, WS_WD = 98 * MiB;
constexpr size_t WS_XH = 130 * MiB;
constexpr size_t WS_Q = 195 * MiB;
constexpr size_t WS_K = 260 * MiB, WS_V = 325 * MiB;
constexpr size_t WS_O0 = 390 * MiB;
constexpr size_t WS_END = 455 * MiB;
static_assert(WS_LIST + (size_t)NEXP * LCAP * 4 <= WS_WQKV0 && WS_DK + (size_t)NBATCH * 16 * KROWS * 4 <= WS_LIST && WS_LF + (size_t)NRP * 16 * 4 <= WS_DK, "small arrays");
static_assert(WS_XH + (size_t)NRP * DM * 2 <= WS_Q && WS_Q + (size_t)NRP * DM * 2 <= WS_K && WS_K + (size_t)NBATCH * KROWS * DM * 2 <= WS_V && WS_V + (size_t)NBATCH * KROWS * DM * 2 <= WS_O0 && WS_O0 + (size_t)NRP * DM * 2 <= WS_END, "activations");
static_assert(WS_K + (size_t)NSLOT * DM * 2 <= WS_O0 && WS_O0 + (size_t)NSLOT * DEXP * 2 <= WS_END, "MoE overlays");
constexpr int CW_TMO = 0, CW_CODE = 1;
constexpr int CW_BAR = 4096;
constexpr int CW_QM = 131072, CW_KM = 147456, CW_QCTR = 148480;
constexpr int CW_CNT = 65536;
constexpr int RING_OFF = 0, RING_BYTES = 131072;
constexpr int ROWTAB_OFF = RING_BYTES, ROWTAB_UNITS = 12;
constexpr int MOEPRE_OFF = ROWTAB_OFF + ROWTAB_UNITS * 1024;
constexpr int MISC_OFF = MOEPRE_OFF + 512;
constexpr int LDS_BYTES = 147456;
static_assert(MISC_OFF + 128 <= LDS_BYTES && attn_body::ATTN_LDS_BYTES <= RING_BYTES, "LDS map");

struct Params {
    const float *x, *meta, *rel_bias, *w_qkv, *lam, *subln, *w_o, *fox_w_in, *fox_b_f, *fox_w_o, *ln_mix_g, *ln_mix_b, *ln_ffn_g, *ln_ffn_b, *rg_w, *rg_b, *re_w, *re_b, *w_gate, *w_up, *w_down;
    float* out; unsigned char* ws; int ph_lo, ph_hi, li, pad;
};
struct Ctx { int tid, lane, wave, vcu, G; LAS unsigned char* lds; };
__device__ __forceinline__ Ctx fresh(const Ctx& C) { Ctx r = C; int t = threadIdx.x; asm volatile("" : "+v"(t)); r.tid = t; r.lane = t & 63; r.wave = __builtin_amdgcn_readfirstlane(t >> 6); return r; }

using pg8::shx;
__device__ __forceinline__ float wave_sum(float v, int lane) {
#pragma unroll
    for (int o = 1; o < 64; o <<= 1) v += shx(v, o, lane);
    return v;
}
__device__ __forceinline__ float bf2f(unsigned short h) { return __uint_as_float((unsigned)h << 16); }
__device__ __forceinline__ float bflo(unsigned w) { return __uint_as_float(w << 16); }
__device__ __forceinline__ float bfhi(unsigned w) { return __uint_as_float(w & 0xffff0000u); }
__device__ __forceinline__ int meta_slot(int j) { return j; }

__device__ __forceinline__ void tr_item(const float* W, int ldw, int k0, int n0, bf16* WT, int ldt, int drow0, LAS float* scr, int lane) {
#pragma unroll 8
    for (int i = 0; i < 32; ++i) { const int kk = 2 * i + (lane >> 5); scr[kk * 33 + (lane & 31)] = W[(size_t)(k0 + kk) * ldw + n0 + (lane & 31)]; }
    LDS_WAIT(); asm volatile("" ::: "memory");
    const int c = lane & 7;
#pragma unroll
    for (int j = 0; j < 4; ++j) { const int n = (lane >> 3) + 8 * j; const LAS float* s = scr + (8 * c) * 33 + n;
        v4u o; o.x = pk2(s[0 * 33], s[1 * 33]); o.y = pk2(s[2 * 33], s[3 * 33]); o.z = pk2(s[4 * 33], s[5 * 33]); o.w = pk2(s[6 * 33], s[7 * 33]);
        *(GAS v4u*)(WT + (size_t)(drow0 + n) * ldt + k0 + 8 * c) = o; }
    LDS_WAIT(); asm volatile("" ::: "memory");
}
__device__ __forceinline__ void convert_experts(const Params& p, const Ctx& C, int layer, int first_item, int gw, int NGW) {
    LAS float* scr = (LAS float*)(C.lds + RING_OFF + C.wave * 16384);
    bf16* Wgu = (bf16*)(p.ws + WS_WGU); bf16* Wd = (bf16*)(p.ws + WS_WD);
    constexpr int PER_E = 768, NIT = NEXP * PER_E;
    for (int it = gw - first_item; it < NIT; it += NGW) { if (it < 0) continue;
        const int e = it / PER_E; int r = it % PER_E; const size_t eo = (size_t)(layer * NEXP + e);
        if (r < 512) { const bool up = r >= 256; r &= 255; const int kb = r >> 4, nb = r & 15, n0 = 32 * nb;
            tr_item((up ? p.w_up : p.w_gate) + eo * DM * DEXP, DEXP, 64 * kb, n0, Wgu + (size_t)e * DM * DM, DM, (n0 >> 7) * 256 + (n0 & 127) + (up ? 128 : 0), scr, C.lane); }
        else { r -= 512; const int kb = r >> 5, nb = r & 31;
            tr_item(p.w_down + eo * DEXP * DM, DM, 64 * kb, 32 * nb, Wd + (size_t)e * DM * DEXP, DEXP, 32 * nb, scr, C.lane); } }
}
__device__ __forceinline__ void p0_prologue(const Params& p, const Ctx& C) {
    LAS float* scr = (LAS float*)(C.lds + RING_OFF + C.wave * 16384);
    const int gw = C.vcu * NWAVES + C.wave, NGW = C.G * NWAVES;
    for (int it = gw; it < 4096; it += NGW) { int r = it;
        if (r < 1536) { tr_item(p.w_qkv, 3072, 64 * (r / 96), 32 * (r % 96), (bf16*)(p.ws + WS_WQKV0), DM, 32 * (r % 96), scr, C.lane); continue; } r -= 1536;
        if (r < 512) { tr_item(p.w_o, DM, 64 * (r >> 5), 32 * (r & 31), (bf16*)(p.ws + WS_WO0), DM, 32 * (r & 31), scr, C.lane); continue; } r -= 512;
        if (r < 1536) { tr_item(p.fox_w_in, 3088, 64 * (r / 96), 32 * (r % 96), (bf16*)(p.ws + WS_WQKV1), DM, 32 * (r % 96), scr, C.lane); continue; } r -= 1536;
        tr_item(p.fox_w_o, DM, 64 * (r >> 5), 32 * (r & 31), (bf16*)(p.ws + WS_WO1), DM, 32 * (r & 31), scr, C.lane); }
    convert_experts(p, C, 0, 0, gw, NGW);
    bf16* XH = (bf16*)(p.ws + WS_XH);
    for (int m = gw; m < NRP; m += NGW) {
        GAS unsigned long long* o8 = (GAS unsigned long long*)(XH + (size_t)m * DM) + C.lane;
        if (m < NR) { const GAS f32x4* xr = (const GAS f32x4*)(m < NREAL ? p.x + (size_t)m * DM : p.meta + (size_t)(m - NREAL) * DM) + C.lane;
#pragma unroll
            for (int j = 0; j < 4; ++j) { const f32x4 v = xr[64 * j]; o8[64 * j] = (unsigned long long)pk2(v.x, v.y) | ((unsigned long long)pk2(v.z, v.w) << 32); } }
        else {
#pragma unroll
            for (int j = 0; j < 4; ++j) o8[64 * j] = 0ull; } }
    { const int gt = C.vcu * (NWAVES * 64) + C.tid;
      if (gt < 16 * 128) { const int m = gt >> 7, d = gt & 127; int bk = d;
          if (d >= 16) { bk = 16 + (d >= 19) + (d >= 21) + (d >= 24) + (d >= 27) + (d >= 31) + (d >= 35) + (d >= 40) + (d >= 46) + (d >= 52) + (d >= 59) + (d >= 67) + (d >= 77) + (d >= 87) + (d >= 99) + (d >= 113); }
          ((float*)(p.ws + WS_TAB))[gt] = (p.rel_bias[bk * 16 + m] - p.rel_bias[31 * 16 + m]) * LOG2E; } }
}

__device__ __forceinline__ float diff_lambda_full(const Params& p, int lane) {
    const float a = p.lam[lane] * p.lam[64 + lane], b = p.lam[128 + lane] * p.lam[192 + lane];
    return __expf(wave_sum(a, lane)) - __expf(wave_sum(b, lane)) + LAMBDA_INIT0;
}
__device__ __forceinline__ void combine_phase(const Params& p, const Ctx& C) {
    const int gw = C.vcu * NWAVES + C.wave, NGW = C.G * NWAVES, lane = C.lane;
    const float lam = diff_lambda_full(p, lane);
    const bf16* O0 = (const bf16*)(p.ws + WS_O0); const bf16* O1 = (const bf16*)p.out; bf16* OA = (bf16*)(p.ws + WS_Q);
    float sw[8];
#pragma unroll
    for (int c = 0; c < 8; ++c) sw[c] = p.subln[((8 * lane) & 127) + c] * (1.f - LAMBDA_INIT0);
    for (int r = gw; r < NREAL; r += NGW) {
#pragma unroll
        for (int j = 0; j < 2; ++j) { const size_t off = (size_t)r * DM + 8 * lane + 512 * j;
            const v4u a = *(const GAS v4u*)(O0 + off), b = *(const GAS v4u*)(O1 + off);
            float d[8]; const unsigned aw[4] = {a.x, a.y, a.z, a.w}, bw[4] = {b.x, b.y, b.z, b.w}; float ss = 0.f;
#pragma unroll
            for (int c = 0; c < 4; ++c) { d[2 * c] = bflo(aw[c]) - lam * bflo(bw[c]); d[2 * c + 1] = bfhi(aw[c]) - lam * bfhi(bw[c]); ss += d[2 * c] * d[2 * c] + d[2 * c + 1] * d[2 * c + 1]; }
            ss += shx(ss, 1, lane); ss += shx(ss, 2, lane); ss += shx(ss, 4, lane); ss += shx(ss, 8, lane);
            const float rs = 1.f / sqrtf(ss * (1.f / 128.f) + LN_EPS);
            v4u o; o.x = pk2(d[0] * rs * sw[0], d[1] * rs * sw[1]); o.y = pk2(d[2] * rs * sw[2], d[3] * rs * sw[3]); o.z = pk2(d[4] * rs * sw[4], d[5] * rs * sw[5]); o.w = pk2(d[6] * rs * sw[6], d[7] * rs * sw[7]);
            *(GAS v4u*)(OA + off) = o; } }
    if (gw < 128) { const int h = gw >> 4, j = gw & 15, kj = lane & 15, s = (lane >> 4) & 1, m = 2 * h + s;
        const bf16* Q = (const bf16*)(p.ws + WS_Q); const bf16* K = (const bf16*)(p.ws + WS_K); const bf16* V = (const bf16*)(p.ws + WS_V);
        const bf16* qp = Q + (size_t)(NREAL + j) * DM + m * 64; const bf16* kp = K + (size_t)meta_slot(kj) * DM + m * 64;
        float dot = 0.f;
#pragma unroll
        for (int c = 0; c < 8; ++c) { const v4u qa = *(const GAS v4u*)(qp + 8 * c), ka = *(const GAS v4u*)(kp + 8 * c); const unsigned qw[4] = {qa.x, qa.y, qa.z, qa.w}, kw[4] = {ka.x, ka.y, ka.z, ka.w};
#pragma unroll
            for (int e = 0; e < 4; ++e) dot += bflo(qw[e]) * bflo(kw[e]) + bfhi(qw[e]) * bfhi(kw[e]); }
        float sc = (kj <= j) ? dot + p.rel_bias[(j - kj) * 16 + m] * LOG2E : -INFINITY;
        float mx = sc; mx = fmaxf(mx, shx(mx, 1, lane)); mx = fmaxf(mx, shx(mx, 2, lane)); mx = fmaxf(mx, shx(mx, 4, lane)); mx = fmaxf(mx, shx(mx, 8, lane));
        float pe = __builtin_amdgcn_exp2f(sc - mx); float l = pe; l += shx(l, 1, lane); l += shx(l, 2, lane); l += shx(l, 4, lane); l += shx(l, 8, lane);
        pe /= l;
        const float a = pe - lam * shx(pe, 16, lane);
        float o0 = 0.f, o1 = 0.f;
        for (int k2 = 0; k2 <= j; ++k2) { const float ak = __builtin_amdgcn_readlane(a, k2); const unsigned vw = *(const GAS unsigned*)(V + (size_t)meta_slot(k2) * DM + h * 128 + 2 * lane); o0 += ak * bflo(vw); o1 += ak * bfhi(vw); }
        const float ss = wave_sum(o0 * o0 + o1 * o1, lane); const float rs = 1.f / sqrtf(ss * (1.f / 128.f) + LN_EPS);
        const float w0 = p.subln[2 * lane] * (1.f - LAMBDA_INIT0), w1 = p.subln[2 * lane + 1] * (1.f - LAMBDA_INIT0);
        *(GAS unsigned*)(OA + (size_t)(NREAL + j) * DM + h * 128 + 2 * lane) = pk2(o0 * rs * w0, o1 * rs * w1); }
}
__device__ __forceinline__ void fox_meta_attn(const Params& p, const Ctx& C) {
    const int gw = C.vcu * NWAVES + C.wave, lane = C.lane;
    if (gw < 256) { const int h = gw >> 4, j = gw & 15, kj = lane & 15;
        bf16* Q = (bf16*)(p.ws + WS_Q); const bf16* K = (const bf16*)(p.ws + WS_K); const bf16* V = (const bf16*)(p.ws + WS_V); const float* DK = (const float*)(p.ws + WS_DK) + (size_t)h * KROWS;
        const bf16* qp = Q + (size_t)(NREAL + j) * DM + h * 64; const bf16* kp = K + (size_t)meta_slot(kj) * DM + h * 64;
        float dot = 0.f;
#pragma unroll
        for (int c = 0; c < 8; ++c) { const v4u qa = *(const GAS v4u*)(qp + 8 * c), ka = *(const GAS v4u*)(kp + 8 * c); const unsigned qw[4] = {qa.x, qa.y, qa.z, qa.w}, kw[4] = {ka.x, ka.y, ka.z, ka.w};
#pragma unroll
            for (int e = 0; e < 4; ++e) dot += bflo(qw[e]) * bflo(kw[e]) + bfhi(qw[e]) * bfhi(kw[e]); }
        float sc = (kj <= j) ? dot + DK[meta_slot(kj)] - DK[meta_slot(j)] : -INFINITY;
        float mx = sc; mx = fmaxf(mx, shx(mx, 1, lane)); mx = fmaxf(mx, shx(mx, 2, lane)); mx = fmaxf(mx, shx(mx, 4, lane)); mx = fmaxf(mx, shx(mx, 8, lane));
        float pe = __builtin_amdgcn_exp2f(sc - mx); float l = pe; l += shx(l, 1, lane); l += shx(l, 2, lane); l += shx(l, 4, lane); l += shx(l, 8, lane);
        pe /= l;
        float o = 0.f;
        for (int k2 = 0; k2 <= j; ++k2) { const float ak = __builtin_amdgcn_readlane(pe, k2); o += ak * bf2f(V[(size_t)meta_slot(k2) * DM + h * 64 + lane]); }
        ((bf16*)(p.ws + WS_O0))[(size_t)(NREAL + j) * DM + h * 64 + lane] = (bf16)f2bf(o); }
}

typedef float f32x4m __attribute__((ext_vector_type(4)));
template <int KIND> __device__ __forceinline__ void ln_phase(const Params& p, const Ctx& C, int layer) {
    constexpr int NCB = (KIND == 0) ? 3 : (KIND == 1 ? 1 : 0), NC = 16 * (NCB ? NCB : 1);
    constexpr int AT_PITCH = 1028;
    const int tid = C.tid, lane = C.lane, wave = C.wave;
    LAS float* At = (LAS float*)(C.lds + RING_OFF);
    LAS float* part = (LAS float*)(C.lds + RING_OFF + 65792);
    LAS float* logit = (LAS float*)(C.lds + RING_OFF + 90368);
    LAS int* sl_e = (LAS int*)(C.lds + RING_OFF + 93440);
    LAS int* cnt_l = (LAS int*)(C.lds + RING_OFF + 94720);
    const float* gsrc = (KIND == 0 ? p.ln_mix_g : p.ln_ffn_g) + layer * DM; const float* bsrc = (KIND == 0 ? p.ln_mix_b : p.ln_ffn_b) + layer * DM;
    f32x4 gv[4], bv[4];
#pragma unroll
    for (int j = 0; j < 4; ++j) { gv[j] = *(const GAS f32x4*)(gsrc + 4 * lane + 256 * j); bv[j] = *(const GAS f32x4*)(bsrc + 4 * lane + 256 * j); }
    float Bf[NCB ? NCB : 1][8][4];
    if constexpr (NCB > 0) { const int kq = lane >> 4, col = lane & 15;
#pragma unroll
        for (int cb = 0; cb < NCB; ++cb)
#pragma unroll
            for (int g = 0; g < 8; ++g)
#pragma unroll
                for (int c = 0; c < 4; ++c) { const int k = 128 * wave + 16 * g + 4 * kq + c, cc = cb * 16 + col; float w;
                    if (KIND == 0) w = cc < 4 ? p.rg_w[((size_t)layer * DM + k) * 4 + cc] : (cc < 36 ? p.re_w[((size_t)layer * DM + k) * 32 + (cc - 4)] : 0.f);
                    else w = p.fox_w_in[(size_t)k * 3088 + 3072 + cc];
                    Bf[cb][g][c] = w; } }
    if (KIND == 0) { if (tid < 96) cnt_l[tid] = 0; }
    bf16* XH = (bf16*)(p.ws + WS_XH); const bf16* Y = (const bf16*)(p.ws + WS_K);
    constexpr int NTILES = NR / 16;
    int it = 0;
    for (int tile = C.vcu; tile < NTILES; tile += C.G, ++it) {
        unsigned long long vv[2][4]; unsigned long long yy[2][2][4];
#pragma unroll
        for (int rr = 0; rr < 2; ++rr) { const int row = tile * 16 + wave * 2 + rr;
#pragma unroll
            for (int j = 0; j < 4; ++j) vv[rr][j] = *((const GAS unsigned long long*)(XH + (size_t)row * DM) + lane + 64 * j);
            if (KIND != 0) {
#pragma unroll
                for (int j = 0; j < 4; ++j) { yy[rr][0][j] = *(const GAS unsigned long long*)(Y + (size_t)(2 * row) * DM + 4 * lane + 256 * j); yy[rr][1][j] = *(const GAS unsigned long long*)(Y + (size_t)(2 * row + 1) * DM + 4 * lane + 256 * j); } } }
#pragma unroll
        for (int rr = 0; rr < 2; ++rr) { const int rl = wave * 2 + rr, row = tile * 16 + rl;
            f32x4 v[4];
#pragma unroll
            for (int j = 0; j < 4; ++j) { const unsigned h0 = (unsigned)vv[rr][j], h1 = (unsigned)(vv[rr][j] >> 32); v[j] = (f32x4){bflo(h0), bfhi(h0), bflo(h1), bfhi(h1)}; }
            if (KIND != 0) {
#pragma unroll
                for (int j = 0; j < 4; ++j) { const unsigned long long y0 = yy[rr][0][j], y1 = yy[rr][1][j];
                    const unsigned a0 = (unsigned)y0, a1 = (unsigned)(y0 >> 32), b0 = (unsigned)y1, b1 = (unsigned)(y1 >> 32);
                    v[j].x = v[j].x * ALPHA + (bflo(a0) + bflo(b0)); v[j].y = v[j].y * ALPHA + (bfhi(a0) + bfhi(b0)); v[j].z = v[j].z * ALPHA + (bflo(a1) + bflo(b1)); v[j].w = v[j].w * ALPHA + (bfhi(a1) + bfhi(b1)); } }
            float s = 0.f;
#pragma unroll
            for (int j = 0; j < 4; ++j) s += (v[j].x + v[j].y) + (v[j].z + v[j].w);
            const float mean = wave_sum(s, lane) * (1.f / DM); float s2 = 0.f;
#pragma unroll
            for (int j = 0; j < 4; ++j) { v[j] = v[j] - mean; s2 += (v[j].x * v[j].x + v[j].y * v[j].y) + (v[j].z * v[j].z + v[j].w * v[j].w); }
            const float rstd = 1.f / sqrtf(wave_sum(s2, lane) * (1.f / DM) + LN_EPS);
#pragma unroll
            for (int j = 0; j < 4; ++j) v[j] = v[j] * rstd * gv[j] + bv[j];
            if (KIND == 2) { if (row < NREAL) {
#pragma unroll
                for (int j = 0; j < 4; ++j) *(GAS f32x4*)(p.out + (size_t)row * DM + 4 * lane + 256 * j) = v[j]; } }
            else {
#pragma unroll
                for (int j = 0; j < 4; ++j) {
                    *((GAS unsigned long long*)(XH + (size_t)row * DM) + lane + 64 * j) = (unsigned long long)pk2(v[j].x, v[j].y) | ((unsigned long long)pk2(v[j].z, v[j].w) << 32);
                    *(LAS f32x4*)(At + rl * AT_PITCH + 4 * lane + 256 * j) = v[j]; } } }
        if constexpr (NCB > 0) {
            __syncthreads();
            f32x4m acc[NCB];
#pragma unroll
            for (int cb = 0; cb < NCB; ++cb) acc[cb] = (f32x4m){0.f, 0.f, 0.f, 0.f};
#pragma unroll
            for (int g = 0; g < 8; ++g) { const f32x4 a4 = *(const LAS f32x4*)(At + (lane & 15) * AT_PITCH + 128 * wave + 16 * g + 4 * (lane >> 4));
#pragma unroll
                for (int c = 0; c < 4; ++c)
#pragma unroll
                    for (int cb = 0; cb < NCB; ++cb) acc[cb] = __builtin_amdgcn_mfma_f32_16x16x4f32(a4[c], Bf[cb][g][c], acc[cb], 0, 0, 0); }
#pragma unroll
            for (int cb = 0; cb < NCB; ++cb)
#pragma unroll
                for (int r = 0; r < 4; ++r) part[(wave * 16 + 4 * (lane >> 4) + r) * 48 + cb * 16 + (lane & 15)] = acc[cb][r];
            __syncthreads();
            for (int idx = tid; idx < 16 * NC; idx += NWAVES * 64) { const int rw = idx / NC, cl = idx % NC; float sacc = 0.f;
#pragma unroll
                for (int w = 0; w < 8; ++w) sacc += part[(w * 16 + rw) * 48 + cl];
                logit[rw * 48 + cl] = sacc; }
            __syncthreads();
            if (KIND == 0) { if (tid < 16) { const int row = tile * 16 + tid; const LAS float* lg = logit + tid * 48;
                float gl[4]; int gs = 0;
#pragma unroll
                for (int i = 0; i < 4; ++i) gl[i] = lg[i] + p.rg_b[layer * 4 + i];
#pragma unroll
                for (int i = 1; i < 4; ++i) if (gl[i] > gl[gs]) gs = i;
                float den = 0.f;
#pragma unroll
                for (int i = 0; i < 4; ++i) den += __expf(gl[i] - gl[gs]);
                const float pg = 1.f / den;
                float el[8];
#pragma unroll
                for (int i = 0; i < 8; ++i) el[i] = lg[4 + gs * 8 + i] + p.re_b[layer * 32 + gs * 8 + i];
                int i0 = 0;
#pragma unroll
                for (int i = 1; i < 8; ++i) if (el[i] > el[i0]) i0 = i;
                int i1 = (i0 == 0) ? 1 : 0;
#pragma unroll
                for (int i = 0; i < 8; ++i) if (i != i0 && el[i] > el[i1]) i1 = i;
                const float ex = __expf(el[i1] - el[i0]); const float w0 = 1.f / (1.f + ex), w1 = ex * w0;
                float* GVp = (float*)(p.ws + WS_GV); GVp[2 * row] = pg * w0; GVp[2 * row + 1] = pg * w1;
                sl_e[it * 32 + 2 * tid] = gs * 8 + i0; sl_e[it * 32 + 2 * tid + 1] = gs * 8 + i1; } }
            else { if (tid < 256) { const int rw = tid >> 4, hh = tid & 15; const float vv = logit[rw * 48 + hh] + p.fox_b_f[hh];
                ((float*)(p.ws + WS_LF))[(size_t)(tile * 16 + rw) * 16 + hh] = fminf(vv, 0.f) - __builtin_amdgcn_logf(1.f + __builtin_amdgcn_exp2f(-fabsf(vv) * LOG2E)) * 0.69314718056f;   } }
        }
    }
    if (KIND == 0) {
        gu32* CNT = (gu32*)(p.ws + WS_CTL) + CW_CNT + layer * 2048; int* LIST = (int*)(p.ws + WS_LIST);
        __syncthreads();
        const int nloc = it * 32;
        for (int s = tid; s < nloc; s += NWAVES * 64) atomicAdd((int*)&cnt_l[sl_e[s]], 1);
        __syncthreads();
        if (tid < 32) { const int n = cnt_l[tid]; cnt_l[32 + tid] = n > 0 ? (int)__hip_atomic_fetch_add(CNT + 64 * tid, (unsigned)n, RLX_AGENT) : 0; cnt_l[64 + tid] = 0; }
        __syncthreads();
        for (int s = tid; s < nloc; s += NWAVES * 64) { const int e = sl_e[s]; const int pos = cnt_l[32 + e] + atomicAdd((int*)&cnt_l[64 + e], 1);
            const int tl = C.vcu + (s >> 5) * C.G; LIST[(size_t)e * LCAP + pos] = 2 * (tl * 16 + ((s & 31) >> 1)) + (s & 1); }
    }
    __syncthreads();
}

__device__ __forceinline__ void cumsum_job(const Params& p, const Ctx& C) {
    if (C.vcu >= 64) return;
    const int b = C.vcu >> 4, h = C.vcu & 15, tid = C.tid, lane = C.lane, wave = C.wave;
    const float* LF = (const float*)(p.ws + WS_LF); float* DK = (float*)(p.ws + WS_DK) + (size_t)(b * 16 + h) * KROWS;
    LAS float* wt = (LAS float*)(C.lds + RING_OFF);
    float cm = 0.f, mine = 0.f; const int myj = (tid < NMETA) ? tid : -1;
    for (int i = 0; i < NMETA; ++i) { cm += LF[(size_t)(NREAL + i) * 16 + h]; if (i == myj) mine = cm; }
    if (tid < KPRE) DK[tid] = (myj >= 0) ? -mine * LOG2E : 0.f;
    if (tid < 64) DK[KPRE + SEQ + tid] = 0.f;
    const float* lp = LF + (size_t)(b * SEQ + tid * 16) * 16 + h;
    float run = 0.f;
#pragma unroll 1
    for (int i = 0; i < 16; ++i) run += lp[i * 16];
    float inc = run;
#pragma unroll
    for (int o = 1; o < 64; o <<= 1) { const float t = __uint_as_float((unsigned)__builtin_amdgcn_ds_bpermute((lane - o) << 2, (int)__float_as_uint(inc))); if (lane >= o) inc += t; }
    if (lane == 63) wt[wave] = inc;
    __syncthreads();
    float base = cm;
    for (int w = 0; w < wave; ++w) base += wt[w];
    base += inc - run;
#pragma unroll 1
    for (int i = 0; i < 16; ++i) { base += lp[i * 16]; DK[KPRE + tid * 16 + i] = -base * LOG2E; }
    __syncthreads();
}

struct MoeOrder {
    int G, c, UT; const LAS int* pre; const char* A; const char* W; size_t wexp, tsB;
    __device__ __forceinline__ bool next(int i, pg8::Unit& u) const {
        const int g = i * G + c; if (g >= UT || i >= ROWTAB_UNITS) return false;
        const int rt = g >> 2; int e = 0; while (pre[e + 1] <= rt) ++e;
        u.pm = rt - pre[e]; u.pn = g & 3; u.A = A; u.B = W + (size_t)e * wexp + (size_t)u.pn * tsB; u.tab = i; u.e = e; return true;
    }
};
__device__ __forceinline__ int moe_setup(const Params& p, const Ctx& C, int layer, MoeOrder& S) {
    LAS int* pre = (LAS int*)(C.lds + MOEPRE_OFF); LAS int* cnts = pre + 40; LAS int* rowtab = (LAS int*)(C.lds + ROWTAB_OFF);
    const gu32* CNT = (const gu32*)(p.ws + WS_CTL) + CW_CNT + layer * 2048;
    if (C.tid < 32) cnts[C.tid] = (int)__hip_atomic_load(CNT + 64 * C.tid, RLX_AGENT);
    __syncthreads();
    if (C.tid == 0) { int a = 0; for (int e = 0; e < NEXP; ++e) { pre[e] = a; a += (cnts[e] + 255) >> 8; } pre[NEXP] = a; }
    __syncthreads();
    S.pre = pre; S.UT = 4 * pre[NEXP];
    const int* LIST = (const int*)(p.ws + WS_LIST);
    pg8::Unit u;
    for (int i = 0; S.next(i, u); ++i) { if (C.tid < 256) { const int idx = 256 * u.pm + C.tid; rowtab[i * 256 + C.tid] = idx < cnts[u.e] ? LIST[(size_t)u.e * LCAP + idx] : -1; } }
    __syncthreads();
    return S.UT;
}

__global__ void __launch_bounds__(NWAVES * 64, 2) trunk_fwd(Params p) {
    extern __shared__ __attribute__((aligned(16))) unsigned char lds[];
    Ctx C;
    C.lds = (LAS unsigned char*)lds; C.tid = threadIdx.x; C.lane = C.tid & 63; C.wave = __builtin_amdgcn_readfirstlane(C.tid >> 6);
    C.G = gridDim.x; { const int bx = blockIdx.x; C.vcu = (C.G % 8 == 0) ? (bx % 8) * (C.G / 8) + bx / 8 : bx; }
    volatile LAS unsigned* MISC = (volatile LAS unsigned*)(C.lds + MISC_OFF);
    gu32* ctl = (gu32*)(p.ws + WS_CTL);
    if (C.tid < 32) MISC[C.tid] = 0u;
    __syncthreads();
    XcdBarrier bar; bar.bar = (unsigned*)(ctl + CW_BAR) + p.li * XCD_BAR_WORDS; bar.x = 0; bar.st = nullptr;
    if (!MK_PER_PHASE) bar = xcd_barrier_post((unsigned*)(ctl + CW_BAR) + p.li * XCD_BAR_WORDS, MISC + 8);
#define GRID_BAR() do { if (MK_PER_PHASE) { if (C.tid == 0) __hip_atomic_store(ctl + CW_TMO, 0xBADBA0u, RLX_AGENT); } else { xcd_barrier(bar); } } while (0)
    const int lo = p.ph_lo, hi = p.ph_hi;
#ifndef SUBMASK
#define SUBMASK 0x7f
#endif
#ifndef REP_MASK
#define REP_MASK 0
#endif
#define NREP(k) (((REP_MASK >> (k)) & 1) ? 2 : 1)
#ifndef PHASE_MASK
#define PHASE_MASK 0xffff
#endif
#define IN(k) (((PHASE_MASK >> (k)) & 1) && lo <= (k) && (k) < hi)
#define SEAM(k) do { if (IN(k) && IN((k) + 1)) GRID_BAR(); } while (0)
    bf16* XH = (bf16*)(p.ws + WS_XH); bf16* QB = (bf16*)(p.ws + WS_Q); bf16* KB = (bf16*)(p.ws + WS_K); bf16* VB = (bf16*)(p.ws + WS_V);
    bf16* O0 = (bf16*)(p.ws + WS_O0); bf16* O1 = (bf16*)p.out;
    const LAS int* rowtab = (const LAS int*)(C.lds + ROWTAB_OFF);

    if (IN(0)) { for (int rep_ = 0; rep_ < NREP(0); ++rep_) p0_prologue(p, fresh(C)); } SEAM(0);

    { constexpr int layer = 0;
        const int pb = 1 + (layer ? 8 : 0);
        if ((SUBMASK & 1) && IN(pb)) { for (int rep_ = 0; rep_ < NREP(pb); ++rep_) {
            if (layer == 1) cumsum_job(p, fresh(C));
            pg8::StaticOrder S; S.init(NRP, 3 * DM, C.G, (int)blockIdx.x, XH, DM * 2, p.ws + (layer ? WS_WQKV1 : WS_WQKV0), DM * 2);
            pg8::EpiQKV E{QB, KB, VB, attn_body::C2, layer ? (unsigned*)(ctl + CW_QM) : nullptr, (unsigned*)(ctl + CW_KM)};
            pg8::gemm_phase<pg8::EpiQKV, pg8::StaticOrder, true, false>(C.lds + RING_OFF, DM, DM * 2, S, E, rowtab, 0);
        } } SEAM(pb);
        if (layer == 0) {
            if (IN(2)) { for (int rep_ = 0; rep_ < NREP(2); ++rep_) {
                const float* TAB = (const float*)(p.ws + WS_TAB);
                for (int pr = C.vcu; pr < NBATCH * 16 * 16; pr += C.G) { const int trip = pr >> 4, s = pr & 15, b = trip >> 4, m = trip & 15; const int cv = (m >> 1) * 128;
#pragma unroll 1
                    for (int w = 0; w < 2; ++w) attn_body::attn_unit_dv<8>(b, w ? s : 31 - s, m * 64, cv, cv, (const attn_body::bf16*)QB, (const attn_body::bf16*)KB, (const attn_body::bf16*)VB, (attn_body::bf16*)((m & 1) ? O1 : O0), TAB + m * 128, (char*)lds + RING_OFF); }
            } } SEAM(2);
            if (IN(3)) { combine_phase(p, fresh(C)); } SEAM(3);
        } else {
            if (IN(10)) { for (int rep_ = 0; rep_ < NREP(10); ++rep_) {
                const float* DK = (const float*)(p.ws + WS_DK);
                for (;;) {
                    const int lane_ = fresh(C).lane;
                    int tko = MOEPRE_OFF; asm volatile("" : "+s"(tko)); LAS int* tk = (LAS int*)(C.lds + tko);
                    if (fresh(C).tid == 0) tk[0] = (int)__hip_atomic_fetch_add(ctl + CW_QCTR + 64 * rep_, 1u, RLX_AGENT);
                    __syncthreads(); const int u = tk[0]; __syncthreads();
                    if (u >= NBATCH * 16 * 32) break;
                    const int qb = 31 - (u >> 6), bh = u & 63, b = bh >> 4, h = bh & 15;
                    const float* dk = DK + (size_t)bh * KROWS;
                    const unsigned qmb = lane_ < 8 ? __hip_atomic_load(ctl + CW_QM + ((size_t)(b * 32 + qb) * 16 + h) * 8 + lane_, RLX_AGENT) : 0u;
                    const unsigned kmb = lane_ < 8 ? __hip_atomic_load(ctl + CW_KM + ((size_t)bh) * 8 + lane_, RLX_AGENT) : 0u;
                    const int ntf = 4 * qb + 6;
                    float e0 = lane_ < ntf ? dk[lane_ == 0 ? NMETA - 1 : 64 * lane_ + 63] : 0.f, e1 = lane_ + 64 < ntf ? dk[64 * (lane_ + 64) + 63] : 0.f, e2 = lane_ + 128 < ntf ? dk[64 * (lane_ + 128) + 63] : 0.f;
                    const float q2 = wave_sum(__uint_as_float(qmb), lane_), k2 = wave_sum(__uint_as_float(kmb), lane_);
                    const float thr = dk[KPRE + 256 * qb] - 40.f - 2.1f * sqrtf(q2 * k2);
                    const unsigned long long m0 = __ballot(lane_ < ntf && e0 >= thr), m1 = __ballot(lane_ + 64 < ntf && e1 >= thr), m2 = __ballot(lane_ + 128 < ntf && e2 >= thr);
                    int tb = m0 ? __builtin_ctzll(m0) : (m1 ? 64 + __builtin_ctzll(m1) : (m2 ? 128 + __builtin_ctzll(m2) : ntf - 6));
                    tb &= ~1; tb = tb > ntf - 6 ? ntf - 6 : tb; tb = __builtin_amdgcn_readfirstlane(tb);
                    attn_body::attn_unit<1, 8>(b, qb, tb, h * 64, h * 64, h * 64, (const attn_body::bf16*)QB, (const attn_body::bf16*)KB, (const attn_body::bf16*)VB, (attn_body::bf16*)O0, dk, (char*)lds + RING_OFF);
                }
                fox_meta_attn(p, fresh(C));
            } } SEAM(10);
        }
        const int pw = layer ? 11 : 4;
        if ((SUBMASK & 4) && IN(pw)) { for (int rep_ = 0; rep_ < NREP(pw); ++rep_) {
            pg8::StaticOrder S; S.init(NRP, DM, C.G, (int)blockIdx.x, layer ? O0 : QB, DM * 2, p.ws + (layer ? WS_WO1 : WS_WO0), DM * 2);
            pg8::EpiZ E{XH};
            pg8::gemm_phase<pg8::EpiZ, pg8::StaticOrder, true, false>(C.lds + RING_OFF, DM, DM * 2, S, E, rowtab, 0);
        } } SEAM(pw);
        if ((SUBMASK & 8) && IN(pw + 1)) { ln_phase<0>(p, fresh(C), layer); } SEAM(pw + 1);
        if ((SUBMASK & 16) && IN(pw + 2)) { for (int rep_ = 0; rep_ < NREP(pw + 2); ++rep_) {
            MoeOrder S; S.G = C.G; S.c = (int)blockIdx.x; S.A = (const char*)XH; S.W = (const char*)(p.ws + WS_WGU); S.wexp = (size_t)DM * DM * 2; S.tsB = (size_t)256 * DM * 2;
            moe_setup(p, fresh(C), layer, S);
            pg8::EpiGU E{(pg8::bf16_t*)O0};
            pg8::gemm_phase<pg8::EpiGU, MoeOrder, true, true>(C.lds + RING_OFF, DM, DM * 2, S, E, rowtab, 1);
        } } SEAM(pw + 2);
        if ((SUBMASK & 32) && IN(pw + 3)) { for (int rep_ = 0; rep_ < NREP(pw + 3); ++rep_) {
            MoeOrder S; S.G = C.G; S.c = (int)blockIdx.x; S.A = (const char*)O0; S.W = (const char*)(p.ws + WS_WD); S.wexp = (size_t)DM * DEXP * 2; S.tsB = (size_t)256 * DEXP * 2;
            moe_setup(p, fresh(C), layer, S);
            pg8::EpiDown E{(pg8::bf16_t*)KB, (const float*)(p.ws + WS_GV)};
            pg8::gemm_phase<pg8::EpiDown, MoeOrder, true, true>(C.lds + RING_OFF, DEXP, DEXP * 2, S, E, rowtab, 0);
        } } SEAM(pw + 3);
        if ((SUBMASK & 64) && IN(pw + 4)) {
            if (layer == 0) { ln_phase<1>(p, fresh(C), 0); { const Ctx Cf = fresh(C); convert_experts(p, Cf, 1, 0, Cf.vcu * NWAVES + Cf.wave, Cf.G * NWAVES); } }
            else ln_phase<2>(p, fresh(C), 1);
        }
        if (layer == 0) SEAM(8);
        }
    { constexpr int layer = 1;
        const int pb = 1 + (layer ? 8 : 0);
        if ((SUBMASK & 1) && IN(pb)) { for (int rep_ = 0; rep_ < NREP(pb); ++rep_) {
            if (layer == 1) cumsum_job(p, fresh(C));
            pg8::StaticOrder S; S.init(NRP, 3 * DM, C.G, (int)blockIdx.x, XH, DM * 2, p.ws + (layer ? WS_WQKV1 : WS_WQKV0), DM * 2);
            pg8::EpiQKV E{QB, KB, VB, attn_body::C2, layer ? (unsigned*)(ctl + CW_QM) : nullptr, (unsigned*)(ctl + CW_KM)};
            pg8::gemm_phase<pg8::EpiQKV, pg8::StaticOrder, true, false>(C.lds + RING_OFF, DM, DM * 2, S, E, rowtab, 0);
        } } SEAM(pb);
        if (layer == 0) {
            if (IN(2)) { for (int rep_ = 0; rep_ < NREP(2); ++rep_) {
                const float* TAB = (const float*)(p.ws + WS_TAB);
                for (int pr = C.vcu; pr < NBATCH * 16 * 16; pr += C.G) { const int trip = pr >> 4, s = pr & 15, b = trip >> 4, m = trip & 15; const int cv = (m >> 1) * 128;
#pragma unroll 1
                    for (int w = 0; w < 2; ++w) attn_body::attn_unit_dv<8>(b, w ? s : 31 - s, m * 64, cv, cv, (const attn_body::bf16*)QB, (const attn_body::bf16*)KB, (const attn_body::bf16*)VB, (attn_body::bf16*)((m & 1) ? O1 : O0), TAB + m * 128, (char*)lds + RING_OFF); }
            } } SEAM(2);
            if (IN(3)) { combine_phase(p, fresh(C)); } SEAM(3);
        } else {
            if (IN(10)) { for (int rep_ = 0; rep_ < NREP(10); ++rep_) {
                const float* DK = (const float*)(p.ws + WS_DK);
                for (;;) {
                    const int lane_ = fresh(C).lane;
                    int tko = MOEPRE_OFF; asm volatile("" : "+s"(tko)); LAS int* tk = (LAS int*)(C.lds + tko);
                    if (fresh(C).tid == 0) tk[0] = (int)__hip_atomic_fetch_add(ctl + CW_QCTR + 64 * rep_, 1u, RLX_AGENT);
                    __syncthreads(); const int u = tk[0]; __syncthreads();
                    if (u >= NBATCH * 16 * 32) break;
                    const int qb = 31 - (u >> 6), bh = u & 63, b = bh >> 4, h = bh & 15;
                    const float* dk = DK + (size_t)bh * KROWS;
                    const unsigned qmb = lane_ < 8 ? __hip_atomic_load(ctl + CW_QM + ((size_t)(b * 32 + qb) * 16 + h) * 8 + lane_, RLX_AGENT) : 0u;
                    const unsigned kmb = lane_ < 8 ? __hip_atomic_load(ctl + CW_KM + ((size_t)bh) * 8 + lane_, RLX_AGENT) : 0u;
                    const int ntf = 4 * qb + 6;
                    float e0 = lane_ < ntf ? dk[lane_ == 0 ? NMETA - 1 : 64 * lane_ + 63] : 0.f, e1 = lane_ + 64 < ntf ? dk[64 * (lane_ + 64) + 63] : 0.f, e2 = lane_ + 128 < ntf ? dk[64 * (lane_ + 128) + 63] : 0.f;
                    const float q2 = wave_sum(__uint_as_float(qmb), lane_), k2 = wave_sum(__uint_as_float(kmb), lane_);
                    const float thr = dk[KPRE + 256 * qb] - 40.f - 2.1f * sqrtf(q2 * k2);
                    const unsigned long long m0 = __ballot(lane_ < ntf && e0 >= thr), m1 = __ballot(lane_ + 64 < ntf && e1 >= thr), m2 = __ballot(lane_ + 128 < ntf && e2 >= thr);
                    int tb = m0 ? __builtin_ctzll(m0) : (m1 ? 64 + __builtin_ctzll(m1) : (m2 ? 128 + __builtin_ctzll(m2) : ntf - 6));
                    tb &= ~1; tb = tb > ntf - 6 ? ntf - 6 : tb; tb = __builtin_amdgcn_readfirstlane(tb);
                    attn_body::attn_unit<1, 8>(b, qb, tb, h * 64, h * 64, h * 64, (const attn_body::bf16*)QB, (const attn_body::bf16*)KB, (const attn_body::bf16*)VB, (attn_body::bf16*)O0, dk, (char*)lds + RING_OFF);
                }
                fox_meta_attn(p, fresh(C));
            } } SEAM(10);
        }
        const int pw = layer ? 11 : 4;
        if ((SUBMASK & 4) && IN(pw)) { for (int rep_ = 0; rep_ < NREP(pw); ++rep_) {
            pg8::StaticOrder S; S.init(NRP, DM, C.G, (int)blockIdx.x, layer ? O0 : QB, DM * 2, p.ws + (layer ? WS_WO1 : WS_WO0), DM * 2);
            pg8::EpiZ E{XH};
            pg8::gemm_phase<pg8::EpiZ, pg8::StaticOrder, true, false>(C.lds + RING_OFF, DM, DM * 2, S, E, rowtab, 0);
        } } SEAM(pw);
        if ((SUBMASK & 8) && IN(pw + 1)) { ln_phase<0>(p, fresh(C), layer); } SEAM(pw + 1);
        if ((SUBMASK & 16) && IN(pw + 2)) { for (int rep_ = 0; rep_ < NREP(pw + 2); ++rep_) {
            MoeOrder S; S.G = C.G; S.c = (int)blockIdx.x; S.A = (const char*)XH; S.W = (const char*)(p.ws + WS_WGU); S.wexp = (size_t)DM * DM * 2; S.tsB = (size_t)256 * DM * 2;
            moe_setup(p, fresh(C), layer, S);
            pg8::EpiGU E{(pg8::bf16_t*)O0};
            pg8::gemm_phase<pg8::EpiGU, MoeOrder, true, true>(C.lds + RING_OFF, DM, DM * 2, S, E, rowtab, 1);
        } } SEAM(pw + 2);
        if ((SUBMASK & 32) && IN(pw + 3)) { for (int rep_ = 0; rep_ < NREP(pw + 3); ++rep_) {
            MoeOrder S; S.G = C.G; S.c = (int)blockIdx.x; S.A = (const char*)O0; S.W = (const char*)(p.ws + WS_WD); S.wexp = (size_t)DM * DEXP * 2; S.tsB = (size_t)256 * DEXP * 2;
            moe_setup(p, fresh(C), layer, S);
            pg8::EpiDown E{(pg8::bf16_t*)KB, (const float*)(p.ws + WS_GV)};
            pg8::gemm_phase<pg8::EpiDown, MoeOrder, true, true>(C.lds + RING_OFF, DEXP, DEXP * 2, S, E, rowtab, 0);
        } } SEAM(pw + 3);
        if ((SUBMASK & 64) && IN(pw + 4)) {
            if (layer == 0) { ln_phase<1>(p, fresh(C), 0); { const Ctx Cf = fresh(C); convert_experts(p, Cf, 1, 0, Cf.vcu * NWAVES + Cf.wave, Cf.G * NWAVES); } }
            else ln_phase<2>(p, fresh(C), 1);
        }
        if (layer == 0) SEAM(8);
        }
#undef IN
#undef SEAM
#undef GRID_BAR
}

extern "C" void kernel_launch(void* const* d_in, const int* in_sizes, int n_in, void* d_out, int out_size, void* d_ws, size_t ws_size, hipStream_t stream) {
    static int grid = 0;
    if (grid == 0) {
        if (n_in != 21 || in_sizes[0] != NREAL * DM || out_size != NREAL * DM || ws_size < WS_END) { fprintf(stderr, "kernel_launch: unexpected shapes (n_in %d, in0 %d, out %d, ws %zu); nothing launched\n", n_in, n_in > 0 ? in_sizes[0] : -1, out_size, ws_size); grid = -1; return; }
        int dev = 0, cus = 0, per_cu = 0;
        if (hipGetDevice(&dev) != hipSuccess || hipDeviceGetAttribute(&cus, hipDeviceAttributeMultiprocessorCount, dev) != hipSuccess) { fprintf(stderr, "kernel_launch: device query failed\n"); grid = -1; return; }
        if (hipFuncSetAttribute((const void*)trunk_fwd, hipFuncAttributeMaxDynamicSharedMemorySize, LDS_BYTES) != hipSuccess) { fprintf(stderr, "kernel_launch: hipFuncSetAttribute failed\n"); grid = -1; return; }
        if (hipOccupancyMaxActiveBlocksPerMultiprocessor(&per_cu, (const void*)trunk_fwd, NWAVES * 64, LDS_BYTES) != hipSuccess || per_cu < 1) { fprintf(stderr, "kernel_launch: occupancy query reports %d workgroups per CU\n", per_cu); }
        (void)hipGetLastError();
        grid = cus;
    }
    if (grid < 0) return;
    if (hipMemsetAsync((char*)d_ws + WS_CTL, 0, CTL_ZERO_BYTES, stream) != hipSuccess) { fprintf(stderr, "kernel_launch: hipMemsetAsync failed\n"); return; }
    Params a{};
    const float** dst = (const float**)&a.x;
    for (int i = 0; i < 21; ++i) dst[i] = (const float*)d_in[i];
    a.out = (float*)d_out; a.ws = (unsigned char*)d_ws;
#if MK_PER_PHASE
    for (int k = 0; k < N_PHASES; ++k) { a.ph_lo = k; a.ph_hi = k + 1; a.li = 0; hipLaunchKernelGGL(trunk_fwd, dim3(grid), dim3(NWAVES * 64), LDS_BYTES, stream, a); }
#else
    a.ph_lo = 0; a.ph_hi = N_PHASES; a.li = 0;
    hipLaunchKernelGGL(trunk_fwd, dim3(grid), dim3(NWAVES * 64), LDS_BYTES, stream, a);
#endif
    const hipError_t le = hipPeekAtLastError();
    if (le != hipSuccess) fprintf(stderr, "kernel_launch: launch failed: %s\n", hipGetErrorName(le));
}
```

```cpp
#include <hip/hip_runtime.h>
#include <hip/hip_bf16.h>
#include <cstdio>
#include <cstdint>
#include <cmath>

constexpr int DM = 1024, NBATCH = 4, SEQ = 8192, NMETA = 16;
constexpr int NREAL = NBATCH * SEQ;
constexpr int NR = NREAL + NMETA;
constexpr int NRP = 129 * 256;
constexpr int KPRE = 64;
constexpr int KROWS = KPRE + SEQ + 64;
constexpr int NSLOT = 2 * NR;
constexpr int NEXP = 32, DEXP = 512;
constexpr float ALPHA = 1.41421356237309515f;
constexpr float LN_EPS = 1e-5f;
constexpr float LOG2E = 1.4426950408889634f;
constexpr float LAMBDA_INIT0 = 0.2f;

namespace pg8 {
#define PG8_LAS __attribute__((address_space(3)))
typedef unsigned short bf16_t;
typedef short bf16x8 __attribute__((ext_vector_type(8)));
typedef float f32x4 __attribute__((ext_vector_type(4)));
typedef unsigned u32x4 __attribute__((ext_vector_type(4)));
constexpr int BM = 256, BK = 64, HALF = 128, HTB = HALF * BK * 2  , STAGE_BYTES = 8 * HTB, NXCD = 8, WGM = 8;

__host__ __device__ __forceinline__ int lds_byte(int r, int c) { const int st = (r >> 4) * 2 + (c >> 5), rr = r & 15, cc = c & 31, ob = rr * 64 + cc * 2; return st * 1024 + (ob ^ (((ob >> 9) & 1) << 5)); }
__host__ __device__ __forceinline__ void stage_rc(int b, int& R, int& C) { const int st = b / 1024, sb = b % 1024, swz = sb ^ (((sb >> 9) & 1) << 5); R = (st >> 1) * 16 + swz / 64; C = (st & 1) * 32 + (swz % 64) / 2; }
__host__ __device__ __forceinline__ int perm32(int rho) { const int n = rho >> 4, i = rho & 15; return 8 * (i >> 2) + 4 * n + (i & 3); }

struct Unit { int pm, pn; const char* A; const char* B; int tab; int e; };

struct StaticOrder {
    int nM, nN, nwg, G, c; const char* A; const char* B; size_t tsA, tsB;
    __device__ void init(int M, int N, int G_, int c_, const void* A_, size_t lda_bytes, const void* B_, size_t ldb_bytes) { nM = M / BM; nN = N / BM; nwg = nM * nN; G = G_; c = c_; A = (const char*)A_; B = (const char*)B_; tsA = lda_bytes * BM; tsB = ldb_bytes * BM; }
    __device__ bool next(int i, Unit& u) const {
        const long L = (long)i * G + c; if (L >= nwg) return false;
        int wgid = (int)L; { const int q = nwg / NXCD, r = nwg % NXCD, xcd = wgid % NXCD, off = wgid / NXCD; wgid = (xcd < r ? xcd * (q + 1) : r * (q + 1) + (xcd - r) * q) + off; }
        const int nig = WGM * nN, gid = wgid / nig, fm = gid * WGM, gsz = (nM - fm) < WGM ? (nM - fm) : WGM;
        u.pm = fm + ((wgid % nig) % gsz); u.pn = (wgid % nig) / gsz; u.A = A + (size_t)u.pm * tsA; u.B = B + (size_t)u.pn * tsB; u.tab = 0; u.e = 0; return true;
    }
};

__device__ __forceinline__ float shx(float v, int m, int lane) { return __uint_as_float((unsigned)__builtin_amdgcn_ds_bpermute((lane ^ m) << 2, (int)__float_as_uint(v))); }
__device__ __forceinline__ unsigned cvt_pk_bf16(float lo, float hi) { unsigned r; asm volatile("v_cvt_pk_bf16_f32 %0, %1, %2" : "=v"(r) : "v"(lo), "v"(hi)); return r; }

template <class Epi, class Sched, bool ALIGN_EPI, bool GATHER>
__device__ __forceinline__ void gemm_phase(PG8_LAS unsigned char* lds, const int K, const unsigned lda, const Sched& S, const Epi& E, const PG8_LAS int* rowtab, const int ashift) {
    int tid_ = threadIdx.x; asm volatile("" : "+v"(tid_));
    const int tid = tid_, wid = __builtin_amdgcn_readfirstlane(tid >> 6), lane = tid & 63, wr = wid >> 2, wc = wid & 3, fr = lane & 15, fq = lane >> 4;
    const int nt = K / BK;
    unsigned voffB[2], offA[2][2], noffA[2][2]; int Rr[2], Cc[2];
#pragma unroll
    for (int i = 0; i < 2; ++i) { int R, C; stage_rc(tid * 16 + i * 8192, R, C); const int Rb = Epi::PERM ? ((R & ~31) + perm32(R & 31)) : R; Rr[i] = R; Cc[i] = C;
        voffB[i] = (unsigned)(Rb * K + C) * 2u;
#pragma unroll
        for (int h = 0; h < 2; ++h) { offA[h][i] = (unsigned)(R + HALF * h) * lda + (unsigned)C * 2u; noffA[h][i] = offA[h][i]; } }
    const size_t kstep = (size_t)(BK * 2);
    const size_t hstep = (size_t)HALF * K * 2;
    const unsigned ldsw = (unsigned)wid * 1024u;
    const int aoff = lds_byte(wr * 64 + fr, fq * 8), boff = lds_byte(wc * 32 + fr, fq * 8);
#define PG8_SA(b, h) (((b) * 2 + (h)) * HTB)
#define PG8_SB(b, h) ((4 + (b) * 2 + (h)) * HTB)
#define PG8_STAGE(bufoff, gbase, voff) do { _Pragma("unroll") for (int _i = 0; _i < 2; ++_i) \
        __builtin_amdgcn_global_load_lds((const unsigned*)((const char*)(gbase) + (voff)[_i]), (PG8_LAS unsigned*)(lds + (bufoff) + ldsw + _i * 8192), 16, 0, 0); } while (0)
#define PG8_LDA(dst, b, h) do { _Pragma("unroll") for (int m = 0; m < 4; ++m) _Pragma("unroll") for (int k = 0; k < 2; ++k) dst[m][k] = *(const PG8_LAS bf16x8*)(lds + PG8_SA(b, h) + aoff + m * 2048 + k * 1024); } while (0)
#define PG8_LDB(dst, b, h) do { _Pragma("unroll") for (int n = 0; n < 2; ++n) _Pragma("unroll") for (int k = 0; k < 2; ++k) dst[n][k] = *(const PG8_LAS bf16x8*)(lds + PG8_SB(b, h) + boff + n * 2048 + k * 1024); } while (0)
#define PG8_MMA(ai, bj, At, Bt) do { __builtin_amdgcn_s_setprio(1); _Pragma("unroll") for (int m = 0; m < 4; ++m) _Pragma("unroll") for (int n = 0; n < 2; ++n) _Pragma("unroll") for (int k = 0; k < 2; ++k) \
        acc[ai][bj][m][n] = __builtin_amdgcn_mfma_f32_16x16x32_bf16(Bt[n][k], At[m][k], acc[ai][bj][m][n], 0, 0, 0); __builtin_amdgcn_s_setprio(0); } while (0)
#define PG8_WAIT_V(n) asm volatile("s_waitcnt vmcnt(" #n ")" ::: "memory")
#define PG8_WAIT_L(n) asm volatile("s_waitcnt lgkmcnt(" #n ")" ::: "memory")
#define PG8_BAR __builtin_amdgcn_s_barrier()
#define PG8_SCHED __builtin_amdgcn_sched_barrier(0)
#define PG8_GOFF(dst, u) do { if constexpr (GATHER) { _Pragma("unroll") for (int _h = 0; _h < 2; ++_h) _Pragma("unroll") for (int _i = 0; _i < 2; ++_i) { \
        int _e = rowtab[(u).tab * 256 + _h * HALF + Rr[_i]]; _e = _e < 0 ? 0 : (_e >> ashift); dst[_h][_i] = (unsigned)_e * lda + (unsigned)Cc[_i] * 2u; } } } while (0)
    Unit cur, nxt; int ui = 0;
    if (!S.next(0, cur)) return;
    f32x4 acc[2][2][4][2];
#pragma unroll
    for (int a = 0; a < 2; ++a)
#pragma unroll
        for (int b = 0; b < 2; ++b)
#pragma unroll
            for (int m = 0; m < 4; ++m)
#pragma unroll
                for (int n = 0; n < 2; ++n) acc[a][b][m][n] = (f32x4){0.f, 0.f, 0.f, 0.f};
    bf16x8 At[4][2], B0[2][2], B1[2][2];
    const char* cA = cur.A; const char* cB = cur.B;
    PG8_GOFF(offA, cur);
    PG8_STAGE(PG8_SB(0, 0), cB, voffB); PG8_STAGE(PG8_SB(0, 1), cB + hstep, voffB); PG8_STAGE(PG8_SA(0, 0), cA, offA[0]); PG8_STAGE(PG8_SA(0, 1), cA, offA[1]);
    if (wr == 1) PG8_BAR;
    PG8_WAIT_V(2); PG8_BAR;
    PG8_STAGE(PG8_SB(1, 0), cB + kstep, voffB); PG8_STAGE(PG8_SA(1, 0), cA + kstep, offA[0]); PG8_STAGE(PG8_SB(1, 1), cB + hstep + kstep, voffB);
    PG8_WAIT_V(6); PG8_BAR;
    for (;;) {
        const bool has_next = S.next(ui + 1, nxt);
        const char* nA = has_next ? nxt.A : cA; const char* nB = has_next ? nxt.B : cB;
        if constexpr (GATHER) { if (has_next) PG8_GOFF(noffA, nxt); else {
#pragma unroll
            for (int h = 0; h < 2; ++h)
#pragma unroll
                for (int i = 0; i < 2; ++i) noffA[h][i] = offA[h][i]; } }
        for (int t = 0; t < nt; t += 2) {
            const bool last = (t == nt - 2);
            const char* a1 = cA + (size_t)(t + 1) * kstep;
            const char* a2 = last ? nA : cA + (size_t)(t + 2) * kstep; const char* b2 = last ? nB : cB + (size_t)(t + 2) * kstep;
            const char* a3 = a2 + kstep; const char* b3 = b2 + kstep;
            unsigned o2[2][2];
#pragma unroll
            for (int h = 0; h < 2; ++h)
#pragma unroll
                for (int i = 0; i < 2; ++i) o2[h][i] = (GATHER && last) ? noffA[h][i] : offA[h][i];
            PG8_LDB(B0, 0, 0); PG8_LDB(B1, 0, 1); PG8_SCHED; PG8_LDA(At, 0, 0); PG8_STAGE(PG8_SA(1, 1), a1, offA[1]);
            PG8_WAIT_V(8); PG8_WAIT_L(0); PG8_BAR; PG8_MMA(0, 0, At, B0); PG8_MMA(0, 1, At, B1); PG8_BAR; PG8_SCHED;
            PG8_LDA(At, 0, 1); PG8_STAGE(PG8_SB(0, 0), b2, voffB); PG8_STAGE(PG8_SB(0, 1), b2 + hstep, voffB); PG8_STAGE(PG8_SA(0, 0), a2, o2[0]);
            PG8_WAIT_V(8); PG8_WAIT_L(0); PG8_BAR; PG8_MMA(1, 0, At, B0); PG8_MMA(1, 1, At, B1); PG8_BAR; PG8_SCHED;
            PG8_LDB(B0, 1, 0); PG8_LDB(B1, 1, 1); PG8_SCHED; PG8_LDA(At, 1, 0); PG8_STAGE(PG8_SA(0, 1), a2, o2[1]);
            PG8_WAIT_V(8); PG8_WAIT_L(0); PG8_BAR; PG8_MMA(0, 0, At, B0); PG8_MMA(0, 1, At, B1); PG8_BAR; PG8_SCHED;
            PG8_LDA(At, 1, 1); PG8_STAGE(PG8_SB(1, 0), b3, voffB); PG8_STAGE(PG8_SB(1, 1), b3 + hstep, voffB); PG8_STAGE(PG8_SA(1, 0), a3, o2[0]);
            PG8_WAIT_V(8); PG8_WAIT_L(0); PG8_BAR; PG8_MMA(1, 0, At, B0); PG8_MMA(1, 1, At, B1); PG8_BAR; PG8_SCHED;
        }
        if constexpr (ALIGN_EPI) { if (wr == 0) PG8_BAR; }
        E(acc, cur, wr, wc, fr, fq, rowtab);
        if (!has_next) break;
#pragma unroll
        for (int a = 0; a < 2; ++a)
#pragma unroll
            for (int b = 0; b < 2; ++b)
#pragma unroll
                for (int m = 0; m < 4; ++m)
#pragma unroll
                    for (int n = 0; n < 2; ++n) acc[a][b][m][n] = (f32x4){0.f, 0.f, 0.f, 0.f};
        cur = nxt; cA = nA; cB = nB; ++ui;
        if constexpr (GATHER) {
#pragma unroll
            for (int h = 0; h < 2; ++h)
#pragma unroll
                for (int i = 0; i < 2; ++i) offA[h][i] = noffA[h][i]; }
        if constexpr (ALIGN_EPI) { if (wr == 1) PG8_BAR; }
    }
    PG8_WAIT_V(0);
    if constexpr (!ALIGN_EPI) { if (wr == 0) PG8_BAR; }
    PG8_BAR;
#undef PG8_SA
#undef PG8_SB
#undef PG8_STAGE
#undef PG8_LDA
#undef PG8_LDB
#undef PG8_MMA
#undef PG8_WAIT_V
#undef PG8_WAIT_L
#undef PG8_BAR
#undef PG8_SCHED
#undef PG8_GOFF
}

struct EpiQKV {
    static constexpr bool PERM = true;
    bf16_t* Q; bf16_t* Kb; bf16_t* Vb; float qscale;
    unsigned* qm; unsigned* km;
    __device__ __forceinline__ void operator()(const f32x4 (&acc)[2][2][4][2], const Unit& u, int wr, int wc, int fr, int fq, const PG8_LAS int*) const {
        const int row0 = u.pm * BM + wr * 64 + fr; const int t = (u.pn * BM) >> 10; const int colt = (u.pn * BM) & 1023;
        const int col0 = colt + wc * 32 + 8 * fq; const float sc = (t == 0) ? qscale : 1.f;
        bf16_t* kv = (t == 1) ? Kb : Vb;
        float mx[2] = {0.f, 0.f};
#pragma unroll
        for (int ai = 0; ai < 2; ++ai)
#pragma unroll
            for (int m = 0; m < 4; ++m) { const int r = row0 + ai * HALF + m * 16;
                if (r < NR) {
#pragma unroll
                for (int bj = 0; bj < 2; ++bj) { const f32x4 v0 = acc[ai][bj][m][0] * sc, v1 = acc[ai][bj][m][1] * sc;
                    u32x4 w; w.x = cvt_pk_bf16(v0[0], v0[1]); w.y = cvt_pk_bf16(v0[2], v0[3]); w.z = cvt_pk_bf16(v1[0], v1[1]); w.w = cvt_pk_bf16(v1[2], v1[3]);
                    const int c = col0 + bj * HALF;
                    bf16_t* dst = (t == 0) ? Q + (size_t)r * DM : kv + (size_t)(r < NREAL ? (r >> 13) * KROWS + KPRE + (r & (SEQ - 1)) : r - NREAL) * DM;
                    *(u32x4*)(dst + c) = w; } }
                if (qm != nullptr && t < 2) {
#pragma unroll
                    for (int bj = 0; bj < 2; ++bj) { const f32x4 v0 = acc[ai][bj][m][0] * sc, v1 = acc[ai][bj][m][1] * sc;
                        float ss = (v0[0] * v0[0] + v0[1] * v0[1]) + (v0[2] * v0[2] + v0[3] * v0[3]) + (v1[0] * v1[0] + v1[1] * v1[1]) + (v1[2] * v1[2] + v1[3] * v1[3]);
                        ss += shx(ss, 16, fq * 16 + fr); ss += shx(ss, 32, fq * 16 + fr);
                        if (r < NR) mx[bj] = fmaxf(mx[bj], ss); } } }
        if (qm != nullptr && t < 2) {
#pragma unroll
            for (int bj = 0; bj < 2; ++bj) { float v = mx[bj]; v = fmaxf(v, shx(v, 1, fq * 16 + fr)); v = fmaxf(v, shx(v, 2, fq * 16 + fr)); v = fmaxf(v, shx(v, 4, fq * 16 + fr)); v = fmaxf(v, shx(v, 8, fq * 16 + fr));
                if (fr == 0 && fq == 0) { const int head = 4 * (u.pn & 3) + 2 * bj + (wc >> 1), part = wc & 1; const unsigned bits = __float_as_uint(v);
                    if (t == 0) { if (u.pm < NREAL / BM) atomicMax(qm + ((size_t)u.pm * 16 + head) * 8 + part, bits); }
                    else if (u.pm < NREAL / BM) atomicMax(km + ((size_t)(u.pm >> 5) * 16 + head) * 8 + part, bits);
                    else { for (int b = 0; b < NBATCH; ++b) atomicMax(km + ((size_t)b * 16 + head) * 8 + part, bits); } } } }
    }
};
struct EpiZ {
    static constexpr bool PERM = true;
    bf16_t* H;
    __device__ __forceinline__ void operator()(const f32x4 (&acc)[2][2][4][2], const Unit& u, int wr, int wc, int fr, int fq, const PG8_LAS int*) const {
        const int row0 = u.pm * BM + wr * 64 + fr; const int col0 = u.pn * BM + wc * 32 + 8 * fq;
#pragma unroll
        for (int ai = 0; ai < 2; ++ai)
#pragma unroll
            for (int m = 0; m < 4; ++m) { const int r = row0 + ai * HALF + m * 16;
                if (r < NR) {
#pragma unroll
                    for (int bj = 0; bj < 2; ++bj) { bf16_t* hp = H + (size_t)r * DM + col0 + bj * HALF; const u32x4 b = *(const u32x4*)hp;
                        const f32x4 v0 = acc[ai][bj][m][0], v1 = acc[ai][bj][m][1];
                        u32x4 w; w.x = cvt_pk_bf16(v0[0] + ALPHA * __uint_as_float(b.x << 16), v0[1] + ALPHA * __uint_as_float(b.x & 0xffff0000u)); w.y = cvt_pk_bf16(v0[2] + ALPHA * __uint_as_float(b.y << 16), v0[3] + ALPHA * __uint_as_float(b.y & 0xffff0000u));
                        w.z = cvt_pk_bf16(v1[0] + ALPHA * __uint_as_float(b.z << 16), v1[1] + ALPHA * __uint_as_float(b.z & 0xffff0000u)); w.w = cvt_pk_bf16(v1[2] + ALPHA * __uint_as_float(b.w << 16), v1[3] + ALPHA * __uint_as_float(b.w & 0xffff0000u));
                        *(u32x4*)hp = w; } } }
    }
};
struct EpiGU {
    static constexpr bool PERM = true;
    bf16_t* U;
    __device__ __forceinline__ void operator()(const f32x4 (&acc)[2][2][4][2], const Unit& u, int wr, int wc, int fr, int fq, const PG8_LAS int* rowtab) const {
        const int col0 = u.pn * HALF + wc * 32 + 8 * fq;
#pragma unroll
        for (int ai = 0; ai < 2; ++ai)
#pragma unroll
            for (int m = 0; m < 4; ++m) { const int slot = rowtab[u.tab * 256 + ai * HALF + wr * 64 + m * 16 + fr];
                if (slot >= 0) { float o[8];
#pragma unroll
                    for (int n = 0; n < 2; ++n)
#pragma unroll
                        for (int c = 0; c < 4; ++c) { const float g = acc[ai][0][m][n][c], up = acc[ai][1][m][n][c]; o[n * 4 + c] = g * up * __builtin_amdgcn_rcpf(1.f + __builtin_amdgcn_exp2f(-g * LOG2E)); }
                    u32x4 w; w.x = cvt_pk_bf16(o[0], o[1]); w.y = cvt_pk_bf16(o[2], o[3]); w.z = cvt_pk_bf16(o[4], o[5]); w.w = cvt_pk_bf16(o[6], o[7]);
                    *(u32x4*)(U + (size_t)slot * DEXP + col0) = w; } }
    }
};
struct EpiDown {
    static constexpr bool PERM = true;
    bf16_t* Y; const float* GV;
    __device__ __forceinline__ void operator()(const f32x4 (&acc)[2][2][4][2], const Unit& u, int wr, int wc, int fr, int fq, const PG8_LAS int* rowtab) const {
        const int col0 = u.pn * BM + wc * 32 + 8 * fq;
#pragma unroll
        for (int ai = 0; ai < 2; ++ai)
#pragma unroll
            for (int m = 0; m < 4; ++m) { const int slot = rowtab[u.tab * 256 + ai * HALF + wr * 64 + m * 16 + fr];
                if (slot >= 0) { const float gv = GV[slot];
#pragma unroll
                    for (int bj = 0; bj < 2; ++bj) { const f32x4 v0 = acc[ai][bj][m][0] * gv, v1 = acc[ai][bj][m][1] * gv;
                        u32x4 w; w.x = cvt_pk_bf16(v0[0], v0[1]); w.y = cvt_pk_bf16(v0[2], v0[3]); w.z = cvt_pk_bf16(v1[0], v1[1]); w.w = cvt_pk_bf16(v1[2], v1[3]);
                        *(u32x4*)(Y + (size_t)slot * DM + col0 + bj * HALF) = w; } } }
    }
};
}
namespace attn_body {
using bf16=__hip_bfloat16;
using bf16x8=__attribute__((ext_vector_type(8)))short;
using s16x4=__attribute__((ext_vector_type(4)))short;
using f32x16=__attribute__((ext_vector_type(16)))float;
using u32x4=__attribute__((ext_vector_type(4)))unsigned;
constexpr int D=64;
constexpr int NW=8,QBLK=32,QB=QBLK*NW,KVBLK=64,NQB=SEQ/QB;
constexpr int ATTN_PITCH=DM, ATTN_UNIT_ROWS=QB;
__device__ __forceinline__ int crow(int r,int hi){return (r&3)+8*(r>>2)+4*hi;}
#define SBAR() __builtin_amdgcn_sched_barrier(0)
__device__ __forceinline__ void cmask(f32x16&p0,f32x16&p1,int jb,int qrel,int hi){
  const float NEG=-INFINITY; int kb=64*jb+4*hi;
  #pragma unroll
  for(int r=0;r<16;++r){int kv=kb+(r&3)+8*(r>>2); if(kv>qrel)p0[r]=NEG; if(kv+32>qrel)p1[r]=NEG;}
}

constexpr int RT_OFFS=320, RT_SIZE=704;

template<int MODE> __device__ __forceinline__ void modtile_slow(f32x16&p0,f32x16&p1,int t,int q_abs,int q0,int hi,const __attribute__((address_space(3))) float* tab){
  const float NEG=-INFINITY; int hi4=4*hi; asm volatile("":"+v"(hi4),"+v"(q_abs));
  if(MODE==0){
    if(t==0){
      int bd=16+q_abs; bd=bd>383?383:bd; const __attribute__((address_space(3))) float* bp=tab+(RT_OFFS+bd-hi4-15);
      #pragma unroll
      for(int r=0;r<16;++r){ p1[r]=NEG; if(r<8)p0[r]+=bp[15-((r&3)+8*(r>>2))]; else p0[r]=NEG; }
    } else {
      const __attribute__((address_space(3))) float* bp=tab+(RT_OFFS+q_abs-64*t+KPRE-hi4-63);
      const int dq=q_abs-64*t+KPRE-hi4;
      #pragma unroll
      for(int r=0;r<16;++r){ const int c=(r&3)+8*(r>>2); p0[r]+=bp[63-c]; p1[r]+=bp[31-c]; }
      if(64*t-KPRE+63>q0){
        #pragma unroll
        for(int r=0;r<16;++r){ const int c=(r&3)+8*(r>>2); if(c>dq)p0[r]=NEG; if(c+32>dq)p1[r]=NEG; } }
    }
  } else {
    if(t==0){
      #pragma unroll
      for(int r=0;r<16;++r){ p1[r]=NEG; if(r<8)p0[r]+=tab[(r&3)+8*(r>>2)+hi4]; else p0[r]=NEG; }
    } else {
      typedef float f4 __attribute__((ext_vector_type(4)));
      const __attribute__((address_space(3))) f4* tp=(const __attribute__((address_space(3))) f4*)(tab+64*t+hi4);
      #pragma unroll
      for(int g=0;g<4;++g){ const f4 a=tp[2*g], b=tp[8+2*g];
        #pragma unroll
        for(int c=0;c<4;++c){ p0[4*g+c]+=a[c]; p1[4*g+c]+=b[c]; }
        asm volatile("":::"memory"); }
      if(64*t-KPRE+63>q0){
        const int dq=q_abs-64*t+KPRE-hi4;
        #pragma unroll
        for(int r=0;r<16;++r){ const int c=(r&3)+8*(r>>2); if(c>dq)p0[r]=NEG; if(c+32>dq)p1[r]=NEG; } }
    }
  }
}
__device__ __forceinline__ void modtile_fast1(f32x16&p0,f32x16&p1,int t,int hi,const __attribute__((address_space(3))) float* tab){
  typedef float f4 __attribute__((ext_vector_type(4)));
  const __attribute__((address_space(3))) f4* tp=(const __attribute__((address_space(3))) f4*)(tab+64*t+4*hi);
  #pragma unroll
  for(int g=0;g<4;++g){ const f4 a=tp[2*g], b=tp[8+2*g];
    #pragma unroll
    for(int c=0;c<4;++c){ p0[4*g+c]+=a[c]; p1[4*g+c]+=b[c]; } }
}
constexpr int NSLOT=3, SLOTB=8192;
constexpr int LDS_K=0, LDS_V=NSLOT*SLOTB, LDS_WS=2*NSLOT*SLOTB, LDS_OST=LDS_WS+NW*64*4, LDS_TAB=LDS_OST+NW*4096, LDS_BYTES=LDS_TAB+KROWS*4;
constexpr float C2=0.125f*1.4426950408889634f;
__device__ __forceinline__ void glds16(const void*gsrc,unsigned lds_dst){unsigned keep;
  asm volatile("s_mov_b32 %0, m0\n\ts_mov_b32 m0, %2\n\ts_nop 0\n\tglobal_load_lds_dwordx4 %1, off\n\ts_mov_b32 m0, %0":"=&s"(keep):"v"(gsrc),"s"(lds_dst):"memory");}
__device__ __forceinline__ float max3f(float a,float b,float c){float r;asm("v_max3_f32 %0, %1, %2, %3":"=v"(r):"v"(a),"v"(b),"v"(c));return r;}
__device__ __forceinline__ float max2f(float a,float b){float r;asm("v_max_f32_e32 %0, %1, %2":"=v"(r):"v"(a),"v"(b));return r;}
__device__ __forceinline__ float fadd_s(float a,float b){float r;asm("v_add_f32_e32 %0, %1, %2":"=v"(r):"v"(a),"v"(b));return r;}
__device__ __forceinline__ float fsub_s(float a,float b){float r;asm("v_sub_f32_e32 %0, %1, %2":"=v"(r):"v"(a),"v"(b));return r;}
typedef float f32x2_t __attribute__((ext_vector_type(2))); typedef __bf16 bf16x2_t __attribute__((ext_vector_type(2)));
__device__ __forceinline__ unsigned cvtpk_s(float lo,float hi){f32x2_t v={lo,hi};bf16x2_t b=__builtin_convertvector(v,bf16x2_t);return __builtin_bit_cast(unsigned,b);}
#define WAIT_BAR(N) asm volatile("s_waitcnt vmcnt(" #N ") lgkmcnt(0)\n\ts_barrier":::"memory")

__device__ __forceinline__ void qkt(f32x16&p0,f32x16&p1,const char*Kslot,const bf16x8*qr,const f32x16&negm,int r32,int hi){
  const char*kb=Kslot+hi*1024+r32*16;
  #pragma unroll
  for(int d0=0;d0<4;++d0){
    const bf16x8 b0=*reinterpret_cast<const bf16x8*>(kb+d0*2048);
    const bf16x8 b1=*reinterpret_cast<const bf16x8*>(kb+d0*2048+512);
    if(d0==0){p0=__builtin_amdgcn_mfma_f32_32x32x16_bf16(b0,qr[0],negm,0,0,0);p1=__builtin_amdgcn_mfma_f32_32x32x16_bf16(b1,qr[0],negm,0,0,0);}
    else{p0=__builtin_amdgcn_mfma_f32_32x32x16_bf16(b0,qr[d0],p0,0,0,0);p1=__builtin_amdgcn_mfma_f32_32x32x16_bf16(b1,qr[d0],p1,0,0,0);}}
}
typedef __attribute__((address_space(3))) const char* lds_cptr;
typedef short v4i16_t __attribute__((ext_vector_type(4)));
__device__ __forceinline__ void kload8(bf16x8*kf,lds_cptr kp){
  kf[0]=*(const __attribute__((address_space(3))) bf16x8*)(kp);      kf[1]=*(const __attribute__((address_space(3))) bf16x8*)(kp+512);
  kf[2]=*(const __attribute__((address_space(3))) bf16x8*)(kp+2048); kf[3]=*(const __attribute__((address_space(3))) bf16x8*)(kp+2560);
  kf[4]=*(const __attribute__((address_space(3))) bf16x8*)(kp+4096); kf[5]=*(const __attribute__((address_space(3))) bf16x8*)(kp+4608);
  kf[6]=*(const __attribute__((address_space(3))) bf16x8*)(kp+6144); kf[7]=*(const __attribute__((address_space(3))) bf16x8*)(kp+6656);
}
__device__ __forceinline__ void kload2(bf16x8*kf,lds_cptr kp,int j){ kf[2*j]=*(const __attribute__((address_space(3))) bf16x8*)(kp+j*2048); kf[2*j+1]=*(const __attribute__((address_space(3))) bf16x8*)(kp+j*2048+512); }
__device__ __forceinline__ s16x4 vtr(lds_cptr p){ return __builtin_bit_cast(s16x4,__builtin_amdgcn_ds_read_tr16_b64_v4i16((__attribute__((address_space(3))) v4i16_t*)p)); }
__device__ __forceinline__ float rowmax(const f32x16&p0,const f32x16&p1){
  float a=max3f(p0[0],p0[1],p1[0]),b=max3f(p0[2],p0[3],p1[1]);a=max3f(a,p1[2],p1[3]);
  #pragma unroll
  for(int r=4;r<16;r+=4){a=max3f(a,p0[r],p0[r+1]);b=max3f(b,p0[r+2],p0[r+3]);a=max3f(a,p1[r],p1[r+1]);b=max3f(b,p1[r+2],p1[r+3]);}
  const float m=max2f(a,b);
  auto rr=__builtin_amdgcn_permlane32_swap(__float_as_uint(m),__float_as_uint(m),false,false);
  return max2f(__uint_as_float(rr[0]),__uint_as_float(rr[1]));
}
__device__ __forceinline__ void pv(f32x16*o,int vb,bf16x8 pa0,bf16x8 pa1,bf16x8 pa2,bf16x8 pa3){
  #pragma unroll
  for(int d0=0;d0<2;++d0){s16x4 lo[4],hi[4];
    #pragma unroll
    for(int ks=0;ks<4;++ks){
      asm volatile("ds_read_b64_tr_b16 %0,%1 offset:%c2":"=&v"(lo[ks]):"v"(vb),"i"(d0*4096+ks*1024):"memory");
      asm volatile("ds_read_b64_tr_b16 %0,%1 offset:%c2":"=&v"(hi[ks]):"v"(vb),"i"(d0*4096+ks*1024+512):"memory");}
    asm volatile("s_waitcnt lgkmcnt(0)":::"memory");SBAR();
    #define PK(k) (bf16x8){lo[k][0],lo[k][1],lo[k][2],lo[k][3],hi[k][0],hi[k][1],hi[k][2],hi[k][3]}
    o[d0]=__builtin_amdgcn_mfma_f32_32x32x16_bf16(pa0,PK(0),o[d0],0,0,0);
    o[d0]=__builtin_amdgcn_mfma_f32_32x32x16_bf16(pa1,PK(1),o[d0],0,0,0);
    o[d0]=__builtin_amdgcn_mfma_f32_32x32x16_bf16(pa2,PK(2),o[d0],0,0,0);
    o[d0]=__builtin_amdgcn_mfma_f32_32x32x16_bf16(pa3,PK(3),o[d0],0,0,0);
    #undef PK
  }
}

#ifndef ATTN_STORE16
#define ATTN_STORE16(p,v) (*(u32x4*)(p)=(v))
#endif
template<int MODE,int THRL> __device__ __forceinline__ void attn_unit(int b,int qb,int tb,int cq,int cv,int co,const bf16*Q,const bf16*__restrict__ K,const bf16*__restrict__ V,bf16*O,const float*tabsrc,char*shm){
  int tid_=threadIdx.x; asm volatile("":"+v"(tid_));
  const int tid=tid_,lane=tid&63,r32=lane&31,hi=lane>>5; const int wid=__builtin_amdgcn_readfirstlane(tid>>6);
  const long rowbase=(long)b*SEQ, rowbase_k=(long)b*KROWS; const int q0=qb*QB;
  const bf16*Qw=Q+(rowbase+q0+wid*QBLK)*DM+cq;
  const bf16*Kh=K+rowbase_k*DM+cq,*Vh=V+rowbase_k*DM+cv;
  const unsigned lds0=(unsigned)(uintptr_t)shm;
  const __attribute__((address_space(3))) char* shm3_=(const __attribute__((address_space(3))) char*)shm;
  float*wsf=(float*)(shm+LDS_WS)+wid*64;
  const bf16*ksrc=Kh+(long)(lane+64*tb)*DM+wid*8;
  const bf16*vsrc=Vh+(long)(16*(wid&3)+(lane>>2)+64*tb)*DM+(wid>>2)*32+(lane&3)*8;
  const unsigned kdst=lds0+LDS_K+wid*1024, vdst=lds0+LDS_V+wid*1024;
  #define DMA_K(t,slot) glds16(ksrc+(long)(t)*KVBLK*DM,(unsigned)__builtin_amdgcn_readfirstlane(kdst+(slot)))
  #define DMA_V(t,slot) glds16(vsrc+(long)(t)*KVBLK*DM,(unsigned)__builtin_amdgcn_readfirstlane(vdst+(slot)))
  const int vb0=(int)(lds0+LDS_V)+((lane>>4)&1)*32+(lane&3)*8+(4*hi+((lane&15)>>2))*64;
  const char*Kbase=shm+LDS_K; bf16x8 kf[8];
  const lds_cptr shm3=(lds_cptr)shm; const lds_cptr kp0=shm3+LDS_K+hi*1024+r32*16; const lds_cptr vp0=shm3+LDS_V+((lane>>4)&1)*32+(lane&3)*8+(4*hi+((lane&15)>>2))*64;
  const int NT=(KPRE+q0+QB+KVBLK)/KVBLK-tb;
  const __attribute__((address_space(3))) float* tab=(const __attribute__((address_space(3))) float*)(shm3_+LDS_TAB);
  { __attribute__((address_space(3))) float* tw=(__attribute__((address_space(3))) float*)(shm3_+LDS_TAB);
    if(MODE==0){ for(int i=tid;i<RT_SIZE;i+=512){ const int d=i-RT_OFFS; tw[i]=d<0?-INFINITY:(d<128?tabsrc[d]:0.f); } }
    else { const int n=KPRE+q0+QB+KVBLK; for(int i=64*tb+tid*4;i<n;i+=2048){ const float4 v=*(const float4*)(tabsrc+i); tw[i]=v.x;tw[i+1]=v.y;tw[i+2]=v.z;tw[i+3]=v.w; } } }
  if(tb==0){ glds16(K+cq+(long)lane*DM+wid*8,(unsigned)__builtin_amdgcn_readfirstlane(kdst)); glds16(V+cv+(long)(16*(wid&3)+(lane>>2))*DM+(wid>>2)*32+(lane&3)*8,(unsigned)__builtin_amdgcn_readfirstlane(vdst)); } else { DMA_K(0,0); DMA_V(0,0); } DMA_K(1,SLOTB);
  bf16x8 qr[4];
  #pragma unroll
  for(int d0=0;d0<4;++d0)qr[d0]=*reinterpret_cast<const bf16x8*>(&Qw[(long)r32*DM+d0*16+hi*8]);
  float l_reg=0.f;f32x16 o[2];o[0]=f32x16{};o[1]=f32x16{};f32x16 negm=f32x16{};asm volatile("":"+v"(negm));
  const int qrel=wid*QBLK+r32, q_abs=q0+qrel;
  #define MODT(P0,P1,t,SL) do{ if(SL)modtile_slow<MODE>(P0,P1,(t)+tb,q_abs,q0,hi,tab); else if(MODE==1)modtile_fast1(P0,P1,(t)+tb,hi,tab); }while(0)
  bool resc=false;
  #define START(P0,P1) do{ const float rm=rowmax(P0,P1); resc=false; \
    { const float dl=(MODE==1)?__builtin_fmaxf(rm,0.f):rm; const float nm_=fsub_s(negm[0],dl); \
      _Pragma("unroll") for(int r=0;r<16;++r){P0[r]=fsub_s(P0[r],dl);P1[r]=fsub_s(P1[r],dl);} \
      _Pragma("unroll") for(int r=0;r<16;++r)negm[r]=nm_; asm volatile("":"+v"(negm)); } \
    _Pragma("unroll") for(int r=0;r<16;++r)P0[r]=__builtin_amdgcn_exp2f(P0[r]); }while(0)
  #define RESC() do{ if(resc){ asm volatile("s_waitcnt lgkmcnt(0)":::"memory"); \
      _Pragma("unroll") for(int d_=0;d_<2;++d_) _Pragma("unroll") for(int r=0;r<16;++r)o[d_][r]*=wsf[crow(r,hi)]; } }while(0)
  f32x16 pA0,pA1,pB0,pB1;
  int sl_prev=0,sl_cur=0,sl_next=SLOTB;
  #define ROT() do{sl_prev=sl_cur;sl_cur=sl_next;sl_next=(sl_next==(NSLOT-1)*SLOTB)?0:sl_next+SLOTB;}while(0)
  DMA_K(2,2*SLOTB);
  WAIT_BAR(3);
  if(MODE==1){ const float m0_=tab[KPRE+q_abs]; _Pragma("unroll") for(int r=0;r<16;++r)negm[r]=-m0_; asm volatile("":"+v"(negm)); }
  qkt(pA0,pA1,Kbase,qr,negm,r32,hi);asm volatile("s_nop 15\n\ts_nop 7":"+v"(pA0),"+v"(pA1));MODT(pA0,pA1,0,true);
  START(pA0,pA1);
  _Pragma("unroll") for(int r=0;r<16;++r)pA1[r]=__builtin_amdgcn_exp2f(pA1[r]);
  WAIT_BAR(0);
  DMA_K(3,0);DMA_V(1,SLOTB);
  ROT();
  kload8(kf,kp0+sl_cur);
  WAIT_BAR(2);
  s16x4 vlo[8],vhi[8]; u32x4 pw0,pw1,pw2,pw3;
  #define PKW(P,B) cvtpk_s(P[B],P[B+1])
  #define PAF(k) __builtin_bit_cast(bf16x8,pw##k)
  #define VFR(i) (bf16x8){vlo[i][0],vlo[i][1],vlo[i][2],vlo[i][3],vhi[i][0],vhi[i][1],vhi[i][2],vhi[i][3]}
  #define PIN(x) asm volatile("":"+v"(x))
  #define MX3(a,b,c) __builtin_fmaxf(__builtin_fmaxf((a),(b)),(c))
  #define GAPA(MF,A0,A1,A2,A3,W0,W1,PW) do{ MF; sacc+=A0; sacc+=A1; sacc+=A2; sacc+=A3; PIN(sacc); W0; W1; PIN(PW); SBAR(); }while(0)
  #define EX(v) __builtin_amdgcn_exp2f(v)
  #define GAPB(MF,X,B) do{ MF; X[B]=EX(X[B]); X[B+1]=EX(X[B+1]); X[B+2]=EX(X[B+2]); X[B+3]=EX(X[B+3]); PIN(X); SBAR(); }while(0)
  #define VRD(i) do{ vlo[i]=vtr(vp_+(((i)>>2)*4096+((i)&3)*1024)); vhi[i]=vtr(vp_+(((i)>>2)*4096+((i)&3)*1024+512)); }while(0)
  #define KRD(G,j) do{ if(G){ kload2(kf,kp0+sl_next,j); SBAR(); } }while(0)
  #define STEP(C0,C1,P0,P1,t,GK,GV,GL,SL) do{ SBAR(); \
    const lds_cptr vp_=vp0+sl_prev; \
    VRD(0); SBAR(); float sacc=(P0[0]+P0[1]); \
    GAPA(C0=__builtin_amdgcn_mfma_f32_32x32x16_bf16(kf[0],qr[0],negm,0,0,0), P0[2],P0[3],P0[4],P0[5],     pw0[0]=PKW(P0,0), pw0[1]=PKW(P0,2), pw0); \
    VRD(4); SBAR(); GAPA(C1=__builtin_amdgcn_mfma_f32_32x32x16_bf16(kf[1],qr[0],negm,0,0,0), P0[6],P0[7],P0[8],P0[9],     pw0[2]=PKW(P0,4), pw0[3]=PKW(P0,6), pw0); \
    VRD(1); SBAR(); GAPA(C0=__builtin_amdgcn_mfma_f32_32x32x16_bf16(kf[2],qr[1],C0,0,0,0),   P0[10],P0[11],P0[12],P0[13], pw1[0]=PKW(P0,8), pw1[1]=PKW(P0,10), pw1); \
    VRD(5); SBAR(); GAPA(C1=__builtin_amdgcn_mfma_f32_32x32x16_bf16(kf[3],qr[1],C1,0,0,0),   P0[14],P0[15],P1[0],P1[1],   pw1[2]=PKW(P0,12),pw1[3]=PKW(P0,14), pw1); \
    VRD(2); SBAR(); GAPA(C0=__builtin_amdgcn_mfma_f32_32x32x16_bf16(kf[4],qr[2],C0,0,0,0),   P1[2],P1[3],P1[4],P1[5],     pw2[0]=PKW(P1,0), pw2[1]=PKW(P1,2), pw2); \
    VRD(6); SBAR(); GAPA(C1=__builtin_amdgcn_mfma_f32_32x32x16_bf16(kf[5],qr[2],C1,0,0,0),   P1[6],P1[7],P1[8],P1[9],     pw2[2]=PKW(P1,4), pw2[3]=PKW(P1,6), pw2); \
    VRD(3); SBAR(); GAPA(C0=__builtin_amdgcn_mfma_f32_32x32x16_bf16(kf[6],qr[3],C0,0,0,0),   P1[10],P1[11],P1[12],P1[13], pw3[0]=PKW(P1,8), pw3[1]=PKW(P1,10), pw3); \
    VRD(7); SBAR(); GAPA(C1=__builtin_amdgcn_mfma_f32_32x32x16_bf16(kf[7],qr[3],C1,0,0,0),   P1[14],P1[15],0.f,0.f,       pw3[2]=PKW(P1,12),pw3[3]=PKW(P1,14), pw3); \
    l_reg+=sacc; \
    if(GK){DMA_K((t)+3,sl_cur);} if(GV){DMA_V((t)+1,sl_next);} \
    MODT(C0,C1,t,SL); \
    { float a=MX3(C0[0],C0[1],C1[0]),b=MX3(C0[2],C0[3],C1[1]); a=MX3(a,C1[2],C1[3]); \
      _Pragma("unroll") for(int r=4;r<16;r+=4){a=MX3(a,C0[r],C0[r+1]);b=MX3(b,C0[r+2],C0[r+3]);a=MX3(a,C1[r],C1[r+1]);b=MX3(b,C1[r+2],C1[r+3]);} \
      float rm=__builtin_fmaxf(a,b); { auto rr=__builtin_amdgcn_permlane32_swap(__float_as_uint(rm),__float_as_uint(rm),false,false); rm=__builtin_fmaxf(__uint_as_float(rr[0]),__uint_as_float(rr[1])); } \
      resc=false; \
      if(__builtin_expect(__any(rm>(float)THRL),0)){ const float dl=__builtin_fmaxf(rm,0.f); const float nm_=negm[0]-dl; \
        _Pragma("unroll") for(int r=0;r<16;++r){C0[r]-=dl;C1[r]-=dl;} \
        _Pragma("unroll") for(int r=0;r<16;++r)negm[r]=nm_; asm volatile("":"+v"(negm)); \
        const float f=__builtin_amdgcn_exp2f(-dl); l_reg*=f; if(hi==0){ int r32_=r32; asm volatile("":"+v"(r32_)); wsf[r32_]=f; } resc=true; } } \
    SBAR(); \
    GAPB(o[0]=__builtin_amdgcn_mfma_f32_32x32x16_bf16(PAF(0),VFR(0),o[0],0,0,0), C0,0); \
    GAPB(o[1]=__builtin_amdgcn_mfma_f32_32x32x16_bf16(PAF(0),VFR(4),o[1],0,0,0), C0,4); \
    KRD(GL,0); GAPB(o[0]=__builtin_amdgcn_mfma_f32_32x32x16_bf16(PAF(1),VFR(1),o[0],0,0,0), C0,8); \
    KRD(GL,1); GAPB(o[1]=__builtin_amdgcn_mfma_f32_32x32x16_bf16(PAF(1),VFR(5),o[1],0,0,0), C0,12); \
    KRD(GL,2); GAPB(o[0]=__builtin_amdgcn_mfma_f32_32x32x16_bf16(PAF(2),VFR(2),o[0],0,0,0), C1,0); \
    KRD(GL,3); GAPB(o[1]=__builtin_amdgcn_mfma_f32_32x32x16_bf16(PAF(2),VFR(6),o[1],0,0,0), C1,4); \
    GAPB(o[0]=__builtin_amdgcn_mfma_f32_32x32x16_bf16(PAF(3),VFR(3),o[0],0,0,0), C1,8); \
    GAPB(o[1]=__builtin_amdgcn_mfma_f32_32x32x16_bf16(PAF(3),VFR(7),o[1],0,0,0), C1,12); \
    }while(0)
  int t=1;
  #define ENDW(tt) do{ if((tt)+3<NT){WAIT_BAR(2);} else if((tt)+2<NT){WAIT_BAR(1);} else {WAIT_BAR(0);} }while(0)
  for(;t+(MODE==1?5:7)<NT;t+=2){
    STEP(pB0,pB1,pA0,pA1,t,true,true,true,false);     WAIT_BAR(2); RESC(); ROT();
    STEP(pA0,pA1,pB0,pB1,t+1,true,true,true,false);   WAIT_BAR(2); RESC(); ROT();
  }
  for(;t+1<NT;t+=2){
    STEP(pB0,pB1,pA0,pA1,t,(t+3<NT),(t+1<NT),(t+1<NT),true);       ENDW(t);   RESC(); ROT();
    STEP(pA0,pA1,pB0,pB1,t+1,(t+4<NT),(t+2<NT),(t+2<NT),true);     ENDW(t+1); RESC(); ROT();
  }
  STEP(pB0,pB1,pA0,pA1,NT-1,false,false,false,true); RESC();
  { float sacc=pB0[0]+pB0[1]; _Pragma("unroll") for(int r=2;r<16;++r)sacc+=pB0[r]; _Pragma("unroll") for(int r=0;r<16;++r)sacc+=pB1[r]; l_reg+=sacc;
    pw0=(u32x4){PKW(pB0,0),PKW(pB0,2),PKW(pB0,4),PKW(pB0,6)};pw1=(u32x4){PKW(pB0,8),PKW(pB0,10),PKW(pB0,12),PKW(pB0,14)};pw2=(u32x4){PKW(pB1,0),PKW(pB1,2),PKW(pB1,4),PKW(pB1,6)};pw3=(u32x4){PKW(pB1,8),PKW(pB1,10),PKW(pB1,12),PKW(pB1,14)};
    SBAR(); pv(o,vb0+sl_cur,PAF(0),PAF(1),PAF(2),PAF(3)); }
  #undef PKW
  #undef PAF
  #undef VFR
  #undef PIN
  #undef MX3
  #undef GAPA
  #undef GAPB
  #undef EX
  #undef VRD
  #undef KRD
  #undef STEP
  #undef ENDW
  {auto rr=__builtin_amdgcn_permlane32_swap(__float_as_uint(l_reg),__float_as_uint(l_reg),false,false);l_reg=__uint_as_float(rr[0])+__uint_as_float(rr[1]);}
  if(hi==0)wsf[32+r32]=l_reg;asm volatile("s_waitcnt lgkmcnt(0)":::"memory");
  float rli[16];
  #pragma unroll
  for(int r=0;r<16;++r)rli[r]=__builtin_amdgcn_rcpf(wsf[32+crow(r,hi)]);
  bf16*Ow=O+(rowbase+q0+wid*QBLK)*DM+co;
  { bf16*stg=(bf16*)(shm+LDS_OST)+wid*2048;
    #pragma unroll
    for(int r=0;r<16;++r){const int orow=crow(r,hi);
      #pragma unroll
      for(int d0=0;d0<2;++d0)stg[orow*64+d0*32+r32]=__float2bfloat16(o[d0][r]*rli[r]);}
    asm volatile("s_waitcnt lgkmcnt(0)":::"memory");
    #pragma unroll
    for(int i=0;i<4;++i){const int row=i*8+(lane>>3),ch=lane&7; const u32x4 v=*(const u32x4*)(stg+row*64+ch*8); ATTN_STORE16(Ow+(long)row*DM+ch*8,v);} }
  asm volatile("s_waitcnt lgkmcnt(0)\n\ts_barrier":::"memory");
  #undef DMA_K
  #undef DMA_V
  #undef MODT
  #undef START
  #undef RESC
  #undef ROT
}

template<int THRL> __device__ __forceinline__ void attn_unit_dv(int b,int qb,int cq,int cv,int co,const bf16*Q,const bf16*__restrict__ K,const bf16*__restrict__ V,bf16*O,const float*tabsrc,char*shm){
  int tid_=threadIdx.x; asm volatile("":"+v"(tid_));
  constexpr int MODE=0, tb=0; const int tid=tid_,lane=tid&63,r32=lane&31,hi=lane>>5; const int wid=__builtin_amdgcn_readfirstlane(tid>>6);
  constexpr int LDS_K=0, LDS_V=NSLOT*SLOTB, LDS_WS=LDS_V+NSLOT*2*SLOTB, LDS_OST=LDS_WS+NW*64*4, LDS_TAB=LDS_OST+NW*4096;
  static_assert(LDS_TAB+RT_SIZE*4<=131072,"dv LDS map");
  const long rowbase=(long)b*SEQ, rowbase_k=(long)b*KROWS; const int q0=qb*QB;
  const bf16*Qw=Q+(rowbase+q0+wid*QBLK)*DM+cq;
  const bf16*Kh=K+rowbase_k*DM+cq,*Vh=V+rowbase_k*DM+cv;
  const unsigned lds0=(unsigned)(uintptr_t)shm;
  const __attribute__((address_space(3))) char* shm3_=(const __attribute__((address_space(3))) char*)shm;
  float*wsf=(float*)(shm+LDS_WS)+wid*64;
  const bf16*ksrc=Kh+(long)(lane+64*tb)*DM+wid*8;
  const bf16*vsrc=Vh+(long)(16*(wid&3)+(lane>>2)+64*tb)*DM+(wid>>2)*32+(lane&3)*8;
  const unsigned kdst=lds0+LDS_K+wid*1024, vdst=lds0+LDS_V+wid*1024;
  #define DMA_K(t,slot) glds16(ksrc+(long)(t)*KVBLK*DM,(unsigned)__builtin_amdgcn_readfirstlane(kdst+(slot)))
  #define DMA_V(t,slot) do{ glds16(vsrc+(long)(t)*KVBLK*DM,(unsigned)__builtin_amdgcn_readfirstlane(vdst+2*(slot))); glds16(vsrc+(long)(t)*KVBLK*DM+64,(unsigned)__builtin_amdgcn_readfirstlane(vdst+2*(slot)+8192)); }while(0)
  const int vb0=(int)(lds0+LDS_V)+((lane>>4)&1)*32+(lane&3)*8+(4*hi+((lane&15)>>2))*64;
  const char*Kbase=shm+LDS_K; bf16x8 kf[8];
  const lds_cptr shm3=(lds_cptr)shm; const lds_cptr kp0=shm3+LDS_K+hi*1024+r32*16; const lds_cptr vp0=shm3+LDS_V+((lane>>4)&1)*32+(lane&3)*8+(4*hi+((lane&15)>>2))*64;
  const int NT=(KPRE+q0+QB+KVBLK)/KVBLK-tb;
  const __attribute__((address_space(3))) float* tab=(const __attribute__((address_space(3))) float*)(shm3_+LDS_TAB);
  { __attribute__((address_space(3))) float* tw=(__attribute__((address_space(3))) float*)(shm3_+LDS_TAB);
    if(MODE==0){ for(int i=tid;i<RT_SIZE;i+=512){ const int d=i-RT_OFFS; tw[i]=d<0?-INFINITY:(d<128?tabsrc[d]:0.f); } }
    else { const int n=KPRE+q0+QB+KVBLK; for(int i=64*tb+tid*4;i<n;i+=2048){ const float4 v=*(const float4*)(tabsrc+i); tw[i]=v.x;tw[i+1]=v.y;tw[i+2]=v.z;tw[i+3]=v.w; } } }
  if(tb==0){ glds16(K+cq+(long)lane*DM+wid*8,(unsigned)__builtin_amdgcn_readfirstlane(kdst)); glds16(V+cv+(long)(16*(wid&3)+(lane>>2))*DM+(wid>>2)*32+(lane&3)*8,(unsigned)__builtin_amdgcn_readfirstlane(vdst)); glds16(V+cv+(long)(16*(wid&3)+(lane>>2))*DM+(wid>>2)*32+(lane&3)*8+64,(unsigned)__builtin_amdgcn_readfirstlane(vdst+8192)); } else { DMA_K(0,0); DMA_V(0,0); } DMA_K(1,SLOTB);
  bf16x8 qr[4];
  #pragma unroll
  for(int d0=0;d0<4;++d0)qr[d0]=*reinterpret_cast<const bf16x8*>(&Qw[(long)r32*DM+d0*16+hi*8]);
  float mhat=0.f,l_reg=0.f;f32x16 o[4];o[0]=f32x16{};o[1]=f32x16{};o[2]=f32x16{};o[3]=f32x16{};const f32x16 zero16=f32x16{};
  const int qrel=wid*QBLK+r32, q_abs=q0+qrel;
  #define MODT(P0,P1,t,SL) do{ if(SL)modtile_slow<MODE>(P0,P1,(t)+tb,q_abs,q0,hi,tab); else if(MODE==1)modtile_fast1(P0,P1,(t)+tb,hi,tab); }while(0)
  bool resc=false;
  #define START(P0,P1) do{ const float rm=rowmax(P0,P1); resc=false; mhat=rm; \
    _Pragma("unroll") for(int r=0;r<16;++r)P0[r]=__builtin_amdgcn_exp2f(P0[r]-mhat); }while(0)
  #define RESC() do{ if(resc){ asm volatile("s_waitcnt lgkmcnt(0)":::"memory"); \
      _Pragma("unroll") for(int d_=0;d_<4;++d_) _Pragma("unroll") for(int r=0;r<16;++r)o[d_][r]*=wsf[crow(r,hi)]; } }while(0)
  f32x16 pA0,pA1,pB0,pB1;
  int sl_prev=0,sl_cur=0,sl_next=SLOTB;
  #define ROT() do{sl_prev=sl_cur;sl_cur=sl_next;sl_next=(sl_next==(NSLOT-1)*SLOTB)?0:sl_next+SLOTB;}while(0)
  DMA_K(2,2*SLOTB);
  WAIT_BAR(3);
  qkt(pA0,pA1,Kbase,qr,zero16,r32,hi);asm volatile("s_nop 15\n\ts_nop 7":"+v"(pA0),"+v"(pA1));MODT(pA0,pA1,0,true);
  START(pA0,pA1);
  _Pragma("unroll") for(int r=0;r<16;++r)pA1[r]=__builtin_amdgcn_exp2f(pA1[r]-mhat);
  WAIT_BAR(0);
  DMA_K(3,0);DMA_V(1,SLOTB);
  ROT();
  kload8(kf,kp0+sl_cur);
  WAIT_BAR(3);
  s16x4 vlo[8],vhi[8],wlo[8],whi[8]; u32x4 pw0,pw1,pw2,pw3;
  #define PKW(P,B) cvtpk_s(P[B],P[B+1])
  #define PAF(k) __builtin_bit_cast(bf16x8,pw##k)
  #define VFR(i) (bf16x8){vlo[i][0],vlo[i][1],vlo[i][2],vlo[i][3],vhi[i][0],vhi[i][1],vhi[i][2],vhi[i][3]}
  #define WFR(i) (bf16x8){wlo[i][0],wlo[i][1],wlo[i][2],wlo[i][3],whi[i][0],whi[i][1],whi[i][2],whi[i][3]}
  #define WRD(i) do{ wlo[i]=vtr(vp_+((2+((i)>>2))*4096+((i)&3)*1024)); whi[i]=vtr(vp_+((2+((i)>>2))*4096+((i)&3)*1024+512)); SBAR(); }while(0)
  #define GAPB2(MF,X,B) do{ MF; X[B]=EX(X[B]-mhat); X[B+1]=EX(X[B+1]-mhat); PIN(X); SBAR(); }while(0)
  #define PIN(x) asm volatile("":"+v"(x))
  #define MX3(a,b,c) __builtin_fmaxf(__builtin_fmaxf((a),(b)),(c))
  #define GAPA(MF,A0,A1,A2,A3,W0,W1,PW) do{ MF; sacc+=A0; sacc+=A1; sacc+=A2; sacc+=A3; PIN(sacc); W0; W1; PIN(PW); SBAR(); }while(0)
  #define EX(v) __builtin_amdgcn_exp2f(v)
  #define GAPB(MF,X,B) do{ MF; X[B]=EX(X[B]); X[B+1]=EX(X[B+1]); X[B+2]=EX(X[B+2]); X[B+3]=EX(X[B+3]); PIN(X); SBAR(); }while(0)
  #define VRD(i) do{ vlo[i]=vtr(vp_+(((i)>>2)*4096+((i)&3)*1024)); vhi[i]=vtr(vp_+(((i)>>2)*4096+((i)&3)*1024+512)); }while(0)
  #define KRD(G,j) do{ if(G){ kload2(kf,kp0+sl_next,j); SBAR(); } }while(0)
  #define STEP(C0,C1,P0,P1,t,GK,GV,GL,SL) do{ SBAR(); \
    const lds_cptr vp_=vp0+2*sl_prev; \
    VRD(0); SBAR(); float sacc=(P0[0]+P0[1]); \
    GAPA(C0=__builtin_amdgcn_mfma_f32_32x32x16_bf16(kf[0],qr[0],zero16,0,0,0), P0[2],P0[3],P0[4],P0[5],     pw0[0]=PKW(P0,0), pw0[1]=PKW(P0,2), pw0); \
    VRD(4); SBAR(); GAPA(C1=__builtin_amdgcn_mfma_f32_32x32x16_bf16(kf[1],qr[0],zero16,0,0,0), P0[6],P0[7],P0[8],P0[9],     pw0[2]=PKW(P0,4), pw0[3]=PKW(P0,6), pw0); \
    VRD(1); SBAR(); GAPA(C0=__builtin_amdgcn_mfma_f32_32x32x16_bf16(kf[2],qr[1],C0,0,0,0),   P0[10],P0[11],P0[12],P0[13], pw1[0]=PKW(P0,8), pw1[1]=PKW(P0,10), pw1); \
    VRD(5); SBAR(); GAPA(C1=__builtin_amdgcn_mfma_f32_32x32x16_bf16(kf[3],qr[1],C1,0,0,0),   P0[14],P0[15],P1[0],P1[1],   pw1[2]=PKW(P0,12),pw1[3]=PKW(P0,14), pw1); \
    VRD(2); SBAR(); GAPA(C0=__builtin_amdgcn_mfma_f32_32x32x16_bf16(kf[4],qr[2],C0,0,0,0),   P1[2],P1[3],P1[4],P1[5],     pw2[0]=PKW(P1,0), pw2[1]=PKW(P1,2), pw2); \
    VRD(6); SBAR(); GAPA(C1=__builtin_amdgcn_mfma_f32_32x32x16_bf16(kf[5],qr[2],C1,0,0,0),   P1[6],P1[7],P1[8],P1[9],     pw2[2]=PKW(P1,4), pw2[3]=PKW(P1,6), pw2); \
    VRD(3); SBAR(); GAPA(C0=__builtin_amdgcn_mfma_f32_32x32x16_bf16(kf[6],qr[3],C0,0,0,0),   P1[10],P1[11],P1[12],P1[13], pw3[0]=PKW(P1,8), pw3[1]=PKW(P1,10), pw3); \
    VRD(7); SBAR(); GAPA(C1=__builtin_amdgcn_mfma_f32_32x32x16_bf16(kf[7],qr[3],C1,0,0,0),   P1[14],P1[15],0.f,0.f,       pw3[2]=PKW(P1,12),pw3[3]=PKW(P1,14), pw3); \
    l_reg+=sacc; \
    if(GK){DMA_K((t)+3,sl_cur);} if(GV){DMA_V((t)+1,sl_next);} \
    MODT(C0,C1,t,SL); \
    { float a=MX3(C0[0],C0[1],C1[0]),b=MX3(C0[2],C0[3],C1[1]); a=MX3(a,C1[2],C1[3]); \
      _Pragma("unroll") for(int r=4;r<16;r+=4){a=MX3(a,C0[r],C0[r+1]);b=MX3(b,C0[r+2],C0[r+3]);a=MX3(a,C1[r],C1[r+1]);b=MX3(b,C1[r+2],C1[r+3]);} \
      float rm=__builtin_fmaxf(a,b); { auto rr=__builtin_amdgcn_permlane32_swap(__float_as_uint(rm),__float_as_uint(rm),false,false); rm=__builtin_fmaxf(__uint_as_float(rr[0]),__uint_as_float(rr[1])); } \
      resc=false; \
      const float rmd=rm-mhat; \
      if(__builtin_expect(__any(rmd>(float)THRL),0)){ const float dl=__builtin_fmaxf(rmd,0.f); mhat+=dl; \
        const float f=__builtin_amdgcn_exp2f(-dl); l_reg*=f; if(hi==0)wsf[r32]=f; resc=true; } } \
    SBAR(); \
    WRD(0); GAPB2(o[0]=__builtin_amdgcn_mfma_f32_32x32x16_bf16(PAF(0),VFR(0),o[0],0,0,0), C0,0); \
    WRD(4); GAPB2(o[1]=__builtin_amdgcn_mfma_f32_32x32x16_bf16(PAF(0),VFR(4),o[1],0,0,0), C0,2); \
    WRD(1); GAPB2(o[0]=__builtin_amdgcn_mfma_f32_32x32x16_bf16(PAF(1),VFR(1),o[0],0,0,0), C0,4); \
    WRD(5); GAPB2(o[1]=__builtin_amdgcn_mfma_f32_32x32x16_bf16(PAF(1),VFR(5),o[1],0,0,0), C0,6); \
    WRD(2); GAPB2(o[0]=__builtin_amdgcn_mfma_f32_32x32x16_bf16(PAF(2),VFR(2),o[0],0,0,0), C0,8); \
    WRD(6); GAPB2(o[1]=__builtin_amdgcn_mfma_f32_32x32x16_bf16(PAF(2),VFR(6),o[1],0,0,0), C0,10); \
    WRD(3); GAPB2(o[0]=__builtin_amdgcn_mfma_f32_32x32x16_bf16(PAF(3),VFR(3),o[0],0,0,0), C0,12); \
    WRD(7); GAPB2(o[1]=__builtin_amdgcn_mfma_f32_32x32x16_bf16(PAF(3),VFR(7),o[1],0,0,0), C0,14); \
    KRD(GL,0); GAPB2(o[2]=__builtin_amdgcn_mfma_f32_32x32x16_bf16(PAF(0),WFR(0),o[2],0,0,0), C1,0); \
    KRD(GL,1); GAPB2(o[3]=__builtin_amdgcn_mfma_f32_32x32x16_bf16(PAF(0),WFR(4),o[3],0,0,0), C1,2); \
    KRD(GL,2); GAPB2(o[2]=__builtin_amdgcn_mfma_f32_32x32x16_bf16(PAF(1),WFR(1),o[2],0,0,0), C1,4); \
    KRD(GL,3); GAPB2(o[3]=__builtin_amdgcn_mfma_f32_32x32x16_bf16(PAF(1),WFR(5),o[3],0,0,0), C1,6); \
    GAPB2(o[2]=__builtin_amdgcn_mfma_f32_32x32x16_bf16(PAF(2),WFR(2),o[2],0,0,0), C1,8); \
    GAPB2(o[3]=__builtin_amdgcn_mfma_f32_32x32x16_bf16(PAF(2),WFR(6),o[3],0,0,0), C1,10); \
    GAPB2(o[2]=__builtin_amdgcn_mfma_f32_32x32x16_bf16(PAF(3),WFR(3),o[2],0,0,0), C1,12); \
    GAPB2(o[3]=__builtin_amdgcn_mfma_f32_32x32x16_bf16(PAF(3),WFR(7),o[3],0,0,0), C1,14); \
    }while(0)
  int t=1;
  #define ENDW(tt) do{ if((tt)+3<NT){WAIT_BAR(3);} else if((tt)+2<NT){WAIT_BAR(2);} else {WAIT_BAR(0);} }while(0)
  for(;t+(MODE==1?5:7)<NT;t+=2){
    STEP(pB0,pB1,pA0,pA1,t,true,true,true,false);     WAIT_BAR(3); RESC(); ROT();
    STEP(pA0,pA1,pB0,pB1,t+1,true,true,true,false);   WAIT_BAR(3); RESC(); ROT();
  }
  for(;t+1<NT;t+=2){
    STEP(pB0,pB1,pA0,pA1,t,(t+3<NT),(t+1<NT),(t+1<NT),true);       ENDW(t);   RESC(); ROT();
    STEP(pA0,pA1,pB0,pB1,t+1,(t+4<NT),(t+2<NT),(t+2<NT),true);     ENDW(t+1); RESC(); ROT();
  }
  STEP(pB0,pB1,pA0,pA1,NT-1,false,false,false,true); RESC();
  { float sacc=pB0[0]+pB0[1]; _Pragma("unroll") for(int r=2;r<16;++r)sacc+=pB0[r]; _Pragma("unroll") for(int r=0;r<16;++r)sacc+=pB1[r]; l_reg+=sacc;
    pw0=(u32x4){PKW(pB0,0),PKW(pB0,2),PKW(pB0,4),PKW(pB0,6)};pw1=(u32x4){PKW(pB0,8),PKW(pB0,10),PKW(pB0,12),PKW(pB0,14)};pw2=(u32x4){PKW(pB1,0),PKW(pB1,2),PKW(pB1,4),PKW(pB1,6)};pw3=(u32x4){PKW(pB1,8),PKW(pB1,10),PKW(pB1,12),PKW(pB1,14)};
    SBAR(); pv(o,vb0+2*sl_cur,PAF(0),PAF(1),PAF(2),PAF(3)); pv(o+2,vb0+2*sl_cur+8192,PAF(0),PAF(1),PAF(2),PAF(3)); }
  #undef PKW
  #undef PAF
  #undef VFR
  #undef PIN
  #undef MX3
  #undef GAPA
  #undef GAPB
  #undef EX
  #undef VRD
  #undef WRD
  #undef WFR
  #undef GAPB2
  #undef KRD
  #undef STEP
  #undef ENDW
  {auto rr=__builtin_amdgcn_permlane32_swap(__float_as_uint(l_reg),__float_as_uint(l_reg),false,false);l_reg=__uint_as_float(rr[0])+__uint_as_float(rr[1]);}
  if(hi==0)wsf[32+r32]=l_reg;asm volatile("s_waitcnt lgkmcnt(0)":::"memory");
  float rli[16];
  #pragma unroll
  for(int r=0;r<16;++r)rli[r]=__builtin_amdgcn_rcpf(wsf[32+crow(r,hi)]);
  bf16*Ow=O+(rowbase+q0+wid*QBLK)*DM+co;
  { bf16*stg=(bf16*)(shm+LDS_OST)+wid*2048;
    #pragma unroll
    for(int ps=0;ps<2;++ps){
      #pragma unroll
      for(int r=0;r<16;++r){const int orow=crow(r,hi);
        #pragma unroll
        for(int d0=0;d0<2;++d0)stg[orow*64+d0*32+r32]=__float2bfloat16(o[2*ps+d0][r]*rli[r]);}
      asm volatile("s_waitcnt lgkmcnt(0)":::"memory");
      #pragma unroll
      for(int i=0;i<4;++i){const int row=i*8+(lane>>3),ch=lane&7; const u32x4 v=*(const u32x4*)(stg+row*64+ch*8); ATTN_STORE16(Ow+(long)row*DM+ps*64+ch*8,v);}
      asm volatile("s_waitcnt lgkmcnt(0)":::"memory"); } }
  asm volatile("s_waitcnt lgkmcnt(0)\n\ts_barrier":::"memory");
  #undef DMA_K
  #undef DMA_V
  #undef MODT
  #undef START
  #undef RESC
  #undef ROT
}
constexpr int ATTN_LDS_BYTES=LDS_BYTES;
#undef SBAR
#undef WAIT_BAR
}
#define GAS __attribute__((address_space(1)))
#define LAS __attribute__((address_space(3)))
typedef unsigned short bf16;
typedef unsigned v4u __attribute__((ext_vector_type(4)));
typedef float f32x4 __attribute__((ext_vector_type(4)));
typedef short bf16x8 __attribute__((ext_vector_type(8)));
typedef GAS unsigned gu32;
typedef GAS unsigned long long gu64;
#define RLX_AGENT __ATOMIC_RELAXED, __HIP_MEMORY_SCOPE_AGENT
#define LDS_WAIT() asm volatile("s_waitcnt lgkmcnt(0)" ::: "memory")
#define VM_WAIT() asm volatile("s_waitcnt vmcnt(0)" ::: "memory")
__device__ __forceinline__ unsigned long long rt() { return __builtin_amdgcn_s_memrealtime(); }
__device__ __forceinline__ unsigned f2bf(float f) { unsigned u = __builtin_bit_cast(unsigned, f); return (u + 0x7fffu + ((u >> 16) & 1u)) >> 16; }
__device__ __forceinline__ unsigned pk2(float lo, float hi) { return f2bf(lo) | (f2bf(hi) << 16); }

#define XB_TMO      128
#define XB_XCNT(j)  (256  + 64 * (j))
#define XB_XSUB(j)  (1280 + 64 * (j))
#define XB_XGEN(j)  (2304 + 64 * (j))
#define XB_TOP      3328
#define XB_TOPGEN   3392
#define XCD_BAR_WORDS 3456
#define XB_SPIN_CAP (1u << 18)

__device__ __forceinline__ unsigned xb_ld(unsigned* p)              { return __hip_atomic_load(p, __ATOMIC_RELAXED, __HIP_MEMORY_SCOPE_AGENT); }
__device__ __forceinline__ unsigned xb_add(unsigned* p, unsigned v) { return __hip_atomic_fetch_add(p, v, __ATOMIC_RELAXED, __HIP_MEMORY_SCOPE_AGENT); }
__device__ __forceinline__ unsigned xb_xcc_id() { return (unsigned)__builtin_amdgcn_s_getreg((3 << 11) | 20) & 0xFu; }
#define XB_SPIN(cond, bar) do { unsigned _sp = 0; while (cond) { __builtin_amdgcn_s_sleep(1); \
    if ((++_sp & 255u) == 0u) { if (xb_ld(&(bar)[XB_TMO])) break; if (_sp > XB_SPIN_CAP) { atomicAdd(&(bar)[XB_TMO], 1u); break; } } } } while (0)

struct XcdBarrier {
    unsigned* bar; unsigned x;
    volatile LAS unsigned* st;
};

__device__ __forceinline__ XcdBarrier xcd_barrier_post(unsigned* bar, volatile LAS unsigned* st) {
    XcdBarrier b; b.bar = bar; b.x = xb_xcc_id(); b.st = st;
    if (threadIdx.x == 0) (void)xb_add(&bar[XB_XCNT(b.x)], 1u);
    return b;
}
__device__ __forceinline__ void xcd_barrier_complete(unsigned* bar, unsigned x, unsigned& nloc, unsigned& nx) {
    const unsigned G = gridDim.x * gridDim.y * gridDim.z;
    unsigned sum, cnt, mine, sp = 0u;
    for (;;) {
        sum = 0u; cnt = 0u; mine = 0u;
#pragma unroll
        for (unsigned j = 0; j < 16; ++j) { const unsigned c = xb_ld(&bar[XB_XCNT(j)]); sum += c; cnt += (c > 0u) ? 1u : 0u; mine = (j == x) ? c : mine; }
        if (sum == G) break;
        __builtin_amdgcn_s_sleep(1);
        if ((++sp & 255u) == 0u) { if (xb_ld(&bar[XB_TMO])) break; if (sp > XB_SPIN_CAP) { atomicAdd(&bar[XB_TMO], 1u); break; } }
    }
    nloc = mine > 0u ? mine : 1u; nx = cnt > 0u ? cnt : 1u;
}

__device__ __forceinline__ void xcd_barrier(const XcdBarrier& b) {
    asm volatile("s_waitcnt vmcnt(0)" ::: "memory");
    __syncthreads();
    if (threadIdx.x == 0) {
        unsigned* bar = b.bar;
        __builtin_amdgcn_s_waitcnt(0);
        unsigned nloc = b.st[0], nx = b.st[1];
        if (nloc == 0u) { xcd_barrier_complete(bar, b.x, nloc, nx); b.st[0] = nloc; b.st[1] = nx; }
        const unsigned old = xb_add(&bar[XB_XSUB(b.x)], 1u);
        const unsigned gen = old / nloc;
        if (old + 1u == (gen + 1u) * nloc) {
            __builtin_amdgcn_fence(__ATOMIC_RELEASE, "agent");
            asm volatile("s_waitcnt vmcnt(0)" ::: "memory");
            const unsigned og = xb_add(&bar[XB_TOP], 1u);
            const unsigned tg = og / nx;
            if (og + 1u == (tg + 1u) * nx) xb_add(&bar[XB_TOPGEN], 1u);
            else XB_SPIN(xb_ld(&bar[XB_TOPGEN]) == tg, bar);
            __builtin_amdgcn_fence(__ATOMIC_ACQUIRE, "agent");
            xb_add(&bar[XB_XGEN(b.x)], 1u);
            asm volatile("s_waitcnt vmcnt(0)" ::: "memory");
        } else {
            XB_SPIN(xb_ld(&bar[XB_XGEN(b.x)]) == gen, bar);
            __builtin_amdgcn_fence(__ATOMIC_ACQUIRE, "agent");
            asm volatile("s_waitcnt vmcnt(0)" ::: "memory");
        }
    }
    __syncthreads();
}

constexpr int NWAVES = 8;
#ifndef MK_PER_PHASE
#define MK_PER_PHASE 0
#endif
constexpr int N_PHASES = 16;

constexpr size_t MiB = 1u << 20;
constexpr size_t WS_CTL = 0, CTL_ZERO_BYTES = 1 * MiB;
constexpr size_t WS_GV = 1 * MiB + 512 * 1024;
constexpr size_t WS_HM = 2 * MiB;
constexpr size_t WS_TAB = 2 * MiB + 256 * 1024;
constexpr size_t WS_LF = 3 * MiB;
constexpr size_t WS_DK = 6 * MiB;
constexpr size_t WS_LIST = 9 * MiB;
constexpr int LCAP = NSLOT;
constexpr size_t WS_WQKV0 = 18 * MiB, WS_WO0 = 24 * MiB, WS_WQKV1 = 26 * MiB, WS_WO1 = 32 * MiB, WS_WGU = 34 * MiB, WS_WD = 98 * MiB;
constexpr size_t WS_XH = 130 * MiB;
constexpr size_t WS_Q = 195 * MiB;
constexpr size_t WS_K = 260 * MiB, WS_V = 325 * MiB;
constexpr size_t WS_O0 = 390 * MiB;
constexpr size_t WS_END = 455 * MiB;
static_assert(WS_LIST + (size_t)NEXP * LCAP * 4 <= WS_WQKV0 && WS_DK + (size_t)NBATCH * 16 * KROWS * 4 <= WS_LIST && WS_LF + (size_t)NRP * 16 * 4 <= WS_DK, "small arrays");
static_assert(WS_XH + (size_t)NRP * DM * 2 <= WS_Q && WS_Q + (size_t)NRP * DM * 2 <= WS_K && WS_K + (size_t)NBATCH * KROWS * DM * 2 <= WS_V && WS_V + (size_t)NBATCH * KROWS * DM * 2 <= WS_O0 && WS_O0 + (size_t)NRP * DM * 2 <= WS_END, "activations");
static_assert(WS_K + (size_t)NSLOT * DM * 2 <= WS_O0 && WS_O0 + (size_t)NSLOT * DEXP * 2 <= WS_END, "MoE overlays");
constexpr int CW_TMO = 0, CW_CODE = 1;
constexpr int CW_BAR = 4096;
constexpr int CW_QM = 131072, CW_KM = 147456, CW_QCTR = 148480;
constexpr int CW_CNT = 65536;
constexpr int RING_OFF = 0, RING_BYTES = 131072;
constexpr int ROWTAB_OFF = RING_BYTES, ROWTAB_UNITS = 12;
constexpr int MOEPRE_OFF = ROWTAB_OFF + ROWTAB_UNITS * 1024;
constexpr int MISC_OFF = MOEPRE_OFF + 512;
constexpr int LDS_BYTES = 147456;
static_assert(MISC_OFF + 128 <= LDS_BYTES && attn_body::ATTN_LDS_BYTES <= RING_BYTES, "LDS map");

struct Params {
    const float *x, *meta, *rel_bias, *w_qkv, *lam, *subln, *w_o, *fox_w_in, *fox_b_f, *fox_w_o, *ln_mix_g, *ln_mix_b, *ln_ffn_g, *ln_ffn_b, *rg_w, *rg_b, *re_w, *re_b, *w_gate, *w_up, *w_down;
    float* out; unsigned char* ws; int ph_lo, ph_hi, li, pad;
};
struct Ctx { int tid, lane, wave, vcu, G; LAS unsigned char* lds; };
__device__ __forceinline__ Ctx fresh(const Ctx& C) { Ctx r = C; int t = threadIdx.x; asm volatile("" : "+v"(t)); r.tid = t; r.lane = t & 63; r.wave = __builtin_amdgcn_readfirstlane(t >> 6); return r; }

using pg8::shx;
__device__ __forceinline__ float wave_sum(float v, int lane) {
#pragma unroll
    for (int o = 1; o < 64; o <<= 1) v += shx(v, o, lane);
    return v;
}
__device__ __forceinline__ float bf2f(unsigned short h) { return __uint_as_float((unsigned)h << 16); }
__device__ __forceinline__ float bflo(unsigned w) { return __uint_as_float(w << 16); }
__device__ __forceinline__ float bfhi(unsigned w) { return __uint_as_float(w & 0xffff0000u); }
__device__ __forceinline__ int meta_slot(int j) { return j; }

__device__ __forceinline__ void tr_item(const float* W, int ldw, int k0, int n0, bf16* WT, int ldt, int drow0, LAS float* scr, int lane) {
#pragma unroll 8
    for (int i = 0; i < 32; ++i) { const int kk = 2 * i + (lane >> 5); scr[kk * 33 + (lane & 31)] = W[(size_t)(k0 + kk) * ldw + n0 + (lane & 31)]; }
    LDS_WAIT(); asm volatile("" ::: "memory");
    const int c = lane & 7;
#pragma unroll
    for (int j = 0; j < 4; ++j) { const int n = (lane >> 3) + 8 * j; const LAS float* s = scr + (8 * c) * 33 + n;
        v4u o; o.x = pk2(s[0 * 33], s[1 * 33]); o.y = pk2(s[2 * 33], s[3 * 33]); o.z = pk2(s[4 * 33], s[5 * 33]); o.w = pk2(s[6 * 33], s[7 * 33]);
        *(GAS v4u*)(WT + (size_t)(drow0 + n) * ldt + k0 + 8 * c) = o; }
    LDS_WAIT(); asm volatile("" ::: "memory");
}
__device__ __forceinline__ void convert_experts(const Params& p, const Ctx& C, int layer, int first_item, int gw, int NGW) {
    LAS float* scr = (LAS float*)(C.lds + RING_OFF + C.wave * 16384);
    bf16* Wgu = (bf16*)(p.ws + WS_WGU); bf16* Wd = (bf16*)(p.ws + WS_WD);
    constexpr int PER_E = 768, NIT = NEXP * PER_E;
    for (int it = gw - first_item; it < NIT; it += NGW) { if (it < 0) continue;
        const int e = it / PER_E; int r = it % PER_E; const size_t eo = (size_t)(layer * NEXP + e);
        if (r < 512) { const bool up = r >= 256; r &= 255; const int kb = r >> 4, nb = r & 15, n0 = 32 * nb;
            tr_item((up ? p.w_up : p.w_gate) + eo * DM * DEXP, DEXP, 64 * kb, n0, Wgu + (size_t)e * DM * DM, DM, (n0 >> 7) * 256 + (n0 & 127) + (up ? 128 : 0), scr, C.lane); }
        else { r -= 512; const int kb = r >> 5, nb = r & 31;
            tr_item(p.w_down + eo * DEXP * DM, DM, 64 * kb, 32 * nb, Wd + (size_t)e * DM * DEXP, DEXP, 32 * nb, scr, C.lane); } }
}
__device__ __forceinline__ void p0_prologue(const Params& p, const Ctx& C) {
    LAS float* scr = (LAS float*)(C.lds + RING_OFF + C.wave * 16384);
    const int gw = C.vcu * NWAVES + C.wave, NGW = C.G * NWAVES;
    for (int it = gw; it < 4096; it += NGW) { int r = it;
        if (r < 1536) { tr_item(p.w_qkv, 3072, 64 * (r / 96), 32 * (r % 96), (bf16*)(p.ws + WS_WQKV0), DM, 32 * (r % 96), scr, C.lane); continue; } r -= 1536;
        if (r < 512) { tr_item(p.w_o, DM, 64 * (r >> 5), 32 * (r & 31), (bf16*)(p.ws + WS_WO0), DM, 32 * (r & 31), scr, C.lane); continue; } r -= 512;
        if (r < 1536) { tr_item(p.fox_w_in, 3088, 64 * (r / 96), 32 * (r % 96), (bf16*)(p.ws + WS_WQKV1), DM, 32 * (r % 96), scr, C.lane); continue; } r -= 1536;
        tr_item(p.fox_w_o, DM, 64 * (r >> 5), 32 * (r & 31), (bf16*)(p.ws + WS_WO1), DM, 32 * (r & 31), scr, C.lane); }
    convert_experts(p, C, 0, 0, gw, NGW);
    bf16* XH = (bf16*)(p.ws + WS_XH);
    for (int m = gw; m < NRP; m += NGW) {
        GAS unsigned long long* o8 = (GAS unsigned long long*)(XH + (size_t)m * DM) + C.lane;
        if (m < NR) { const GAS f32x4* xr = (const GAS f32x4*)(m < NREAL ? p.x + (size_t)m * DM : p.meta + (size_t)(m - NREAL) * DM) + C.lane;
#pragma unroll
            for (int j = 0; j < 4; ++j) { const f32x4 v = xr[64 * j]; o8[64 * j] = (unsigned long long)pk2(v.x, v.y) | ((unsigned long long)pk2(v.z, v.w) << 32); } }
        else {
#pragma unroll
            for (int j = 0; j < 4; ++j) o8[64 * j] = 0ull; } }
    { const int gt = C.vcu * (NWAVES * 64) + C.tid;
      if (gt < 16 * 128) { const int m = gt >> 7, d = gt & 127; int bk = d;
          if (d >= 16) { bk = 16 + (d >= 19) + (d >= 21) + (d >= 24) + (d >= 27) + (d >= 31) + (d >= 35) + (d >= 40) + (d >= 46) + (d >= 52) + (d >= 59) + (d >= 67) + (d >= 77) + (d >= 87) + (d >= 99) + (d >= 113); }
          ((float*)(p.ws + WS_TAB))[gt] = (p.rel_bias[bk * 16 + m] - p.rel_bias[31 * 16 + m]) * LOG2E; } }
}

__device__ __forceinline__ float diff_lambda_full(const Params& p, int lane) {
    const float a = p.lam[lane] * p.lam[64 + lane], b = p.lam[128 + lane] * p.lam[192 + lane];
    return __expf(wave_sum(a, lane)) - __expf(wave_sum(b, lane)) + LAMBDA_INIT0;
}
__device__ __forceinline__ void combine_rows(const Params& p, const Ctx& C, int b, int h, int qb, float lam) {
    const int lane = C.lane;
    const bf16* O0 = (const bf16*)(p.ws + WS_O0); const bf16* O1 = (const bf16*)p.out; bf16* OA = (bf16*)(p.ws + WS_Q);
    float sw[8];
#pragma unroll
    for (int c = 0; c < 8; ++c) sw[c] = p.subln[8 * (lane & 15) + c] * (1.f - LAMBDA_INIT0);
    asm volatile("s_waitcnt vmcnt(0)" ::: "memory");
#pragma unroll 2
    for (int i = 0; i < 8; ++i) { const size_t off = (size_t)(b * SEQ + 256 * qb + 32 * C.wave + 4 * i + (lane >> 4)) * DM + h * 128 + 8 * (lane & 15);
        const v4u a = *(const GAS v4u*)(O0 + off), bq = *(const GAS v4u*)(O1 + off);
        float dd[8]; const unsigned aw[4] = {a.x, a.y, a.z, a.w}, bw[4] = {bq.x, bq.y, bq.z, bq.w}; float ss = 0.f;
#pragma unroll
        for (int c = 0; c < 4; ++c) { dd[2 * c] = bflo(aw[c]) - lam * bflo(bw[c]); dd[2 * c + 1] = bfhi(aw[c]) - lam * bfhi(bw[c]); ss += dd[2 * c] * dd[2 * c] + dd[2 * c + 1] * dd[2 * c + 1]; }
        ss += shx(ss, 1, lane); ss += shx(ss, 2, lane); ss += shx(ss, 4, lane); ss += shx(ss, 8, lane);
        const float rs = 1.f / sqrtf(ss * (1.f / 128.f) + LN_EPS);
        v4u o; o.x = pk2(dd[0] * rs * sw[0], dd[1] * rs * sw[1]); o.y = pk2(dd[2] * rs * sw[2], dd[3] * rs * sw[3]); o.z = pk2(dd[4] * rs * sw[4], dd[5] * rs * sw[5]); o.w = pk2(dd[6] * rs * sw[6], dd[7] * rs * sw[7]);
        *(GAS v4u*)(OA + off) = o; }
}
__device__ __forceinline__ void diff_meta_attn(const Params& p, const Ctx& C, float lam) {
    const int gw = C.vcu * NWAVES + C.wave, lane = C.lane; bf16* OA = (bf16*)(p.ws + WS_Q);
    if (gw < 128) { const int h = gw >> 4, j = gw & 15, kj = lane & 15, s = (lane >> 4) & 1, m = 2 * h + s;
        const bf16* Q = (const bf16*)(p.ws + WS_Q); const bf16* K = (const bf16*)(p.ws + WS_K); const bf16* V = (const bf16*)(p.ws + WS_V);
        const bf16* qp = Q + (size_t)(NREAL + j) * DM + m * 64; const bf16* kp = K + (size_t)meta_slot(kj) * DM + m * 64;
        float dot = 0.f;
#pragma unroll
        for (int c = 0; c < 8; ++c) { const v4u qa = *(const GAS v4u*)(qp + 8 * c), ka = *(const GAS v4u*)(kp + 8 * c); const unsigned qw[4] = {qa.x, qa.y, qa.z, qa.w}, kw[4] = {ka.x, ka.y, ka.z, ka.w};
#pragma unroll
            for (int e = 0; e < 4; ++e) dot += bflo(qw[e]) * bflo(kw[e]) + bfhi(qw[e]) * bfhi(kw[e]); }
        float sc = (kj <= j) ? dot + p.rel_bias[(j - kj) * 16 + m] * LOG2E : -INFINITY;
        float mx = sc; mx = fmaxf(mx, shx(mx, 1, lane)); mx = fmaxf(mx, shx(mx, 2, lane)); mx = fmaxf(mx, shx(mx, 4, lane)); mx = fmaxf(mx, shx(mx, 8, lane));
        float pe = __builtin_amdgcn_exp2f(sc - mx); float l = pe; l += shx(l, 1, lane); l += shx(l, 2, lane); l += shx(l, 4, lane); l += shx(l, 8, lane);
        pe /= l;
        const float a = pe - lam * shx(pe, 16, lane);
        float o0 = 0.f, o1 = 0.f;
        for (int k2 = 0; k2 <= j; ++k2) { const float ak = __builtin_amdgcn_readlane(a, k2); const unsigned vw = *(const GAS unsigned*)(V + (size_t)meta_slot(k2) * DM + h * 128 + 2 * lane); o0 += ak * bflo(vw); o1 += ak * bfhi(vw); }
        const float ss = wave_sum(o0 * o0 + o1 * o1, lane); const float rs = 1.f / sqrtf(ss * (1.f / 128.f) + LN_EPS);
        const float w0 = p.subln[2 * lane] * (1.f - LAMBDA_INIT0), w1 = p.subln[2 * lane + 1] * (1.f - LAMBDA_INIT0);
        *(GAS unsigned*)(OA + (size_t)(NREAL + j) * DM + h * 128 + 2 * lane) = pk2(o0 * rs * w0, o1 * rs * w1); }
}
__device__ __forceinline__ void fox_meta_attn(const Params& p, const Ctx& C) {
    const int gw = C.vcu * NWAVES + C.wave, lane = C.lane;
    if (gw < 256) { const int h = gw >> 4, j = gw & 15, kj = lane & 15;
        bf16* Q = (bf16*)(p.ws + WS_Q); const bf16* K = (const bf16*)(p.ws + WS_K); const bf16* V = (const bf16*)(p.ws + WS_V); const float* DK = (const float*)(p.ws + WS_DK) + (size_t)h * KROWS;
        const bf16* qp = Q + (size_t)(NREAL + j) * DM + h * 64; const bf16* kp = K + (size_t)meta_slot(kj) * DM + h * 64;
        float dot = 0.f;
#pragma unroll
        for (int c = 0; c < 8; ++c) { const v4u qa = *(const GAS v4u*)(qp + 8 * c), ka = *(const GAS v4u*)(kp + 8 * c); const unsigned qw[4] = {qa.x, qa.y, qa.z, qa.w}, kw[4] = {ka.x, ka.y, ka.z, ka.w};
#pragma unroll
            for (int e = 0; e < 4; ++e) dot += bflo(qw[e]) * bflo(kw[e]) + bfhi(qw[e]) * bfhi(kw[e]); }
        float sc = (kj <= j) ? dot + DK[meta_slot(kj)] - DK[meta_slot(j)] : -INFINITY;
        float mx = sc; mx = fmaxf(mx, shx(mx, 1, lane)); mx = fmaxf(mx, shx(mx, 2, lane)); mx = fmaxf(mx, shx(mx, 4, lane)); mx = fmaxf(mx, shx(mx, 8, lane));
        float pe = __builtin_amdgcn_exp2f(sc - mx); float l = pe; l += shx(l, 1, lane); l += shx(l, 2, lane); l += shx(l, 4, lane); l += shx(l, 8, lane);
        pe /= l;
        float o = 0.f;
        for (int k2 = 0; k2 <= j; ++k2) { const float ak = __builtin_amdgcn_readlane(pe, k2); o += ak * bf2f(V[(size_t)meta_slot(k2) * DM + h * 64 + lane]); }
        ((bf16*)(p.ws + WS_O0))[(size_t)(NREAL + j) * DM + h * 64 + lane] = (bf16)f2bf(o); }
}

typedef float f32x4m __attribute__((ext_vector_type(4)));
template <int KIND> __device__ __forceinline__ void ln_phase(const Params& p, const Ctx& C, int layer) {
    constexpr int NCB = (KIND == 0) ? 3 : (KIND == 1 ? 1 : 0), NC = 16 * (NCB ? NCB : 1);
    constexpr int AT_PITCH = 1028;
    const int tid = C.tid, lane = C.lane, wave = C.wave;
    LAS float* At = (LAS float*)(C.lds + RING_OFF);
    LAS float* part = (LAS float*)(C.lds + RING_OFF + 65792);
    LAS float* logit = (LAS float*)(C.lds + RING_OFF + 90368);
    LAS int* sl_e = (LAS int*)(C.lds + RING_OFF + 93440);
    LAS int* cnt_l = (LAS int*)(C.lds + RING_OFF + 94720);
    const float* gsrc = (KIND == 0 ? p.ln_mix_g : p.ln_ffn_g) + layer * DM; const float* bsrc = (KIND == 0 ? p.ln_mix_b : p.ln_ffn_b) + layer * DM;
    f32x4 gv[4], bv[4];
#pragma unroll
    for (int j = 0; j < 4; ++j) { gv[j] = *(const GAS f32x4*)(gsrc + 4 * lane + 256 * j); bv[j] = *(const GAS f32x4*)(bsrc + 4 * lane + 256 * j); }
    float Bf[NCB ? NCB : 1][8][4];
    if constexpr (NCB > 0) { const int kq = lane >> 4, col = lane & 15;
#pragma unroll
        for (int cb = 0; cb < NCB; ++cb)
#pragma unroll
            for (int g = 0; g < 8; ++g)
#pragma unroll
                for (int c = 0; c < 4; ++c) { const int k = 128 * wave + 16 * g + 4 * kq + c, cc = cb * 16 + col; float w;
                    if (KIND == 0) w = cc < 4 ? p.rg_w[((size_t)layer * DM + k) * 4 + cc] : (cc < 36 ? p.re_w[((size_t)layer * DM + k) * 32 + (cc - 4)] : 0.f);
                    else w = p.fox_w_in[(size_t)k * 3088 + 3072 + cc];
                    Bf[cb][g][c] = w; } }
    if (KIND == 0) { if (tid < 96) cnt_l[tid] = 0; }
    bf16* XH = (bf16*)(p.ws + WS_XH); const bf16* Y = (const bf16*)(p.ws + WS_K);
    constexpr int NTILES = NR / 16;
    int it = 0;
    for (int tile = C.vcu; tile < NTILES; tile += C.G, ++it) {
        unsigned long long vv[2][4]; unsigned long long yy[2][2][4];
#pragma unroll
        for (int rr = 0; rr < 2; ++rr) { const int row = tile * 16 + wave * 2 + rr;
#pragma unroll
            for (int j = 0; j < 4; ++j) vv[rr][j] = *((const GAS unsigned long long*)(XH + (size_t)row * DM) + lane + 64 * j);
            if (KIND != 0) {
#pragma unroll
                for (int j = 0; j < 4; ++j) { yy[rr][0][j] = *(const GAS unsigned long long*)(Y + (size_t)(2 * row) * DM + 4 * lane + 256 * j); yy[rr][1][j] = *(const GAS unsigned long long*)(Y + (size_t)(2 * row + 1) * DM + 4 * lane + 256 * j); } } }
#pragma unroll
        for (int rr = 0; rr < 2; ++rr) { const int rl = wave * 2 + rr, row = tile * 16 + rl;
            f32x4 v[4];
#pragma unroll
            for (int j = 0; j < 4; ++j) { const unsigned h0 = (unsigned)vv[rr][j], h1 = (unsigned)(vv[rr][j] >> 32); v[j] = (f32x4){bflo(h0), bfhi(h0), bflo(h1), bfhi(h1)}; }
            if (KIND != 0) {
#pragma unroll
                for (int j = 0; j < 4; ++j) { const unsigned long long y0 = yy[rr][0][j], y1 = yy[rr][1][j];
                    const unsigned a0 = (unsigned)y0, a1 = (unsigned)(y0 >> 32), b0 = (unsigned)y1, b1 = (unsigned)(y1 >> 32);
                    v[j].x = v[j].x * ALPHA + (bflo(a0) + bflo(b0)); v[j].y = v[j].y * ALPHA + (bfhi(a0) + bfhi(b0)); v[j].z = v[j].z * ALPHA + (bflo(a1) + bflo(b1)); v[j].w = v[j].w * ALPHA + (bfhi(a1) + bfhi(b1)); } }
            float s = 0.f;
#pragma unroll
            for (int j = 0; j < 4; ++j) s += (v[j].x + v[j].y) + (v[j].z + v[j].w);
            const float mean = wave_sum(s, lane) * (1.f / DM); float s2 = 0.f;
#pragma unroll
            for (int j = 0; j < 4; ++j) { v[j] = v[j] - mean; s2 += (v[j].x * v[j].x + v[j].y * v[j].y) + (v[j].z * v[j].z + v[j].w * v[j].w); }
            const float rstd = 1.f / sqrtf(wave_sum(s2, lane) * (1.f / DM) + LN_EPS);
#pragma unroll
            for (int j = 0; j < 4; ++j) v[j] = v[j] * rstd * gv[j] + bv[j];
            if (KIND == 2) { if (row < NREAL) {
#pragma unroll
                for (int j = 0; j < 4; ++j) *(GAS f32x4*)(p.out + (size_t)row * DM + 4 * lane + 256 * j) = v[j]; } }
            else {
#pragma unroll
                for (int j = 0; j < 4; ++j) {
                    *((GAS unsigned long long*)(XH + (size_t)row * DM) + lane + 64 * j) = (unsigned long long)pk2(v[j].x, v[j].y) | ((unsigned long long)pk2(v[j].z, v[j].w) << 32);
                    *(LAS f32x4*)(At + rl * AT_PITCH + 4 * lane + 256 * j) = v[j]; } } }
        if constexpr (NCB > 0) {
            __syncthreads();
            f32x4m acc[NCB];
#pragma unroll
            for (int cb = 0; cb < NCB; ++cb) acc[cb] = (f32x4m){0.f, 0.f, 0.f, 0.f};
#pragma unroll
            for (int g = 0; g < 8; ++g) { const f32x4 a4 = *(const LAS f32x4*)(At + (lane & 15) * AT_PITCH + 128 * wave + 16 * g + 4 * (lane >> 4));
#pragma unroll
                for (int c = 0; c < 4; ++c)
#pragma unroll
                    for (int cb = 0; cb < NCB; ++cb) acc[cb] = __builtin_amdgcn_mfma_f32_16x16x4f32(a4[c], Bf[cb][g][c], acc[cb], 0, 0, 0); }
#pragma unroll
            for (int cb = 0; cb < NCB; ++cb)
#pragma unroll
                for (int r = 0; r < 4; ++r) part[(wave * 16 + 4 * (lane >> 4) + r) * 48 + cb * 16 + (lane & 15)] = acc[cb][r];
            __syncthreads();
            for (int idx = tid; idx < 16 * NC; idx += NWAVES * 64) { const int rw = idx / NC, cl = idx % NC; float sacc = 0.f;
#pragma unroll
                for (int w = 0; w < 8; ++w) sacc += part[(w * 16 + rw) * 48 + cl];
                logit[rw * 48 + cl] = sacc; }
            __syncthreads();
            if (KIND == 0) { if (tid < 16) { const int row = tile * 16 + tid; const LAS float* lg = logit + tid * 48;
                float gl[4]; int gs = 0;
#pragma unroll
                for (int i = 0; i < 4; ++i) gl[i] = lg[i] + p.rg_b[layer * 4 + i];
#pragma unroll
                for (int i = 1; i < 4; ++i) if (gl[i] > gl[gs]) gs = i;
                float den = 0.f;
#pragma unroll
                for (int i = 0; i < 4; ++i) den += __expf(gl[i] - gl[gs]);
                const float pg = 1.f / den;
                float el[8];
#pragma unroll
                for (int i = 0; i < 8; ++i) el[i] = lg[4 + gs * 8 + i] + p.re_b[layer * 32 + gs * 8 + i];
                int i0 = 0;
#pragma unroll
                for (int i = 1; i < 8; ++i) if (el[i] > el[i0]) i0 = i;
                int i1 = (i0 == 0) ? 1 : 0;
#pragma unroll
                for (int i = 0; i < 8; ++i) if (i != i0 && el[i] > el[i1]) i1 = i;
                const float ex = __expf(el[i1] - el[i0]); const float w0 = 1.f / (1.f + ex), w1 = ex * w0;
                float* GVp = (float*)(p.ws + WS_GV); GVp[2 * row] = pg * w0; GVp[2 * row + 1] = pg * w1;
                sl_e[it * 32 + 2 * tid] = gs * 8 + i0; sl_e[it * 32 + 2 * tid + 1] = gs * 8 + i1; } }
            else { if (tid < 256) { const int rw = tid >> 4, hh = tid & 15; const float vv = logit[rw * 48 + hh] + p.fox_b_f[hh];
                ((float*)(p.ws + WS_LF))[(size_t)(tile * 16 + rw) * 16 + hh] = fminf(vv, 0.f) - __builtin_amdgcn_logf(1.f + __builtin_amdgcn_exp2f(-fabsf(vv) * LOG2E)) * 0.69314718056f;   } }
        }
    }
    if (KIND == 0) {
        gu32* CNT = (gu32*)(p.ws + WS_CTL) + CW_CNT + layer * 2048; int* LIST = (int*)(p.ws + WS_LIST);
        __syncthreads();
        const int nloc = it * 32;
        for (int s = tid; s < nloc; s += NWAVES * 64) atomicAdd((int*)&cnt_l[sl_e[s]], 1);
        __syncthreads();
        if (tid < 32) { const int n = cnt_l[tid]; cnt_l[32 + tid] = n > 0 ? (int)__hip_atomic_fetch_add(CNT + 64 * tid, (unsigned)n, RLX_AGENT) : 0; cnt_l[64 + tid] = 0; }
        __syncthreads();
        for (int s = tid; s < nloc; s += NWAVES * 64) { const int e = sl_e[s]; const int pos = cnt_l[32 + e] + atomicAdd((int*)&cnt_l[64 + e], 1);
            const int tl = C.vcu + (s >> 5) * C.G; LIST[(size_t)e * LCAP + pos] = 2 * (tl * 16 + ((s & 31) >> 1)) + (s & 1); }
    }
    __syncthreads();
}

__device__ __forceinline__ void cumsum_job(const Params& p, const Ctx& C) {
    if (C.vcu >= 64) return;
    const int b = C.vcu >> 4, h = C.vcu & 15, tid = C.tid, lane = C.lane, wave = C.wave;
    const float* LF = (const float*)(p.ws + WS_LF); float* DK = (float*)(p.ws + WS_DK) + (size_t)(b * 16 + h) * KROWS;
    LAS float* wt = (LAS float*)(C.lds + RING_OFF);
    float cm = 0.f, mine = 0.f; const int myj = (tid < NMETA) ? tid : -1;
    for (int i = 0; i < NMETA; ++i) { cm += LF[(size_t)(NREAL + i) * 16 + h]; if (i == myj) mine = cm; }
    if (tid < KPRE) DK[tid] = (myj >= 0) ? -mine * LOG2E : 0.f;
    if (tid < 64) DK[KPRE + SEQ + tid] = 0.f;
    const float* lp = LF + (size_t)(b * SEQ + tid * 16) * 16 + h;
    float run = 0.f;
#pragma unroll 1
    for (int i = 0; i < 16; ++i) run += lp[i * 16];
    float inc = run;
#pragma unroll
    for (int o = 1; o < 64; o <<= 1) { const float t = __uint_as_float((unsigned)__builtin_amdgcn_ds_bpermute((lane - o) << 2, (int)__float_as_uint(inc))); if (lane >= o) inc += t; }
    if (lane == 63) wt[wave] = inc;
    __syncthreads();
    float base = cm;
    for (int w = 0; w < wave; ++w) base += wt[w];
    base += inc - run;
#pragma unroll 1
    for (int i = 0; i < 16; ++i) { base += lp[i * 16]; DK[KPRE + tid * 16 + i] = -base * LOG2E; }
    __syncthreads();
}

struct MoeOrder {
    int G, c, UT; const LAS int* pre; const char* A; const char* W; size_t wexp, tsB;
    __device__ __forceinline__ bool next(int i, pg8::Unit& u) const {
        const int g = i * G + c; if (g >= UT || i >= ROWTAB_UNITS) return false;
        const int rt = g >> 2; int e = 0; while (pre[e + 1] <= rt) ++e;
        u.pm = rt - pre[e]; u.pn = g & 3; u.A = A; u.B = W + (size_t)e * wexp + (size_t)u.pn * tsB; u.tab = i; u.e = e; return true;
    }
};
__device__ __forceinline__ int moe_setup(const Params& p, const Ctx& C, int layer, MoeOrder& S) {
    LAS int* pre = (LAS int*)(C.lds + MOEPRE_OFF); LAS int* cnts = pre + 40; LAS int* rowtab = (LAS int*)(C.lds + ROWTAB_OFF);
    const gu32* CNT = (const gu32*)(p.ws + WS_CTL) + CW_CNT + layer * 2048;
    if (C.tid < 32) cnts[C.tid] = (int)__hip_atomic_load(CNT + 64 * C.tid, RLX_AGENT);
    __syncthreads();
    if (C.tid == 0) { int a = 0; for (int e = 0; e < NEXP; ++e) { pre[e] = a; a += (cnts[e] + 255) >> 8; } pre[NEXP] = a; }
    __syncthreads();
    S.pre = pre; S.UT = 4 * pre[NEXP];
    const int* LIST = (const int*)(p.ws + WS_LIST);
    pg8::Unit u;
    for (int i = 0; S.next(i, u); ++i) { if (C.tid < 256) { const int idx = 256 * u.pm + C.tid; rowtab[i * 256 + C.tid] = idx < cnts[u.e] ? LIST[(size_t)u.e * LCAP + idx] : -1; } }
    __syncthreads();
    return S.UT;
}

__global__ void __launch_bounds__(NWAVES * 64, 2) trunk_fwd(Params p) {
    extern __shared__ __attribute__((aligned(16))) unsigned char lds[];
    Ctx C;
    C.lds = (LAS unsigned char*)lds; C.tid = threadIdx.x; C.lane = C.tid & 63; C.wave = __builtin_amdgcn_readfirstlane(C.tid >> 6);
    C.G = gridDim.x; { const int bx = blockIdx.x; C.vcu = (C.G % 8 == 0) ? (bx % 8) * (C.G / 8) + bx / 8 : bx; }
    volatile LAS unsigned* MISC = (volatile LAS unsigned*)(C.lds + MISC_OFF);
    gu32* ctl = (gu32*)(p.ws + WS_CTL);
    if (C.tid < 32) MISC[C.tid] = 0u;
    __syncthreads();
    XcdBarrier bar; bar.bar = (unsigned*)(ctl + CW_BAR) + p.li * XCD_BAR_WORDS; bar.x = 0; bar.st = nullptr;
    if (!MK_PER_PHASE) bar = xcd_barrier_post((unsigned*)(ctl + CW_BAR) + p.li * XCD_BAR_WORDS, MISC + 8);
#define GRID_BAR() do { if (MK_PER_PHASE) { if (C.tid == 0) __hip_atomic_store(ctl + CW_TMO, 0xBADBA0u, RLX_AGENT); } else { xcd_barrier(bar); } } while (0)
    const int lo = p.ph_lo, hi = p.ph_hi;
#ifndef SUBMASK
#define SUBMASK 0x7f
#endif
#ifndef REP_MASK
#define REP_MASK 0
#endif
#define NREP(k) (((REP_MASK >> (k)) & 1) ? 2 : 1)
#ifndef PHASE_MASK
#define PHASE_MASK 0xffff
#endif
#define IN(k) (((PHASE_MASK >> (k)) & 1) && lo <= (k) && (k) < hi)
#define SEAM(k) do { if (IN(k) && IN((k) + 1)) GRID_BAR(); } while (0)
    bf16* XH = (bf16*)(p.ws + WS_XH); bf16* QB = (bf16*)(p.ws + WS_Q); bf16* KB = (bf16*)(p.ws + WS_K); bf16* VB = (bf16*)(p.ws + WS_V);
    bf16* O0 = (bf16*)(p.ws + WS_O0); bf16* O1 = (bf16*)p.out;
    const LAS int* rowtab = (const LAS int*)(C.lds + ROWTAB_OFF);

    if (IN(0)) { for (int rep_ = 0; rep_ < NREP(0); ++rep_) p0_prologue(p, fresh(C)); } SEAM(0);

    { constexpr int layer = 0;
        const int pb = 1 + (layer ? 8 : 0);
        if ((SUBMASK & 1) && IN(pb)) { for (int rep_ = 0; rep_ < NREP(pb); ++rep_) {
            if (layer == 1) cumsum_job(p, fresh(C));
            pg8::StaticOrder S; S.init(NRP, 3 * DM, C.G, (int)blockIdx.x, XH, DM * 2, p.ws + (layer ? WS_WQKV1 : WS_WQKV0), DM * 2);
            pg8::EpiQKV E{QB, KB, VB, attn_body::C2, layer ? (unsigned*)(ctl + CW_QM) : nullptr, (unsigned*)(ctl + CW_KM)};
            pg8::gemm_phase<pg8::EpiQKV, pg8::StaticOrder, true, false>(C.lds + RING_OFF, DM, DM * 2, S, E, rowtab, 0);
        } } SEAM(pb);
        if (layer == 0) {
            if (IN(2)) { for (int rep_ = 0; rep_ < NREP(2); ++rep_) {
                const float* TAB = (const float*)(p.ws + WS_TAB);
                const float lam = diff_lambda_full(p, fresh(C).lane);
                for (int it = C.vcu; it < NBATCH * 8 * 16; it += C.G) { const int bh = it >> 4, s = it & 15, b = bh >> 3, h = bh & 7;
#pragma unroll 1
                    for (int w = 0; w < 2; ++w) { const int qb = w ? s : 31 - s;
#pragma unroll 1
                        for (int mm = 0; mm < 2; ++mm) attn_body::attn_unit_dv<8>(b, qb, (2 * h + mm) * 64, h * 128, h * 128, (const attn_body::bf16*)QB, (const attn_body::bf16*)KB, (const attn_body::bf16*)VB, (attn_body::bf16*)(mm ? O1 : O0), TAB + (2 * h + mm) * 128, (char*)lds + RING_OFF);
                        combine_rows(p, fresh(C), b, h, qb, lam); } }
                diff_meta_attn(p, fresh(C), lam);
            } } SEAM(2);
        } else {
            if (IN(10)) { for (int rep_ = 0; rep_ < NREP(10); ++rep_) {
                const float* DK = (const float*)(p.ws + WS_DK);
                for (;;) {
                    const int lane_ = fresh(C).lane;
                    int tko = MOEPRE_OFF; asm volatile("" : "+s"(tko)); LAS int* tk = (LAS int*)(C.lds + tko);
                    if (fresh(C).tid == 0) tk[0] = (int)__hip_atomic_fetch_add(ctl + CW_QCTR + 64 * rep_, 1u, RLX_AGENT);
                    __syncthreads(); const int u = tk[0]; __syncthreads();
                    if (u >= NBATCH * 16 * 32) break;
                    const int qb = 31 - (u >> 6), bh = u & 63, b = bh >> 4, h = bh & 15;
                    const float* dk = DK + (size_t)bh * KROWS;
                    const unsigned qmb = lane_ < 8 ? __hip_atomic_load(ctl + CW_QM + ((size_t)(b * 32 + qb) * 16 + h) * 8 + lane_, RLX_AGENT) : 0u;
                    const unsigned kmb = lane_ < 8 ? __hip_atomic_load(ctl + CW_KM + ((size_t)bh) * 8 + lane_, RLX_AGENT) : 0u;
                    const int ntf = 4 * qb + 6;
                    float e0 = lane_ < ntf ? dk[lane_ == 0 ? NMETA - 1 : 64 * lane_ + 63] : 0.f, e1 = lane_ + 64 < ntf ? dk[64 * (lane_ + 64) + 63] : 0.f, e2 = lane_ + 128 < ntf ? dk[64 * (lane_ + 128) + 63] : 0.f;
                    const float q2 = wave_sum(__uint_as_float(qmb), lane_), k2 = wave_sum(__uint_as_float(kmb), lane_);
                    const float thr = dk[KPRE + 256 * qb] - 40.f - 2.1f * sqrtf(q2 * k2);
                    const unsigned long long m0 = __ballot(lane_ < ntf && e0 >= thr), m1 = __ballot(lane_ + 64 < ntf && e1 >= thr), m2 = __ballot(lane_ + 128 < ntf && e2 >= thr);
                    int tb = m0 ? __builtin_ctzll(m0) : (m1 ? 64 + __builtin_ctzll(m1) : (m2 ? 128 + __builtin_ctzll(m2) : ntf - 6));
                    tb &= ~1; tb = tb > ntf - 6 ? ntf - 6 : tb; tb = __builtin_amdgcn_readfirstlane(tb);
                    attn_body::attn_unit<1, 8>(b, qb, tb, h * 64, h * 64, h * 64, (const attn_body::bf16*)QB, (const attn_body::bf16*)KB, (const attn_body::bf16*)VB, (attn_body::bf16*)O0, dk, (char*)lds + RING_OFF);
                }
                fox_meta_attn(p, fresh(C));
            } } SEAM(10);
        }
        const int pw = layer ? 11 : 4;
        if ((SUBMASK & 4) && IN(pw)) { for (int rep_ = 0; rep_ < NREP(pw); ++rep_) {
            pg8::StaticOrder S; S.init(NRP, DM, C.G, (int)blockIdx.x, layer ? O0 : QB, DM * 2, p.ws + (layer ? WS_WO1 : WS_WO0), DM * 2);
            pg8::EpiZ E{XH};
            pg8::gemm_phase<pg8::EpiZ, pg8::StaticOrder, true, false>(C.lds + RING_OFF, DM, DM * 2, S, E, rowtab, 0);
        } } SEAM(pw);
        if ((SUBMASK & 8) && IN(pw + 1)) { ln_phase<0>(p, fresh(C), layer); } SEAM(pw + 1);
        if ((SUBMASK & 16) && IN(pw + 2)) { for (int rep_ = 0; rep_ < NREP(pw + 2); ++rep_) {
            MoeOrder S; S.G = C.G; S.c = (int)blockIdx.x; S.A = (const char*)XH; S.W = (const char*)(p.ws + WS_WGU); S.wexp = (size_t)DM * DM * 2; S.tsB = (size_t)256 * DM * 2;
            moe_setup(p, fresh(C), layer, S);
            pg8::EpiGU E{(pg8::bf16_t*)O0};
            pg8::gemm_phase<pg8::EpiGU, MoeOrder, true, true>(C.lds + RING_OFF, DM, DM * 2, S, E, rowtab, 1);
        } } SEAM(pw + 2);
        if ((SUBMASK & 32) && IN(pw + 3)) { for (int rep_ = 0; rep_ < NREP(pw + 3); ++rep_) {
            MoeOrder S; S.G = C.G; S.c = (int)blockIdx.x; S.A = (const char*)O0; S.W = (const char*)(p.ws + WS_WD); S.wexp = (size_t)DM * DEXP * 2; S.tsB = (size_t)256 * DEXP * 2;
            moe_setup(p, fresh(C), layer, S);
            pg8::EpiDown E{(pg8::bf16_t*)KB, (const float*)(p.ws + WS_GV)};
            pg8::gemm_phase<pg8::EpiDown, MoeOrder, true, true>(C.lds + RING_OFF, DEXP, DEXP * 2, S, E, rowtab, 0);
        } } SEAM(pw + 3);
        if ((SUBMASK & 64) && IN(pw + 4)) {
            if (layer == 0) { ln_phase<1>(p, fresh(C), 0); { const Ctx Cf = fresh(C); convert_experts(p, Cf, 1, 0, Cf.vcu * NWAVES + Cf.wave, Cf.G * NWAVES); } }
            else ln_phase<2>(p, fresh(C), 1);
        }
        if (layer == 0) SEAM(8);
        }
    { constexpr int layer = 1;
        const int pb = 1 + (layer ? 8 : 0);
        if ((SUBMASK & 1) && IN(pb)) { for (int rep_ = 0; rep_ < NREP(pb); ++rep_) {
            if (layer == 1) cumsum_job(p, fresh(C));
            pg8::StaticOrder S; S.init(NRP, 3 * DM, C.G, (int)blockIdx.x, XH, DM * 2, p.ws + (layer ? WS_WQKV1 : WS_WQKV0), DM * 2);
            pg8::EpiQKV E{QB, KB, VB, attn_body::C2, layer ? (unsigned*)(ctl + CW_QM) : nullptr, (unsigned*)(ctl + CW_KM)};
            pg8::gemm_phase<pg8::EpiQKV, pg8::StaticOrder, true, false>(C.lds + RING_OFF, DM, DM * 2, S, E, rowtab, 0);
        } } SEAM(pb);
        if (layer == 0) {
            if (IN(2)) { for (int rep_ = 0; rep_ < NREP(2); ++rep_) {
                const float* TAB = (const float*)(p.ws + WS_TAB);
                const float lam = diff_lambda_full(p, fresh(C).lane);
                for (int it = C.vcu; it < NBATCH * 8 * 16; it += C.G) { const int bh = it >> 4, s = it & 15, b = bh >> 3, h = bh & 7;
#pragma unroll 1
                    for (int w = 0; w < 2; ++w) { const int qb = w ? s : 31 - s;
#pragma unroll 1
                        for (int mm = 0; mm < 2; ++mm) attn_body::attn_unit_dv<8>(b, qb, (2 * h + mm) * 64, h * 128, h * 128, (const attn_body::bf16*)QB, (const attn_body::bf16*)KB, (const attn_body::bf16*)VB, (attn_body::bf16*)(mm ? O1 : O0), TAB + (2 * h + mm) * 128, (char*)lds + RING_OFF);
                        combine_rows(p, fresh(C), b, h, qb, lam); } }
                diff_meta_attn(p, fresh(C), lam);
            } } SEAM(2);
        } else {
            if (IN(10)) { for (int rep_ = 0; rep_ < NREP(10); ++rep_) {
                const float* DK = (const float*)(p.ws + WS_DK);
                for (;;) {
                    const int lane_ = fresh(C).lane;
                    int tko = MOEPRE_OFF; asm volatile("" : "+s"(tko)); LAS int* tk = (LAS int*)(C.lds + tko);
                    if (fresh(C).tid == 0) tk[0] = (int)__hip_atomic_fetch_add(ctl + CW_QCTR + 64 * rep_, 1u, RLX_AGENT);
                    __syncthreads(); const int u = tk[0]; __syncthreads();
                    if (u >= NBATCH * 16 * 32) break;
                    const int qb = 31 - (u >> 6), bh = u & 63, b = bh >> 4, h = bh & 15;
                    const float* dk = DK + (size_t)bh * KROWS;
                    const unsigned qmb = lane_ < 8 ? __hip_atomic_load(ctl + CW_QM + ((size_t)(b * 32 + qb) * 16 + h) * 8 + lane_, RLX_AGENT) : 0u;
                    const unsigned kmb = lane_ < 8 ? __hip_atomic_load(ctl + CW_KM + ((size_t)bh) * 8 + lane_, RLX_AGENT) : 0u;
                    const int ntf = 4 * qb + 6;
                    float e0 = lane_ < ntf ? dk[lane_ == 0 ? NMETA - 1 : 64 * lane_ + 63] : 0.f, e1 = lane_ + 64 < ntf ? dk[64 * (lane_ + 64) + 63] : 0.f, e2 = lane_ + 128 < ntf ? dk[64 * (lane_ + 128) + 63] : 0.f;
                    const float q2 = wave_sum(__uint_as_float(qmb), lane_), k2 = wave_sum(__uint_as_float(kmb), lane_);
                    const float thr = dk[KPRE + 256 * qb] - 40.f - 2.1f * sqrtf(q2 * k2);
                    const unsigned long long m0 = __ballot(lane_ < ntf && e0 >= thr), m1 = __ballot(lane_ + 64 < ntf && e1 >= thr), m2 = __ballot(lane_ + 128 < ntf && e2 >= thr);
                    int tb = m0 ? __builtin_ctzll(m0) : (m1 ? 64 + __builtin_ctzll(m1) : (m2 ? 128 + __builtin_ctzll(m2) : ntf - 6));
                    tb &= ~1; tb = tb > ntf - 6 ? ntf - 6 : tb; tb = __builtin_amdgcn_readfirstlane(tb);
                    attn_body::attn_unit<1, 8>(b, qb, tb, h * 64, h * 64, h * 64, (const attn_body::bf16*)QB, (const attn_body::bf16*)KB, (const attn_body::bf16*)VB, (attn_body::bf16*)O0, dk, (char*)lds + RING_OFF);
                }
                fox_meta_attn(p, fresh(C));
            } } SEAM(10);
        }
        const int pw = layer ? 11 : 4;
        if ((SUBMASK & 4) && IN(pw)) { for (int rep_ = 0; rep_ < NREP(pw); ++rep_) {
            pg8::StaticOrder S; S.init(NRP, DM, C.G, (int)blockIdx.x, layer ? O0 : QB, DM * 2, p.ws + (layer ? WS_WO1 : WS_WO0), DM * 2);
            pg8::EpiZ E{XH};
            pg8::gemm_phase<pg8::EpiZ, pg8::StaticOrder, true, false>(C.lds + RING_OFF, DM, DM * 2, S, E, rowtab, 0);
        } } SEAM(pw);
        if ((SUBMASK & 8) && IN(pw + 1)) { ln_phase<0>(p, fresh(C), layer); } SEAM(pw + 1);
        if ((SUBMASK & 16) && IN(pw + 2)) { for (int rep_ = 0; rep_ < NREP(pw + 2); ++rep_) {
            MoeOrder S; S.G = C.G; S.c = (int)blockIdx.x; S.A = (const char*)XH; S.W = (const char*)(p.ws + WS_WGU); S.wexp = (size_t)DM * DM * 2; S.tsB = (size_t)256 * DM * 2;
            moe_setup(p, fresh(C), layer, S);
            pg8::EpiGU E{(pg8::bf16_t*)O0};
            pg8::gemm_phase<pg8::EpiGU, MoeOrder, true, true>(C.lds + RING_OFF, DM, DM * 2, S, E, rowtab, 1);
        } } SEAM(pw + 2);
        if ((SUBMASK & 32) && IN(pw + 3)) { for (int rep_ = 0; rep_ < NREP(pw + 3); ++rep_) {
            MoeOrder S; S.G = C.G; S.c = (int)blockIdx.x; S.A = (const char*)O0; S.W = (const char*)(p.ws + WS_WD); S.wexp = (size_t)DM * DEXP * 2; S.tsB = (size_t)256 * DEXP * 2;
            moe_setup(p, fresh(C), layer, S);
            pg8::EpiDown E{(pg8::bf16_t*)KB, (const float*)(p.ws + WS_GV)};
            pg8::gemm_phase<pg8::EpiDown, MoeOrder, true, true>(C.lds + RING_OFF, DEXP, DEXP * 2, S, E, rowtab, 0);
        } } SEAM(pw + 3);
        if ((SUBMASK & 64) && IN(pw + 4)) {
            if (layer == 0) { ln_phase<1>(p, fresh(C), 0); { const Ctx Cf = fresh(C); convert_experts(p, Cf, 1, 0, Cf.vcu * NWAVES + Cf.wave, Cf.G * NWAVES); } }
            else ln_phase<2>(p, fresh(C), 1);
        }
        if (layer == 0) SEAM(8);
        }
#undef IN
#undef SEAM
#undef GRID_BAR
}

extern "C" void kernel_launch(void* const* d_in, const int* in_sizes, int n_in, void* d_out, int out_size, void* d_ws, size_t ws_size, hipStream_t stream) {
    static int grid = 0;
    if (grid == 0) {
        if (n_in != 21 || in_sizes[0] != NREAL * DM || out_size != NREAL * DM || ws_size < WS_END) { fprintf(stderr, "kernel_launch: unexpected shapes (n_in %d, in0 %d, out %d, ws %zu); nothing launched\n", n_in, n_in > 0 ? in_sizes[0] : -1, out_size, ws_size); grid = -1; return; }
        int dev = 0, cus = 0, per_cu = 0;
        if (hipGetDevice(&dev) != hipSuccess || hipDeviceGetAttribute(&cus, hipDeviceAttributeMultiprocessorCount, dev) != hipSuccess) { fprintf(stderr, "kernel_launch: device query failed\n"); grid = -1; return; }
        if (hipFuncSetAttribute((const void*)trunk_fwd, hipFuncAttributeMaxDynamicSharedMemorySize, LDS_BYTES) != hipSuccess) { fprintf(stderr, "kernel_launch: hipFuncSetAttribute failed\n"); grid = -1; return; }
        if (hipOccupancyMaxActiveBlocksPerMultiprocessor(&per_cu, (const void*)trunk_fwd, NWAVES * 64, LDS_BYTES) != hipSuccess || per_cu < 1) { fprintf(stderr, "kernel_launch: occupancy query reports %d workgroups per CU\n", per_cu); }
        (void)hipGetLastError();
        grid = cus;
    }
    if (grid < 0) return;
    if (hipMemsetAsync((char*)d_ws + WS_CTL, 0, CTL_ZERO_BYTES, stream) != hipSuccess) { fprintf(stderr, "kernel_launch: hipMemsetAsync failed\n"); return; }
    Params a{};
    const float** dst = (const float**)&a.x;
    for (int i = 0; i < 21; ++i) dst[i] = (const float*)d_in[i];
    a.out = (float*)d_out; a.ws = (unsigned char*)d_ws;
#if MK_PER_PHASE
    for (int k = 0; k < N_PHASES; ++k) { a.ph_lo = k; a.ph_hi = k + 1; a.li = 0; hipLaunchKernelGGL(trunk_fwd, dim3(grid), dim3(NWAVES * 64), LDS_BYTES, stream, a); }
#else
    a.ph_lo = 0; a.ph_hi = N_PHASES; a.li = 0;
    hipLaunchKernelGGL(trunk_fwd, dim3(grid), dim3(NWAVES * 64), LDS_BYTES, stream, a);
#endif
    const hipError_t le = hipPeekAtLastError();
    if (le != hipSuccess) fprintf(stderr, "kernel_launch: launch failed: %s\n", hipGetErrorName(le));
}
```

```cpp
#include <hip/hip_runtime.h>
#include <hip/hip_bf16.h>
#include <cstdio>
#include <cstdint>
#include <cmath>

constexpr int DM = 1024, NBATCH = 4, SEQ = 8192, NMETA = 16;
constexpr int NREAL = NBATCH * SEQ;
constexpr int NR = NREAL + NMETA;
constexpr int NRP = 129 * 256;
constexpr int KPRE = 64;
constexpr int KROWS = KPRE + SEQ + 64;
constexpr int NSLOT = 2 * NR;
constexpr int NEXP = 32, DEXP = 512;
constexpr float ALPHA = 1.41421356237309515f;
constexpr float LN_EPS = 1e-5f;
constexpr float LOG2E = 1.4426950408889634f;
constexpr float LAMBDA_INIT0 = 0.2f;

namespace pg8 {
#define PG8_LAS __attribute__((address_space(3)))
typedef unsigned short bf16_t;
typedef short bf16x8 __attribute__((ext_vector_type(8)));
typedef float f32x4 __attribute__((ext_vector_type(4)));
typedef unsigned u32x4 __attribute__((ext_vector_type(4)));
constexpr int BM = 256, BK = 64, HALF = 128, HTB = HALF * BK * 2  , STAGE_BYTES = 8 * HTB, NXCD = 8, WGM = 8;

__host__ __device__ __forceinline__ int lds_byte(int r, int c) { const int st = (r >> 4) * 2 + (c >> 5), rr = r & 15, cc = c & 31, ob = rr * 64 + cc * 2; return st * 1024 + (ob ^ (((ob >> 9) & 1) << 5)); }
__host__ __device__ __forceinline__ void stage_rc(int b, int& R, int& C) { const int st = b / 1024, sb = b % 1024, swz = sb ^ (((sb >> 9) & 1) << 5); R = (st >> 1) * 16 + swz / 64; C = (st & 1) * 32 + (swz % 64) / 2; }
__host__ __device__ __forceinline__ int perm32(int rho) { const int n = rho >> 4, i = rho & 15; return 8 * (i >> 2) + 4 * n + (i & 3); }

struct Unit { int pm, pn; const char* A; const char* B; int tab; int e; };

struct StaticOrder {
    int nM, nN, nwg, G, c; const char* A; const char* B; size_t tsA, tsB;
    __device__ void init(int M, int N, int G_, int c_, const void* A_, size_t lda_bytes, const void* B_, size_t ldb_bytes) { nM = M / BM; nN = N / BM; nwg = nM * nN; G = G_; c = c_; A = (const char*)A_; B = (const char*)B_; tsA = lda_bytes * BM; tsB = ldb_bytes * BM; }
    __device__ bool next(int i, Unit& u) const {
        const long L = (long)i * G + c; if (L >= nwg) return false;
        int wgid = (int)L; { const int q = nwg / NXCD, r = nwg % NXCD, xcd = wgid % NXCD, off = wgid / NXCD; wgid = (xcd < r ? xcd * (q + 1) : r * (q + 1) + (xcd - r) * q) + off; }
        const int nig = WGM * nN, gid = wgid / nig, fm = gid * WGM, gsz = (nM - fm) < WGM ? (nM - fm) : WGM;
        u.pm = fm + ((wgid % nig) % gsz); u.pn = (wgid % nig) / gsz; u.A = A + (size_t)u.pm * tsA; u.B = B + (size_t)u.pn * tsB; u.tab = 0; u.e = 0; return true;
    }
};

__device__ __forceinline__ float shx(float v, int m, int lane) { return __uint_as_float((unsigned)__builtin_amdgcn_ds_bpermute((lane ^ m) << 2, (int)__float_as_uint(v))); }
__device__ __forceinline__ unsigned cvt_pk_bf16(float lo, float hi) { unsigned r; asm volatile("v_cvt_pk_bf16_f32 %0, %1, %2" : "=v"(r) : "v"(lo), "v"(hi)); return r; }

template <class Epi, class Sched, bool ALIGN_EPI, bool GATHER>
__device__ __forceinline__ void gemm_phase(PG8_LAS unsigned char* lds, const int K, const unsigned lda, const Sched& S, const Epi& E, const PG8_LAS int* rowtab, const int ashift) {
    int tid_ = threadIdx.x; asm volatile("" : "+v"(tid_));
    const int tid = tid_, wid = __builtin_amdgcn_readfirstlane(tid >> 6), lane = tid & 63, wr = wid >> 2, wc = wid & 3, fr = lane & 15, fq = lane >> 4;
    const int nt = K / BK;
    unsigned voffB[2], offA[2][2], noffA[2][2]; int Rr[2], Cc[2];
#pragma unroll
    for (int i = 0; i < 2; ++i) { int R, C; stage_rc(tid * 16 + i * 8192, R, C); const int Rb = Epi::PERM ? ((R & ~31) + perm32(R & 31)) : R; Rr[i] = R; Cc[i] = C;
        voffB[i] = (unsigned)(Rb * K + C) * 2u;
#pragma unroll
        for (int h = 0; h < 2; ++h) { offA[h][i] = (unsigned)(R + HALF * h) * lda + (unsigned)C * 2u; noffA[h][i] = offA[h][i]; } }
    const size_t kstep = (size_t)(BK * 2);
    const size_t hstep = (size_t)HALF * K * 2;
    const unsigned ldsw = (unsigned)wid * 1024u;
    const int aoff = lds_byte(wr * 64 + fr, fq * 8), boff = lds_byte(wc * 32 + fr, fq * 8);
#define PG8_SA(b, h) (((b) * 2 + (h)) * HTB)
#define PG8_SB(b, h) ((4 + (b) * 2 + (h)) * HTB)
#define PG8_STAGE(bufoff, gbase, voff) do { _Pragma("unroll") for (int _i = 0; _i < 2; ++_i) \
        __builtin_amdgcn_global_load_lds((const unsigned*)((const char*)(gbase) + (voff)[_i]), (PG8_LAS unsigned*)(lds + (bufoff) + ldsw + _i * 8192), 16, 0, 0); } while (0)
#define PG8_LDA(dst, b, h) do { _Pragma("unroll") for (int m = 0; m < 4; ++m) _Pragma("unroll") for (int k = 0; k < 2; ++k) dst[m][k] = *(const PG8_LAS bf16x8*)(lds + PG8_SA(b, h) + aoff + m * 2048 + k * 1024); } while (0)
#define PG8_LDB(dst, b, h) do { _Pragma("unroll") for (int n = 0; n < 2; ++n) _Pragma("unroll") for (int k = 0; k < 2; ++k) dst[n][k] = *(const PG8_LAS bf16x8*)(lds + PG8_SB(b, h) + boff + n * 2048 + k * 1024); } while (0)
#define PG8_MMA(ai, bj, At, Bt) do { __builtin_amdgcn_s_setprio(1); _Pragma("unroll") for (int m = 0; m < 4; ++m) _Pragma("unroll") for (int n = 0; n < 2; ++n) _Pragma("unroll") for (int k = 0; k < 2; ++k) \
        acc[ai][bj][m][n] = __builtin_amdgcn_mfma_f32_16x16x32_bf16(Bt[n][k], At[m][k], acc[ai][bj][m][n], 0, 0, 0); __builtin_amdgcn_s_setprio(0); } while (0)
#define PG8_WAIT_V(n) asm volatile("s_waitcnt vmcnt(" #n ")" ::: "memory")
#define PG8_WAIT_L(n) asm volatile("s_waitcnt lgkmcnt(" #n ")" ::: "memory")
#define PG8_BAR __builtin_amdgcn_s_barrier()
#define PG8_SCHED __builtin_amdgcn_sched_barrier(0)
#define PG8_GOFF(dst, u) do { if constexpr (GATHER) { _Pragma("unroll") for (int _h = 0; _h < 2; ++_h) _Pragma("unroll") for (int _i = 0; _i < 2; ++_i) { \
        int _e = rowtab[(u).tab * 256 + _h * HALF + Rr[_i]]; _e = _e < 0 ? 0 : (_e >> ashift); dst[_h][_i] = (unsigned)_e * lda + (unsigned)Cc[_i] * 2u; } } } while (0)
    Unit cur, nxt; int ui = 0;
    if (!S.next(0, cur)) return;
    f32x4 acc[2][2][4][2];
#pragma unroll
    for (int a = 0; a < 2; ++a)
#pragma unroll
        for (int b = 0; b < 2; ++b)
#pragma unroll
            for (int m = 0; m < 4; ++m)
#pragma unroll
                for (int n = 0; n < 2; ++n) acc[a][b][m][n] = (f32x4){0.f, 0.f, 0.f, 0.f};
    bf16x8 At[4][2], B0[2][2], B1[2][2];
    const char* cA = cur.A; const char* cB = cur.B;
    PG8_GOFF(offA, cur);
    PG8_STAGE(PG8_SB(0, 0), cB, voffB); PG8_STAGE(PG8_SB(0, 1), cB + hstep, voffB); PG8_STAGE(PG8_SA(0, 0), cA, offA[0]); PG8_STAGE(PG8_SA(0, 1), cA, offA[1]);
    if (wr == 1) PG8_BAR;
    PG8_WAIT_V(2); PG8_BAR;
    PG8_STAGE(PG8_SB(1, 0), cB + kstep, voffB); PG8_STAGE(PG8_SA(1, 0), cA + kstep, offA[0]); PG8_STAGE(PG8_SB(1, 1), cB + hstep + kstep, voffB);
    PG8_WAIT_V(6); PG8_BAR;
    for (;;) {
        const bool has_next = S.next(ui + 1, nxt);
        const char* nA = has_next ? nxt.A : cA; const char* nB = has_next ? nxt.B : cB;
        if constexpr (GATHER) { if (has_next) PG8_GOFF(noffA, nxt); else {
#pragma unroll
            for (int h = 0; h < 2; ++h)
#pragma unroll
                for (int i = 0; i < 2; ++i) noffA[h][i] = offA[h][i]; } }
        for (int t = 0; t < nt; t += 2) {
            const bool last = (t == nt - 2);
            const char* a1 = cA + (size_t)(t + 1) * kstep;
            const char* a2 = last ? nA : cA + (size_t)(t + 2) * kstep; const char* b2 = last ? nB : cB + (size_t)(t + 2) * kstep;
            const char* a3 = a2 + kstep; const char* b3 = b2 + kstep;
            unsigned o2[2][2];
#pragma unroll
            for (int h = 0; h < 2; ++h)
#pragma unroll
                for (int i = 0; i < 2; ++i) o2[h][i] = (GATHER && last) ? noffA[h][i] : offA[h][i];
            PG8_LDB(B0, 0, 0); PG8_LDB(B1, 0, 1); PG8_SCHED; PG8_LDA(At, 0, 0); PG8_STAGE(PG8_SA(1, 1), a1, offA[1]);
            PG8_WAIT_V(8); PG8_WAIT_L(0); PG8_BAR; PG8_MMA(0, 0, At, B0); PG8_MMA(0, 1, At, B1); PG8_BAR; PG8_SCHED;
            PG8_LDA(At, 0, 1); PG8_STAGE(PG8_SB(0, 0), b2, voffB); PG8_STAGE(PG8_SB(0, 1), b2 + hstep, voffB); PG8_STAGE(PG8_SA(0, 0), a2, o2[0]);
            PG8_WAIT_V(8); PG8_WAIT_L(0); PG8_BAR; PG8_MMA(1, 0, At, B0); PG8_MMA(1, 1, At, B1); PG8_BAR; PG8_SCHED;
            PG8_LDB(B0, 1, 0); PG8_LDB(B1, 1, 1); PG8_SCHED; PG8_LDA(At, 1, 0); PG8_STAGE(PG8_SA(0, 1), a2, o2[1]);
            PG8_WAIT_V(8); PG8_WAIT_L(0); PG8_BAR; PG8_MMA(0, 0, At, B0); PG8_MMA(0, 1, At, B1); PG8_BAR; PG8_SCHED;
            PG8_LDA(At, 1, 1); PG8_STAGE(PG8_SB(1, 0), b3, voffB); PG8_STAGE(PG8_SB(1, 1), b3 + hstep, voffB); PG8_STAGE(PG8_SA(1, 0), a3, o2[0]);
            PG8_WAIT_V(8); PG8_WAIT_L(0); PG8_BAR; PG8_MMA(1, 0, At, B0); PG8_MMA(1, 1, At, B1); PG8_BAR; PG8_SCHED;
        }
        if constexpr (ALIGN_EPI) { if (wr == 0) PG8_BAR; }
        E(acc, cur, wr, wc, fr, fq, rowtab);
        if (!has_next) break;
#pragma unroll
        for (int a = 0; a < 2; ++a)
#pragma unroll
            for (int b = 0; b < 2; ++b)
#pragma unroll
                for (int m = 0; m < 4; ++m)
#pragma unroll
                    for (int n = 0; n < 2; ++n) acc[a][b][m][n] = (f32x4){0.f, 0.f, 0.f, 0.f};
        cur = nxt; cA = nA; cB = nB; ++ui;
        if constexpr (GATHER) {
#pragma unroll
            for (int h = 0; h < 2; ++h)
#pragma unroll
                for (int i = 0; i < 2; ++i) offA[h][i] = noffA[h][i]; }
        if constexpr (ALIGN_EPI) { if (wr == 1) PG8_BAR; }
    }
    PG8_WAIT_V(0);
    if constexpr (!ALIGN_EPI) { if (wr == 0) PG8_BAR; }
    PG8_BAR;
#undef PG8_SA
#undef PG8_SB
#undef PG8_STAGE
#undef PG8_LDA
#undef PG8_LDB
#undef PG8_MMA
#undef PG8_WAIT_V
#undef PG8_WAIT_L
#undef PG8_BAR
#undef PG8_SCHED
#undef PG8_GOFF
}

struct EpiQKV {
    static constexpr bool PERM = true;
    bf16_t* Q; bf16_t* Kb; bf16_t* Vb; float qscale;
    unsigned* qm; unsigned* km;
    __device__ __forceinline__ void operator()(const f32x4 (&acc)[2][2][4][2], const Unit& u, int wr, int wc, int fr, int fq, const PG8_LAS int*) const {
        const int row0 = u.pm * BM + wr * 64 + fr; const int t = (u.pn * BM) >> 10; const int colt = (u.pn * BM) & 1023;
        const int col0 = colt + wc * 32 + 8 * fq; const float sc = (t == 0) ? qscale : 1.f;
        bf16_t* kv = (t == 1) ? Kb : Vb;
        float mx[2] = {0.f, 0.f};
#pragma unroll
        for (int ai = 0; ai < 2; ++ai)
#pragma unroll
            for (int m = 0; m < 4; ++m) { const int r = row0 + ai * HALF + m * 16;
                if (r < NR) {
#pragma unroll
                for (int bj = 0; bj < 2; ++bj) { const f32x4 v0 = acc[ai][bj][m][0] * sc, v1 = acc[ai][bj][m][1] * sc;
                    u32x4 w; w.x = cvt_pk_bf16(v0[0], v0[1]); w.y = cvt_pk_bf16(v0[2], v0[3]); w.z = cvt_pk_bf16(v1[0], v1[1]); w.w = cvt_pk_bf16(v1[2], v1[3]);
                    const int c = col0 + bj * HALF;
                    bf16_t* dst = (t == 0) ? Q + (size_t)r * DM : kv + (size_t)(r < NREAL ? (r >> 13) * KROWS + KPRE + (r & (SEQ - 1)) : r - NREAL) * DM;
                    *(u32x4*)(dst + c) = w; } }
                if (qm != nullptr && t < 2) {
#pragma unroll
                    for (int bj = 0; bj < 2; ++bj) { const f32x4 v0 = acc[ai][bj][m][0] * sc, v1 = acc[ai][bj][m][1] * sc;
                        float ss = (v0[0] * v0[0] + v0[1] * v0[1]) + (v0[2] * v0[2] + v0[3] * v0[3]) + (v1[0] * v1[0] + v1[1] * v1[1]) + (v1[2] * v1[2] + v1[3] * v1[3]);
                        ss += shx(ss, 16, fq * 16 + fr); ss += shx(ss, 32, fq * 16 + fr);
                        if (r < NR) mx[bj] = fmaxf(mx[bj], ss); } } }
        if (qm != nullptr && t < 2) {
#pragma unroll
            for (int bj = 0; bj < 2; ++bj) { float v = mx[bj]; v = fmaxf(v, shx(v, 1, fq * 16 + fr)); v = fmaxf(v, shx(v, 2, fq * 16 + fr)); v = fmaxf(v, shx(v, 4, fq * 16 + fr)); v = fmaxf(v, shx(v, 8, fq * 16 + fr));
                if (fr == 0 && fq == 0) { const int head = 4 * (u.pn & 3) + 2 * bj + (wc >> 1), part = wc & 1; const unsigned bits = __float_as_uint(v);
                    if (t == 0) { if (u.pm < NREAL / BM) atomicMax(qm + ((size_t)u.pm * 16 + head) * 8 + part, bits); }
                    else if (u.pm < NREAL / BM) atomicMax(km + ((size_t)(u.pm >> 5) * 16 + head) * 8 + part, bits);
                    else { for (int b = 0; b < NBATCH; ++b) atomicMax(km + ((size_t)b * 16 + head) * 8 + part, bits); } } } }
    }
};
struct EpiZ {
    static constexpr bool PERM = true;
    bf16_t* H;
    __device__ __forceinline__ void operator()(const f32x4 (&acc)[2][2][4][2], const Unit& u, int wr, int wc, int fr, int fq, const PG8_LAS int*) const {
        const int row0 = u.pm * BM + wr * 64 + fr; const int col0 = u.pn * BM + wc * 32 + 8 * fq;
#pragma unroll
        for (int ai = 0; ai < 2; ++ai)
#pragma unroll
            for (int m = 0; m < 4; ++m) { const int r = row0 + ai * HALF + m * 16;
                if (r < NR) {
#pragma unroll
                    for (int bj = 0; bj < 2; ++bj) { bf16_t* hp = H + (size_t)r * DM + col0 + bj * HALF; const u32x4 b = *(const u32x4*)hp;
                        const f32x4 v0 = acc[ai][bj][m][0], v1 = acc[ai][bj][m][1];
                        u32x4 w; w.x = cvt_pk_bf16(v0[0] + ALPHA * __uint_as_float(b.x << 16), v0[1] + ALPHA * __uint_as_float(b.x & 0xffff0000u)); w.y = cvt_pk_bf16(v0[2] + ALPHA * __uint_as_float(b.y << 16), v0[3] + ALPHA * __uint_as_float(b.y & 0xffff0000u));
                        w.z = cvt_pk_bf16(v1[0] + ALPHA * __uint_as_float(b.z << 16), v1[1] + ALPHA * __uint_as_float(b.z & 0xffff0000u)); w.w = cvt_pk_bf16(v1[2] + ALPHA * __uint_as_float(b.w << 16), v1[3] + ALPHA * __uint_as_float(b.w & 0xffff0000u));
                        *(u32x4*)hp = w; } } }
    }
};
struct EpiGU {
    static constexpr bool PERM = true;
    bf16_t* U;
    __device__ __forceinline__ void operator()(const f32x4 (&acc)[2][2][4][2], const Unit& u, int wr, int wc, int fr, int fq, const PG8_LAS int* rowtab) const {
        const int col0 = u.pn * HALF + wc * 32 + 8 * fq;
#pragma unroll
        for (int ai = 0; ai < 2; ++ai)
#pragma unroll
            for (int m = 0; m < 4; ++m) { const int slot = rowtab[u.tab * 256 + ai * HALF + wr * 64 + m * 16 + fr];
                if (slot >= 0) { float o[8];
#pragma unroll
                    for (int n = 0; n < 2; ++n)
#pragma unroll
                        for (int c = 0; c < 4; ++c) { const float g = acc[ai][0][m][n][c], up = acc[ai][1][m][n][c]; o[n * 4 + c] = g * up * __builtin_amdgcn_rcpf(1.f + __builtin_amdgcn_exp2f(-g * LOG2E)); }
                    u32x4 w; w.x = cvt_pk_bf16(o[0], o[1]); w.y = cvt_pk_bf16(o[2], o[3]); w.z = cvt_pk_bf16(o[4], o[5]); w.w = cvt_pk_bf16(o[6], o[7]);
                    *(u32x4*)(U + (size_t)slot * DEXP + col0) = w; } }
    }
};
struct EpiDown {
    static constexpr bool PERM = true;
    bf16_t* Y; const float* GV;
    __device__ __forceinline__ void operator()(const f32x4 (&acc)[2][2][4][2], const Unit& u, int wr, int wc, int fr, int fq, const PG8_LAS int* rowtab) const {
        const int col0 = u.pn * BM + wc * 32 + 8 * fq;
#pragma unroll
        for (int ai = 0; ai < 2; ++ai)
#pragma unroll
            for (int m = 0; m < 4; ++m) { const int slot = rowtab[u.tab * 256 + ai * HALF + wr * 64 + m * 16 + fr];
                if (slot >= 0) { const float gv = GV[slot];
#pragma unroll
                    for (int bj = 0; bj < 2; ++bj) { const f32x4 v0 = acc[ai][bj][m][0] * gv, v1 = acc[ai][bj][m][1] * gv;
                        u32x4 w; w.x = cvt_pk_bf16(v0[0], v0[1]); w.y = cvt_pk_bf16(v0[2], v0[3]); w.z = cvt_pk_bf16(v1[0], v1[1]); w.w = cvt_pk_bf16(v1[2], v1[3]);
                        *(u32x4*)(Y + (size_t)slot * DM + col0 + bj * HALF) = w; } } }
    }
};
}
namespace attn_body {
using bf16=__hip_bfloat16;
using bf16x8=__attribute__((ext_vector_type(8)))short;
using s16x4=__attribute__((ext_vector_type(4)))short;
using f32x16=__attribute__((ext_vector_type(16)))float;
using u32x4=__attribute__((ext_vector_type(4)))unsigned;
constexpr int D=64;
constexpr int NW=8,QBLK=32,QB=QBLK*NW,KVBLK=64,NQB=SEQ/QB;
constexpr int ATTN_PITCH=DM, ATTN_UNIT_ROWS=QB;
__device__ __forceinline__ int crow(int r,int hi){return (r&3)+8*(r>>2)+4*hi;}
#define SBAR() __builtin_amdgcn_sched_barrier(0)
__device__ __forceinline__ void cmask(f32x16&p0,f32x16&p1,int jb,int qrel,int hi){
  const float NEG=-INFINITY; int kb=64*jb+4*hi;
  #pragma unroll
  for(int r=0;r<16;++r){int kv=kb+(r&3)+8*(r>>2); if(kv>qrel)p0[r]=NEG; if(kv+32>qrel)p1[r]=NEG;}
}

constexpr int RT_OFFS=320, RT_SIZE=704;

template<int MODE> __device__ __forceinline__ void modtile_slow(f32x16&p0,f32x16&p1,int t,int q_abs,int q0,int hi,const __attribute__((address_space(3))) float* tab){
  const float NEG=-INFINITY; int hi4=4*hi; asm volatile("":"+v"(hi4),"+v"(q_abs));
  if(MODE==0){
    if(t==0){
      int bd=16+q_abs; bd=bd>383?383:bd; const __attribute__((address_space(3))) float* bp=tab+(RT_OFFS+bd-hi4-15);
      #pragma unroll
      for(int r=0;r<16;++r){ p1[r]=NEG; if(r<8)p0[r]+=bp[15-((r&3)+8*(r>>2))]; else p0[r]=NEG; }
    } else {
      const __attribute__((address_space(3))) float* bp=tab+(RT_OFFS+q_abs-64*t+KPRE-hi4-63);
      const int dq=q_abs-64*t+KPRE-hi4;
      #pragma unroll
      for(int r=0;r<16;++r){ const int c=(r&3)+8*(r>>2); p0[r]+=bp[63-c]; p1[r]+=bp[31-c]; }
      if(64*t-KPRE+63>q0){
        #pragma unroll
        for(int r=0;r<16;++r){ const int c=(r&3)+8*(r>>2); if(c>dq)p0[r]=NEG; if(c+32>dq)p1[r]=NEG; } }
    }
  } else {
    if(t==0){
      #pragma unroll
      for(int r=0;r<16;++r){ p1[r]=NEG; if(r<8)p0[r]+=tab[(r&3)+8*(r>>2)+hi4]; else p0[r]=NEG; }
    } else {
      typedef float f4 __attribute__((ext_vector_type(4)));
      const __attribute__((address_space(3))) f4* tp=(const __attribute__((address_space(3))) f4*)(tab+64*t+hi4);
      #pragma unroll
      for(int g=0;g<4;++g){ const f4 a=tp[2*g], b=tp[8+2*g];
        #pragma unroll
        for(int c=0;c<4;++c){ p0[4*g+c]+=a[c]; p1[4*g+c]+=b[c]; }
        asm volatile("":::"memory"); }
      if(64*t-KPRE+63>q0){
        const int dq=q_abs-64*t+KPRE-hi4;
        #pragma unroll
        for(int r=0;r<16;++r){ const int c=(r&3)+8*(r>>2); if(c>dq)p0[r]=NEG; if(c+32>dq)p1[r]=NEG; } }
    }
  }
}
__device__ __forceinline__ void modtile_fast1(f32x16&p0,f32x16&p1,int t,int hi,const __attribute__((address_space(3))) float* tab){
  typedef float f4 __attribute__((ext_vector_type(4)));
  const __attribute__((address_space(3))) f4* tp=(const __attribute__((address_space(3))) f4*)(tab+64*t+4*hi);
  #pragma unroll
  for(int g=0;g<4;++g){ const f4 a=tp[2*g], b=tp[8+2*g];
    #pragma unroll
    for(int c=0;c<4;++c){ p0[4*g+c]+=a[c]; p1[4*g+c]+=b[c]; } }
}
constexpr int NSLOT=3, SLOTB=8192;
constexpr int LDS_K=0, LDS_V=NSLOT*SLOTB, LDS_WS=2*NSLOT*SLOTB, LDS_OST=LDS_WS+NW*64*4, LDS_TAB=LDS_OST+NW*4096, LDS_BYTES=LDS_TAB+KROWS*4;
constexpr float C2=0.125f*1.4426950408889634f;
__device__ __forceinline__ void glds16(const void*gsrc,unsigned lds_dst){unsigned keep;
  asm volatile("s_mov_b32 %0, m0\n\ts_mov_b32 m0, %2\n\ts_nop 0\n\tglobal_load_lds_dwordx4 %1, off\n\ts_mov_b32 m0, %0":"=&s"(keep):"v"(gsrc),"s"(lds_dst):"memory");}
__device__ __forceinline__ float max3f(float a,float b,float c){float r;asm("v_max3_f32 %0, %1, %2, %3":"=v"(r):"v"(a),"v"(b),"v"(c));return r;}
__device__ __forceinline__ float max2f(float a,float b){float r;asm("v_max_f32_e32 %0, %1, %2":"=v"(r):"v"(a),"v"(b));return r;}
__device__ __forceinline__ float fadd_s(float a,float b){float r;asm("v_add_f32_e32 %0, %1, %2":"=v"(r):"v"(a),"v"(b));return r;}
__device__ __forceinline__ float fsub_s(float a,float b){float r;asm("v_sub_f32_e32 %0, %1, %2":"=v"(r):"v"(a),"v"(b));return r;}
typedef float f32x2_t __attribute__((ext_vector_type(2))); typedef __bf16 bf16x2_t __attribute__((ext_vector_type(2)));
__device__ __forceinline__ unsigned cvtpk_s(float lo,float hi){f32x2_t v={lo,hi};bf16x2_t b=__builtin_convertvector(v,bf16x2_t);return __builtin_bit_cast(unsigned,b);}
#define WAIT_BAR(N) asm volatile("s_waitcnt vmcnt(" #N ") lgkmcnt(0)\n\ts_barrier":::"memory")

__device__ __forceinline__ void qkt(f32x16&p0,f32x16&p1,const char*Kslot,const bf16x8*qr,const f32x16&negm,int r32,int hi){
  const char*kb=Kslot+hi*1024+r32*16;
  #pragma unroll
  for(int d0=0;d0<4;++d0){
    const bf16x8 b0=*reinterpret_cast<const bf16x8*>(kb+d0*2048);
    const bf16x8 b1=*reinterpret_cast<const bf16x8*>(kb+d0*2048+512);
    if(d0==0){p0=__builtin_amdgcn_mfma_f32_32x32x16_bf16(b0,qr[0],negm,0,0,0);p1=__builtin_amdgcn_mfma_f32_32x32x16_bf16(b1,qr[0],negm,0,0,0);}
    else{p0=__builtin_amdgcn_mfma_f32_32x32x16_bf16(b0,qr[d0],p0,0,0,0);p1=__builtin_amdgcn_mfma_f32_32x32x16_bf16(b1,qr[d0],p1,0,0,0);}}
}
typedef __attribute__((address_space(3))) const char* lds_cptr;
typedef short v4i16_t __attribute__((ext_vector_type(4)));
__device__ __forceinline__ void kload8(bf16x8*kf,lds_cptr kp){
  kf[0]=*(const __attribute__((address_space(3))) bf16x8*)(kp);      kf[1]=*(const __attribute__((address_space(3))) bf16x8*)(kp+512);
  kf[2]=*(const __attribute__((address_space(3))) bf16x8*)(kp+2048); kf[3]=*(const __attribute__((address_space(3))) bf16x8*)(kp+2560);
  kf[4]=*(const __attribute__((address_space(3))) bf16x8*)(kp+4096); kf[5]=*(const __attribute__((address_space(3))) bf16x8*)(kp+4608);
  kf[6]=*(const __attribute__((address_space(3))) bf16x8*)(kp+6144); kf[7]=*(const __attribute__((address_space(3))) bf16x8*)(kp+6656);
}
__device__ __forceinline__ void kload2(bf16x8*kf,lds_cptr kp,int j){ kf[2*j]=*(const __attribute__((address_space(3))) bf16x8*)(kp+j*2048); kf[2*j+1]=*(const __attribute__((address_space(3))) bf16x8*)(kp+j*2048+512); }
__device__ __forceinline__ s16x4 vtr(lds_cptr p){ return __builtin_bit_cast(s16x4,__builtin_amdgcn_ds_read_tr16_b64_v4i16((__attribute__((address_space(3))) v4i16_t*)p)); }
__device__ __forceinline__ float rowmax(const f32x16&p0,const f32x16&p1){
  float a=max3f(p0[0],p0[1],p1[0]),b=max3f(p0[2],p0[3],p1[1]);a=max3f(a,p1[2],p1[3]);
  #pragma unroll
  for(int r=4;r<16;r+=4){a=max3f(a,p0[r],p0[r+1]);b=max3f(b,p0[r+2],p0[r+3]);a=max3f(a,p1[r],p1[r+1]);b=max3f(b,p1[r+2],p1[r+3]);}
  const float m=max2f(a,b);
  auto rr=__builtin_amdgcn_permlane32_swap(__float_as_uint(m),__float_as_uint(m),false,false);
  return max2f(__uint_as_float(rr[0]),__uint_as_float(rr[1]));
}
__device__ __forceinline__ void pv(f32x16*o,int vb,bf16x8 pa0,bf16x8 pa1,bf16x8 pa2,bf16x8 pa3){
  #pragma unroll
  for(int d0=0;d0<2;++d0){s16x4 lo[4],hi[4];
    #pragma unroll
    for(int ks=0;ks<4;++ks){
      asm volatile("ds_read_b64_tr_b16 %0,%1 offset:%c2":"=&v"(lo[ks]):"v"(vb),"i"(d0*4096+ks*1024):"memory");
      asm volatile("ds_read_b64_tr_b16 %0,%1 offset:%c2":"=&v"(hi[ks]):"v"(vb),"i"(d0*4096+ks*1024+512):"memory");}
    asm volatile("s_waitcnt lgkmcnt(0)":::"memory");SBAR();
    #define PK(k) (bf16x8){lo[k][0],lo[k][1],lo[k][2],lo[k][3],hi[k][0],hi[k][1],hi[k][2],hi[k][3]}
    o[d0]=__builtin_amdgcn_mfma_f32_32x32x16_bf16(pa0,PK(0),o[d0],0,0,0);
    o[d0]=__builtin_amdgcn_mfma_f32_32x32x16_bf16(pa1,PK(1),o[d0],0,0,0);
    o[d0]=__builtin_amdgcn_mfma_f32_32x32x16_bf16(pa2,PK(2),o[d0],0,0,0);
    o[d0]=__builtin_amdgcn_mfma_f32_32x32x16_bf16(pa3,PK(3),o[d0],0,0,0);
    #undef PK
  }
}

#ifndef ATTN_STORE16
#define ATTN_STORE16(p,v) (*(u32x4*)(p)=(v))
#endif
template<int MODE,int THRL> __device__ __forceinline__ void attn_unit(int b,int qb,int tb,int cq,int cv,int co,const bf16*Q,const bf16*__restrict__ K,const bf16*__restrict__ V,bf16*O,const float*tabsrc,char*shm){
  int tid_=threadIdx.x; asm volatile("":"+v"(tid_));
  const int tid=tid_,lane=tid&63,r32=lane&31,hi=lane>>5; const int wid=__builtin_amdgcn_readfirstlane(tid>>6);
  const long rowbase=(long)b*SEQ, rowbase_k=(long)b*KROWS; const int q0=qb*QB;
  const bf16*Qw=Q+(rowbase+q0+wid*QBLK)*DM+cq;
  const bf16*Kh=K+rowbase_k*DM+cq,*Vh=V+rowbase_k*DM+cv;
  const unsigned lds0=(unsigned)(uintptr_t)shm;
  const __attribute__((address_space(3))) char* shm3_=(const __attribute__((address_space(3))) char*)shm;
  float*wsf=(float*)(shm+LDS_WS)+wid*64;
  const bf16*ksrc=Kh+(long)(lane+64*tb)*DM+wid*8;
  const bf16*vsrc=Vh+(long)(16*(wid&3)+(lane>>2)+64*tb)*DM+(wid>>2)*32+(lane&3)*8;
  const unsigned kdst=lds0+LDS_K+wid*1024, vdst=lds0+LDS_V+wid*1024;
  #define DMA_K(t,slot) glds16(ksrc+(long)(t)*KVBLK*DM,(unsigned)__builtin_amdgcn_readfirstlane(kdst+(slot)))
  #define DMA_V(t,slot) glds16(vsrc+(long)(t)*KVBLK*DM,(unsigned)__builtin_amdgcn_readfirstlane(vdst+(slot)))
  const int vb0=(int)(lds0+LDS_V)+((lane>>4)&1)*32+(lane&3)*8+(4*hi+((lane&15)>>2))*64;
  const char*Kbase=shm+LDS_K; bf16x8 kf[8];
  const lds_cptr shm3=(lds_cptr)shm; const lds_cptr kp0=shm3+LDS_K+hi*1024+r32*16; const lds_cptr vp0=shm3+LDS_V+((lane>>4)&1)*32+(lane&3)*8+(4*hi+((lane&15)>>2))*64;
  const int NT=(KPRE+q0+QB+KVBLK)/KVBLK-tb;
  const __attribute__((address_space(3))) float* tab=(const __attribute__((address_space(3))) float*)(shm3_+LDS_TAB);
  { __attribute__((address_space(3))) float* tw=(__attribute__((address_space(3))) float*)(shm3_+LDS_TAB);
    if(MODE==0){ for(int i=tid;i<RT_SIZE;i+=512){ const int d=i-RT_OFFS; tw[i]=d<0?-INFINITY:(d<128?tabsrc[d]:0.f); } }
    else { const int n=KPRE+q0+QB+KVBLK; for(int i=64*tb+tid*4;i<n;i+=2048){ const float4 v=*(const float4*)(tabsrc+i); tw[i]=v.x;tw[i+1]=v.y;tw[i+2]=v.z;tw[i+3]=v.w; } } }
  if(tb==0){ glds16(K+cq+(long)lane*DM+wid*8,(unsigned)__builtin_amdgcn_readfirstlane(kdst)); glds16(V+cv+(long)(16*(wid&3)+(lane>>2))*DM+(wid>>2)*32+(lane&3)*8,(unsigned)__builtin_amdgcn_readfirstlane(vdst)); } else { DMA_K(0,0); DMA_V(0,0); } DMA_K(1,SLOTB);
  bf16x8 qr[4];
  #pragma unroll
  for(int d0=0;d0<4;++d0)qr[d0]=*reinterpret_cast<const bf16x8*>(&Qw[(long)r32*DM+d0*16+hi*8]);
  float l_reg=0.f;f32x16 o[2];o[0]=f32x16{};o[1]=f32x16{};f32x16 negm=f32x16{};asm volatile("":"+v"(negm));
  const int qrel=wid*QBLK+r32, q_abs=q0+qrel;
  #define MODT(P0,P1,t,SL) do{ if(SL)modtile_slow<MODE>(P0,P1,(t)+tb,q_abs,q0,hi,tab); else if(MODE==1)modtile_fast1(P0,P1,(t)+tb,hi,tab); }while(0)
  bool resc=false;
  #define START(P0,P1) do{ const float rm=rowmax(P0,P1); resc=false; \
    { const float dl=(MODE==1)?__builtin_fmaxf(rm,0.f):rm; const float nm_=fsub_s(negm[0],dl); \
      _Pragma("unroll") for(int r=0;r<16;++r){P0[r]=fsub_s(P0[r],dl);P1[r]=fsub_s(P1[r],dl);} \
      _Pragma("unroll") for(int r=0;r<16;++r)negm[r]=nm_; asm volatile("":"+v"(negm)); } \
    _Pragma("unroll") for(int r=0;r<16;++r)P0[r]=__builtin_amdgcn_exp2f(P0[r]); }while(0)
  #define RESC() do{ if(resc){ asm volatile("s_waitcnt lgkmcnt(0)":::"memory"); \
      _Pragma("unroll") for(int d_=0;d_<2;++d_) _Pragma("unroll") for(int r=0;r<16;++r)o[d_][r]*=wsf[crow(r,hi)]; } }while(0)
  f32x16 pA0,pA1,pB0,pB1;
  int sl_prev=0,sl_cur=0,sl_next=SLOTB;
  #define ROT() do{sl_prev=sl_cur;sl_cur=sl_next;sl_next=(sl_next==(NSLOT-1)*SLOTB)?0:sl_next+SLOTB;}while(0)
  DMA_K(2,2*SLOTB);
  WAIT_BAR(3);
  if(MODE==1){ const float m0_=tab[KPRE+q_abs]; _Pragma("unroll") for(int r=0;r<16;++r)negm[r]=-m0_; asm volatile("":"+v"(negm)); }
  qkt(pA0,pA1,Kbase,qr,negm,r32,hi);asm volatile("s_nop 15\n\ts_nop 7":"+v"(pA0),"+v"(pA1));MODT(pA0,pA1,0,true);
  START(pA0,pA1);
  _Pragma("unroll") for(int r=0;r<16;++r)pA1[r]=__builtin_amdgcn_exp2f(pA1[r]);
  WAIT_BAR(0);
  DMA_K(3,0);DMA_V(1,SLOTB);
  ROT();
  kload8(kf,kp0+sl_cur);
  WAIT_BAR(2);
  s16x4 vlo[8],vhi[8]; u32x4 pw0,pw1,pw2,pw3;
  #define PKW(P,B) cvtpk_s(P[B],P[B+1])
  #define PAF(k) __builtin_bit_cast(bf16x8,pw##k)
  #define VFR(i) (bf16x8){vlo[i][0],vlo[i][1],vlo[i][2],vlo[i][3],vhi[i][0],vhi[i][1],vhi[i][2],vhi[i][3]}
  #define PIN(x) asm volatile("":"+v"(x))
  #define MX3(a,b,c) __builtin_fmaxf(__builtin_fmaxf((a),(b)),(c))
  #define GAPA(MF,A0,A1,A2,A3,W0,W1,PW) do{ MF; sacc+=A0; sacc+=A1; sacc+=A2; sacc+=A3; PIN(sacc); W0; W1; PIN(PW); SBAR(); }while(0)
  #define EX(v) __builtin_amdgcn_exp2f(v)
  #define GAPB(MF,X,B) do{ MF; X[B]=EX(X[B]); X[B+1]=EX(X[B+1]); X[B+2]=EX(X[B+2]); X[B+3]=EX(X[B+3]); PIN(X); SBAR(); }while(0)
  #define VRD(i) do{ vlo[i]=vtr(vp_+(((i)>>2)*4096+((i)&3)*1024)); vhi[i]=vtr(vp_+(((i)>>2)*4096+((i)&3)*1024+512)); }while(0)
  #define KRD(G,j) do{ if(G){ kload2(kf,kp0+sl_next,j); SBAR(); } }while(0)
  #define STEP(C0,C1,P0,P1,t,GK,GV,GL,SL) do{ SBAR(); \
    const lds_cptr vp_=vp0+sl_prev; \
    VRD(0); SBAR(); float sacc=(P0[0]+P0[1]); \
    GAPA(C0=__builtin_amdgcn_mfma_f32_32x32x16_bf16(kf[0],qr[0],negm,0,0,0), P0[2],P0[3],P0[4],P0[5],     pw0[0]=PKW(P0,0), pw0[1]=PKW(P0,2), pw0); \
    VRD(4); SBAR(); GAPA(C1=__builtin_amdgcn_mfma_f32_32x32x16_bf16(kf[1],qr[0],negm,0,0,0), P0[6],P0[7],P0[8],P0[9],     pw0[2]=PKW(P0,4), pw0[3]=PKW(P0,6), pw0); \
    VRD(1); SBAR(); GAPA(C0=__builtin_amdgcn_mfma_f32_32x32x16_bf16(kf[2],qr[1],C0,0,0,0),   P0[10],P0[11],P0[12],P0[13], pw1[0]=PKW(P0,8), pw1[1]=PKW(P0,10), pw1); \
    VRD(5); SBAR(); GAPA(C1=__builtin_amdgcn_mfma_f32_32x32x16_bf16(kf[3],qr[1],C1,0,0,0),   P0[14],P0[15],P1[0],P1[1],   pw1[2]=PKW(P0,12),pw1[3]=PKW(P0,14), pw1); \
    VRD(2); SBAR(); GAPA(C0=__builtin_amdgcn_mfma_f32_32x32x16_bf16(kf[4],qr[2],C0,0,0,0),   P1[2],P1[3],P1[4],P1[5],     pw2[0]=PKW(P1,0), pw2[1]=PKW(P1,2), pw2); \
    VRD(6); SBAR(); GAPA(C1=__builtin_amdgcn_mfma_f32_32x32x16_bf16(kf[5],qr[2],C1,0,0,0),   P1[6],P1[7],P1[8],P1[9],     pw2[2]=PKW(P1,4), pw2[3]=PKW(P1,6), pw2); \
    VRD(3); SBAR(); GAPA(C0=__builtin_amdgcn_mfma_f32_32x32x16_bf16(kf[6],qr[3],C0,0,0,0),   P1[10],P1[11],P1[12],P1[13], pw3[0]=PKW(P1,8), pw3[1]=PKW(P1,10), pw3); \
    VRD(7); SBAR(); GAPA(C1=__builtin_amdgcn_mfma_f32_32x32x16_bf16(kf[7],qr[3],C1,0,0,0),   P1[14],P1[15],0.f,0.f,       pw3[2]=PKW(P1,12),pw3[3]=PKW(P1,14), pw3); \
    l_reg+=sacc; \
    if(GK){DMA_K((t)+3,sl_cur);} if(GV){DMA_V((t)+1,sl_next);} \
    MODT(C0,C1,t,SL); \
    { float a=MX3(C0[0],C0[1],C1[0]),b=MX3(C0[2],C0[3],C1[1]); a=MX3(a,C1[2],C1[3]); \
      _Pragma("unroll") for(int r=4;r<16;r+=4){a=MX3(a,C0[r],C0[r+1]);b=MX3(b,C0[r+2],C0[r+3]);a=MX3(a,C1[r],C1[r+1]);b=MX3(b,C1[r+2],C1[r+3]);} \
      float rm=__builtin_fmaxf(a,b); { auto rr=__builtin_amdgcn_permlane32_swap(__float_as_uint(rm),__float_as_uint(rm),false,false); rm=__builtin_fmaxf(__uint_as_float(rr[0]),__uint_as_float(rr[1])); } \
      resc=false; \
      if(__builtin_expect(__any(rm>(float)THRL),0)){ const float dl=__builtin_fmaxf(rm,0.f); const float nm_=negm[0]-dl; \
        _Pragma("unroll") for(int r=0;r<16;++r){C0[r]-=dl;C1[r]-=dl;} \
        _Pragma("unroll") for(int r=0;r<16;++r)negm[r]=nm_; asm volatile("":"+v"(negm)); \
        const float f=__builtin_amdgcn_exp2f(-dl); l_reg*=f; if(hi==0){ int r32_=r32; asm volatile("":"+v"(r32_)); wsf[r32_]=f; } resc=true; } } \
    SBAR(); \
    GAPB(o[0]=__builtin_amdgcn_mfma_f32_32x32x16_bf16(PAF(0),VFR(0),o[0],0,0,0), C0,0); \
    GAPB(o[1]=__builtin_amdgcn_mfma_f32_32x32x16_bf16(PAF(0),VFR(4),o[1],0,0,0), C0,4); \
    KRD(GL,0); GAPB(o[0]=__builtin_amdgcn_mfma_f32_32x32x16_bf16(PAF(1),VFR(1),o[0],0,0,0), C0,8); \
    KRD(GL,1); GAPB(o[1]=__builtin_amdgcn_mfma_f32_32x32x16_bf16(PAF(1),VFR(5),o[1],0,0,0), C0,12); \
    KRD(GL,2); GAPB(o[0]=__builtin_amdgcn_mfma_f32_32x32x16_bf16(PAF(2),VFR(2),o[0],0,0,0), C1,0); \
    KRD(GL,3); GAPB(o[1]=__builtin_amdgcn_mfma_f32_32x32x16_bf16(PAF(2),VFR(6),o[1],0,0,0), C1,4); \
    GAPB(o[0]=__builtin_amdgcn_mfma_f32_32x32x16_bf16(PAF(3),VFR(3),o[0],0,0,0), C1,8); \
    GAPB(o[1]=__builtin_amdgcn_mfma_f32_32x32x16_bf16(PAF(3),VFR(7),o[1],0,0,0), C1,12); \
    }while(0)
  int t=1;
  #define ENDW(tt) do{ if((tt)+3<NT){WAIT_BAR(2);} else if((tt)+2<NT){WAIT_BAR(1);} else {WAIT_BAR(0);} }while(0)
  for(;t+(MODE==1?5:7)<NT;t+=2){
    STEP(pB0,pB1,pA0,pA1,t,true,true,true,false);     WAIT_BAR(2); RESC(); ROT();
    STEP(pA0,pA1,pB0,pB1,t+1,true,true,true,false);   WAIT_BAR(2); RESC(); ROT();
  }
  for(;t+1<NT;t+=2){
    STEP(pB0,pB1,pA0,pA1,t,(t+3<NT),(t+1<NT),(t+1<NT),true);       ENDW(t);   RESC(); ROT();
    STEP(pA0,pA1,pB0,pB1,t+1,(t+4<NT),(t+2<NT),(t+2<NT),true);     ENDW(t+1); RESC(); ROT();
  }
  STEP(pB0,pB1,pA0,pA1,NT-1,false,false,false,true); RESC();
  { float sacc=pB0[0]+pB0[1]; _Pragma("unroll") for(int r=2;r<16;++r)sacc+=pB0[r]; _Pragma("unroll") for(int r=0;r<16;++r)sacc+=pB1[r]; l_reg+=sacc;
    pw0=(u32x4){PKW(pB0,0),PKW(pB0,2),PKW(pB0,4),PKW(pB0,6)};pw1=(u32x4){PKW(pB0,8),PKW(pB0,10),PKW(pB0,12),PKW(pB0,14)};pw2=(u32x4){PKW(pB1,0),PKW(pB1,2),PKW(pB1,4),PKW(pB1,6)};pw3=(u32x4){PKW(pB1,8),PKW(pB1,10),PKW(pB1,12),PKW(pB1,14)};
    SBAR(); pv(o,vb0+sl_cur,PAF(0),PAF(1),PAF(2),PAF(3)); }
  #undef PKW
  #undef PAF
  #undef VFR
  #undef PIN
  #undef MX3
  #undef GAPA
  #undef GAPB
  #undef EX
  #undef VRD
  #undef KRD
  #undef STEP
  #undef ENDW
  {auto rr=__builtin_amdgcn_permlane32_swap(__float_as_uint(l_reg),__float_as_uint(l_reg),false,false);l_reg=__uint_as_float(rr[0])+__uint_as_float(rr[1]);}
  if(hi==0)wsf[32+r32]=l_reg;asm volatile("s_waitcnt lgkmcnt(0)":::"memory");
  float rli[16];
  #pragma unroll
  for(int r=0;r<16;++r)rli[r]=__builtin_amdgcn_rcpf(wsf[32+crow(r,hi)]);
  bf16*Ow=O+(rowbase+q0+wid*QBLK)*DM+co;
  { bf16*stg=(bf16*)(shm+LDS_OST)+wid*2048;
    #pragma unroll
    for(int r=0;r<16;++r){const int orow=crow(r,hi);
      #pragma unroll
      for(int d0=0;d0<2;++d0)stg[orow*64+d0*32+r32]=__float2bfloat16(o[d0][r]*rli[r]);}
    asm volatile("s_waitcnt lgkmcnt(0)":::"memory");
    #pragma unroll
    for(int i=0;i<4;++i){const int row=i*8+(lane>>3),ch=lane&7; const u32x4 v=*(const u32x4*)(stg+row*64+ch*8); ATTN_STORE16(Ow+(long)row*DM+ch*8,v);} }
  asm volatile("s_waitcnt lgkmcnt(0)\n\ts_barrier":::"memory");
  #undef DMA_K
  #undef DMA_V
  #undef MODT
  #undef START
  #undef RESC
  #undef ROT
}

template<int THRL> __device__ __forceinline__ void attn_unit_dv(int b,int qb,int cq,int cv,int co,const bf16*Q,const bf16*__restrict__ K,const bf16*__restrict__ V,bf16*O,const float*tabsrc,char*shm){
  int tid_=threadIdx.x; asm volatile("":"+v"(tid_));
  constexpr int MODE=0, tb=0; const int tid=tid_,lane=tid&63,r32=lane&31,hi=lane>>5; const int wid=__builtin_amdgcn_readfirstlane(tid>>6);
  constexpr int LDS_K=0, LDS_V=NSLOT*SLOTB, LDS_WS=LDS_V+NSLOT*2*SLOTB, LDS_OST=LDS_WS+NW*64*4, LDS_TAB=LDS_OST+NW*4096;
  static_assert(LDS_TAB+RT_SIZE*4<=131072,"dv LDS map");
  const long rowbase=(long)b*SEQ, rowbase_k=(long)b*KROWS; const int q0=qb*QB;
  const bf16*Qw=Q+(rowbase+q0+wid*QBLK)*DM+cq;
  const bf16*Kh=K+rowbase_k*DM+cq,*Vh=V+rowbase_k*DM+cv;
  const unsigned lds0=(unsigned)(uintptr_t)shm;
  const __attribute__((address_space(3))) char* shm3_=(const __attribute__((address_space(3))) char*)shm;
  float*wsf=(float*)(shm+LDS_WS)+wid*64;
  const bf16*ksrc=Kh+(long)(lane+64*tb)*DM+wid*8;
  const bf16*vsrc=Vh+(long)(16*(wid&3)+(lane>>2)+64*tb)*DM+(wid>>2)*32+(lane&3)*8;
  const unsigned kdst=lds0+LDS_K+wid*1024, vdst=lds0+LDS_V+wid*1024;
  #define DMA_K(t,slot) glds16(ksrc+(long)(t)*KVBLK*DM,(unsigned)__builtin_amdgcn_readfirstlane(kdst+(slot)))
  #define DMA_V(t,slot) do{ glds16(vsrc+(long)(t)*KVBLK*DM,(unsigned)__builtin_amdgcn_readfirstlane(vdst+2*(slot))); glds16(vsrc+(long)(t)*KVBLK*DM+64,(unsigned)__builtin_amdgcn_readfirstlane(vdst+2*(slot)+8192)); }while(0)
  const int vb0=(int)(lds0+LDS_V)+((lane>>4)&1)*32+(lane&3)*8+(4*hi+((lane&15)>>2))*64;
  const char*Kbase=shm+LDS_K; bf16x8 kf[8];
  const lds_cptr shm3=(lds_cptr)shm; const lds_cptr kp0=shm3+LDS_K+hi*1024+r32*16; const lds_cptr vp0=shm3+LDS_V+((lane>>4)&1)*32+(lane&3)*8+(4*hi+((lane&15)>>2))*64;
  const int NT=(KPRE+q0+QB+KVBLK)/KVBLK-tb;
  const __attribute__((address_space(3))) float* tab=(const __attribute__((address_space(3))) float*)(shm3_+LDS_TAB);
  { __attribute__((address_space(3))) float* tw=(__attribute__((address_space(3))) float*)(shm3_+LDS_TAB);
    if(MODE==0){ for(int i=tid;i<RT_SIZE;i+=512){ const int d=i-RT_OFFS; tw[i]=d<0?-INFINITY:(d<128?tabsrc[d]:0.f); } }
    else { const int n=KPRE+q0+QB+KVBLK; for(int i=64*tb+tid*4;i<n;i+=2048){ const float4 v=*(const float4*)(tabsrc+i); tw[i]=v.x;tw[i+1]=v.y;tw[i+2]=v.z;tw[i+3]=v.w; } } }
  if(tb==0){ glds16(K+cq+(long)lane*DM+wid*8,(unsigned)__builtin_amdgcn_readfirstlane(kdst)); glds16(V+cv+(long)(16*(wid&3)+(lane>>2))*DM+(wid>>2)*32+(lane&3)*8,(unsigned)__builtin_amdgcn_readfirstlane(vdst)); glds16(V+cv+(long)(16*(wid&3)+(lane>>2))*DM+(wid>>2)*32+(lane&3)*8+64,(unsigned)__builtin_amdgcn_readfirstlane(vdst+8192)); } else { DMA_K(0,0); DMA_V(0,0); } DMA_K(1,SLOTB);
  bf16x8 qr[4];
  #pragma unroll
  for(int d0=0;d0<4;++d0)qr[d0]=*reinterpret_cast<const bf16x8*>(&Qw[(long)r32*DM+d0*16+hi*8]);
  float mhat=0.f,l_reg=0.f;f32x16 o[4];o[0]=f32x16{};o[1]=f32x16{};o[2]=f32x16{};o[3]=f32x16{};const f32x16 zero16=f32x16{}; bool hasref=false;
  const int qrel=wid*QBLK+r32, q_abs=q0+qrel;
  #define MODT(P0,P1,t,SL) do{ if(SL)modtile_slow<MODE>(P0,P1,(t)+tb,q_abs,q0,hi,tab); else if(MODE==1)modtile_fast1(P0,P1,(t)+tb,hi,tab); }while(0)
  bool resc=false;
  #define START(P0,P1) do{ const float rm=rowmax(P0,P1); resc=false; mhat=(rm>=-64.f&&rm<64.f)?0.f:64.f*__builtin_floorf(rm*0.015625f+0.5f); hasref=__any(mhat!=0.f); \
    if(__builtin_expect(hasref,0)){ _Pragma("unroll") for(int r=0;r<16;++r){P0[r]-=mhat;P1[r]-=mhat;} } \
    _Pragma("unroll") for(int r=0;r<16;++r)P0[r]=__builtin_amdgcn_exp2f(P0[r]); }while(0)
  #define RESC() do{ if(resc){ asm volatile("s_waitcnt lgkmcnt(0)":::"memory"); \
      _Pragma("unroll") for(int d_=0;d_<4;++d_) _Pragma("unroll") for(int r=0;r<16;++r)o[d_][r]*=wsf[crow(r,hi)]; } }while(0)
  f32x16 pA0,pA1,pB0,pB1;
  int sl_prev=0,sl_cur=0,sl_next=SLOTB;
  #define ROT() do{sl_prev=sl_cur;sl_cur=sl_next;sl_next=(sl_next==(NSLOT-1)*SLOTB)?0:sl_next+SLOTB;}while(0)
  DMA_K(2,2*SLOTB);
  WAIT_BAR(3);
  qkt(pA0,pA1,Kbase,qr,zero16,r32,hi);asm volatile("s_nop 15\n\ts_nop 7":"+v"(pA0),"+v"(pA1));MODT(pA0,pA1,0,true);
  START(pA0,pA1);
  _Pragma("unroll") for(int r=0;r<16;++r)pA1[r]=__builtin_amdgcn_exp2f(pA1[r]);
  WAIT_BAR(0);
  DMA_K(3,0);DMA_V(1,SLOTB);
  ROT();
  kload8(kf,kp0+sl_cur);
  WAIT_BAR(3);
  s16x4 vlo[8],vhi[8],wlo[8],whi[8]; u32x4 pw0,pw1,pw2,pw3;
  #define PKW(P,B) cvtpk_s(P[B],P[B+1])
  #define PAF(k) __builtin_bit_cast(bf16x8,pw##k)
  #define VFR(i) (bf16x8){vlo[i][0],vlo[i][1],vlo[i][2],vlo[i][3],vhi[i][0],vhi[i][1],vhi[i][2],vhi[i][3]}
  #define WFR(i) (bf16x8){wlo[i][0],wlo[i][1],wlo[i][2],wlo[i][3],whi[i][0],whi[i][1],whi[i][2],whi[i][3]}
  #define WRD(i) do{ wlo[i]=vtr(vp_+((2+((i)>>2))*4096+((i)&3)*1024)); whi[i]=vtr(vp_+((2+((i)>>2))*4096+((i)&3)*1024+512)); SBAR(); }while(0)
  #define GAPB2(MF,X,B) do{ MF; X[B]=EX(X[B]); X[B+1]=EX(X[B+1]); PIN(X); SBAR(); }while(0)
  #define PIN(x) asm volatile("":"+v"(x))
  #define MX3(a,b,c) __builtin_fmaxf(__builtin_fmaxf((a),(b)),(c))
  #define GAPA(MF,A0,A1,A2,A3,W0,W1,PW) do{ MF; sacc+=A0; sacc+=A1; sacc+=A2; sacc+=A3; PIN(sacc); W0; W1; PIN(PW); SBAR(); }while(0)
  #define EX(v) __builtin_amdgcn_exp2f(v)
  #define GAPB(MF,X,B) do{ MF; X[B]=EX(X[B]); X[B+1]=EX(X[B+1]); X[B+2]=EX(X[B+2]); X[B+3]=EX(X[B+3]); PIN(X); SBAR(); }while(0)
  #define VRD(i) do{ vlo[i]=vtr(vp_+(((i)>>2)*4096+((i)&3)*1024)); vhi[i]=vtr(vp_+(((i)>>2)*4096+((i)&3)*1024+512)); }while(0)
  #define KRD(G,j) do{ if(G){ kload2(kf,kp0+sl_next,j); SBAR(); } }while(0)
  #define STEP(C0,C1,P0,P1,t,GK,GV,GL,SL) do{ SBAR(); \
    const lds_cptr vp_=vp0+2*sl_prev; \
    VRD(0); SBAR(); float sacc=(P0[0]+P0[1]); \
    GAPA(C0=__builtin_amdgcn_mfma_f32_32x32x16_bf16(kf[0],qr[0],zero16,0,0,0), P0[2],P0[3],P0[4],P0[5],     pw0[0]=PKW(P0,0), pw0[1]=PKW(P0,2), pw0); \
    VRD(4); SBAR(); GAPA(C1=__builtin_amdgcn_mfma_f32_32x32x16_bf16(kf[1],qr[0],zero16,0,0,0), P0[6],P0[7],P0[8],P0[9],     pw0[2]=PKW(P0,4), pw0[3]=PKW(P0,6), pw0); \
    VRD(1); SBAR(); GAPA(C0=__builtin_amdgcn_mfma_f32_32x32x16_bf16(kf[2],qr[1],C0,0,0,0),   P0[10],P0[11],P0[12],P0[13], pw1[0]=PKW(P0,8), pw1[1]=PKW(P0,10), pw1); \
    VRD(5); SBAR(); GAPA(C1=__builtin_amdgcn_mfma_f32_32x32x16_bf16(kf[3],qr[1],C1,0,0,0),   P0[14],P0[15],P1[0],P1[1],   pw1[2]=PKW(P0,12),pw1[3]=PKW(P0,14), pw1); \
    VRD(2); SBAR(); GAPA(C0=__builtin_amdgcn_mfma_f32_32x32x16_bf16(kf[4],qr[2],C0,0,0,0),   P1[2],P1[3],P1[4],P1[5],     pw2[0]=PKW(P1,0), pw2[1]=PKW(P1,2), pw2); \
    VRD(6); SBAR(); GAPA(C1=__builtin_amdgcn_mfma_f32_32x32x16_bf16(kf[5],qr[2],C1,0,0,0),   P1[6],P1[7],P1[8],P1[9],     pw2[2]=PKW(P1,4), pw2[3]=PKW(P1,6), pw2); \
    VRD(3); SBAR(); GAPA(C0=__builtin_amdgcn_mfma_f32_32x32x16_bf16(kf[6],qr[3],C0,0,0,0),   P1[10],P1[11],P1[12],P1[13], pw3[0]=PKW(P1,8), pw3[1]=PKW(P1,10), pw3); \
    VRD(7); SBAR(); GAPA(C1=__builtin_amdgcn_mfma_f32_32x32x16_bf16(kf[7],qr[3],C1,0,0,0),   P1[14],P1[15],0.f,0.f,       pw3[2]=PKW(P1,12),pw3[3]=PKW(P1,14), pw3); \
    l_reg+=sacc; \
    if(GK){DMA_K((t)+3,sl_cur);} if(GV){DMA_V((t)+1,sl_next);} \
    MODT(C0,C1,t,SL); \
    { float a=MX3(C0[0],C0[1],C1[0]),b=MX3(C0[2],C0[3],C1[1]); a=MX3(a,C1[2],C1[3]); \
      _Pragma("unroll") for(int r=4;r<16;r+=4){a=MX3(a,C0[r],C0[r+1]);b=MX3(b,C0[r+2],C0[r+3]);a=MX3(a,C1[r],C1[r+1]);b=MX3(b,C1[r+2],C1[r+3]);} \
      float rm=__builtin_fmaxf(a,b); { auto rr=__builtin_amdgcn_permlane32_swap(__float_as_uint(rm),__float_as_uint(rm),false,false); rm=__builtin_fmaxf(__uint_as_float(rr[0]),__uint_as_float(rr[1])); } \
      resc=false; \
      const float rmd=rm-mhat; \
      if(__builtin_expect(__any(rmd>64.f),0)){ const float dl=rmd>64.f?64.f*__builtin_floorf(rmd*0.015625f):0.f; mhat+=dl; hasref=true; \
        const float f=__builtin_amdgcn_exp2f(-dl); l_reg*=f; if(hi==0)wsf[r32]=f; resc=true; } \
      if(__builtin_expect(hasref,0)){ _Pragma("unroll") for(int r=0;r<16;++r){C0[r]-=mhat;C1[r]-=mhat;} } } \
    SBAR(); \
    WRD(0); GAPB2(o[0]=__builtin_amdgcn_mfma_f32_32x32x16_bf16(PAF(0),VFR(0),o[0],0,0,0), C0,0); \
    WRD(4); GAPB2(o[1]=__builtin_amdgcn_mfma_f32_32x32x16_bf16(PAF(0),VFR(4),o[1],0,0,0), C0,2); \
    WRD(1); GAPB2(o[0]=__builtin_amdgcn_mfma_f32_32x32x16_bf16(PAF(1),VFR(1),o[0],0,0,0), C0,4); \
    WRD(5); GAPB2(o[1]=__builtin_amdgcn_mfma_f32_32x32x16_bf16(PAF(1),VFR(5),o[1],0,0,0), C0,6); \
    WRD(2); GAPB2(o[0]=__builtin_amdgcn_mfma_f32_32x32x16_bf16(PAF(2),VFR(2),o[0],0,0,0), C0,8); \
    WRD(6); GAPB2(o[1]=__builtin_amdgcn_mfma_f32_32x32x16_bf16(PAF(2),VFR(6),o[1],0,0,0), C0,10); \
    WRD(3); GAPB2(o[0]=__builtin_amdgcn_mfma_f32_32x32x16_bf16(PAF(3),VFR(3),o[0],0,0,0), C0,12); \
    WRD(7); GAPB2(o[1]=__builtin_amdgcn_mfma_f32_32x32x16_bf16(PAF(3),VFR(7),o[1],0,0,0), C0,14); \
    KRD(GL,0); GAPB2(o[2]=__builtin_amdgcn_mfma_f32_32x32x16_bf16(PAF(0),WFR(0),o[2],0,0,0), C1,0); \
    KRD(GL,1); GAPB2(o[3]=__builtin_amdgcn_mfma_f32_32x32x16_bf16(PAF(0),WFR(4),o[3],0,0,0), C1,2); \
    KRD(GL,2); GAPB2(o[2]=__builtin_amdgcn_mfma_f32_32x32x16_bf16(PAF(1),WFR(1),o[2],0,0,0), C1,4); \
    KRD(GL,3); GAPB2(o[3]=__builtin_amdgcn_mfma_f32_32x32x16_bf16(PAF(1),WFR(5),o[3],0,0,0), C1,6); \
    GAPB2(o[2]=__builtin_amdgcn_mfma_f32_32x32x16_bf16(PAF(2),WFR(2),o[2],0,0,0), C1,8); \
    GAPB2(o[3]=__builtin_amdgcn_mfma_f32_32x32x16_bf16(PAF(2),WFR(6),o[3],0,0,0), C1,10); \
    GAPB2(o[2]=__builtin_amdgcn_mfma_f32_32x32x16_bf16(PAF(3),WFR(3),o[2],0,0,0), C1,12); \
    GAPB2(o[3]=__builtin_amdgcn_mfma_f32_32x32x16_bf16(PAF(3),WFR(7),o[3],0,0,0), C1,14); \
    }while(0)
  int t=1;
  #define ENDW(tt) do{ if((tt)+3<NT){WAIT_BAR(3);} else if((tt)+2<NT){WAIT_BAR(2);} else {WAIT_BAR(0);} }while(0)
  for(;t+(MODE==1?5:7)<NT;t+=2){
    STEP(pB0,pB1,pA0,pA1,t,true,true,true,false);     WAIT_BAR(3); RESC(); ROT();
    STEP(pA0,pA1,pB0,pB1,t+1,true,true,true,false);   WAIT_BAR(3); RESC(); ROT();
  }
  for(;t+1<NT;t+=2){
    STEP(pB0,pB1,pA0,pA1,t,(t+3<NT),(t+1<NT),(t+1<NT),true);       ENDW(t);   RESC(); ROT();
    STEP(pA0,pA1,pB0,pB1,t+1,(t+4<NT),(t+2<NT),(t+2<NT),true);     ENDW(t+1); RESC(); ROT();
  }
  STEP(pB0,pB1,pA0,pA1,NT-1,false,false,false,true); RESC();
  { float sacc=pB0[0]+pB0[1]; _Pragma("unroll") for(int r=2;r<16;++r)sacc+=pB0[r]; _Pragma("unroll") for(int r=0;r<16;++r)sacc+=pB1[r]; l_reg+=sacc;
    pw0=(u32x4){PKW(pB0,0),PKW(pB0,2),PKW(pB0,4),PKW(pB0,6)};pw1=(u32x4){PKW(pB0,8),PKW(pB0,10),PKW(pB0,12),PKW(pB0,14)};pw2=(u32x4){PKW(pB1,0),PKW(pB1,2),PKW(pB1,4),PKW(pB1,6)};pw3=(u32x4){PKW(pB1,8),PKW(pB1,10),PKW(pB1,12),PKW(pB1,14)};
    SBAR(); pv(o,vb0+2*sl_cur,PAF(0),PAF(1),PAF(2),PAF(3)); pv(o+2,vb0+2*sl_cur+8192,PAF(0),PAF(1),PAF(2),PAF(3)); }
  #undef PKW
  #undef PAF
  #undef VFR
  #undef PIN
  #undef MX3
  #undef GAPA
  #undef GAPB
  #undef EX
  #undef VRD
  #undef WRD
  #undef WFR
  #undef GAPB2
  #undef KRD
  #undef STEP
  #undef ENDW
  {auto rr=__builtin_amdgcn_permlane32_swap(__float_as_uint(l_reg),__float_as_uint(l_reg),false,false);l_reg=__uint_as_float(rr[0])+__uint_as_float(rr[1]);}
  if(hi==0)wsf[32+r32]=l_reg;asm volatile("s_waitcnt lgkmcnt(0)":::"memory");
  float rli[16];
  #pragma unroll
  for(int r=0;r<16;++r)rli[r]=__builtin_amdgcn_rcpf(wsf[32+crow(r,hi)]);
  bf16*Ow=O+(rowbase+q0+wid*QBLK)*DM+co;
  { bf16*stg=(bf16*)(shm+LDS_OST)+wid*2048;
    #pragma unroll
    for(int ps=0;ps<2;++ps){
      #pragma unroll
      for(int r=0;r<16;++r){const int orow=crow(r,hi);
        #pragma unroll
        for(int d0=0;d0<2;++d0)stg[orow*64+d0*32+r32]=__float2bfloat16(o[2*ps+d0][r]*rli[r]);}
      asm volatile("s_waitcnt lgkmcnt(0)":::"memory");
      #pragma unroll
      for(int i=0;i<4;++i){const int row=i*8+(lane>>3),ch=lane&7; const u32x4 v=*(const u32x4*)(stg+row*64+ch*8); ATTN_STORE16(Ow+(long)row*DM+ps*64+ch*8,v);}
      asm volatile("s_waitcnt lgkmcnt(0)":::"memory"); } }
  asm volatile("s_waitcnt lgkmcnt(0)\n\ts_barrier":::"memory");
  #undef DMA_K
  #undef DMA_V
  #undef MODT
  #undef START
  #undef RESC
  #undef ROT
}
constexpr int ATTN_LDS_BYTES=LDS_BYTES;
#undef SBAR
#undef WAIT_BAR
}
#define GAS __attribute__((address_space(1)))
#define LAS __attribute__((address_space(3)))
typedef unsigned short bf16;
typedef unsigned v4u __attribute__((ext_vector_type(4)));
typedef float f32x4 __attribute__((ext_vector_type(4)));
typedef short bf16x8 __attribute__((ext_vector_type(8)));
typedef GAS unsigned gu32;
typedef GAS unsigned long long gu64;
#define RLX_AGENT __ATOMIC_RELAXED, __HIP_MEMORY_SCOPE_AGENT
#define LDS_WAIT() asm volatile("s_waitcnt lgkmcnt(0)" ::: "memory")
#define VM_WAIT() asm volatile("s_waitcnt vmcnt(0)" ::: "memory")
__device__ __forceinline__ unsigned long long rt() { return __builtin_amdgcn_s_memrealtime(); }
__device__ __forceinline__ unsigned f2bf(float f) { unsigned u = __builtin_bit_cast(unsigned, f); return (u + 0x7fffu + ((u >> 16) & 1u)) >> 16; }
__device__ __forceinline__ unsigned pk2(float lo, float hi) { return f2bf(lo) | (f2bf(hi) << 16); }

#define XB_TMO      128
#define XB_XCNT(j)  (256  + 64 * (j))
#define XB_XSUB(j)  (1280 + 64 * (j))
#define XB_XGEN(j)  (2304 + 64 * (j))
#define XB_TOP      3328
#define XB_TOPGEN   3392
#define XCD_BAR_WORDS 3456
#define XB_SPIN_CAP (1u << 18)

__device__ __forceinline__ unsigned xb_ld(unsigned* p)              { return __hip_atomic_load(p, __ATOMIC_RELAXED, __HIP_MEMORY_SCOPE_AGENT); }
__device__ __forceinline__ unsigned xb_add(unsigned* p, unsigned v) { return __hip_atomic_fetch_add(p, v, __ATOMIC_RELAXED, __HIP_MEMORY_SCOPE_AGENT); }
__device__ __forceinline__ unsigned xb_xcc_id() { return (unsigned)__builtin_amdgcn_s_getreg((3 << 11) | 20) & 0xFu; }
#define XB_SPIN(cond, bar) do { unsigned _sp = 0; while (cond) { __builtin_amdgcn_s_sleep(1); \
    if ((++_sp & 255u) == 0u) { if (xb_ld(&(bar)[XB_TMO])) break; if (_sp > XB_SPIN_CAP) { atomicAdd(&(bar)[XB_TMO], 1u); break; } } } } while (0)

struct XcdBarrier {
    unsigned* bar; unsigned x;
    volatile LAS unsigned* st;
};

__device__ __forceinline__ XcdBarrier xcd_barrier_post(unsigned* bar, volatile LAS unsigned* st) {
    XcdBarrier b; b.bar = bar; b.x = xb_xcc_id(); b.st = st;
    if (threadIdx.x == 0) (void)xb_add(&bar[XB_XCNT(b.x)], 1u);
    return b;
}
__device__ __forceinline__ void xcd_barrier_complete(unsigned* bar, unsigned x, unsigned& nloc, unsigned& nx) {
    const unsigned G = gridDim.x * gridDim.y * gridDim.z;
    unsigned sum, cnt, mine, sp = 0u;
    for (;;) {
        sum = 0u; cnt = 0u; mine = 0u;
#pragma unroll
        for (unsigned j = 0; j < 16; ++j) { const unsigned c = xb_ld(&bar[XB_XCNT(j)]); sum += c; cnt += (c > 0u) ? 1u : 0u; mine = (j == x) ? c : mine; }
        if (sum == G) break;
        __builtin_amdgcn_s_sleep(1);
        if ((++sp & 255u) == 0u) { if (xb_ld(&bar[XB_TMO])) break; if (sp > XB_SPIN_CAP) { atomicAdd(&bar[XB_TMO], 1u); break; } }
    }
    nloc = mine > 0u ? mine : 1u; nx = cnt > 0u ? cnt : 1u;
}

__device__ __forceinline__ void xcd_barrier(const XcdBarrier& b) {
    asm volatile("s_waitcnt vmcnt(0)" ::: "memory");
    __syncthreads();
    if (threadIdx.x == 0) {
        unsigned* bar = b.bar;
        __builtin_amdgcn_s_waitcnt(0);
        unsigned nloc = b.st[0], nx = b.st[1];
        if (nloc == 0u) { xcd_barrier_complete(bar, b.x, nloc, nx); b.st[0] = nloc; b.st[1] = nx; }
        const unsigned old = xb_add(&bar[XB_XSUB(b.x)], 1u);
        const unsigned gen = old / nloc;
        if (old + 1u == (gen + 1u) * nloc) {
            __builtin_amdgcn_fence(__ATOMIC_RELEASE, "agent");
            asm volatile("s_waitcnt vmcnt(0)" ::: "memory");
            const unsigned og = xb_add(&bar[XB_TOP], 1u);
            const unsigned tg = og / nx;
            if (og + 1u == (tg + 1u) * nx) xb_add(&bar[XB_TOPGEN], 1u);
            else XB_SPIN(xb_ld(&bar[XB_TOPGEN]) == tg, bar);
            __builtin_amdgcn_fence(__ATOMIC_ACQUIRE, "agent");
            xb_add(&bar[XB_XGEN(b.x)], 1u);
            asm volatile("s_waitcnt vmcnt(0)" ::: "memory");
        } else {
            XB_SPIN(xb_ld(&bar[XB_XGEN(b.x)]) == gen, bar);
            __builtin_amdgcn_fence(__ATOMIC_ACQUIRE, "agent");
            asm volatile("s_waitcnt vmcnt(0)" ::: "memory");
        }
    }
    __syncthreads();
}

constexpr int NWAVES = 8;
#ifndef MK_PER_PHASE
#define MK_PER_PHASE 0
#endif
constexpr int N_PHASES = 16;

constexpr size_t MiB = 1u << 20;
constexpr size_t WS_CTL = 0, CTL_ZERO_BYTES = 1 * MiB;
constexpr size_t WS_GV = 1 * MiB + 512 * 1024;
constexpr size_t WS_HM = 2 * MiB;
constexpr size_t WS_TAB = 2 * MiB + 256 * 1024;
constexpr size_t WS_LF = 3 * MiB;
constexpr size_t WS_DK = 6 * MiB;
constexpr size_t WS_LIST = 9 * MiB;
constexpr int LCAP = NSLOT;
constexpr size_t WS_WQKV0 = 18 * MiB, WS_WO0 = 24 * MiB, WS_WQKV1 = 26 * MiB, WS_WO1 = 32 * MiB, WS_WGU = 34 * MiB, WS_WD = 98 * MiB;
constexpr size_t WS_XH = 130 * MiB;
constexpr size_t WS_Q = 195 * MiB;
constexpr size_t WS_K = 260 * MiB, WS_V = 325 * MiB;
constexpr size_t WS_O0 = 390 * MiB;
constexpr size_t WS_END = 455 * MiB;
static_assert(WS_LIST + (size_t)NEXP * LCAP * 4 <= WS_WQKV0 && WS_DK + (size_t)NBATCH * 16 * KROWS * 4 <= WS_LIST && WS_LF + (size_t)NRP * 16 * 4 <= WS_DK, "small arrays");
static_assert(WS_XH + (size_t)NRP * DM * 2 <= WS_Q && WS_Q + (size_t)NRP * DM * 2 <= WS_K && WS_K + (size_t)NBATCH * KROWS * DM * 2 <= WS_V && WS_V + (size_t)NBATCH * KROWS * DM * 2 <= WS_O0 && WS_O0 + (size_t)NRP * DM * 2 <= WS_END, "activations");
static_assert(WS_K + (size_t)NSLOT * DM * 2 <= WS_O0 && WS_O0 + (size_t)NSLOT * DEXP * 2 <= WS_END, "MoE overlays");
constexpr int CW_TMO = 0, CW_CODE = 1;
constexpr int CW_BAR = 4096;
constexpr int CW_QM = 131072, CW_KM = 147456, CW_QCTR = 148480;
constexpr int CW_CNT = 65536;
constexpr int RING_OFF = 0, RING_BYTES = 131072;
constexpr int ROWTAB_OFF = RING_BYTES, ROWTAB_UNITS = 12;
constexpr int MOEPRE_OFF = ROWTAB_OFF + ROWTAB_UNITS * 1024;
constexpr int MISC_OFF = MOEPRE_OFF + 512;
constexpr int LDS_BYTES = 147456;
static_assert(MISC_OFF + 128 <= LDS_BYTES && attn_body::ATTN_LDS_BYTES <= RING_BYTES, "LDS map");

struct Params {
    const float *x, *meta, *rel_bias, *w_qkv, *lam, *subln, *w_o, *fox_w_in, *fox_b_f, *fox_w_o, *ln_mix_g, *ln_mix_b, *ln_ffn_g, *ln_ffn_b, *rg_w, *rg_b, *re_w, *re_b, *w_gate, *w_up, *w_down;
    float* out; unsigned char* ws; int ph_lo, ph_hi, li, pad;
};
struct Ctx { int tid, lane, wave, vcu, G; LAS unsigned char* lds; };
__device__ __forceinline__ Ctx fresh(const Ctx& C) { Ctx r = C; int t = threadIdx.x; asm volatile("" : "+v"(t)); r.tid = t; r.lane = t & 63; r.wave = __builtin_amdgcn_readfirstlane(t >> 6); return r; }

using pg8::shx;
__device__ __forceinline__ float wave_sum(float v, int lane) {
#pragma unroll
    for (int o = 1; o < 64; o <<= 1) v += shx(v, o, lane);
    return v;
}
__device__ __forceinline__ float bf2f(unsigned short h) { return __uint_as_float((unsigned)h << 16); }
__device__ __forceinline__ float bflo(unsigned w) { return __uint_as_float(w << 16); }
__device__ __forceinline__ float bfhi(unsigned w) { return __uint_as_float(w & 0xffff0000u); }
__device__ __forceinline__ int meta_slot(int j) { return j; }

__device__ __forceinline__ void tr_item(const float* W, int ldw, int k0, int n0, bf16* WT, int ldt, int drow0, LAS float* scr, int lane) {
#pragma unroll 8
    for (int i = 0; i < 32; ++i) { const int kk = 2 * i + (lane >> 5); scr[kk * 33 + (lane & 31)] = W[(size_t)(k0 + kk) * ldw + n0 + (lane & 31)]; }
    LDS_WAIT(); asm volatile("" ::: "memory");
    const int c = lane & 7;
#pragma unroll
    for (int j = 0; j < 4; ++j) { const int n = (lane >> 3) + 8 * j; const LAS float* s = scr + (8 * c) * 33 + n;
        v4u o; o.x = pk2(s[0 * 33], s[1 * 33]); o.y = pk2(s[2 * 33], s[3 * 33]); o.z = pk2(s[4 * 33], s[5 * 33]); o.w = pk2(s[6 * 33], s[7 * 33]);
        *(GAS v4u*)(WT + (size_t)(drow0 + n) * ldt + k0 + 8 * c) = o; }
    LDS_WAIT(); asm volatile("" ::: "memory");
}
__device__ __forceinline__ void convert_experts(const Params& p, const Ctx& C, int layer, int first_item, int gw, int NGW) {
    LAS float* scr = (LAS float*)(C.lds + RING_OFF + C.wave * 16384);
    bf16* Wgu = (bf16*)(p.ws + WS_WGU); bf16* Wd = (bf16*)(p.ws + WS_WD);
    constexpr int PER_E = 768, NIT = NEXP * PER_E;
    for (int it = gw - first_item; it < NIT; it += NGW) { if (it < 0) continue;
        const int e = it / PER_E; int r = it % PER_E; const size_t eo = (size_t)(layer * NEXP + e);
        if (r < 512) { const bool up = r >= 256; r &= 255; const int kb = r >> 4, nb = r & 15, n0 = 32 * nb;
            tr_item((up ? p.w_up : p.w_gate) + eo * DM * DEXP, DEXP, 64 * kb, n0, Wgu + (size_t)e * DM * DM, DM, (n0 >> 7) * 256 + (n0 & 127) + (up ? 128 : 0), scr, C.lane); }
        else { r -= 512; const int kb = r >> 5, nb = r & 31;
            tr_item(p.w_down + eo * DEXP * DM, DM, 64 * kb, 32 * nb, Wd + (size_t)e * DM * DEXP, DEXP, 32 * nb, scr, C.lane); } }
}
__device__ __forceinline__ void p0_prologue(const Params& p, const Ctx& C) {
    LAS float* scr = (LAS float*)(C.lds + RING_OFF + C.wave * 16384);
    const int gw = C.vcu * NWAVES + C.wave, NGW = C.G * NWAVES;
    for (int it = gw; it < 4096; it += NGW) { int r = it;
        if (r < 1536) { tr_item(p.w_qkv, 3072, 64 * (r / 96), 32 * (r % 96), (bf16*)(p.ws + WS_WQKV0), DM, 32 * (r % 96), scr, C.lane); continue; } r -= 1536;
        if (r < 512) { tr_item(p.w_o, DM, 64 * (r >> 5), 32 * (r & 31), (bf16*)(p.ws + WS_WO0), DM, 32 * (r & 31), scr, C.lane); continue; } r -= 512;
        if (r < 1536) { tr_item(p.fox_w_in, 3088, 64 * (r / 96), 32 * (r % 96), (bf16*)(p.ws + WS_WQKV1), DM, 32 * (r % 96), scr, C.lane); continue; } r -= 1536;
        tr_item(p.fox_w_o, DM, 64 * (r >> 5), 32 * (r & 31), (bf16*)(p.ws + WS_WO1), DM, 32 * (r & 31), scr, C.lane); }
    convert_experts(p, C, 0, 0, gw, NGW);
    bf16* XH = (bf16*)(p.ws + WS_XH);
    for (int m = gw; m < NRP; m += NGW) {
        GAS unsigned long long* o8 = (GAS unsigned long long*)(XH + (size_t)m * DM) + C.lane;
        if (m < NR) { const GAS f32x4* xr = (const GAS f32x4*)(m < NREAL ? p.x + (size_t)m * DM : p.meta + (size_t)(m - NREAL) * DM) + C.lane;
#pragma unroll
            for (int j = 0; j < 4; ++j) { const f32x4 v = xr[64 * j]; o8[64 * j] = (unsigned long long)pk2(v.x, v.y) | ((unsigned long long)pk2(v.z, v.w) << 32); } }
        else {
#pragma unroll
            for (int j = 0; j < 4; ++j) o8[64 * j] = 0ull; } }
    { const int gt = C.vcu * (NWAVES * 64) + C.tid;
      if (gt < 16 * 128) { const int m = gt >> 7, d = gt & 127; int bk = d;
          if (d >= 16) { bk = 16 + (d >= 19) + (d >= 21) + (d >= 24) + (d >= 27) + (d >= 31) + (d >= 35) + (d >= 40) + (d >= 46) + (d >= 52) + (d >= 59) + (d >= 67) + (d >= 77) + (d >= 87) + (d >= 99) + (d >= 113); }
          ((float*)(p.ws + WS_TAB))[gt] = (p.rel_bias[bk * 16 + m] - p.rel_bias[31 * 16 + m]) * LOG2E; } }
}

__device__ __forceinline__ float diff_lambda_full(const Params& p, int lane) {
    const float a = p.lam[lane] * p.lam[64 + lane], b = p.lam[128 + lane] * p.lam[192 + lane];
    return __expf(wave_sum(a, lane)) - __expf(wave_sum(b, lane)) + LAMBDA_INIT0;
}
__device__ __forceinline__ void combine_rows(const Params& p, const Ctx& C, int b, int h, int qb, float lam) {
    const int lane = C.lane;
    const bf16* O0 = (const bf16*)(p.ws + WS_O0); const bf16* O1 = (const bf16*)p.out; bf16* OA = (bf16*)(p.ws + WS_Q);
    float sw[8];
#pragma unroll
    for (int c = 0; c < 8; ++c) sw[c] = p.subln[8 * (lane & 15) + c] * (1.f - LAMBDA_INIT0);
    asm volatile("s_waitcnt vmcnt(0)" ::: "memory");
#pragma unroll 2
    for (int i = 0; i < 8; ++i) { const size_t off = (size_t)(b * SEQ + 256 * qb + 32 * C.wave + 4 * i + (lane >> 4)) * DM + h * 128 + 8 * (lane & 15);
        const v4u a = *(const GAS v4u*)(O0 + off), bq = *(const GAS v4u*)(O1 + off);
        float dd[8]; const unsigned aw[4] = {a.x, a.y, a.z, a.w}, bw[4] = {bq.x, bq.y, bq.z, bq.w}; float ss = 0.f;
#pragma unroll
        for (int c = 0; c < 4; ++c) { dd[2 * c] = bflo(aw[c]) - lam * bflo(bw[c]); dd[2 * c + 1] = bfhi(aw[c]) - lam * bfhi(bw[c]); ss += dd[2 * c] * dd[2 * c] + dd[2 * c + 1] * dd[2 * c + 1]; }
        ss += shx(ss, 1, lane); ss += shx(ss, 2, lane); ss += shx(ss, 4, lane); ss += shx(ss, 8, lane);
        const float rs = 1.f / sqrtf(ss * (1.f / 128.f) + LN_EPS);
        v4u o; o.x = pk2(dd[0] * rs * sw[0], dd[1] * rs * sw[1]); o.y = pk2(dd[2] * rs * sw[2], dd[3] * rs * sw[3]); o.z = pk2(dd[4] * rs * sw[4], dd[5] * rs * sw[5]); o.w = pk2(dd[6] * rs * sw[6], dd[7] * rs * sw[7]);
        *(GAS v4u*)(OA + off) = o; }
}
__device__ __forceinline__ void diff_meta_attn(const Params& p, const Ctx& C, float lam) {
    const int gw = C.vcu * NWAVES + C.wave, lane = C.lane; bf16* OA = (bf16*)(p.ws + WS_Q);
    if (gw < 128) { const int h = gw >> 4, j = gw & 15, kj = lane & 15, s = (lane >> 4) & 1, m = 2 * h + s;
        const bf16* Q = (const bf16*)(p.ws + WS_Q); const bf16* K = (const bf16*)(p.ws + WS_K); const bf16* V = (const bf16*)(p.ws + WS_V);
        const bf16* qp = Q + (size_t)(NREAL + j) * DM + m * 64; const bf16* kp = K + (size_t)meta_slot(kj) * DM + m * 64;
        float dot = 0.f;
#pragma unroll
        for (int c = 0; c < 8; ++c) { const v4u qa = *(const GAS v4u*)(qp + 8 * c), ka = *(const GAS v4u*)(kp + 8 * c); const unsigned qw[4] = {qa.x, qa.y, qa.z, qa.w}, kw[4] = {ka.x, ka.y, ka.z, ka.w};
#pragma unroll
            for (int e = 0; e < 4; ++e) dot += bflo(qw[e]) * bflo(kw[e]) + bfhi(qw[e]) * bfhi(kw[e]); }
        float sc = (kj <= j) ? dot + p.rel_bias[(j - kj) * 16 + m] * LOG2E : -INFINITY;
        float mx = sc; mx = fmaxf(mx, shx(mx, 1, lane)); mx = fmaxf(mx, shx(mx, 2, lane)); mx = fmaxf(mx, shx(mx, 4, lane)); mx = fmaxf(mx, shx(mx, 8, lane));
        float pe = __builtin_amdgcn_exp2f(sc - mx); float l = pe; l += shx(l, 1, lane); l += shx(l, 2, lane); l += shx(l, 4, lane); l += shx(l, 8, lane);
        pe /= l;
        const float a = pe - lam * shx(pe, 16, lane);
        float o0 = 0.f, o1 = 0.f;
        for (int k2 = 0; k2 <= j; ++k2) { const float ak = __builtin_amdgcn_readlane(a, k2); const unsigned vw = *(const GAS unsigned*)(V + (size_t)meta_slot(k2) * DM + h * 128 + 2 * lane); o0 += ak * bflo(vw); o1 += ak * bfhi(vw); }
        const float ss = wave_sum(o0 * o0 + o1 * o1, lane); const float rs = 1.f / sqrtf(ss * (1.f / 128.f) + LN_EPS);
        const float w0 = p.subln[2 * lane] * (1.f - LAMBDA_INIT0), w1 = p.subln[2 * lane + 1] * (1.f - LAMBDA_INIT0);
        *(GAS unsigned*)(OA + (size_t)(NREAL + j) * DM + h * 128 + 2 * lane) = pk2(o0 * rs * w0, o1 * rs * w1); }
}
__device__ __forceinline__ void fox_meta_attn(const Params& p, const Ctx& C) {
    const int gw = C.vcu * NWAVES + C.wave, lane = C.lane;
    if (gw < 256) { const int h = gw >> 4, j = gw & 15, kj = lane & 15;
        bf16* Q = (bf16*)(p.ws + WS_Q); const bf16* K = (const bf16*)(p.ws + WS_K); const bf16* V = (const bf16*)(p.ws + WS_V); const float* DK = (const float*)(p.ws + WS_DK) + (size_t)h * KROWS;
        const bf16* qp = Q + (size_t)(NREAL + j) * DM + h * 64; const bf16* kp = K + (size_t)meta_slot(kj) * DM + h * 64;
        float dot = 0.f;
#pragma unroll
        for (int c = 0; c < 8; ++c) { const v4u qa = *(const GAS v4u*)(qp + 8 * c), ka = *(const GAS v4u*)(kp + 8 * c); const unsigned qw[4] = {qa.x, qa.y, qa.z, qa.w}, kw[4] = {ka.x, ka.y, ka.z, ka.w};
#pragma unroll
            for (int e = 0; e < 4; ++e) dot += bflo(qw[e]) * bflo(kw[e]) + bfhi(qw[e]) * bfhi(kw[e]); }
        float sc = (kj <= j) ? dot + DK[meta_slot(kj)] - DK[meta_slot(j)] : -INFINITY;
        float mx = sc; mx = fmaxf(mx, shx(mx, 1, lane)); mx = fmaxf(mx, shx(mx, 2, lane)); mx = fmaxf(mx, shx(mx, 4, lane)); mx = fmaxf(mx, shx(mx, 8, lane));
        float pe = __builtin_amdgcn_exp2f(sc - mx); float l = pe; l += shx(l, 1, lane); l += shx(l, 2, lane); l += shx(l, 4, lane); l += shx(l, 8, lane);
        pe /= l;
        float o = 0.f;
        for (int k2 = 0; k2 <= j; ++k2) { const float ak = __builtin_amdgcn_readlane(pe, k2); o += ak * bf2f(V[(size_t)meta_slot(k2) * DM + h * 64 + lane]); }
        ((bf16*)(p.ws + WS_O0))[(size_t)(NREAL + j) * DM + h * 64 + lane] = (bf16)f2bf(o); }
}

typedef float f32x4m __attribute__((ext_vector_type(4)));
template <int KIND> __device__ __forceinline__ void ln_phase(const Params& p, const Ctx& C, int layer) {
    constexpr int NCB = (KIND == 0) ? 3 : (KIND == 1 ? 1 : 0), NC = 16 * (NCB ? NCB : 1);
    constexpr int AT_PITCH = 1028;
    const int tid = C.tid, lane = C.lane, wave = C.wave;
    LAS float* At = (LAS float*)(C.lds + RING_OFF);
    LAS float* part = (LAS float*)(C.lds + RING_OFF + 65792);
    LAS float* logit = (LAS float*)(C.lds + RING_OFF + 90368);
    LAS int* sl_e = (LAS int*)(C.lds + RING_OFF + 93440);
    LAS int* cnt_l = (LAS int*)(C.lds + RING_OFF + 94720);
    const float* gsrc = (KIND == 0 ? p.ln_mix_g : p.ln_ffn_g) + layer * DM; const float* bsrc = (KIND == 0 ? p.ln_mix_b : p.ln_ffn_b) + layer * DM;
    f32x4 gv[4], bv[4];
#pragma unroll
    for (int j = 0; j < 4; ++j) { gv[j] = *(const GAS f32x4*)(gsrc + 4 * lane + 256 * j); bv[j] = *(const GAS f32x4*)(bsrc + 4 * lane + 256 * j); }
    float Bf[NCB ? NCB : 1][8][4];
    if constexpr (NCB > 0) { const int kq = lane >> 4, col = lane & 15;
#pragma unroll
        for (int cb = 0; cb < NCB; ++cb)
#pragma unroll
            for (int g = 0; g < 8; ++g)
#pragma unroll
                for (int c = 0; c < 4; ++c) { const int k = 128 * wave + 16 * g + 4 * kq + c, cc = cb * 16 + col; float w;
                    if (KIND == 0) w = cc < 4 ? p.rg_w[((size_t)layer * DM + k) * 4 + cc] : (cc < 36 ? p.re_w[((size_t)layer * DM + k) * 32 + (cc - 4)] : 0.f);
                    else w = p.fox_w_in[(size_t)k * 3088 + 3072 + cc];
                    Bf[cb][g][c] = w; } }
    if (KIND == 0) { if (tid < 96) cnt_l[tid] = 0; }
    bf16* XH = (bf16*)(p.ws + WS_XH); const bf16* Y = (const bf16*)(p.ws + WS_K);
    constexpr int NTILES = NR / 16;
    int it = 0;
    for (int tile = C.vcu; tile < NTILES; tile += C.G, ++it) {
        unsigned long long vv[2][4]; unsigned long long yy[2][2][4];
#pragma unroll
        for (int rr = 0; rr < 2; ++rr) { const int row = tile * 16 + wave * 2 + rr;
#pragma unroll
            for (int j = 0; j < 4; ++j) vv[rr][j] = *((const GAS unsigned long long*)(XH + (size_t)row * DM) + lane + 64 * j);
            if (KIND != 0) {
#pragma unroll
                for (int j = 0; j < 4; ++j) { yy[rr][0][j] = *(const GAS unsigned long long*)(Y + (size_t)(2 * row) * DM + 4 * lane + 256 * j); yy[rr][1][j] = *(const GAS unsigned long long*)(Y + (size_t)(2 * row + 1) * DM + 4 * lane + 256 * j); } } }
#pragma unroll
        for (int rr = 0; rr < 2; ++rr) { const int rl = wave * 2 + rr, row = tile * 16 + rl;
            f32x4 v[4];
#pragma unroll
            for (int j = 0; j < 4; ++j) { const unsigned h0 = (unsigned)vv[rr][j], h1 = (unsigned)(vv[rr][j] >> 32); v[j] = (f32x4){bflo(h0), bfhi(h0), bflo(h1), bfhi(h1)}; }
            if (KIND != 0) {
#pragma unroll
                for (int j = 0; j < 4; ++j) { const unsigned long long y0 = yy[rr][0][j], y1 = yy[rr][1][j];
                    const unsigned a0 = (unsigned)y0, a1 = (unsigned)(y0 >> 32), b0 = (unsigned)y1, b1 = (unsigned)(y1 >> 32);
                    v[j].x = v[j].x * ALPHA + (bflo(a0) + bflo(b0)); v[j].y = v[j].y * ALPHA + (bfhi(a0) + bfhi(b0)); v[j].z = v[j].z * ALPHA + (bflo(a1) + bflo(b1)); v[j].w = v[j].w * ALPHA + (bfhi(a1) + bfhi(b1)); } }
            float s = 0.f;
#pragma unroll
            for (int j = 0; j < 4; ++j) s += (v[j].x + v[j].y) + (v[j].z + v[j].w);
            const float mean = wave_sum(s, lane) * (1.f / DM); float s2 = 0.f;
#pragma unroll
            for (int j = 0; j < 4; ++j) { v[j] = v[j] - mean; s2 += (v[j].x * v[j].x + v[j].y * v[j].y) + (v[j].z * v[j].z + v[j].w * v[j].w); }
            const float rstd = 1.f / sqrtf(wave_sum(s2, lane) * (1.f / DM) + LN_EPS);
#pragma unroll
            for (int j = 0; j < 4; ++j) v[j] = v[j] * rstd * gv[j] + bv[j];
            if (KIND == 2) { if (row < NREAL) {
#pragma unroll
                for (int j = 0; j < 4; ++j) *(GAS f32x4*)(p.out + (size_t)row * DM + 4 * lane + 256 * j) = v[j]; } }
            else {
#pragma unroll
                for (int j = 0; j < 4; ++j) {
                    *((GAS unsigned long long*)(XH + (size_t)row * DM) + lane + 64 * j) = (unsigned long long)pk2(v[j].x, v[j].y) | ((unsigned long long)pk2(v[j].z, v[j].w) << 32);
                    *(LAS f32x4*)(At + rl * AT_PITCH + 4 * lane + 256 * j) = v[j]; } } }
        if constexpr (NCB > 0) {
            __syncthreads();
            f32x4m acc[NCB];
#pragma unroll
            for (int cb = 0; cb < NCB; ++cb) acc[cb] = (f32x4m){0.f, 0.f, 0.f, 0.f};
#pragma unroll
            for (int g = 0; g < 8; ++g) { const f32x4 a4 = *(const LAS f32x4*)(At + (lane & 15) * AT_PITCH + 128 * wave + 16 * g + 4 * (lane >> 4));
#pragma unroll
                for (int c = 0; c < 4; ++c)
#pragma unroll
                    for (int cb = 0; cb < NCB; ++cb) acc[cb] = __builtin_amdgcn_mfma_f32_16x16x4f32(a4[c], Bf[cb][g][c], acc[cb], 0, 0, 0); }
#pragma unroll
            for (int cb = 0; cb < NCB; ++cb)
#pragma unroll
                for (int r = 0; r < 4; ++r) part[(wave * 16 + 4 * (lane >> 4) + r) * 48 + cb * 16 + (lane & 15)] = acc[cb][r];
            __syncthreads();
            for (int idx = tid; idx < 16 * NC; idx += NWAVES * 64) { const int rw = idx / NC, cl = idx % NC; float sacc = 0.f;
#pragma unroll
                for (int w = 0; w < 8; ++w) sacc += part[(w * 16 + rw) * 48 + cl];
                logit[rw * 48 + cl] = sacc; }
            __syncthreads();
            if (KIND == 0) { if (tid < 16) { const int row = tile * 16 + tid; const LAS float* lg = logit + tid * 48;
                float gl[4]; int gs = 0;
#pragma unroll
                for (int i = 0; i < 4; ++i) gl[i] = lg[i] + p.rg_b[layer * 4 + i];
#pragma unroll
                for (int i = 1; i < 4; ++i) if (gl[i] > gl[gs]) gs = i;
                float den = 0.f;
#pragma unroll
                for (int i = 0; i < 4; ++i) den += __expf(gl[i] - gl[gs]);
                const float pg = 1.f / den;
                float el[8];
#pragma unroll
                for (int i = 0; i < 8; ++i) el[i] = lg[4 + gs * 8 + i] + p.re_b[layer * 32 + gs * 8 + i];
                int i0 = 0;
#pragma unroll
                for (int i = 1; i < 8; ++i) if (el[i] > el[i0]) i0 = i;
                int i1 = (i0 == 0) ? 1 : 0;
#pragma unroll
                for (int i = 0; i < 8; ++i) if (i != i0 && el[i] > el[i1]) i1 = i;
                const float ex = __expf(el[i1] - el[i0]); const float w0 = 1.f / (1.f + ex), w1 = ex * w0;
                float* GVp = (float*)(p.ws + WS_GV); GVp[2 * row] = pg * w0; GVp[2 * row + 1] = pg * w1;
                sl_e[it * 32 + 2 * tid] = gs * 8 + i0; sl_e[it * 32 + 2 * tid + 1] = gs * 8 + i1; } }
            else { if (tid < 256) { const int rw = tid >> 4, hh = tid & 15; const float vv = logit[rw * 48 + hh] + p.fox_b_f[hh];
                ((float*)(p.ws + WS_LF))[(size_t)(tile * 16 + rw) * 16 + hh] = fminf(vv, 0.f) - __builtin_amdgcn_logf(1.f + __builtin_amdgcn_exp2f(-fabsf(vv) * LOG2E)) * 0.69314718056f;   } }
        }
    }
    if (KIND == 0) {
        gu32* CNT = (gu32*)(p.ws + WS_CTL) + CW_CNT + layer * 2048; int* LIST = (int*)(p.ws + WS_LIST);
        __syncthreads();
        const int nloc = it * 32;
        for (int s = tid; s < nloc; s += NWAVES * 64) atomicAdd((int*)&cnt_l[sl_e[s]], 1);
        __syncthreads();
        if (tid < 32) { const int n = cnt_l[tid]; cnt_l[32 + tid] = n > 0 ? (int)__hip_atomic_fetch_add(CNT + 64 * tid, (unsigned)n, RLX_AGENT) : 0; cnt_l[64 + tid] = 0; }
        __syncthreads();
        for (int s = tid; s < nloc; s += NWAVES * 64) { const int e = sl_e[s]; const int pos = cnt_l[32 + e] + atomicAdd((int*)&cnt_l[64 + e], 1);
            const int tl = C.vcu + (s >> 5) * C.G; LIST[(size_t)e * LCAP + pos] = 2 * (tl * 16 + ((s & 31) >> 1)) + (s & 1); }
    }
    __syncthreads();
}

__device__ __forceinline__ void cumsum_job(const Params& p, const Ctx& C) {
    if (C.vcu >= 64) return;
    const int b = C.vcu >> 4, h = C.vcu & 15, tid = C.tid, lane = C.lane, wave = C.wave;
    const float* LF = (const float*)(p.ws + WS_LF); float* DK = (float*)(p.ws + WS_DK) + (size_t)(b * 16 + h) * KROWS;
    LAS float* wt = (LAS float*)(C.lds + RING_OFF);
    float cm = 0.f, mine = 0.f; const int myj = (tid < NMETA) ? tid : -1;
    for (int i = 0; i < NMETA; ++i) { cm += LF[(size_t)(NREAL + i) * 16 + h]; if (i == myj) mine = cm; }
    if (tid < KPRE) DK[tid] = (myj >= 0) ? -mine * LOG2E : 0.f;
    if (tid < 64) DK[KPRE + SEQ + tid] = 0.f;
    const float* lp = LF + (size_t)(b * SEQ + tid * 16) * 16 + h;
    float run = 0.f;
#pragma unroll 1
    for (int i = 0; i < 16; ++i) run += lp[i * 16];
    float inc = run;
#pragma unroll
    for (int o = 1; o < 64; o <<= 1) { const float t = __uint_as_float((unsigned)__builtin_amdgcn_ds_bpermute((lane - o) << 2, (int)__float_as_uint(inc))); if (lane >= o) inc += t; }
    if (lane == 63) wt[wave] = inc;
    __syncthreads();
    float base = cm;
    for (int w = 0; w < wave; ++w) base += wt[w];
    base += inc - run;
#pragma unroll 1
    for (int i = 0; i < 16; ++i) { base += lp[i * 16]; DK[KPRE + tid * 16 + i] = -base * LOG2E; }
    __syncthreads();
}

struct MoeOrder {
    int G, c, UT; const LAS int* pre; const char* A; const char* W; size_t wexp, tsB;
    __device__ __forceinline__ bool next(int i, pg8::Unit& u) const {
        const int g = i * G + c; if (g >= UT || i >= ROWTAB_UNITS) return false;
        const int rt = g >> 2; int e = 0; while (pre[e + 1] <= rt) ++e;
        u.pm = rt - pre[e]; u.pn = g & 3; u.A = A; u.B = W + (size_t)e * wexp + (size_t)u.pn * tsB; u.tab = i; u.e = e; return true;
    }
};
__device__ __forceinline__ int moe_setup(const Params& p, const Ctx& C, int layer, MoeOrder& S) {
    LAS int* pre = (LAS int*)(C.lds + MOEPRE_OFF); LAS int* cnts = pre + 40; LAS int* rowtab = (LAS int*)(C.lds + ROWTAB_OFF);
    const gu32* CNT = (const gu32*)(p.ws + WS_CTL) + CW_CNT + layer * 2048;
    if (C.tid < 32) cnts[C.tid] = (int)__hip_atomic_load(CNT + 64 * C.tid, RLX_AGENT);
    __syncthreads();
    if (C.tid == 0) { int a = 0; for (int e = 0; e < NEXP; ++e) { pre[e] = a; a += (cnts[e] + 255) >> 8; } pre[NEXP] = a; }
    __syncthreads();
    S.pre = pre; S.UT = 4 * pre[NEXP];
    const int* LIST = (const int*)(p.ws + WS_LIST);
    pg8::Unit u;
    for (int i = 0; S.next(i, u); ++i) { if (C.tid < 256) { const int idx = 256 * u.pm + C.tid; rowtab[i * 256 + C.tid] = idx < cnts[u.e] ? LIST[(size_t)u.e * LCAP + idx] : -1; } }
    __syncthreads();
    return S.UT;
}

__global__ void __launch_bounds__(NWAVES * 64, 2) trunk_fwd(Params p) {
    extern __shared__ __attribute__((aligned(16))) unsigned char lds[];
    Ctx C;
    C.lds = (LAS unsigned char*)lds; C.tid = threadIdx.x; C.lane = C.tid & 63; C.wave = __builtin_amdgcn_readfirstlane(C.tid >> 6);
    C.G = gridDim.x; { const int bx = blockIdx.x; C.vcu = (C.G % 8 == 0) ? (bx % 8) * (C.G / 8) + bx / 8 : bx; }
    volatile LAS unsigned* MISC = (volatile LAS unsigned*)(C.lds + MISC_OFF);
    gu32* ctl = (gu32*)(p.ws + WS_CTL);
    if (C.tid < 32) MISC[C.tid] = 0u;
    __syncthreads();
    XcdBarrier bar; bar.bar = (unsigned*)(ctl + CW_BAR) + p.li * XCD_BAR_WORDS; bar.x = 0; bar.st = nullptr;
    if (!MK_PER_PHASE) bar = xcd_barrier_post((unsigned*)(ctl + CW_BAR) + p.li * XCD_BAR_WORDS, MISC + 8);
#define GRID_BAR() do { if (MK_PER_PHASE) { if (C.tid == 0) __hip_atomic_store(ctl + CW_TMO, 0xBADBA0u, RLX_AGENT); } else { xcd_barrier(bar); } } while (0)
    const int lo = p.ph_lo, hi = p.ph_hi;
#ifndef SUBMASK
#define SUBMASK 0x7f
#endif
#ifndef REP_MASK
#define REP_MASK 0
#endif
#define NREP(k) (((REP_MASK >> (k)) & 1) ? 2 : 1)
#ifndef PHASE_MASK
#define PHASE_MASK 0xffff
#endif
#define IN(k) (((PHASE_MASK >> (k)) & 1) && lo <= (k) && (k) < hi)
#define SEAM(k) do { if (IN(k) && IN((k) + 1)) GRID_BAR(); } while (0)
    bf16* XH = (bf16*)(p.ws + WS_XH); bf16* QB = (bf16*)(p.ws + WS_Q); bf16* KB = (bf16*)(p.ws + WS_K); bf16* VB = (bf16*)(p.ws + WS_V);
    bf16* O0 = (bf16*)(p.ws + WS_O0); bf16* O1 = (bf16*)p.out;
    const LAS int* rowtab = (const LAS int*)(C.lds + ROWTAB_OFF);

    if (IN(0)) { for (int rep_ = 0; rep_ < NREP(0); ++rep_) p0_prologue(p, fresh(C)); } SEAM(0);

    { constexpr int layer = 0;
        const int pb = 1 + (layer ? 8 : 0);
        if ((SUBMASK & 1) && IN(pb)) { for (int rep_ = 0; rep_ < NREP(pb); ++rep_) {
            if (layer == 1) cumsum_job(p, fresh(C));
            pg8::StaticOrder S; S.init(NRP, 3 * DM, C.G, (int)blockIdx.x, XH, DM * 2, p.ws + (layer ? WS_WQKV1 : WS_WQKV0), DM * 2);
            pg8::EpiQKV E{QB, KB, VB, attn_body::C2, layer ? (unsigned*)(ctl + CW_QM) : nullptr, (unsigned*)(ctl + CW_KM)};
            pg8::gemm_phase<pg8::EpiQKV, pg8::StaticOrder, true, false>(C.lds + RING_OFF, DM, DM * 2, S, E, rowtab, 0);
        } } SEAM(pb);
        if (layer == 0) {
            if (IN(2)) { for (int rep_ = 0; rep_ < NREP(2); ++rep_) {
                const float* TAB = (const float*)(p.ws + WS_TAB);
                const float lam = diff_lambda_full(p, fresh(C).lane);
                for (int it = C.vcu; it < NBATCH * 8 * 16; it += C.G) { const int bh = it >> 4, s = it & 15, b = bh >> 3, h = bh & 7;
#pragma unroll 1
                    for (int w = 0; w < 2; ++w) { const int qb = w ? s : 31 - s;
#pragma unroll 1
                        for (int mm = 0; mm < 2; ++mm) attn_body::attn_unit_dv<8>(b, qb, (2 * h + mm) * 64, h * 128, h * 128, (const attn_body::bf16*)QB, (const attn_body::bf16*)KB, (const attn_body::bf16*)VB, (attn_body::bf16*)(mm ? O1 : O0), TAB + (2 * h + mm) * 128, (char*)lds + RING_OFF);
                        combine_rows(p, fresh(C), b, h, qb, lam); } }
                diff_meta_attn(p, fresh(C), lam);
            } } SEAM(2);
        } else {
            if (IN(10)) { for (int rep_ = 0; rep_ < NREP(10); ++rep_) {
                const float* DK = (const float*)(p.ws + WS_DK);
                for (;;) {
                    const int lane_ = fresh(C).lane;
                    int tko = MOEPRE_OFF; asm volatile("" : "+s"(tko)); LAS int* tk = (LAS int*)(C.lds + tko);
                    if (fresh(C).tid == 0) tk[0] = (int)__hip_atomic_fetch_add(ctl + CW_QCTR + 64 * rep_, 1u, RLX_AGENT);
                    __syncthreads(); const int u = tk[0]; __syncthreads();
                    if (u >= NBATCH * 16 * 32) break;
                    const int qb = 31 - (u >> 6), bh = u & 63, b = bh >> 4, h = bh & 15;
                    const float* dk = DK + (size_t)bh * KROWS;
                    const unsigned qmb = lane_ < 8 ? __hip_atomic_load(ctl + CW_QM + ((size_t)(b * 32 + qb) * 16 + h) * 8 + lane_, RLX_AGENT) : 0u;
                    const unsigned kmb = lane_ < 8 ? __hip_atomic_load(ctl + CW_KM + ((size_t)bh) * 8 + lane_, RLX_AGENT) : 0u;
                    const int ntf = 4 * qb + 6;
                    float e0 = lane_ < ntf ? dk[lane_ == 0 ? NMETA - 1 : 64 * lane_ + 63] : 0.f, e1 = lane_ + 64 < ntf ? dk[64 * (lane_ + 64) + 63] : 0.f, e2 = lane_ + 128 < ntf ? dk[64 * (lane_ + 128) + 63] : 0.f;
                    const float q2 = wave_sum(__uint_as_float(qmb), lane_), k2 = wave_sum(__uint_as_float(kmb), lane_);
                    const float thr = dk[KPRE + 256 * qb] - 40.f - 2.1f * sqrtf(q2 * k2);
                    const unsigned long long m0 = __ballot(lane_ < ntf && e0 >= thr), m1 = __ballot(lane_ + 64 < ntf && e1 >= thr), m2 = __ballot(lane_ + 128 < ntf && e2 >= thr);
                    int tb = m0 ? __builtin_ctzll(m0) : (m1 ? 64 + __builtin_ctzll(m1) : (m2 ? 128 + __builtin_ctzll(m2) : ntf - 6));
                    tb &= ~1; tb = tb > ntf - 6 ? ntf - 6 : tb; tb = __builtin_amdgcn_readfirstlane(tb);
                    attn_body::attn_unit<1, 8>(b, qb, tb, h * 64, h * 64, h * 64, (const attn_body::bf16*)QB, (const attn_body::bf16*)KB, (const attn_body::bf16*)VB, (attn_body::bf16*)O0, dk, (char*)lds + RING_OFF);
                }
                fox_meta_attn(p, fresh(C));
            } } SEAM(10);
        }
        const int pw = layer ? 11 : 4;
        if ((SUBMASK & 4) && IN(pw)) { for (int rep_ = 0; rep_ < NREP(pw); ++rep_) {
            pg8::StaticOrder S; S.init(NRP, DM, C.G, (int)blockIdx.x, layer ? O0 : QB, DM * 2, p.ws + (layer ? WS_WO1 : WS_WO0), DM * 2);
            pg8::EpiZ E{XH};
            pg8::gemm_phase<pg8::EpiZ, pg8::StaticOrder, true, false>(C.lds + RING_OFF, DM, DM * 2, S, E, rowtab, 0);
        } } SEAM(pw);
        if ((SUBMASK & 8) && IN(pw + 1)) { ln_phase<0>(p, fresh(C), layer); } SEAM(pw + 1);
        if ((SUBMASK & 16) && IN(pw + 2)) { for (int rep_ = 0; rep_ < NREP(pw + 2); ++rep_) {
            MoeOrder S; S.G = C.G; S.c = (int)blockIdx.x; S.A = (const char*)XH; S.W = (const char*)(p.ws + WS_WGU); S.wexp = (size_t)DM * DM * 2; S.tsB = (size_t)256 * DM * 2;
            moe_setup(p, fresh(C), layer, S);
            pg8::EpiGU E{(pg8::bf16_t*)O0};
            pg8::gemm_phase<pg8::EpiGU, MoeOrder, true, true>(C.lds + RING_OFF, DM, DM * 2, S, E, rowtab, 1);
        } } SEAM(pw + 2);
        if ((SUBMASK & 32) && IN(pw + 3)) { for (int rep_ = 0; rep_ < NREP(pw + 3); ++rep_) {
            MoeOrder S; S.G = C.G; S.c = (int)blockIdx.x; S.A = (const char*)O0; S.W = (const char*)(p.ws + WS_WD); S.wexp = (size_t)DM * DEXP * 2; S.tsB = (size_t)256 * DEXP * 2;
            moe_setup(p, fresh(C), layer, S);
            pg8::EpiDown E{(pg8::bf16_t*)KB, (const float*)(p.ws + WS_GV)};
            pg8::gemm_phase<pg8::EpiDown, MoeOrder, true, true>(C.lds + RING_OFF, DEXP, DEXP * 2, S, E, rowtab, 0);
        } } SEAM(pw + 3);
        if ((SUBMASK & 64) && IN(pw + 4)) {
            if (layer == 0) { ln_phase<1>(p, fresh(C), 0); { const Ctx Cf = fresh(C); convert_experts(p, Cf, 1, 0, Cf.vcu * NWAVES + Cf.wave, Cf.G * NWAVES); } }
            else ln_phase<2>(p, fresh(C), 1);
        }
        if (layer == 0) SEAM(8);
        }
    { constexpr int layer = 1;
        const int pb = 1 + (layer ? 8 : 0);
        if ((SUBMASK & 1) && IN(pb)) { for (int rep_ = 0; rep_ < NREP(pb); ++rep_) {
            if (layer == 1) cumsum_job(p, fresh(C));
            pg8::StaticOrder S; S.init(NRP, 3 * DM, C.G, (int)blockIdx.x, XH, DM * 2, p.ws + (layer ? WS_WQKV1 : WS_WQKV0), DM * 2);
            pg8::EpiQKV E{QB, KB, VB, attn_body::C2, layer ? (unsigned*)(ctl + CW_QM) : nullptr, (unsigned*)(ctl + CW_KM)};
            pg8::gemm_phase<pg8::EpiQKV, pg8::StaticOrder, true, false>(C.lds + RING_OFF, DM, DM * 2, S, E, rowtab, 0);
        } } SEAM(pb);
        if (layer == 0) {
            if (IN(2)) { for (int rep_ = 0; rep_ < NREP(2); ++rep_) {
                const float* TAB = (const float*)(p.ws + WS_TAB);
                const float lam = diff_lambda_full(p, fresh(C).lane);
                for (int it = C.vcu; it < NBATCH * 8 * 16; it += C.G) { const int bh = it >> 4, s = it & 15, b = bh >> 3, h = bh & 7;
#pragma unroll 1
                    for (int w = 0; w < 2; ++w) { const int qb = w ? s : 31 - s;
#pragma unroll 1
                        for (int mm = 0; mm < 2; ++mm) attn_body::attn_unit_dv<8>(b, qb, (2 * h + mm) * 64, h * 128, h * 128, (const attn_body::bf16*)QB, (const attn_body::bf16*)KB, (const attn_body::bf16*)VB, (attn_body::bf16*)(mm ? O1 : O0), TAB + (2 * h + mm) * 128, (char*)lds + RING_OFF);
                        combine_rows(p, fresh(C), b, h, qb, lam); } }
                diff_meta_attn(p, fresh(C), lam);
            } } SEAM(2);
        } else {
            if (IN(10)) { for (int rep_ = 0; rep_ < NREP(10); ++rep_) {
                const float* DK = (const float*)(p.ws + WS_DK);
                for (;;) {
                    const int lane_ = fresh(C).lane;
                    int tko = MOEPRE_OFF; asm volatile("" : "+s"(tko)); LAS int* tk = (LAS int*)(C.lds + tko);
                    if (fresh(C).tid == 0) tk[0] = (int)__hip_atomic_fetch_add(ctl + CW_QCTR + 64 * rep_, 1u, RLX_AGENT);
                    __syncthreads(); const int u = tk[0]; __syncthreads();
                    if (u >= NBATCH * 16 * 32) break;
                    const int qb = 31 - (u >> 6), bh = u & 63, b = bh >> 4, h = bh & 15;
                    const float* dk = DK + (size_t)bh * KROWS;
                    const unsigned qmb = lane_ < 8 ? __hip_atomic_load(ctl + CW_QM + ((size_t)(b * 32 + qb) * 16 + h) * 8 + lane_, RLX_AGENT) : 0u;
                    const unsigned kmb = lane_ < 8 ? __hip_atomic_load(ctl + CW_KM + ((size_t)bh) * 8 + lane_, RLX_AGENT) : 0u;
                    const int ntf = 4 * qb + 6;
                    float e0 = lane_ < ntf ? dk[lane_ == 0 ? NMETA - 1 : 64 * lane_ + 63] : 0.f, e1 = lane_ + 64 < ntf ? dk[64 * (lane_ + 64) + 63] : 0.f, e2 = lane_ + 128 < ntf ? dk[64 * (lane_ + 128) + 63] : 0.f;
                    const float q2 = wave_sum(__uint_as_float(qmb), lane_), k2 = wave_sum(__uint_as_float(kmb), lane_);
                    const float thr = dk[KPRE + 256 * qb] - 40.f - 2.1f * sqrtf(q2 * k2);
                    const unsigned long long m0 = __ballot(lane_ < ntf && e0 >= thr), m1 = __ballot(lane_ + 64 < ntf && e1 >= thr), m2 = __ballot(lane_ + 128 < ntf && e2 >= thr);
                    int tb = m0 ? __builtin_ctzll(m0) : (m1 ? 64 + __builtin_ctzll(m1) : (m2 ? 128 + __builtin_ctzll(m2) : ntf - 6));
                    tb &= ~1; tb = tb > ntf - 6 ? ntf - 6 : tb; tb = __builtin_amdgcn_readfirstlane(tb);
                    attn_body::attn_unit<1, 8>(b, qb, tb, h * 64, h * 64, h * 64, (const attn_body::bf16*)QB, (const attn_body::bf16*)KB, (const attn_body::bf16*)VB, (attn_body::bf16*)O0, dk, (char*)lds + RING_OFF);
                }
                fox_meta_attn(p, fresh(C));
            } } SEAM(10);
        }
        const int pw = layer ? 11 : 4;
        if ((SUBMASK & 4) && IN(pw)) { for (int rep_ = 0; rep_ < NREP(pw); ++rep_) {
            pg8::StaticOrder S; S.init(NRP, DM, C.G, (int)blockIdx.x, layer ? O0 : QB, DM * 2, p.ws + (layer ? WS_WO1 : WS_WO0), DM * 2);
            pg8::EpiZ E{XH};
            pg8::gemm_phase<pg8::EpiZ, pg8::StaticOrder, true, false>(C.lds + RING_OFF, DM, DM * 2, S, E, rowtab, 0);
        } } SEAM(pw);
        if ((SUBMASK & 8) && IN(pw + 1)) { ln_phase<0>(p, fresh(C), layer); } SEAM(pw + 1);
        if ((SUBMASK & 16) && IN(pw + 2)) { for (int rep_ = 0; rep_ < NREP(pw + 2); ++rep_) {
            MoeOrder S; S.G = C.G; S.c = (int)blockIdx.x; S.A = (const char*)XH; S.W = (const char*)(p.ws + WS_WGU); S.wexp = (size_t)DM * DM * 2; S.tsB = (size_t)256 * DM * 2;
            moe_setup(p, fresh(C), layer, S);
            pg8::EpiGU E{(pg8::bf16_t*)O0};
            pg8::gemm_phase<pg8::EpiGU, MoeOrder, true, true>(C.lds + RING_OFF, DM, DM * 2, S, E, rowtab, 1);
        } } SEAM(pw + 2);
        if ((SUBMASK & 32) && IN(pw + 3)) { for (int rep_ = 0; rep_ < NREP(pw + 3); ++rep_) {
            MoeOrder S; S.G = C.G; S.c = (int)blockIdx.x; S.A = (const char*)O0; S.W = (const char*)(p.ws + WS_WD); S.wexp = (size_t)DM * DEXP * 2; S.tsB = (size_t)256 * DEXP * 2;
            moe_setup(p, fresh(C), layer, S);
            pg8::EpiDown E{(pg8::bf16_t*)KB, (const float*)(p.ws + WS_GV)};
            pg8::gemm_phase<pg8::EpiDown, MoeOrder, true, true>(C.lds + RING_OFF, DEXP, DEXP * 2, S, E, rowtab, 0);
        } } SEAM(pw + 3);
        if ((SUBMASK & 64) && IN(pw + 4)) {
            if (layer == 0) { ln_phase<1>(p, fresh(C), 0); { const Ctx Cf = fresh(C); convert_experts(p, Cf, 1, 0, Cf.vcu * NWAVES + Cf.wave, Cf.G * NWAVES); } }
            else ln_phase<2>(p, fresh(C), 1);
        }
        if (layer == 0) SEAM(8);
        }
#undef IN
#undef SEAM
#undef GRID_BAR
}

extern "C" void kernel_launch(void* const* d_in, const int* in_sizes, int n_in, void* d_out, int out_size, void* d_ws, size_t ws_size, hipStream_t stream) {
    static int grid = 0;
    if (grid == 0) {
        if (n_in != 21 || in_sizes[0] != NREAL * DM || out_size != NREAL * DM || ws_size < WS_END) { fprintf(stderr, "kernel_launch: unexpected shapes (n_in %d, in0 %d, out %d, ws %zu); nothing launched\n", n_in, n_in > 0 ? in_sizes[0] : -1, out_size, ws_size); grid = -1; return; }
        int dev = 0, cus = 0, per_cu = 0;
        if (hipGetDevice(&dev) != hipSuccess || hipDeviceGetAttribute(&cus, hipDeviceAttributeMultiprocessorCount, dev) != hipSuccess) { fprintf(stderr, "kernel_launch: device query failed\n"); grid = -1; return; }
        if (hipFuncSetAttribute((const void*)trunk_fwd, hipFuncAttributeMaxDynamicSharedMemorySize, LDS_BYTES) != hipSuccess) { fprintf(stderr, "kernel_launch: hipFuncSetAttribute failed\n"); grid = -1; return; }
        if (hipOccupancyMaxActiveBlocksPerMultiprocessor(&per_cu, (const void*)trunk_fwd, NWAVES * 64, LDS_BYTES) != hipSuccess || per_cu < 1) { fprintf(stderr, "kernel_launch: occupancy query reports %d workgroups per CU\n", per_cu); }
        (void)hipGetLastError();
        grid = cus;
    }
    if (grid < 0) return;
    if (hipMemsetAsync((char*)d_ws + WS_CTL, 0, CTL_ZERO_BYTES, stream) != hipSuccess) { fprintf(stderr, "kernel_launch: hipMemsetAsync failed\n"); return; }
    Params a{};
    const float** dst = (const float**)&a.x;
    for (int i = 0; i < 21; ++i) dst[i] = (const float*)d_in[i];
    a.out = (float*)d_out; a.ws = (unsigned char*)d_ws;
#if MK_PER_PHASE
    for (int k = 0; k < N_PHASES; ++k) { a.ph_lo = k; a.ph_hi = k + 1; a.li = 0; hipLaunchKernelGGL(trunk_fwd, dim3(grid), dim3(NWAVES * 64), LDS_BYTES, stream, a); }
#else
    a.ph_lo = 0; a.ph_hi = N_PHASES; a.li = 0;
    hipLaunchKernelGGL(trunk_fwd, dim3(grid), dim3(NWAVES * 64), LDS_BYTES, stream, a);
#endif
    const hipError_t le = hipPeekAtLastError();
    if (le != hipSuccess) fprintf(stderr, "kernel_launch: launch failed: %s\n", hipGetErrorName(le));
}
```

```cpp
#include <hip/hip_runtime.h>
#include <hip/hip_bf16.h>
#include <cstdio>
#include <cstdint>
#include <cmath>

constexpr int DM = 1024, NBATCH = 4, SEQ = 8192, NMETA = 16;
constexpr int NREAL = NBATCH * SEQ;
constexpr int NR = NREAL + NMETA;
constexpr int NRP = 129 * 256;
constexpr int KPRE = 64;
constexpr int KROWS = KPRE + SEQ + 64;
constexpr int NSLOT = 2 * NR;
constexpr int NEXP = 32, DEXP = 512;
constexpr float ALPHA = 1.41421356237309515f;
constexpr float LN_EPS = 1e-5f;
constexpr float LOG2E = 1.4426950408889634f;
constexpr float LAMBDA_INIT0 = 0.2f;

namespace pg8 {
#define PG8_LAS __attribute__((address_space(3)))
typedef unsigned short bf16_t;
typedef short bf16x8 __attribute__((ext_vector_type(8)));
typedef float f32x4 __attribute__((ext_vector_type(4)));
typedef unsigned u32x4 __attribute__((ext_vector_type(4)));
constexpr int BM = 256, BK = 64, HALF = 128, HTB = HALF * BK * 2  , STAGE_BYTES = 8 * HTB, NXCD = 8, WGM = 8;

__host__ __device__ __forceinline__ int lds_byte(int r, int c) { const int st = (r >> 4) * 2 + (c >> 5), rr = r & 15, cc = c & 31, ob = rr * 64 + cc * 2; return st * 1024 + (ob ^ (((ob >> 9) & 1) << 5)); }
__host__ __device__ __forceinline__ void stage_rc(int b, int& R, int& C) { const int st = b / 1024, sb = b % 1024, swz = sb ^ (((sb >> 9) & 1) << 5); R = (st >> 1) * 16 + swz / 64; C = (st & 1) * 32 + (swz % 64) / 2; }
__host__ __device__ __forceinline__ int perm32(int rho) { const int n = rho >> 4, i = rho & 15; return 8 * (i >> 2) + 4 * n + (i & 3); }

struct Unit { int pm, pn; const char* A; const char* B; int tab; int e; };

struct StaticOrder {
    int nM, nN, nwg, G, c; const char* A; const char* B; size_t tsA, tsB;
    __device__ void init(int M, int N, int G_, int c_, const void* A_, size_t lda_bytes, const void* B_, size_t ldb_bytes) { nM = M / BM; nN = N / BM; nwg = nM * nN; G = G_; c = c_; A = (const char*)A_; B = (const char*)B_; tsA = lda_bytes * BM; tsB = ldb_bytes * BM; }
    __device__ bool next(int i, Unit& u) const {
        const long L = (long)i * G + c; if (L >= nwg) return false;
        int wgid = (int)L; { const int q = nwg / NXCD, r = nwg % NXCD, xcd = wgid % NXCD, off = wgid / NXCD; wgid = (xcd < r ? xcd * (q + 1) : r * (q + 1) + (xcd - r) * q) + off; }
        const int nig = WGM * nN, gid = wgid / nig, fm = gid * WGM, gsz = (nM - fm) < WGM ? (nM - fm) : WGM;
        u.pm = fm + ((wgid % nig) % gsz); u.pn = (wgid % nig) / gsz; u.A = A + (size_t)u.pm * tsA; u.B = B + (size_t)u.pn * tsB; u.tab = 0; u.e = 0; return true;
    }
};

__device__ __forceinline__ float shx(float v, int m, int lane) { return __uint_as_float((unsigned)__builtin_amdgcn_ds_bpermute((lane ^ m) << 2, (int)__float_as_uint(v))); }
__device__ __forceinline__ unsigned cvt_pk_bf16(float lo, float hi) { unsigned r; asm volatile("v_cvt_pk_bf16_f32 %0, %1, %2" : "=v"(r) : "v"(lo), "v"(hi)); return r; }

template <class Epi, class Sched, bool ALIGN_EPI, bool GATHER>
__device__ __forceinline__ void gemm_phase(PG8_LAS unsigned char* lds, const int K, const unsigned lda, const Sched& S, const Epi& E, const PG8_LAS int* rowtab, const int ashift) {
    int tid_ = threadIdx.x; asm volatile("" : "+v"(tid_));
    const int tid = tid_, wid = __builtin_amdgcn_readfirstlane(tid >> 6), lane = tid & 63, wr = wid >> 2, wc = wid & 3, fr = lane & 15, fq = lane >> 4;
    const int nt = K / BK;
    unsigned voffB[2], offA[2][2], noffA[2][2]; int Rr[2], Cc[2];
#pragma unroll
    for (int i = 0; i < 2; ++i) { int R, C; stage_rc(tid * 16 + i * 8192, R, C); const int Rb = Epi::PERM ? ((R & ~31) + perm32(R & 31)) : R; Rr[i] = R; Cc[i] = C;
        voffB[i] = (unsigned)(Rb * K + C) * 2u;
#pragma unroll
        for (int h = 0; h < 2; ++h) { offA[h][i] = (unsigned)(R + HALF * h) * lda + (unsigned)C * 2u; noffA[h][i] = offA[h][i]; } }
    const size_t kstep = (size_t)(BK * 2);
    const size_t hstep = (size_t)HALF * K * 2;
    const unsigned ldsw = (unsigned)wid * 1024u;
    const int aoff = lds_byte(wr * 64 + fr, fq * 8), boff = lds_byte(wc * 32 + fr, fq * 8);
#define PG8_SA(b, h) (((b) * 2 + (h)) * HTB)
#define PG8_SB(b, h) ((4 + (b) * 2 + (h)) * HTB)
#define PG8_STAGE(bufoff, gbase, voff) do { _Pragma("unroll") for (int _i = 0; _i < 2; ++_i) \
        __builtin_amdgcn_global_load_lds((const unsigned*)((const char*)(gbase) + (voff)[_i]), (PG8_LAS unsigned*)(lds + (bufoff) + ldsw + _i * 8192), 16, 0, 0); } while (0)
#define PG8_LDA(dst, b, h) do { _Pragma("unroll") for (int m = 0; m < 4; ++m) _Pragma("unroll") for (int k = 0; k < 2; ++k) dst[m][k] = *(const PG8_LAS bf16x8*)(lds + PG8_SA(b, h) + aoff + m * 2048 + k * 1024); } while (0)
#define PG8_LDB(dst, b, h) do { _Pragma("unroll") for (int n = 0; n < 2; ++n) _Pragma("unroll") for (int k = 0; k < 2; ++k) dst[n][k] = *(const PG8_LAS bf16x8*)(lds + PG8_SB(b, h) + boff + n * 2048 + k * 1024); } while (0)
#define PG8_MMA(ai, bj, At, Bt) do { __builtin_amdgcn_s_setprio(1); _Pragma("unroll") for (int m = 0; m < 4; ++m) _Pragma("unroll") for (int n = 0; n < 2; ++n) _Pragma("unroll") for (int k = 0; k < 2; ++k) \
        acc[ai][bj][m][n] = __builtin_amdgcn_mfma_f32_16x16x32_bf16(Bt[n][k], At[m][k], acc[ai][bj][m][n], 0, 0, 0); __builtin_amdgcn_s_setprio(0); } while (0)
#define PG8_WAIT_V(n) asm volatile("s_waitcnt vmcnt(" #n ")" ::: "memory")
#define PG8_WAIT_L(n) asm volatile("s_waitcnt lgkmcnt(" #n ")" ::: "memory")
#define PG8_BAR __builtin_amdgcn_s_barrier()
#define PG8_SCHED __builtin_amdgcn_sched_barrier(0)
#define PG8_GOFF(dst, u) do { if constexpr (GATHER) { _Pragma("unroll") for (int _h = 0; _h < 2; ++_h) _Pragma("unroll") for (int _i = 0; _i < 2; ++_i) { \
        int _e = rowtab[(u).tab * 256 + _h * HALF + Rr[_i]]; _e = _e < 0 ? 0 : (_e >> ashift); dst[_h][_i] = (unsigned)_e * lda + (unsigned)Cc[_i] * 2u; } } } while (0)
    Unit cur, nxt; int ui = 0;
    if (!S.next(0, cur)) return;
    f32x4 acc[2][2][4][2];
#pragma unroll
    for (int a = 0; a < 2; ++a)
#pragma unroll
        for (int b = 0; b < 2; ++b)
#pragma unroll
            for (int m = 0; m < 4; ++m)
#pragma unroll
                for (int n = 0; n < 2; ++n) acc[a][b][m][n] = (f32x4){0.f, 0.f, 0.f, 0.f};
    bf16x8 At[4][2], B0[2][2], B1[2][2];
    const char* cA = cur.A; const char* cB = cur.B;
    PG8_GOFF(offA, cur);
    PG8_STAGE(PG8_SB(0, 0), cB, voffB); PG8_STAGE(PG8_SB(0, 1), cB + hstep, voffB); PG8_STAGE(PG8_SA(0, 0), cA, offA[0]); PG8_STAGE(PG8_SA(0, 1), cA, offA[1]);
    if (wr == 1) PG8_BAR;
    PG8_WAIT_V(2); PG8_BAR;
    PG8_STAGE(PG8_SB(1, 0), cB + kstep, voffB); PG8_STAGE(PG8_SA(1, 0), cA + kstep, offA[0]); PG8_STAGE(PG8_SB(1, 1), cB + hstep + kstep, voffB);
    PG8_WAIT_V(6); PG8_BAR;
    for (;;) {
        const bool has_next = S.next(ui + 1, nxt);
        const char* nA = has_next ? nxt.A : cA; const char* nB = has_next ? nxt.B : cB;
        if constexpr (GATHER) { if (has_next) PG8_GOFF(noffA, nxt); else {
#pragma unroll
            for (int h = 0; h < 2; ++h)
#pragma unroll
                for (int i = 0; i < 2; ++i) noffA[h][i] = offA[h][i]; } }
        for (int t = 0; t < nt; t += 2) {
            const bool last = (t == nt - 2);
            const char* a1 = cA + (size_t)(t + 1) * kstep;
            const char* a2 = last ? nA : cA + (size_t)(t + 2) * kstep; const char* b2 = last ? nB : cB + (size_t)(t + 2) * kstep;
            const char* a3 = a2 + kstep; const char* b3 = b2 + kstep;
            unsigned o2[2][2];
#pragma unroll
            for (int h = 0; h < 2; ++h)
#pragma unroll
                for (int i = 0; i < 2; ++i) o2[h][i] = (GATHER && last) ? noffA[h][i] : offA[h][i];
            PG8_LDB(B0, 0, 0); PG8_LDB(B1, 0, 1); PG8_SCHED; PG8_LDA(At, 0, 0); PG8_STAGE(PG8_SA(1, 1), a1, offA[1]);
            PG8_WAIT_V(8); PG8_WAIT_L(0); PG8_BAR; PG8_MMA(0, 0, At, B0); PG8_MMA(0, 1, At, B1); PG8_BAR; PG8_SCHED;
            PG8_LDA(At, 0, 1); PG8_STAGE(PG8_SB(0, 0), b2, voffB); PG8_STAGE(PG8_SB(0, 1), b2 + hstep, voffB); PG8_STAGE(PG8_SA(0, 0), a2, o2[0]);
            PG8_WAIT_V(8); PG8_WAIT_L(0); PG8_BAR; PG8_MMA(1, 0, At, B0); PG8_MMA(1, 1, At, B1); PG8_BAR; PG8_SCHED;
            PG8_LDB(B0, 1, 0); PG8_LDB(B1, 1, 1); PG8_SCHED; PG8_LDA(At, 1, 0); PG8_STAGE(PG8_SA(0, 1), a2, o2[1]);
            PG8_WAIT_V(8); PG8_WAIT_L(0); PG8_BAR; PG8_MMA(0, 0, At, B0); PG8_MMA(0, 1, At, B1); PG8_BAR; PG8_SCHED;
            PG8_LDA(At, 1, 1); PG8_STAGE(PG8_SB(1, 0), b3, voffB); PG8_STAGE(PG8_SB(1, 1), b3 + hstep, voffB); PG8_STAGE(PG8_SA(1, 0), a3, o2[0]);
            PG8_WAIT_V(8); PG8_WAIT_L(0); PG8_BAR; PG8_MMA(1, 0, At, B0); PG8_MMA(1, 1, At, B1); PG8_BAR; PG8_SCHED;
        }
        if constexpr (ALIGN_EPI) { if (wr == 0) PG8_BAR; }
        E(acc, cur, wr, wc, fr, fq, rowtab);
        if (!has_next) break;
#pragma unroll
        for (int a = 0; a < 2; ++a)
#pragma unroll
            for (int b = 0; b < 2; ++b)
#pragma unroll
                for (int m = 0; m < 4; ++m)
#pragma unroll
                    for (int n = 0; n < 2; ++n) acc[a][b][m][n] = (f32x4){0.f, 0.f, 0.f, 0.f};
        cur = nxt; cA = nA; cB = nB; ++ui;
        if constexpr (GATHER) {
#pragma unroll
            for (int h = 0; h < 2; ++h)
#pragma unroll
                for (int i = 0; i < 2; ++i) offA[h][i] = noffA[h][i]; }
        if constexpr (ALIGN_EPI) { if (wr == 1) PG8_BAR; }
    }
    PG8_WAIT_V(0);
    if constexpr (!ALIGN_EPI) { if (wr == 0) PG8_BAR; }
    PG8_BAR;
#undef PG8_SA
#undef PG8_SB
#undef PG8_STAGE
#undef PG8_LDA
#undef PG8_LDB
#undef PG8_MMA
#undef PG8_WAIT_V
#undef PG8_WAIT_L
#undef PG8_BAR
#undef PG8_SCHED
#undef PG8_GOFF
}

struct EpiQKV {
    static constexpr bool PERM = true;
    bf16_t* Q; bf16_t* Kb; bf16_t* Vb; float qscale;
    unsigned* qm; unsigned* km;
    __device__ __forceinline__ void operator()(const f32x4 (&acc)[2][2][4][2], const Unit& u, int wr, int wc, int fr, int fq, const PG8_LAS int*) const {
        const int row0 = u.pm * BM + wr * 64 + fr; const int t = (u.pn * BM) >> 10; const int colt = (u.pn * BM) & 1023;
        const int col0 = colt + wc * 32 + 8 * fq; const float sc = (t == 0) ? qscale : 1.f;
        bf16_t* kv = (t == 1) ? Kb : Vb;
        float mx[2] = {0.f, 0.f};
#pragma unroll
        for (int ai = 0; ai < 2; ++ai)
#pragma unroll
            for (int m = 0; m < 4; ++m) { const int r = row0 + ai * HALF + m * 16;
                if (r < NR) {
#pragma unroll
                for (int bj = 0; bj < 2; ++bj) { const f32x4 v0 = acc[ai][bj][m][0] * sc, v1 = acc[ai][bj][m][1] * sc;
                    u32x4 w; w.x = cvt_pk_bf16(v0[0], v0[1]); w.y = cvt_pk_bf16(v0[2], v0[3]); w.z = cvt_pk_bf16(v1[0], v1[1]); w.w = cvt_pk_bf16(v1[2], v1[3]);
                    const int c = col0 + bj * HALF;
                    bf16_t* dst = (t == 0) ? Q + (size_t)r * DM : kv + (size_t)(r < NREAL ? (r >> 13) * KROWS + KPRE + (r & (SEQ - 1)) : r - NREAL) * DM;
                    *(u32x4*)(dst + c) = w; } }
                if (qm != nullptr && t < 2) {
#pragma unroll
                    for (int bj = 0; bj < 2; ++bj) { const f32x4 v0 = acc[ai][bj][m][0] * sc, v1 = acc[ai][bj][m][1] * sc;
                        float ss = (v0[0] * v0[0] + v0[1] * v0[1]) + (v0[2] * v0[2] + v0[3] * v0[3]) + (v1[0] * v1[0] + v1[1] * v1[1]) + (v1[2] * v1[2] + v1[3] * v1[3]);
                        ss += shx(ss, 16, fq * 16 + fr); ss += shx(ss, 32, fq * 16 + fr);
                        if (r < NR) mx[bj] = fmaxf(mx[bj], ss); } } }
        if (qm != nullptr && t < 2) {
#pragma unroll
            for (int bj = 0; bj < 2; ++bj) { float v = mx[bj]; v = fmaxf(v, shx(v, 1, fq * 16 + fr)); v = fmaxf(v, shx(v, 2, fq * 16 + fr)); v = fmaxf(v, shx(v, 4, fq * 16 + fr)); v = fmaxf(v, shx(v, 8, fq * 16 + fr));
                if (fr == 0 && fq == 0) { const int head = 4 * (u.pn & 3) + 2 * bj + (wc >> 1), part = wc & 1; const unsigned bits = __float_as_uint(v);
                    if (t == 0) { if (u.pm < NREAL / BM) atomicMax(qm + ((size_t)u.pm * 16 + head) * 8 + part, bits); }
                    else if (u.pm < NREAL / BM) atomicMax(km + ((size_t)(u.pm >> 5) * 16 + head) * 8 + part, bits);
                    else { for (int b = 0; b < NBATCH; ++b) atomicMax(km + ((size_t)b * 16 + head) * 8 + part, bits); } } } }
    }
};
struct EpiZ {
    static constexpr bool PERM = true;
    bf16_t* H;
    __device__ __forceinline__ void operator()(const f32x4 (&acc)[2][2][4][2], const Unit& u, int wr, int wc, int fr, int fq, const PG8_LAS int*) const {
        const int row0 = u.pm * BM + wr * 64 + fr; const int col0 = u.pn * BM + wc * 32 + 8 * fq;
#pragma unroll
        for (int ai = 0; ai < 2; ++ai)
#pragma unroll
            for (int m = 0; m < 4; ++m) { const int r = row0 + ai * HALF + m * 16;
                if (r < NR) {
#pragma unroll
                    for (int bj = 0; bj < 2; ++bj) { bf16_t* hp = H + (size_t)r * DM + col0 + bj * HALF; const u32x4 b = *(const u32x4*)hp;
                        const f32x4 v0 = acc[ai][bj][m][0], v1 = acc[ai][bj][m][1];
                        u32x4 w; w.x = cvt_pk_bf16(v0[0] + ALPHA * __uint_as_float(b.x << 16), v0[1] + ALPHA * __uint_as_float(b.x & 0xffff0000u)); w.y = cvt_pk_bf16(v0[2] + ALPHA * __uint_as_float(b.y << 16), v0[3] + ALPHA * __uint_as_float(b.y & 0xffff0000u));
                        w.z = cvt_pk_bf16(v1[0] + ALPHA * __uint_as_float(b.z << 16), v1[1] + ALPHA * __uint_as_float(b.z & 0xffff0000u)); w.w = cvt_pk_bf16(v1[2] + ALPHA * __uint_as_float(b.w << 16), v1[3] + ALPHA * __uint_as_float(b.w & 0xffff0000u));
                        *(u32x4*)hp = w; } } }
    }
};
struct EpiGU {
    static constexpr bool PERM = true;
    bf16_t* U;
    __device__ __forceinline__ void operator()(const f32x4 (&acc)[2][2][4][2], const Unit& u, int wr, int wc, int fr, int fq, const PG8_LAS int* rowtab) const {
        const int col0 = u.pn * HALF + wc * 32 + 8 * fq;
#pragma unroll
        for (int ai = 0; ai < 2; ++ai)
#pragma unroll
            for (int m = 0; m < 4; ++m) { const int slot = rowtab[u.tab * 256 + ai * HALF + wr * 64 + m * 16 + fr];
                if (slot >= 0) { float o[8];
#pragma unroll
                    for (int n = 0; n < 2; ++n)
#pragma unroll
                        for (int c = 0; c < 4; ++c) { const float g = acc[ai][0][m][n][c], up = acc[ai][1][m][n][c]; o[n * 4 + c] = g * up * __builtin_amdgcn_rcpf(1.f + __builtin_amdgcn_exp2f(-g * LOG2E)); }
                    u32x4 w; w.x = cvt_pk_bf16(o[0], o[1]); w.y = cvt_pk_bf16(o[2], o[3]); w.z = cvt_pk_bf16(o[4], o[5]); w.w = cvt_pk_bf16(o[6], o[7]);
                    *(u32x4*)(U + (size_t)slot * DEXP + col0) = w; } }
    }
};
struct EpiDown {
    static constexpr bool PERM = true;
    bf16_t* Y; const float* GV;
    __device__ __forceinline__ void operator()(const f32x4 (&acc)[2][2][4][2], const Unit& u, int wr, int wc, int fr, int fq, const PG8_LAS int* rowtab) const {
        const int col0 = u.pn * BM + wc * 32 + 8 * fq;
#pragma unroll
        for (int ai = 0; ai < 2; ++ai)
#pragma unroll
            for (int m = 0; m < 4; ++m) { const int slot = rowtab[u.tab * 256 + ai * HALF + wr * 64 + m * 16 + fr];
                if (slot >= 0) { const float gv = GV[slot];
#pragma unroll
                    for (int bj = 0; bj < 2; ++bj) { const f32x4 v0 = acc[ai][bj][m][0] * gv, v1 = acc[ai][bj][m][1] * gv;
                        u32x4 w; w.x = cvt_pk_bf16(v0[0], v0[1]); w.y = cvt_pk_bf16(v0[2], v0[3]); w.z = cvt_pk_bf16(v1[0], v1[1]); w.w = cvt_pk_bf16(v1[2], v1[3]);
                        *(u32x4*)(Y + (size_t)slot * DM + col0 + bj * HALF) = w; } } }
    }
};
}
namespace attn_body {
using bf16=__hip_bfloat16;
using bf16x8=__attribute__((ext_vector_type(8)))short;
using s16x4=__attribute__((ext_vector_type(4)))short;
using f32x16=__attribute__((ext_vector_type(16)))float;
using u32x4=__attribute__((ext_vector_type(4)))unsigned;
constexpr int D=64;
constexpr int NW=8,QBLK=32,QB=QBLK*NW,KVBLK=64,NQB=SEQ/QB;
constexpr int ATTN_PITCH=DM, ATTN_UNIT_ROWS=QB;
__device__ __forceinline__ int crow(int r,int hi){return (r&3)+8*(r>>2)+4*hi;}
#define SBAR() __builtin_amdgcn_sched_barrier(0)
__device__ __forceinline__ void cmask(f32x16&p0,f32x16&p1,int jb,int qrel,int hi){
  const float NEG=-INFINITY; int kb=64*jb+4*hi;
  #pragma unroll
  for(int r=0;r<16;++r){int kv=kb+(r&3)+8*(r>>2); if(kv>qrel)p0[r]=NEG; if(kv+32>qrel)p1[r]=NEG;}
}

constexpr int RT_OFFS=320, RT_SIZE=704;

template<int MODE> __device__ __forceinline__ void modtile_slow(f32x16&p0,f32x16&p1,int t,int q_abs,int q0,int hi,const __attribute__((address_space(3))) float* tab){
  const float NEG=-INFINITY; int hi4=4*hi; asm volatile("":"+v"(hi4),"+v"(q_abs));
  if(MODE==0){
    if(t==0){
      int bd=16+q_abs; bd=bd>383?383:bd; const __attribute__((address_space(3))) float* bp=tab+(RT_OFFS+bd-hi4-15);
      #pragma unroll
      for(int r=0;r<16;++r){ p1[r]=NEG; if(r<8)p0[r]+=bp[15-((r&3)+8*(r>>2))]; else p0[r]=NEG; }
    } else {
      const __attribute__((address_space(3))) float* bp=tab+(RT_OFFS+q_abs-64*t+KPRE-hi4-63);
      const int dq=q_abs-64*t+KPRE-hi4;
      #pragma unroll
      for(int r=0;r<16;++r){ const int c=(r&3)+8*(r>>2); p0[r]+=bp[63-c]; p1[r]+=bp[31-c]; }
      if(64*t-KPRE+63>q0){
        #pragma unroll
        for(int r=0;r<16;++r){ const int c=(r&3)+8*(r>>2); if(c>dq)p0[r]=NEG; if(c+32>dq)p1[r]=NEG; } }
    }
  } else {
    if(t==0){
      #pragma unroll
      for(int r=0;r<16;++r){ p1[r]=NEG; if(r<8)p0[r]+=tab[(r&3)+8*(r>>2)+hi4]; else p0[r]=NEG; }
    } else {
      typedef float f4 __attribute__((ext_vector_type(4)));
      const __attribute__((address_space(3))) f4* tp=(const __attribute__((address_space(3))) f4*)(tab+64*t+hi4);
      #pragma unroll
      for(int g=0;g<4;++g){ const f4 a=tp[2*g], b=tp[8+2*g];
        #pragma unroll
        for(int c=0;c<4;++c){ p0[4*g+c]+=a[c]; p1[4*g+c]+=b[c]; }
        asm volatile("":::"memory"); }
      if(64*t-KPRE+63>q0){
        const int dq=q_abs-64*t+KPRE-hi4;
        #pragma unroll
        for(int r=0;r<16;++r){ const int c=(r&3)+8*(r>>2); if(c>dq)p0[r]=NEG; if(c+32>dq)p1[r]=NEG; } }
    }
  }
}
__device__ __forceinline__ void modtile_fast1(f32x16&p0,f32x16&p1,int t,int hi,const __attribute__((address_space(3))) float* tab){
  typedef float f4 __attribute__((ext_vector_type(4)));
  const __attribute__((address_space(3))) f4* tp=(const __attribute__((address_space(3))) f4*)(tab+64*t+4*hi);
  #pragma unroll
  for(int g=0;g<4;++g){ const f4 a=tp[2*g], b=tp[8+2*g];
    #pragma unroll
    for(int c=0;c<4;++c){ p0[4*g+c]+=a[c]; p1[4*g+c]+=b[c]; } }
}
constexpr int NSLOT=3, SLOTB=8192;
constexpr int LDS_K=0, LDS_V=NSLOT*SLOTB, LDS_WS=2*NSLOT*SLOTB, LDS_OST=LDS_WS+NW*64*4, LDS_TAB=LDS_OST+NW*4096, LDS_BYTES=LDS_TAB+KROWS*4;
constexpr float C2=0.125f*1.4426950408889634f;
__device__ __forceinline__ void glds16(const void*gsrc,unsigned lds_dst){unsigned keep;
  asm volatile("s_mov_b32 %0, m0\n\ts_mov_b32 m0, %2\n\ts_nop 0\n\tglobal_load_lds_dwordx4 %1, off\n\ts_mov_b32 m0, %0":"=&s"(keep):"v"(gsrc),"s"(lds_dst):"memory");}
__device__ __forceinline__ float max3f(float a,float b,float c){float r;asm("v_max3_f32 %0, %1, %2, %3":"=v"(r):"v"(a),"v"(b),"v"(c));return r;}
__device__ __forceinline__ float max2f(float a,float b){float r;asm("v_max_f32_e32 %0, %1, %2":"=v"(r):"v"(a),"v"(b));return r;}
__device__ __forceinline__ float fadd_s(float a,float b){float r;asm("v_add_f32_e32 %0, %1, %2":"=v"(r):"v"(a),"v"(b));return r;}
__device__ __forceinline__ float fsub_s(float a,float b){float r;asm("v_sub_f32_e32 %0, %1, %2":"=v"(r):"v"(a),"v"(b));return r;}
typedef float f32x2_t __attribute__((ext_vector_type(2))); typedef __bf16 bf16x2_t __attribute__((ext_vector_type(2)));
__device__ __forceinline__ unsigned cvtpk_s(float lo,float hi){f32x2_t v={lo,hi};bf16x2_t b=__builtin_convertvector(v,bf16x2_t);return __builtin_bit_cast(unsigned,b);}
#define WAIT_BAR(N) asm volatile("s_waitcnt vmcnt(" #N ") lgkmcnt(0)\n\ts_barrier":::"memory")

__device__ __forceinline__ void qkt(f32x16&p0,f32x16&p1,const char*Kslot,const bf16x8*qr,const f32x16&negm,int r32,int hi){
  const char*kb=Kslot+hi*1024+r32*16;
  #pragma unroll
  for(int d0=0;d0<4;++d0){
    const bf16x8 b0=*reinterpret_cast<const bf16x8*>(kb+d0*2048);
    const bf16x8 b1=*reinterpret_cast<const bf16x8*>(kb+d0*2048+512);
    if(d0==0){p0=__builtin_amdgcn_mfma_f32_32x32x16_bf16(b0,qr[0],negm,0,0,0);p1=__builtin_amdgcn_mfma_f32_32x32x16_bf16(b1,qr[0],negm,0,0,0);}
    else{p0=__builtin_amdgcn_mfma_f32_32x32x16_bf16(b0,qr[d0],p0,0,0,0);p1=__builtin_amdgcn_mfma_f32_32x32x16_bf16(b1,qr[d0],p1,0,0,0);}}
}
typedef __attribute__((address_space(3))) const char* lds_cptr;
typedef short v4i16_t __attribute__((ext_vector_type(4)));
__device__ __forceinline__ void kload8(bf16x8*kf,lds_cptr kp){
  kf[0]=*(const __attribute__((address_space(3))) bf16x8*)(kp);      kf[1]=*(const __attribute__((address_space(3))) bf16x8*)(kp+512);
  kf[2]=*(const __attribute__((address_space(3))) bf16x8*)(kp+2048); kf[3]=*(const __attribute__((address_space(3))) bf16x8*)(kp+2560);
  kf[4]=*(const __attribute__((address_space(3))) bf16x8*)(kp+4096); kf[5]=*(const __attribute__((address_space(3))) bf16x8*)(kp+4608);
  kf[6]=*(const __attribute__((address_space(3))) bf16x8*)(kp+6144); kf[7]=*(const __attribute__((address_space(3))) bf16x8*)(kp+6656);
}
__device__ __forceinline__ void kload2(bf16x8*kf,lds_cptr kp,int j){ kf[2*j]=*(const __attribute__((address_space(3))) bf16x8*)(kp+j*2048); kf[2*j+1]=*(const __attribute__((address_space(3))) bf16x8*)(kp+j*2048+512); }
__device__ __forceinline__ s16x4 vtr(lds_cptr p){ return __builtin_bit_cast(s16x4,__builtin_amdgcn_ds_read_tr16_b64_v4i16((__attribute__((address_space(3))) v4i16_t*)p)); }
__device__ __forceinline__ float rowmax(const f32x16&p0,const f32x16&p1){
  float a=max3f(p0[0],p0[1],p1[0]),b=max3f(p0[2],p0[3],p1[1]);a=max3f(a,p1[2],p1[3]);
  #pragma unroll
  for(int r=4;r<16;r+=4){a=max3f(a,p0[r],p0[r+1]);b=max3f(b,p0[r+2],p0[r+3]);a=max3f(a,p1[r],p1[r+1]);b=max3f(b,p1[r+2],p1[r+3]);}
  const float m=max2f(a,b);
  auto rr=__builtin_amdgcn_permlane32_swap(__float_as_uint(m),__float_as_uint(m),false,false);
  return max2f(__uint_as_float(rr[0]),__uint_as_float(rr[1]));
}
__device__ __forceinline__ void pv(f32x16*o,int vb,bf16x8 pa0,bf16x8 pa1,bf16x8 pa2,bf16x8 pa3){
  #pragma unroll
  for(int d0=0;d0<2;++d0){s16x4 lo[4],hi[4];
    #pragma unroll
    for(int ks=0;ks<4;++ks){
      asm volatile("ds_read_b64_tr_b16 %0,%1 offset:%c2":"=&v"(lo[ks]):"v"(vb),"i"(d0*4096+ks*1024):"memory");
      asm volatile("ds_read_b64_tr_b16 %0,%1 offset:%c2":"=&v"(hi[ks]):"v"(vb),"i"(d0*4096+ks*1024+512):"memory");}
    asm volatile("s_waitcnt lgkmcnt(0)":::"memory");SBAR();
    #define PK(k) (bf16x8){lo[k][0],lo[k][1],lo[k][2],lo[k][3],hi[k][0],hi[k][1],hi[k][2],hi[k][3]}
    o[d0]=__builtin_amdgcn_mfma_f32_32x32x16_bf16(pa0,PK(0),o[d0],0,0,0);
    o[d0]=__builtin_amdgcn_mfma_f32_32x32x16_bf16(pa1,PK(1),o[d0],0,0,0);
    o[d0]=__builtin_amdgcn_mfma_f32_32x32x16_bf16(pa2,PK(2),o[d0],0,0,0);
    o[d0]=__builtin_amdgcn_mfma_f32_32x32x16_bf16(pa3,PK(3),o[d0],0,0,0);
    #undef PK
  }
}

#ifndef ATTN_STORE16
#define ATTN_STORE16(p,v) (*(u32x4*)(p)=(v))
#endif
template<int MODE,int THRL> __device__ __forceinline__ void attn_unit(int b,int qb,int tb,int cq,int cv,int co,const bf16*Q,const bf16*__restrict__ K,const bf16*__restrict__ V,bf16*O,const float*tabsrc,char*shm){
  int tid_=threadIdx.x; asm volatile("":"+v"(tid_));
  const int tid=tid_,lane=tid&63,r32=lane&31,hi=lane>>5; const int wid=__builtin_amdgcn_readfirstlane(tid>>6);
  const long rowbase=(long)b*SEQ, rowbase_k=(long)b*KROWS; const int q0=qb*QB;
  const bf16*Qw=Q+(rowbase+q0+wid*QBLK)*DM+cq;
  const bf16*Kh=K+rowbase_k*DM+cq,*Vh=V+rowbase_k*DM+cv;
  const unsigned lds0=(unsigned)(uintptr_t)shm;
  const __attribute__((address_space(3))) char* shm3_=(const __attribute__((address_space(3))) char*)shm;
  float*wsf=(float*)(shm+LDS_WS)+wid*64;
  const bf16*ksrc=Kh+(long)(lane+64*tb)*DM+wid*8;
  const bf16*vsrc=Vh+(long)(16*(wid&3)+(lane>>2)+64*tb)*DM+(wid>>2)*32+(lane&3)*8;
  const unsigned kdst=lds0+LDS_K+wid*1024, vdst=lds0+LDS_V+wid*1024;
  #define DMA_K(t,slot) glds16(ksrc+(long)(t)*KVBLK*DM,(unsigned)__builtin_amdgcn_readfirstlane(kdst+(slot)))
  #define DMA_V(t,slot) glds16(vsrc+(long)(t)*KVBLK*DM,(unsigned)__builtin_amdgcn_readfirstlane(vdst+(slot)))
  const int vb0=(int)(lds0+LDS_V)+((lane>>4)&1)*32+(lane&3)*8+(4*hi+((lane&15)>>2))*64;
  const char*Kbase=shm+LDS_K; bf16x8 kf[8];
  const lds_cptr shm3=(lds_cptr)shm; const lds_cptr kp0=shm3+LDS_K+hi*1024+r32*16; const lds_cptr vp0=shm3+LDS_V+((lane>>4)&1)*32+(lane&3)*8+(4*hi+((lane&15)>>2))*64;
  const int NT=(KPRE+q0+QB+KVBLK)/KVBLK-tb;
  const __attribute__((address_space(3))) float* tab=(const __attribute__((address_space(3))) float*)(shm3_+LDS_TAB);
  { __attribute__((address_space(3))) float* tw=(__attribute__((address_space(3))) float*)(shm3_+LDS_TAB);
    if(MODE==0){ for(int i=tid;i<RT_SIZE;i+=512){ const int d=i-RT_OFFS; tw[i]=d<0?-INFINITY:(d<128?tabsrc[d]:0.f); } }
    else { const int n=KPRE+q0+QB+KVBLK; for(int i=64*tb+tid*4;i<n;i+=2048){ const float4 v=*(const float4*)(tabsrc+i); tw[i]=v.x;tw[i+1]=v.y;tw[i+2]=v.z;tw[i+3]=v.w; } } }
  if(tb==0){ glds16(K+cq+(long)lane*DM+wid*8,(unsigned)__builtin_amdgcn_readfirstlane(kdst)); glds16(V+cv+(long)(16*(wid&3)+(lane>>2))*DM+(wid>>2)*32+(lane&3)*8,(unsigned)__builtin_amdgcn_readfirstlane(vdst)); } else { DMA_K(0,0); DMA_V(0,0); } DMA_K(1,SLOTB);
  bf16x8 qr[4];
  #pragma unroll
  for(int d0=0;d0<4;++d0)qr[d0]=*reinterpret_cast<const bf16x8*>(&Qw[(long)r32*DM+d0*16+hi*8]);
  float l_reg=0.f;f32x16 o[2];o[0]=f32x16{};o[1]=f32x16{};f32x16 negm=f32x16{};asm volatile("":"+v"(negm));
  const int qrel=wid*QBLK+r32, q_abs=q0+qrel;
  #define MODT(P0,P1,t,SL) do{ if(SL)modtile_slow<MODE>(P0,P1,(t)+tb,q_abs,q0,hi,tab); else if(MODE==1)modtile_fast1(P0,P1,(t)+tb,hi,tab); }while(0)
  bool resc=false;
  #define START(P0,P1) do{ const float rm=rowmax(P0,P1); resc=false; \
    { const float dl=(MODE==1)?__builtin_fmaxf(rm,0.f):rm; const float nm_=fsub_s(negm[0],dl); \
      _Pragma("unroll") for(int r=0;r<16;++r){P0[r]=fsub_s(P0[r],dl);P1[r]=fsub_s(P1[r],dl);} \
      _Pragma("unroll") for(int r=0;r<16;++r)negm[r]=nm_; asm volatile("":"+v"(negm)); } \
    _Pragma("unroll") for(int r=0;r<16;++r)P0[r]=__builtin_amdgcn_exp2f(P0[r]); }while(0)
  #define RESC() do{ if(resc){ asm volatile("s_waitcnt lgkmcnt(0)":::"memory"); \
      _Pragma("unroll") for(int d_=0;d_<2;++d_) _Pragma("unroll") for(int r=0;r<16;++r)o[d_][r]*=wsf[crow(r,hi)]; } }while(0)
  f32x16 pA0,pA1,pB0,pB1;
  int sl_prev=0,sl_cur=0,sl_next=SLOTB;
  #define ROT() do{sl_prev=sl_cur;sl_cur=sl_next;sl_next=(sl_next==(NSLOT-1)*SLOTB)?0:sl_next+SLOTB;}while(0)
  DMA_K(2,2*SLOTB);
  WAIT_BAR(3);
  if(MODE==1){ const float m0_=tab[KPRE+q_abs]; _Pragma("unroll") for(int r=0;r<16;++r)negm[r]=-m0_; asm volatile("":"+v"(negm)); }
  qkt(pA0,pA1,Kbase,qr,negm,r32,hi);asm volatile("s_nop 15\n\ts_nop 7":"+v"(pA0),"+v"(pA1));MODT(pA0,pA1,0,true);
  START(pA0,pA1);
  _Pragma("unroll") for(int r=0;r<16;++r)pA1[r]=__builtin_amdgcn_exp2f(pA1[r]);
  WAIT_BAR(0);
  DMA_K(3,0);DMA_V(1,SLOTB);
  ROT();
  kload8(kf,kp0+sl_cur);
  WAIT_BAR(2);
  s16x4 vlo[8],vhi[8]; u32x4 pw0,pw1,pw2,pw3;
  #define PKW(P,B) cvtpk_s(P[B],P[B+1])
  #define PAF(k) __builtin_bit_cast(bf16x8,pw##k)
  #define VFR(i) (bf16x8){vlo[i][0],vlo[i][1],vlo[i][2],vlo[i][3],vhi[i][0],vhi[i][1],vhi[i][2],vhi[i][3]}
  #define PIN(x) asm volatile("":"+v"(x))
  #define MX3(a,b,c) __builtin_fmaxf(__builtin_fmaxf((a),(b)),(c))
  #define GAPA(MF,A0,A1,A2,A3,W0,W1,PW) do{ MF; sacc+=A0; sacc+=A1; sacc+=A2; sacc+=A3; PIN(sacc); W0; W1; PIN(PW); SBAR(); }while(0)
  #define EX(v) __builtin_amdgcn_exp2f(v)
  #define GAPB(MF,X,B) do{ MF; X[B]=EX(X[B]); X[B+1]=EX(X[B+1]); X[B+2]=EX(X[B+2]); X[B+3]=EX(X[B+3]); PIN(X); SBAR(); }while(0)
  #define VRD(i) do{ vlo[i]=vtr(vp_+(((i)>>2)*4096+((i)&3)*1024)); vhi[i]=vtr(vp_+(((i)>>2)*4096+((i)&3)*1024+512)); }while(0)
  #define KRD(G,j) do{ if(G){ kload2(kf,kp0+sl_next,j); SBAR(); } }while(0)
  #define STEP(C0,C1,P0,P1,t,GK,GV,GL,SL) do{ SBAR(); \
    const lds_cptr vp_=vp0+sl_prev; \
    VRD(0); SBAR(); float sacc=(P0[0]+P0[1]); \
    GAPA(C0=__builtin_amdgcn_mfma_f32_32x32x16_bf16(kf[0],qr[0],negm,0,0,0), P0[2],P0[3],P0[4],P0[5],     pw0[0]=PKW(P0,0), pw0[1]=PKW(P0,2), pw0); \
    VRD(4); SBAR(); GAPA(C1=__builtin_amdgcn_mfma_f32_32x32x16_bf16(kf[1],qr[0],negm,0,0,0), P0[6],P0[7],P0[8],P0[9],     pw0[2]=PKW(P0,4), pw0[3]=PKW(P0,6), pw0); \
    VRD(1); SBAR(); GAPA(C0=__builtin_amdgcn_mfma_f32_32x32x16_bf16(kf[2],qr[1],C0,0,0,0),   P0[10],P0[11],P0[12],P0[13], pw1[0]=PKW(P0,8), pw1[1]=PKW(P0,10), pw1); \
    VRD(5); SBAR(); GAPA(C1=__builtin_amdgcn_mfma_f32_32x32x16_bf16(kf[3],qr[1],C1,0,0,0),   P0[14],P0[15],P1[0],P1[1],   pw1[2]=PKW(P0,12),pw1[3]=PKW(P0,14), pw1); \
    VRD(2); SBAR(); GAPA(C0=__builtin_amdgcn_mfma_f32_32x32x16_bf16(kf[4],qr[2],C0,0,0,0),   P1[2],P1[3],P1[4],P1[5],     pw2[0]=PKW(P1,0), pw2[1]=PKW(P1,2), pw2); \
    VRD(6); SBAR(); GAPA(C1=__builtin_amdgcn_mfma_f32_32x32x16_bf16(kf[5],qr[2],C1,0,0,0),   P1[6],P1[7],P1[8],P1[9],     pw2[2]=PKW(P1,4), pw2[3]=PKW(P1,6), pw2); \
    VRD(3); SBAR(); GAPA(C0=__builtin_amdgcn_mfma_f32_32x32x16_bf16(kf[6],qr[3],C0,0,0,0),   P1[10],P1[11],P1[12],P1[13], pw3[0]=PKW(P1,8), pw3[1]=PKW(P1,10), pw3); \
    VRD(7); SBAR(); GAPA(C1=__builtin_amdgcn_mfma_f32_32x32x16_bf16(kf[7],qr[3],C1,0,0,0),   P1[14],P1[15],0.f,0.f,       pw3[2]=PKW(P1,12),pw3[3]=PKW(P1,14), pw3); \
    l_reg+=sacc; \
    if(GK){DMA_K((t)+3,sl_cur);} if(GV){DMA_V((t)+1,sl_next);} \
    MODT(C0,C1,t,SL); \
    { float a=MX3(C0[0],C0[1],C1[0]),b=MX3(C0[2],C0[3],C1[1]); a=MX3(a,C1[2],C1[3]); \
      _Pragma("unroll") for(int r=4;r<16;r+=4){a=MX3(a,C0[r],C0[r+1]);b=MX3(b,C0[r+2],C0[r+3]);a=MX3(a,C1[r],C1[r+1]);b=MX3(b,C1[r+2],C1[r+3]);} \
      float rm=__builtin_fmaxf(a,b); { auto rr=__builtin_amdgcn_permlane32_swap(__float_as_uint(rm),__float_as_uint(rm),false,false); rm=__builtin_fmaxf(__uint_as_float(rr[0]),__uint_as_float(rr[1])); } \
      resc=false; \
      if(__builtin_expect(__any(rm>(float)THRL),0)){ const float dl=__builtin_fmaxf(rm,0.f); const float nm_=negm[0]-dl; \
        _Pragma("unroll") for(int r=0;r<16;++r){C0[r]-=dl;C1[r]-=dl;} \
        _Pragma("unroll") for(int r=0;r<16;++r)negm[r]=nm_; asm volatile("":"+v"(negm)); \
        const float f=__builtin_amdgcn_exp2f(-dl); l_reg*=f; if(hi==0){ int r32_=r32; asm volatile("":"+v"(r32_)); wsf[r32_]=f; } resc=true; } } \
    SBAR(); \
    GAPB(o[0]=__builtin_amdgcn_mfma_f32_32x32x16_bf16(PAF(0),VFR(0),o[0],0,0,0), C0,0); \
    GAPB(o[1]=__builtin_amdgcn_mfma_f32_32x32x16_bf16(PAF(0),VFR(4),o[1],0,0,0), C0,4); \
    KRD(GL,0); GAPB(o[0]=__builtin_amdgcn_mfma_f32_32x32x16_bf16(PAF(1),VFR(1),o[0],0,0,0), C0,8); \
    KRD(GL,1); GAPB(o[1]=__builtin_amdgcn_mfma_f32_32x32x16_bf16(PAF(1),VFR(5),o[1],0,0,0), C0,12); \
    KRD(GL,2); GAPB(o[0]=__builtin_amdgcn_mfma_f32_32x32x16_bf16(PAF(2),VFR(2),o[0],0,0,0), C1,0); \
    KRD(GL,3); GAPB(o[1]=__builtin_amdgcn_mfma_f32_32x32x16_bf16(PAF(2),VFR(6),o[1],0,0,0), C1,4); \
    GAPB(o[0]=__builtin_amdgcn_mfma_f32_32x32x16_bf16(PAF(3),VFR(3),o[0],0,0,0), C1,8); \
    GAPB(o[1]=__builtin_amdgcn_mfma_f32_32x32x16_bf16(PAF(3),VFR(7),o[1],0,0,0), C1,12); \
    }while(0)
  int t=1;
  #define ENDW(tt) do{ if((tt)+3<NT){WAIT_BAR(2);} else if((tt)+2<NT){WAIT_BAR(1);} else {WAIT_BAR(0);} }while(0)
  for(;t+(MODE==1?5:7)<NT;t+=2){
    STEP(pB0,pB1,pA0,pA1,t,true,true,true,false);     WAIT_BAR(2); RESC(); ROT();
    STEP(pA0,pA1,pB0,pB1,t+1,true,true,true,false);   WAIT_BAR(2); RESC(); ROT();
  }
  for(;t+1<NT;t+=2){
    STEP(pB0,pB1,pA0,pA1,t,(t+3<NT),(t+1<NT),(t+1<NT),true);       ENDW(t);   RESC(); ROT();
    STEP(pA0,pA1,pB0,pB1,t+1,(t+4<NT),(t+2<NT),(t+2<NT),true);     ENDW(t+1); RESC(); ROT();
  }
  STEP(pB0,pB1,pA0,pA1,NT-1,false,false,false,true); RESC();
  { float sacc=pB0[0]+pB0[1]; _Pragma("unroll") for(int r=2;r<16;++r)sacc+=pB0[r]; _Pragma("unroll") for(int r=0;r<16;++r)sacc+=pB1[r]; l_reg+=sacc;
    pw0=(u32x4){PKW(pB0,0),PKW(pB0,2),PKW(pB0,4),PKW(pB0,6)};pw1=(u32x4){PKW(pB0,8),PKW(pB0,10),PKW(pB0,12),PKW(pB0,14)};pw2=(u32x4){PKW(pB1,0),PKW(pB1,2),PKW(pB1,4),PKW(pB1,6)};pw3=(u32x4){PKW(pB1,8),PKW(pB1,10),PKW(pB1,12),PKW(pB1,14)};
    SBAR(); pv(o,vb0+sl_cur,PAF(0),PAF(1),PAF(2),PAF(3)); }
  #undef PKW
  #undef PAF
  #undef VFR
  #undef PIN
  #undef MX3
  #undef GAPA
  #undef GAPB
  #undef EX
  #undef VRD
  #undef KRD
  #undef STEP
  #undef ENDW
  {auto rr=__builtin_amdgcn_permlane32_swap(__float_as_uint(l_reg),__float_as_uint(l_reg),false,false);l_reg=__uint_as_float(rr[0])+__uint_as_float(rr[1]);}
  if(hi==0)wsf[32+r32]=l_reg;asm volatile("s_waitcnt lgkmcnt(0)":::"memory");
  float rli[16];
  #pragma unroll
  for(int r=0;r<16;++r)rli[r]=__builtin_amdgcn_rcpf(wsf[32+crow(r,hi)]);
  bf16*Ow=O+(rowbase+q0+wid*QBLK)*DM+co;
  { bf16*stg=(bf16*)(shm+LDS_OST)+wid*2048;
    #pragma unroll
    for(int r=0;r<16;++r){const int orow=crow(r,hi);
      #pragma unroll
      for(int d0=0;d0<2;++d0)stg[orow*64+d0*32+r32]=__float2bfloat16(o[d0][r]*rli[r]);}
    asm volatile("s_waitcnt lgkmcnt(0)":::"memory");
    #pragma unroll
    for(int i=0;i<4;++i){const int row=i*8+(lane>>3),ch=lane&7; const u32x4 v=*(const u32x4*)(stg+row*64+ch*8); ATTN_STORE16(Ow+(long)row*DM+ch*8,v);} }
  asm volatile("s_waitcnt lgkmcnt(0)\n\ts_barrier":::"memory");
  #undef DMA_K
  #undef DMA_V
  #undef MODT
  #undef START
  #undef RESC
  #undef ROT
}

template<int THRL> __device__ __forceinline__ void attn_unit_dv(int b,int qb,int cq,int cv,int co,const bf16*Q,const bf16*__restrict__ K,const bf16*__restrict__ V,bf16*O,const float*tabsrc,char*shm){
  int tid_=threadIdx.x; asm volatile("":"+v"(tid_));
  constexpr int MODE=0, tb=0; const int tid=tid_,lane=tid&63,r32=lane&31,hi=lane>>5; const int wid=__builtin_amdgcn_readfirstlane(tid>>6);
  constexpr int LDS_K=0, LDS_V=NSLOT*SLOTB, LDS_WS=LDS_V+NSLOT*2*SLOTB, LDS_OST=LDS_WS+NW*64*4, LDS_TAB=LDS_OST+NW*4096;
  static_assert(LDS_TAB+RT_SIZE*4<=131072,"dv LDS map");
  const long rowbase=(long)b*SEQ, rowbase_k=(long)b*KROWS; const int q0=qb*QB;
  const bf16*Qw=Q+(rowbase+q0+wid*QBLK)*DM+cq;
  const bf16*Kh=K+rowbase_k*DM+cq,*Vh=V+rowbase_k*DM+cv;
  const unsigned lds0=(unsigned)(uintptr_t)shm;
  const __attribute__((address_space(3))) char* shm3_=(const __attribute__((address_space(3))) char*)shm;
  float*wsf=(float*)(shm+LDS_WS)+wid*64;
  const bf16*ksrc=Kh+(long)(lane+64*tb)*DM+wid*8;
  const bf16*vsrc=Vh+(long)(16*(wid&3)+(lane>>2)+64*tb)*DM+(wid>>2)*32+(lane&3)*8;
  const unsigned kdst=lds0+LDS_K+wid*1024, vdst=lds0+LDS_V+wid*1024;
  #define DMA_K(t,slot) glds16(ksrc+(long)(t)*KVBLK*DM,(unsigned)__builtin_amdgcn_readfirstlane(kdst+(slot)))
  #define DMA_V(t,slot) do{ glds16(vsrc+(long)(t)*KVBLK*DM,(unsigned)__builtin_amdgcn_readfirstlane(vdst+2*(slot))); glds16(vsrc+(long)(t)*KVBLK*DM+64,(unsigned)__builtin_amdgcn_readfirstlane(vdst+2*(slot)+8192)); }while(0)
  const int vb0=(int)(lds0+LDS_V)+((lane>>4)&1)*32+(lane&3)*8+(4*hi+((lane&15)>>2))*64;
  const char*Kbase=shm+LDS_K; bf16x8 kf[8];
  const lds_cptr shm3=(lds_cptr)shm; const lds_cptr kp0=shm3+LDS_K+hi*1024+r32*16; const lds_cptr vp0=shm3+LDS_V+((lane>>4)&1)*32+(lane&3)*8+(4*hi+((lane&15)>>2))*64;
  const int NT=(KPRE+q0+QB+KVBLK)/KVBLK-tb;
  const __attribute__((address_space(3))) float* tab=(const __attribute__((address_space(3))) float*)(shm3_+LDS_TAB);
  { __attribute__((address_space(3))) float* tw=(__attribute__((address_space(3))) float*)(shm3_+LDS_TAB);
    if(MODE==0){ for(int i=tid;i<RT_SIZE;i+=512){ const int d=i-RT_OFFS; tw[i]=d<0?-INFINITY:(d<128?tabsrc[d]:0.f); } }
    else { const int n=KPRE+q0+QB+KVBLK; for(int i=64*tb+tid*4;i<n;i+=2048){ const float4 v=*(const float4*)(tabsrc+i); tw[i]=v.x;tw[i+1]=v.y;tw[i+2]=v.z;tw[i+3]=v.w; } } }
  if(tb==0){ glds16(K+cq+(long)lane*DM+wid*8,(unsigned)__builtin_amdgcn_readfirstlane(kdst)); glds16(V+cv+(long)(16*(wid&3)+(lane>>2))*DM+(wid>>2)*32+(lane&3)*8,(unsigned)__builtin_amdgcn_readfirstlane(vdst)); glds16(V+cv+(long)(16*(wid&3)+(lane>>2))*DM+(wid>>2)*32+(lane&3)*8+64,(unsigned)__builtin_amdgcn_readfirstlane(vdst+8192)); } else { DMA_K(0,0); DMA_V(0,0); } DMA_K(1,SLOTB);
  bf16x8 qr[4];
  #pragma unroll
  for(int d0=0;d0<4;++d0)qr[d0]=*reinterpret_cast<const bf16x8*>(&Qw[(long)r32*DM+d0*16+hi*8]);
  float mhat=0.f,l_reg=0.f;f32x16 o[4];o[0]=f32x16{};o[1]=f32x16{};o[2]=f32x16{};o[3]=f32x16{};const f32x16 zero16=f32x16{}; bool hasref=false;
  const int qrel=wid*QBLK+r32, q_abs=q0+qrel;
  #define MODT(P0,P1,t,SL) do{ if(SL)modtile_slow<MODE>(P0,P1,(t)+tb,q_abs,q0,hi,tab); else if(MODE==1)modtile_fast1(P0,P1,(t)+tb,hi,tab); }while(0)
  bool resc=false;
  #define START(P0,P1) do{ const float rm=rowmax(P0,P1); resc=false; mhat=(rm>=-64.f&&rm<64.f)?0.f:64.f*__builtin_floorf(rm*0.015625f+0.5f); hasref=__any(mhat!=0.f); \
    if(__builtin_expect(hasref,0)){ _Pragma("unroll") for(int r=0;r<16;++r){P0[r]-=mhat;P1[r]-=mhat;} } \
    _Pragma("unroll") for(int r=0;r<16;++r)P0[r]=__builtin_amdgcn_exp2f(P0[r]); }while(0)
  #define RESC() do{ if(resc){ asm volatile("s_waitcnt lgkmcnt(0)":::"memory"); \
      _Pragma("unroll") for(int d_=0;d_<4;++d_) _Pragma("unroll") for(int r=0;r<16;++r)o[d_][r]*=wsf[crow(r,hi)]; } }while(0)
  f32x16 pA0,pA1,pB0,pB1;
  int sl_prev=0,sl_cur=0,sl_next=SLOTB;
  #define ROT() do{sl_prev=sl_cur;sl_cur=sl_next;sl_next=(sl_next==(NSLOT-1)*SLOTB)?0:sl_next+SLOTB;}while(0)
  DMA_K(2,2*SLOTB);
  WAIT_BAR(3);
  qkt(pA0,pA1,Kbase,qr,zero16,r32,hi);asm volatile("s_nop 15\n\ts_nop 7":"+v"(pA0),"+v"(pA1));MODT(pA0,pA1,0,true);
  START(pA0,pA1);
  _Pragma("unroll") for(int r=0;r<16;++r)pA1[r]=__builtin_amdgcn_exp2f(pA1[r]);
  WAIT_BAR(0);
  DMA_K(3,0);DMA_V(1,SLOTB);
  ROT();
  kload8(kf,kp0+sl_cur);
  WAIT_BAR(3);
  s16x4 vlo[8],vhi[8],wlo[8],whi[8]; u32x4 pw0,pw1,pw2,pw3;
  #define PKW(P,B) cvtpk_s(P[B],P[B+1])
  #define PAF(k) __builtin_bit_cast(bf16x8,pw##k)
  #define VFR(i) (bf16x8){vlo[i][0],vlo[i][1],vlo[i][2],vlo[i][3],vhi[i][0],vhi[i][1],vhi[i][2],vhi[i][3]}
  #define WFR(i) (bf16x8){wlo[i][0],wlo[i][1],wlo[i][2],wlo[i][3],whi[i][0],whi[i][1],whi[i][2],whi[i][3]}
  #define WRD(i) do{ wlo[i]=vtr(vp_+((2+((i)>>2))*4096+((i)&3)*1024)); whi[i]=vtr(vp_+((2+((i)>>2))*4096+((i)&3)*1024+512)); SBAR(); }while(0)
  #define GAPB2(MF,X,B) do{ MF; X[B]=EX(X[B]); X[B+1]=EX(X[B+1]); PIN(X); SBAR(); }while(0)
  #define PIN(x) asm volatile("":"+v"(x))
  #define MX3(a,b,c) __builtin_fmaxf(__builtin_fmaxf((a),(b)),(c))
  #define GAPA(MF,A0,A1,A2,A3,W0,W1,PW) do{ MF; sacc+=A0; sacc+=A1; sacc+=A2; sacc+=A3; PIN(sacc); W0; W1; PIN(PW); SBAR(); }while(0)
  #define EX(v) __builtin_amdgcn_exp2f(v)
  #define GAPB(MF,X,B) do{ MF; X[B]=EX(X[B]); X[B+1]=EX(X[B+1]); X[B+2]=EX(X[B+2]); X[B+3]=EX(X[B+3]); PIN(X); SBAR(); }while(0)
  #define VRD(i) do{ vlo[i]=vtr(vp_+(((i)>>2)*4096+((i)&3)*1024)); vhi[i]=vtr(vp_+(((i)>>2)*4096+((i)&3)*1024+512)); }while(0)
  #define KRD(G,j) do{ if(G){ kload2(kf,kp0+sl_next,j); SBAR(); } }while(0)
  #define STEP(C0,C1,P0,P1,t,GK,GV,GL,SL) do{ SBAR(); \
    const lds_cptr vp_=vp0+2*sl_prev; \
    VRD(0); SBAR(); float sacc=(P0[0]+P0[1]); \
    GAPA(C0=__builtin_amdgcn_mfma_f32_32x32x16_bf16(kf[0],qr[0],zero16,0,0,0), P0[2],P0[3],P0[4],P0[5],     pw0[0]=PKW(P0,0), pw0[1]=PKW(P0,2), pw0); \
    VRD(4); SBAR(); GAPA(C1=__builtin_amdgcn_mfma_f32_32x32x16_bf16(kf[1],qr[0],zero16,0,0,0), P0[6],P0[7],P0[8],P0[9],     pw0[2]=PKW(P0,4), pw0[3]=PKW(P0,6), pw0); \
    VRD(1); SBAR(); GAPA(C0=__builtin_amdgcn_mfma_f32_32x32x16_bf16(kf[2],qr[1],C0,0,0,0),   P0[10],P0[11],P0[12],P0[13], pw1[0]=PKW(P0,8), pw1[1]=PKW(P0,10), pw1); \
    VRD(5); SBAR(); GAPA(C1=__builtin_amdgcn_mfma_f32_32x32x16_bf16(kf[3],qr[1],C1,0,0,0),   P0[14],P0[15],P1[0],P1[1],   pw1[2]=PKW(P0,12),pw1[3]=PKW(P0,14), pw1); \
    VRD(2); SBAR(); GAPA(C0=__builtin_amdgcn_mfma_f32_32x32x16_bf16(kf[4],qr[2],C0,0,0,0),   P1[2],P1[3],P1[4],P1[5],     pw2[0]=PKW(P1,0), pw2[1]=PKW(P1,2), pw2); \
    VRD(6); SBAR(); GAPA(C1=__builtin_amdgcn_mfma_f32_32x32x16_bf16(kf[5],qr[2],C1,0,0,0),   P1[6],P1[7],P1[8],P1[9],     pw2[2]=PKW(P1,4), pw2[3]=PKW(P1,6), pw2); \
    VRD(3); SBAR(); GAPA(C0=__builtin_amdgcn_mfma_f32_32x32x16_bf16(kf[6],qr[3],C0,0,0,0),   P1[10],P1[11],P1[12],P1[13], pw3[0]=PKW(P1,8), pw3[1]=PKW(P1,10), pw3); \
    VRD(7); SBAR(); GAPA(C1=__builtin_amdgcn_mfma_f32_32x32x16_bf16(kf[7],qr[3],C1,0,0,0),   P1[14],P1[15],0.f,0.f,       pw3[2]=PKW(P1,12),pw3[3]=PKW(P1,14), pw3); \
    l_reg+=sacc; \
    if(GK){DMA_K((t)+3,sl_cur);} if(GV){DMA_V((t)+1,sl_next);} \
    MODT(C0,C1,t,SL); \
    { float a=MX3(C0[0],C0[1],C1[0]),b=MX3(C0[2],C0[3],C1[1]); a=MX3(a,C1[2],C1[3]); \
      _Pragma("unroll") for(int r=4;r<16;r+=4){a=MX3(a,C0[r],C0[r+1]);b=MX3(b,C0[r+2],C0[r+3]);a=MX3(a,C1[r],C1[r+1]);b=MX3(b,C1[r+2],C1[r+3]);} \
      float rm=__builtin_fmaxf(a,b); { auto rr=__builtin_amdgcn_permlane32_swap(__float_as_uint(rm),__float_as_uint(rm),false,false); rm=__builtin_fmaxf(__uint_as_float(rr[0]),__uint_as_float(rr[1])); } \
      resc=false; \
      const float rmd=rm-mhat; \
      if(__builtin_expect(__any(rmd>64.f),0)){ const float dl=rmd>64.f?64.f*__builtin_floorf(rmd*0.015625f):0.f; mhat+=dl; hasref=true; \
        const float f=__builtin_amdgcn_exp2f(-dl); l_reg*=f; if(hi==0)wsf[r32]=f; resc=true; } \
      if(__builtin_expect(hasref,0)){ _Pragma("unroll") for(int r=0;r<16;++r){C0[r]-=mhat;C1[r]-=mhat;} } } \
    SBAR(); \
    WRD(0); GAPB2(o[0]=__builtin_amdgcn_mfma_f32_32x32x16_bf16(PAF(0),VFR(0),o[0],0,0,0), C0,0); \
    WRD(4); GAPB2(o[1]=__builtin_amdgcn_mfma_f32_32x32x16_bf16(PAF(0),VFR(4),o[1],0,0,0), C0,2); \
    WRD(1); GAPB2(o[0]=__builtin_amdgcn_mfma_f32_32x32x16_bf16(PAF(1),VFR(1),o[0],0,0,0), C0,4); \
    WRD(5); GAPB2(o[1]=__builtin_amdgcn_mfma_f32_32x32x16_bf16(PAF(1),VFR(5),o[1],0,0,0), C0,6); \
    WRD(2); GAPB2(o[0]=__builtin_amdgcn_mfma_f32_32x32x16_bf16(PAF(2),VFR(2),o[0],0,0,0), C0,8); \
    WRD(6); GAPB2(o[1]=__builtin_amdgcn_mfma_f32_32x32x16_bf16(PAF(2),VFR(6),o[1],0,0,0), C0,10); \
    WRD(3); GAPB2(o[0]=__builtin_amdgcn_mfma_f32_32x32x16_bf16(PAF(3),VFR(3),o[0],0,0,0), C0,12); \
    WRD(7); GAPB2(o[1]=__builtin_amdgcn_mfma_f32_32x32x16_bf16(PAF(3),VFR(7),o[1],0,0,0), C0,14); \
    KRD(GL,0); GAPB2(o[2]=__builtin_amdgcn_mfma_f32_32x32x16_bf16(PAF(0),WFR(0),o[2],0,0,0), C1,0); \
    KRD(GL,1); GAPB2(o[3]=__builtin_amdgcn_mfma_f32_32x32x16_bf16(PAF(0),WFR(4),o[3],0,0,0), C1,2); \
    KRD(GL,2); GAPB2(o[2]=__builtin_amdgcn_mfma_f32_32x32x16_bf16(PAF(1),WFR(1),o[2],0,0,0), C1,4); \
    KRD(GL,3); GAPB2(o[3]=__builtin_amdgcn_mfma_f32_32x32x16_bf16(PAF(1),WFR(5),o[3],0,0,0), C1,6); \
    GAPB2(o[2]=__builtin_amdgcn_mfma_f32_32x32x16_bf16(PAF(2),WFR(2),o[2],0,0,0), C1,8); \
    GAPB2(o[3]=__builtin_amdgcn_mfma_f32_32x32x16_bf16(PAF(2),WFR(6),o[3],0,0,0), C1,10); \
    GAPB2(o[2]=__builtin_amdgcn_mfma_f32_32x32x16_bf16(PAF(3),WFR(3),o[2],0,0,0), C1,12); \
    GAPB2(o[3]=__builtin_amdgcn_mfma_f32_32x32x16_bf16(PAF(3),WFR(7),o[3],0,0,0), C1,14); \
    }while(0)
  int t=1;
  #define ENDW(tt) do{ if((tt)+3<NT){WAIT_BAR(3);} else if((tt)+2<NT){WAIT_BAR(2);} else {WAIT_BAR(0);} }while(0)
  for(;t+(MODE==1?5:7)<NT;t+=2){
    STEP(pB0,pB1,pA0,pA1,t,true,true,true,false);     WAIT_BAR(3); RESC(); ROT();
    STEP(pA0,pA1,pB0,pB1,t+1,true,true,true,false);   WAIT_BAR(3); RESC(); ROT();
  }
  for(;t+1<NT;t+=2){
    STEP(pB0,pB1,pA0,pA1,t,(t+3<NT),(t+1<NT),(t+1<NT),true);       ENDW(t);   RESC(); ROT();
    STEP(pA0,pA1,pB0,pB1,t+1,(t+4<NT),(t+2<NT),(t+2<NT),true);     ENDW(t+1); RESC(); ROT();
  }
  STEP(pB0,pB1,pA0,pA1,NT-1,false,false,false,true); RESC();
  { float sacc=pB0[0]+pB0[1]; _Pragma("unroll") for(int r=2;r<16;++r)sacc+=pB0[r]; _Pragma("unroll") for(int r=0;r<16;++r)sacc+=pB1[r]; l_reg+=sacc;
    pw0=(u32x4){PKW(pB0,0),PKW(pB0,2),PKW(pB0,4),PKW(pB0,6)};pw1=(u32x4){PKW(pB0,8),PKW(pB0,10),PKW(pB0,12),PKW(pB0,14)};pw2=(u32x4){PKW(pB1,0),PKW(pB1,2),PKW(pB1,4),PKW(pB1,6)};pw3=(u32x4){PKW(pB1,8),PKW(pB1,10),PKW(pB1,12),PKW(pB1,14)};
    SBAR(); pv(o,vb0+2*sl_cur,PAF(0),PAF(1),PAF(2),PAF(3)); pv(o+2,vb0+2*sl_cur+8192,PAF(0),PAF(1),PAF(2),PAF(3)); }
  #undef PKW
  #undef PAF
  #undef VFR
  #undef PIN
  #undef MX3
  #undef GAPA
  #undef GAPB
  #undef EX
  #undef VRD
  #undef WRD
  #undef WFR
  #undef GAPB2
  #undef KRD
  #undef STEP
  #undef ENDW
  {auto rr=__builtin_amdgcn_permlane32_swap(__float_as_uint(l_reg),__float_as_uint(l_reg),false,false);l_reg=__uint_as_float(rr[0])+__uint_as_float(rr[1]);}
  if(hi==0)wsf[32+r32]=l_reg;asm volatile("s_waitcnt lgkmcnt(0)":::"memory");
  float rli[16];
  #pragma unroll
  for(int r=0;r<16;++r)rli[r]=__builtin_amdgcn_rcpf(wsf[32+crow(r,hi)]);
  bf16*Ow=O+(rowbase+q0+wid*QBLK)*DM+co;
  { bf16*stg=(bf16*)(shm+LDS_OST)+wid*2048;
    #pragma unroll
    for(int ps=0;ps<2;++ps){
      #pragma unroll
      for(int r=0;r<16;++r){const int orow=crow(r,hi);
        #pragma unroll
        for(int d0=0;d0<2;++d0)stg[orow*64+d0*32+r32]=__float2bfloat16(o[2*ps+d0][r]*rli[r]);}
      asm volatile("s_waitcnt lgkmcnt(0)":::"memory");
      #pragma unroll
      for(int i=0;i<4;++i){const int row=i*8+(lane>>3),ch=lane&7; const u32x4 v=*(const u32x4*)(stg+row*64+ch*8); ATTN_STORE16(Ow+(long)row*DM+ps*64+ch*8,v);}
      asm volatile("s_waitcnt lgkmcnt(0)":::"memory"); } }
  asm volatile("s_waitcnt lgkmcnt(0)\n\ts_barrier":::"memory");
  #undef DMA_K
  #undef DMA_V
  #undef MODT
  #undef START
  #undef RESC
  #undef ROT
}
constexpr int ATTN_LDS_BYTES=LDS_BYTES;
#undef SBAR
#undef WAIT_BAR
}
#define GAS __attribute__((address_space(1)))
#define LAS __attribute__((address_space(3)))
typedef unsigned short bf16;
typedef unsigned v4u __attribute__((ext_vector_type(4)));
typedef float f32x4 __attribute__((ext_vector_type(4)));
typedef short bf16x8 __attribute__((ext_vector_type(8)));
typedef GAS unsigned gu32;
typedef GAS unsigned long long gu64;
#define RLX_AGENT __ATOMIC_RELAXED, __HIP_MEMORY_SCOPE_AGENT
#define LDS_WAIT() asm volatile("s_waitcnt lgkmcnt(0)" ::: "memory")
#define VM_WAIT() asm volatile("s_waitcnt vmcnt(0)" ::: "memory")
__device__ __forceinline__ unsigned long long rt() { return __builtin_amdgcn_s_memrealtime(); }
__device__ __forceinline__ unsigned f2bf(float f) { unsigned u = __builtin_bit_cast(unsigned, f); return (u + 0x7fffu + ((u >> 16) & 1u)) >> 16; }
__device__ __forceinline__ unsigned pk2(float lo, float hi) { return f2bf(lo) | (f2bf(hi) << 16); }

#define XB_TMO      128
#define XB_XCNT(j)  (256  + 64 * (j))
#define XB_XSUB(j)  (1280 + 64 * (j))
#define XB_XGEN(j)  (2304 + 64 * (j))
#define XB_TOP      3328
#define XB_TOPGEN   3392
#define XCD_BAR_WORDS 3456
#define XB_SPIN_CAP (1u << 18)

__device__ __forceinline__ unsigned xb_ld(unsigned* p)              { return __hip_atomic_load(p, __ATOMIC_RELAXED, __HIP_MEMORY_SCOPE_AGENT); }
__device__ __forceinline__ unsigned xb_add(unsigned* p, unsigned v) { return __hip_atomic_fetch_add(p, v, __ATOMIC_RELAXED, __HIP_MEMORY_SCOPE_AGENT); }
__device__ __forceinline__ unsigned xb_xcc_id() { return (unsigned)__builtin_amdgcn_s_getreg((3 << 11) | 20) & 0xFu; }
#define XB_SPIN(cond, bar) do { unsigned _sp = 0; while (cond) { __builtin_amdgcn_s_sleep(1); \
    if ((++_sp & 255u) == 0u) { if (xb_ld(&(bar)[XB_TMO])) break; if (_sp > XB_SPIN_CAP) { atomicAdd(&(bar)[XB_TMO], 1u); break; } } } } while (0)

struct XcdBarrier {
    unsigned* bar; unsigned x;
    volatile LAS unsigned* st;
};

__device__ __forceinline__ XcdBarrier xcd_barrier_post(unsigned* bar, volatile LAS unsigned* st) {
    XcdBarrier b; b.bar = bar; b.x = xb_xcc_id(); b.st = st;
    if (threadIdx.x == 0) (void)xb_add(&bar[XB_XCNT(b.x)], 1u);
    return b;
}
__device__ __forceinline__ void xcd_barrier_complete(unsigned* bar, unsigned x, unsigned& nloc, unsigned& nx) {
    const unsigned G = gridDim.x * gridDim.y * gridDim.z;
    unsigned sum, cnt, mine, sp = 0u;
    for (;;) {
        sum = 0u; cnt = 0u; mine = 0u;
#pragma unroll
        for (unsigned j = 0; j < 16; ++j) { const unsigned c = xb_ld(&bar[XB_XCNT(j)]); sum += c; cnt += (c > 0u) ? 1u : 0u; mine = (j == x) ? c : mine; }
        if (sum == G) break;
        __builtin_amdgcn_s_sleep(1);
        if ((++sp & 255u) == 0u) { if (xb_ld(&bar[XB_TMO])) break; if (sp > XB_SPIN_CAP) { atomicAdd(&bar[XB_TMO], 1u); break; } }
    }
    nloc = mine > 0u ? mine : 1u; nx = cnt > 0u ? cnt : 1u;
}

__device__ __forceinline__ void xcd_barrier(const XcdBarrier& b) {
    asm volatile("s_waitcnt vmcnt(0)" ::: "memory");
    __syncthreads();
    if (threadIdx.x == 0) {
        unsigned* bar = b.bar;
        __builtin_amdgcn_s_waitcnt(0);
        unsigned nloc = b.st[0], nx = b.st[1];
        if (nloc == 0u) { xcd_barrier_complete(bar, b.x, nloc, nx); b.st[0] = nloc; b.st[1] = nx; }
        const unsigned old = xb_add(&bar[XB_XSUB(b.x)], 1u);
        const unsigned gen = old / nloc;
        if (old + 1u == (gen + 1u) * nloc) {
            __builtin_amdgcn_fence(__ATOMIC_RELEASE, "agent");
            asm volatile("s_waitcnt vmcnt(0)" ::: "memory");
            const unsigned og = xb_add(&bar[XB_TOP], 1u);
            const unsigned tg = og / nx;
            if (og + 1u == (tg + 1u) * nx) xb_add(&bar[XB_TOPGEN], 1u);
            else XB_SPIN(xb_ld(&bar[XB_TOPGEN]) == tg, bar);
            __builtin_amdgcn_fence(__ATOMIC_ACQUIRE, "agent");
            xb_add(&bar[XB_XGEN(b.x)], 1u);
            asm volatile("s_waitcnt vmcnt(0)" ::: "memory");
        } else {
            XB_SPIN(xb_ld(&bar[XB_XGEN(b.x)]) == gen, bar);
            __builtin_amdgcn_fence(__ATOMIC_ACQUIRE, "agent");
            asm volatile("s_waitcnt vmcnt(0)" ::: "memory");
        }
    }
    __syncthreads();
}

constexpr int NWAVES = 8;
#ifndef MK_PER_PHASE
#define MK_PER_PHASE 0
#endif
constexpr int N_PHASES = 16;

constexpr size_t MiB = 1u << 20;
constexpr size_t WS_CTL = 0, CTL_ZERO_BYTES = 1 * MiB;
constexpr size_t WS_GV = 1 * MiB + 512 * 1024;
constexpr size_t WS_HM = 2 * MiB;
constexpr size_t WS_TAB = 2 * MiB + 256 * 1024;
constexpr size_t WS_LF = 3 * MiB;
constexpr size_t WS_DK = 6 * MiB;
constexpr size_t WS_LIST = 9 * MiB;
constexpr int LCAP = NSLOT;
constexpr size_t WS_WQKV0 = 18 * MiB, WS_WO0 = 24 * MiB, WS_WQKV1 = 26 * MiB, WS_WO1 = 32 * MiB, WS_WGU = 34 * MiB, WS_WD = 98 * MiB;
constexpr size_t WS_XH = 130 * MiB;
constexpr size_t WS_Q = 195 * MiB;
constexpr size_t WS_K = 260 * MiB, WS_V = 325 * MiB;
constexpr size_t WS_O0 = 390 * MiB;
constexpr size_t WS_END = 455 * MiB;
static_assert(WS_LIST + (size_t)NEXP * LCAP * 4 <= WS_WQKV0 && WS_DK + (size_t)NBATCH * 16 * KROWS * 4 <= WS_LIST && WS_LF + (size_t)NRP * 16 * 4 <= WS_DK, "small arrays");
static_assert(WS_XH + (size_t)NRP * DM * 2 <= WS_Q && WS_Q + (size_t)NRP * DM * 2 <= WS_K && WS_K + (size_t)NBATCH * KROWS * DM * 2 <= WS_V && WS_V + (size_t)NBATCH * KROWS * DM * 2 <= WS_O0 && WS_O0 + (size_t)NRP * DM * 2 <= WS_END, "activations");
static_assert(WS_K + (size_t)NSLOT * DM * 2 <= WS_O0 && WS_O0 + (size_t)NSLOT * DEXP * 2 <= WS_END, "MoE overlays");
constexpr int CW_TMO = 0, CW_CODE = 1;
constexpr int CW_BAR = 4096;
constexpr int CW_QM = 131072, CW_KM = 147456, CW_QCTR = 148480;
constexpr int CW_CNT = 65536;
constexpr int RING_OFF = 0, RING_BYTES = 131072;
constexpr int ROWTAB_OFF = RING_BYTES, ROWTAB_UNITS = 12;
constexpr int MOEPRE_OFF = ROWTAB_OFF + ROWTAB_UNITS * 1024;
constexpr int MISC_OFF = MOEPRE_OFF + 512;
constexpr int LDS_BYTES = 147456;
static_assert(MISC_OFF + 128 <= LDS_BYTES && attn_body::ATTN_LDS_BYTES <= RING_BYTES, "LDS map");

struct Params {
    const float *x, *meta, *rel_bias, *w_qkv, *lam, *subln, *w_o, *fox_w_in, *fox_b_f, *fox_w_o, *ln_mix_g, *ln_mix_b, *ln_ffn_g, *ln_ffn_b, *rg_w, *rg_b, *re_w, *re_b, *w_gate, *w_up, *w_down;
    float* out; unsigned char* ws; int ph_lo, ph_hi, li, pad;
};
struct Ctx { int tid, lane, wave, vcu, G; LAS unsigned char* lds; };
__device__ __forceinline__ Ctx fresh(const Ctx& C) { Ctx r = C; int t = threadIdx.x; asm volatile("" : "+v"(t)); r.tid = t; r.lane = t & 63; r.wave = __builtin_amdgcn_readfirstlane(t >> 6); return r; }

using pg8::shx;
__device__ __forceinline__ float wave_sum(float v, int lane) {
#pragma unroll
    for (int o = 1; o < 64; o <<= 1) v += shx(v, o, lane);
    return v;
}
__device__ __forceinline__ float bf2f(unsigned short h) { return __uint_as_float((unsigned)h << 16); }
__device__ __forceinline__ float bflo(unsigned w) { return __uint_as_float(w << 16); }
__device__ __forceinline__ float bfhi(unsigned w) { return __uint_as_float(w & 0xffff0000u); }
__device__ __forceinline__ int meta_slot(int j) { return j; }

__device__ __forceinline__ void tr_item(const float* W, int ldw, int k0, int n0, bf16* WT, int ldt, int drow0, LAS float* scr, int lane) {
#pragma unroll 8
    for (int i = 0; i < 32; ++i) { const int kk = 2 * i + (lane >> 5); scr[kk * 33 + (lane & 31)] = W[(size_t)(k0 + kk) * ldw + n0 + (lane & 31)]; }
    LDS_WAIT(); asm volatile("" ::: "memory");
    const int c = lane & 7;
#pragma unroll
    for (int j = 0; j < 4; ++j) { const int n = (lane >> 3) + 8 * j; const LAS float* s = scr + (8 * c) * 33 + n;
        v4u o; o.x = pk2(s[0 * 33], s[1 * 33]); o.y = pk2(s[2 * 33], s[3 * 33]); o.z = pk2(s[4 * 33], s[5 * 33]); o.w = pk2(s[6 * 33], s[7 * 33]);
        *(GAS v4u*)(WT + (size_t)(drow0 + n) * ldt + k0 + 8 * c) = o; }
    LDS_WAIT(); asm volatile("" ::: "memory");
}
__device__ __forceinline__ void convert_experts(const Params& p, const Ctx& C, int layer, int first_item, int gw, int NGW) {
    LAS float* scr = (LAS float*)(C.lds + RING_OFF + C.wave * 16384);
    bf16* Wgu = (bf16*)(p.ws + WS_WGU); bf16* Wd = (bf16*)(p.ws + WS_WD);
    constexpr int PER_E = 768, NIT = NEXP * PER_E;
    for (int it = gw - first_item; it < NIT; it += NGW) { if (it < 0) continue;
        const int e = it / PER_E; int r = it % PER_E; const size_t eo = (size_t)(layer * NEXP + e);
        if (r < 512) { const bool up = r >= 256; r &= 255; const int kb = r >> 4, nb = r & 15, n0 = 32 * nb;
            tr_item((up ? p.w_up : p.w_gate) + eo * DM * DEXP, DEXP, 64 * kb, n0, Wgu + (size_t)e * DM * DM, DM, (n0 >> 7) * 256 + (n0 & 127) + (up ? 128 : 0), scr, C.lane); }
        else { r -= 512; const int kb = r >> 5, nb = r & 31;
            tr_item(p.w_down + eo * DEXP * DM, DM, 64 * kb, 32 * nb, Wd + (size_t)e * DM * DEXP, DEXP, 32 * nb, scr, C.lane); } }
}
__device__ __forceinline__ void p0_prologue(const Params& p, const Ctx& C) {
    LAS float* scr = (LAS float*)(C.lds + RING_OFF + C.wave * 16384);
    const int gw = C.vcu * NWAVES + C.wave, NGW = C.G * NWAVES;
    for (int it = gw; it < 4096; it += NGW) { int r = it;
        if (r < 1536) { tr_item(p.w_qkv, 3072, 64 * (r / 96), 32 * (r % 96), (bf16*)(p.ws + WS_WQKV0), DM, 32 * (r % 96), scr, C.lane); continue; } r -= 1536;
        if (r < 512) { tr_item(p.w_o, DM, 64 * (r >> 5), 32 * (r & 31), (bf16*)(p.ws + WS_WO0), DM, 32 * (r & 31), scr, C.lane); continue; } r -= 512;
        if (r < 1536) { tr_item(p.fox_w_in, 3088, 64 * (r / 96), 32 * (r % 96), (bf16*)(p.ws + WS_WQKV1), DM, 32 * (r % 96), scr, C.lane); continue; } r -= 1536;
        tr_item(p.fox_w_o, DM, 64 * (r >> 5), 32 * (r & 31), (bf16*)(p.ws + WS_WO1), DM, 32 * (r & 31), scr, C.lane); }
    convert_experts(p, C, 0, 0, gw, NGW);
    bf16* XH = (bf16*)(p.ws + WS_XH);
    for (int m = gw; m < NRP; m += NGW) {
        GAS unsigned long long* o8 = (GAS unsigned long long*)(XH + (size_t)m * DM) + C.lane;
        if (m < NR) { const GAS f32x4* xr = (const GAS f32x4*)(m < NREAL ? p.x + (size_t)m * DM : p.meta + (size_t)(m - NREAL) * DM) + C.lane;
#pragma unroll
            for (int j = 0; j < 4; ++j) { const f32x4 v = xr[64 * j]; o8[64 * j] = (unsigned long long)pk2(v.x, v.y) | ((unsigned long long)pk2(v.z, v.w) << 32); } }
        else {
#pragma unroll
            for (int j = 0; j < 4; ++j) o8[64 * j] = 0ull; } }
    { const int gt = C.vcu * (NWAVES * 64) + C.tid;
      if (gt < 16 * 128) { const int m = gt >> 7, d = gt & 127; int bk = d;
          if (d >= 16) { bk = 16 + (d >= 19) + (d >= 21) + (d >= 24) + (d >= 27) + (d >= 31) + (d >= 35) + (d >= 40) + (d >= 46) + (d >= 52) + (d >= 59) + (d >= 67) + (d >= 77) + (d >= 87) + (d >= 99) + (d >= 113); }
          ((float*)(p.ws + WS_TAB))[gt] = (p.rel_bias[bk * 16 + m] - p.rel_bias[31 * 16 + m]) * LOG2E; } }
}

__device__ __forceinline__ float diff_lambda_full(const Params& p, int lane) {
    const float a = p.lam[lane] * p.lam[64 + lane], b = p.lam[128 + lane] * p.lam[192 + lane];
    return __expf(wave_sum(a, lane)) - __expf(wave_sum(b, lane)) + LAMBDA_INIT0;
}
__device__ __forceinline__ void combine_rows(const Params& p, const Ctx& C, int b, int h, int qb, float lam) {
    const int lane = C.lane;
    const bf16* O0 = (const bf16*)(p.ws + WS_O0); const bf16* O1 = (const bf16*)p.out; bf16* OA = (bf16*)(p.ws + WS_Q);
    float sw[8];
#pragma unroll
    for (int c = 0; c < 8; ++c) sw[c] = p.subln[8 * (lane & 15) + c] * (1.f - LAMBDA_INIT0);
    asm volatile("s_waitcnt vmcnt(0)" ::: "memory");
#pragma unroll 2
    for (int i = 0; i < 8; ++i) { const size_t off = (size_t)(b * SEQ + 256 * qb + 32 * C.wave + 4 * i + (lane >> 4)) * DM + h * 128 + 8 * (lane & 15);
        const v4u a = *(const GAS v4u*)(O0 + off), bq = *(const GAS v4u*)(O1 + off);
        float dd[8]; const unsigned aw[4] = {a.x, a.y, a.z, a.w}, bw[4] = {bq.x, bq.y, bq.z, bq.w}; float ss = 0.f;
#pragma unroll
        for (int c = 0; c < 4; ++c) { dd[2 * c] = bflo(aw[c]) - lam * bflo(bw[c]); dd[2 * c + 1] = bfhi(aw[c]) - lam * bfhi(bw[c]); ss += dd[2 * c] * dd[2 * c] + dd[2 * c + 1] * dd[2 * c + 1]; }
        ss += shx(ss, 1, lane); ss += shx(ss, 2, lane); ss += shx(ss, 4, lane); ss += shx(ss, 8, lane);
        const float rs = 1.f / sqrtf(ss * (1.f / 128.f) + LN_EPS);
        v4u o; o.x = pk2(dd[0] * rs * sw[0], dd[1] * rs * sw[1]); o.y = pk2(dd[2] * rs * sw[2], dd[3] * rs * sw[3]); o.z = pk2(dd[4] * rs * sw[4], dd[5] * rs * sw[5]); o.w = pk2(dd[6] * rs * sw[6], dd[7] * rs * sw[7]);
        *(GAS v4u*)(OA + off) = o; }
}
__device__ __forceinline__ void diff_meta_attn(const Params& p, const Ctx& C, float lam) {
    const int gw = C.vcu * NWAVES + C.wave, lane = C.lane; bf16* OA = (bf16*)(p.ws + WS_Q);
    if (gw < 128) { const int h = gw >> 4, j = gw & 15, kj = lane & 15, s = (lane >> 4) & 1, m = 2 * h + s;
        const bf16* Q = (const bf16*)(p.ws + WS_Q); const bf16* K = (const bf16*)(p.ws + WS_K); const bf16* V = (const bf16*)(p.ws + WS_V);
        const bf16* qp = Q + (size_t)(NREAL + j) * DM + m * 64; const bf16* kp = K + (size_t)meta_slot(kj) * DM + m * 64;
        float dot = 0.f;
#pragma unroll
        for (int c = 0; c < 8; ++c) { const v4u qa = *(const GAS v4u*)(qp + 8 * c), ka = *(const GAS v4u*)(kp + 8 * c); const unsigned qw[4] = {qa.x, qa.y, qa.z, qa.w}, kw[4] = {ka.x, ka.y, ka.z, ka.w};
#pragma unroll
            for (int e = 0; e < 4; ++e) dot += bflo(qw[e]) * bflo(kw[e]) + bfhi(qw[e]) * bfhi(kw[e]); }
        float sc = (kj <= j) ? dot + p.rel_bias[(j - kj) * 16 + m] * LOG2E : -INFINITY;
        float mx = sc; mx = fmaxf(mx, shx(mx, 1, lane)); mx = fmaxf(mx, shx(mx, 2, lane)); mx = fmaxf(mx, shx(mx, 4, lane)); mx = fmaxf(mx, shx(mx, 8, lane));
        float pe = __builtin_amdgcn_exp2f(sc - mx); float l = pe; l += shx(l, 1, lane); l += shx(l, 2, lane); l += shx(l, 4, lane); l += shx(l, 8, lane);
        pe /= l;
        const float a = pe - lam * shx(pe, 16, lane);
        float o0 = 0.f, o1 = 0.f;
        for (int k2 = 0; k2 <= j; ++k2) { const float ak = __builtin_amdgcn_readlane(a, k2); const unsigned vw = *(const GAS unsigned*)(V + (size_t)meta_slot(k2) * DM + h * 128 + 2 * lane); o0 += ak * bflo(vw); o1 += ak * bfhi(vw); }
        const float ss = wave_sum(o0 * o0 + o1 * o1, lane); const float rs = 1.f / sqrtf(ss * (1.f / 128.f) + LN_EPS);
        const float w0 = p.subln[2 * lane] * (1.f - LAMBDA_INIT0), w1 = p.subln[2 * lane + 1] * (1.f - LAMBDA_INIT0);
        *(GAS unsigned*)(OA + (size_t)(NREAL + j) * DM + h * 128 + 2 * lane) = pk2(o0 * rs * w0, o1 * rs * w1); }
}
__device__ __forceinline__ void fox_meta_attn(const Params& p, const Ctx& C) {
    const int gw = C.vcu * NWAVES + C.wave, lane = C.lane;
    if (gw < 256) { const int h = gw >> 4, j = gw & 15, kj = lane & 15;
        bf16* Q = (bf16*)(p.ws + WS_Q); const bf16* K = (const bf16*)(p.ws + WS_K); const bf16* V = (const bf16*)(p.ws + WS_V); const float* DK = (const float*)(p.ws + WS_DK) + (size_t)h * KROWS;
        const bf16* qp = Q + (size_t)(NREAL + j) * DM + h * 64; const bf16* kp = K + (size_t)meta_slot(kj) * DM + h * 64;
        float dot = 0.f;
#pragma unroll
        for (int c = 0; c < 8; ++c) { const v4u qa = *(const GAS v4u*)(qp + 8 * c), ka = *(const GAS v4u*)(kp + 8 * c); const unsigned qw[4] = {qa.x, qa.y, qa.z, qa.w}, kw[4] = {ka.x, ka.y, ka.z, ka.w};
#pragma unroll
            for (int e = 0; e < 4; ++e) dot += bflo(qw[e]) * bflo(kw[e]) + bfhi(qw[e]) * bfhi(kw[e]); }
        float sc = (kj <= j) ? dot + DK[meta_slot(kj)] - DK[meta_slot(j)] : -INFINITY;
        float mx = sc; mx = fmaxf(mx, shx(mx, 1, lane)); mx = fmaxf(mx, shx(mx, 2, lane)); mx = fmaxf(mx, shx(mx, 4, lane)); mx = fmaxf(mx, shx(mx, 8, lane));
        float pe = __builtin_amdgcn_exp2f(sc - mx); float l = pe; l += shx(l, 1, lane); l += shx(l, 2, lane); l += shx(l, 4, lane); l += shx(l, 8, lane);
        pe /= l;
        float o = 0.f;
        for (int k2 = 0; k2 <= j; ++k2) { const float ak = __builtin_amdgcn_readlane(pe, k2); o += ak * bf2f(V[(size_t)meta_slot(k2) * DM + h * 64 + lane]); }
        ((bf16*)(p.ws + WS_O0))[(size_t)(NREAL + j) * DM + h * 64 + lane] = (bf16)f2bf(o); }
}

typedef float f32x4m __attribute__((ext_vector_type(4)));
template <int KIND> __device__ __forceinline__ void ln_phase(const Params& p, const Ctx& C, int layer) {
    constexpr int NCB = (KIND == 0) ? 3 : (KIND == 1 ? 1 : 0), NC = 16 * (NCB ? NCB : 1);
    constexpr int AT_PITCH = 1028;
    const int tid = C.tid, lane = C.lane, wave = C.wave;
    LAS float* At = (LAS float*)(C.lds + RING_OFF);
    LAS float* part = (LAS float*)(C.lds + RING_OFF + 65792);
    LAS float* logit = (LAS float*)(C.lds + RING_OFF + 90368);
    LAS int* sl_e = (LAS int*)(C.lds + RING_OFF + 93440);
    LAS int* cnt_l = (LAS int*)(C.lds + RING_OFF + 94720);
    const float* gsrc = (KIND == 0 ? p.ln_mix_g : p.ln_ffn_g) + layer * DM; const float* bsrc = (KIND == 0 ? p.ln_mix_b : p.ln_ffn_b) + layer * DM;
    f32x4 gv[4], bv[4];
#pragma unroll
    for (int j = 0; j < 4; ++j) { gv[j] = *(const GAS f32x4*)(gsrc + 4 * lane + 256 * j); bv[j] = *(const GAS f32x4*)(bsrc + 4 * lane + 256 * j); }
    float Bf[NCB ? NCB : 1][8][4];
    if constexpr (NCB > 0) { const int kq = lane >> 4, col = lane & 15;
#pragma unroll
        for (int cb = 0; cb < NCB; ++cb)
#pragma unroll
            for (int g = 0; g < 8; ++g)
#pragma unroll
                for (int c = 0; c < 4; ++c) { const int k = 128 * wave + 16 * g + 4 * kq + c, cc = cb * 16 + col; float w;
                    if (KIND == 0) w = cc < 4 ? p.rg_w[((size_t)layer * DM + k) * 4 + cc] : (cc < 36 ? p.re_w[((size_t)layer * DM + k) * 32 + (cc - 4)] : 0.f);
                    else w = p.fox_w_in[(size_t)k * 3088 + 3072 + cc];
                    Bf[cb][g][c] = w; } }
    if (KIND == 0) { if (tid < 96) cnt_l[tid] = 0; }
    bf16* XH = (bf16*)(p.ws + WS_XH); const bf16* Y = (const bf16*)(p.ws + WS_K);
    constexpr int NTILES = NR / 16;
    int it = 0;
    for (int tile = C.vcu; tile < NTILES; tile += C.G, ++it) {
        unsigned long long vv[2][4]; unsigned long long yy[2][2][4];
#pragma unroll
        for (int rr = 0; rr < 2; ++rr) { const int row = tile * 16 + wave * 2 + rr;
#pragma unroll
            for (int j = 0; j < 4; ++j) vv[rr][j] = *((const GAS unsigned long long*)(XH + (size_t)row * DM) + lane + 64 * j);
            if (KIND != 0) {
#pragma unroll
                for (int j = 0; j < 4; ++j) { yy[rr][0][j] = *(const GAS unsigned long long*)(Y + (size_t)(2 * row) * DM + 4 * lane + 256 * j); yy[rr][1][j] = *(const GAS unsigned long long*)(Y + (size_t)(2 * row + 1) * DM + 4 * lane + 256 * j); } } }
#pragma unroll
        for (int rr = 0; rr < 2; ++rr) { const int rl = wave * 2 + rr, row = tile * 16 + rl;
            f32x4 v[4];
#pragma unroll
            for (int j = 0; j < 4; ++j) { const unsigned h0 = (unsigned)vv[rr][j], h1 = (unsigned)(vv[rr][j] >> 32); v[j] = (f32x4){bflo(h0), bfhi(h0), bflo(h1), bfhi(h1)}; }
            if (KIND != 0) {
#pragma unroll
                for (int j = 0; j < 4; ++j) { const unsigned long long y0 = yy[rr][0][j], y1 = yy[rr][1][j];
                    const unsigned a0 = (unsigned)y0, a1 = (unsigned)(y0 >> 32), b0 = (unsigned)y1, b1 = (unsigned)(y1 >> 32);
                    v[j].x = v[j].x * ALPHA + (bflo(a0) + bflo(b0)); v[j].y = v[j].y * ALPHA + (bfhi(a0) + bfhi(b0)); v[j].z = v[j].z * ALPHA + (bflo(a1) + bflo(b1)); v[j].w = v[j].w * ALPHA + (bfhi(a1) + bfhi(b1)); } }
            float s = 0.f;
#pragma unroll
            for (int j = 0; j < 4; ++j) s += (v[j].x + v[j].y) + (v[j].z + v[j].w);
            const float mean = wave_sum(s, lane) * (1.f / DM); float s2 = 0.f;
#pragma unroll
            for (int j = 0; j < 4; ++j) { v[j] = v[j] - mean; s2 += (v[j].x * v[j].x + v[j].y * v[j].y) + (v[j].z * v[j].z + v[j].w * v[j].w); }
            const float rstd = 1.f / sqrtf(wave_sum(s2, lane) * (1.f / DM) + LN_EPS);
#pragma unroll
            for (int j = 0; j < 4; ++j) v[j] = v[j] * rstd * gv[j] + bv[j];
            if (KIND == 2) { if (row < NREAL) {
#pragma unroll
                for (int j = 0; j < 4; ++j) *(GAS f32x4*)(p.out + (size_t)row * DM + 4 * lane + 256 * j) = v[j]; } }
            else {
#pragma unroll
                for (int j = 0; j < 4; ++j) {
                    *((GAS unsigned long long*)(XH + (size_t)row * DM) + lane + 64 * j) = (unsigned long long)pk2(v[j].x, v[j].y) | ((unsigned long long)pk2(v[j].z, v[j].w) << 32);
                    *(LAS f32x4*)(At + rl * AT_PITCH + 4 * lane + 256 * j) = v[j]; } } }
        if constexpr (NCB > 0) {
            __syncthreads();
            f32x4m acc[NCB];
#pragma unroll
            for (int cb = 0; cb < NCB; ++cb) acc[cb] = (f32x4m){0.f, 0.f, 0.f, 0.f};
#pragma unroll
            for (int g = 0; g < 8; ++g) { const f32x4 a4 = *(const LAS f32x4*)(At + (lane & 15) * AT_PITCH + 128 * wave + 16 * g + 4 * (lane >> 4));
#pragma unroll
                for (int c = 0; c < 4; ++c)
#pragma unroll
                    for (int cb = 0; cb < NCB; ++cb) acc[cb] = __builtin_amdgcn_mfma_f32_16x16x4f32(a4[c], Bf[cb][g][c], acc[cb], 0, 0, 0); }
#pragma unroll
            for (int cb = 0; cb < NCB; ++cb)
#pragma unroll
                for (int r = 0; r < 4; ++r) part[(wave * 16 + 4 * (lane >> 4) + r) * 48 + cb * 16 + (lane & 15)] = acc[cb][r];
            __syncthreads();
            for (int idx = tid; idx < 16 * NC; idx += NWAVES * 64) { const int rw = idx / NC, cl = idx % NC; float sacc = 0.f;
#pragma unroll
                for (int w = 0; w < 8; ++w) sacc += part[(w * 16 + rw) * 48 + cl];
                logit[rw * 48 + cl] = sacc; }
            __syncthreads();
            if (KIND == 0) { if (tid < 16) { const int row = tile * 16 + tid; const LAS float* lg = logit + tid * 48;
                float gl[4]; int gs = 0;
#pragma unroll
                for (int i = 0; i < 4; ++i) gl[i] = lg[i] + p.rg_b[layer * 4 + i];
#pragma unroll
                for (int i = 1; i < 4; ++i) if (gl[i] > gl[gs]) gs = i;
                float den = 0.f;
#pragma unroll
                for (int i = 0; i < 4; ++i) den += __expf(gl[i] - gl[gs]);
                const float pg = 1.f / den;
                float el[8];
#pragma unroll
                for (int i = 0; i < 8; ++i) el[i] = lg[4 + gs * 8 + i] + p.re_b[layer * 32 + gs * 8 + i];
                int i0 = 0;
#pragma unroll
                for (int i = 1; i < 8; ++i) if (el[i] > el[i0]) i0 = i;
                int i1 = (i0 == 0) ? 1 : 0;
#pragma unroll
                for (int i = 0; i < 8; ++i) if (i != i0 && el[i] > el[i1]) i1 = i;
                const float ex = __expf(el[i1] - el[i0]); const float w0 = 1.f / (1.f + ex), w1 = ex * w0;
                float* GVp = (float*)(p.ws + WS_GV); GVp[2 * row] = pg * w0; GVp[2 * row + 1] = pg * w1;
                sl_e[it * 32 + 2 * tid] = gs * 8 + i0; sl_e[it * 32 + 2 * tid + 1] = gs * 8 + i1; } }
            else { if (tid < 256) { const int rw = tid >> 4, hh = tid & 15; const float vv = logit[rw * 48 + hh] + p.fox_b_f[hh];
                ((float*)(p.ws + WS_LF))[(size_t)(tile * 16 + rw) * 16 + hh] = fminf(vv, 0.f) - __builtin_amdgcn_logf(1.f + __builtin_amdgcn_exp2f(-fabsf(vv) * LOG2E)) * 0.69314718056f;   } }
        }
    }
    if (KIND == 0) {
        gu32* CNT = (gu32*)(p.ws + WS_CTL) + CW_CNT + layer * 2048; int* LIST = (int*)(p.ws + WS_LIST);
        __syncthreads();
        const int nloc = it * 32;
        for (int s = tid; s < nloc; s += NWAVES * 64) atomicAdd((int*)&cnt_l[sl_e[s]], 1);
        __syncthreads();
        if (tid < 32) { const int n = cnt_l[tid]; cnt_l[32 + tid] = n > 0 ? (int)__hip_atomic_fetch_add(CNT + 64 * tid, (unsigned)n, RLX_AGENT) : 0; cnt_l[64 + tid] = 0; }
        __syncthreads();
        for (int s = tid; s < nloc; s += NWAVES * 64) { const int e = sl_e[s]; const int pos = cnt_l[32 + e] + atomicAdd((int*)&cnt_l[64 + e], 1);
            const int tl = C.vcu + (s >> 5) * C.G; LIST[(size_t)e * LCAP + pos] = 2 * (tl * 16 + ((s & 31) >> 1)) + (s & 1); }
    }
    __syncthreads();
}

__device__ __forceinline__ void cumsum_job(const Params& p, const Ctx& C) {
    if (C.vcu >= 64) return;
    const int b = C.vcu >> 4, h = C.vcu & 15, tid = C.tid, lane = C.lane, wave = C.wave;
    const float* LF = (const float*)(p.ws + WS_LF); float* DK = (float*)(p.ws + WS_DK) + (size_t)(b * 16 + h) * KROWS;
    LAS float* wt = (LAS float*)(C.lds + RING_OFF);
    float cm = 0.f, mine = 0.f; const int myj = (tid < NMETA) ? tid : -1;
    for (int i = 0; i < NMETA; ++i) { cm += LF[(size_t)(NREAL + i) * 16 + h]; if (i == myj) mine = cm; }
    if (tid < KPRE) DK[tid] = (myj >= 0) ? -mine * LOG2E : 0.f;
    if (tid < 64) DK[KPRE + SEQ + tid] = 0.f;
    const float* lp = LF + (size_t)(b * SEQ + tid * 16) * 16 + h;
    float run = 0.f;
#pragma unroll 1
    for (int i = 0; i < 16; ++i) run += lp[i * 16];
    float inc = run;
#pragma unroll
    for (int o = 1; o < 64; o <<= 1) { const float t = __uint_as_float((unsigned)__builtin_amdgcn_ds_bpermute((lane - o) << 2, (int)__float_as_uint(inc))); if (lane >= o) inc += t; }
    if (lane == 63) wt[wave] = inc;
    __syncthreads();
    float base = cm;
    for (int w = 0; w < wave; ++w) base += wt[w];
    base += inc - run;
#pragma unroll 1
    for (int i = 0; i < 16; ++i) { base += lp[i * 16]; DK[KPRE + tid * 16 + i] = -base * LOG2E; }
    __syncthreads();
}

template <int KIND> __device__ __forceinline__ void meta_proj(const Params& p, const Ctx& C, const bf16* A, const bf16* Wt, int ntasks, unsigned* km) {
    if (C.wave != 0 || C.vcu >= ntasks) return;
    typedef float f32x4m_ __attribute__((ext_vector_type(4)));
    const int lane = C.lane, j = lane & 15, kq = lane >> 4, c0 = 16 * C.vcu;
    const GAS v4u* ap = (const GAS v4u*)(A + (size_t)(NREAL + j) * DM + 8 * kq); const GAS v4u* bp = (const GAS v4u*)(Wt + (size_t)(c0 + j) * DM + 8 * kq);
    f32x4m_ acc = {0.f, 0.f, 0.f, 0.f};
#pragma unroll 8
    for (int ks = 0; ks < 32; ++ks) { const v4u a = ap[4 * ks], b = bp[4 * ks];
        acc = __builtin_amdgcn_mfma_f32_16x16x32_bf16(__builtin_bit_cast(bf16x8, a), __builtin_bit_cast(bf16x8, b), acc, 0, 0, 0); }
    const int c = c0 + j;
    if (KIND == 0) { const int t = c >> 10, cc = c & 1023; bf16* Qb = (bf16*)(p.ws + WS_Q); bf16* kvb = (bf16*)(p.ws + (t == 1 ? WS_K : WS_V));
#pragma unroll
        for (int r = 0; r < 4; ++r) { const int i = 4 * kq + r; if (t == 0) Qb[(size_t)(NREAL + i) * DM + cc] = (bf16)f2bf(acc[r] * attn_body::C2); else kvb[(size_t)i * DM + cc] = (bf16)f2bf(acc[r]); }
        if (km != nullptr && t == 1) {
#pragma unroll
            for (int r = 0; r < 4; ++r) { float ss = acc[r] * acc[r]; ss += shx(ss, 1, lane); ss += shx(ss, 2, lane); ss += shx(ss, 4, lane); ss += shx(ss, 8, lane);
                float mx = ss; mx = fmaxf(mx, shx(mx, 16, lane)); mx = fmaxf(mx, shx(mx, 32, lane));
                acc[r] = mx; }
            const float m4 = fmaxf(fmaxf(acc[0], acc[1]), fmaxf(acc[2], acc[3]));
            if (lane == 0) { const int head = cc >> 6, quarter = (cc >> 4) & 3;
                for (int b = 0; b < NBATCH; ++b) atomicMax(km + ((size_t)b * 16 + head) * 8 + 2 + quarter, __float_as_uint(m4)); } } }
    else { bf16* H = (bf16*)(p.ws + WS_XH);
#pragma unroll
        for (int r = 0; r < 4; ++r) { const size_t o = (size_t)(NREAL + 4 * kq + r) * DM + c; H[o] = (bf16)f2bf(acc[r] + ALPHA * bf2f(H[o])); } }
}

struct MoeOrder {
    int G, c, UT; const LAS int* pre; const char* A; const char* W; size_t wexp, tsB;
    __device__ __forceinline__ bool next(int i, pg8::Unit& u) const {
        const int g = i * G + c; if (g >= UT || i >= ROWTAB_UNITS) return false;
        const int rt = g >> 2; int e = 0; while (pre[e + 1] <= rt) ++e;
        u.pm = rt - pre[e]; u.pn = g & 3; u.A = A; u.B = W + (size_t)e * wexp + (size_t)u.pn * tsB; u.tab = i; u.e = e; return true;
    }
};
__device__ __forceinline__ int moe_setup(const Params& p, const Ctx& C, int layer, MoeOrder& S) {
    LAS int* pre = (LAS int*)(C.lds + MOEPRE_OFF); LAS int* cnts = pre + 40; LAS int* rowtab = (LAS int*)(C.lds + ROWTAB_OFF);
    const gu32* CNT = (const gu32*)(p.ws + WS_CTL) + CW_CNT + layer * 2048;
    if (C.tid < 32) cnts[C.tid] = (int)__hip_atomic_load(CNT + 64 * C.tid, RLX_AGENT);
    __syncthreads();
    if (C.tid == 0) { int a = 0; for (int e = 0; e < NEXP; ++e) { pre[e] = a; a += (cnts[e] + 255) >> 8; } pre[NEXP] = a; }
    __syncthreads();
    S.pre = pre; S.UT = 4 * pre[NEXP];
    const int* LIST = (const int*)(p.ws + WS_LIST);
    pg8::Unit u;
    for (int i = 0; S.next(i, u); ++i) { if (C.tid < 256) { const int idx = 256 * u.pm + C.tid; rowtab[i * 256 + C.tid] = idx < cnts[u.e] ? LIST[(size_t)u.e * LCAP + idx] : -1; } }
    __syncthreads();
    return S.UT;
}

__global__ void __launch_bounds__(NWAVES * 64, 2) trunk_fwd(Params p) {
    extern __shared__ __attribute__((aligned(16))) unsigned char lds[];
    Ctx C;
    C.lds = (LAS unsigned char*)lds; C.tid = threadIdx.x; C.lane = C.tid & 63; C.wave = __builtin_amdgcn_readfirstlane(C.tid >> 6);
    C.G = gridDim.x; { const int bx = blockIdx.x; C.vcu = (C.G % 8 == 0) ? (bx % 8) * (C.G / 8) + bx / 8 : bx; }
    volatile LAS unsigned* MISC = (volatile LAS unsigned*)(C.lds + MISC_OFF);
    gu32* ctl = (gu32*)(p.ws + WS_CTL);
    if (C.tid < 32) MISC[C.tid] = 0u;
    __syncthreads();
    XcdBarrier bar; bar.bar = (unsigned*)(ctl + CW_BAR) + p.li * XCD_BAR_WORDS; bar.x = 0; bar.st = nullptr;
    if (!MK_PER_PHASE) bar = xcd_barrier_post((unsigned*)(ctl + CW_BAR) + p.li * XCD_BAR_WORDS, MISC + 8);
#define GRID_BAR() do { if (MK_PER_PHASE) { if (C.tid == 0) __hip_atomic_store(ctl + CW_TMO, 0xBADBA0u, RLX_AGENT); } else { xcd_barrier(bar); } } while (0)
    const int lo = p.ph_lo, hi = p.ph_hi;
#ifndef SUBMASK
#define SUBMASK 0x7f
#endif
#ifndef REP_MASK
#define REP_MASK 0
#endif
#define NREP(k) (((REP_MASK >> (k)) & 1) ? 2 : 1)
#ifndef PHASE_MASK
#define PHASE_MASK 0xffff
#endif
#define IN(k) (((PHASE_MASK >> (k)) & 1) && lo <= (k) && (k) < hi)
#define SEAM(k) do { if (IN(k) && IN((k) + 1)) GRID_BAR(); } while (0)
    bf16* XH = (bf16*)(p.ws + WS_XH); bf16* QB = (bf16*)(p.ws + WS_Q); bf16* KB = (bf16*)(p.ws + WS_K); bf16* VB = (bf16*)(p.ws + WS_V);
    bf16* O0 = (bf16*)(p.ws + WS_O0); bf16* O1 = (bf16*)p.out;
    const LAS int* rowtab = (const LAS int*)(C.lds + ROWTAB_OFF);

    if (IN(0)) { for (int rep_ = 0; rep_ < NREP(0); ++rep_) p0_prologue(p, fresh(C)); } SEAM(0);

    { constexpr int layer = 0;
        const int pb = 1 + (layer ? 8 : 0);
        if ((SUBMASK & 1) && IN(pb)) { for (int rep_ = 0; rep_ < NREP(pb); ++rep_) {
            if (layer == 1) cumsum_job(p, fresh(C));
            meta_proj<0>(p, fresh(C), XH, (const bf16*)(p.ws + (layer ? WS_WQKV1 : WS_WQKV0)), 3 * DM / 16, layer ? (unsigned*)(ctl + CW_KM) : nullptr);
            pg8::StaticOrder S; S.init(NREAL, 3 * DM, C.G, (int)blockIdx.x, XH, DM * 2, p.ws + (layer ? WS_WQKV1 : WS_WQKV0), DM * 2);
            pg8::EpiQKV E{QB, KB, VB, attn_body::C2, layer ? (unsigned*)(ctl + CW_QM) : nullptr, (unsigned*)(ctl + CW_KM)};
            pg8::gemm_phase<pg8::EpiQKV, pg8::StaticOrder, true, false>(C.lds + RING_OFF, DM, DM * 2, S, E, rowtab, 0);
        } } SEAM(pb);
        if (layer == 0) {
            if (IN(2)) { for (int rep_ = 0; rep_ < NREP(2); ++rep_) {
                const float* TAB = (const float*)(p.ws + WS_TAB);
                const float lam = diff_lambda_full(p, fresh(C).lane);
                for (int it = C.vcu; it < NBATCH * 8 * 16; it += C.G) { const int bh = it >> 4, s = it & 15, b = bh >> 3, h = bh & 7;
#pragma unroll 1
                    for (int w = 0; w < 2; ++w) { const int qb = w ? s : 31 - s;
#pragma unroll 1
                        for (int mm = 0; mm < 2; ++mm) attn_body::attn_unit_dv<8>(b, qb, (2 * h + mm) * 64, h * 128, h * 128, (const attn_body::bf16*)QB, (const attn_body::bf16*)KB, (const attn_body::bf16*)VB, (attn_body::bf16*)(mm ? O1 : O0), TAB + (2 * h + mm) * 128, (char*)lds + RING_OFF);
                        combine_rows(p, fresh(C), b, h, qb, lam); } }
                diff_meta_attn(p, fresh(C), lam);
            } } SEAM(2);
        } else {
            if (IN(10)) { for (int rep_ = 0; rep_ < NREP(10); ++rep_) {
                const float* DK = (const float*)(p.ws + WS_DK);
                for (;;) {
                    const int lane_ = fresh(C).lane;
                    int tko = MOEPRE_OFF; asm volatile("" : "+s"(tko)); LAS int* tk = (LAS int*)(C.lds + tko);
                    if (fresh(C).tid == 0) tk[0] = (int)__hip_atomic_fetch_add(ctl + CW_QCTR + 64 * rep_, 1u, RLX_AGENT);
                    __syncthreads(); const int u = tk[0]; __syncthreads();
                    if (u >= NBATCH * 16 * 32) break;
                    const int qb = 31 - (u >> 6), bh = u & 63, b = bh >> 4, h = bh & 15;
                    const float* dk = DK + (size_t)bh * KROWS;
                    const unsigned qmb = lane_ < 8 ? __hip_atomic_load(ctl + CW_QM + ((size_t)(b * 32 + qb) * 16 + h) * 8 + lane_, RLX_AGENT) : 0u;
                    const unsigned kmb = lane_ < 8 ? __hip_atomic_load(ctl + CW_KM + ((size_t)bh) * 8 + lane_, RLX_AGENT) : 0u;
                    const int ntf = 4 * qb + 6;
                    float e0 = lane_ < ntf ? dk[lane_ == 0 ? NMETA - 1 : 64 * lane_ + 63] : 0.f, e1 = lane_ + 64 < ntf ? dk[64 * (lane_ + 64) + 63] : 0.f, e2 = lane_ + 128 < ntf ? dk[64 * (lane_ + 128) + 63] : 0.f;
                    const float q2 = wave_sum(__uint_as_float(qmb), lane_), k2 = fmaxf(wave_sum(lane_ < 2 ? __uint_as_float(kmb) : 0.f, lane_), wave_sum(lane_ >= 2 ? __uint_as_float(kmb) : 0.f, lane_));
                    const float thr = dk[KPRE + 256 * qb] - 40.f - 2.1f * sqrtf(q2 * k2);
                    const unsigned long long m0 = __ballot(lane_ < ntf && e0 >= thr), m1 = __ballot(lane_ + 64 < ntf && e1 >= thr), m2 = __ballot(lane_ + 128 < ntf && e2 >= thr);
                    int tb = m0 ? __builtin_ctzll(m0) : (m1 ? 64 + __builtin_ctzll(m1) : (m2 ? 128 + __builtin_ctzll(m2) : ntf - 6));
                    tb &= ~1; tb = tb > ntf - 6 ? ntf - 6 : tb; tb = __builtin_amdgcn_readfirstlane(tb);
                    attn_body::attn_unit<1, 8>(b, qb, tb, h * 64, h * 64, h * 64, (const attn_body::bf16*)QB, (const attn_body::bf16*)KB, (const attn_body::bf16*)VB, (attn_body::bf16*)O0, dk, (char*)lds + RING_OFF);
                }
                fox_meta_attn(p, fresh(C));
            } } SEAM(10);
        }
        const int pw = layer ? 11 : 4;
        if ((SUBMASK & 4) && IN(pw)) { for (int rep_ = 0; rep_ < NREP(pw); ++rep_) {
            meta_proj<1>(p, fresh(C), layer ? O0 : QB, (const bf16*)(p.ws + (layer ? WS_WO1 : WS_WO0)), DM / 16, nullptr);
            pg8::StaticOrder S; S.init(NREAL, DM, C.G, (int)blockIdx.x, layer ? O0 : QB, DM * 2, p.ws + (layer ? WS_WO1 : WS_WO0), DM * 2);
            pg8::EpiZ E{XH};
            pg8::gemm_phase<pg8::EpiZ, pg8::StaticOrder, true, false>(C.lds + RING_OFF, DM, DM * 2, S, E, rowtab, 0);
        } } SEAM(pw);
        if ((SUBMASK & 8) && IN(pw + 1)) { ln_phase<0>(p, fresh(C), layer); } SEAM(pw + 1);
        if ((SUBMASK & 16) && IN(pw + 2)) { for (int rep_ = 0; rep_ < NREP(pw + 2); ++rep_) {
            MoeOrder S; S.G = C.G; S.c = (int)blockIdx.x; S.A = (const char*)XH; S.W = (const char*)(p.ws + WS_WGU); S.wexp = (size_t)DM * DM * 2; S.tsB = (size_t)256 * DM * 2;
            moe_setup(p, fresh(C), layer, S);
            pg8::EpiGU E{(pg8::bf16_t*)O0};
            pg8::gemm_phase<pg8::EpiGU, MoeOrder, true, true>(C.lds + RING_OFF, DM, DM * 2, S, E, rowtab, 1);
        } } SEAM(pw + 2);
        if ((SUBMASK & 32) && IN(pw + 3)) { for (int rep_ = 0; rep_ < NREP(pw + 3); ++rep_) {
            MoeOrder S; S.G = C.G; S.c = (int)blockIdx.x; S.A = (const char*)O0; S.W = (const char*)(p.ws + WS_WD); S.wexp = (size_t)DM * DEXP * 2; S.tsB = (size_t)256 * DEXP * 2;
            moe_setup(p, fresh(C), layer, S);
            pg8::EpiDown E{(pg8::bf16_t*)KB, (const float*)(p.ws + WS_GV)};
            pg8::gemm_phase<pg8::EpiDown, MoeOrder, true, true>(C.lds + RING_OFF, DEXP, DEXP * 2, S, E, rowtab, 0);
        } } SEAM(pw + 3);
        if ((SUBMASK & 64) && IN(pw + 4)) {
            if (layer == 0) { ln_phase<1>(p, fresh(C), 0); { const Ctx Cf = fresh(C); convert_experts(p, Cf, 1, 0, Cf.vcu * NWAVES + Cf.wave, Cf.G * NWAVES); } }
            else ln_phase<2>(p, fresh(C), 1);
        }
        if (layer == 0) SEAM(8);
        }
    { constexpr int layer = 1;
        const int pb = 1 + (layer ? 8 : 0);
        if ((SUBMASK & 1) && IN(pb)) { for (int rep_ = 0; rep_ < NREP(pb); ++rep_) {
            if (layer == 1) cumsum_job(p, fresh(C));
            meta_proj<0>(p, fresh(C), XH, (const bf16*)(p.ws + (layer ? WS_WQKV1 : WS_WQKV0)), 3 * DM / 16, layer ? (unsigned*)(ctl + CW_KM) : nullptr);
            pg8::StaticOrder S; S.init(NREAL, 3 * DM, C.G, (int)blockIdx.x, XH, DM * 2, p.ws + (layer ? WS_WQKV1 : WS_WQKV0), DM * 2);
            pg8::EpiQKV E{QB, KB, VB, attn_body::C2, layer ? (unsigned*)(ctl + CW_QM) : nullptr, (unsigned*)(ctl + CW_KM)};
            pg8::gemm_phase<pg8::EpiQKV, pg8::StaticOrder, true, false>(C.lds + RING_OFF, DM, DM * 2, S, E, rowtab, 0);
        } } SEAM(pb);
        if (layer == 0) {
            if (IN(2)) { for (int rep_ = 0; rep_ < NREP(2); ++rep_) {
                const float* TAB = (const float*)(p.ws + WS_TAB);
                const float lam = diff_lambda_full(p, fresh(C).lane);
                for (int it = C.vcu; it < NBATCH * 8 * 16; it += C.G) { const int bh = it >> 4, s = it & 15, b = bh >> 3, h = bh & 7;
#pragma unroll 1
                    for (int w = 0; w < 2; ++w) { const int qb = w ? s : 31 - s;
#pragma unroll 1
                        for (int mm = 0; mm < 2; ++mm) attn_body::attn_unit_dv<8>(b, qb, (2 * h + mm) * 64, h * 128, h * 128, (const attn_body::bf16*)QB, (const attn_body::bf16*)KB, (const attn_body::bf16*)VB, (attn_body::bf16*)(mm ? O1 : O0), TAB + (2 * h + mm) * 128, (char*)lds + RING_OFF);
                        combine_rows(p, fresh(C), b, h, qb, lam); } }
                diff_meta_attn(p, fresh(C), lam);
            } } SEAM(2);
        } else {
            if (IN(10)) { for (int rep_ = 0; rep_ < NREP(10); ++rep_) {
                const float* DK = (const float*)(p.ws + WS_DK);
                for (;;) {
                    const int lane_ = fresh(C).lane;
                    int tko = MOEPRE_OFF; asm volatile("" : "+s"(tko)); LAS int* tk = (LAS int*)(C.lds + tko);
                    if (fresh(C).tid == 0) tk[0] = (int)__hip_atomic_fetch_add(ctl + CW_QCTR + 64 * rep_, 1u, RLX_AGENT);
                    __syncthreads(); const int u = tk[0]; __syncthreads();
                    if (u >= NBATCH * 16 * 32) break;
                    const int qb = 31 - (u >> 6), bh = u & 63, b = bh >> 4, h = bh & 15;
                    const float* dk = DK + (size_t)bh * KROWS;
                    const unsigned qmb = lane_ < 8 ? __hip_atomic_load(ctl + CW_QM + ((size_t)(b * 32 + qb) * 16 + h) * 8 + lane_, RLX_AGENT) : 0u;
                    const unsigned kmb = lane_ < 8 ? __hip_atomic_load(ctl + CW_KM + ((size_t)bh) * 8 + lane_, RLX_AGENT) : 0u;
                    const int ntf = 4 * qb + 6;
                    float e0 = lane_ < ntf ? dk[lane_ == 0 ? NMETA - 1 : 64 * lane_ + 63] : 0.f, e1 = lane_ + 64 < ntf ? dk[64 * (lane_ + 64) + 63] : 0.f, e2 = lane_ + 128 < ntf ? dk[64 * (lane_ + 128) + 63] : 0.f;
                    const float q2 = wave_sum(__uint_as_float(qmb), lane_), k2 = fmaxf(wave_sum(lane_ < 2 ? __uint_as_float(kmb) : 0.f, lane_), wave_sum(lane_ >= 2 ? __uint_as_float(kmb) : 0.f, lane_));
                    const float thr = dk[KPRE + 256 * qb] - 40.f - 2.1f * sqrtf(q2 * k2);
                    const unsigned long long m0 = __ballot(lane_ < ntf && e0 >= thr), m1 = __ballot(lane_ + 64 < ntf && e1 >= thr), m2 = __ballot(lane_ + 128 < ntf && e2 >= thr);
                    int tb = m0 ? __builtin_ctzll(m0) : (m1 ? 64 + __builtin_ctzll(m1) : (m2 ? 128 + __builtin_ctzll(m2) : ntf - 6));
                    tb &= ~1; tb = tb > ntf - 6 ? ntf - 6 : tb; tb = __builtin_amdgcn_readfirstlane(tb);
                    attn_body::attn_unit<1, 8>(b, qb, tb, h * 64, h * 64, h * 64, (const attn_body::bf16*)QB, (const attn_body::bf16*)KB, (const attn_body::bf16*)VB, (attn_body::bf16*)O0, dk, (char*)lds + RING_OFF);
                }
                fox_meta_attn(p, fresh(C));
            } } SEAM(10);
        }
        const int pw = layer ? 11 : 4;
        if ((SUBMASK & 4) && IN(pw)) { for (int rep_ = 0; rep_ < NREP(pw); ++rep_) {
            meta_proj<1>(p, fresh(C), layer ? O0 : QB, (const bf16*)(p.ws + (layer ? WS_WO1 : WS_WO0)), DM / 16, nullptr);
            pg8::StaticOrder S; S.init(NREAL, DM, C.G, (int)blockIdx.x, layer ? O0 : QB, DM * 2, p.ws + (layer ? WS_WO1 : WS_WO0), DM * 2);
            pg8::EpiZ E{XH};
            pg8::gemm_phase<pg8::EpiZ, pg8::StaticOrder, true, false>(C.lds + RING_OFF, DM, DM * 2, S, E, rowtab, 0);
        } } SEAM(pw);
        if ((SUBMASK & 8) && IN(pw + 1)) { ln_phase<0>(p, fresh(C), layer); } SEAM(pw + 1);
        if ((SUBMASK & 16) && IN(pw + 2)) { for (int rep_ = 0; rep_ < NREP(pw + 2); ++rep_) {
            MoeOrder S; S.G = C.G; S.c = (int)blockIdx.x; S.A = (const char*)XH; S.W = (const char*)(p.ws + WS_WGU); S.wexp = (size_t)DM * DM * 2; S.tsB = (size_t)256 * DM * 2;
            moe_setup(p, fresh(C), layer, S);
            pg8::EpiGU E{(pg8::bf16_t*)O0};
            pg8::gemm_phase<pg8::EpiGU, MoeOrder, true, true>(C.lds + RING_OFF, DM, DM * 2, S, E, rowtab, 1);
        } } SEAM(pw + 2);
        if ((SUBMASK & 32) && IN(pw + 3)) { for (int rep_ = 0; rep_ < NREP(pw + 3); ++rep_) {
            MoeOrder S; S.G = C.G; S.c = (int)blockIdx.x; S.A = (const char*)O0; S.W = (const char*)(p.ws + WS_WD); S.wexp = (size_t)DM * DEXP * 2; S.tsB = (size_t)256 * DEXP * 2;
            moe_setup(p, fresh(C), layer, S);
            pg8::EpiDown E{(pg8::bf16_t*)KB, (const float*)(p.ws + WS_GV)};
            pg8::gemm_phase<pg8::EpiDown, MoeOrder, true, true>(C.lds + RING_OFF, DEXP, DEXP * 2, S, E, rowtab, 0);
        } } SEAM(pw + 3);
        if ((SUBMASK & 64) && IN(pw + 4)) {
            if (layer == 0) { ln_phase<1>(p, fresh(C), 0); { const Ctx Cf = fresh(C); convert_experts(p, Cf, 1, 0, Cf.vcu * NWAVES + Cf.wave, Cf.G * NWAVES); } }
            else ln_phase<2>(p, fresh(C), 1);
        }
        if (layer == 0) SEAM(8);
        }
#undef IN
#undef SEAM
#undef GRID_BAR
}

extern "C" void kernel_launch(void* const* d_in, const int* in_sizes, int n_in, void* d_out, int out_size, void* d_ws, size_t ws_size, hipStream_t stream) {
    static int grid = 0;
    if (grid == 0) {
        if (n_in != 21 || in_sizes[0] != NREAL * DM || out_size != NREAL * DM || ws_size < WS_END) { fprintf(stderr, "kernel_launch: unexpected shapes (n_in %d, in0 %d, out %d, ws %zu); nothing launched\n", n_in, n_in > 0 ? in_sizes[0] : -1, out_size, ws_size); grid = -1; return; }
        int dev = 0, cus = 0, per_cu = 0;
        if (hipGetDevice(&dev) != hipSuccess || hipDeviceGetAttribute(&cus, hipDeviceAttributeMultiprocessorCount, dev) != hipSuccess) { fprintf(stderr, "kernel_launch: device query failed\n"); grid = -1; return; }
        if (hipFuncSetAttribute((const void*)trunk_fwd, hipFuncAttributeMaxDynamicSharedMemorySize, LDS_BYTES) != hipSuccess) { fprintf(stderr, "kernel_launch: hipFuncSetAttribute failed\n"); grid = -1; return; }
        if (hipOccupancyMaxActiveBlocksPerMultiprocessor(&per_cu, (const void*)trunk_fwd, NWAVES * 64, LDS_BYTES) != hipSuccess || per_cu < 1) { fprintf(stderr, "kernel_launch: occupancy query reports %d workgroups per CU\n", per_cu); }
        (void)hipGetLastError();
        grid = cus;
    }
    if (grid < 0) return;
    if (hipMemsetAsync((char*)d_ws + WS_CTL, 0, CTL_ZERO_BYTES, stream) != hipSuccess) { fprintf(stderr, "kernel_launch: hipMemsetAsync failed\n"); return; }
    Params a{};
    const float** dst = (const float**)&a.x;
    for (int i = 0; i < 21; ++i) dst[i] = (const float*)d_in[i];
    a.out = (float*)d_out; a.ws = (unsigned char*)d_ws;
#if MK_PER_PHASE
    for (int k = 0; k < N_PHASES; ++k) { a.ph_lo = k; a.ph_hi = k + 1; a.li = 0; hipLaunchKernelGGL(trunk_fwd, dim3(grid), dim3(NWAVES * 64), LDS_BYTES, stream, a); }
#else
    a.ph_lo = 0; a.ph_hi = N_PHASES; a.li = 0;
    hipLaunchKernelGGL(trunk_fwd, dim3(grid), dim3(NWAVES * 64), LDS_BYTES, stream, a);
#endif
    const hipError_t le = hipPeekAtLastError();
    if (le != hipSuccess) fprintf(stderr, "kernel_launch: launch failed: %s\n", hipGetErrorName(le));
}
```

```cpp
#include <hip/hip_runtime.h>
#include <hip/hip_bf16.h>
#include <cstdio>
#include <cstdint>
#include <cmath>

constexpr int DM = 1024, NBATCH = 4, SEQ = 8192, NMETA = 16;
constexpr int NREAL = NBATCH * SEQ;
constexpr int NR = NREAL + NMETA;
constexpr int NRP = 129 * 256;
constexpr int KPRE = 64;
constexpr int KROWS = KPRE + SEQ + 64;
constexpr int NSLOT = 2 * NR;
constexpr int NEXP = 32, DEXP = 512;
constexpr float ALPHA = 1.41421356237309515f;
constexpr float LN_EPS = 1e-5f;
constexpr float LOG2E = 1.4426950408889634f;
constexpr float LAMBDA_INIT0 = 0.2f;

namespace pg8 {
#define PG8_LAS __attribute__((address_space(3)))
typedef unsigned short bf16_t;
typedef short bf16x8 __attribute__((ext_vector_type(8)));
typedef float f32x4 __attribute__((ext_vector_type(4)));
typedef unsigned u32x4 __attribute__((ext_vector_type(4)));
constexpr int BM = 256, BK = 64, HALF = 128, HTB = HALF * BK * 2  , STAGE_BYTES = 8 * HTB, NXCD = 8, WGM = 8;

__host__ __device__ __forceinline__ int lds_byte(int r, int c) { const int st = (r >> 4) * 2 + (c >> 5), rr = r & 15, cc = c & 31, ob = rr * 64 + cc * 2; return st * 1024 + (ob ^ (((ob >> 9) & 1) << 5)); }
__host__ __device__ __forceinline__ void stage_rc(int b, int& R, int& C) { const int st = b / 1024, sb = b % 1024, swz = sb ^ (((sb >> 9) & 1) << 5); R = (st >> 1) * 16 + swz / 64; C = (st & 1) * 32 + (swz % 64) / 2; }
__host__ __device__ __forceinline__ int perm32(int rho) { const int n = rho >> 4, i = rho & 15; return 8 * (i >> 2) + 4 * n + (i & 3); }

struct Unit { int pm, pn; const char* A; const char* B; int tab; int e; };

struct StaticOrder {
    int nM, nN, nwg, G, c; const char* A; const char* B; size_t tsA, tsB;
    __device__ void init(int M, int N, int G_, int c_, const void* A_, size_t lda_bytes, const void* B_, size_t ldb_bytes) { nM = M / BM; nN = N / BM; nwg = nM * nN; G = G_; c = c_; A = (const char*)A_; B = (const char*)B_; tsA = lda_bytes * BM; tsB = ldb_bytes * BM; }
    __device__ bool next(int i, Unit& u) const {
        const long L = (long)i * G + c; if (L >= nwg) return false;
        int wgid = (int)L; { const int q = nwg / NXCD, r = nwg % NXCD, xcd = wgid % NXCD, off = wgid / NXCD; wgid = (xcd < r ? xcd * (q + 1) : r * (q + 1) + (xcd - r) * q) + off; }
        const int nig = WGM * nN, gid = wgid / nig, fm = gid * WGM, gsz = (nM - fm) < WGM ? (nM - fm) : WGM;
        u.pm = fm + ((wgid % nig) % gsz); u.pn = (wgid % nig) / gsz; u.A = A + (size_t)u.pm * tsA; u.B = B + (size_t)u.pn * tsB; u.tab = 0; u.e = 0; return true;
    }
};

__device__ __forceinline__ float shx(float v, int m, int lane) { return __uint_as_float((unsigned)__builtin_amdgcn_ds_bpermute((lane ^ m) << 2, (int)__float_as_uint(v))); }
__device__ __forceinline__ unsigned cvt_pk_bf16(float lo, float hi) { unsigned r; asm volatile("v_cvt_pk_bf16_f32 %0, %1, %2" : "=v"(r) : "v"(lo), "v"(hi)); return r; }

template <class Epi, class Sched, bool ALIGN_EPI, bool GATHER>
__device__ __forceinline__ void gemm_phase(PG8_LAS unsigned char* lds, const int K, const unsigned lda, const Sched& S, const Epi& E, const PG8_LAS int* rowtab, const int ashift) {
    int tid_ = threadIdx.x; asm volatile("" : "+v"(tid_));
    const int tid = tid_, wid = __builtin_amdgcn_readfirstlane(tid >> 6), lane = tid & 63, wr = wid >> 2, wc = wid & 3, fr = lane & 15, fq = lane >> 4;
    const int nt = K / BK;
    unsigned voffB[2], offA[2][2], noffA[2][2]; int Rr[2], Cc[2];
#pragma unroll
    for (int i = 0; i < 2; ++i) { int R, C; stage_rc(tid * 16 + i * 8192, R, C); const int Rb = Epi::PERM ? ((R & ~31) + perm32(R & 31)) : R; Rr[i] = R; Cc[i] = C;
        voffB[i] = (unsigned)(Rb * K + C) * 2u;
#pragma unroll
        for (int h = 0; h < 2; ++h) { offA[h][i] = (unsigned)(R + HALF * h) * lda + (unsigned)C * 2u; noffA[h][i] = offA[h][i]; } }
    const size_t kstep = (size_t)(BK * 2);
    const size_t hstep = (size_t)HALF * K * 2;
    const unsigned ldsw = (unsigned)wid * 1024u;
    const int aoff = lds_byte(wr * 64 + fr, fq * 8), boff = lds_byte(wc * 32 + fr, fq * 8);
#define PG8_SA(b, h) (((b) * 2 + (h)) * HTB)
#define PG8_SB(b, h) ((4 + (b) * 2 + (h)) * HTB)
#define PG8_STAGE(bufoff, gbase, voff) do { _Pragma("unroll") for (int _i = 0; _i < 2; ++_i) \
        __builtin_amdgcn_global_load_lds((const unsigned*)((const char*)(gbase) + (voff)[_i]), (PG8_LAS unsigned*)(lds + (bufoff) + ldsw + _i * 8192), 16, 0, 0); } while (0)
#define PG8_LDA(dst, b, h) do { _Pragma("unroll") for (int m = 0; m < 4; ++m) _Pragma("unroll") for (int k = 0; k < 2; ++k) dst[m][k] = *(const PG8_LAS bf16x8*)(lds + PG8_SA(b, h) + aoff + m * 2048 + k * 1024); } while (0)
#define PG8_LDB(dst, b, h) do { _Pragma("unroll") for (int n = 0; n < 2; ++n) _Pragma("unroll") for (int k = 0; k < 2; ++k) dst[n][k] = *(const PG8_LAS bf16x8*)(lds + PG8_SB(b, h) + boff + n * 2048 + k * 1024); } while (0)
#define PG8_MMA(ai, bj, At, Bt) do { __builtin_amdgcn_s_setprio(1); _Pragma("unroll") for (int m = 0; m < 4; ++m) _Pragma("unroll") for (int n = 0; n < 2; ++n) _Pragma("unroll") for (int k = 0; k < 2; ++k) \
        acc[ai][bj][m][n] = __builtin_amdgcn_mfma_f32_16x16x32_bf16(Bt[n][k], At[m][k], acc[ai][bj][m][n], 0, 0, 0); __builtin_amdgcn_s_setprio(0); } while (0)
#define PG8_WAIT_V(n) asm volatile("s_waitcnt vmcnt(" #n ")" ::: "memory")
#define PG8_WAIT_L(n) asm volatile("s_waitcnt lgkmcnt(" #n ")" ::: "memory")
#define PG8_BAR __builtin_amdgcn_s_barrier()
#define PG8_SCHED __builtin_amdgcn_sched_barrier(0)
#define PG8_GOFF(dst, u) do { if constexpr (GATHER) { _Pragma("unroll") for (int _h = 0; _h < 2; ++_h) _Pragma("unroll") for (int _i = 0; _i < 2; ++_i) { \
        int _e = rowtab[(u).tab * 256 + _h * HALF + Rr[_i]]; _e = _e < 0 ? 0 : (_e >> ashift); dst[_h][_i] = (unsigned)_e * lda + (unsigned)Cc[_i] * 2u; } } } while (0)
    Unit cur, nxt; int ui = 0;
    if (!S.next(0, cur)) return;
    f32x4 acc[2][2][4][2];
#pragma unroll
    for (int a = 0; a < 2; ++a)
#pragma unroll
        for (int b = 0; b < 2; ++b)
#pragma unroll
            for (int m = 0; m < 4; ++m)
#pragma unroll
                for (int n = 0; n < 2; ++n) acc[a][b][m][n] = (f32x4){0.f, 0.f, 0.f, 0.f};
    bf16x8 At[4][2], B0[2][2], B1[2][2];
    const char* cA = cur.A; const char* cB = cur.B;
    PG8_GOFF(offA, cur);
    PG8_STAGE(PG8_SB(0, 0), cB, voffB); PG8_STAGE(PG8_SB(0, 1), cB + hstep, voffB); PG8_STAGE(PG8_SA(0, 0), cA, offA[0]); PG8_STAGE(PG8_SA(0, 1), cA, offA[1]);
    if (wr == 1) PG8_BAR;
    PG8_WAIT_V(2); PG8_BAR;
    PG8_STAGE(PG8_SB(1, 0), cB + kstep, voffB); PG8_STAGE(PG8_SA(1, 0), cA + kstep, offA[0]); PG8_STAGE(PG8_SB(1, 1), cB + hstep + kstep, voffB);
    PG8_WAIT_V(6); PG8_BAR;
    for (;;) {
        const bool has_next = S.next(ui + 1, nxt);
        const char* nA = has_next ? nxt.A : cA; const char* nB = has_next ? nxt.B : cB;
        if constexpr (GATHER) { if (has_next) PG8_GOFF(noffA, nxt); else {
#pragma unroll
            for (int h = 0; h < 2; ++h)
#pragma unroll
                for (int i = 0; i < 2; ++i) noffA[h][i] = offA[h][i]; } }
        for (int t = 0; t < nt; t += 2) {
            const bool last = (t == nt - 2);
            const char* a1 = cA + (size_t)(t + 1) * kstep;
            const char* a2 = last ? nA : cA + (size_t)(t + 2) * kstep; const char* b2 = last ? nB : cB + (size_t)(t + 2) * kstep;
            const char* a3 = a2 + kstep; const char* b3 = b2 + kstep;
            unsigned o2[2][2];
#pragma unroll
            for (int h = 0; h < 2; ++h)
#pragma unroll
                for (int i = 0; i < 2; ++i) o2[h][i] = (GATHER && last) ? noffA[h][i] : offA[h][i];
            PG8_LDB(B0, 0, 0); PG8_LDB(B1, 0, 1); PG8_SCHED; PG8_LDA(At, 0, 0); PG8_STAGE(PG8_SA(1, 1), a1, offA[1]);
            PG8_WAIT_V(8); PG8_WAIT_L(0); PG8_BAR; PG8_MMA(0, 0, At, B0); PG8_MMA(0, 1, At, B1); PG8_BAR; PG8_SCHED;
            PG8_LDA(At, 0, 1); PG8_STAGE(PG8_SB(0, 0), b2, voffB); PG8_STAGE(PG8_SB(0, 1), b2 + hstep, voffB); PG8_STAGE(PG8_SA(0, 0), a2, o2[0]);
            PG8_WAIT_V(8); PG8_WAIT_L(0); PG8_BAR; PG8_MMA(1, 0, At, B0); PG8_MMA(1, 1, At, B1); PG8_BAR; PG8_SCHED;
            PG8_LDB(B0, 1, 0); PG8_LDB(B1, 1, 1); PG8_SCHED; PG8_LDA(At, 1, 0); PG8_STAGE(PG8_SA(0, 1), a2, o2[1]);
            PG8_WAIT_V(8); PG8_WAIT_L(0); PG8_BAR; PG8_MMA(0, 0, At, B0); PG8_MMA(0, 1, At, B1); PG8_BAR; PG8_SCHED;
            PG8_LDA(At, 1, 1); PG8_STAGE(PG8_SB(1, 0), b3, voffB); PG8_STAGE(PG8_SB(1, 1), b3 + hstep, voffB); PG8_STAGE(PG8_SA(1, 0), a3, o2[0]);
            PG8_WAIT_V(8); PG8_WAIT_L(0); PG8_BAR; PG8_MMA(1, 0, At, B0); PG8_MMA(1, 1, At, B1); PG8_BAR; PG8_SCHED;
        }
        if constexpr (ALIGN_EPI) { if (wr == 0) PG8_BAR; }
        E(acc, cur, wr, wc, fr, fq, rowtab);
        if (!has_next) break;
#pragma unroll
        for (int a = 0; a < 2; ++a)
#pragma unroll
            for (int b = 0; b < 2; ++b)
#pragma unroll
                for (int m = 0; m < 4; ++m)
#pragma unroll
                    for (int n = 0; n < 2; ++n) acc[a][b][m][n] = (f32x4){0.f, 0.f, 0.f, 0.f};
        cur = nxt; cA = nA; cB = nB; ++ui;
        if constexpr (GATHER) {
#pragma unroll
            for (int h = 0; h < 2; ++h)
#pragma unroll
                for (int i = 0; i < 2; ++i) offA[h][i] = noffA[h][i]; }
        if constexpr (ALIGN_EPI) { if (wr == 1) PG8_BAR; }
    }
    PG8_WAIT_V(0);
    if constexpr (!ALIGN_EPI) { if (wr == 0) PG8_BAR; }
    PG8_BAR;
#undef PG8_SA
#undef PG8_SB
#undef PG8_STAGE
#undef PG8_LDA
#undef PG8_LDB
#undef PG8_MMA
#undef PG8_WAIT_V
#undef PG8_WAIT_L
#undef PG8_BAR
#undef PG8_SCHED
#undef PG8_GOFF
}

struct EpiQKV {
    static constexpr bool PERM = true;
    bf16_t* Q; bf16_t* Kb; bf16_t* Vb; float qscale;
    unsigned* qm; unsigned* km;
    __device__ __forceinline__ void operator()(const f32x4 (&acc)[2][2][4][2], const Unit& u, int wr, int wc, int fr, int fq, const PG8_LAS int*) const {
        const int row0 = u.pm * BM + wr * 64 + fr; const int t = (u.pn * BM) >> 10; const int colt = (u.pn * BM) & 1023;
        const int col0 = colt + wc * 32 + 8 * fq; const float sc = (t == 0) ? qscale : 1.f;
        bf16_t* kv = (t == 1) ? Kb : Vb;
        float mx[2] = {0.f, 0.f};
#pragma unroll
        for (int ai = 0; ai < 2; ++ai)
#pragma unroll
            for (int m = 0; m < 4; ++m) { const int r = row0 + ai * HALF + m * 16;
                if (r < NR) {
#pragma unroll
                for (int bj = 0; bj < 2; ++bj) { const f32x4 v0 = acc[ai][bj][m][0] * sc, v1 = acc[ai][bj][m][1] * sc;
                    u32x4 w; w.x = cvt_pk_bf16(v0[0], v0[1]); w.y = cvt_pk_bf16(v0[2], v0[3]); w.z = cvt_pk_bf16(v1[0], v1[1]); w.w = cvt_pk_bf16(v1[2], v1[3]);
                    const int c = col0 + bj * HALF;
                    bf16_t* dst = (t == 0) ? Q + (size_t)r * DM : kv + (size_t)(r < NREAL ? (r >> 13) * KROWS + KPRE + (r & (SEQ - 1)) : r - NREAL) * DM;
                    *(u32x4*)(dst + c) = w; } }
                if (qm != nullptr && t < 2) {
#pragma unroll
                    for (int bj = 0; bj < 2; ++bj) { const f32x4 v0 = acc[ai][bj][m][0] * sc, v1 = acc[ai][bj][m][1] * sc;
                        float ss = (v0[0] * v0[0] + v0[1] * v0[1]) + (v0[2] * v0[2] + v0[3] * v0[3]) + (v1[0] * v1[0] + v1[1] * v1[1]) + (v1[2] * v1[2] + v1[3] * v1[3]);
                        ss += shx(ss, 16, fq * 16 + fr); ss += shx(ss, 32, fq * 16 + fr);
                        if (r < NR) mx[bj] = fmaxf(mx[bj], ss); } } }
        if (qm != nullptr && t < 2) {
#pragma unroll
            for (int bj = 0; bj < 2; ++bj) { float v = mx[bj]; v = fmaxf(v, shx(v, 1, fq * 16 + fr)); v = fmaxf(v, shx(v, 2, fq * 16 + fr)); v = fmaxf(v, shx(v, 4, fq * 16 + fr)); v = fmaxf(v, shx(v, 8, fq * 16 + fr));
                if (fr == 0 && fq == 0) { const int head = 4 * (u.pn & 3) + 2 * bj + (wc >> 1), part = wc & 1; const unsigned bits = __float_as_uint(v);
                    if (t == 0) { if (u.pm < NREAL / BM) atomicMax(qm + ((size_t)u.pm * 16 + head) * 8 + part, bits); }
                    else if (u.pm < NREAL / BM) atomicMax(km + ((size_t)(u.pm >> 5) * 16 + head) * 8 + part, bits);
                    else { for (int b = 0; b < NBATCH; ++b) atomicMax(km + ((size_t)b * 16 + head) * 8 + part, bits); } } } }
    }
};
struct EpiZ {
    static constexpr bool PERM = true;
    bf16_t* H;
    __device__ __forceinline__ void operator()(const f32x4 (&acc)[2][2][4][2], const Unit& u, int wr, int wc, int fr, int fq, const PG8_LAS int*) const {
        const int row0 = u.pm * BM + wr * 64 + fr; const int col0 = u.pn * BM + wc * 32 + 8 * fq;
#pragma unroll
        for (int ai = 0; ai < 2; ++ai)
#pragma unroll
            for (int m = 0; m < 4; ++m) { const int r = row0 + ai * HALF + m * 16;
                if (r < NR) {
#pragma unroll
                    for (int bj = 0; bj < 2; ++bj) { bf16_t* hp = H + (size_t)r * DM + col0 + bj * HALF; const u32x4 b = *(const u32x4*)hp;
                        const f32x4 v0 = acc[ai][bj][m][0], v1 = acc[ai][bj][m][1];
                        u32x4 w; w.x = cvt_pk_bf16(v0[0] + ALPHA * __uint_as_float(b.x << 16), v0[1] + ALPHA * __uint_as_float(b.x & 0xffff0000u)); w.y = cvt_pk_bf16(v0[2] + ALPHA * __uint_as_float(b.y << 16), v0[3] + ALPHA * __uint_as_float(b.y & 0xffff0000u));
                        w.z = cvt_pk_bf16(v1[0] + ALPHA * __uint_as_float(b.z << 16), v1[1] + ALPHA * __uint_as_float(b.z & 0xffff0000u)); w.w = cvt_pk_bf16(v1[2] + ALPHA * __uint_as_float(b.w << 16), v1[3] + ALPHA * __uint_as_float(b.w & 0xffff0000u));
                        *(u32x4*)hp = w; } } }
    }
};
struct EpiGU {
    static constexpr bool PERM = true;
    bf16_t* U;
    __device__ __forceinline__ void operator()(const f32x4 (&acc)[2][2][4][2], const Unit& u, int wr, int wc, int fr, int fq, const PG8_LAS int* rowtab) const {
        const int col0 = u.pn * HALF + wc * 32 + 8 * fq;
#pragma unroll
        for (int ai = 0; ai < 2; ++ai)
#pragma unroll
            for (int m = 0; m < 4; ++m) { const int slot = rowtab[u.tab * 256 + ai * HALF + wr * 64 + m * 16 + fr];
                if (slot >= 0) { float o[8];
#pragma unroll
                    for (int n = 0; n < 2; ++n)
#pragma unroll
                        for (int c = 0; c < 4; ++c) { const float g = acc[ai][0][m][n][c], up = acc[ai][1][m][n][c]; o[n * 4 + c] = g * up * __builtin_amdgcn_rcpf(1.f + __builtin_amdgcn_exp2f(-g * LOG2E)); }
                    u32x4 w; w.x = cvt_pk_bf16(o[0], o[1]); w.y = cvt_pk_bf16(o[2], o[3]); w.z = cvt_pk_bf16(o[4], o[5]); w.w = cvt_pk_bf16(o[6], o[7]);
                    *(u32x4*)(U + (size_t)slot * DEXP + col0) = w; } }
    }
};
struct EpiDown {
    static constexpr bool PERM = true;
    bf16_t* Y; const float* GV;
    __device__ __forceinline__ void operator()(const f32x4 (&acc)[2][2][4][2], const Unit& u, int wr, int wc, int fr, int fq, const PG8_LAS int* rowtab) const {
        const int col0 = u.pn * BM + wc * 32 + 8 * fq;
#pragma unroll
        for (int ai = 0; ai < 2; ++ai)
#pragma unroll
            for (int m = 0; m < 4; ++m) { const int slot = rowtab[u.tab * 256 + ai * HALF + wr * 64 + m * 16 + fr];
                if (slot >= 0) { const float gv = GV[slot];
#pragma unroll
                    for (int bj = 0; bj < 2; ++bj) { const f32x4 v0 = acc[ai][bj][m][0] * gv, v1 = acc[ai][bj][m][1] * gv;
                        u32x4 w; w.x = cvt_pk_bf16(v0[0], v0[1]); w.y = cvt_pk_bf16(v0[2], v0[3]); w.z = cvt_pk_bf16(v1[0], v1[1]); w.w = cvt_pk_bf16(v1[2], v1[3]);
                        *(u32x4*)(Y + (size_t)slot * DM + col0 + bj * HALF) = w; } } }
    }
};
}
namespace attn_body {
using bf16=__hip_bfloat16;
using bf16x8=__attribute__((ext_vector_type(8)))short;
using s16x4=__attribute__((ext_vector_type(4)))short;
using f32x16=__attribute__((ext_vector_type(16)))float;
using u32x4=__attribute__((ext_vector_type(4)))unsigned;
constexpr int D=64;
constexpr int NW=8,QBLK=32,QB=QBLK*NW,KVBLK=64,NQB=SEQ/QB;
constexpr int ATTN_PITCH=DM, ATTN_UNIT_ROWS=QB;
__device__ __forceinline__ int crow(int r,int hi){return (r&3)+8*(r>>2)+4*hi;}
#define SBAR() __builtin_amdgcn_sched_barrier(0)
__device__ __forceinline__ void cmask(f32x16&p0,f32x16&p1,int jb,int qrel,int hi){
  const float NEG=-INFINITY; int kb=64*jb+4*hi;
  #pragma unroll
  for(int r=0;r<16;++r){int kv=kb+(r&3)+8*(r>>2); if(kv>qrel)p0[r]=NEG; if(kv+32>qrel)p1[r]=NEG;}
}

constexpr int RT_OFFS=320, RT_SIZE=704;

template<int MODE> __device__ __forceinline__ void modtile_slow(f32x16&p0,f32x16&p1,int t,int q_abs,int q0,int hi,const __attribute__((address_space(3))) float* tab){
  const float NEG=-INFINITY; int hi4=4*hi; asm volatile("":"+v"(hi4),"+v"(q_abs));
  if(MODE==0){
    if(t==0){
      int bd=16+q_abs; bd=bd>383?383:bd; const __attribute__((address_space(3))) float* bp=tab+(RT_OFFS+bd-hi4-15);
      #pragma unroll
      for(int r=0;r<16;++r){ p1[r]=NEG; if(r<8)p0[r]+=bp[15-((r&3)+8*(r>>2))]; else p0[r]=NEG; }
    } else {
      const __attribute__((address_space(3))) float* bp=tab+(RT_OFFS+q_abs-64*t+KPRE-hi4-63);
      const int dq=q_abs-64*t+KPRE-hi4;
      #pragma unroll
      for(int r=0;r<16;++r){ const int c=(r&3)+8*(r>>2); p0[r]+=bp[63-c]; p1[r]+=bp[31-c]; }
      if(64*t-KPRE+63>q0){
        #pragma unroll
        for(int r=0;r<16;++r){ const int c=(r&3)+8*(r>>2); if(c>dq)p0[r]=NEG; if(c+32>dq)p1[r]=NEG; } }
    }
  } else {
    if(t==0){
      #pragma unroll
      for(int r=0;r<16;++r){ p1[r]=NEG; if(r<8)p0[r]+=tab[(r&3)+8*(r>>2)+hi4]; else p0[r]=NEG; }
    } else {
      typedef float f4 __attribute__((ext_vector_type(4)));
      const __attribute__((address_space(3))) f4* tp=(const __attribute__((address_space(3))) f4*)(tab+64*t+hi4);
      #pragma unroll
      for(int g=0;g<4;++g){ const f4 a=tp[2*g], b=tp[8+2*g];
        #pragma unroll
        for(int c=0;c<4;++c){ p0[4*g+c]+=a[c]; p1[4*g+c]+=b[c]; }
        asm volatile("":::"memory"); }
      if(64*t-KPRE+63>q0){
        const int dq=q_abs-64*t+KPRE-hi4;
        #pragma unroll
        for(int r=0;r<16;++r){ const int c=(r&3)+8*(r>>2); if(c>dq)p0[r]=NEG; if(c+32>dq)p1[r]=NEG; } }
    }
  }
}
__device__ __forceinline__ void modtile_fast1(f32x16&p0,f32x16&p1,int t,int hi,const __attribute__((address_space(3))) float* tab){
  typedef float f4 __attribute__((ext_vector_type(4)));
  const __attribute__((address_space(3))) f4* tp=(const __attribute__((address_space(3))) f4*)(tab+64*t+4*hi);
  #pragma unroll
  for(int g=0;g<4;++g){ const f4 a=tp[2*g], b=tp[8+2*g];
    #pragma unroll
    for(int c=0;c<4;++c){ p0[4*g+c]+=a[c]; p1[4*g+c]+=b[c]; } }
}
constexpr int NSLOT=3, SLOTB=8192;
constexpr int LDS_K=0, LDS_V=NSLOT*SLOTB, LDS_WS=2*NSLOT*SLOTB, LDS_OST=LDS_WS+NW*64*4, LDS_TAB=LDS_OST+NW*4096, LDS_BYTES=LDS_TAB+KROWS*4;
constexpr float C2=0.125f*1.4426950408889634f;
__device__ __forceinline__ void glds16(const void*gsrc,unsigned lds_dst){unsigned keep;
  asm volatile("s_mov_b32 %0, m0\n\ts_mov_b32 m0, %2\n\ts_nop 0\n\tglobal_load_lds_dwordx4 %1, off\n\ts_mov_b32 m0, %0":"=&s"(keep):"v"(gsrc),"s"(lds_dst):"memory");}
__device__ __forceinline__ float max3f(float a,float b,float c){float r;asm("v_max3_f32 %0, %1, %2, %3":"=v"(r):"v"(a),"v"(b),"v"(c));return r;}
__device__ __forceinline__ float max2f(float a,float b){float r;asm("v_max_f32_e32 %0, %1, %2":"=v"(r):"v"(a),"v"(b));return r;}
__device__ __forceinline__ float fadd_s(float a,float b){float r;asm("v_add_f32_e32 %0, %1, %2":"=v"(r):"v"(a),"v"(b));return r;}
__device__ __forceinline__ float fsub_s(float a,float b){float r;asm("v_sub_f32_e32 %0, %1, %2":"=v"(r):"v"(a),"v"(b));return r;}
typedef float f32x2_t __attribute__((ext_vector_type(2))); typedef __bf16 bf16x2_t __attribute__((ext_vector_type(2)));
__device__ __forceinline__ unsigned cvtpk_s(float lo,float hi){f32x2_t v={lo,hi};bf16x2_t b=__builtin_convertvector(v,bf16x2_t);return __builtin_bit_cast(unsigned,b);}
#define WAIT_BAR(N) asm volatile("s_waitcnt vmcnt(" #N ") lgkmcnt(0)\n\ts_barrier":::"memory")

__device__ __forceinline__ void qkt(f32x16&p0,f32x16&p1,const char*Kslot,const bf16x8*qr,const f32x16&negm,int r32,int hi){
  const char*kb=Kslot+hi*1024+r32*16;
  #pragma unroll
  for(int d0=0;d0<4;++d0){
    const bf16x8 b0=*reinterpret_cast<const bf16x8*>(kb+d0*2048);
    const bf16x8 b1=*reinterpret_cast<const bf16x8*>(kb+d0*2048+512);
    if(d0==0){p0=__builtin_amdgcn_mfma_f32_32x32x16_bf16(b0,qr[0],negm,0,0,0);p1=__builtin_amdgcn_mfma_f32_32x32x16_bf16(b1,qr[0],negm,0,0,0);}
    else{p0=__builtin_amdgcn_mfma_f32_32x32x16_bf16(b0,qr[d0],p0,0,0,0);p1=__builtin_amdgcn_mfma_f32_32x32x16_bf16(b1,qr[d0],p1,0,0,0);}}
}
typedef __attribute__((address_space(3))) const char* lds_cptr;
typedef short v4i16_t __attribute__((ext_vector_type(4)));
__device__ __forceinline__ void kload8(bf16x8*kf,lds_cptr kp){
  kf[0]=*(const __attribute__((address_space(3))) bf16x8*)(kp);      kf[1]=*(const __attribute__((address_space(3))) bf16x8*)(kp+512);
  kf[2]=*(const __attribute__((address_space(3))) bf16x8*)(kp+2048); kf[3]=*(const __attribute__((address_space(3))) bf16x8*)(kp+2560);
  kf[4]=*(const __attribute__((address_space(3))) bf16x8*)(kp+4096); kf[5]=*(const __attribute__((address_space(3))) bf16x8*)(kp+4608);
  kf[6]=*(const __attribute__((address_space(3))) bf16x8*)(kp+6144); kf[7]=*(const __attribute__((address_space(3))) bf16x8*)(kp+6656);
}
__device__ __forceinline__ void kload2(bf16x8*kf,lds_cptr kp,int j){ kf[2*j]=*(const __attribute__((address_space(3))) bf16x8*)(kp+j*2048); kf[2*j+1]=*(const __attribute__((address_space(3))) bf16x8*)(kp+j*2048+512); }
__device__ __forceinline__ s16x4 vtr(lds_cptr p){ return __builtin_bit_cast(s16x4,__builtin_amdgcn_ds_read_tr16_b64_v4i16((__attribute__((address_space(3))) v4i16_t*)p)); }
__device__ __forceinline__ float rowmax(const f32x16&p0,const f32x16&p1){
  float a=max3f(p0[0],p0[1],p1[0]),b=max3f(p0[2],p0[3],p1[1]);a=max3f(a,p1[2],p1[3]);
  #pragma unroll
  for(int r=4;r<16;r+=4){a=max3f(a,p0[r],p0[r+1]);b=max3f(b,p0[r+2],p0[r+3]);a=max3f(a,p1[r],p1[r+1]);b=max3f(b,p1[r+2],p1[r+3]);}
  const float m=max2f(a,b);
  auto rr=__builtin_amdgcn_permlane32_swap(__float_as_uint(m),__float_as_uint(m),false,false);
  return max2f(__uint_as_float(rr[0]),__uint_as_float(rr[1]));
}
__device__ __forceinline__ void pv(f32x16*o,int vb,bf16x8 pa0,bf16x8 pa1,bf16x8 pa2,bf16x8 pa3){
  #pragma unroll
  for(int d0=0;d0<2;++d0){s16x4 lo[4],hi[4];
    #pragma unroll
    for(int ks=0;ks<4;++ks){
      asm volatile("ds_read_b64_tr_b16 %0,%1 offset:%c2":"=&v"(lo[ks]):"v"(vb),"i"(d0*4096+ks*1024):"memory");
      asm volatile("ds_read_b64_tr_b16 %0,%1 offset:%c2":"=&v"(hi[ks]):"v"(vb),"i"(d0*4096+ks*1024+512):"memory");}
    asm volatile("s_waitcnt lgkmcnt(0)":::"memory");SBAR();
    #define PK(k) (bf16x8){lo[k][0],lo[k][1],lo[k][2],lo[k][3],hi[k][0],hi[k][1],hi[k][2],hi[k][3]}
    o[d0]=__builtin_amdgcn_mfma_f32_32x32x16_bf16(pa0,PK(0),o[d0],0,0,0);
    o[d0]=__builtin_amdgcn_mfma_f32_32x32x16_bf16(pa1,PK(1),o[d0],0,0,0);
    o[d0]=__builtin_amdgcn_mfma_f32_32x32x16_bf16(pa2,PK(2),o[d0],0,0,0);
    o[d0]=__builtin_amdgcn_mfma_f32_32x32x16_bf16(pa3,PK(3),o[d0],0,0,0);
    #undef PK
  }
}

#ifndef ATTN_STORE16
#define ATTN_STORE16(p,v) (*(u32x4*)(p)=(v))
#endif
template<int MODE,int THRL> __device__ __forceinline__ void attn_unit(int b,int qb,int tb,int cq,int cv,int co,const bf16*Q,const bf16*__restrict__ K,const bf16*__restrict__ V,bf16*O,const float*tabsrc,char*shm){
  int tid_=threadIdx.x; asm volatile("":"+v"(tid_));
  const int tid=tid_,lane=tid&63,r32=lane&31,hi=lane>>5; const int wid=__builtin_amdgcn_readfirstlane(tid>>6);
  const long rowbase=(long)b*SEQ, rowbase_k=(long)b*KROWS; const int q0=qb*QB;
  const bf16*Qw=Q+(rowbase+q0+wid*QBLK)*DM+cq;
  const bf16*Kh=K+rowbase_k*DM+cq,*Vh=V+rowbase_k*DM+cv;
  const unsigned lds0=(unsigned)(uintptr_t)shm;
  const __attribute__((address_space(3))) char* shm3_=(const __attribute__((address_space(3))) char*)shm;
  float*wsf=(float*)(shm+LDS_WS)+wid*64;
  const bf16*ksrc=Kh+(long)(lane+64*tb)*DM+wid*8;
  const bf16*vsrc=Vh+(long)(16*(wid&3)+(lane>>2)+64*tb)*DM+(wid>>2)*32+(lane&3)*8;
  const unsigned kdst=lds0+LDS_K+wid*1024, vdst=lds0+LDS_V+wid*1024;
  #define DMA_K(t,slot) glds16(ksrc+(long)(t)*KVBLK*DM,(unsigned)__builtin_amdgcn_readfirstlane(kdst+(slot)))
  #define DMA_V(t,slot) glds16(vsrc+(long)(t)*KVBLK*DM,(unsigned)__builtin_amdgcn_readfirstlane(vdst+(slot)))
  const int vb0=(int)(lds0+LDS_V)+((lane>>4)&1)*32+(lane&3)*8+(4*hi+((lane&15)>>2))*64;
  const char*Kbase=shm+LDS_K; bf16x8 kf[8];
  const lds_cptr shm3=(lds_cptr)shm; const lds_cptr kp0=shm3+LDS_K+hi*1024+r32*16; const lds_cptr vp0=shm3+LDS_V+((lane>>4)&1)*32+(lane&3)*8+(4*hi+((lane&15)>>2))*64;
  const int NT=(KPRE+q0+QB+KVBLK)/KVBLK-tb;
  const __attribute__((address_space(3))) float* tab=(const __attribute__((address_space(3))) float*)(shm3_+LDS_TAB);
  { __attribute__((address_space(3))) float* tw=(__attribute__((address_space(3))) float*)(shm3_+LDS_TAB);
    if(MODE==0){ for(int i=tid;i<RT_SIZE;i+=512){ const int d=i-RT_OFFS; tw[i]=d<0?-INFINITY:(d<128?tabsrc[d]:0.f); } }
    else { const int n=KPRE+q0+QB+KVBLK; for(int i=64*tb+tid*4;i<n;i+=2048){ const float4 v=*(const float4*)(tabsrc+i); tw[i]=v.x;tw[i+1]=v.y;tw[i+2]=v.z;tw[i+3]=v.w; } } }
  if(tb==0){ glds16(K+cq+(long)lane*DM+wid*8,(unsigned)__builtin_amdgcn_readfirstlane(kdst)); glds16(V+cv+(long)(16*(wid&3)+(lane>>2))*DM+(wid>>2)*32+(lane&3)*8,(unsigned)__builtin_amdgcn_readfirstlane(vdst)); } else { DMA_K(0,0); DMA_V(0,0); } DMA_K(1,SLOTB);
  bf16x8 qr[4];
  #pragma unroll
  for(int d0=0;d0<4;++d0)qr[d0]=*reinterpret_cast<const bf16x8*>(&Qw[(long)r32*DM+d0*16+hi*8]);
  float l_reg=0.f;f32x16 o[2];o[0]=f32x16{};o[1]=f32x16{};f32x16 negm=f32x16{};asm volatile("":"+v"(negm));
  const int qrel=wid*QBLK+r32, q_abs=q0+qrel;
  #define MODT(P0,P1,t,SL) do{ if(SL)modtile_slow<MODE>(P0,P1,(t)+tb,q_abs,q0,hi,tab); else if(MODE==1)modtile_fast1(P0,P1,(t)+tb,hi,tab); }while(0)
  bool resc=false;
  #define START(P0,P1) do{ const float rm=rowmax(P0,P1); resc=false; \
    { const float dl=(MODE==1)?__builtin_fmaxf(rm,0.f):rm; const float nm_=fsub_s(negm[0],dl); \
      _Pragma("unroll") for(int r=0;r<16;++r){P0[r]=fsub_s(P0[r],dl);P1[r]=fsub_s(P1[r],dl);} \
      _Pragma("unroll") for(int r=0;r<16;++r)negm[r]=nm_; asm volatile("":"+v"(negm)); } \
    _Pragma("unroll") for(int r=0;r<16;++r)P0[r]=__builtin_amdgcn_exp2f(P0[r]); }while(0)
  #define RESC() do{ if(resc){ asm volatile("s_waitcnt lgkmcnt(0)":::"memory"); \
      _Pragma("unroll") for(int d_=0;d_<2;++d_) _Pragma("unroll") for(int r=0;r<16;++r)o[d_][r]*=wsf[crow(r,hi)]; } }while(0)
  f32x16 pA0,pA1,pB0,pB1;
  int sl_prev=0,sl_cur=0,sl_next=SLOTB;
  #define ROT() do{sl_prev=sl_cur;sl_cur=sl_next;sl_next=(sl_next==(NSLOT-1)*SLOTB)?0:sl_next+SLOTB;}while(0)
  DMA_K(2,2*SLOTB);
  WAIT_BAR(3);
  if(MODE==1){ const float m0_=tab[KPRE+q_abs]; _Pragma("unroll") for(int r=0;r<16;++r)negm[r]=-m0_; asm volatile("":"+v"(negm)); }
  qkt(pA0,pA1,Kbase,qr,negm,r32,hi);asm volatile("s_nop 15\n\ts_nop 7":"+v"(pA0),"+v"(pA1));MODT(pA0,pA1,0,true);
  START(pA0,pA1);
  _Pragma("unroll") for(int r=0;r<16;++r)pA1[r]=__builtin_amdgcn_exp2f(pA1[r]);
  WAIT_BAR(0);
  DMA_K(3,0);DMA_V(1,SLOTB);
  ROT();
  kload8(kf,kp0+sl_cur);
  WAIT_BAR(2);
  s16x4 vlo[8],vhi[8]; u32x4 pw0,pw1,pw2,pw3;
  #define PKW(P,B) cvtpk_s(P[B],P[B+1])
  #define PAF(k) __builtin_bit_cast(bf16x8,pw##k)
  #define VFR(i) (bf16x8){vlo[i][0],vlo[i][1],vlo[i][2],vlo[i][3],vhi[i][0],vhi[i][1],vhi[i][2],vhi[i][3]}
  #define PIN(x) asm volatile("":"+v"(x))
  #define MX3(a,b,c) __builtin_fmaxf(__builtin_fmaxf((a),(b)),(c))
  #define GAPA(MF,A0,A1,A2,A3,W0,W1,PW) do{ MF; sacc+=A0; sacc+=A1; sacc+=A2; sacc+=A3; PIN(sacc); W0; W1; PIN(PW); SBAR(); }while(0)
  #define EX(v) __builtin_amdgcn_exp2f(v)
  #define GAPB(MF,X,B) do{ MF; X[B]=EX(X[B]); X[B+1]=EX(X[B+1]); X[B+2]=EX(X[B+2]); X[B+3]=EX(X[B+3]); PIN(X); SBAR(); }while(0)
  #define VRD(i) do{ vlo[i]=vtr(vp_+(((i)>>2)*4096+((i)&3)*1024)); vhi[i]=vtr(vp_+(((i)>>2)*4096+((i)&3)*1024+512)); }while(0)
  #define KRD(G,j) do{ if(G){ kload2(kf,kp0+sl_next,j); SBAR(); } }while(0)
  #define STEP(C0,C1,P0,P1,t,GK,GV,GL,SL) do{ SBAR(); \
    const lds_cptr vp_=vp0+sl_prev; \
    VRD(0); SBAR(); float sacc=(P0[0]+P0[1]); \
    GAPA(C0=__builtin_amdgcn_mfma_f32_32x32x16_bf16(kf[0],qr[0],negm,0,0,0), P0[2],P0[3],P0[4],P0[5],     pw0[0]=PKW(P0,0), pw0[1]=PKW(P0,2), pw0); \
    VRD(4); SBAR(); GAPA(C1=__builtin_amdgcn_mfma_f32_32x32x16_bf16(kf[1],qr[0],negm,0,0,0), P0[6],P0[7],P0[8],P0[9],     pw0[2]=PKW(P0,4), pw0[3]=PKW(P0,6), pw0); \
    VRD(1); SBAR(); GAPA(C0=__builtin_amdgcn_mfma_f32_32x32x16_bf16(kf[2],qr[1],C0,0,0,0),   P0[10],P0[11],P0[12],P0[13], pw1[0]=PKW(P0,8), pw1[1]=PKW(P0,10), pw1); \
    VRD(5); SBAR(); GAPA(C1=__builtin_amdgcn_mfma_f32_32x32x16_bf16(kf[3],qr[1],C1,0,0,0),   P0[14],P0[15],P1[0],P1[1],   pw1[2]=PKW(P0,12),pw1[3]=PKW(P0,14), pw1); \
    VRD(2); SBAR(); GAPA(C0=__builtin_amdgcn_mfma_f32_32x32x16_bf16(kf[4],qr[2],C0,0,0,0),   P1[2],P1[3],P1[4],P1[5],     pw2[0]=PKW(P1,0), pw2[1]=PKW(P1,2), pw2); \
    VRD(6); SBAR(); GAPA(C1=__builtin_amdgcn_mfma_f32_32x32x16_bf16(kf[5],qr[2],C1,0,0,0),   P1[6],P1[7],P1[8],P1[9],     pw2[2]=PKW(P1,4), pw2[3]=PKW(P1,6), pw2); \
    VRD(3); SBAR(); GAPA(C0=__builtin_amdgcn_mfma_f32_32x32x16_bf16(kf[6],qr[3],C0,0,0,0),   P1[10],P1[11],P1[12],P1[13], pw3[0]=PKW(P1,8), pw3[1]=PKW(P1,10), pw3); \
    VRD(7); SBAR(); GAPA(C1=__builtin_amdgcn_mfma_f32_32x32x16_bf16(kf[7],qr[3],C1,0,0,0),   P1[14],P1[15],0.f,0.f,       pw3[2]=PKW(P1,12),pw3[3]=PKW(P1,14), pw3); \
    l_reg+=sacc; \
    if(GK){DMA_K((t)+3,sl_cur);} if(GV){DMA_V((t)+1,sl_next);} \
    MODT(C0,C1,t,SL); \
    { float a=MX3(C0[0],C0[1],C1[0]),b=MX3(C0[2],C0[3],C1[1]); a=MX3(a,C1[2],C1[3]); \
      _Pragma("unroll") for(int r=4;r<16;r+=4){a=MX3(a,C0[r],C0[r+1]);b=MX3(b,C0[r+2],C0[r+3]);a=MX3(a,C1[r],C1[r+1]);b=MX3(b,C1[r+2],C1[r+3]);} \
      float rm=__builtin_fmaxf(a,b); { auto rr=__builtin_amdgcn_permlane32_swap(__float_as_uint(rm),__float_as_uint(rm),false,false); rm=__builtin_fmaxf(__uint_as_float(rr[0]),__uint_as_float(rr[1])); } \
      resc=false; \
      if(__builtin_expect(__any(rm>(float)THRL),0)){ const float dl=__builtin_fmaxf(rm,0.f); const float nm_=negm[0]-dl; \
        _Pragma("unroll") for(int r=0;r<16;++r){C0[r]-=dl;C1[r]-=dl;} \
        _Pragma("unroll") for(int r=0;r<16;++r)negm[r]=nm_; asm volatile("":"+v"(negm)); \
        const float f=__builtin_amdgcn_exp2f(-dl); l_reg*=f; if(hi==0){ int r32_=r32; asm volatile("":"+v"(r32_)); wsf[r32_]=f; } resc=true; } } \
    SBAR(); \
    GAPB(o[0]=__builtin_amdgcn_mfma_f32_32x32x16_bf16(PAF(0),VFR(0),o[0],0,0,0), C0,0); \
    GAPB(o[1]=__builtin_amdgcn_mfma_f32_32x32x16_bf16(PAF(0),VFR(4),o[1],0,0,0), C0,4); \
    KRD(GL,0); GAPB(o[0]=__builtin_amdgcn_mfma_f32_32x32x16_bf16(PAF(1),VFR(1),o[0],0,0,0), C0,8); \
    KRD(GL,1); GAPB(o[1]=__builtin_amdgcn_mfma_f32_32x32x16_bf16(PAF(1),VFR(5),o[1],0,0,0), C0,12); \
    KRD(GL,2); GAPB(o[0]=__builtin_amdgcn_mfma_f32_32x32x16_bf16(PAF(2),VFR(2),o[0],0,0,0), C1,0); \
    KRD(GL,3); GAPB(o[1]=__builtin_amdgcn_mfma_f32_32x32x16_bf16(PAF(2),VFR(6),o[1],0,0,0), C1,4); \
    GAPB(o[0]=__builtin_amdgcn_mfma_f32_32x32x16_bf16(PAF(3),VFR(3),o[0],0,0,0), C1,8); \
    GAPB(o[1]=__builtin_amdgcn_mfma_f32_32x32x16_bf16(PAF(3),VFR(7),o[1],0,0,0), C1,12); \
    }while(0)
  int t=1;
  #define ENDW(tt) do{ if((tt)+3<NT){WAIT_BAR(2);} else if((tt)+2<NT){WAIT_BAR(1);} else {WAIT_BAR(0);} }while(0)
  for(;t+(MODE==1?5:7)<NT;t+=2){
    STEP(pB0,pB1,pA0,pA1,t,true,true,true,false);     WAIT_BAR(2); RESC(); ROT();
    STEP(pA0,pA1,pB0,pB1,t+1,true,true,true,false);   WAIT_BAR(2); RESC(); ROT();
  }
  for(;t+1<NT;t+=2){
    STEP(pB0,pB1,pA0,pA1,t,(t+3<NT),(t+1<NT),(t+1<NT),true);       ENDW(t);   RESC(); ROT();
    STEP(pA0,pA1,pB0,pB1,t+1,(t+4<NT),(t+2<NT),(t+2<NT),true);     ENDW(t+1); RESC(); ROT();
  }
  STEP(pB0,pB1,pA0,pA1,NT-1,false,false,false,true); RESC();
  { float sacc=pB0[0]+pB0[1]; _Pragma("unroll") for(int r=2;r<16;++r)sacc+=pB0[r]; _Pragma("unroll") for(int r=0;r<16;++r)sacc+=pB1[r]; l_reg+=sacc;
    pw0=(u32x4){PKW(pB0,0),PKW(pB0,2),PKW(pB0,4),PKW(pB0,6)};pw1=(u32x4){PKW(pB0,8),PKW(pB0,10),PKW(pB0,12),PKW(pB0,14)};pw2=(u32x4){PKW(pB1,0),PKW(pB1,2),PKW(pB1,4),PKW(pB1,6)};pw3=(u32x4){PKW(pB1,8),PKW(pB1,10),PKW(pB1,12),PKW(pB1,14)};
    SBAR(); pv(o,vb0+sl_cur,PAF(0),PAF(1),PAF(2),PAF(3)); }
  #undef PKW
  #undef PAF
  #undef VFR
  #undef PIN
  #undef MX3
  #undef GAPA
  #undef GAPB
  #undef EX
  #undef VRD
  #undef KRD
  #undef STEP
  #undef ENDW
  {auto rr=__builtin_amdgcn_permlane32_swap(__float_as_uint(l_reg),__float_as_uint(l_reg),false,false);l_reg=__uint_as_float(rr[0])+__uint_as_float(rr[1]);}
  if(hi==0)wsf[32+r32]=l_reg;asm volatile("s_waitcnt lgkmcnt(0)":::"memory");
  float rli[16];
  #pragma unroll
  for(int r=0;r<16;++r)rli[r]=__builtin_amdgcn_rcpf(wsf[32+crow(r,hi)]);
  bf16*Ow=O+(rowbase+q0+wid*QBLK)*DM+co;
  { bf16*stg=(bf16*)(shm+LDS_OST)+wid*2048;
    #pragma unroll
    for(int r=0;r<16;++r){const int orow=crow(r,hi);
      #pragma unroll
      for(int d0=0;d0<2;++d0)stg[orow*64+d0*32+r32]=__float2bfloat16(o[d0][r]*rli[r]);}
    asm volatile("s_waitcnt lgkmcnt(0)":::"memory");
    #pragma unroll
    for(int i=0;i<4;++i){const int row=i*8+(lane>>3),ch=lane&7; const u32x4 v=*(const u32x4*)(stg+row*64+ch*8); ATTN_STORE16(Ow+(long)row*DM+ch*8,v);} }
  asm volatile("s_waitcnt lgkmcnt(0)\n\ts_barrier":::"memory");
  #undef DMA_K
  #undef DMA_V
  #undef MODT
  #undef START
  #undef RESC
  #undef ROT
}

template<int THRL> __device__ __forceinline__ void attn_unit_dv(int b,int qb,int cq,int cv,int co,const bf16*Q,const bf16*__restrict__ K,const bf16*__restrict__ V,bf16*O,const float*tabsrc,char*shm){
  int tid_=threadIdx.x; asm volatile("":"+v"(tid_));
  constexpr int MODE=0, tb=0; const int tid=tid_,lane=tid&63,r32=lane&31,hi=lane>>5; const int wid=__builtin_amdgcn_readfirstlane(tid>>6);
  constexpr int LDS_K=0, LDS_V=NSLOT*SLOTB, LDS_WS=LDS_V+NSLOT*2*SLOTB, LDS_OST=LDS_WS+NW*64*4, LDS_TAB=LDS_OST+NW*4096;
  static_assert(LDS_TAB+RT_SIZE*4<=131072,"dv LDS map");
  const long rowbase=(long)b*SEQ, rowbase_k=(long)b*KROWS; const int q0=qb*QB;
  const bf16*Qw=Q+(rowbase+q0+wid*QBLK)*DM+cq;
  const bf16*Kh=K+rowbase_k*DM+cq,*Vh=V+rowbase_k*DM+cv;
  const unsigned lds0=(unsigned)(uintptr_t)shm;
  const __attribute__((address_space(3))) char* shm3_=(const __attribute__((address_space(3))) char*)shm;
  float*wsf=(float*)(shm+LDS_WS)+wid*64;
  const bf16*ksrc=Kh+(long)(lane+64*tb)*DM+wid*8;
  const bf16*vsrc=Vh+(long)(16*(wid&3)+(lane>>2)+64*tb)*DM+(wid>>2)*32+(lane&3)*8;
  const unsigned kdst=lds0+LDS_K+wid*1024, vdst=lds0+LDS_V+wid*1024;
  #define DMA_K(t,slot) glds16(ksrc+(long)(t)*KVBLK*DM,(unsigned)__builtin_amdgcn_readfirstlane(kdst+(slot)))
  #define DMA_V(t,slot) do{ glds16(vsrc+(long)(t)*KVBLK*DM,(unsigned)__builtin_amdgcn_readfirstlane(vdst+2*(slot))); glds16(vsrc+(long)(t)*KVBLK*DM+64,(unsigned)__builtin_amdgcn_readfirstlane(vdst+2*(slot)+8192)); }while(0)
  const int vb0=(int)(lds0+LDS_V)+((lane>>4)&1)*32+(lane&3)*8+(4*hi+((lane&15)>>2))*64;
  const char*Kbase=shm+LDS_K; bf16x8 kf[8];
  const lds_cptr shm3=(lds_cptr)shm; const lds_cptr kp0=shm3+LDS_K+hi*1024+r32*16; const lds_cptr vp0=shm3+LDS_V+((lane>>4)&1)*32+(lane&3)*8+(4*hi+((lane&15)>>2))*64;
  const int NT=(KPRE+q0+QB+KVBLK)/KVBLK-tb;
  const __attribute__((address_space(3))) float* tab=(const __attribute__((address_space(3))) float*)(shm3_+LDS_TAB);
  { __attribute__((address_space(3))) float* tw=(__attribute__((address_space(3))) float*)(shm3_+LDS_TAB);
    if(MODE==0){ for(int i=tid;i<RT_SIZE;i+=512){ const int d=i-RT_OFFS; tw[i]=d<0?-INFINITY:(d<128?tabsrc[d]:0.f); } }
    else { const int n=KPRE+q0+QB+KVBLK; for(int i=64*tb+tid*4;i<n;i+=2048){ const float4 v=*(const float4*)(tabsrc+i); tw[i]=v.x;tw[i+1]=v.y;tw[i+2]=v.z;tw[i+3]=v.w; } } }
  if(tb==0){ glds16(K+cq+(long)lane*DM+wid*8,(unsigned)__builtin_amdgcn_readfirstlane(kdst)); glds16(V+cv+(long)(16*(wid&3)+(lane>>2))*DM+(wid>>2)*32+(lane&3)*8,(unsigned)__builtin_amdgcn_readfirstlane(vdst)); glds16(V+cv+(long)(16*(wid&3)+(lane>>2))*DM+(wid>>2)*32+(lane&3)*8+64,(unsigned)__builtin_amdgcn_readfirstlane(vdst+8192)); } else { DMA_K(0,0); DMA_V(0,0); } DMA_K(1,SLOTB);
  bf16x8 qr[4];
  #pragma unroll
  for(int d0=0;d0<4;++d0)qr[d0]=*reinterpret_cast<const bf16x8*>(&Qw[(long)r32*DM+d0*16+hi*8]);
  float mhat=0.f,l_reg=0.f;f32x16 o[4];o[0]=f32x16{};o[1]=f32x16{};o[2]=f32x16{};o[3]=f32x16{};const f32x16 zero16=f32x16{}; bool hasref=false;
  const int qrel=wid*QBLK+r32, q_abs=q0+qrel;
  #define MODT(P0,P1,t,SL) do{ if(SL)modtile_slow<MODE>(P0,P1,(t)+tb,q_abs,q0,hi,tab); else if(MODE==1)modtile_fast1(P0,P1,(t)+tb,hi,tab); }while(0)
  bool resc=false;
  #define START(P0,P1) do{ const float rm=rowmax(P0,P1); resc=false; mhat=(rm>=-64.f&&rm<64.f)?0.f:64.f*__builtin_floorf(rm*0.015625f+0.5f); hasref=__any(mhat!=0.f); \
    if(__builtin_expect(hasref,0)){ _Pragma("unroll") for(int r=0;r<16;++r){P0[r]-=mhat;P1[r]-=mhat;} } \
    _Pragma("unroll") for(int r=0;r<16;++r)P0[r]=__builtin_amdgcn_exp2f(P0[r]); }while(0)
  #define RESC() do{ if(resc){ asm volatile("s_waitcnt lgkmcnt(0)":::"memory"); \
      _Pragma("unroll") for(int d_=0;d_<4;++d_) _Pragma("unroll") for(int r=0;r<16;++r)o[d_][r]*=wsf[crow(r,hi)]; } }while(0)
  f32x16 pA0,pA1,pB0,pB1;
  int sl_prev=0,sl_cur=0,sl_next=SLOTB;
  #define ROT() do{sl_prev=sl_cur;sl_cur=sl_next;sl_next=(sl_next==(NSLOT-1)*SLOTB)?0:sl_next+SLOTB;}while(0)
  DMA_K(2,2*SLOTB);
  WAIT_BAR(3);
  qkt(pA0,pA1,Kbase,qr,zero16,r32,hi);asm volatile("s_nop 15\n\ts_nop 7":"+v"(pA0),"+v"(pA1));MODT(pA0,pA1,0,true);
  START(pA0,pA1);
  _Pragma("unroll") for(int r=0;r<16;++r)pA1[r]=__builtin_amdgcn_exp2f(pA1[r]);
  WAIT_BAR(0);
  DMA_K(3,0);DMA_V(1,SLOTB);
  ROT();
  kload8(kf,kp0+sl_cur);
  WAIT_BAR(3);
  s16x4 vlo[8],vhi[8],wlo[8],whi[8]; u32x4 pw0,pw1,pw2,pw3;
  #define PKW(P,B) cvtpk_s(P[B],P[B+1])
  #define PAF(k) __builtin_bit_cast(bf16x8,pw##k)
  #define VFR(i) (bf16x8){vlo[i][0],vlo[i][1],vlo[i][2],vlo[i][3],vhi[i][0],vhi[i][1],vhi[i][2],vhi[i][3]}
  #define WFR(i) (bf16x8){wlo[i][0],wlo[i][1],wlo[i][2],wlo[i][3],whi[i][0],whi[i][1],whi[i][2],whi[i][3]}
  #define WRD(i) do{ wlo[i]=vtr(vp_+((2+((i)>>2))*4096+((i)&3)*1024)); whi[i]=vtr(vp_+((2+((i)>>2))*4096+((i)&3)*1024+512)); SBAR(); }while(0)
  #define GAPB2(MF,X,B) do{ MF; X[B]=EX(X[B]); X[B+1]=EX(X[B+1]); PIN(X); SBAR(); }while(0)
  #define PIN(x) asm volatile("":"+v"(x))
  #define MX3(a,b,c) __builtin_fmaxf(__builtin_fmaxf((a),(b)),(c))
  #define GAPA(MF,A0,A1,A2,A3,W0,W1,PW) do{ MF; sacc+=A0; sacc+=A1; sacc+=A2; sacc+=A3; PIN(sacc); W0; W1; PIN(PW); SBAR(); }while(0)
  #define EX(v) __builtin_amdgcn_exp2f(v)
  #define GAPB(MF,X,B) do{ MF; X[B]=EX(X[B]); X[B+1]=EX(X[B+1]); X[B+2]=EX(X[B+2]); X[B+3]=EX(X[B+3]); PIN(X); SBAR(); }while(0)
  #define VRD(i) do{ vlo[i]=vtr(vp_+(((i)>>2)*4096+((i)&3)*1024)); vhi[i]=vtr(vp_+(((i)>>2)*4096+((i)&3)*1024+512)); }while(0)
  #define KRD(G,j) do{ if(G){ kload2(kf,kp0+sl_next,j); SBAR(); } }while(0)
  #define STEP(C0,C1,P0,P1,t,GK,GV,GL,SL) do{ SBAR(); \
    const lds_cptr vp_=vp0+2*sl_prev; \
    VRD(0); SBAR(); float sacc=(P0[0]+P0[1]); \
    GAPA(C0=__builtin_amdgcn_mfma_f32_32x32x16_bf16(kf[0],qr[0],zero16,0,0,0), P0[2],P0[3],P0[4],P0[5],     pw0[0]=PKW(P0,0), pw0[1]=PKW(P0,2), pw0); \
    VRD(4); SBAR(); GAPA(C1=__builtin_amdgcn_mfma_f32_32x32x16_bf16(kf[1],qr[0],zero16,0,0,0), P0[6],P0[7],P0[8],P0[9],     pw0[2]=PKW(P0,4), pw0[3]=PKW(P0,6), pw0); \
    VRD(1); SBAR(); GAPA(C0=__builtin_amdgcn_mfma_f32_32x32x16_bf16(kf[2],qr[1],C0,0,0,0),   P0[10],P0[11],P0[12],P0[13], pw1[0]=PKW(P0,8), pw1[1]=PKW(P0,10), pw1); \
    VRD(5); SBAR(); GAPA(C1=__builtin_amdgcn_mfma_f32_32x32x16_bf16(kf[3],qr[1],C1,0,0,0),   P0[14],P0[15],P1[0],P1[1],   pw1[2]=PKW(P0,12),pw1[3]=PKW(P0,14), pw1); \
    VRD(2); SBAR(); GAPA(C0=__builtin_amdgcn_mfma_f32_32x32x16_bf16(kf[4],qr[2],C0,0,0,0),   P1[2],P1[3],P1[4],P1[5],     pw2[0]=PKW(P1,0), pw2[1]=PKW(P1,2), pw2); \
    VRD(6); SBAR(); GAPA(C1=__builtin_amdgcn_mfma_f32_32x32x16_bf16(kf[5],qr[2],C1,0,0,0),   P1[6],P1[7],P1[8],P1[9],     pw2[2]=PKW(P1,4), pw2[3]=PKW(P1,6), pw2); \
    VRD(3); SBAR(); GAPA(C0=__builtin_amdgcn_mfma_f32_32x32x16_bf16(kf[6],qr[3],C0,0,0,0),   P1[10],P1[11],P1[12],P1[13], pw3[0]=PKW(P1,8), pw3[1]=PKW(P1,10), pw3); \
    VRD(7); SBAR(); GAPA(C1=__builtin_amdgcn_mfma_f32_32x32x16_bf16(kf[7],qr[3],C1,0,0,0),   P1[14],P1[15],0.f,0.f,       pw3[2]=PKW(P1,12),pw3[3]=PKW(P1,14), pw3); \
    l_reg+=sacc; \
    if(GK){DMA_K((t)+3,sl_cur);} if(GV){DMA_V((t)+1,sl_next);} \
    MODT(C0,C1,t,SL); \
    { float a=MX3(C0[0],C0[1],C1[0]),b=MX3(C0[2],C0[3],C1[1]); a=MX3(a,C1[2],C1[3]); \
      _Pragma("unroll") for(int r=4;r<16;r+=4){a=MX3(a,C0[r],C0[r+1]);b=MX3(b,C0[r+2],C0[r+3]);a=MX3(a,C1[r],C1[r+1]);b=MX3(b,C1[r+2],C1[r+3]);} \
      float rm=__builtin_fmaxf(a,b); { auto rr=__builtin_amdgcn_permlane32_swap(__float_as_uint(rm),__float_as_uint(rm),false,false); rm=__builtin_fmaxf(__uint_as_float(rr[0]),__uint_as_float(rr[1])); } \
      resc=false; \
      const float rmd=rm-mhat; \
      if(__builtin_expect(__any(rmd>64.f),0)){ const float dl=rmd>64.f?64.f*__builtin_floorf(rmd*0.015625f):0.f; mhat+=dl; hasref=true; \
        const float f=__builtin_amdgcn_exp2f(-dl); l_reg*=f; if(hi==0)wsf[r32]=f; resc=true; } \
      if(__builtin_expect(hasref,0)){ _Pragma("unroll") for(int r=0;r<16;++r){C0[r]-=mhat;C1[r]-=mhat;} } } \
    SBAR(); \
    WRD(0); GAPB2(o[0]=__builtin_amdgcn_mfma_f32_32x32x16_bf16(PAF(0),VFR(0),o[0],0,0,0), C0,0); \
    WRD(4); GAPB2(o[1]=__builtin_amdgcn_mfma_f32_32x32x16_bf16(PAF(0),VFR(4),o[1],0,0,0), C0,2); \
    WRD(1); GAPB2(o[0]=__builtin_amdgcn_mfma_f32_32x32x16_bf16(PAF(1),VFR(1),o[0],0,0,0), C0,4); \
    WRD(5); GAPB2(o[1]=__builtin_amdgcn_mfma_f32_32x32x16_bf16(PAF(1),VFR(5),o[1],0,0,0), C0,6); \
    WRD(2); GAPB2(o[0]=__builtin_amdgcn_mfma_f32_32x32x16_bf16(PAF(2),VFR(2),o[0],0,0,0), C0,8); \
    WRD(6); GAPB2(o[1]=__builtin_amdgcn_mfma_f32_32x32x16_bf16(PAF(2),VFR(6),o[1],0,0,0), C0,10); \
    WRD(3); GAPB2(o[0]=__builtin_amdgcn_mfma_f32_32x32x16_bf16(PAF(3),VFR(3),o[0],0,0,0), C0,12); \
    WRD(7); GAPB2(o[1]=__builtin_amdgcn_mfma_f32_32x32x16_bf16(PAF(3),VFR(7),o[1],0,0,0), C0,14); \
    KRD(GL,0); GAPB2(o[2]=__builtin_amdgcn_mfma_f32_32x32x16_bf16(PAF(0),WFR(0),o[2],0,0,0), C1,0); \
    KRD(GL,1); GAPB2(o[3]=__builtin_amdgcn_mfma_f32_32x32x16_bf16(PAF(0),WFR(4),o[3],0,0,0), C1,2); \
    KRD(GL,2); GAPB2(o[2]=__builtin_amdgcn_mfma_f32_32x32x16_bf16(PAF(1),WFR(1),o[2],0,0,0), C1,4); \
    KRD(GL,3); GAPB2(o[3]=__builtin_amdgcn_mfma_f32_32x32x16_bf16(PAF(1),WFR(5),o[3],0,0,0), C1,6); \
    GAPB2(o[2]=__builtin_amdgcn_mfma_f32_32x32x16_bf16(PAF(2),WFR(2),o[2],0,0,0), C1,8); \
    GAPB2(o[3]=__builtin_amdgcn_mfma_f32_32x32x16_bf16(PAF(2),WFR(6),o[3],0,0,0), C1,10); \
    GAPB2(o[2]=__builtin_amdgcn_mfma_f32_32x32x16_bf16(PAF(3),WFR(3),o[2],0,0,0), C1,12); \
    GAPB2(o[3]=__builtin_amdgcn_mfma_f32_32x32x16_bf16(PAF(3),WFR(7),o[3],0,0,0), C1,14); \
    }while(0)
  int t=1;
  #define ENDW(tt) do{ if((tt)+3<NT){WAIT_BAR(3);} else if((tt)+2<NT){WAIT_BAR(2);} else {WAIT_BAR(0);} }while(0)
  for(;t+(MODE==1?5:7)<NT;t+=2){
    STEP(pB0,pB1,pA0,pA1,t,true,true,true,false);     WAIT_BAR(3); RESC(); ROT();
    STEP(pA0,pA1,pB0,pB1,t+1,true,true,true,false);   WAIT_BAR(3); RESC(); ROT();
  }
  for(;t+1<NT;t+=2){
    STEP(pB0,pB1,pA0,pA1,t,(t+3<NT),(t+1<NT),(t+1<NT),true);       ENDW(t);   RESC(); ROT();
    STEP(pA0,pA1,pB0,pB1,t+1,(t+4<NT),(t+2<NT),(t+2<NT),true);     ENDW(t+1); RESC(); ROT();
  }
  STEP(pB0,pB1,pA0,pA1,NT-1,false,false,false,true); RESC();
  { float sacc=pB0[0]+pB0[1]; _Pragma("unroll") for(int r=2;r<16;++r)sacc+=pB0[r]; _Pragma("unroll") for(int r=0;r<16;++r)sacc+=pB1[r]; l_reg+=sacc;
    pw0=(u32x4){PKW(pB0,0),PKW(pB0,2),PKW(pB0,4),PKW(pB0,6)};pw1=(u32x4){PKW(pB0,8),PKW(pB0,10),PKW(pB0,12),PKW(pB0,14)};pw2=(u32x4){PKW(pB1,0),PKW(pB1,2),PKW(pB1,4),PKW(pB1,6)};pw3=(u32x4){PKW(pB1,8),PKW(pB1,10),PKW(pB1,12),PKW(pB1,14)};
    SBAR(); pv(o,vb0+2*sl_cur,PAF(0),PAF(1),PAF(2),PAF(3)); pv(o+2,vb0+2*sl_cur+8192,PAF(0),PAF(1),PAF(2),PAF(3)); }
  #undef PKW
  #undef PAF
  #undef VFR
  #undef PIN
  #undef MX3
  #undef GAPA
  #undef GAPB
  #undef EX
  #undef VRD
  #undef WRD
  #undef WFR
  #undef GAPB2
  #undef KRD
  #undef STEP
  #undef ENDW
  {auto rr=__builtin_amdgcn_permlane32_swap(__float_as_uint(l_reg),__float_as_uint(l_reg),false,false);l_reg=__uint_as_float(rr[0])+__uint_as_float(rr[1]);}
  if(hi==0)wsf[32+r32]=l_reg;asm volatile("s_waitcnt lgkmcnt(0)":::"memory");
  float rli[16];
  #pragma unroll
  for(int r=0;r<16;++r)rli[r]=__builtin_amdgcn_rcpf(wsf[32+crow(r,hi)]);
  bf16*Ow=O+(rowbase+q0+wid*QBLK)*DM+co;
  { bf16*stg=(bf16*)(shm+LDS_OST)+wid*2048;
    #pragma unroll
    for(int ps=0;ps<2;++ps){
      #pragma unroll
      for(int r=0;r<16;++r){const int orow=crow(r,hi);
        #pragma unroll
        for(int d0=0;d0<2;++d0)stg[orow*64+d0*32+r32]=__float2bfloat16(o[2*ps+d0][r]*rli[r]);}
      asm volatile("s_waitcnt lgkmcnt(0)":::"memory");
      #pragma unroll
      for(int i=0;i<4;++i){const int row=i*8+(lane>>3),ch=lane&7; const u32x4 v=*(const u32x4*)(stg+row*64+ch*8); ATTN_STORE16(Ow+(long)row*DM+ps*64+ch*8,v);}
      asm volatile("s_waitcnt lgkmcnt(0)":::"memory"); } }
  asm volatile("s_waitcnt lgkmcnt(0)\n\ts_barrier":::"memory");
  #undef DMA_K
  #undef DMA_V
  #undef MODT
  #undef START
  #undef RESC
  #undef ROT
}
constexpr int ATTN_LDS_BYTES=LDS_BYTES;
#undef SBAR
#undef WAIT_BAR
}
#define GAS __attribute__((address_space(1)))
#define LAS __attribute__((address_space(3)))
typedef unsigned short bf16;
typedef unsigned v4u __attribute__((ext_vector_type(4)));
typedef float f32x4 __attribute__((ext_vector_type(4)));
typedef short bf16x8 __attribute__((ext_vector_type(8)));
typedef GAS unsigned gu32;
typedef GAS unsigned long long gu64;
#define RLX_AGENT __ATOMIC_RELAXED, __HIP_MEMORY_SCOPE_AGENT
#define LDS_WAIT() asm volatile("s_waitcnt lgkmcnt(0)" ::: "memory")
#define VM_WAIT() asm volatile("s_waitcnt vmcnt(0)" ::: "memory")
__device__ __forceinline__ unsigned long long rt() { return __builtin_amdgcn_s_memrealtime(); }
__device__ __forceinline__ unsigned f2bf(float f) { unsigned u = __builtin_bit_cast(unsigned, f); return (u + 0x7fffu + ((u >> 16) & 1u)) >> 16; }
__device__ __forceinline__ unsigned pk2(float lo, float hi) { return f2bf(lo) | (f2bf(hi) << 16); }

#define XB_TMO      128
#define XB_XCNT(j)  (256  + 64 * (j))
#define XB_XSUB(j)  (1280 + 64 * (j))
#define XB_XGEN(j)  (2304 + 64 * (j))
#define XB_TOP      3328
#define XB_TOPGEN   3392
#define XCD_BAR_WORDS 3456
#define XB_SPIN_CAP (1u << 18)

__device__ __forceinline__ unsigned xb_ld(unsigned* p)              { return __hip_atomic_load(p, __ATOMIC_RELAXED, __HIP_MEMORY_SCOPE_AGENT); }
__device__ __forceinline__ unsigned xb_add(unsigned* p, unsigned v) { return __hip_atomic_fetch_add(p, v, __ATOMIC_RELAXED, __HIP_MEMORY_SCOPE_AGENT); }
__device__ __forceinline__ unsigned xb_xcc_id() { return (unsigned)__builtin_amdgcn_s_getreg((3 << 11) | 20) & 0xFu; }
#define XB_SPIN(cond, bar) do { unsigned _sp = 0; while (cond) { __builtin_amdgcn_s_sleep(1); \
    if ((++_sp & 255u) == 0u) { if (xb_ld(&(bar)[XB_TMO])) break; if (_sp > XB_SPIN_CAP) { atomicAdd(&(bar)[XB_TMO], 1u); break; } } } } while (0)

struct XcdBarrier {
    unsigned* bar; unsigned x;
    volatile LAS unsigned* st;
};

__device__ __forceinline__ XcdBarrier xcd_barrier_post(unsigned* bar, volatile LAS unsigned* st) {
    XcdBarrier b; b.bar = bar; b.x = xb_xcc_id(); b.st = st;
    if (threadIdx.x == 0) (void)xb_add(&bar[XB_XCNT(b.x)], 1u);
    return b;
}
__device__ __forceinline__ void xcd_barrier_complete(unsigned* bar, unsigned x, unsigned& nloc, unsigned& nx) {
    const unsigned G = gridDim.x * gridDim.y * gridDim.z;
    unsigned sum, cnt, mine, sp = 0u;
    for (;;) {
        sum = 0u; cnt = 0u; mine = 0u;
#pragma unroll
        for (unsigned j = 0; j < 16; ++j) { const unsigned c = xb_ld(&bar[XB_XCNT(j)]); sum += c; cnt += (c > 0u) ? 1u : 0u; mine = (j == x) ? c : mine; }
        if (sum == G) break;
        __builtin_amdgcn_s_sleep(1);
        if ((++sp & 255u) == 0u) { if (xb_ld(&bar[XB_TMO])) break; if (sp > XB_SPIN_CAP) { atomicAdd(&bar[XB_TMO], 1u); break; } }
    }
    nloc = mine > 0u ? mine : 1u; nx = cnt > 0u ? cnt : 1u;
}

__device__ __forceinline__ void xcd_barrier(const XcdBarrier& b) {
    asm volatile("s_waitcnt vmcnt(0)" ::: "memory");
    __syncthreads();
    if (threadIdx.x == 0) {
        unsigned* bar = b.bar;
        __builtin_amdgcn_s_waitcnt(0);
        unsigned nloc = b.st[0], nx = b.st[1];
        if (nloc == 0u) { xcd_barrier_complete(bar, b.x, nloc, nx); b.st[0] = nloc; b.st[1] = nx; }
        const unsigned old = xb_add(&bar[XB_XSUB(b.x)], 1u);
        const unsigned gen = old / nloc;
        if (old + 1u == (gen + 1u) * nloc) {
            __builtin_amdgcn_fence(__ATOMIC_RELEASE, "agent");
            asm volatile("s_waitcnt vmcnt(0)" ::: "memory");
            const unsigned og = xb_add(&bar[XB_TOP], 1u);
            const unsigned tg = og / nx;
            if (og + 1u == (tg + 1u) * nx) xb_add(&bar[XB_TOPGEN], 1u);
            else XB_SPIN(xb_ld(&bar[XB_TOPGEN]) == tg, bar);
            __builtin_amdgcn_fence(__ATOMIC_ACQUIRE, "agent");
            xb_add(&bar[XB_XGEN(b.x)], 1u);
            asm volatile("s_waitcnt vmcnt(0)" ::: "memory");
        } else {
            XB_SPIN(xb_ld(&bar[XB_XGEN(b.x)]) == gen, bar);
            __builtin_amdgcn_fence(__ATOMIC_ACQUIRE, "agent");
            asm volatile("s_waitcnt vmcnt(0)" ::: "memory");
        }
    }
    __syncthreads();
}

constexpr int NWAVES = 8;
#ifndef MK_PER_PHASE
#define MK_PER_PHASE 0
#endif
constexpr int N_PHASES = 16;

constexpr size_t MiB = 1u << 20;
constexpr size_t WS_CTL = 0, CTL_ZERO_BYTES = 1 * MiB;
constexpr size_t WS_GV = 1 * MiB + 512 * 1024;
constexpr size_t WS_HM = 2 * MiB;
constexpr size_t WS_TAB = 2 * MiB + 256 * 1024;
constexpr size_t WS_LF = 3 * MiB;
constexpr size_t WS_DK = 6 * MiB;
constexpr size_t WS_LIST = 9 * MiB;
constexpr int LCAP = NSLOT;
constexpr size_t WS_WQKV0 = 18 * MiB, WS_WO0 = 24 * MiB, WS_WQKV1 = 26 * MiB, WS_WO1 = 32 * MiB, WS_WGU = 34 * MiB, WS_WD = 98 * MiB;
constexpr size_t WS_XH = 130 * MiB;
constexpr size_t WS_Q = 195 * MiB;
constexpr size_t WS_K = 260 * MiB, WS_V = 325 * MiB;
constexpr size_t WS_O0 = 390 * MiB;
constexpr size_t WS_END = 455 * MiB;
static_assert(WS_LIST + (size_t)NEXP * LCAP * 4 <= WS_WQKV0 && WS_DK + (size_t)NBATCH * 16 * KROWS * 4 <= WS_LIST && WS_LF + (size_t)NRP * 16 * 4 <= WS_DK, "small arrays");
static_assert(WS_XH + (size_t)NRP * DM * 2 <= WS_Q && WS_Q + (size_t)NRP * DM * 2 <= WS_K && WS_K + (size_t)NBATCH * KROWS * DM * 2 <= WS_V && WS_V + (size_t)NBATCH * KROWS * DM * 2 <= WS_O0 && WS_O0 + (size_t)NRP * DM * 2 <= WS_END, "activations");
static_assert(WS_K + (size_t)NSLOT * DM * 2 <= WS_O0 && WS_O0 + (size_t)NSLOT * DEXP * 2 <= WS_END, "MoE overlays");
constexpr int CW_TMO = 0, CW_CODE = 1;
constexpr int CW_BAR = 4096;
constexpr int CW_QM = 131072, CW_KM = 147456, CW_QCTR = 148480;
constexpr int CW_CNT = 65536;
constexpr int RING_OFF = 0, RING_BYTES = 131072;
constexpr int ROWTAB_OFF = RING_BYTES, ROWTAB_UNITS = 12;
constexpr int MOEPRE_OFF = ROWTAB_OFF + ROWTAB_UNITS * 1024;
constexpr int MISC_OFF = MOEPRE_OFF + 512;
constexpr int LDS_BYTES = 147456;
static_assert(MISC_OFF + 128 <= LDS_BYTES && attn_body::ATTN_LDS_BYTES <= RING_BYTES, "LDS map");

struct Params {
    const float *x, *meta, *rel_bias, *w_qkv, *lam, *subln, *w_o, *fox_w_in, *fox_b_f, *fox_w_o, *ln_mix_g, *ln_mix_b, *ln_ffn_g, *ln_ffn_b, *rg_w, *rg_b, *re_w, *re_b, *w_gate, *w_up, *w_down;
    float* out; unsigned char* ws; int ph_lo, ph_hi, li, pad;
};
struct Ctx { int tid, lane, wave, vcu, G; LAS unsigned char* lds; };
__device__ __forceinline__ Ctx fresh(const Ctx& C) { Ctx r = C; int t = threadIdx.x; asm volatile("" : "+v"(t)); r.tid = t; r.lane = t & 63; r.wave = __builtin_amdgcn_readfirstlane(t >> 6); return r; }

using pg8::shx;
__device__ __forceinline__ float wave_sum(float v, int lane) {
#pragma unroll
    for (int o = 1; o < 64; o <<= 1) v += shx(v, o, lane);
    return v;
}
__device__ __forceinline__ float bf2f(unsigned short h) { return __uint_as_float((unsigned)h << 16); }
__device__ __forceinline__ float bflo(unsigned w) { return __uint_as_float(w << 16); }
__device__ __forceinline__ float bfhi(unsigned w) { return __uint_as_float(w & 0xffff0000u); }
__device__ __forceinline__ int meta_slot(int j) { return j; }

__device__ __forceinline__ void tr_item(const float* W, int ldw, int k0, int n0, bf16* WT, int ldt, int drow0, LAS float* scr, int lane) {
#pragma unroll 8
    for (int i = 0; i < 32; ++i) { const int kk = 2 * i + (lane >> 5); scr[kk * 33 + (lane & 31)] = W[(size_t)(k0 + kk) * ldw + n0 + (lane & 31)]; }
    LDS_WAIT(); asm volatile("" ::: "memory");
    const int c = lane & 7;
#pragma unroll
    for (int j = 0; j < 4; ++j) { const int n = (lane >> 3) + 8 * j; const LAS float* s = scr + (8 * c) * 33 + n;
        v4u o; o.x = pk2(s[0 * 33], s[1 * 33]); o.y = pk2(s[2 * 33], s[3 * 33]); o.z = pk2(s[4 * 33], s[5 * 33]); o.w = pk2(s[6 * 33], s[7 * 33]);
        *(GAS v4u*)(WT + (size_t)(drow0 + n) * ldt + k0 + 8 * c) = o; }
    LDS_WAIT(); asm volatile("" ::: "memory");
}
__device__ __forceinline__ void convert_experts(const Params& p, const Ctx& C, int layer, int first_item, int gw, int NGW) {
    LAS float* scr = (LAS float*)(C.lds + RING_OFF + C.wave * 16384);
    bf16* Wgu = (bf16*)(p.ws + WS_WGU); bf16* Wd = (bf16*)(p.ws + WS_WD);
    constexpr int PER_E = 768, NIT = NEXP * PER_E;
    for (int it = gw - first_item; it < NIT; it += NGW) { if (it < 0) continue;
        const int e = it / PER_E; int r = it % PER_E; const size_t eo = (size_t)(layer * NEXP + e);
        if (r < 512) { const bool up = r >= 256; r &= 255; const int kb = r >> 4, nb = r & 15, n0 = 32 * nb;
            tr_item((up ? p.w_up : p.w_gate) + eo * DM * DEXP, DEXP, 64 * kb, n0, Wgu + (size_t)e * DM * DM, DM, (n0 >> 7) * 256 + (n0 & 127) + (up ? 128 : 0), scr, C.lane); }
        else { r -= 512; const int kb = r >> 5, nb = r & 31;
            tr_item(p.w_down + eo * DEXP * DM, DM, 64 * kb, 32 * nb, Wd + (size_t)e * DM * DEXP, DEXP, 32 * nb, scr, C.lane); } }
}
__device__ __forceinline__ void p0_prologue(const Params& p, const Ctx& C) {
    LAS float* scr = (LAS float*)(C.lds + RING_OFF + C.wave * 16384);
    const int gw = C.vcu * NWAVES + C.wave, NGW = C.G * NWAVES;
    for (int it = gw; it < 4096; it += NGW) { int r = it;
        if (r < 1536) { tr_item(p.w_qkv, 3072, 64 * (r / 96), 32 * (r % 96), (bf16*)(p.ws + WS_WQKV0), DM, 32 * (r % 96), scr, C.lane); continue; } r -= 1536;
        if (r < 512) { tr_item(p.w_o, DM, 64 * (r >> 5), 32 * (r & 31), (bf16*)(p.ws + WS_WO0), DM, 32 * (r & 31), scr, C.lane); continue; } r -= 512;
        if (r < 1536) { tr_item(p.fox_w_in, 3088, 64 * (r / 96), 32 * (r % 96), (bf16*)(p.ws + WS_WQKV1), DM, 32 * (r % 96), scr, C.lane); continue; } r -= 1536;
        tr_item(p.fox_w_o, DM, 64 * (r >> 5), 32 * (r & 31), (bf16*)(p.ws + WS_WO1), DM, 32 * (r & 31), scr, C.lane); }
    convert_experts(p, C, 0, 0, gw, NGW);
    bf16* XH = (bf16*)(p.ws + WS_XH);
    for (int m = gw; m < NRP; m += NGW) {
        GAS unsigned long long* o8 = (GAS unsigned long long*)(XH + (size_t)m * DM) + C.lane;
        if (m < NR) { const GAS f32x4* xr = (const GAS f32x4*)(m < NREAL ? p.x + (size_t)m * DM : p.meta + (size_t)(m - NREAL) * DM) + C.lane;
#pragma unroll
            for (int j = 0; j < 4; ++j) { const f32x4 v = xr[64 * j]; o8[64 * j] = (unsigned long long)pk2(v.x, v.y) | ((unsigned long long)pk2(v.z, v.w) << 32); } }
        else {
#pragma unroll
            for (int j = 0; j < 4; ++j) o8[64 * j] = 0ull; } }
    { const int gt = C.vcu * (NWAVES * 64) + C.tid;
      if (gt < 16 * 128) { const int m = gt >> 7, d = gt & 127; int bk = d;
          if (d >= 16) { bk = 16 + (d >= 19) + (d >= 21) + (d >= 24) + (d >= 27) + (d >= 31) + (d >= 35) + (d >= 40) + (d >= 46) + (d >= 52) + (d >= 59) + (d >= 67) + (d >= 77) + (d >= 87) + (d >= 99) + (d >= 113); }
          ((float*)(p.ws + WS_TAB))[gt] = (p.rel_bias[bk * 16 + m] - p.rel_bias[31 * 16 + m]) * LOG2E; } }
}

__device__ __forceinline__ float diff_lambda_full(const Params& p, int lane) {
    const float a = p.lam[lane] * p.lam[64 + lane], b = p.lam[128 + lane] * p.lam[192 + lane];
    return __expf(wave_sum(a, lane)) - __expf(wave_sum(b, lane)) + LAMBDA_INIT0;
}
__device__ __forceinline__ void combine_rows(const Params& p, const Ctx& C, int b, int h, int qb, float lam) {
    const int lane = C.lane;
    const bf16* O0 = (const bf16*)(p.ws + WS_O0); const bf16* O1 = (const bf16*)p.out; bf16* OA = (bf16*)(p.ws + WS_Q);
    float sw[8];
#pragma unroll
    for (int c = 0; c < 8; ++c) sw[c] = p.subln[8 * (lane & 15) + c] * (1.f - LAMBDA_INIT0);
    asm volatile("s_waitcnt vmcnt(0)" ::: "memory");
#pragma unroll 2
    for (int i = 0; i < 8; ++i) { const size_t off = (size_t)(b * SEQ + 256 * qb + 32 * C.wave + 4 * i + (lane >> 4)) * DM + h * 128 + 8 * (lane & 15);
        const v4u a = *(const GAS v4u*)(O0 + off), bq = *(const GAS v4u*)(O1 + off);
        float dd[8]; const unsigned aw[4] = {a.x, a.y, a.z, a.w}, bw[4] = {bq.x, bq.y, bq.z, bq.w}; float ss = 0.f;
#pragma unroll
        for (int c = 0; c < 4; ++c) { dd[2 * c] = bflo(aw[c]) - lam * bflo(bw[c]); dd[2 * c + 1] = bfhi(aw[c]) - lam * bfhi(bw[c]); ss += dd[2 * c] * dd[2 * c] + dd[2 * c + 1] * dd[2 * c + 1]; }
        ss += shx(ss, 1, lane); ss += shx(ss, 2, lane); ss += shx(ss, 4, lane); ss += shx(ss, 8, lane);
        const float rs = 1.f / sqrtf(ss * (1.f / 128.f) + LN_EPS);
        v4u o; o.x = pk2(dd[0] * rs * sw[0], dd[1] * rs * sw[1]); o.y = pk2(dd[2] * rs * sw[2], dd[3] * rs * sw[3]); o.z = pk2(dd[4] * rs * sw[4], dd[5] * rs * sw[5]); o.w = pk2(dd[6] * rs * sw[6], dd[7] * rs * sw[7]);
        *(GAS v4u*)(OA + off) = o; }
}
__device__ __forceinline__ void diff_meta_attn(const Params& p, const Ctx& C, float lam) {
    const int gw = C.vcu * NWAVES + C.wave, lane = C.lane; bf16* OA = (bf16*)(p.ws + WS_Q);
    if (gw < 128) { const int h = gw >> 4, j = gw & 15, kj = lane & 15, s = (lane >> 4) & 1, m = 2 * h + s;
        const bf16* Q = (const bf16*)(p.ws + WS_Q); const bf16* K = (const bf16*)(p.ws + WS_K); const bf16* V = (const bf16*)(p.ws + WS_V);
        const bf16* qp = Q + (size_t)(NREAL + j) * DM + m * 64; const bf16* kp = K + (size_t)meta_slot(kj) * DM + m * 64;
        float dot = 0.f;
#pragma unroll
        for (int c = 0; c < 8; ++c) { const v4u qa = *(const GAS v4u*)(qp + 8 * c), ka = *(const GAS v4u*)(kp + 8 * c); const unsigned qw[4] = {qa.x, qa.y, qa.z, qa.w}, kw[4] = {ka.x, ka.y, ka.z, ka.w};
#pragma unroll
            for (int e = 0; e < 4; ++e) dot += bflo(qw[e]) * bflo(kw[e]) + bfhi(qw[e]) * bfhi(kw[e]); }
        float sc = (kj <= j) ? dot + p.rel_bias[(j - kj) * 16 + m] * LOG2E : -INFINITY;
        float mx = sc; mx = fmaxf(mx, shx(mx, 1, lane)); mx = fmaxf(mx, shx(mx, 2, lane)); mx = fmaxf(mx, shx(mx, 4, lane)); mx = fmaxf(mx, shx(mx, 8, lane));
        float pe = __builtin_amdgcn_exp2f(sc - mx); float l = pe; l += shx(l, 1, lane); l += shx(l, 2, lane); l += shx(l, 4, lane); l += shx(l, 8, lane);
        pe /= l;
        const float a = pe - lam * shx(pe, 16, lane);
        float o0 = 0.f, o1 = 0.f;
        for (int k2 = 0; k2 <= j; ++k2) { const float ak = __builtin_amdgcn_readlane(a, k2); const unsigned vw = *(const GAS unsigned*)(V + (size_t)meta_slot(k2) * DM + h * 128 + 2 * lane); o0 += ak * bflo(vw); o1 += ak * bfhi(vw); }
        const float ss = wave_sum(o0 * o0 + o1 * o1, lane); const float rs = 1.f / sqrtf(ss * (1.f / 128.f) + LN_EPS);
        const float w0 = p.subln[2 * lane] * (1.f - LAMBDA_INIT0), w1 = p.subln[2 * lane + 1] * (1.f - LAMBDA_INIT0);
        *(GAS unsigned*)(OA + (size_t)(NREAL + j) * DM + h * 128 + 2 * lane) = pk2(o0 * rs * w0, o1 * rs * w1); }
}
__device__ __forceinline__ void fox_meta_attn(const Params& p, const Ctx& C) {
    const int gw = C.vcu * NWAVES + C.wave, lane = C.lane;
    if (gw < 256) { const int h = gw >> 4, j = gw & 15, kj = lane & 15;
        bf16* Q = (bf16*)(p.ws + WS_Q); const bf16* K = (const bf16*)(p.ws + WS_K); const bf16* V = (const bf16*)(p.ws + WS_V); const float* DK = (const float*)(p.ws + WS_DK) + (size_t)h * KROWS;
        const bf16* qp = Q + (size_t)(NREAL + j) * DM + h * 64; const bf16* kp = K + (size_t)meta_slot(kj) * DM + h * 64;
        float dot = 0.f;
#pragma unroll
        for (int c = 0; c < 8; ++c) { const v4u qa = *(const GAS v4u*)(qp + 8 * c), ka = *(const GAS v4u*)(kp + 8 * c); const unsigned qw[4] = {qa.x, qa.y, qa.z, qa.w}, kw[4] = {ka.x, ka.y, ka.z, ka.w};
#pragma unroll
            for (int e = 0; e < 4; ++e) dot += bflo(qw[e]) * bflo(kw[e]) + bfhi(qw[e]) * bfhi(kw[e]); }
        float sc = (kj <= j) ? dot + DK[meta_slot(kj)] - DK[meta_slot(j)] : -INFINITY;
        float mx = sc; mx = fmaxf(mx, shx(mx, 1, lane)); mx = fmaxf(mx, shx(mx, 2, lane)); mx = fmaxf(mx, shx(mx, 4, lane)); mx = fmaxf(mx, shx(mx, 8, lane));
        float pe = __builtin_amdgcn_exp2f(sc - mx); float l = pe; l += shx(l, 1, lane); l += shx(l, 2, lane); l += shx(l, 4, lane); l += shx(l, 8, lane);
        pe /= l;
        float o = 0.f;
        for (int k2 = 0; k2 <= j; ++k2) { const float ak = __builtin_amdgcn_readlane(pe, k2); o += ak * bf2f(V[(size_t)meta_slot(k2) * DM + h * 64 + lane]); }
        ((bf16*)(p.ws + WS_O0))[(size_t)(NREAL + j) * DM + h * 64 + lane] = (bf16)f2bf(o); }
}

typedef float f32x4m __attribute__((ext_vector_type(4)));
template <int KIND> __device__ __forceinline__ void ln_phase(const Params& p, const Ctx& C, int layer) {
    constexpr int NCB = (KIND == 0) ? 3 : (KIND == 1 ? 1 : 0), NC = 16 * (NCB ? NCB : 1);
    constexpr int AT_PITCH = 1028;
    const int tid = C.tid, lane = C.lane, wave = C.wave;
    LAS float* At = (LAS float*)(C.lds + RING_OFF);
    LAS float* part = (LAS float*)(C.lds + RING_OFF + 65792);
    LAS float* logit = (LAS float*)(C.lds + RING_OFF + 90368);
    LAS int* sl_e = (LAS int*)(C.lds + RING_OFF + 93440);
    LAS int* cnt_l = (LAS int*)(C.lds + RING_OFF + 94720);
    const float* gsrc = (KIND == 0 ? p.ln_mix_g : p.ln_ffn_g) + layer * DM; const float* bsrc = (KIND == 0 ? p.ln_mix_b : p.ln_ffn_b) + layer * DM;
    f32x4 gv[4], bv[4];
#pragma unroll
    for (int j = 0; j < 4; ++j) { gv[j] = *(const GAS f32x4*)(gsrc + 4 * lane + 256 * j); bv[j] = *(const GAS f32x4*)(bsrc + 4 * lane + 256 * j); }
    float Bf[NCB ? NCB : 1][8][4];
    if constexpr (NCB > 0) { const int kq = lane >> 4, col = lane & 15;
#pragma unroll
        for (int cb = 0; cb < NCB; ++cb)
#pragma unroll
            for (int g = 0; g < 8; ++g)
#pragma unroll
                for (int c = 0; c < 4; ++c) { const int k = 128 * wave + 16 * g + 4 * kq + c, cc = cb * 16 + col; float w;
                    if (KIND == 0) w = cc < 4 ? p.rg_w[((size_t)layer * DM + k) * 4 + cc] : (cc < 36 ? p.re_w[((size_t)layer * DM + k) * 32 + (cc - 4)] : 0.f);
                    else w = p.fox_w_in[(size_t)k * 3088 + 3072 + cc];
                    Bf[cb][g][c] = w; } }
    if (KIND == 0) { if (tid < 96) cnt_l[tid] = 0; }
    bf16* XH = (bf16*)(p.ws + WS_XH); const bf16* Y = (const bf16*)(p.ws + WS_K);
    constexpr int NTILES = NR / 16;
    int it = 0;
    for (int tile = C.vcu; tile < NTILES; tile += C.G, ++it) {
        unsigned long long vv[2][4]; unsigned long long yy[2][2][4];
#pragma unroll
        for (int rr = 0; rr < 2; ++rr) { const int row = tile * 16 + wave * 2 + rr;
#pragma unroll
            for (int j = 0; j < 4; ++j) vv[rr][j] = *((const GAS unsigned long long*)(XH + (size_t)row * DM) + lane + 64 * j);
            if (KIND != 0) {
#pragma unroll
                for (int j = 0; j < 4; ++j) { yy[rr][0][j] = *(const GAS unsigned long long*)(Y + (size_t)(2 * row) * DM + 4 * lane + 256 * j); yy[rr][1][j] = *(const GAS unsigned long long*)(Y + (size_t)(2 * row + 1) * DM + 4 * lane + 256 * j); } } }
#pragma unroll
        for (int rr = 0; rr < 2; ++rr) { const int rl = wave * 2 + rr, row = tile * 16 + rl;
            f32x4 v[4];
#pragma unroll
            for (int j = 0; j < 4; ++j) { const unsigned h0 = (unsigned)vv[rr][j], h1 = (unsigned)(vv[rr][j] >> 32); v[j] = (f32x4){bflo(h0), bfhi(h0), bflo(h1), bfhi(h1)}; }
            if (KIND != 0) {
#pragma unroll
                for (int j = 0; j < 4; ++j) { const unsigned long long y0 = yy[rr][0][j], y1 = yy[rr][1][j];
                    const unsigned a0 = (unsigned)y0, a1 = (unsigned)(y0 >> 32), b0 = (unsigned)y1, b1 = (unsigned)(y1 >> 32);
                    v[j].x = v[j].x * ALPHA + (bflo(a0) + bflo(b0)); v[j].y = v[j].y * ALPHA + (bfhi(a0) + bfhi(b0)); v[j].z = v[j].z * ALPHA + (bflo(a1) + bflo(b1)); v[j].w = v[j].w * ALPHA + (bfhi(a1) + bfhi(b1)); } }
            float s = 0.f;
#pragma unroll
            for (int j = 0; j < 4; ++j) s += (v[j].x + v[j].y) + (v[j].z + v[j].w);
            const float mean = wave_sum(s, lane) * (1.f / DM); float s2 = 0.f;
#pragma unroll
            for (int j = 0; j < 4; ++j) { v[j] = v[j] - mean; s2 += (v[j].x * v[j].x + v[j].y * v[j].y) + (v[j].z * v[j].z + v[j].w * v[j].w); }
            const float rstd = 1.f / sqrtf(wave_sum(s2, lane) * (1.f / DM) + LN_EPS);
#pragma unroll
            for (int j = 0; j < 4; ++j) v[j] = v[j] * rstd * gv[j] + bv[j];
            if (KIND == 2) { if (row < NREAL) {
#pragma unroll
                for (int j = 0; j < 4; ++j) *(GAS f32x4*)(p.out + (size_t)row * DM + 4 * lane + 256 * j) = v[j]; } }
            else {
#pragma unroll
                for (int j = 0; j < 4; ++j) {
                    *((GAS unsigned long long*)(XH + (size_t)row * DM) + lane + 64 * j) = (unsigned long long)pk2(v[j].x, v[j].y) | ((unsigned long long)pk2(v[j].z, v[j].w) << 32);
                    *(LAS f32x4*)(At + rl * AT_PITCH + 4 * lane + 256 * j) = v[j]; } } }
        if constexpr (NCB > 0) {
            __syncthreads();
            f32x4m acc[NCB];
#pragma unroll
            for (int cb = 0; cb < NCB; ++cb) acc[cb] = (f32x4m){0.f, 0.f, 0.f, 0.f};
#pragma unroll
            for (int g = 0; g < 8; ++g) { const f32x4 a4 = *(const LAS f32x4*)(At + (lane & 15) * AT_PITCH + 128 * wave + 16 * g + 4 * (lane >> 4));
#pragma unroll
                for (int c = 0; c < 4; ++c)
#pragma unroll
                    for (int cb = 0; cb < NCB; ++cb) acc[cb] = __builtin_amdgcn_mfma_f32_16x16x4f32(a4[c], Bf[cb][g][c], acc[cb], 0, 0, 0); }
#pragma unroll
            for (int cb = 0; cb < NCB; ++cb)
#pragma unroll
                for (int r = 0; r < 4; ++r) part[(wave * 16 + 4 * (lane >> 4) + r) * 48 + cb * 16 + (lane & 15)] = acc[cb][r];
            __syncthreads();
            for (int idx = tid; idx < 16 * NC; idx += NWAVES * 64) { const int rw = idx / NC, cl = idx % NC; float sacc = 0.f;
#pragma unroll
                for (int w = 0; w < 8; ++w) sacc += part[(w * 16 + rw) * 48 + cl];
                logit[rw * 48 + cl] = sacc; }
            __syncthreads();
            if (KIND == 0) { if (tid < 16) { const int row = tile * 16 + tid; const LAS float* lg = logit + tid * 48;
                float gl[4]; int gs = 0;
#pragma unroll
                for (int i = 0; i < 4; ++i) gl[i] = lg[i] + p.rg_b[layer * 4 + i];
#pragma unroll
                for (int i = 1; i < 4; ++i) if (gl[i] > gl[gs]) gs = i;
                float den = 0.f;
#pragma unroll
                for (int i = 0; i < 4; ++i) den += __expf(gl[i] - gl[gs]);
                const float pg = 1.f / den;
                float el[8];
#pragma unroll
                for (int i = 0; i < 8; ++i) el[i] = lg[4 + gs * 8 + i] + p.re_b[layer * 32 + gs * 8 + i];
                int i0 = 0;
#pragma unroll
                for (int i = 1; i < 8; ++i) if (el[i] > el[i0]) i0 = i;
                int i1 = (i0 == 0) ? 1 : 0;
#pragma unroll
                for (int i = 0; i < 8; ++i) if (i != i0 && el[i] > el[i1]) i1 = i;
                const float ex = __expf(el[i1] - el[i0]); const float w0 = 1.f / (1.f + ex), w1 = ex * w0;
                float* GVp = (float*)(p.ws + WS_GV); GVp[2 * row] = pg * w0; GVp[2 * row + 1] = pg * w1;
                sl_e[it * 32 + 2 * tid] = gs * 8 + i0; sl_e[it * 32 + 2 * tid + 1] = gs * 8 + i1; } }
            else { if (tid < 256) { const int rw = tid >> 4, hh = tid & 15; const float vv = logit[rw * 48 + hh] + p.fox_b_f[hh];
                ((float*)(p.ws + WS_LF))[(size_t)(tile * 16 + rw) * 16 + hh] = fminf(vv, 0.f) - __builtin_amdgcn_logf(1.f + __builtin_amdgcn_exp2f(-fabsf(vv) * LOG2E)) * 0.69314718056f;   } }
        }
    }
    if (KIND == 0) {
        gu32* CNT = (gu32*)(p.ws + WS_CTL) + CW_CNT + layer * 2048; int* LIST = (int*)(p.ws + WS_LIST);
        __syncthreads();
        const int nloc = it * 32;
        for (int s = tid; s < nloc; s += NWAVES * 64) atomicAdd((int*)&cnt_l[sl_e[s]], 1);
        __syncthreads();
        if (tid < 32) { const int n = cnt_l[tid]; cnt_l[32 + tid] = n > 0 ? (int)__hip_atomic_fetch_add(CNT + 64 * tid, (unsigned)n, RLX_AGENT) : 0; cnt_l[64 + tid] = 0; }
        __syncthreads();
        for (int s = tid; s < nloc; s += NWAVES * 64) { const int e = sl_e[s]; const int pos = cnt_l[32 + e] + atomicAdd((int*)&cnt_l[64 + e], 1);
            const int tl = C.vcu + (s >> 5) * C.G; LIST[(size_t)e * LCAP + pos] = 2 * (tl * 16 + ((s & 31) >> 1)) + (s & 1); }
    }
    __syncthreads();
}

__device__ __forceinline__ void cumsum_job(const Params& p, const Ctx& C) {
    if (C.vcu >= 64) return;
    const int b = C.vcu >> 4, h = C.vcu & 15, tid = C.tid, lane = C.lane, wave = C.wave;
    const float* LF = (const float*)(p.ws + WS_LF); float* DK = (float*)(p.ws + WS_DK) + (size_t)(b * 16 + h) * KROWS;
    LAS float* wt = (LAS float*)(C.lds + RING_OFF);
    float cm = 0.f, mine = 0.f; const int myj = (tid < NMETA) ? tid : -1;
    for (int i = 0; i < NMETA; ++i) { cm += LF[(size_t)(NREAL + i) * 16 + h]; if (i == myj) mine = cm; }
    if (tid < KPRE) DK[tid] = (myj >= 0) ? -mine * LOG2E : 0.f;
    if (tid < 64) DK[KPRE + SEQ + tid] = 0.f;
    const float* lp = LF + (size_t)(b * SEQ + tid * 16) * 16 + h;
    float run = 0.f;
#pragma unroll 1
    for (int i = 0; i < 16; ++i) run += lp[i * 16];
    float inc = run;
#pragma unroll
    for (int o = 1; o < 64; o <<= 1) { const float t = __uint_as_float((unsigned)__builtin_amdgcn_ds_bpermute((lane - o) << 2, (int)__float_as_uint(inc))); if (lane >= o) inc += t; }
    if (lane == 63) wt[wave] = inc;
    __syncthreads();
    float base = cm;
    for (int w = 0; w < wave; ++w) base += wt[w];
    base += inc - run;
#pragma unroll 1
    for (int i = 0; i < 16; ++i) { base += lp[i * 16]; DK[KPRE + tid * 16 + i] = -base * LOG2E; }
    __syncthreads();
}

template <int KIND> __device__ __forceinline__ void meta_proj(const Params& p, const Ctx& C, const bf16* A, const bf16* Wt, int ntasks, unsigned* km) {
    if (C.wave != 0 || C.vcu >= ntasks) return;
    typedef float f32x4m_ __attribute__((ext_vector_type(4)));
    const int lane = C.lane, j = lane & 15, kq = lane >> 4, c0 = 16 * C.vcu;
    const GAS v4u* ap = (const GAS v4u*)(A + (size_t)(NREAL + j) * DM + 8 * kq); const GAS v4u* bp = (const GAS v4u*)(Wt + (size_t)(c0 + j) * DM + 8 * kq);
    f32x4m_ acc = {0.f, 0.f, 0.f, 0.f};
#pragma unroll 8
    for (int ks = 0; ks < 32; ++ks) { const v4u a = ap[4 * ks], b = bp[4 * ks];
        acc = __builtin_amdgcn_mfma_f32_16x16x32_bf16(__builtin_bit_cast(bf16x8, a), __builtin_bit_cast(bf16x8, b), acc, 0, 0, 0); }
    const int c = c0 + j;
    if (KIND == 0) { const int t = c >> 10, cc = c & 1023; bf16* Qb = (bf16*)(p.ws + WS_Q); bf16* kvb = (bf16*)(p.ws + (t == 1 ? WS_K : WS_V));
#pragma unroll
        for (int r = 0; r < 4; ++r) { const int i = 4 * kq + r; if (t == 0) Qb[(size_t)(NREAL + i) * DM + cc] = (bf16)f2bf(acc[r] * attn_body::C2); else kvb[(size_t)i * DM + cc] = (bf16)f2bf(acc[r]); }
        if (km != nullptr && t == 1) {
#pragma unroll
            for (int r = 0; r < 4; ++r) { float ss = acc[r] * acc[r]; ss += shx(ss, 1, lane); ss += shx(ss, 2, lane); ss += shx(ss, 4, lane); ss += shx(ss, 8, lane);
                float mx = ss; mx = fmaxf(mx, shx(mx, 16, lane)); mx = fmaxf(mx, shx(mx, 32, lane));
                acc[r] = mx; }
            const float m4 = fmaxf(fmaxf(acc[0], acc[1]), fmaxf(acc[2], acc[3]));
            if (lane == 0) { const int head = cc >> 6, quarter = (cc >> 4) & 3;
                for (int b = 0; b < NBATCH; ++b) atomicMax(km + ((size_t)b * 16 + head) * 8 + 2 + quarter, __float_as_uint(m4)); } } }
    else { bf16* H = (bf16*)(p.ws + WS_XH);
#pragma unroll
        for (int r = 0; r < 4; ++r) { const size_t o = (size_t)(NREAL + 4 * kq + r) * DM + c; H[o] = (bf16)f2bf(acc[r] + ALPHA * bf2f(H[o])); } }
}

struct MoeOrder {
    int G, c, UT; const LAS int* pre; const char* A; const char* W; size_t wexp, tsB;
    __device__ __forceinline__ bool next(int i, pg8::Unit& u) const {
        const int g = i * G + c; if (g >= UT || i >= ROWTAB_UNITS) return false;
        const int rt = g >> 2; int e = 0; while (pre[e + 1] <= rt) ++e;
        u.pm = rt - pre[e]; u.pn = g & 3; u.A = A; u.B = W + (size_t)e * wexp + (size_t)u.pn * tsB; u.tab = i; u.e = e; return true;
    }
};
__device__ __forceinline__ int moe_setup(const Params& p, const Ctx& C, int layer, MoeOrder& S) {
    LAS int* pre = (LAS int*)(C.lds + MOEPRE_OFF); LAS int* cnts = pre + 40; LAS int* rowtab = (LAS int*)(C.lds + ROWTAB_OFF);
    const gu32* CNT = (const gu32*)(p.ws + WS_CTL) + CW_CNT + layer * 2048;
    if (C.tid < 32) cnts[C.tid] = (int)__hip_atomic_load(CNT + 64 * C.tid, RLX_AGENT);
    __syncthreads();
    if (C.tid == 0) { int a = 0; for (int e = 0; e < NEXP; ++e) { pre[e] = a; a += (cnts[e] + 255) >> 8; } pre[NEXP] = a; }
    __syncthreads();
    S.pre = pre; S.UT = 4 * pre[NEXP];
    const int* LIST = (const int*)(p.ws + WS_LIST);
    pg8::Unit u;
    for (int i = 0; S.next(i, u); ++i) { if (C.tid < 256) { const int idx = 256 * u.pm + C.tid; rowtab[i * 256 + C.tid] = idx < cnts[u.e] ? LIST[(size_t)u.e * LCAP + idx] : -1; } }
    __syncthreads();
    return S.UT;
}

__global__ void __launch_bounds__(NWAVES * 64, 2) trunk_fwd(Params p) {
    extern __shared__ __attribute__((aligned(16))) unsigned char lds[];
    Ctx C;
    C.lds = (LAS unsigned char*)lds; C.tid = threadIdx.x; C.lane = C.tid & 63; C.wave = __builtin_amdgcn_readfirstlane(C.tid >> 6);
    C.G = gridDim.x; { const int bx = blockIdx.x; C.vcu = (C.G % 8 == 0) ? (bx % 8) * (C.G / 8) + bx / 8 : bx; }
    volatile LAS unsigned* MISC = (volatile LAS unsigned*)(C.lds + MISC_OFF);
    gu32* ctl = (gu32*)(p.ws + WS_CTL);
    if (C.tid < 32) MISC[C.tid] = 0u;
    __syncthreads();
    XcdBarrier bar; bar.bar = (unsigned*)(ctl + CW_BAR) + p.li * XCD_BAR_WORDS; bar.x = 0; bar.st = nullptr;
    if (!MK_PER_PHASE) bar = xcd_barrier_post((unsigned*)(ctl + CW_BAR) + p.li * XCD_BAR_WORDS, MISC + 8);
#define GRID_BAR() do { if (MK_PER_PHASE) { if (C.tid == 0) __hip_atomic_store(ctl + CW_TMO, 0xBADBA0u, RLX_AGENT); } else { xcd_barrier(bar); } } while (0)
    const int lo = p.ph_lo, hi = p.ph_hi;
#ifndef SUBMASK
#define SUBMASK 0x7f
#endif
#ifndef REP_MASK
#define REP_MASK 0
#endif
#define NREP(k) (((REP_MASK >> (k)) & 1) ? 2 : 1)
#ifndef PHASE_MASK
#define PHASE_MASK 0xffff
#endif
#define IN(k) (((PHASE_MASK >> (k)) & 1) && lo <= (k) && (k) < hi)
#define SEAM(k) do { if (IN(k) && IN((k) + 1)) GRID_BAR(); } while (0)
    bf16* XH = (bf16*)(p.ws + WS_XH); bf16* QB = (bf16*)(p.ws + WS_Q); bf16* KB = (bf16*)(p.ws + WS_K); bf16* VB = (bf16*)(p.ws + WS_V);
    bf16* O0 = (bf16*)(p.ws + WS_O0); bf16* O1 = (bf16*)p.out;
    const LAS int* rowtab = (const LAS int*)(C.lds + ROWTAB_OFF);

    if (IN(0)) { for (int rep_ = 0; rep_ < NREP(0); ++rep_) p0_prologue(p, fresh(C)); } SEAM(0);

    { constexpr int layer = 0;
        const int pb = 1 + (layer ? 8 : 0);
        if ((SUBMASK & 1) && IN(pb)) { for (int rep_ = 0; rep_ < NREP(pb); ++rep_) {
            if (layer == 1) cumsum_job(p, fresh(C));
            meta_proj<0>(p, fresh(C), XH, (const bf16*)(p.ws + (layer ? WS_WQKV1 : WS_WQKV0)), 3 * DM / 16, layer ? (unsigned*)(ctl + CW_KM) : nullptr);
            pg8::StaticOrder S; S.init(NREAL, 3 * DM, C.G, (int)blockIdx.x, XH, DM * 2, p.ws + (layer ? WS_WQKV1 : WS_WQKV0), DM * 2);
            pg8::EpiQKV E{QB, KB, VB, attn_body::C2, layer ? (unsigned*)(ctl + CW_QM) : nullptr, (unsigned*)(ctl + CW_KM)};
            pg8::gemm_phase<pg8::EpiQKV, pg8::StaticOrder, true, false>(C.lds + RING_OFF, DM, DM * 2, S, E, rowtab, 0);
        } } SEAM(pb);
        if (layer == 0) {
            if (IN(2)) { for (int rep_ = 0; rep_ < NREP(2); ++rep_) {
                const float* TAB = (const float*)(p.ws + WS_TAB);
                const float lam = diff_lambda_full(p, fresh(C).lane);
                for (int it = C.vcu; it < NBATCH * 8 * 16; it += C.G) { const int bh = it >> 4, s = it & 15, b = bh >> 3, h = bh & 7;
#pragma unroll 1
                    for (int w = 0; w < 2; ++w) { const int qb = w ? s : 31 - s;
#pragma unroll 1
                        for (int mm = 0; mm < 2; ++mm) attn_body::attn_unit_dv<8>(b, qb, (2 * h + mm) * 64, h * 128, h * 128, (const attn_body::bf16*)QB, (const attn_body::bf16*)KB, (const attn_body::bf16*)VB, (attn_body::bf16*)(mm ? O1 : O0), TAB + (2 * h + mm) * 128, (char*)lds + RING_OFF);
                        combine_rows(p, fresh(C), b, h, qb, lam); } }
                diff_meta_attn(p, fresh(C), lam);
            } } SEAM(2);
        } else {
            if (IN(10)) { for (int rep_ = 0; rep_ < NREP(10); ++rep_) {
                const float* DK = (const float*)(p.ws + WS_DK);
                for (;;) {
                    const int lane_ = fresh(C).lane;
                    int tko = MOEPRE_OFF; asm volatile("" : "+s"(tko)); LAS int* tk = (LAS int*)(C.lds + tko);
                    if (fresh(C).tid == 0) tk[0] = (int)__hip_atomic_fetch_add(ctl + CW_QCTR + 64 * rep_, 1u, RLX_AGENT);
                    __syncthreads(); const int u = tk[0]; __syncthreads();
                    if (u >= NBATCH * 16 * 32) break;
                    const int qb = 31 - (u >> 6), bh = u & 63, b = bh >> 4, h = bh & 15;
                    const float* dk = DK + (size_t)bh * KROWS;
                    const unsigned qmb = lane_ < 8 ? __hip_atomic_load(ctl + CW_QM + ((size_t)(b * 32 + qb) * 16 + h) * 8 + lane_, RLX_AGENT) : 0u;
                    const unsigned kmb = lane_ < 8 ? __hip_atomic_load(ctl + CW_KM + ((size_t)bh) * 8 + lane_, RLX_AGENT) : 0u;
                    const int ntf = 4 * qb + 6;
                    float e0 = lane_ < ntf ? dk[lane_ == 0 ? NMETA - 1 : 64 * lane_ + 63] : 0.f, e1 = lane_ + 64 < ntf ? dk[64 * (lane_ + 64) + 63] : 0.f, e2 = lane_ + 128 < ntf ? dk[64 * (lane_ + 128) + 63] : 0.f;
                    const float q2 = wave_sum(__uint_as_float(qmb), lane_), k2 = fmaxf(wave_sum(lane_ < 2 ? __uint_as_float(kmb) : 0.f, lane_), wave_sum(lane_ >= 2 ? __uint_as_float(kmb) : 0.f, lane_));
                    const float thr = dk[KPRE + 256 * qb] - 40.f - 2.1f * sqrtf(q2 * k2);
                    const unsigned long long m0 = __ballot(lane_ < ntf && e0 >= thr), m1 = __ballot(lane_ + 64 < ntf && e1 >= thr), m2 = __ballot(lane_ + 128 < ntf && e2 >= thr);
                    int tb = m0 ? __builtin_ctzll(m0) : (m1 ? 64 + __builtin_ctzll(m1) : (m2 ? 128 + __builtin_ctzll(m2) : ntf - 6));
                    tb &= ~1; tb = tb > ntf - 6 ? ntf - 6 : tb; tb = __builtin_amdgcn_readfirstlane(tb);
                    attn_body::attn_unit<1, 8>(b, qb, tb, h * 64, h * 64, h * 64, (const attn_body::bf16*)QB, (const attn_body::bf16*)KB, (const attn_body::bf16*)VB, (attn_body::bf16*)O0, dk, (char*)lds + RING_OFF);
                }
                fox_meta_attn(p, fresh(C));
            } } SEAM(10);
        }
        const int pw = layer ? 11 : 4;
        if ((SUBMASK & 4) && IN(pw)) { for (int rep_ = 0; rep_ < NREP(pw); ++rep_) {
            meta_proj<1>(p, fresh(C), layer ? O0 : QB, (const bf16*)(p.ws + (layer ? WS_WO1 : WS_WO0)), DM / 16, nullptr);
            pg8::StaticOrder S; S.init(NREAL, DM, C.G, (int)blockIdx.x, layer ? O0 : QB, DM * 2, p.ws + (layer ? WS_WO1 : WS_WO0), DM * 2);
            pg8::EpiZ E{XH};
            pg8::gemm_phase<pg8::EpiZ, pg8::StaticOrder, true, false>(C.lds + RING_OFF, DM, DM * 2, S, E, rowtab, 0);
        } } SEAM(pw);
        if ((SUBMASK & 8) && IN(pw + 1)) { ln_phase<0>(p, fresh(C), layer); } SEAM(pw + 1);
        if ((SUBMASK & 16) && IN(pw + 2)) { for (int rep_ = 0; rep_ < NREP(pw + 2); ++rep_) {
            MoeOrder S; S.G = C.G; S.c = C.vcu;     S.A = (const char*)XH; S.W = (const char*)(p.ws + WS_WGU); S.wexp = (size_t)DM * DM * 2; S.tsB = (size_t)256 * DM * 2;
            moe_setup(p, fresh(C), layer, S);
            pg8::EpiGU E{(pg8::bf16_t*)O0};
            pg8::gemm_phase<pg8::EpiGU, MoeOrder, true, true>(C.lds + RING_OFF, DM, DM * 2, S, E, rowtab, 1);
        } } SEAM(pw + 2);
        if ((SUBMASK & 32) && IN(pw + 3)) { for (int rep_ = 0; rep_ < NREP(pw + 3); ++rep_) {
            MoeOrder S; S.G = C.G; S.c = C.vcu;     S.A = (const char*)O0; S.W = (const char*)(p.ws + WS_WD); S.wexp = (size_t)DM * DEXP * 2; S.tsB = (size_t)256 * DEXP * 2;
            moe_setup(p, fresh(C), layer, S);
            pg8::EpiDown E{(pg8::bf16_t*)KB, (const float*)(p.ws + WS_GV)};
            pg8::gemm_phase<pg8::EpiDown, MoeOrder, true, true>(C.lds + RING_OFF, DEXP, DEXP * 2, S, E, rowtab, 0);
        } } SEAM(pw + 3);
        if ((SUBMASK & 64) && IN(pw + 4)) {
            if (layer == 0) { ln_phase<1>(p, fresh(C), 0); { const Ctx Cf = fresh(C); convert_experts(p, Cf, 1, 0, Cf.vcu * NWAVES + Cf.wave, Cf.G * NWAVES); } }
            else ln_phase<2>(p, fresh(C), 1);
        }
        if (layer == 0) SEAM(8);
        }
    { constexpr int layer = 1;
        const int pb = 1 + (layer ? 8 : 0);
        if ((SUBMASK & 1) && IN(pb)) { for (int rep_ = 0; rep_ < NREP(pb); ++rep_) {
            if (layer == 1) cumsum_job(p, fresh(C));
            meta_proj<0>(p, fresh(C), XH, (const bf16*)(p.ws + (layer ? WS_WQKV1 : WS_WQKV0)), 3 * DM / 16, layer ? (unsigned*)(ctl + CW_KM) : nullptr);
            pg8::StaticOrder S; S.init(NREAL, 3 * DM, C.G, (int)blockIdx.x, XH, DM * 2, p.ws + (layer ? WS_WQKV1 : WS_WQKV0), DM * 2);
            pg8::EpiQKV E{QB, KB, VB, attn_body::C2, layer ? (unsigned*)(ctl + CW_QM) : nullptr, (unsigned*)(ctl + CW_KM)};
            pg8::gemm_phase<pg8::EpiQKV, pg8::StaticOrder, true, false>(C.lds + RING_OFF, DM, DM * 2, S, E, rowtab, 0);
        } } SEAM(pb);
        if (layer == 0) {
            if (IN(2)) { for (int rep_ = 0; rep_ < NREP(2); ++rep_) {
                const float* TAB = (const float*)(p.ws + WS_TAB);
                const float lam = diff_lambda_full(p, fresh(C).lane);
                for (int it = C.vcu; it < NBATCH * 8 * 16; it += C.G) { const int bh = it >> 4, s = it & 15, b = bh >> 3, h = bh & 7;
#pragma unroll 1
                    for (int w = 0; w < 2; ++w) { const int qb = w ? s : 31 - s;
#pragma unroll 1
                        for (int mm = 0; mm < 2; ++mm) attn_body::attn_unit_dv<8>(b, qb, (2 * h + mm) * 64, h * 128, h * 128, (const attn_body::bf16*)QB, (const attn_body::bf16*)KB, (const attn_body::bf16*)VB, (attn_body::bf16*)(mm ? O1 : O0), TAB + (2 * h + mm) * 128, (char*)lds + RING_OFF);
                        combine_rows(p, fresh(C), b, h, qb, lam); } }
                diff_meta_attn(p, fresh(C), lam);
            } } SEAM(2);
        } else {
            if (IN(10)) { for (int rep_ = 0; rep_ < NREP(10); ++rep_) {
                const float* DK = (const float*)(p.ws + WS_DK);
                for (;;) {
                    const int lane_ = fresh(C).lane;
                    int tko = MOEPRE_OFF; asm volatile("" : "+s"(tko)); LAS int* tk = (LAS int*)(C.lds + tko);
                    if (fresh(C).tid == 0) tk[0] = (int)__hip_atomic_fetch_add(ctl + CW_QCTR + 64 * rep_, 1u, RLX_AGENT);
                    __syncthreads(); const int u = tk[0]; __syncthreads();
                    if (u >= NBATCH * 16 * 32) break;
                    const int qb = 31 - (u >> 6), bh = u & 63, b = bh >> 4, h = bh & 15;
                    const float* dk = DK + (size_t)bh * KROWS;
                    const unsigned qmb = lane_ < 8 ? __hip_atomic_load(ctl + CW_QM + ((size_t)(b * 32 + qb) * 16 + h) * 8 + lane_, RLX_AGENT) : 0u;
                    const unsigned kmb = lane_ < 8 ? __hip_atomic_load(ctl + CW_KM + ((size_t)bh) * 8 + lane_, RLX_AGENT) : 0u;
                    const int ntf = 4 * qb + 6;
                    float e0 = lane_ < ntf ? dk[lane_ == 0 ? NMETA - 1 : 64 * lane_ + 63] : 0.f, e1 = lane_ + 64 < ntf ? dk[64 * (lane_ + 64) + 63] : 0.f, e2 = lane_ + 128 < ntf ? dk[64 * (lane_ + 128) + 63] : 0.f;
                    const float q2 = wave_sum(__uint_as_float(qmb), lane_), k2 = fmaxf(wave_sum(lane_ < 2 ? __uint_as_float(kmb) : 0.f, lane_), wave_sum(lane_ >= 2 ? __uint_as_float(kmb) : 0.f, lane_));
                    const float thr = dk[KPRE + 256 * qb] - 40.f - 2.1f * sqrtf(q2 * k2);
                    const unsigned long long m0 = __ballot(lane_ < ntf && e0 >= thr), m1 = __ballot(lane_ + 64 < ntf && e1 >= thr), m2 = __ballot(lane_ + 128 < ntf && e2 >= thr);
                    int tb = m0 ? __builtin_ctzll(m0) : (m1 ? 64 + __builtin_ctzll(m1) : (m2 ? 128 + __builtin_ctzll(m2) : ntf - 6));
                    tb &= ~1; tb = tb > ntf - 6 ? ntf - 6 : tb; tb = __builtin_amdgcn_readfirstlane(tb);
                    attn_body::attn_unit<1, 8>(b, qb, tb, h * 64, h * 64, h * 64, (const attn_body::bf16*)QB, (const attn_body::bf16*)KB, (const attn_body::bf16*)VB, (attn_body::bf16*)O0, dk, (char*)lds + RING_OFF);
                }
                fox_meta_attn(p, fresh(C));
            } } SEAM(10);
        }
        const int pw = layer ? 11 : 4;
        if ((SUBMASK & 4) && IN(pw)) { for (int rep_ = 0; rep_ < NREP(pw); ++rep_) {
            meta_proj<1>(p, fresh(C), layer ? O0 : QB, (const bf16*)(p.ws + (layer ? WS_WO1 : WS_WO0)), DM / 16, nullptr);
            pg8::StaticOrder S; S.init(NREAL, DM, C.G, (int)blockIdx.x, layer ? O0 : QB, DM * 2, p.ws + (layer ? WS_WO1 : WS_WO0), DM * 2);
            pg8::EpiZ E{XH};
            pg8::gemm_phase<pg8::EpiZ, pg8::StaticOrder, true, false>(C.lds + RING_OFF, DM, DM * 2, S, E, rowtab, 0);
        } } SEAM(pw);
        if ((SUBMASK & 8) && IN(pw + 1)) { ln_phase<0>(p, fresh(C), layer); } SEAM(pw + 1);
        if ((SUBMASK & 16) && IN(pw + 2)) { for (int rep_ = 0; rep_ < NREP(pw + 2); ++rep_) {
            MoeOrder S; S.G = C.G; S.c = C.vcu;     S.A = (const char*)XH; S.W = (const char*)(p.ws + WS_WGU); S.wexp = (size_t)DM * DM * 2; S.tsB = (size_t)256 * DM * 2;
            moe_setup(p, fresh(C), layer, S);
            pg8::EpiGU E{(pg8::bf16_t*)O0};
            pg8::gemm_phase<pg8::EpiGU, MoeOrder, true, true>(C.lds + RING_OFF, DM, DM * 2, S, E, rowtab, 1);
        } } SEAM(pw + 2);
        if ((SUBMASK & 32) && IN(pw + 3)) { for (int rep_ = 0; rep_ < NREP(pw + 3); ++rep_) {
            MoeOrder S; S.G = C.G; S.c = C.vcu;     S.A = (const char*)O0; S.W = (const char*)(p.ws + WS_WD); S.wexp = (size_t)DM * DEXP * 2; S.tsB = (size_t)256 * DEXP * 2;
            moe_setup(p, fresh(C), layer, S);
            pg8::EpiDown E{(pg8::bf16_t*)KB, (const float*)(p.ws + WS_GV)};
            pg8::gemm_phase<pg8::EpiDown, MoeOrder, true, true>(C.lds + RING_OFF, DEXP, DEXP * 2, S, E, rowtab, 0);
        } } SEAM(pw + 3);
        if ((SUBMASK & 64) && IN(pw + 4)) {
            if (layer == 0) { ln_phase<1>(p, fresh(C), 0); { const Ctx Cf = fresh(C); convert_experts(p, Cf, 1, 0, Cf.vcu * NWAVES + Cf.wave, Cf.G * NWAVES); } }
            else ln_phase<2>(p, fresh(C), 1);
        }
        if (layer == 0) SEAM(8);
        }
#undef IN
#undef SEAM
#undef GRID_BAR
}

extern "C" void kernel_launch(void* const* d_in, const int* in_sizes, int n_in, void* d_out, int out_size, void* d_ws, size_t ws_size, hipStream_t stream) {
    static int grid = 0;
    if (grid == 0) {
        if (n_in != 21 || in_sizes[0] != NREAL * DM || out_size != NREAL * DM || ws_size < WS_END) { fprintf(stderr, "kernel_launch: unexpected shapes (n_in %d, in0 %d, out %d, ws %zu); nothing launched\n", n_in, n_in > 0 ? in_sizes[0] : -1, out_size, ws_size); grid = -1; return; }
        int dev = 0, cus = 0, per_cu = 0;
        if (hipGetDevice(&dev) != hipSuccess || hipDeviceGetAttribute(&cus, hipDeviceAttributeMultiprocessorCount, dev) != hipSuccess) { fprintf(stderr, "kernel_launch: device query failed\n"); grid = -1; return; }
        if (hipFuncSetAttribute((const void*)trunk_fwd, hipFuncAttributeMaxDynamicSharedMemorySize, LDS_BYTES) != hipSuccess) { fprintf(stderr, "kernel_launch: hipFuncSetAttribute failed\n"); grid = -1; return; }
        if (hipOccupancyMaxActiveBlocksPerMultiprocessor(&per_cu, (const void*)trunk_fwd, NWAVES * 64, LDS_BYTES) != hipSuccess || per_cu < 1) { fprintf(stderr, "kernel_launch: occupancy query reports %d workgroups per CU\n", per_cu); }
        (void)hipGetLastError();
        grid = cus;
    }
    if (grid < 0) return;
    if (hipMemsetAsync((char*)d_ws + WS_CTL, 0, CTL_ZERO_BYTES, stream) != hipSuccess) { fprintf(stderr, "kernel_launch: hipMemsetAsync failed\n"); return; }
    Params a{};
    const float** dst = (const float**)&a.x;
    for (int i = 0; i < 21; ++i) dst[i] = (const float*)d_in[i];
    a.out = (float*)d_out; a.ws = (unsigned char*)d_ws;
#if MK_PER_PHASE
    for (int k = 0; k < N_PHASES; ++k) { a.ph_lo = k; a.ph_hi = k + 1; a.li = 0; hipLaunchKernelGGL(trunk_fwd, dim3(grid), dim3(NWAVES * 64), LDS_BYTES, stream, a); }
#else
    a.ph_lo = 0; a.ph_hi = N_PHASES; a.li = 0;
    hipLaunchKernelGGL(trunk_fwd, dim3(grid), dim3(NWAVES * 64), LDS_BYTES, stream, a);
#endif
    const hipError_t le = hipPeekAtLastError();
    if (le != hipSuccess) fprintf(stderr, "kernel_launch: launch failed: %s\n", hipGetErrorName(le));
}
```

```cpp
#include <hip/hip_runtime.h>
#include <hip/hip_bf16.h>
#include <cstdio>
#include <cstdint>
#include <cmath>

constexpr int DM = 1024, NBATCH = 4, SEQ = 8192, NMETA = 16;
constexpr int NREAL = NBATCH * SEQ;
constexpr int NR = NREAL + NMETA;
constexpr int NRP = 129 * 256;
constexpr int KPRE = 64;
constexpr int KROWS = KPRE + SEQ + 64;
constexpr int NSLOT = 2 * NR;
constexpr int NEXP = 32, DEXP = 512;
constexpr float ALPHA = 1.41421356237309515f;
constexpr float LN_EPS = 1e-5f;
constexpr float LOG2E = 1.4426950408889634f;
constexpr float LAMBDA_INIT0 = 0.2f;

namespace pg8 {
#define PG8_LAS __attribute__((address_space(3)))
typedef unsigned short bf16_t;
typedef short bf16x8 __attribute__((ext_vector_type(8)));
typedef float f32x4 __attribute__((ext_vector_type(4)));
typedef unsigned u32x4 __attribute__((ext_vector_type(4)));
constexpr int BM = 256, BK = 64, HALF = 128, HTB = HALF * BK * 2  , STAGE_BYTES = 8 * HTB, NXCD = 8, WGM = 8;

__host__ __device__ __forceinline__ int lds_byte(int r, int c) { const int st = (r >> 4) * 2 + (c >> 5), rr = r & 15, cc = c & 31, ob = rr * 64 + cc * 2; return st * 1024 + (ob ^ (((ob >> 9) & 1) << 5)); }
__host__ __device__ __forceinline__ void stage_rc(int b, int& R, int& C) { const int st = b / 1024, sb = b % 1024, swz = sb ^ (((sb >> 9) & 1) << 5); R = (st >> 1) * 16 + swz / 64; C = (st & 1) * 32 + (swz % 64) / 2; }
__host__ __device__ __forceinline__ int perm32(int rho) { const int n = rho >> 4, i = rho & 15; return 8 * (i >> 2) + 4 * n + (i & 3); }

struct Unit { int pm, pn; const char* A; const char* B; int tab; int e; };

struct StaticOrder {
    int nM, nN, nwg, G, c; const char* A; const char* B; size_t tsA, tsB;
    __device__ void init(int M, int N, int G_, int c_, const void* A_, size_t lda_bytes, const void* B_, size_t ldb_bytes) { nM = M / BM; nN = N / BM; nwg = nM * nN; G = G_; c = c_; A = (const char*)A_; B = (const char*)B_; tsA = lda_bytes * BM; tsB = ldb_bytes * BM; }
    __device__ bool next(int i, Unit& u) const {
        const long L = (long)i * G + c; if (L >= nwg) return false;
        int wgid = (int)L; { const int q = nwg / NXCD, r = nwg % NXCD, xcd = wgid % NXCD, off = wgid / NXCD; wgid = (xcd < r ? xcd * (q + 1) : r * (q + 1) + (xcd - r) * q) + off; }
        const int nig = WGM * nN, gid = wgid / nig, fm = gid * WGM, gsz = (nM - fm) < WGM ? (nM - fm) : WGM;
        u.pm = fm + ((wgid % nig) % gsz); u.pn = (wgid % nig) / gsz; u.A = A + (size_t)u.pm * tsA; u.B = B + (size_t)u.pn * tsB; u.tab = 0; u.e = 0; return true;
    }
};

__device__ __forceinline__ float shx(float v, int m, int lane) { return __uint_as_float((unsigned)__builtin_amdgcn_ds_bpermute((lane ^ m) << 2, (int)__float_as_uint(v))); }
__device__ __forceinline__ unsigned cvt_pk_bf16(float lo, float hi) { unsigned r; asm volatile("v_cvt_pk_bf16_f32 %0, %1, %2" : "=v"(r) : "v"(lo), "v"(hi)); return r; }

template <class Epi, class Sched, bool ALIGN_EPI, bool GATHER>
__device__ __forceinline__ void gemm_phase(PG8_LAS unsigned char* lds, const int K, const unsigned lda, const Sched& S, const Epi& E, const PG8_LAS int* rowtab, const int ashift) {
    int tid_ = threadIdx.x; asm volatile("" : "+v"(tid_));
    const int tid = tid_, wid = __builtin_amdgcn_readfirstlane(tid >> 6), lane = tid & 63, wr = wid >> 2, wc = wid & 3, fr = lane & 15, fq = lane >> 4;
    const int nt = K / BK;
    unsigned voffB[2], offA[2][2], noffA[2][2]; int Rr[2], Cc[2];
#pragma unroll
    for (int i = 0; i < 2; ++i) { int R, C; stage_rc(tid * 16 + i * 8192, R, C); const int Rb = Epi::PERM ? ((R & ~31) + perm32(R & 31)) : R; Rr[i] = R; Cc[i] = C;
        voffB[i] = (unsigned)(Rb * K + C) * 2u;
#pragma unroll
        for (int h = 0; h < 2; ++h) { offA[h][i] = (unsigned)(R + HALF * h) * lda + (unsigned)C * 2u; noffA[h][i] = offA[h][i]; } }
    const size_t kstep = (size_t)(BK * 2);
    const size_t hstep = (size_t)HALF * K * 2;
    const unsigned ldsw = (unsigned)wid * 1024u;
    const int aoff = lds_byte(wr * 64 + fr, fq * 8), boff = lds_byte(wc * 32 + fr, fq * 8);
#define PG8_SA(b, h) (((b) * 2 + (h)) * HTB)
#define PG8_SB(b, h) ((4 + (b) * 2 + (h)) * HTB)
#define PG8_STAGE(bufoff, gbase, voff) do { _Pragma("unroll") for (int _i = 0; _i < 2; ++_i) \
        __builtin_amdgcn_global_load_lds((const unsigned*)((const char*)(gbase) + (voff)[_i]), (PG8_LAS unsigned*)(lds + (bufoff) + ldsw + _i * 8192), 16, 0, 0); } while (0)
#define PG8_LDA(dst, b, h) do { _Pragma("unroll") for (int m = 0; m < 4; ++m) _Pragma("unroll") for (int k = 0; k < 2; ++k) dst[m][k] = *(const PG8_LAS bf16x8*)(lds + PG8_SA(b, h) + aoff + m * 2048 + k * 1024); } while (0)
#define PG8_LDB(dst, b, h) do { _Pragma("unroll") for (int n = 0; n < 2; ++n) _Pragma("unroll") for (int k = 0; k < 2; ++k) dst[n][k] = *(const PG8_LAS bf16x8*)(lds + PG8_SB(b, h) + boff + n * 2048 + k * 1024); } while (0)
#define PG8_MMA(ai, bj, At, Bt) do { __builtin_amdgcn_s_setprio(1); _Pragma("unroll") for (int m = 0; m < 4; ++m) _Pragma("unroll") for (int n = 0; n < 2; ++n) _Pragma("unroll") for (int k = 0; k < 2; ++k) \
        acc[ai][bj][m][n] = __builtin_amdgcn_mfma_f32_16x16x32_bf16(Bt[n][k], At[m][k], acc[ai][bj][m][n], 0, 0, 0); __builtin_amdgcn_s_setprio(0); } while (0)
#define PG8_WAIT_V(n) asm volatile("s_waitcnt vmcnt(" #n ")" ::: "memory")
#define PG8_WAIT_L(n) asm volatile("s_waitcnt lgkmcnt(" #n ")" ::: "memory")
#define PG8_BAR __builtin_amdgcn_s_barrier()
#define PG8_SCHED __builtin_amdgcn_sched_barrier(0)
#define PG8_GOFF(dst, u) do { if constexpr (GATHER) { _Pragma("unroll") for (int _h = 0; _h < 2; ++_h) _Pragma("unroll") for (int _i = 0; _i < 2; ++_i) { \
        int _e = rowtab[(u).tab * 256 + _h * HALF + Rr[_i]]; _e = _e < 0 ? 0 : (_e >> ashift); dst[_h][_i] = (unsigned)_e * lda + (unsigned)Cc[_i] * 2u; } } } while (0)
    Unit cur, nxt; int ui = 0;
    if (!S.next(0, cur)) return;
    f32x4 acc[2][2][4][2];
#pragma unroll
    for (int a = 0; a < 2; ++a)
#pragma unroll
        for (int b = 0; b < 2; ++b)
#pragma unroll
            for (int m = 0; m < 4; ++m)
#pragma unroll
                for (int n = 0; n < 2; ++n) acc[a][b][m][n] = (f32x4){0.f, 0.f, 0.f, 0.f};
    bf16x8 At[4][2], B0[2][2], B1[2][2];
    const char* cA = cur.A; const char* cB = cur.B;
    PG8_GOFF(offA, cur);
    PG8_STAGE(PG8_SB(0, 0), cB, voffB); PG8_STAGE(PG8_SB(0, 1), cB + hstep, voffB); PG8_STAGE(PG8_SA(0, 0), cA, offA[0]); PG8_STAGE(PG8_SA(0, 1), cA, offA[1]);
    if (wr == 1) PG8_BAR;
    PG8_WAIT_V(2); PG8_BAR;
    PG8_STAGE(PG8_SB(1, 0), cB + kstep, voffB); PG8_STAGE(PG8_SA(1, 0), cA + kstep, offA[0]); PG8_STAGE(PG8_SB(1, 1), cB + hstep + kstep, voffB);
    PG8_WAIT_V(6); PG8_BAR;
    for (;;) {
        const bool has_next = S.next(ui + 1, nxt);
        const char* nA = has_next ? nxt.A : cA; const char* nB = has_next ? nxt.B : cB;
        if constexpr (GATHER) { if (has_next) PG8_GOFF(noffA, nxt); else {
#pragma unroll
            for (int h = 0; h < 2; ++h)
#pragma unroll
                for (int i = 0; i < 2; ++i) noffA[h][i] = offA[h][i]; } }
        for (int t = 0; t < nt; t += 2) {
            const bool last = (t == nt - 2);
            const char* a1 = cA + (size_t)(t + 1) * kstep;
            const char* a2 = last ? nA : cA + (size_t)(t + 2) * kstep; const char* b2 = last ? nB : cB + (size_t)(t + 2) * kstep;
            const char* a3 = a2 + kstep; const char* b3 = b2 + kstep;
            unsigned o2[2][2];
#pragma unroll
            for (int h = 0; h < 2; ++h)
#pragma unroll
                for (int i = 0; i < 2; ++i) o2[h][i] = (GATHER && last) ? noffA[h][i] : offA[h][i];
            PG8_LDB(B0, 0, 0); PG8_LDB(B1, 0, 1); PG8_SCHED; PG8_LDA(At, 0, 0); PG8_STAGE(PG8_SA(1, 1), a1, offA[1]);
            PG8_WAIT_V(8); PG8_WAIT_L(0); PG8_BAR; PG8_MMA(0, 0, At, B0); PG8_MMA(0, 1, At, B1); PG8_BAR; PG8_SCHED;
            PG8_LDA(At, 0, 1); PG8_STAGE(PG8_SB(0, 0), b2, voffB); PG8_STAGE(PG8_SB(0, 1), b2 + hstep, voffB); PG8_STAGE(PG8_SA(0, 0), a2, o2[0]);
            PG8_WAIT_V(8); PG8_WAIT_L(0); PG8_BAR; PG8_MMA(1, 0, At, B0); PG8_MMA(1, 1, At, B1); PG8_BAR; PG8_SCHED;
            PG8_LDB(B0, 1, 0); PG8_LDB(B1, 1, 1); PG8_SCHED; PG8_LDA(At, 1, 0); PG8_STAGE(PG8_SA(0, 1), a2, o2[1]);
            PG8_WAIT_V(8); PG8_WAIT_L(0); PG8_BAR; PG8_MMA(0, 0, At, B0); PG8_MMA(0, 1, At, B1); PG8_BAR; PG8_SCHED;
            PG8_LDA(At, 1, 1); PG8_STAGE(PG8_SB(1, 0), b3, voffB); PG8_STAGE(PG8_SB(1, 1), b3 + hstep, voffB); PG8_STAGE(PG8_SA(1, 0), a3, o2[0]);
            PG8_WAIT_V(8); PG8_WAIT_L(0); PG8_BAR; PG8_MMA(1, 0, At, B0); PG8_MMA(1, 1, At, B1); PG8_BAR; PG8_SCHED;
        }
        if constexpr (ALIGN_EPI) { if (wr == 0) PG8_BAR; }
        E(acc, cur, wr, wc, fr, fq, rowtab);
        if (!has_next) break;
#pragma unroll
        for (int a = 0; a < 2; ++a)
#pragma unroll
            for (int b = 0; b < 2; ++b)
#pragma unroll
                for (int m = 0; m < 4; ++m)
#pragma unroll
                    for (int n = 0; n < 2; ++n) acc[a][b][m][n] = (f32x4){0.f, 0.f, 0.f, 0.f};
        cur = nxt; cA = nA; cB = nB; ++ui;
        if constexpr (GATHER) {
#pragma unroll
            for (int h = 0; h < 2; ++h)
#pragma unroll
                for (int i = 0; i < 2; ++i) offA[h][i] = noffA[h][i]; }
        if constexpr (ALIGN_EPI) { if (wr == 1) PG8_BAR; }
    }
    PG8_WAIT_V(0);
    if constexpr (!ALIGN_EPI) { if (wr == 0) PG8_BAR; }
    PG8_BAR;
#undef PG8_SA
#undef PG8_SB
#undef PG8_STAGE
#undef PG8_LDA
#undef PG8_LDB
#undef PG8_MMA
#undef PG8_WAIT_V
#undef PG8_WAIT_L
#undef PG8_BAR
#undef PG8_SCHED
#undef PG8_GOFF
}

struct EpiQKV {
    static constexpr bool PERM = true;
    bf16_t* Q; bf16_t* Kb; bf16_t* Vb; float qscale;
    unsigned* qm; unsigned* km;
    __device__ __forceinline__ void operator()(const f32x4 (&acc)[2][2][4][2], const Unit& u, int wr, int wc, int fr, int fq, const PG8_LAS int*) const {
        const int row0 = u.pm * BM + wr * 64 + fr; const int t = (u.pn * BM) >> 10; const int colt = (u.pn * BM) & 1023;
        const int col0 = colt + wc * 32 + 8 * fq; const float sc = (t == 0) ? qscale : 1.f;
        bf16_t* kv = (t == 1) ? Kb : Vb;
        float mx[2] = {0.f, 0.f};
#pragma unroll
        for (int ai = 0; ai < 2; ++ai)
#pragma unroll
            for (int m = 0; m < 4; ++m) { const int r = row0 + ai * HALF + m * 16;
                if (r < NR) {
#pragma unroll
                for (int bj = 0; bj < 2; ++bj) { const f32x4 v0 = acc[ai][bj][m][0] * sc, v1 = acc[ai][bj][m][1] * sc;
                    u32x4 w; w.x = cvt_pk_bf16(v0[0], v0[1]); w.y = cvt_pk_bf16(v0[2], v0[3]); w.z = cvt_pk_bf16(v1[0], v1[1]); w.w = cvt_pk_bf16(v1[2], v1[3]);
                    const int c = col0 + bj * HALF;
                    bf16_t* dst = (t == 0) ? Q + (size_t)r * DM : kv + (size_t)(r < NREAL ? (r >> 13) * KROWS + KPRE + (r & (SEQ - 1)) : r - NREAL) * DM;
                    *(u32x4*)(dst + c) = w; } }
                if (qm != nullptr && t < 2) {
#pragma unroll
                    for (int bj = 0; bj < 2; ++bj) { const f32x4 v0 = acc[ai][bj][m][0] * sc, v1 = acc[ai][bj][m][1] * sc;
                        float ss = (v0[0] * v0[0] + v0[1] * v0[1]) + (v0[2] * v0[2] + v0[3] * v0[3]) + (v1[0] * v1[0] + v1[1] * v1[1]) + (v1[2] * v1[2] + v1[3] * v1[3]);
                        ss += shx(ss, 16, fq * 16 + fr); ss += shx(ss, 32, fq * 16 + fr);
                        if (r < NR) mx[bj] = fmaxf(mx[bj], ss); } } }
        if (qm != nullptr && t < 2) {
#pragma unroll
            for (int bj = 0; bj < 2; ++bj) { float v = mx[bj]; v = fmaxf(v, shx(v, 1, fq * 16 + fr)); v = fmaxf(v, shx(v, 2, fq * 16 + fr)); v = fmaxf(v, shx(v, 4, fq * 16 + fr)); v = fmaxf(v, shx(v, 8, fq * 16 + fr));
                if (fr == 0 && fq == 0) { const int head = 4 * (u.pn & 3) + 2 * bj + (wc >> 1), part = wc & 1; const unsigned bits = __float_as_uint(v);
                    if (t == 0) { if (u.pm < NREAL / BM) atomicMax(qm + ((size_t)u.pm * 16 + head) * 8 + part, bits); }
                    else if (u.pm < NREAL / BM) atomicMax(km + ((size_t)(u.pm >> 5) * 16 + head) * 8 + part, bits);
                    else { for (int b = 0; b < NBATCH; ++b) atomicMax(km + ((size_t)b * 16 + head) * 8 + part, bits); } } } }
    }
};
struct EpiZ {
    static constexpr bool PERM = true;
    bf16_t* H;
    __device__ __forceinline__ void operator()(const f32x4 (&acc)[2][2][4][2], const Unit& u, int wr, int wc, int fr, int fq, const PG8_LAS int*) const {
        const int row0 = u.pm * BM + wr * 64 + fr; const int col0 = u.pn * BM + wc * 32 + 8 * fq;
#pragma unroll
        for (int ai = 0; ai < 2; ++ai)
#pragma unroll
            for (int m = 0; m < 4; ++m) { const int r = row0 + ai * HALF + m * 16;
                if (r < NR) {
#pragma unroll
                    for (int bj = 0; bj < 2; ++bj) { bf16_t* hp = H + (size_t)r * DM + col0 + bj * HALF; const u32x4 b = *(const u32x4*)hp;
                        const f32x4 v0 = acc[ai][bj][m][0], v1 = acc[ai][bj][m][1];
                        u32x4 w; w.x = cvt_pk_bf16(v0[0] + ALPHA * __uint_as_float(b.x << 16), v0[1] + ALPHA * __uint_as_float(b.x & 0xffff0000u)); w.y = cvt_pk_bf16(v0[2] + ALPHA * __uint_as_float(b.y << 16), v0[3] + ALPHA * __uint_as_float(b.y & 0xffff0000u));
                        w.z = cvt_pk_bf16(v1[0] + ALPHA * __uint_as_float(b.z << 16), v1[1] + ALPHA * __uint_as_float(b.z & 0xffff0000u)); w.w = cvt_pk_bf16(v1[2] + ALPHA * __uint_as_float(b.w << 16), v1[3] + ALPHA * __uint_as_float(b.w & 0xffff0000u));
                        *(u32x4*)hp = w; } } }
    }
};
struct EpiGU {
    static constexpr bool PERM = true;
    bf16_t* U;
    __device__ __forceinline__ void operator()(const f32x4 (&acc)[2][2][4][2], const Unit& u, int wr, int wc, int fr, int fq, const PG8_LAS int* rowtab) const {
        const int col0 = u.pn * HALF + wc * 32 + 8 * fq;
#pragma unroll
        for (int ai = 0; ai < 2; ++ai)
#pragma unroll
            for (int m = 0; m < 4; ++m) { const int slot = rowtab[u.tab * 256 + ai * HALF + wr * 64 + m * 16 + fr];
                if (slot >= 0) { float o[8];
#pragma unroll
                    for (int n = 0; n < 2; ++n)
#pragma unroll
                        for (int c = 0; c < 4; ++c) { const float g = acc[ai][0][m][n][c], up = acc[ai][1][m][n][c]; o[n * 4 + c] = g * up * __builtin_amdgcn_rcpf(1.f + __builtin_amdgcn_exp2f(-g * LOG2E)); }
                    u32x4 w; w.x = cvt_pk_bf16(o[0], o[1]); w.y = cvt_pk_bf16(o[2], o[3]); w.z = cvt_pk_bf16(o[4], o[5]); w.w = cvt_pk_bf16(o[6], o[7]);
                    *(u32x4*)(U + (size_t)slot * DEXP + col0) = w; } }
    }
};
struct EpiDown {
    static constexpr bool PERM = true;
    bf16_t* Y; const float* GV;
    __device__ __forceinline__ void operator()(const f32x4 (&acc)[2][2][4][2], const Unit& u, int wr, int wc, int fr, int fq, const PG8_LAS int* rowtab) const {
        const int col0 = u.pn * BM + wc * 32 + 8 * fq;
#pragma unroll
        for (int ai = 0; ai < 2; ++ai)
#pragma unroll
            for (int m = 0; m < 4; ++m) { const int slot = rowtab[u.tab * 256 + ai * HALF + wr * 64 + m * 16 + fr];
                if (slot >= 0) { const float gv = GV[slot];
#pragma unroll
                    for (int bj = 0; bj < 2; ++bj) { const f32x4 v0 = acc[ai][bj][m][0] * gv, v1 = acc[ai][bj][m][1] * gv;
                        u32x4 w; w.x = cvt_pk_bf16(v0[0], v0[1]); w.y = cvt_pk_bf16(v0[2], v0[3]); w.z = cvt_pk_bf16(v1[0], v1[1]); w.w = cvt_pk_bf16(v1[2], v1[3]);
                        *(u32x4*)(Y + (size_t)slot * DM + col0 + bj * HALF) = w; } } }
    }
};
}
namespace attn_body {
using bf16=__hip_bfloat16;
using bf16x8=__attribute__((ext_vector_type(8)))short;
using s16x4=__attribute__((ext_vector_type(4)))short;
using f32x16=__attribute__((ext_vector_type(16)))float;
using u32x4=__attribute__((ext_vector_type(4)))unsigned;
constexpr int D=64;
constexpr int NW=8,QBLK=32,QB=QBLK*NW,KVBLK=64,NQB=SEQ/QB;
constexpr int ATTN_PITCH=DM, ATTN_UNIT_ROWS=QB;
__device__ __forceinline__ int crow(int r,int hi){return (r&3)+8*(r>>2)+4*hi;}
#define SBAR() __builtin_amdgcn_sched_barrier(0)
__device__ __forceinline__ void cmask(f32x16&p0,f32x16&p1,int jb,int qrel,int hi){
  const float NEG=-INFINITY; int kb=64*jb+4*hi;
  #pragma unroll
  for(int r=0;r<16;++r){int kv=kb+(r&3)+8*(r>>2); if(kv>qrel)p0[r]=NEG; if(kv+32>qrel)p1[r]=NEG;}
}

constexpr int RT_OFFS=320, RT_SIZE=704;

template<int MODE> __device__ __forceinline__ void modtile_slow(f32x16&p0,f32x16&p1,int t,int q_abs,int q0,int hi,const __attribute__((address_space(3))) float* tab){
  const float NEG=-INFINITY; int hi4=4*hi; asm volatile("":"+v"(hi4),"+v"(q_abs));
  if(MODE==0){
    if(t==0){
      int bd=16+q_abs; bd=bd>383?383:bd; const __attribute__((address_space(3))) float* bp=tab+(RT_OFFS+bd-hi4-15);
      #pragma unroll
      for(int r=0;r<16;++r){ p1[r]=NEG; if(r<8)p0[r]+=bp[15-((r&3)+8*(r>>2))]; else p0[r]=NEG; }
    } else {
      const __attribute__((address_space(3))) float* bp=tab+(RT_OFFS+q_abs-64*t+KPRE-hi4-63);
      const int dq=q_abs-64*t+KPRE-hi4;
      #pragma unroll
      for(int r=0;r<16;++r){ const int c=(r&3)+8*(r>>2); p0[r]+=bp[63-c]; p1[r]+=bp[31-c]; }
      if(64*t-KPRE+63>q0){
        #pragma unroll
        for(int r=0;r<16;++r){ const int c=(r&3)+8*(r>>2); if(c>dq)p0[r]=NEG; if(c+32>dq)p1[r]=NEG; } }
    }
  } else {
    if(t==0){
      #pragma unroll
      for(int r=0;r<16;++r){ p1[r]=NEG; if(r<8)p0[r]+=tab[(r&3)+8*(r>>2)+hi4]; else p0[r]=NEG; }
    } else {
      typedef float f4 __attribute__((ext_vector_type(4)));
      const __attribute__((address_space(3))) f4* tp=(const __attribute__((address_space(3))) f4*)(tab+64*t+hi4);
      #pragma unroll
      for(int g=0;g<4;++g){ const f4 a=tp[2*g], b=tp[8+2*g];
        #pragma unroll
        for(int c=0;c<4;++c){ p0[4*g+c]+=a[c]; p1[4*g+c]+=b[c]; }
        asm volatile("":::"memory"); }
      if(64*t-KPRE+63>q0){
        const int dq=q_abs-64*t+KPRE-hi4;
        #pragma unroll
        for(int r=0;r<16;++r){ const int c=(r&3)+8*(r>>2); if(c>dq)p0[r]=NEG; if(c+32>dq)p1[r]=NEG; } }
    }
  }
}
__device__ __forceinline__ void modtile_fast1(f32x16&p0,f32x16&p1,int t,int hi,const __attribute__((address_space(3))) float* tab){
  typedef float f4 __attribute__((ext_vector_type(4)));
  const __attribute__((address_space(3))) f4* tp=(const __attribute__((address_space(3))) f4*)(tab+64*t+4*hi);
  #pragma unroll
  for(int g=0;g<4;++g){ const f4 a=tp[2*g], b=tp[8+2*g];
    #pragma unroll
    for(int c=0;c<4;++c){ p0[4*g+c]+=a[c]; p1[4*g+c]+=b[c]; } }
}
constexpr int NSLOT=3, SLOTB=8192;
constexpr int LDS_K=0, LDS_V=NSLOT*SLOTB, LDS_WS=2*NSLOT*SLOTB, LDS_OST=LDS_WS+NW*64*4, LDS_TAB=LDS_OST+NW*4096, LDS_BYTES=LDS_TAB+KROWS*4;
constexpr float C2=0.125f*1.4426950408889634f;
__device__ __forceinline__ void glds16(const void*gsrc,unsigned lds_dst){unsigned keep;
  asm volatile("s_mov_b32 %0, m0\n\ts_mov_b32 m0, %2\n\ts_nop 0\n\tglobal_load_lds_dwordx4 %1, off\n\ts_mov_b32 m0, %0":"=&s"(keep):"v"(gsrc),"s"(lds_dst):"memory");}
__device__ __forceinline__ float max3f(float a,float b,float c){float r;asm("v_max3_f32 %0, %1, %2, %3":"=v"(r):"v"(a),"v"(b),"v"(c));return r;}
__device__ __forceinline__ float max2f(float a,float b){float r;asm("v_max_f32_e32 %0, %1, %2":"=v"(r):"v"(a),"v"(b));return r;}
__device__ __forceinline__ float fadd_s(float a,float b){float r;asm("v_add_f32_e32 %0, %1, %2":"=v"(r):"v"(a),"v"(b));return r;}
__device__ __forceinline__ float fsub_s(float a,float b){float r;asm("v_sub_f32_e32 %0, %1, %2":"=v"(r):"v"(a),"v"(b));return r;}
typedef float f32x2_t __attribute__((ext_vector_type(2))); typedef __bf16 bf16x2_t __attribute__((ext_vector_type(2)));
__device__ __forceinline__ unsigned cvtpk_s(float lo,float hi){f32x2_t v={lo,hi};bf16x2_t b=__builtin_convertvector(v,bf16x2_t);return __builtin_bit_cast(unsigned,b);}
#define WAIT_BAR(N) asm volatile("s_waitcnt vmcnt(" #N ") lgkmcnt(0)\n\ts_barrier":::"memory")

__device__ __forceinline__ void qkt(f32x16&p0,f32x16&p1,const char*Kslot,const bf16x8*qr,const f32x16&negm,int r32,int hi){
  const char*kb=Kslot+hi*1024+r32*16;
  #pragma unroll
  for(int d0=0;d0<4;++d0){
    const bf16x8 b0=*reinterpret_cast<const bf16x8*>(kb+d0*2048);
    const bf16x8 b1=*reinterpret_cast<const bf16x8*>(kb+d0*2048+512);
    if(d0==0){p0=__builtin_amdgcn_mfma_f32_32x32x16_bf16(b0,qr[0],negm,0,0,0);p1=__builtin_amdgcn_mfma_f32_32x32x16_bf16(b1,qr[0],negm,0,0,0);}
    else{p0=__builtin_amdgcn_mfma_f32_32x32x16_bf16(b0,qr[d0],p0,0,0,0);p1=__builtin_amdgcn_mfma_f32_32x32x16_bf16(b1,qr[d0],p1,0,0,0);}}
}
typedef __attribute__((address_space(3))) const char* lds_cptr;
typedef short v4i16_t __attribute__((ext_vector_type(4)));
__device__ __forceinline__ void kload8(bf16x8*kf,lds_cptr kp){
  kf[0]=*(const __attribute__((address_space(3))) bf16x8*)(kp);      kf[1]=*(const __attribute__((address_space(3))) bf16x8*)(kp+512);
  kf[2]=*(const __attribute__((address_space(3))) bf16x8*)(kp+2048); kf[3]=*(const __attribute__((address_space(3))) bf16x8*)(kp+2560);
  kf[4]=*(const __attribute__((address_space(3))) bf16x8*)(kp+4096); kf[5]=*(const __attribute__((address_space(3))) bf16x8*)(kp+4608);
  kf[6]=*(const __attribute__((address_space(3))) bf16x8*)(kp+6144); kf[7]=*(const __attribute__((address_space(3))) bf16x8*)(kp+6656);
}
__device__ __forceinline__ void kload2(bf16x8*kf,lds_cptr kp,int j){ kf[2*j]=*(const __attribute__((address_space(3))) bf16x8*)(kp+j*2048); kf[2*j+1]=*(const __attribute__((address_space(3))) bf16x8*)(kp+j*2048+512); }
__device__ __forceinline__ s16x4 vtr(lds_cptr p){ return __builtin_bit_cast(s16x4,__builtin_amdgcn_ds_read_tr16_b64_v4i16((__attribute__((address_space(3))) v4i16_t*)p)); }
__device__ __forceinline__ float rowmax(const f32x16&p0,const f32x16&p1){
  float a=max3f(p0[0],p0[1],p1[0]),b=max3f(p0[2],p0[3],p1[1]);a=max3f(a,p1[2],p1[3]);
  #pragma unroll
  for(int r=4;r<16;r+=4){a=max3f(a,p0[r],p0[r+1]);b=max3f(b,p0[r+2],p0[r+3]);a=max3f(a,p1[r],p1[r+1]);b=max3f(b,p1[r+2],p1[r+3]);}
  const float m=max2f(a,b);
  auto rr=__builtin_amdgcn_permlane32_swap(__float_as_uint(m),__float_as_uint(m),false,false);
  return max2f(__uint_as_float(rr[0]),__uint_as_float(rr[1]));
}
__device__ __forceinline__ void pv(f32x16*o,int vb,bf16x8 pa0,bf16x8 pa1,bf16x8 pa2,bf16x8 pa3){
  #pragma unroll
  for(int d0=0;d0<2;++d0){s16x4 lo[4],hi[4];
    #pragma unroll
    for(int ks=0;ks<4;++ks){
      asm volatile("ds_read_b64_tr_b16 %0,%1 offset:%c2":"=&v"(lo[ks]):"v"(vb),"i"(d0*4096+ks*1024):"memory");
      asm volatile("ds_read_b64_tr_b16 %0,%1 offset:%c2":"=&v"(hi[ks]):"v"(vb),"i"(d0*4096+ks*1024+512):"memory");}
    asm volatile("s_waitcnt lgkmcnt(0)":::"memory");SBAR();
    #define PK(k) (bf16x8){lo[k][0],lo[k][1],lo[k][2],lo[k][3],hi[k][0],hi[k][1],hi[k][2],hi[k][3]}
    o[d0]=__builtin_amdgcn_mfma_f32_32x32x16_bf16(pa0,PK(0),o[d0],0,0,0);
    o[d0]=__builtin_amdgcn_mfma_f32_32x32x16_bf16(pa1,PK(1),o[d0],0,0,0);
    o[d0]=__builtin_amdgcn_mfma_f32_32x32x16_bf16(pa2,PK(2),o[d0],0,0,0);
    o[d0]=__builtin_amdgcn_mfma_f32_32x32x16_bf16(pa3,PK(3),o[d0],0,0,0);
    #undef PK
  }
}

#ifndef ATTN_STORE16
#define ATTN_STORE16(p,v) (*(u32x4*)(p)=(v))
#endif
template<int MODE,int THRL> __device__ __forceinline__ void attn_unit(int b,int qb,int tb,int cq,int cv,int co,const bf16*Q,const bf16*__restrict__ K,const bf16*__restrict__ V,bf16*O,const float*tabsrc,char*shm){
  int tid_=threadIdx.x; asm volatile("":"+v"(tid_));
  const int tid=tid_,lane=tid&63,r32=lane&31,hi=lane>>5; const int wid=__builtin_amdgcn_readfirstlane(tid>>6);
  const long rowbase=(long)b*SEQ, rowbase_k=(long)b*KROWS; const int q0=qb*QB;
  const bf16*Qw=Q+(rowbase+q0+wid*QBLK)*DM+cq;
  const bf16*Kh=K+rowbase_k*DM+cq,*Vh=V+rowbase_k*DM+cv;
  const unsigned lds0=(unsigned)(uintptr_t)shm;
  const __attribute__((address_space(3))) char* shm3_=(const __attribute__((address_space(3))) char*)shm;
  float*wsf=(float*)(shm+LDS_WS)+wid*64;
  const bf16*ksrc=Kh+(long)(lane+64*tb)*DM+wid*8;
  const bf16*vsrc=Vh+(long)(16*(wid&3)+(lane>>2)+64*tb)*DM+(wid>>2)*32+(lane&3)*8;
  const unsigned kdst=lds0+LDS_K+wid*1024, vdst=lds0+LDS_V+wid*1024;
  #define DMA_K(t,slot) glds16(ksrc+(long)(t)*KVBLK*DM,(unsigned)__builtin_amdgcn_readfirstlane(kdst+(slot)))
  #define DMA_V(t,slot) glds16(vsrc+(long)(t)*KVBLK*DM,(unsigned)__builtin_amdgcn_readfirstlane(vdst+(slot)))
  const int vb0=(int)(lds0+LDS_V)+((lane>>4)&1)*32+(lane&3)*8+(4*hi+((lane&15)>>2))*64;
  const char*Kbase=shm+LDS_K; bf16x8 kf[8];
  const lds_cptr shm3=(lds_cptr)shm; const lds_cptr kp0=shm3+LDS_K+hi*1024+r32*16; const lds_cptr vp0=shm3+LDS_V+((lane>>4)&1)*32+(lane&3)*8+(4*hi+((lane&15)>>2))*64;
  const int NT=(KPRE+q0+QB+KVBLK)/KVBLK-tb;
  const __attribute__((address_space(3))) float* tab=(const __attribute__((address_space(3))) float*)(shm3_+LDS_TAB);
  { __attribute__((address_space(3))) float* tw=(__attribute__((address_space(3))) float*)(shm3_+LDS_TAB);
    if(MODE==0){ for(int i=tid;i<RT_SIZE;i+=512){ const int d=i-RT_OFFS; tw[i]=d<0?-INFINITY:(d<128?tabsrc[d]:0.f); } }
    else { const int n=KPRE+q0+QB+KVBLK; for(int i=64*tb+tid*4;i<n;i+=2048){ const float4 v=*(const float4*)(tabsrc+i); tw[i]=v.x;tw[i+1]=v.y;tw[i+2]=v.z;tw[i+3]=v.w; } } }
  if(tb==0){ glds16(K+cq+(long)lane*DM+wid*8,(unsigned)__builtin_amdgcn_readfirstlane(kdst)); glds16(V+cv+(long)(16*(wid&3)+(lane>>2))*DM+(wid>>2)*32+(lane&3)*8,(unsigned)__builtin_amdgcn_readfirstlane(vdst)); } else { DMA_K(0,0); DMA_V(0,0); } DMA_K(1,SLOTB);
  bf16x8 qr[4];
  #pragma unroll
  for(int d0=0;d0<4;++d0)qr[d0]=*reinterpret_cast<const bf16x8*>(&Qw[(long)r32*DM+d0*16+hi*8]);
  float l_reg=0.f;f32x16 o[2];o[0]=f32x16{};o[1]=f32x16{};f32x16 negm=f32x16{};asm volatile("":"+v"(negm));
  const int qrel=wid*QBLK+r32, q_abs=q0+qrel;
  #define MODT(P0,P1,t,SL) do{ if(SL)modtile_slow<MODE>(P0,P1,(t)+tb,q_abs,q0,hi,tab); else if(MODE==1)modtile_fast1(P0,P1,(t)+tb,hi,tab); }while(0)
  bool resc=false;
  #define START(P0,P1) do{ const float rm=rowmax(P0,P1); resc=false; \
    { const float dl=(MODE==1)?__builtin_fmaxf(rm,0.f):rm; const float nm_=fsub_s(negm[0],dl); \
      _Pragma("unroll") for(int r=0;r<16;++r){P0[r]=fsub_s(P0[r],dl);P1[r]=fsub_s(P1[r],dl);} \
      _Pragma("unroll") for(int r=0;r<16;++r)negm[r]=nm_; asm volatile("":"+v"(negm)); } \
    _Pragma("unroll") for(int r=0;r<16;++r)P0[r]=__builtin_amdgcn_exp2f(P0[r]); }while(0)
  #define RESC() do{ if(resc){ asm volatile("s_waitcnt lgkmcnt(0)":::"memory"); \
      _Pragma("unroll") for(int d_=0;d_<2;++d_) _Pragma("unroll") for(int r=0;r<16;++r)o[d_][r]*=wsf[crow(r,hi)]; } }while(0)
  f32x16 pA0,pA1,pB0,pB1;
  int sl_prev=0,sl_cur=0,sl_next=SLOTB;
  #define ROT() do{sl_prev=sl_cur;sl_cur=sl_next;sl_next=(sl_next==(NSLOT-1)*SLOTB)?0:sl_next+SLOTB;}while(0)
  DMA_K(2,2*SLOTB);
  WAIT_BAR(3);
  if(MODE==1){ const float m0_=tab[KPRE+q_abs]; _Pragma("unroll") for(int r=0;r<16;++r)negm[r]=-m0_; asm volatile("":"+v"(negm)); }
  qkt(pA0,pA1,Kbase,qr,negm,r32,hi);asm volatile("s_nop 15\n\ts_nop 7":"+v"(pA0),"+v"(pA1));MODT(pA0,pA1,0,true);
  START(pA0,pA1);
  _Pragma("unroll") for(int r=0;r<16;++r)pA1[r]=__builtin_amdgcn_exp2f(pA1[r]);
  WAIT_BAR(0);
  DMA_K(3,0);DMA_V(1,SLOTB);
  ROT();
  kload8(kf,kp0+sl_cur);
  WAIT_BAR(2);
  s16x4 vlo[8],vhi[8]; u32x4 pw0,pw1,pw2,pw3;
  #define PKW(P,B) cvtpk_s(P[B],P[B+1])
  #define PAF(k) __builtin_bit_cast(bf16x8,pw##k)
  #define VFR(i) (bf16x8){vlo[i][0],vlo[i][1],vlo[i][2],vlo[i][3],vhi[i][0],vhi[i][1],vhi[i][2],vhi[i][3]}
  #define PIN(x) asm volatile("":"+v"(x))
  #define MX3(a,b,c) __builtin_fmaxf(__builtin_fmaxf((a),(b)),(c))
  #define GAPA(MF,A0,A1,A2,A3,W0,W1,PW) do{ MF; sacc+=A0; sacc+=A1; sacc+=A2; sacc+=A3; PIN(sacc); W0; W1; PIN(PW); SBAR(); }while(0)
  #define EX(v) __builtin_amdgcn_exp2f(v)
  #define GAPB(MF,X,B) do{ MF; X[B]=EX(X[B]); X[B+1]=EX(X[B+1]); X[B+2]=EX(X[B+2]); X[B+3]=EX(X[B+3]); PIN(X); SBAR(); }while(0)
  #define VRD(i) do{ vlo[i]=vtr(vp_+(((i)>>2)*4096+((i)&3)*1024)); vhi[i]=vtr(vp_+(((i)>>2)*4096+((i)&3)*1024+512)); }while(0)
  #define KRD(G,j) do{ if(G){ kload2(kf,kp0+sl_next,j); SBAR(); } }while(0)
  #define STEP(C0,C1,P0,P1,t,GK,GV,GL,SL) do{ SBAR(); \
    const lds_cptr vp_=vp0+sl_prev; \
    VRD(0); SBAR(); float sacc=(P0[0]+P0[1]); \
    GAPA(C0=__builtin_amdgcn_mfma_f32_32x32x16_bf16(kf[0],qr[0],negm,0,0,0), P0[2],P0[3],P0[4],P0[5],     pw0[0]=PKW(P0,0), pw0[1]=PKW(P0,2), pw0); \
    VRD(4); SBAR(); GAPA(C1=__builtin_amdgcn_mfma_f32_32x32x16_bf16(kf[1],qr[0],negm,0,0,0), P0[6],P0[7],P0[8],P0[9],     pw0[2]=PKW(P0,4), pw0[3]=PKW(P0,6), pw0); \
    VRD(1); SBAR(); GAPA(C0=__builtin_amdgcn_mfma_f32_32x32x16_bf16(kf[2],qr[1],C0,0,0,0),   P0[10],P0[11],P0[12],P0[13], pw1[0]=PKW(P0,8), pw1[1]=PKW(P0,10), pw1); \
    VRD(5); SBAR(); GAPA(C1=__builtin_amdgcn_mfma_f32_32x32x16_bf16(kf[3],qr[1],C1,0,0,0),   P0[14],P0[15],P1[0],P1[1],   pw1[2]=PKW(P0,12),pw1[3]=PKW(P0,14), pw1); \
    VRD(2); SBAR(); GAPA(C0=__builtin_amdgcn_mfma_f32_32x32x16_bf16(kf[4],qr[2],C0,0,0,0),   P1[2],P1[3],P1[4],P1[5],     pw2[0]=PKW(P1,0), pw2[1]=PKW(P1,2), pw2); \
    VRD(6); SBAR(); GAPA(C1=__builtin_amdgcn_mfma_f32_32x32x16_bf16(kf[5],qr[2],C1,0,0,0),   P1[6],P1[7],P1[8],P1[9],     pw2[2]=PKW(P1,4), pw2[3]=PKW(P1,6), pw2); \
    VRD(3); SBAR(); GAPA(C0=__builtin_amdgcn_mfma_f32_32x32x16_bf16(kf[6],qr[3],C0,0,0,0),   P1[10],P1[11],P1[12],P1[13], pw3[0]=PKW(P1,8), pw3[1]=PKW(P1,10), pw3); \
    VRD(7); SBAR(); GAPA(C1=__builtin_amdgcn_mfma_f32_32x32x16_bf16(kf[7],qr[3],C1,0,0,0),   P1[14],P1[15],0.f,0.f,       pw3[2]=PKW(P1,12),pw3[3]=PKW(P1,14), pw3); \
    l_reg+=sacc; \
    if(GK){DMA_K((t)+3,sl_cur);} if(GV){DMA_V((t)+1,sl_next);} \
    MODT(C0,C1,t,SL); \
    { float a=MX3(C0[0],C0[1],C1[0]),b=MX3(C0[2],C0[3],C1[1]); a=MX3(a,C1[2],C1[3]); \
      _Pragma("unroll") for(int r=4;r<16;r+=4){a=MX3(a,C0[r],C0[r+1]);b=MX3(b,C0[r+2],C0[r+3]);a=MX3(a,C1[r],C1[r+1]);b=MX3(b,C1[r+2],C1[r+3]);} \
      float rm=__builtin_fmaxf(a,b); { auto rr=__builtin_amdgcn_permlane32_swap(__float_as_uint(rm),__float_as_uint(rm),false,false); rm=__builtin_fmaxf(__uint_as_float(rr[0]),__uint_as_float(rr[1])); } \
      resc=false; \
      if(__builtin_expect(__any(rm>(float)THRL),0)){ const float dl=__builtin_fmaxf(rm,0.f); const float nm_=negm[0]-dl; \
        _Pragma("unroll") for(int r=0;r<16;++r){C0[r]-=dl;C1[r]-=dl;} \
        _Pragma("unroll") for(int r=0;r<16;++r)negm[r]=nm_; asm volatile("":"+v"(negm)); \
        const float f=__builtin_amdgcn_exp2f(-dl); l_reg*=f; if(hi==0){ int r32_=r32; asm volatile("":"+v"(r32_)); wsf[r32_]=f; } resc=true; } } \
    SBAR(); \
    GAPB(o[0]=__builtin_amdgcn_mfma_f32_32x32x16_bf16(PAF(0),VFR(0),o[0],0,0,0), C0,0); \
    GAPB(o[1]=__builtin_amdgcn_mfma_f32_32x32x16_bf16(PAF(0),VFR(4),o[1],0,0,0), C0,4); \
    KRD(GL,0); GAPB(o[0]=__builtin_amdgcn_mfma_f32_32x32x16_bf16(PAF(1),VFR(1),o[0],0,0,0), C0,8); \
    KRD(GL,1); GAPB(o[1]=__builtin_amdgcn_mfma_f32_32x32x16_bf16(PAF(1),VFR(5),o[1],0,0,0), C0,12); \
    KRD(GL,2); GAPB(o[0]=__builtin_amdgcn_mfma_f32_32x32x16_bf16(PAF(2),VFR(2),o[0],0,0,0), C1,0); \
    KRD(GL,3); GAPB(o[1]=__builtin_amdgcn_mfma_f32_32x32x16_bf16(PAF(2),VFR(6),o[1],0,0,0), C1,4); \
    GAPB(o[0]=__builtin_amdgcn_mfma_f32_32x32x16_bf16(PAF(3),VFR(3),o[0],0,0,0), C1,8); \
    GAPB(o[1]=__builtin_amdgcn_mfma_f32_32x32x16_bf16(PAF(3),VFR(7),o[1],0,0,0), C1,12); \
    }while(0)
  int t=1;
  #define ENDW(tt) do{ if((tt)+3<NT){WAIT_BAR(2);} else if((tt)+2<NT){WAIT_BAR(1);} else {WAIT_BAR(0);} }while(0)
  for(;t+(MODE==1?5:7)<NT;t+=2){
    STEP(pB0,pB1,pA0,pA1,t,true,true,true,false);     WAIT_BAR(2); RESC(); ROT();
    STEP(pA0,pA1,pB0,pB1,t+1,true,true,true,false);   WAIT_BAR(2); RESC(); ROT();
  }
  for(;t+1<NT;t+=2){
    STEP(pB0,pB1,pA0,pA1,t,(t+3<NT),(t+1<NT),(t+1<NT),true);       ENDW(t);   RESC(); ROT();
    STEP(pA0,pA1,pB0,pB1,t+1,(t+4<NT),(t+2<NT),(t+2<NT),true);     ENDW(t+1); RESC(); ROT();
  }
  STEP(pB0,pB1,pA0,pA1,NT-1,false,false,false,true); RESC();
  { float sacc=pB0[0]+pB0[1]; _Pragma("unroll") for(int r=2;r<16;++r)sacc+=pB0[r]; _Pragma("unroll") for(int r=0;r<16;++r)sacc+=pB1[r]; l_reg+=sacc;
    pw0=(u32x4){PKW(pB0,0),PKW(pB0,2),PKW(pB0,4),PKW(pB0,6)};pw1=(u32x4){PKW(pB0,8),PKW(pB0,10),PKW(pB0,12),PKW(pB0,14)};pw2=(u32x4){PKW(pB1,0),PKW(pB1,2),PKW(pB1,4),PKW(pB1,6)};pw3=(u32x4){PKW(pB1,8),PKW(pB1,10),PKW(pB1,12),PKW(pB1,14)};
    SBAR(); pv(o,vb0+sl_cur,PAF(0),PAF(1),PAF(2),PAF(3)); }
  #undef PKW
  #undef PAF
  #undef VFR
  #undef PIN
  #undef MX3
  #undef GAPA
  #undef GAPB
  #undef EX
  #undef VRD
  #undef KRD
  #undef STEP
  #undef ENDW
  {auto rr=__builtin_amdgcn_permlane32_swap(__float_as_uint(l_reg),__float_as_uint(l_reg),false,false);l_reg=__uint_as_float(rr[0])+__uint_as_float(rr[1]);}
  if(hi==0)wsf[32+r32]=l_reg;asm volatile("s_waitcnt lgkmcnt(0)":::"memory");
  float rli[16];
  #pragma unroll
  for(int r=0;r<16;++r)rli[r]=__builtin_amdgcn_rcpf(wsf[32+crow(r,hi)]);
  bf16*Ow=O+(rowbase+q0+wid*QBLK)*DM+co;
  { bf16*stg=(bf16*)(shm+LDS_OST)+wid*2048;
    #pragma unroll
    for(int r=0;r<16;++r){const int orow=crow(r,hi);
      #pragma unroll
      for(int d0=0;d0<2;++d0)stg[orow*64+d0*32+r32]=__float2bfloat16(o[d0][r]*rli[r]);}
    asm volatile("s_waitcnt lgkmcnt(0)":::"memory");
    #pragma unroll
    for(int i=0;i<4;++i){const int row=i*8+(lane>>3),ch=lane&7; const u32x4 v=*(const u32x4*)(stg+row*64+ch*8); ATTN_STORE16(Ow+(long)row*DM+ch*8,v);} }
  asm volatile("s_waitcnt lgkmcnt(0)\n\ts_barrier":::"memory");
  #undef DMA_K
  #undef DMA_V
  #undef MODT
  #undef START
  #undef RESC
  #undef ROT
}

template<int THRL> __device__ __forceinline__ void attn_unit_dv(int b,int qb,int cq,int cv,int co,const bf16*Q,const bf16*__restrict__ K,const bf16*__restrict__ V,bf16*O,const float*tabsrc,char*shm){
  int tid_=threadIdx.x; asm volatile("":"+v"(tid_));
  constexpr int MODE=0, tb=0; const int tid=tid_,lane=tid&63,r32=lane&31,hi=lane>>5; const int wid=__builtin_amdgcn_readfirstlane(tid>>6);
  constexpr int LDS_K=0, LDS_V=NSLOT*SLOTB, LDS_WS=LDS_V+NSLOT*2*SLOTB, LDS_OST=LDS_WS+NW*64*4, LDS_TAB=LDS_OST+NW*4096;
  static_assert(LDS_TAB+RT_SIZE*4<=131072,"dv LDS map");
  const long rowbase=(long)b*SEQ, rowbase_k=(long)b*KROWS; const int q0=qb*QB;
  const bf16*Qw=Q+(rowbase+q0+wid*QBLK)*DM+cq;
  const bf16*Kh=K+rowbase_k*DM+cq,*Vh=V+rowbase_k*DM+cv;
  const unsigned lds0=(unsigned)(uintptr_t)shm;
  const __attribute__((address_space(3))) char* shm3_=(const __attribute__((address_space(3))) char*)shm;
  float*wsf=(float*)(shm+LDS_WS)+wid*64;
  const bf16*ksrc=Kh+(long)(lane+64*tb)*DM+wid*8;
  const bf16*vsrc=Vh+(long)(16*(wid&3)+(lane>>2)+64*tb)*DM+(wid>>2)*32+(lane&3)*8;
  const unsigned kdst=lds0+LDS_K+wid*1024, vdst=lds0+LDS_V+wid*1024;
  #define DMA_K(t,slot) glds16(ksrc+(long)(t)*KVBLK*DM,(unsigned)__builtin_amdgcn_readfirstlane(kdst+(slot)))
  #define DMA_V(t,slot) do{ glds16(vsrc+(long)(t)*KVBLK*DM,(unsigned)__builtin_amdgcn_readfirstlane(vdst+2*(slot))); glds16(vsrc+(long)(t)*KVBLK*DM+64,(unsigned)__builtin_amdgcn_readfirstlane(vdst+2*(slot)+8192)); }while(0)
  const int vb0=(int)(lds0+LDS_V)+((lane>>4)&1)*32+(lane&3)*8+(4*hi+((lane&15)>>2))*64;
  const char*Kbase=shm+LDS_K; bf16x8 kf[8];
  const lds_cptr shm3=(lds_cptr)shm; const lds_cptr kp0=shm3+LDS_K+hi*1024+r32*16; const lds_cptr vp0=shm3+LDS_V+((lane>>4)&1)*32+(lane&3)*8+(4*hi+((lane&15)>>2))*64;
  const int NT=(KPRE+q0+QB+KVBLK)/KVBLK-tb;
  const __attribute__((address_space(3))) float* tab=(const __attribute__((address_space(3))) float*)(shm3_+LDS_TAB);
  { __attribute__((address_space(3))) float* tw=(__attribute__((address_space(3))) float*)(shm3_+LDS_TAB);
    if(MODE==0){ for(int i=tid;i<RT_SIZE;i+=512){ const int d=i-RT_OFFS; tw[i]=d<0?-INFINITY:(d<128?tabsrc[d]:0.f); } }
    else { const int n=KPRE+q0+QB+KVBLK; for(int i=64*tb+tid*4;i<n;i+=2048){ const float4 v=*(const float4*)(tabsrc+i); tw[i]=v.x;tw[i+1]=v.y;tw[i+2]=v.z;tw[i+3]=v.w; } } }
  if(tb==0){ glds16(K+cq+(long)lane*DM+wid*8,(unsigned)__builtin_amdgcn_readfirstlane(kdst)); glds16(V+cv+(long)(16*(wid&3)+(lane>>2))*DM+(wid>>2)*32+(lane&3)*8,(unsigned)__builtin_amdgcn_readfirstlane(vdst)); glds16(V+cv+(long)(16*(wid&3)+(lane>>2))*DM+(wid>>2)*32+(lane&3)*8+64,(unsigned)__builtin_amdgcn_readfirstlane(vdst+8192)); } else { DMA_K(0,0); DMA_V(0,0); } DMA_K(1,SLOTB);
  bf16x8 qr[4];
  #pragma unroll
  for(int d0=0;d0<4;++d0)qr[d0]=*reinterpret_cast<const bf16x8*>(&Qw[(long)r32*DM+d0*16+hi*8]);
  float mhat=0.f,l_reg=0.f;f32x16 o[4];o[0]=f32x16{};o[1]=f32x16{};o[2]=f32x16{};o[3]=f32x16{};const f32x16 zero16=f32x16{}; bool hasref=false;
  const int qrel=wid*QBLK+r32, q_abs=q0+qrel;
  #define MODT(P0,P1,t,SL) do{ if(SL)modtile_slow<MODE>(P0,P1,(t)+tb,q_abs,q0,hi,tab); else if(MODE==1)modtile_fast1(P0,P1,(t)+tb,hi,tab); }while(0)
  bool resc=false;
  #define START(P0,P1) do{ const float rm=rowmax(P0,P1); resc=false; mhat=(rm>=-64.f&&rm<64.f)?0.f:64.f*__builtin_floorf(rm*0.015625f+0.5f); hasref=__any(mhat!=0.f); \
    if(__builtin_expect(hasref,0)){ _Pragma("unroll") for(int r=0;r<16;++r){P0[r]-=mhat;P1[r]-=mhat;} } \
    _Pragma("unroll") for(int r=0;r<16;++r)P0[r]=__builtin_amdgcn_exp2f(P0[r]); }while(0)
  #define RESC() do{ if(resc){ asm volatile("s_waitcnt lgkmcnt(0)":::"memory"); \
      _Pragma("unroll") for(int d_=0;d_<4;++d_) _Pragma("unroll") for(int r=0;r<16;++r)o[d_][r]*=wsf[crow(r,hi)]; } }while(0)
  f32x16 pA0,pA1,pB0,pB1;
  int sl_prev=0,sl_cur=0,sl_next=SLOTB;
  #define ROT() do{sl_prev=sl_cur;sl_cur=sl_next;sl_next=(sl_next==(NSLOT-1)*SLOTB)?0:sl_next+SLOTB;}while(0)
  DMA_K(2,2*SLOTB);
  WAIT_BAR(3);
  qkt(pA0,pA1,Kbase,qr,zero16,r32,hi);asm volatile("s_nop 15\n\ts_nop 7":"+v"(pA0),"+v"(pA1));MODT(pA0,pA1,0,true);
  START(pA0,pA1);
  _Pragma("unroll") for(int r=0;r<16;++r)pA1[r]=__builtin_amdgcn_exp2f(pA1[r]);
  WAIT_BAR(0);
  DMA_K(3,0);DMA_V(1,SLOTB);
  ROT();
  kload8(kf,kp0+sl_cur);
  WAIT_BAR(3);
  s16x4 vlo[8],vhi[8],wlo[8],whi[8]; u32x4 pw0,pw1,pw2,pw3;
  #define PKW(P,B) cvtpk_s(P[B],P[B+1])
  #define PAF(k) __builtin_bit_cast(bf16x8,pw##k)
  #define VFR(i) (bf16x8){vlo[i][0],vlo[i][1],vlo[i][2],vlo[i][3],vhi[i][0],vhi[i][1],vhi[i][2],vhi[i][3]}
  #define WFR(i) (bf16x8){wlo[i][0],wlo[i][1],wlo[i][2],wlo[i][3],whi[i][0],whi[i][1],whi[i][2],whi[i][3]}
  #define WRD(i) do{ wlo[i]=vtr(vp_+((2+((i)>>2))*4096+((i)&3)*1024)); whi[i]=vtr(vp_+((2+((i)>>2))*4096+((i)&3)*1024+512)); SBAR(); }while(0)
  #define GAPB2(MF,X,B) do{ MF; X[B]=EX(X[B]); X[B+1]=EX(X[B+1]); PIN(X); SBAR(); }while(0)
  #define PIN(x) asm volatile("":"+v"(x))
  #define MX3(a,b,c) __builtin_fmaxf(__builtin_fmaxf((a),(b)),(c))
  #define GAPA(MF,A0,A1,A2,A3,W0,W1,PW) do{ MF; sacc+=A0; sacc+=A1; sacc+=A2; sacc+=A3; PIN(sacc); W0; W1; PIN(PW); SBAR(); }while(0)
  #define EX(v) __builtin_amdgcn_exp2f(v)
  #define GAPB(MF,X,B) do{ MF; X[B]=EX(X[B]); X[B+1]=EX(X[B+1]); X[B+2]=EX(X[B+2]); X[B+3]=EX(X[B+3]); PIN(X); SBAR(); }while(0)
  #define VRD(i) do{ vlo[i]=vtr(vp_+(((i)>>2)*4096+((i)&3)*1024)); vhi[i]=vtr(vp_+(((i)>>2)*4096+((i)&3)*1024+512)); }while(0)
  #define KRD(G,j) do{ if(G){ kload2(kf,kp0+sl_next,j); SBAR(); } }while(0)
  #define STEP(C0,C1,P0,P1,t,GK,GV,GL,SL) do{ SBAR(); \
    const lds_cptr vp_=vp0+2*sl_prev; \
    VRD(0); SBAR(); float sacc=(P0[0]+P0[1]); \
    GAPA(C0=__builtin_amdgcn_mfma_f32_32x32x16_bf16(kf[0],qr[0],zero16,0,0,0), P0[2],P0[3],P0[4],P0[5],     pw0[0]=PKW(P0,0), pw0[1]=PKW(P0,2), pw0); \
    VRD(4); SBAR(); GAPA(C1=__builtin_amdgcn_mfma_f32_32x32x16_bf16(kf[1],qr[0],zero16,0,0,0), P0[6],P0[7],P0[8],P0[9],     pw0[2]=PKW(P0,4), pw0[3]=PKW(P0,6), pw0); \
    VRD(1); SBAR(); GAPA(C0=__builtin_amdgcn_mfma_f32_32x32x16_bf16(kf[2],qr[1],C0,0,0,0),   P0[10],P0[11],P0[12],P0[13], pw1[0]=PKW(P0,8), pw1[1]=PKW(P0,10), pw1); \
    VRD(5); SBAR(); GAPA(C1=__builtin_amdgcn_mfma_f32_32x32x16_bf16(kf[3],qr[1],C1,0,0,0),   P0[14],P0[15],P1[0],P1[1],   pw1[2]=PKW(P0,12),pw1[3]=PKW(P0,14), pw1); \
    VRD(2); SBAR(); GAPA(C0=__builtin_amdgcn_mfma_f32_32x32x16_bf16(kf[4],qr[2],C0,0,0,0),   P1[2],P1[3],P1[4],P1[5],     pw2[0]=PKW(P1,0), pw2[1]=PKW(P1,2), pw2); \
    VRD(6); SBAR(); GAPA(C1=__builtin_amdgcn_mfma_f32_32x32x16_bf16(kf[5],qr[2],C1,0,0,0),   P1[6],P1[7],P1[8],P1[9],     pw2[2]=PKW(P1,4), pw2[3]=PKW(P1,6), pw2); \
    VRD(3); SBAR(); GAPA(C0=__builtin_amdgcn_mfma_f32_32x32x16_bf16(kf[6],qr[3],C0,0,0,0),   P1[10],P1[11],P1[12],P1[13], pw3[0]=PKW(P1,8), pw3[1]=PKW(P1,10), pw3); \
    VRD(7); SBAR(); GAPA(C1=__builtin_amdgcn_mfma_f32_32x32x16_bf16(kf[7],qr[3],C1,0,0,0),   P1[14],P1[15],0.f,0.f,       pw3[2]=PKW(P1,12),pw3[3]=PKW(P1,14), pw3); \
    l_reg+=sacc; \
    if(GK){DMA_K((t)+3,sl_cur);} if(GV){DMA_V((t)+1,sl_next);} \
    MODT(C0,C1,t,SL); \
    { float a=MX3(C0[0],C0[1],C1[0]),b=MX3(C0[2],C0[3],C1[1]); a=MX3(a,C1[2],C1[3]); \
      _Pragma("unroll") for(int r=4;r<16;r+=4){a=MX3(a,C0[r],C0[r+1]);b=MX3(b,C0[r+2],C0[r+3]);a=MX3(a,C1[r],C1[r+1]);b=MX3(b,C1[r+2],C1[r+3]);} \
      float rm=__builtin_fmaxf(a,b); { auto rr=__builtin_amdgcn_permlane32_swap(__float_as_uint(rm),__float_as_uint(rm),false,false); rm=__builtin_fmaxf(__uint_as_float(rr[0]),__uint_as_float(rr[1])); } \
      resc=false; \
      const float rmd=rm-mhat; \
      if(__builtin_expect(__any(rmd>64.f),0)){ const float dl=rmd>64.f?64.f*__builtin_floorf(rmd*0.015625f):0.f; mhat+=dl; hasref=true; \
        const float f=__builtin_amdgcn_exp2f(-dl); l_reg*=f; if(hi==0)wsf[r32]=f; resc=true; } \
      if(__builtin_expect(hasref,0)){ _Pragma("unroll") for(int r=0;r<16;++r){C0[r]-=mhat;C1[r]-=mhat;} } } \
    SBAR(); \
    WRD(0); GAPB2(o[0]=__builtin_amdgcn_mfma_f32_32x32x16_bf16(PAF(0),VFR(0),o[0],0,0,0), C0,0); \
    WRD(4); GAPB2(o[1]=__builtin_amdgcn_mfma_f32_32x32x16_bf16(PAF(0),VFR(4),o[1],0,0,0), C0,2); \
    WRD(1); GAPB2(o[0]=__builtin_amdgcn_mfma_f32_32x32x16_bf16(PAF(1),VFR(1),o[0],0,0,0), C0,4); \
    WRD(5); GAPB2(o[1]=__builtin_amdgcn_mfma_f32_32x32x16_bf16(PAF(1),VFR(5),o[1],0,0,0), C0,6); \
    WRD(2); GAPB2(o[0]=__builtin_amdgcn_mfma_f32_32x32x16_bf16(PAF(2),VFR(2),o[0],0,0,0), C0,8); \
    WRD(6); GAPB2(o[1]=__builtin_amdgcn_mfma_f32_32x32x16_bf16(PAF(2),VFR(6),o[1],0,0,0), C0,10); \
    WRD(3); GAPB2(o[0]=__builtin_amdgcn_mfma_f32_32x32x16_bf16(PAF(3),VFR(3),o[0],0,0,0), C0,12); \
    WRD(7); GAPB2(o[1]=__builtin_amdgcn_mfma_f32_32x32x16_bf16(PAF(3),VFR(7),o[1],0,0,0), C0,14); \
    KRD(GL,0); GAPB2(o[2]=__builtin_amdgcn_mfma_f32_32x32x16_bf16(PAF(0),WFR(0),o[2],0,0,0), C1,0); \
    KRD(GL,1); GAPB2(o[3]=__builtin_amdgcn_mfma_f32_32x32x16_bf16(PAF(0),WFR(4),o[3],0,0,0), C1,2); \
    KRD(GL,2); GAPB2(o[2]=__builtin_amdgcn_mfma_f32_32x32x16_bf16(PAF(1),WFR(1),o[2],0,0,0), C1,4); \
    KRD(GL,3); GAPB2(o[3]=__builtin_amdgcn_mfma_f32_32x32x16_bf16(PAF(1),WFR(5),o[3],0,0,0), C1,6); \
    GAPB2(o[2]=__builtin_amdgcn_mfma_f32_32x32x16_bf16(PAF(2),WFR(2),o[2],0,0,0), C1,8); \
    GAPB2(o[3]=__builtin_amdgcn_mfma_f32_32x32x16_bf16(PAF(2),WFR(6),o[3],0,0,0), C1,10); \
    GAPB2(o[2]=__builtin_amdgcn_mfma_f32_32x32x16_bf16(PAF(3),WFR(3),o[2],0,0,0), C1,12); \
    GAPB2(o[3]=__builtin_amdgcn_mfma_f32_32x32x16_bf16(PAF(3),WFR(7),o[3],0,0,0), C1,14); \
    }while(0)
  int t=1;
  #define ENDW(tt) do{ if((tt)+3<NT){WAIT_BAR(3);} else if((tt)+2<NT){WAIT_BAR(2);} else {WAIT_BAR(0);} }while(0)
  for(;t+(MODE==1?5:7)<NT;t+=2){
    STEP(pB0,pB1,pA0,pA1,t,true,true,true,false);     WAIT_BAR(3); RESC(); ROT();
    STEP(pA0,pA1,pB0,pB1,t+1,true,true,true,false);   WAIT_BAR(3); RESC(); ROT();
  }
  for(;t+1<NT;t+=2){
    STEP(pB0,pB1,pA0,pA1,t,(t+3<NT),(t+1<NT),(t+1<NT),true);       ENDW(t);   RESC(); ROT();
    STEP(pA0,pA1,pB0,pB1,t+1,(t+4<NT),(t+2<NT),(t+2<NT),true);     ENDW(t+1); RESC(); ROT();
  }
  STEP(pB0,pB1,pA0,pA1,NT-1,false,false,false,true); RESC();
  { float sacc=pB0[0]+pB0[1]; _Pragma("unroll") for(int r=2;r<16;++r)sacc+=pB0[r]; _Pragma("unroll") for(int r=0;r<16;++r)sacc+=pB1[r]; l_reg+=sacc;
    pw0=(u32x4){PKW(pB0,0),PKW(pB0,2),PKW(pB0,4),PKW(pB0,6)};pw1=(u32x4){PKW(pB0,8),PKW(pB0,10),PKW(pB0,12),PKW(pB0,14)};pw2=(u32x4){PKW(pB1,0),PKW(pB1,2),PKW(pB1,4),PKW(pB1,6)};pw3=(u32x4){PKW(pB1,8),PKW(pB1,10),PKW(pB1,12),PKW(pB1,14)};
    SBAR(); pv(o,vb0+2*sl_cur,PAF(0),PAF(1),PAF(2),PAF(3)); pv(o+2,vb0+2*sl_cur+8192,PAF(0),PAF(1),PAF(2),PAF(3)); }
  #undef PKW
  #undef PAF
  #undef VFR
  #undef PIN
  #undef MX3
  #undef GAPA
  #undef GAPB
  #undef EX
  #undef VRD
  #undef WRD
  #undef WFR
  #undef GAPB2
  #undef KRD
  #undef STEP
  #undef ENDW
  {auto rr=__builtin_amdgcn_permlane32_swap(__float_as_uint(l_reg),__float_as_uint(l_reg),false,false);l_reg=__uint_as_float(rr[0])+__uint_as_float(rr[1]);}
  if(hi==0)wsf[32+r32]=l_reg;asm volatile("s_waitcnt lgkmcnt(0)":::"memory");
  float rli[16];
  #pragma unroll
  for(int r=0;r<16;++r)rli[r]=__builtin_amdgcn_rcpf(wsf[32+crow(r,hi)]);
  bf16*Ow=O+(rowbase+q0+wid*QBLK)*DM+co;
  { bf16*stg=(bf16*)(shm+LDS_OST)+wid*2048;
    #pragma unroll
    for(int ps=0;ps<2;++ps){
      #pragma unroll
      for(int r=0;r<16;++r){const int orow=crow(r,hi);
        #pragma unroll
        for(int d0=0;d0<2;++d0)stg[orow*64+d0*32+r32]=__float2bfloat16(o[2*ps+d0][r]*rli[r]);}
      asm volatile("s_waitcnt lgkmcnt(0)":::"memory");
      #pragma unroll
      for(int i=0;i<4;++i){const int row=i*8+(lane>>3),ch=lane&7; const u32x4 v=*(const u32x4*)(stg+row*64+ch*8); ATTN_STORE16(Ow+(long)row*DM+ps*64+ch*8,v);}
      asm volatile("s_waitcnt lgkmcnt(0)":::"memory"); } }
  asm volatile("s_waitcnt lgkmcnt(0)\n\ts_barrier":::"memory");
  #undef DMA_K
  #undef DMA_V
  #undef MODT
  #undef START
  #undef RESC
  #undef ROT
}
constexpr int ATTN_LDS_BYTES=LDS_BYTES;
#undef SBAR
#undef WAIT_BAR
}
#define GAS __attribute__((address_space(1)))
#define LAS __attribute__((address_space(3)))
typedef unsigned short bf16;
typedef unsigned v4u __attribute__((ext_vector_type(4)));
typedef float f32x4 __attribute__((ext_vector_type(4)));
typedef short bf16x8 __attribute__((ext_vector_type(8)));
typedef GAS unsigned gu32;
typedef GAS unsigned long long gu64;
#define RLX_AGENT __ATOMIC_RELAXED, __HIP_MEMORY_SCOPE_AGENT
#define LDS_WAIT() asm volatile("s_waitcnt lgkmcnt(0)" ::: "memory")
#define VM_WAIT() asm volatile("s_waitcnt vmcnt(0)" ::: "memory")
__device__ __forceinline__ unsigned long long rt() { return __builtin_amdgcn_s_memrealtime(); }
__device__ __forceinline__ unsigned f2bf(float f) { unsigned u = __builtin_bit_cast(unsigned, f); return (u + 0x7fffu + ((u >> 16) & 1u)) >> 16; }
__device__ __forceinline__ unsigned pk2(float lo, float hi) { return f2bf(lo) | (f2bf(hi) << 16); }

#define XB_TMO      128
#define XB_XCNT(j)  (256  + 64 * (j))
#define XB_XSUB(j)  (1280 + 64 * (j))
#define XB_XGEN(j)  (2304 + 64 * (j))
#define XB_TOP      3328
#define XB_TOPGEN   3392
#define XCD_BAR_WORDS 3456
#define XB_SPIN_CAP (1u << 18)

__device__ __forceinline__ unsigned xb_ld(unsigned* p)              { return __hip_atomic_load(p, __ATOMIC_RELAXED, __HIP_MEMORY_SCOPE_AGENT); }
__device__ __forceinline__ unsigned xb_add(unsigned* p, unsigned v) { return __hip_atomic_fetch_add(p, v, __ATOMIC_RELAXED, __HIP_MEMORY_SCOPE_AGENT); }
__device__ __forceinline__ unsigned xb_xcc_id() { return (unsigned)__builtin_amdgcn_s_getreg((3 << 11) | 20) & 0xFu; }
#define XB_SPIN(cond, bar) do { unsigned _sp = 0; while (cond) { __builtin_amdgcn_s_sleep(1); \
    if ((++_sp & 255u) == 0u) { if (xb_ld(&(bar)[XB_TMO])) break; if (_sp > XB_SPIN_CAP) { atomicAdd(&(bar)[XB_TMO], 1u); break; } } } } while (0)

struct XcdBarrier {
    unsigned* bar; unsigned x;
    volatile LAS unsigned* st;
};

__device__ __forceinline__ XcdBarrier xcd_barrier_post(unsigned* bar, volatile LAS unsigned* st) {
    XcdBarrier b; b.bar = bar; b.x = xb_xcc_id(); b.st = st;
    if (threadIdx.x == 0) (void)xb_add(&bar[XB_XCNT(b.x)], 1u);
    return b;
}
__device__ __forceinline__ void xcd_barrier_complete(unsigned* bar, unsigned x, unsigned& nloc, unsigned& nx) {
    const unsigned G = gridDim.x * gridDim.y * gridDim.z;
    unsigned sum, cnt, mine, sp = 0u;
    for (;;) {
        sum = 0u; cnt = 0u; mine = 0u;
#pragma unroll
        for (unsigned j = 0; j < 16; ++j) { const unsigned c = xb_ld(&bar[XB_XCNT(j)]); sum += c; cnt += (c > 0u) ? 1u : 0u; mine = (j == x) ? c : mine; }
        if (sum == G) break;
        __builtin_amdgcn_s_sleep(1);
        if ((++sp & 255u) == 0u) { if (xb_ld(&bar[XB_TMO])) break; if (sp > XB_SPIN_CAP) { atomicAdd(&bar[XB_TMO], 1u); break; } }
    }
    nloc = mine > 0u ? mine : 1u; nx = cnt > 0u ? cnt : 1u;
}

__device__ __forceinline__ void xcd_barrier(const XcdBarrier& b) {
    asm volatile("s_waitcnt vmcnt(0)" ::: "memory");
    __syncthreads();
    if (threadIdx.x == 0) {
        unsigned* bar = b.bar;
        __builtin_amdgcn_s_waitcnt(0);
        unsigned nloc = b.st[0], nx = b.st[1];
        if (nloc == 0u) { xcd_barrier_complete(bar, b.x, nloc, nx); b.st[0] = nloc; b.st[1] = nx; }
        const unsigned old = xb_add(&bar[XB_XSUB(b.x)], 1u);
        const unsigned gen = old / nloc;
        if (old + 1u == (gen + 1u) * nloc) {
            __builtin_amdgcn_fence(__ATOMIC_RELEASE, "agent");
            asm volatile("s_waitcnt vmcnt(0)" ::: "memory");
            const unsigned og = xb_add(&bar[XB_TOP], 1u);
            const unsigned tg = og / nx;
            if (og + 1u == (tg + 1u) * nx) xb_add(&bar[XB_TOPGEN], 1u);
            else XB_SPIN(xb_ld(&bar[XB_TOPGEN]) == tg, bar);
            __builtin_amdgcn_fence(__ATOMIC_ACQUIRE, "agent");
            xb_add(&bar[XB_XGEN(b.x)], 1u);
            asm volatile("s_waitcnt vmcnt(0)" ::: "memory");
        } else {
            XB_SPIN(xb_ld(&bar[XB_XGEN(b.x)]) == gen, bar);
            __builtin_amdgcn_fence(__ATOMIC_ACQUIRE, "agent");
            asm volatile("s_waitcnt vmcnt(0)" ::: "memory");
        }
    }
    __syncthreads();
}

constexpr int NWAVES = 8;
#ifndef MK_PER_PHASE
#define MK_PER_PHASE 0
#endif
constexpr int N_PHASES = 16;

constexpr size_t MiB = 1u << 20;
constexpr size_t WS_CTL = 0, CTL_ZERO_BYTES = 1 * MiB;
constexpr size_t WS_GV = 1 * MiB + 512 * 1024;
constexpr size_t WS_HM = 2 * MiB;
constexpr size_t WS_TAB = 2 * MiB + 256 * 1024;
constexpr size_t WS_LF = 3 * MiB;
constexpr size_t WS_DK = 6 * MiB;
constexpr size_t WS_LIST = 9 * MiB;
constexpr int LCAP = NSLOT;
constexpr size_t WS_WQKV0 = 18 * MiB, WS_WO0 = 24 * MiB, WS_WQKV1 = 26 * MiB, WS_WO1 = 32 * MiB, WS_WGU = 34 * MiB, WS_WD = 98 * MiB;
constexpr size_t WS_XH = 130 * MiB;
constexpr size_t WS_Q = 195 * MiB;
constexpr size_t WS_K = 260 * MiB, WS_V = 325 * MiB;
constexpr size_t WS_O0 = 390 * MiB;
constexpr size_t WS_END = 455 * MiB;
static_assert(WS_LIST + (size_t)NEXP * LCAP * 4 <= WS_WQKV0 && WS_DK + (size_t)NBATCH * 16 * KROWS * 4 <= WS_LIST && WS_LF + (size_t)NRP * 16 * 4 <= WS_DK, "small arrays");
static_assert(WS_XH + (size_t)NRP * DM * 2 <= WS_Q && WS_Q + (size_t)NRP * DM * 2 <= WS_K && WS_K + (size_t)NBATCH * KROWS * DM * 2 <= WS_V && WS_V + (size_t)NBATCH * KROWS * DM * 2 <= WS_O0 && WS_O0 + (size_t)NRP * DM * 2 <= WS_END, "activations");
static_assert(WS_K + (size_t)NSLOT * DM * 2 <= WS_O0 && WS_O0 + (size_t)NSLOT * DEXP * 2 <= WS_END, "MoE overlays");
constexpr int CW_TMO = 0, CW_CODE = 1;
constexpr int CW_BAR = 4096;
constexpr int CW_QM = 131072, CW_KM = 147456, CW_QCTR = 148480;
constexpr int CW_CNT = 65536;
constexpr int RING_OFF = 0, RING_BYTES = 131072;
constexpr int ROWTAB_OFF = RING_BYTES, ROWTAB_UNITS = 12;
constexpr int MOEPRE_OFF = ROWTAB_OFF + ROWTAB_UNITS * 1024;
constexpr int MISC_OFF = MOEPRE_OFF + 512;
constexpr int LDS_BYTES = 147456;
static_assert(MISC_OFF + 128 <= LDS_BYTES && attn_body::ATTN_LDS_BYTES <= RING_BYTES, "LDS map");

struct Params {
    const float *x, *meta, *rel_bias, *w_qkv, *lam, *subln, *w_o, *fox_w_in, *fox_b_f, *fox_w_o, *ln_mix_g, *ln_mix_b, *ln_ffn_g, *ln_ffn_b, *rg_w, *rg_b, *re_w, *re_b, *w_gate, *w_up, *w_down;
    float* out; unsigned char* ws; int ph_lo, ph_hi, li, pad;
};
struct Ctx { int tid, lane, wave, vcu, G; LAS unsigned char* lds; };
__device__ __forceinline__ Ctx fresh(const Ctx& C) { Ctx r = C; int t = threadIdx.x; asm volatile("" : "+v"(t)); r.tid = t; r.lane = t & 63; r.wave = __builtin_amdgcn_readfirstlane(t >> 6); return r; }

using pg8::shx;
__device__ __forceinline__ float wave_sum(float v, int lane) {
#pragma unroll
    for (int o = 1; o < 64; o <<= 1) v += shx(v, o, lane);
    return v;
}
__device__ __forceinline__ float bf2f(unsigned short h) { return __uint_as_float((unsigned)h << 16); }
__device__ __forceinline__ float bflo(unsigned w) { return __uint_as_float(w << 16); }
__device__ __forceinline__ float bfhi(unsigned w) { return __uint_as_float(w & 0xffff0000u); }
__device__ __forceinline__ int meta_slot(int j) { return j; }

__device__ __forceinline__ void tr_item(const float* W, int ldw, int k0, int n0, bf16* WT, int ldt, int drow0, LAS float* scr, int lane) {
#pragma unroll 8
    for (int i = 0; i < 32; ++i) { const int kk = 2 * i + (lane >> 5); scr[kk * 33 + (lane & 31)] = W[(size_t)(k0 + kk) * ldw + n0 + (lane & 31)]; }
    LDS_WAIT(); asm volatile("" ::: "memory");
    const int c = lane & 7;
#pragma unroll
    for (int j = 0; j < 4; ++j) { const int n = (lane >> 3) + 8 * j; const LAS float* s = scr + (8 * c) * 33 + n;
        v4u o; o.x = pk2(s[0 * 33], s[1 * 33]); o.y = pk2(s[2 * 33], s[3 * 33]); o.z = pk2(s[4 * 33], s[5 * 33]); o.w = pk2(s[6 * 33], s[7 * 33]);
        *(GAS v4u*)(WT + (size_t)(drow0 + n) * ldt + k0 + 8 * c) = o; }
    LDS_WAIT(); asm volatile("" ::: "memory");
}
__device__ __forceinline__ void convert_experts(const Params& p, const Ctx& C, int layer, int first_item, int gw, int NGW) {
    LAS float* scr = (LAS float*)(C.lds + RING_OFF + C.wave * 16384);
    bf16* Wgu = (bf16*)(p.ws + WS_WGU); bf16* Wd = (bf16*)(p.ws + WS_WD);
    constexpr int PER_E = 768, NIT = NEXP * PER_E;
    for (int it = gw - first_item; it < NIT; it += NGW) { if (it < 0) continue;
        const int e = it / PER_E; int r = it % PER_E; const size_t eo = (size_t)(layer * NEXP + e);
        if (r < 512) { const bool up = r >= 256; r &= 255; const int kb = r >> 4, nb = r & 15, n0 = 32 * nb;
            tr_item((up ? p.w_up : p.w_gate) + eo * DM * DEXP, DEXP, 64 * kb, n0, Wgu + (size_t)e * DM * DM, DM, (n0 >> 7) * 256 + (n0 & 127) + (up ? 128 : 0), scr, C.lane); }
        else { r -= 512; const int kb = r >> 5, nb = r & 31;
            tr_item(p.w_down + eo * DEXP * DM, DM, 64 * kb, 32 * nb, Wd + (size_t)e * DM * DEXP, DEXP, 32 * nb, scr, C.lane); } }
}
__device__ __forceinline__ void p0_prologue(const Params& p, const Ctx& C) {
    LAS float* scr = (LAS float*)(C.lds + RING_OFF + C.wave * 16384);
    const int gw = C.vcu * NWAVES + C.wave, NGW = C.G * NWAVES;
    for (int it = gw; it < 4096; it += NGW) { int r = it;
        if (r < 1536) { tr_item(p.w_qkv, 3072, 64 * (r / 96), 32 * (r % 96), (bf16*)(p.ws + WS_WQKV0), DM, 32 * (r % 96), scr, C.lane); continue; } r -= 1536;
        if (r < 512) { tr_item(p.w_o, DM, 64 * (r >> 5), 32 * (r & 31), (bf16*)(p.ws + WS_WO0), DM, 32 * (r & 31), scr, C.lane); continue; } r -= 512;
        if (r < 1536) { tr_item(p.fox_w_in, 3088, 64 * (r / 96), 32 * (r % 96), (bf16*)(p.ws + WS_WQKV1), DM, 32 * (r % 96), scr, C.lane); continue; } r -= 1536;
        tr_item(p.fox_w_o, DM, 64 * (r >> 5), 32 * (r & 31), (bf16*)(p.ws + WS_WO1), DM, 32 * (r & 31), scr, C.lane); }
    convert_experts(p, C, 0, 0, gw, NGW);
    bf16* XH = (bf16*)(p.ws + WS_XH);
    for (int m = gw; m < NRP; m += NGW) {
        GAS unsigned long long* o8 = (GAS unsigned long long*)(XH + (size_t)m * DM) + C.lane;
        if (m < NR) { const GAS f32x4* xr = (const GAS f32x4*)(m < NREAL ? p.x + (size_t)m * DM : p.meta + (size_t)(m - NREAL) * DM) + C.lane;
#pragma unroll
            for (int j = 0; j < 4; ++j) { const f32x4 v = xr[64 * j]; o8[64 * j] = (unsigned long long)pk2(v.x, v.y) | ((unsigned long long)pk2(v.z, v.w) << 32); } }
        else {
#pragma unroll
            for (int j = 0; j < 4; ++j) o8[64 * j] = 0ull; } }
    { const int gt = C.vcu * (NWAVES * 64) + C.tid;
      if (gt < 16 * 128) { const int m = gt >> 7, d = gt & 127; int bk = d;
          if (d >= 16) { bk = 16 + (d >= 19) + (d >= 21) + (d >= 24) + (d >= 27) + (d >= 31) + (d >= 35) + (d >= 40) + (d >= 46) + (d >= 52) + (d >= 59) + (d >= 67) + (d >= 77) + (d >= 87) + (d >= 99) + (d >= 113); }
          ((float*)(p.ws + WS_TAB))[gt] = (p.rel_bias[bk * 16 + m] - p.rel_bias[31 * 16 + m]) * LOG2E; } }
}

__device__ __forceinline__ float diff_lambda_full(const Params& p, int lane) {
    const float a = p.lam[lane] * p.lam[64 + lane], b = p.lam[128 + lane] * p.lam[192 + lane];
    return __expf(wave_sum(a, lane)) - __expf(wave_sum(b, lane)) + LAMBDA_INIT0;
}
__device__ __forceinline__ void combine_rows(const Params& p, const Ctx& C, int b, int h, int qb, float lam) {
    const int lane = C.lane;
    const bf16* O0 = (const bf16*)(p.ws + WS_O0); const bf16* O1 = (const bf16*)p.out; bf16* OA = (bf16*)(p.ws + WS_Q);
    float sw[8];
#pragma unroll
    for (int c = 0; c < 8; ++c) sw[c] = p.subln[8 * (lane & 15) + c] * (1.f - LAMBDA_INIT0);
    asm volatile("s_waitcnt vmcnt(0)" ::: "memory");
#pragma unroll 2
    for (int i = 0; i < 8; ++i) { const size_t off = (size_t)(b * SEQ + 256 * qb + 32 * C.wave + 4 * i + (lane >> 4)) * DM + h * 128 + 8 * (lane & 15);
        const v4u a = *(const GAS v4u*)(O0 + off), bq = *(const GAS v4u*)(O1 + off);
        float dd[8]; const unsigned aw[4] = {a.x, a.y, a.z, a.w}, bw[4] = {bq.x, bq.y, bq.z, bq.w}; float ss = 0.f;
#pragma unroll
        for (int c = 0; c < 4; ++c) { dd[2 * c] = bflo(aw[c]) - lam * bflo(bw[c]); dd[2 * c + 1] = bfhi(aw[c]) - lam * bfhi(bw[c]); ss += dd[2 * c] * dd[2 * c] + dd[2 * c + 1] * dd[2 * c + 1]; }
        ss += shx(ss, 1, lane); ss += shx(ss, 2, lane); ss += shx(ss, 4, lane); ss += shx(ss, 8, lane);
        const float rs = 1.f / sqrtf(ss * (1.f / 128.f) + LN_EPS);
        v4u o; o.x = pk2(dd[0] * rs * sw[0], dd[1] * rs * sw[1]); o.y = pk2(dd[2] * rs * sw[2], dd[3] * rs * sw[3]); o.z = pk2(dd[4] * rs * sw[4], dd[5] * rs * sw[5]); o.w = pk2(dd[6] * rs * sw[6], dd[7] * rs * sw[7]);
        *(GAS v4u*)(OA + off) = o; }
}
__device__ __forceinline__ void diff_meta_attn(const Params& p, const Ctx& C, float lam) {
    const int gw = C.vcu * NWAVES + C.wave, lane = C.lane; bf16* OA = (bf16*)(p.ws + WS_Q);
    if (gw < 128) { const int h = gw >> 4, j = gw & 15, kj = lane & 15, s = (lane >> 4) & 1, m = 2 * h + s;
        const bf16* Q = (const bf16*)(p.ws + WS_Q); const bf16* K = (const bf16*)(p.ws + WS_K); const bf16* V = (const bf16*)(p.ws + WS_V);
        const bf16* qp = Q + (size_t)(NREAL + j) * DM + m * 64; const bf16* kp = K + (size_t)meta_slot(kj) * DM + m * 64;
        float dot = 0.f;
#pragma unroll
        for (int c = 0; c < 8; ++c) { const v4u qa = *(const GAS v4u*)(qp + 8 * c), ka = *(const GAS v4u*)(kp + 8 * c); const unsigned qw[4] = {qa.x, qa.y, qa.z, qa.w}, kw[4] = {ka.x, ka.y, ka.z, ka.w};
#pragma unroll
            for (int e = 0; e < 4; ++e) dot += bflo(qw[e]) * bflo(kw[e]) + bfhi(qw[e]) * bfhi(kw[e]); }
        float sc = (kj <= j) ? dot + p.rel_bias[(j - kj) * 16 + m] * LOG2E : -INFINITY;
        float mx = sc; mx = fmaxf(mx, shx(mx, 1, lane)); mx = fmaxf(mx, shx(mx, 2, lane)); mx = fmaxf(mx, shx(mx, 4, lane)); mx = fmaxf(mx, shx(mx, 8, lane));
        float pe = __builtin_amdgcn_exp2f(sc - mx); float l = pe; l += shx(l, 1, lane); l += shx(l, 2, lane); l += shx(l, 4, lane); l += shx(l, 8, lane);
        pe /= l;
        const float a = pe - lam * shx(pe, 16, lane);
        float o0 = 0.f, o1 = 0.f;
        for (int k2 = 0; k2 <= j; ++k2) { const float ak = __builtin_amdgcn_readlane(a, k2); const unsigned vw = *(const GAS unsigned*)(V + (size_t)meta_slot(k2) * DM + h * 128 + 2 * lane); o0 += ak * bflo(vw); o1 += ak * bfhi(vw); }
        const float ss = wave_sum(o0 * o0 + o1 * o1, lane); const float rs = 1.f / sqrtf(ss * (1.f / 128.f) + LN_EPS);
        const float w0 = p.subln[2 * lane] * (1.f - LAMBDA_INIT0), w1 = p.subln[2 * lane + 1] * (1.f - LAMBDA_INIT0);
        *(GAS unsigned*)(OA + (size_t)(NREAL + j) * DM + h * 128 + 2 * lane) = pk2(o0 * rs * w0, o1 * rs * w1); }
}
__device__ __forceinline__ void fox_meta_attn(const Params& p, const Ctx& C) {
    const int gw = C.vcu * NWAVES + C.wave, lane = C.lane;
    if (gw < 256) { const int h = gw >> 4, j = gw & 15, kj = lane & 15;
        bf16* Q = (bf16*)(p.ws + WS_Q); const bf16* K = (const bf16*)(p.ws + WS_K); const bf16* V = (const bf16*)(p.ws + WS_V); const float* DK = (const float*)(p.ws + WS_DK) + (size_t)h * KROWS;
        const bf16* qp = Q + (size_t)(NREAL + j) * DM + h * 64; const bf16* kp = K + (size_t)meta_slot(kj) * DM + h * 64;
        float dot = 0.f;
#pragma unroll
        for (int c = 0; c < 8; ++c) { const v4u qa = *(const GAS v4u*)(qp + 8 * c), ka = *(const GAS v4u*)(kp + 8 * c); const unsigned qw[4] = {qa.x, qa.y, qa.z, qa.w}, kw[4] = {ka.x, ka.y, ka.z, ka.w};
#pragma unroll
            for (int e = 0; e < 4; ++e) dot += bflo(qw[e]) * bflo(kw[e]) + bfhi(qw[e]) * bfhi(kw[e]); }
        float sc = (kj <= j) ? dot + DK[meta_slot(kj)] - DK[meta_slot(j)] : -INFINITY;
        float mx = sc; mx = fmaxf(mx, shx(mx, 1, lane)); mx = fmaxf(mx, shx(mx, 2, lane)); mx = fmaxf(mx, shx(mx, 4, lane)); mx = fmaxf(mx, shx(mx, 8, lane));
        float pe = __builtin_amdgcn_exp2f(sc - mx); float l = pe; l += shx(l, 1, lane); l += shx(l, 2, lane); l += shx(l, 4, lane); l += shx(l, 8, lane);
        pe /= l;
        float o = 0.f;
        for (int k2 = 0; k2 <= j; ++k2) { const float ak = __builtin_amdgcn_readlane(pe, k2); o += ak * bf2f(V[(size_t)meta_slot(k2) * DM + h * 64 + lane]); }
        ((bf16*)(p.ws + WS_O0))[(size_t)(NREAL + j) * DM + h * 64 + lane] = (bf16)f2bf(o); }
}

typedef float f32x4m __attribute__((ext_vector_type(4)));
template <int KIND> __device__ __forceinline__ void ln_phase(const Params& p, const Ctx& C, int layer) {
    constexpr int NCB = (KIND == 0) ? 3 : (KIND == 1 ? 1 : 0), NC = 16 * (NCB ? NCB : 1);
    constexpr int AT_PITCH = 1028;
    const int tid = C.tid, lane = C.lane, wave = C.wave;
    LAS float* At = (LAS float*)(C.lds + RING_OFF);
    LAS float* part = (LAS float*)(C.lds + RING_OFF + 65792);
    LAS float* logit = (LAS float*)(C.lds + RING_OFF + 90368);
    LAS int* sl_e = (LAS int*)(C.lds + RING_OFF + 93440);
    LAS int* cnt_l = (LAS int*)(C.lds + RING_OFF + 94720);
    const float* gsrc = (KIND == 0 ? p.ln_mix_g : p.ln_ffn_g) + layer * DM; const float* bsrc = (KIND == 0 ? p.ln_mix_b : p.ln_ffn_b) + layer * DM;
    f32x4 gv[4], bv[4];
#pragma unroll
    for (int j = 0; j < 4; ++j) { gv[j] = *(const GAS f32x4*)(gsrc + 4 * lane + 256 * j); bv[j] = *(const GAS f32x4*)(bsrc + 4 * lane + 256 * j); }
    float Bf[NCB ? NCB : 1][8][4];
    if constexpr (NCB > 0) { const int kq = lane >> 4, col = lane & 15;
#pragma unroll
        for (int cb = 0; cb < NCB; ++cb)
#pragma unroll
            for (int g = 0; g < 8; ++g)
#pragma unroll
                for (int c = 0; c < 4; ++c) { const int k = 128 * wave + 16 * g + 4 * kq + c, cc = cb * 16 + col; float w;
                    if (KIND == 0) w = cc < 4 ? p.rg_w[((size_t)layer * DM + k) * 4 + cc] : (cc < 36 ? p.re_w[((size_t)layer * DM + k) * 32 + (cc - 4)] : 0.f);
                    else w = p.fox_w_in[(size_t)k * 3088 + 3072 + cc];
                    Bf[cb][g][c] = w; } }
    if (KIND == 0) { if (tid < 96) cnt_l[tid] = 0; }
    bf16* XH = (bf16*)(p.ws + WS_XH); const bf16* Y = (const bf16*)(p.ws + WS_K);
    constexpr int NTILES = NR / 16;
    int it = 0;
    unsigned long long vv[2][4], yy[2][2][4], nv[2][4], ny[2][2][4];
#define LN_LOAD(VV, YY, TILE) do { _Pragma("unroll") for (int rr = 0; rr < 2; ++rr) { const int row_ = (TILE) * 16 + wave * 2 + rr; \
            _Pragma("unroll") for (int j = 0; j < 4; ++j) VV[rr][j] = *((const GAS unsigned long long*)(XH + (size_t)row_ * DM) + lane + 64 * j); \
            if (KIND != 0) { _Pragma("unroll") for (int j = 0; j < 4; ++j) { YY[rr][0][j] = *(const GAS unsigned long long*)(Y + (size_t)(2 * row_) * DM + 4 * lane + 256 * j); YY[rr][1][j] = *(const GAS unsigned long long*)(Y + (size_t)(2 * row_ + 1) * DM + 4 * lane + 256 * j); } } } } while (0)
    if (C.vcu < NTILES) LN_LOAD(nv, ny, C.vcu);
    for (int tile = C.vcu; tile < NTILES; tile += C.G, ++it) {
#pragma unroll
        for (int rr = 0; rr < 2; ++rr)
#pragma unroll
            for (int j = 0; j < 4; ++j) { vv[rr][j] = nv[rr][j]; if (KIND != 0) { yy[rr][0][j] = ny[rr][0][j]; yy[rr][1][j] = ny[rr][1][j]; } }
#pragma unroll
        for (int rr = 0; rr < 2; ++rr) { const int rl = wave * 2 + rr, row = tile * 16 + rl;
            f32x4 v[4];
#pragma unroll
            for (int j = 0; j < 4; ++j) { const unsigned h0 = (unsigned)vv[rr][j], h1 = (unsigned)(vv[rr][j] >> 32); v[j] = (f32x4){bflo(h0), bfhi(h0), bflo(h1), bfhi(h1)}; }
            if (KIND != 0) {
#pragma unroll
                for (int j = 0; j < 4; ++j) { const unsigned long long y0 = yy[rr][0][j], y1 = yy[rr][1][j];
                    const unsigned a0 = (unsigned)y0, a1 = (unsigned)(y0 >> 32), b0 = (unsigned)y1, b1 = (unsigned)(y1 >> 32);
                    v[j].x = v[j].x * ALPHA + (bflo(a0) + bflo(b0)); v[j].y = v[j].y * ALPHA + (bfhi(a0) + bfhi(b0)); v[j].z = v[j].z * ALPHA + (bflo(a1) + bflo(b1)); v[j].w = v[j].w * ALPHA + (bfhi(a1) + bfhi(b1)); } }
            float s = 0.f;
#pragma unroll
            for (int j = 0; j < 4; ++j) s += (v[j].x + v[j].y) + (v[j].z + v[j].w);
            const float mean = wave_sum(s, lane) * (1.f / DM); float s2 = 0.f;
#pragma unroll
            for (int j = 0; j < 4; ++j) { v[j] = v[j] - mean; s2 += (v[j].x * v[j].x + v[j].y * v[j].y) + (v[j].z * v[j].z + v[j].w * v[j].w); }
            const float rstd = 1.f / sqrtf(wave_sum(s2, lane) * (1.f / DM) + LN_EPS);
#pragma unroll
            for (int j = 0; j < 4; ++j) v[j] = v[j] * rstd * gv[j] + bv[j];
            if (KIND == 2) { if (row < NREAL) {
#pragma unroll
                for (int j = 0; j < 4; ++j) *(GAS f32x4*)(p.out + (size_t)row * DM + 4 * lane + 256 * j) = v[j]; } }
            else {
#pragma unroll
                for (int j = 0; j < 4; ++j) {
                    *((GAS unsigned long long*)(XH + (size_t)row * DM) + lane + 64 * j) = (unsigned long long)pk2(v[j].x, v[j].y) | ((unsigned long long)pk2(v[j].z, v[j].w) << 32);
                    *(LAS f32x4*)(At + rl * AT_PITCH + 4 * lane + 256 * j) = v[j]; } } }
        if (tile + C.G < NTILES) LN_LOAD(nv, ny, tile + C.G);
        if constexpr (NCB > 0) {
            __syncthreads();
            f32x4m acc[NCB];
#pragma unroll
            for (int cb = 0; cb < NCB; ++cb) acc[cb] = (f32x4m){0.f, 0.f, 0.f, 0.f};
#pragma unroll
            for (int g = 0; g < 8; ++g) { const f32x4 a4 = *(const LAS f32x4*)(At + (lane & 15) * AT_PITCH + 128 * wave + 16 * g + 4 * (lane >> 4));
#pragma unroll
                for (int c = 0; c < 4; ++c)
#pragma unroll
                    for (int cb = 0; cb < NCB; ++cb) acc[cb] = __builtin_amdgcn_mfma_f32_16x16x4f32(a4[c], Bf[cb][g][c], acc[cb], 0, 0, 0); }
#pragma unroll
            for (int cb = 0; cb < NCB; ++cb)
#pragma unroll
                for (int r = 0; r < 4; ++r) part[(wave * 16 + 4 * (lane >> 4) + r) * 48 + cb * 16 + (lane & 15)] = acc[cb][r];
            __syncthreads();
            for (int idx = tid; idx < 16 * NC; idx += NWAVES * 64) { const int rw = idx / NC, cl = idx % NC; float sacc = 0.f;
#pragma unroll
                for (int w = 0; w < 8; ++w) sacc += part[(w * 16 + rw) * 48 + cl];
                logit[rw * 48 + cl] = sacc; }
            __syncthreads();
            if (KIND == 0) { if (tid < 16) { const int row = tile * 16 + tid; const LAS float* lg = logit + tid * 48;
                float gl[4]; int gs = 0;
#pragma unroll
                for (int i = 0; i < 4; ++i) gl[i] = lg[i] + p.rg_b[layer * 4 + i];
#pragma unroll
                for (int i = 1; i < 4; ++i) if (gl[i] > gl[gs]) gs = i;
                float den = 0.f;
#pragma unroll
                for (int i = 0; i < 4; ++i) den += __expf(gl[i] - gl[gs]);
                const float pg = 1.f / den;
                float el[8];
#pragma unroll
                for (int i = 0; i < 8; ++i) el[i] = lg[4 + gs * 8 + i] + p.re_b[layer * 32 + gs * 8 + i];
                int i0 = 0;
#pragma unroll
                for (int i = 1; i < 8; ++i) if (el[i] > el[i0]) i0 = i;
                int i1 = (i0 == 0) ? 1 : 0;
#pragma unroll
                for (int i = 0; i < 8; ++i) if (i != i0 && el[i] > el[i1]) i1 = i;
                const float ex = __expf(el[i1] - el[i0]); const float w0 = 1.f / (1.f + ex), w1 = ex * w0;
                float* GVp = (float*)(p.ws + WS_GV); GVp[2 * row] = pg * w0; GVp[2 * row + 1] = pg * w1;
                sl_e[it * 32 + 2 * tid] = gs * 8 + i0; sl_e[it * 32 + 2 * tid + 1] = gs * 8 + i1; } }
            else { if (tid < 256) { const int rw = tid >> 4, hh = tid & 15; const float vv = logit[rw * 48 + hh] + p.fox_b_f[hh];
                ((float*)(p.ws + WS_LF))[(size_t)(tile * 16 + rw) * 16 + hh] = fminf(vv, 0.f) - __builtin_amdgcn_logf(1.f + __builtin_amdgcn_exp2f(-fabsf(vv) * LOG2E)) * 0.69314718056f;   } }
        }
    }
#undef LN_LOAD
    if (KIND == 0) {
        gu32* CNT = (gu32*)(p.ws + WS_CTL) + CW_CNT + layer * 2048; int* LIST = (int*)(p.ws + WS_LIST);
        __syncthreads();
        const int nloc = it * 32;
        for (int s = tid; s < nloc; s += NWAVES * 64) atomicAdd((int*)&cnt_l[sl_e[s]], 1);
        __syncthreads();
        if (tid < 32) { const int n = cnt_l[tid]; cnt_l[32 + tid] = n > 0 ? (int)__hip_atomic_fetch_add(CNT + 64 * tid, (unsigned)n, RLX_AGENT) : 0; cnt_l[64 + tid] = 0; }
        __syncthreads();
        for (int s = tid; s < nloc; s += NWAVES * 64) { const int e = sl_e[s]; const int pos = cnt_l[32 + e] + atomicAdd((int*)&cnt_l[64 + e], 1);
            const int tl = C.vcu + (s >> 5) * C.G; LIST[(size_t)e * LCAP + pos] = 2 * (tl * 16 + ((s & 31) >> 1)) + (s & 1); }
    }
    __syncthreads();
}

__device__ __forceinline__ void cumsum_job(const Params& p, const Ctx& C) {
    if (C.vcu >= 64) return;
    const int b = C.vcu >> 4, h = C.vcu & 15, tid = C.tid, lane = C.lane, wave = C.wave;
    const float* LF = (const float*)(p.ws + WS_LF); float* DK = (float*)(p.ws + WS_DK) + (size_t)(b * 16 + h) * KROWS;
    LAS float* wt = (LAS float*)(C.lds + RING_OFF);
    float cm = 0.f, mine = 0.f; const int myj = (tid < NMETA) ? tid : -1;
    for (int i = 0; i < NMETA; ++i) { cm += LF[(size_t)(NREAL + i) * 16 + h]; if (i == myj) mine = cm; }
    if (tid < KPRE) DK[tid] = (myj >= 0) ? -mine * LOG2E : 0.f;
    if (tid < 64) DK[KPRE + SEQ + tid] = 0.f;
    const float* lp = LF + (size_t)(b * SEQ + tid * 16) * 16 + h;
    float run = 0.f;
#pragma unroll 1
    for (int i = 0; i < 16; ++i) run += lp[i * 16];
    float inc = run;
#pragma unroll
    for (int o = 1; o < 64; o <<= 1) { const float t = __uint_as_float((unsigned)__builtin_amdgcn_ds_bpermute((lane - o) << 2, (int)__float_as_uint(inc))); if (lane >= o) inc += t; }
    if (lane == 63) wt[wave] = inc;
    __syncthreads();
    float base = cm;
    for (int w = 0; w < wave; ++w) base += wt[w];
    base += inc - run;
#pragma unroll 1
    for (int i = 0; i < 16; ++i) { base += lp[i * 16]; DK[KPRE + tid * 16 + i] = -base * LOG2E; }
    __syncthreads();
}

template <int KIND> __device__ __forceinline__ void meta_proj(const Params& p, const Ctx& C, const bf16* A, const bf16* Wt, int ntasks, unsigned* km) {
    if (C.wave != 0 || C.vcu >= ntasks) return;
    typedef float f32x4m_ __attribute__((ext_vector_type(4)));
    const int lane = C.lane, j = lane & 15, kq = lane >> 4, c0 = 16 * C.vcu;
    const GAS v4u* ap = (const GAS v4u*)(A + (size_t)(NREAL + j) * DM + 8 * kq); const GAS v4u* bp = (const GAS v4u*)(Wt + (size_t)(c0 + j) * DM + 8 * kq);
    f32x4m_ acc = {0.f, 0.f, 0.f, 0.f};
#pragma unroll 8
    for (int ks = 0; ks < 32; ++ks) { const v4u a = ap[4 * ks], b = bp[4 * ks];
        acc = __builtin_amdgcn_mfma_f32_16x16x32_bf16(__builtin_bit_cast(bf16x8, a), __builtin_bit_cast(bf16x8, b), acc, 0, 0, 0); }
    const int c = c0 + j;
    if (KIND == 0) { const int t = c >> 10, cc = c & 1023; bf16* Qb = (bf16*)(p.ws + WS_Q); bf16* kvb = (bf16*)(p.ws + (t == 1 ? WS_K : WS_V));
#pragma unroll
        for (int r = 0; r < 4; ++r) { const int i = 4 * kq + r; if (t == 0) Qb[(size_t)(NREAL + i) * DM + cc] = (bf16)f2bf(acc[r] * attn_body::C2); else kvb[(size_t)i * DM + cc] = (bf16)f2bf(acc[r]); }
        if (km != nullptr && t == 1) {
#pragma unroll
            for (int r = 0; r < 4; ++r) { float ss = acc[r] * acc[r]; ss += shx(ss, 1, lane); ss += shx(ss, 2, lane); ss += shx(ss, 4, lane); ss += shx(ss, 8, lane);
                float mx = ss; mx = fmaxf(mx, shx(mx, 16, lane)); mx = fmaxf(mx, shx(mx, 32, lane));
                acc[r] = mx; }
            const float m4 = fmaxf(fmaxf(acc[0], acc[1]), fmaxf(acc[2], acc[3]));
            if (lane == 0) { const int head = cc >> 6, quarter = (cc >> 4) & 3;
                for (int b = 0; b < NBATCH; ++b) atomicMax(km + ((size_t)b * 16 + head) * 8 + 2 + quarter, __float_as_uint(m4)); } } }
    else { bf16* H = (bf16*)(p.ws + WS_XH);
#pragma unroll
        for (int r = 0; r < 4; ++r) { const size_t o = (size_t)(NREAL + 4 * kq + r) * DM + c; H[o] = (bf16)f2bf(acc[r] + ALPHA * bf2f(H[o])); } }
}

struct MoeOrder {
    int G, c, UT; const LAS int* pre; const char* A; const char* W; size_t wexp, tsB;
    __device__ __forceinline__ bool next(int i, pg8::Unit& u) const {
        const int g = i * G + c; if (g >= UT || i >= ROWTAB_UNITS) return false;
        const int rt = g >> 2; int e = 0; while (pre[e + 1] <= rt) ++e;
        u.pm = rt - pre[e]; u.pn = g & 3; u.A = A; u.B = W + (size_t)e * wexp + (size_t)u.pn * tsB; u.tab = i; u.e = e; return true;
    }
};
__device__ __forceinline__ int moe_setup(const Params& p, const Ctx& C, int layer, MoeOrder& S) {
    LAS int* pre = (LAS int*)(C.lds + MOEPRE_OFF); LAS int* cnts = pre + 40; LAS int* rowtab = (LAS int*)(C.lds + ROWTAB_OFF);
    const gu32* CNT = (const gu32*)(p.ws + WS_CTL) + CW_CNT + layer * 2048;
    if (C.tid < 32) cnts[C.tid] = (int)__hip_atomic_load(CNT + 64 * C.tid, RLX_AGENT);
    __syncthreads();
    if (C.tid == 0) { int a = 0; for (int e = 0; e < NEXP; ++e) { pre[e] = a; a += (cnts[e] + 255) >> 8; } pre[NEXP] = a; }
    __syncthreads();
    S.pre = pre; S.UT = 4 * pre[NEXP];
    const int* LIST = (const int*)(p.ws + WS_LIST);
    pg8::Unit u;
    for (int i = 0; S.next(i, u); ++i) { if (C.tid < 256) { const int idx = 256 * u.pm + C.tid; rowtab[i * 256 + C.tid] = idx < cnts[u.e] ? LIST[(size_t)u.e * LCAP + idx] : -1; } }
    __syncthreads();
    return S.UT;
}

__global__ void __launch_bounds__(NWAVES * 64, 2) trunk_fwd(Params p) {
    extern __shared__ __attribute__((aligned(16))) unsigned char lds[];
    Ctx C;
    C.lds = (LAS unsigned char*)lds; C.tid = threadIdx.x; C.lane = C.tid & 63; C.wave = __builtin_amdgcn_readfirstlane(C.tid >> 6);
    C.G = gridDim.x; { const int bx = blockIdx.x; C.vcu = (C.G % 8 == 0) ? (bx % 8) * (C.G / 8) + bx / 8 : bx; }
    volatile LAS unsigned* MISC = (volatile LAS unsigned*)(C.lds + MISC_OFF);
    gu32* ctl = (gu32*)(p.ws + WS_CTL);
    if (C.tid < 32) MISC[C.tid] = 0u;
    __syncthreads();
    XcdBarrier bar; bar.bar = (unsigned*)(ctl + CW_BAR) + p.li * XCD_BAR_WORDS; bar.x = 0; bar.st = nullptr;
    if (!MK_PER_PHASE) bar = xcd_barrier_post((unsigned*)(ctl + CW_BAR) + p.li * XCD_BAR_WORDS, MISC + 8);
#define GRID_BAR() do { if (MK_PER_PHASE) { if (C.tid == 0) __hip_atomic_store(ctl + CW_TMO, 0xBADBA0u, RLX_AGENT); } else { xcd_barrier(bar); } } while (0)
    const int lo = p.ph_lo, hi = p.ph_hi;
#ifndef SUBMASK
#define SUBMASK 0x7f
#endif
#ifndef REP_MASK
#define REP_MASK 0
#endif
#define NREP(k) (((REP_MASK >> (k)) & 1) ? 2 : 1)
#ifndef PHASE_MASK
#define PHASE_MASK 0xffff
#endif
#define IN(k) (((PHASE_MASK >> (k)) & 1) && lo <= (k) && (k) < hi)
#define SEAM(k) do { if (IN(k) && IN((k) + 1)) GRID_BAR(); } while (0)
    bf16* XH = (bf16*)(p.ws + WS_XH); bf16* QB = (bf16*)(p.ws + WS_Q); bf16* KB = (bf16*)(p.ws + WS_K); bf16* VB = (bf16*)(p.ws + WS_V);
    bf16* O0 = (bf16*)(p.ws + WS_O0); bf16* O1 = (bf16*)p.out;
    const LAS int* rowtab = (const LAS int*)(C.lds + ROWTAB_OFF);

    if (IN(0)) { for (int rep_ = 0; rep_ < NREP(0); ++rep_) p0_prologue(p, fresh(C)); } SEAM(0);

    { constexpr int layer = 0;
        const int pb = 1 + (layer ? 8 : 0);
        if ((SUBMASK & 1) && IN(pb)) { for (int rep_ = 0; rep_ < NREP(pb); ++rep_) {
            if (layer == 1) cumsum_job(p, fresh(C));
            meta_proj<0>(p, fresh(C), XH, (const bf16*)(p.ws + (layer ? WS_WQKV1 : WS_WQKV0)), 3 * DM / 16, layer ? (unsigned*)(ctl + CW_KM) : nullptr);
            pg8::StaticOrder S; S.init(NREAL, 3 * DM, C.G, (int)blockIdx.x, XH, DM * 2, p.ws + (layer ? WS_WQKV1 : WS_WQKV0), DM * 2);
            pg8::EpiQKV E{QB, KB, VB, attn_body::C2, layer ? (unsigned*)(ctl + CW_QM) : nullptr, (unsigned*)(ctl + CW_KM)};
            pg8::gemm_phase<pg8::EpiQKV, pg8::StaticOrder, true, false>(C.lds + RING_OFF, DM, DM * 2, S, E, rowtab, 0);
        } } SEAM(pb);
        if (layer == 0) {
            if (IN(2)) { for (int rep_ = 0; rep_ < NREP(2); ++rep_) {
                const float* TAB = (const float*)(p.ws + WS_TAB);
                const float lam = diff_lambda_full(p, fresh(C).lane);
                for (int it = C.vcu; it < NBATCH * 8 * 16; it += C.G) { const int bh = it >> 4, s = it & 15, b = bh >> 3, h = bh & 7;
#pragma unroll 1
                    for (int w = 0; w < 2; ++w) { const int qb = w ? s : 31 - s;
#pragma unroll 1
                        for (int mm = 0; mm < 2; ++mm) attn_body::attn_unit_dv<8>(b, qb, (2 * h + mm) * 64, h * 128, h * 128, (const attn_body::bf16*)QB, (const attn_body::bf16*)KB, (const attn_body::bf16*)VB, (attn_body::bf16*)(mm ? O1 : O0), TAB + (2 * h + mm) * 128, (char*)lds + RING_OFF);
                        combine_rows(p, fresh(C), b, h, qb, lam); } }
                diff_meta_attn(p, fresh(C), lam);
            } } SEAM(2);
        } else {
            if (IN(10)) { for (int rep_ = 0; rep_ < NREP(10); ++rep_) {
                const float* DK = (const float*)(p.ws + WS_DK);
                for (;;) {
                    const int lane_ = fresh(C).lane;
                    int tko = MOEPRE_OFF; asm volatile("" : "+s"(tko)); LAS int* tk = (LAS int*)(C.lds + tko);
                    if (fresh(C).tid == 0) tk[0] = (int)__hip_atomic_fetch_add(ctl + CW_QCTR + 64 * rep_, 1u, RLX_AGENT);
                    __syncthreads(); const int u = tk[0]; __syncthreads();
                    if (u >= NBATCH * 16 * 32) break;
                    const int qb = 31 - (u >> 6), bh = u & 63, b = bh >> 4, h = bh & 15;
                    const float* dk = DK + (size_t)bh * KROWS;
                    const unsigned qmb = lane_ < 8 ? __hip_atomic_load(ctl + CW_QM + ((size_t)(b * 32 + qb) * 16 + h) * 8 + lane_, RLX_AGENT) : 0u;
                    const unsigned kmb = lane_ < 8 ? __hip_atomic_load(ctl + CW_KM + ((size_t)bh) * 8 + lane_, RLX_AGENT) : 0u;
                    const int ntf = 4 * qb + 6;
                    float e0 = lane_ < ntf ? dk[lane_ == 0 ? NMETA - 1 : 64 * lane_ + 63] : 0.f, e1 = lane_ + 64 < ntf ? dk[64 * (lane_ + 64) + 63] : 0.f, e2 = lane_ + 128 < ntf ? dk[64 * (lane_ + 128) + 63] : 0.f;
                    const float q2 = wave_sum(__uint_as_float(qmb), lane_), k2 = fmaxf(wave_sum(lane_ < 2 ? __uint_as_float(kmb) : 0.f, lane_), wave_sum(lane_ >= 2 ? __uint_as_float(kmb) : 0.f, lane_));
                    const float thr = dk[KPRE + 256 * qb] - 40.f - 2.1f * sqrtf(q2 * k2);
                    const unsigned long long m0 = __ballot(lane_ < ntf && e0 >= thr), m1 = __ballot(lane_ + 64 < ntf && e1 >= thr), m2 = __ballot(lane_ + 128 < ntf && e2 >= thr);
                    int tb = m0 ? __builtin_ctzll(m0) : (m1 ? 64 + __builtin_ctzll(m1) : (m2 ? 128 + __builtin_ctzll(m2) : ntf - 6));
                    tb &= ~1; tb = tb > ntf - 6 ? ntf - 6 : tb; tb = __builtin_amdgcn_readfirstlane(tb);
                    attn_body::attn_unit<1, 8>(b, qb, tb, h * 64, h * 64, h * 64, (const attn_body::bf16*)QB, (const attn_body::bf16*)KB, (const attn_body::bf16*)VB, (attn_body::bf16*)O0, dk, (char*)lds + RING_OFF);
                }
                fox_meta_attn(p, fresh(C));
            } } SEAM(10);
        }
        const int pw = layer ? 11 : 4;
        if ((SUBMASK & 4) && IN(pw)) { for (int rep_ = 0; rep_ < NREP(pw); ++rep_) {
            meta_proj<1>(p, fresh(C), layer ? O0 : QB, (const bf16*)(p.ws + (layer ? WS_WO1 : WS_WO0)), DM / 16, nullptr);
            pg8::StaticOrder S; S.init(NREAL, DM, C.G, (int)blockIdx.x, layer ? O0 : QB, DM * 2, p.ws + (layer ? WS_WO1 : WS_WO0), DM * 2);
            pg8::EpiZ E{XH};
            pg8::gemm_phase<pg8::EpiZ, pg8::StaticOrder, true, false>(C.lds + RING_OFF, DM, DM * 2, S, E, rowtab, 0);
        } } SEAM(pw);
        if ((SUBMASK & 8) && IN(pw + 1)) { ln_phase<0>(p, fresh(C), layer); } SEAM(pw + 1);
        if ((SUBMASK & 16) && IN(pw + 2)) { for (int rep_ = 0; rep_ < NREP(pw + 2); ++rep_) {
            MoeOrder S; S.G = C.G; S.c = C.vcu;     S.A = (const char*)XH; S.W = (const char*)(p.ws + WS_WGU); S.wexp = (size_t)DM * DM * 2; S.tsB = (size_t)256 * DM * 2;
            moe_setup(p, fresh(C), layer, S);
            pg8::EpiGU E{(pg8::bf16_t*)O0};
            pg8::gemm_phase<pg8::EpiGU, MoeOrder, true, true>(C.lds + RING_OFF, DM, DM * 2, S, E, rowtab, 1);
        } } SEAM(pw + 2);
        if ((SUBMASK & 32) && IN(pw + 3)) { for (int rep_ = 0; rep_ < NREP(pw + 3); ++rep_) {
            MoeOrder S; S.G = C.G; S.c = C.vcu;     S.A = (const char*)O0; S.W = (const char*)(p.ws + WS_WD); S.wexp = (size_t)DM * DEXP * 2; S.tsB = (size_t)256 * DEXP * 2;
            moe_setup(p, fresh(C), layer, S);
            pg8::EpiDown E{(pg8::bf16_t*)KB, (const float*)(p.ws + WS_GV)};
            pg8::gemm_phase<pg8::EpiDown, MoeOrder, true, true>(C.lds + RING_OFF, DEXP, DEXP * 2, S, E, rowtab, 0);
        } } SEAM(pw + 3);
        if ((SUBMASK & 64) && IN(pw + 4)) {
            if (layer == 0) { ln_phase<1>(p, fresh(C), 0); { const Ctx Cf = fresh(C); convert_experts(p, Cf, 1, 0, Cf.vcu * NWAVES + Cf.wave, Cf.G * NWAVES); } }
            else ln_phase<2>(p, fresh(C), 1);
        }
        if (layer == 0) SEAM(8);
        }
    { constexpr int layer = 1;
        const int pb = 1 + (layer ? 8 : 0);
        if ((SUBMASK & 1) && IN(pb)) { for (int rep_ = 0; rep_ < NREP(pb); ++rep_) {
            if (layer == 1) cumsum_job(p, fresh(C));
            meta_proj<0>(p, fresh(C), XH, (const bf16*)(p.ws + (layer ? WS_WQKV1 : WS_WQKV0)), 3 * DM / 16, layer ? (unsigned*)(ctl + CW_KM) : nullptr);
            pg8::StaticOrder S; S.init(NREAL, 3 * DM, C.G, (int)blockIdx.x, XH, DM * 2, p.ws + (layer ? WS_WQKV1 : WS_WQKV0), DM * 2);
            pg8::EpiQKV E{QB, KB, VB, attn_body::C2, layer ? (unsigned*)(ctl + CW_QM) : nullptr, (unsigned*)(ctl + CW_KM)};
            pg8::gemm_phase<pg8::EpiQKV, pg8::StaticOrder, true, false>(C.lds + RING_OFF, DM, DM * 2, S, E, rowtab, 0);
        } } SEAM(pb);
        if (layer == 0) {
            if (IN(2)) { for (int rep_ = 0; rep_ < NREP(2); ++rep_) {
                const float* TAB = (const float*)(p.ws + WS_TAB);
                const float lam = diff_lambda_full(p, fresh(C).lane);
                for (int it = C.vcu; it < NBATCH * 8 * 16; it += C.G) { const int bh = it >> 4, s = it & 15, b = bh >> 3, h = bh & 7;
#pragma unroll 1
                    for (int w = 0; w < 2; ++w) { const int qb = w ? s : 31 - s;
#pragma unroll 1
                        for (int mm = 0; mm < 2; ++mm) attn_body::attn_unit_dv<8>(b, qb, (2 * h + mm) * 64, h * 128, h * 128, (const attn_body::bf16*)QB, (const attn_body::bf16*)KB, (const attn_body::bf16*)VB, (attn_body::bf16*)(mm ? O1 : O0), TAB + (2 * h + mm) * 128, (char*)lds + RING_OFF);
                        combine_rows(p, fresh(C), b, h, qb, lam); } }
                diff_meta_attn(p, fresh(C), lam);
            } } SEAM(2);
        } else {
            if (IN(10)) { for (int rep_ = 0; rep_ < NREP(10); ++rep_) {
                const float* DK = (const float*)(p.ws + WS_DK);
                for (;;) {
                    const int lane_ = fresh(C).lane;
                    int tko = MOEPRE_OFF; asm volatile("" : "+s"(tko)); LAS int* tk = (LAS int*)(C.lds + tko);
                    if (fresh(C).tid == 0) tk[0] = (int)__hip_atomic_fetch_add(ctl + CW_QCTR + 64 * rep_, 1u, RLX_AGENT);
                    __syncthreads(); const int u = tk[0]; __syncthreads();
                    if (u >= NBATCH * 16 * 32) break;
                    const int qb = 31 - (u >> 6), bh = u & 63, b = bh >> 4, h = bh & 15;
                    const float* dk = DK + (size_t)bh * KROWS;
                    const unsigned qmb = lane_ < 8 ? __hip_atomic_load(ctl + CW_QM + ((size_t)(b * 32 + qb) * 16 + h) * 8 + lane_, RLX_AGENT) : 0u;
                    const unsigned kmb = lane_ < 8 ? __hip_atomic_load(ctl + CW_KM + ((size_t)bh) * 8 + lane_, RLX_AGENT) : 0u;
                    const int ntf = 4 * qb + 6;
                    float e0 = lane_ < ntf ? dk[lane_ == 0 ? NMETA - 1 : 64 * lane_ + 63] : 0.f, e1 = lane_ + 64 < ntf ? dk[64 * (lane_ + 64) + 63] : 0.f, e2 = lane_ + 128 < ntf ? dk[64 * (lane_ + 128) + 63] : 0.f;
                    const float q2 = wave_sum(__uint_as_float(qmb), lane_), k2 = fmaxf(wave_sum(lane_ < 2 ? __uint_as_float(kmb) : 0.f, lane_), wave_sum(lane_ >= 2 ? __uint_as_float(kmb) : 0.f, lane_));
                    const float thr = dk[KPRE + 256 * qb] - 40.f - 2.1f * sqrtf(q2 * k2);
                    const unsigned long long m0 = __ballot(lane_ < ntf && e0 >= thr), m1 = __ballot(lane_ + 64 < ntf && e1 >= thr), m2 = __ballot(lane_ + 128 < ntf && e2 >= thr);
                    int tb = m0 ? __builtin_ctzll(m0) : (m1 ? 64 + __builtin_ctzll(m1) : (m2 ? 128 + __builtin_ctzll(m2) : ntf - 6));
                    tb &= ~1; tb = tb > ntf - 6 ? ntf - 6 : tb; tb = __builtin_amdgcn_readfirstlane(tb);
                    attn_body::attn_unit<1, 8>(b, qb, tb, h * 64, h * 64, h * 64, (const attn_body::bf16*)QB, (const attn_body::bf16*)KB, (const attn_body::bf16*)VB, (attn_body::bf16*)O0, dk, (char*)lds + RING_OFF);
                }
                fox_meta_attn(p, fresh(C));
            } } SEAM(10);
        }
        const int pw = layer ? 11 : 4;
        if ((SUBMASK & 4) && IN(pw)) { for (int rep_ = 0; rep_ < NREP(pw); ++rep_) {
            meta_proj<1>(p, fresh(C), layer ? O0 : QB, (const bf16*)(p.ws + (layer ? WS_WO1 : WS_WO0)), DM / 16, nullptr);
            pg8::StaticOrder S; S.init(NREAL, DM, C.G, (int)blockIdx.x, layer ? O0 : QB, DM * 2, p.ws + (layer ? WS_WO1 : WS_WO0), DM * 2);
            pg8::EpiZ E{XH};
            pg8::gemm_phase<pg8::EpiZ, pg8::StaticOrder, true, false>(C.lds + RING_OFF, DM, DM * 2, S, E, rowtab, 0);
        } } SEAM(pw);
        if ((SUBMASK & 8) && IN(pw + 1)) { ln_phase<0>(p, fresh(C), layer); } SEAM(pw + 1);
        if ((SUBMASK & 16) && IN(pw + 2)) { for (int rep_ = 0; rep_ < NREP(pw + 2); ++rep_) {
            MoeOrder S; S.G = C.G; S.c = C.vcu;     S.A = (const char*)XH; S.W = (const char*)(p.ws + WS_WGU); S.wexp = (size_t)DM * DM * 2; S.tsB = (size_t)256 * DM * 2;
            moe_setup(p, fresh(C), layer, S);
            pg8::EpiGU E{(pg8::bf16_t*)O0};
            pg8::gemm_phase<pg8::EpiGU, MoeOrder, true, true>(C.lds + RING_OFF, DM, DM * 2, S, E, rowtab, 1);
        } } SEAM(pw + 2);
        if ((SUBMASK & 32) && IN(pw + 3)) { for (int rep_ = 0; rep_ < NREP(pw + 3); ++rep_) {
            MoeOrder S; S.G = C.G; S.c = C.vcu;     S.A = (const char*)O0; S.W = (const char*)(p.ws + WS_WD); S.wexp = (size_t)DM * DEXP * 2; S.tsB = (size_t)256 * DEXP * 2;
            moe_setup(p, fresh(C), layer, S);
            pg8::EpiDown E{(pg8::bf16_t*)KB, (const float*)(p.ws + WS_GV)};
            pg8::gemm_phase<pg8::EpiDown, MoeOrder, true, true>(C.lds + RING_OFF, DEXP, DEXP * 2, S, E, rowtab, 0);
        } } SEAM(pw + 3);
        if ((SUBMASK & 64) && IN(pw + 4)) {
            if (layer == 0) { ln_phase<1>(p, fresh(C), 0); { const Ctx Cf = fresh(C); convert_experts(p, Cf, 1, 0, Cf.vcu * NWAVES + Cf.wave, Cf.G * NWAVES); } }
            else ln_phase<2>(p, fresh(C), 1);
        }
        if (layer == 0) SEAM(8);
        }
#undef IN
#undef SEAM
#undef GRID_BAR
}

extern "C" void kernel_launch(void* const* d_in, const int* in_sizes, int n_in, void* d_out, int out_size, void* d_ws, size_t ws_size, hipStream_t stream) {
    static int grid = 0;
    if (grid == 0) {
        if (n_in != 21 || in_sizes[0] != NREAL * DM || out_size != NREAL * DM || ws_size < WS_END) { fprintf(stderr, "kernel_launch: unexpected shapes (n_in %d, in0 %d, out %d, ws %zu); nothing launched\n", n_in, n_in > 0 ? in_sizes[0] : -1, out_size, ws_size); grid = -1; return; }
        int dev = 0, cus = 0, per_cu = 0;
        if (hipGetDevice(&dev) != hipSuccess || hipDeviceGetAttribute(&cus, hipDeviceAttributeMultiprocessorCount, dev) != hipSuccess) { fprintf(stderr, "kernel_launch: device query failed\n"); grid = -1; return; }
        if (hipFuncSetAttribute((const void*)trunk_fwd, hipFuncAttributeMaxDynamicSharedMemorySize, LDS_BYTES) != hipSuccess) { fprintf(stderr, "kernel_launch: hipFuncSetAttribute failed\n"); grid = -1; return; }
        if (hipOccupancyMaxActiveBlocksPerMultiprocessor(&per_cu, (const void*)trunk_fwd, NWAVES * 64, LDS_BYTES) != hipSuccess || per_cu < 1) { fprintf(stderr, "kernel_launch: occupancy query reports %d workgroups per CU\n", per_cu); }
        (void)hipGetLastError();
        grid = cus;
    }
    if (grid < 0) return;
    if (hipMemsetAsync((char*)d_ws + WS_CTL, 0, CTL_ZERO_BYTES, stream) != hipSuccess) { fprintf(stderr, "kernel_launch: hipMemsetAsync failed\n"); return; }
    Params a{};
    const float** dst = (const float**)&a.x;
    for (int i = 0; i < 21; ++i) dst[i] = (const float*)d_in[i];
    a.out = (float*)d_out; a.ws = (unsigned char*)d_ws;
#if MK_PER_PHASE
    for (int k = 0; k < N_PHASES; ++k) { a.ph_lo = k; a.ph_hi = k + 1; a.li = 0; hipLaunchKernelGGL(trunk_fwd, dim3(grid), dim3(NWAVES * 64), LDS_BYTES, stream, a); }
#else
    a.ph_lo = 0; a.ph_hi = N_PHASES; a.li = 0;
    hipLaunchKernelGGL(trunk_fwd, dim3(grid), dim3(NWAVES * 64), LDS_BYTES, stream, a);
#endif
    const hipError_t le = hipPeekAtLastError();
    if (le != hipSuccess) fprintf(stderr, "kernel_launch: launch failed: %s\n", hipGetErrorName(le));
}
```
